# Optimizing an MI355X kernel written in HIP

```python
import math
import jax, jax.numpy as jnp
from jax import lax
import numpy as np

D_MODEL = 1024
BATCH = 4
SEQ = 4096
DEPTH = 1

N_MEM = 256
N_HEADS_A = 8
HEAD_DIM_A = 64
WIDTH_A = N_HEADS_A * HEAD_DIM_A
DILATED_PATTERNS = ((128, 1), (512, 4), (2048, 16))
N_HEADS_B = 8
QK_NOPE_DIM = 64
QK_ROPE_DIM = 32
V_DIM_B = 64
WIDTH_B = N_HEADS_B * V_DIM_B
Q_LORA_RANK = 256
KV_LORA_RANK = 128
ROPE_THETA = 10000.0
MIX_WIDTH = WIDTH_A + WIDTH_B
IN_PROJ_WIDTH = 3 * WIDTH_A + Q_LORA_RANK + KV_LORA_RANK + QK_ROPE_DIM
NUM_BUCKETS = 32
MAX_DISTANCE = 1024
N_HEADS_MEM = 4
HEAD_DIM_MEM = D_MODEL // N_HEADS_MEM
N_EXPERTS = 32
TOP_K = 4
D_EXPERT = D_MODEL
SWIGLU_LIMIT = 7.0
SWIGLU_ALPHA = 1.702
EXPERT_BLOCK = 256
Q_BLOCK = 128
EPS = 1e-6
NEG_INF = -1e30

kernel_name = "hybrid_dilated_mla_moe_encoder"


def rmsnorm(x, g):
    xf = x.astype(jnp.float32)
    y = xf * lax.rsqrt(jnp.mean(xf * xf, axis=-1, keepdims=True) + EPS)
    return (y * g.astype(jnp.float32)).astype(x.dtype)


def rope_cos_sin(positions):
    inv_freq = ROPE_THETA ** (-jnp.arange(0, QK_ROPE_DIM, 2, dtype=jnp.float32) / QK_ROPE_DIM)
    ang = positions.astype(jnp.float32)[..., None] * inv_freq
    return jnp.cos(ang), jnp.sin(ang)


def apply_rope(x, cos, sin):
    x1, x2 = jnp.split(x.astype(jnp.float32), 2, axis=-1)
    return jnp.concatenate([x1 * cos - x2 * sin, x1 * sin + x2 * cos], axis=-1).astype(x.dtype)


def rel_bucket(rel):
    nb = NUM_BUCKETS // 2
    max_exact = nb // 2
    ret = (rel > 0).astype(jnp.int32) * nb
    n = jnp.abs(rel)
    nf = jnp.maximum(n, max_exact).astype(jnp.float32)
    large = max_exact + (jnp.log(nf / max_exact) / math.log(MAX_DISTANCE / max_exact)
                         * (nb - max_exact)).astype(jnp.int32)
    large = jnp.minimum(large, nb - 1)
    return ret + jnp.where(n < max_exact, n, large)


def dilated_attention(q, k, v, positions, rel_bias):
    b, s = q.shape[:2]
    n_blocks = s // Q_BLOCK
    scale = HEAD_DIM_A ** -0.5

    def block(i):
        q0 = i * Q_BLOCK
        qb = lax.dynamic_slice_in_dim(q, q0, Q_BLOCK, axis=1)
        qpos = lax.dynamic_slice_in_dim(positions, q0, Q_BLOCK, axis=1)
        qidx = q0 + jnp.arange(Q_BLOCK)
        outs, lses = [], []
        for window, dil in DILATED_PATTERNS:
            half = window // (2 * dil)
            offs = jnp.arange(-half, half + 1) * dil
            kidx = qidx[:, None] + offs[None, :]
            valid = (kidx >= 0) & (kidx < s)
            kidx = jnp.clip(kidx, 0, s - 1)
            kg = k[:, kidx]
            vg = v[:, kidx]
            rel = positions[:, kidx] - qpos[:, :, None]
            bias = rel_bias[rel_bucket(rel)]
            sc = (jnp.einsum('bqhd,bqkhd->bqkh', qb, kg).astype(jnp.float32) * scale
                  + bias.astype(jnp.float32))
            sc = jnp.where(valid[None, :, :, None], sc, NEG_INF)
            lse = jax.nn.logsumexp(sc, axis=2)
            p = jnp.exp(sc - lse[:, :, None, :])
            outs.append(jnp.einsum('bqkh,bqkhd->bqhd', p, vg.astype(jnp.float32)))
            lses.append(lse)
        wts = jax.nn.softmax(jnp.stack(lses, axis=0), axis=0)
        o = jnp.sum(wts[..., None] * jnp.stack(outs, axis=0), axis=0)
        return o.astype(q.dtype)

    o = lax.map(block, jnp.arange(n_blocks))
    return o.transpose(1, 0, 2, 3, 4).reshape(b, s, WIDTH_A)


def mla_attention(q_nope, q_pe, k_nope, k_pe, v):
    b, s = q_nope.shape[:2]
    nb = s // Q_BLOCK
    scale = (QK_NOPE_DIM + QK_ROPE_DIM) ** -0.5

    def to_blocks(t):
        return t.reshape(b, nb, Q_BLOCK, *t.shape[2:]).swapaxes(0, 1)

    def block(args):
        qn, qp = args
        sc = (jnp.einsum('bqhd,bkhd->bhqk', qn, k_nope)
              + jnp.einsum('bqhr,bkr->bhqk', qp, k_pe)).astype(jnp.float32) * scale
        p = jax.nn.softmax(sc, axis=-1)
        return jnp.einsum('bhqk,bkhd->bqhd', p.astype(v.dtype), v)

    o = lax.map(block, (to_blocks(q_nope), to_blocks(q_pe)))
    return o.swapaxes(0, 1).reshape(b, s, WIDTH_B)


def hybrid_mixer(xn, positions, cos, sin, w_in, g_q_a, w_q_b, g_kv_a, w_kv_b,
                 rel_bias, g_out_a, g_out_b, w_o):
    b, s, _ = xn.shape
    z = xn @ w_in
    cuts = [WIDTH_A, 2 * WIDTH_A, 3 * WIDTH_A, 3 * WIDTH_A + Q_LORA_RANK,
            3 * WIDTH_A + Q_LORA_RANK + KV_LORA_RANK]
    qa, ka, va, zq, zkv, zkpe = jnp.split(z, cuts, axis=-1)
    shp_a = (b, s, N_HEADS_A, HEAD_DIM_A)
    o_a = dilated_attention(qa.reshape(shp_a), ka.reshape(shp_a), va.reshape(shp_a),
                            positions, rel_bias)
    q = (rmsnorm(zq, g_q_a) @ w_q_b).reshape(b, s, N_HEADS_B, QK_NOPE_DIM + QK_ROPE_DIM)
    q_nope, q_pe = jnp.split(q, [QK_NOPE_DIM], axis=-1)
    q_pe = apply_rope(q_pe, cos[:, :, None, :], sin[:, :, None, :])
    kv = (rmsnorm(zkv, g_kv_a) @ w_kv_b).reshape(b, s, N_HEADS_B, QK_NOPE_DIM + V_DIM_B)
    k_nope, v_b = jnp.split(kv, [QK_NOPE_DIM], axis=-1)
    k_pe = apply_rope(zkpe, cos, sin)
    o_b = mla_attention(q_nope, q_pe, k_nope, k_pe, v_b)
    o = jnp.concatenate([rmsnorm(o_a, g_out_a), rmsnorm(o_b, g_out_b)], axis=-1)
    return o @ w_o


def memory_cross_attention(hn, mem, g_mem, w_mq, w_mkv, w_mo):
    b, s, _ = hn.shape
    m = mem.shape[1]
    q = (hn @ w_mq).reshape(b, s, N_HEADS_MEM, HEAD_DIM_MEM)
    kv = (rmsnorm(mem, g_mem) @ w_mkv).reshape(b, m, 2, N_HEADS_MEM, HEAD_DIM_MEM)
    k, v = kv[:, :, 0], kv[:, :, 1]
    sc = jnp.einsum('bqhd,bmhd->bhqm', q, k).astype(jnp.float32) * HEAD_DIM_MEM ** -0.5
    p = jax.nn.softmax(sc, axis=-1)
    o = jnp.einsum('bhqm,bmhd->bqhd', p.astype(v.dtype), v).reshape(b, s, D_MODEL)
    return o @ w_mo


def moe_ffn(hn, w_router, b_router, w_gate_up, b_gate_up, w_down, b_down):
    b, s, d = hn.shape
    t = b * s
    xt = hn.reshape(t, d)
    logits = (xt @ w_router + b_router).astype(jnp.float32)
    top_val, top_idx = lax.top_k(logits, TOP_K)
    gates = jax.nn.softmax(top_val, axis=-1)
    n_assign = t * TOP_K
    flat_e = top_idx.reshape(-1)
    order = jnp.argsort(flat_e)
    sorted_e = flat_e[order]
    sorted_tok = (order // TOP_K).astype(jnp.int32)
    counts = jnp.bincount(flat_e, length=N_EXPERTS)
    padded = ((counts + EXPERT_BLOCK - 1) // EXPERT_BLOCK) * EXPERT_BLOCK
    ends = jnp.cumsum(padded)
    pad_start = ends - padded
    start = jnp.cumsum(counts) - counts
    dest = pad_start[sorted_e] + (jnp.arange(n_assign) - start[sorted_e])
    n_blk = -(-n_assign // EXPERT_BLOCK) + N_EXPERTS
    m_pad = n_blk * EXPERT_BLOCK
    tok_buf = jnp.zeros((m_pad,), jnp.int32).at[dest].set(sorted_tok)
    gate_buf = jnp.zeros((m_pad,), xt.dtype).at[dest].set(
        gates.reshape(-1)[order].astype(xt.dtype))
    block_expert = jnp.clip(
        jnp.searchsorted(ends, jnp.arange(n_blk) * EXPERT_BLOCK, side='right'),
        0, N_EXPERTS - 1)

    def expert_block(args):
        e, tok = args
        xb = xt[tok]
        gu = xb @ w_gate_up[e] + b_gate_up[e]
        gate, up = jnp.split(gu, 2, axis=-1)
        gate = jnp.minimum(gate, SWIGLU_LIMIT)
        up = jnp.clip(up, -SWIGLU_LIMIT, SWIGLU_LIMIT)
        hmid = (up + 1.0) * (gate * jax.nn.sigmoid(SWIGLU_ALPHA * gate))
        return hmid @ w_down[e] + b_down[e]

    out = lax.map(expert_block, (block_expert, tok_buf.reshape(n_blk, EXPERT_BLOCK)))
    out = out.reshape(m_pad, d) * gate_buf[:, None]
    y = jnp.zeros((t, d), xt.dtype).at[tok_buf].add(out)
    return y.reshape(b, s, d)


def setup_inputs(seed: int = 0) -> dict:
    key = jax.random.key(seed)
    ks = jax.random.split(key, 32)
    f32 = jnp.float32
    L = DEPTH

    def nrm(k, shape, scale):
        return jax.random.normal(k, shape, f32) * scale

    def gain(k, shape):
        return 1.0 + 0.05 * jax.random.normal(k, shape, f32)

    x = nrm(ks[0], (BATCH, SEQ, D_MODEL), 1.0)
    mem = nrm(ks[1], (BATCH, N_MEM, D_MODEL), 1.0)
    positions = (jnp.arange(SEQ, dtype=jnp.int32)[None, :]
                 + jax.random.randint(ks[2], (BATCH, 1), 0, 1024, dtype=jnp.int32))
    return {
        "x": x,
        "mem": mem,
        "positions": positions,
        "g_mix": gain(ks[3], (L, D_MODEL)),
        "w_in": nrm(ks[4], (L, D_MODEL, IN_PROJ_WIDTH), D_MODEL ** -0.5),
        "g_q_a": gain(ks[5], (L, Q_LORA_RANK)),
        "w_q_b": nrm(ks[6], (L, Q_LORA_RANK, N_HEADS_B * (QK_NOPE_DIM + QK_ROPE_DIM)), Q_LORA_RANK ** -0.5),
        "g_kv_a": gain(ks[7], (L, KV_LORA_RANK)),
        "w_kv_b": nrm(ks[8], (L, KV_LORA_RANK, N_HEADS_B * (QK_NOPE_DIM + V_DIM_B)), KV_LORA_RANK ** -0.5),
        "rel_bias": nrm(ks[9], (NUM_BUCKETS, N_HEADS_A), 0.5),
        "g_out_a": gain(ks[10], (L, WIDTH_A)),
        "g_out_b": gain(ks[11], (L, WIDTH_B)),
        "w_o": nrm(ks[12], (L, MIX_WIDTH, D_MODEL), MIX_WIDTH ** -0.5),
        "g_xattn": gain(ks[13], (L, D_MODEL)),
        "g_mem": gain(ks[14], (L, D_MODEL)),
        "w_mq": nrm(ks[15], (L, D_MODEL, D_MODEL), D_MODEL ** -0.5),
        "w_mkv": nrm(ks[16], (L, D_MODEL, 2 * D_MODEL), D_MODEL ** -0.5),
        "w_mo": nrm(ks[17], (L, D_MODEL, D_MODEL), D_MODEL ** -0.5),
        "g_moe": gain(ks[18], (L, D_MODEL)),
        "w_router": nrm(ks[19], (L, D_MODEL, N_EXPERTS), D_MODEL ** -0.5),
        "b_router": nrm(ks[20], (L, N_EXPERTS), 0.01),
        "w_gate_up": nrm(ks[21], (L, N_EXPERTS, D_MODEL, 2 * D_EXPERT), D_MODEL ** -0.5),
        "b_gate_up": nrm(ks[22], (L, N_EXPERTS, 2 * D_EXPERT), 0.02),
        "w_down": nrm(ks[23], (L, N_EXPERTS, D_EXPERT, D_MODEL), D_EXPERT ** -0.5),
        "b_down": nrm(ks[24], (L, N_EXPERTS, D_MODEL), 0.02),
        "g_final": gain(ks[25], (D_MODEL,)),
    }


def reference(x, mem, positions, g_mix, w_in, g_q_a, w_q_b, g_kv_a, w_kv_b, rel_bias,
              g_out_a, g_out_b, w_o, g_xattn, g_mem, w_mq, w_mkv, w_mo, g_moe,
              w_router, b_router, w_gate_up, b_gate_up, w_down, b_down, g_final):
    cos, sin = rope_cos_sin(positions)
    h = x
    for l in range(DEPTH):
        h = h + hybrid_mixer(rmsnorm(h, g_mix[l]), positions, cos, sin, w_in[l], g_q_a[l],
                             w_q_b[l], g_kv_a[l], w_kv_b[l], rel_bias, g_out_a[l],
                             g_out_b[l], w_o[l])
        h = h + memory_cross_attention(rmsnorm(h, g_xattn[l]), mem, g_mem[l], w_mq[l],
                                       w_mkv[l], w_mo[l])
        h = h + moe_ffn(rmsnorm(h, g_moe[l]), w_router[l], b_router[l], w_gate_up[l],
                        b_gate_up[l], w_down[l], b_down[l])
    return rmsnorm(h, g_final)
```

```cpp
#include <hip/hip_runtime.h>
#include <stdint.h>
#include <string.h>
#include <math.h>

namespace {
constexpr int NB = 4, S = 4096, D = 1024, T = NB * S, NMEM = 256, INW = 1952;
constexpr int NE = 32, TOPK = 4, NA = T * TOPK;
constexpr int MT = 64;
constexpr int MPAD = NA + NE * MT;
constexpr int NTILE = MPAD / MT;

__device__ __forceinline__ int rel_bucket(int rel) {
    int n = rel < 0 ? -rel : rel;
    int b;
    if (n < 8) b = n; else if (n < 15) b = 8; else if (n < 27) b = 9; else if (n < 50) b = 10; else if (n < 91) b = 11;
    else if (n < 166) b = 12; else if (n < 305) b = 13; else if (n < 559) b = 14; else b = 15;
    return b + (rel > 0 ? 16 : 0);
}

__global__ void k_rmsnorm(const float* __restrict__ x, int ldx, const float* __restrict__ g, float* __restrict__ y, int ldy, int Dn) {
    __shared__ float red[256];
    const int row = blockIdx.x, t = threadIdx.x;
    const float* xr = x + (size_t)row * ldx;
    float s = 0.f;
    for (int i = t; i < Dn; i += 256) { float v = xr[i]; s += v * v; }
    red[t] = s; __syncthreads();
    for (int o = 128; o > 0; o >>= 1) { if (t < o) red[t] += red[t + o]; __syncthreads(); }
    const float r = rsqrtf(red[0] / (float)Dn + 1e-6f);
    for (int i = t; i < Dn; i += 256) y[(size_t)row * ldy + i] = xr[i] * r * g[i];
}

struct GemmArgs {
    const float* A; const float* W; const float* bias;
    const int* tile_expert;
    const int* row_flat;
    const float* gatev;
    const float* R;
    float* C;
    long wstride, bstride;
    int lda, ldw, ldc, M, N, K;
    int mode;
    int pad_;
};

template <int DUAL>
__global__ void __launch_bounds__(256) k_sgemm(GemmArgs a) {
    __shared__ float As[16][68];
    __shared__ float Ws[16][68];
    __shared__ float Ws2[DUAL ? 16 : 1][68];
    const int t = threadIdx.x, tx = t & 15, ty = t >> 4;
    const int m0 = blockIdx.y * 64, n0 = blockIdx.x * 64;
    int e = 0;
    if (a.tile_expert) { e = a.tile_expert[blockIdx.y]; if (e < 0) return; }
    const float* W = a.W + (size_t)e * a.wstride;
    const float* bias = a.bias ? a.bias + (size_t)e * a.bstride : nullptr;
    const int lr = t >> 2, lk = (t & 3) * 4;
    long arow = m0 + lr;
    if (a.mode == 1) { int f = a.row_flat[m0 + lr]; arow = f >= 0 ? (f >> 2) : 0; }
    const float* Ap = a.A + (size_t)arow * a.lda + lk;
    const int wk = t >> 4, wn = (t & 15) * 4;
    float acc[4][4] = {}, acc2[4][4] = {};
    for (int k0 = 0; k0 < a.K; k0 += 16) {
        const float4 av = *(const float4*)(Ap + k0);
        As[lk + 0][lr] = av.x; As[lk + 1][lr] = av.y; As[lk + 2][lr] = av.z; As[lk + 3][lr] = av.w;
        float4 wv = make_float4(0.f, 0.f, 0.f, 0.f), wv2 = wv;
        if (n0 + wn < a.N) {
            wv = *(const float4*)(W + (size_t)(k0 + wk) * a.ldw + n0 + wn);
            if (DUAL) wv2 = *(const float4*)(W + (size_t)(k0 + wk) * a.ldw + n0 + wn + 1024);
        }
        *(float4*)&Ws[wk][wn] = wv;
        if (DUAL) *(float4*)&Ws2[wk][wn] = wv2;
        __syncthreads();
#pragma unroll
        for (int k = 0; k < 16; ++k) {
            const float4 a4 = *(const float4*)&As[k][ty * 4];
            const float4 w4 = *(const float4*)&Ws[k][tx * 4];
            const float aa[4] = {a4.x, a4.y, a4.z, a4.w}, ww[4] = {w4.x, w4.y, w4.z, w4.w};
#pragma unroll
            for (int i = 0; i < 4; ++i)
#pragma unroll
                for (int j = 0; j < 4; ++j) acc[i][j] += aa[i] * ww[j];
            if (DUAL) {
                const float4 v4 = *(const float4*)&Ws2[k][tx * 4];
                const float vv[4] = {v4.x, v4.y, v4.z, v4.w};
#pragma unroll
                for (int i = 0; i < 4; ++i)
#pragma unroll
                    for (int j = 0; j < 4; ++j) acc2[i][j] += aa[i] * vv[j];
            }
        }
        __syncthreads();
    }
#pragma unroll
    for (int i = 0; i < 4; ++i) {
        const int r = m0 + ty * 4 + i;
        long crow = r; float gsc = 1.f;
        if (a.mode == 2) { const int f = a.row_flat[r]; if (f < 0) continue; crow = f; gsc = a.gatev[f]; }
#pragma unroll
        for (int j = 0; j < 4; ++j) {
            const int n = n0 + tx * 4 + j;
            if (n >= a.N) continue;
            float v = acc[i][j] + (bias ? bias[n] : 0.f);
            if (DUAL) {
                float gte = v, up = acc2[i][j] + bias[n + 1024];
                gte = fminf(gte, 7.0f); up = fminf(fmaxf(up, -7.0f), 7.0f);
                v = (up + 1.0f) * (gte * (1.0f / (1.0f + expf(-1.702f * gte))));
            }
            if (a.mode == 2) v *= gsc;
            if (a.R) v += a.R[(size_t)crow * a.ldc + n];
            a.C[(size_t)crow * a.ldc + n] = v;
        }
    }
}

struct RopeTab { double inv_freq_rev[16]; };
__global__ void k_rope(float* __restrict__ q, const float* __restrict__ z, float* __restrict__ kpe, const int* __restrict__ pos, RopeTab tab) {
    const int idx = blockIdx.x * 256 + threadIdx.x;
    if (idx >= T * 16) return;
    const int t = idx >> 4, j = idx & 15;
    const double rev = (double)pos[t] * tab.inv_freq_rev[j];
    const float fr = (float)(rev - floor(rev));
    const float sn = __builtin_amdgcn_sinf(fr), cs = __builtin_amdgcn_cosf(fr);
    {
        const float x1 = z[(size_t)t * INW + 1920 + j], x2 = z[(size_t)t * INW + 1936 + j];
        kpe[(size_t)t * 32 + j] = x1 * cs - x2 * sn; kpe[(size_t)t * 32 + 16 + j] = x1 * sn + x2 * cs;
    }
    for (int h = 0; h < 8; ++h) {
        float* p = q + (size_t)t * 768 + h * 96 + 64;
        const float x1 = p[j], x2 = p[16 + j];
        p[j] = x1 * cs - x2 * sn; p[16 + j] = x1 * sn + x2 * cs;
    }
}

__global__ void __launch_bounds__(256) k_dilated(const float* __restrict__ z, const int* __restrict__ pos, const float* __restrict__ rel_bias, float* __restrict__ oa) {
    const int idx = blockIdx.x * 256 + threadIdx.x;
    const int h = idx & 7, tok = idx >> 3, b = tok / S, i = tok % S;
    float q[64], acc[64];
    const float* qp = z + (size_t)tok * INW + h * 64;
#pragma unroll
    for (int d = 0; d < 64; ++d) { q[d] = qp[d]; acc[d] = 0.f; }
    float m = -3.0e38f, l = 0.f;
    const int qpos = pos[tok];
    for (int g = 0; g < 3; ++g) {
        const int dil = g == 0 ? 1 : (g == 1 ? 4 : 16);
        for (int j = -64; j <= 64; ++j) {
            const int kidx = i + j * dil;
            if (kidx < 0 || kidx >= S) continue;
            const int kt = b * S + kidx;
            const float* kp = z + (size_t)kt * INW + 512 + h * 64;
            const float* vp = z + (size_t)kt * INW + 1024 + h * 64;
            float s = 0.f;
#pragma unroll
            for (int d = 0; d < 64; ++d) s += q[d] * kp[d];
            s = s * 0.125f + rel_bias[rel_bucket(pos[kt] - qpos) * 8 + h];
            const float mn = fmaxf(m, s), corr = expf(m - mn), p = expf(s - mn);
            l = l * corr + p;
#pragma unroll
            for (int d = 0; d < 64; ++d) acc[d] = acc[d] * corr + p * vp[d];
            m = mn;
        }
    }
    const float inv = 1.f / l;
    float* op = oa + (size_t)tok * 512 + h * 64;
#pragma unroll
    for (int d = 0; d < 64; ++d) op[d] = acc[d] * inv;
}

__global__ void __launch_bounds__(256) k_mla(const float* __restrict__ q, const float* __restrict__ kv, const float* __restrict__ kpe, float* __restrict__ ob) {
    const int bh = blockIdx.y, b = bh >> 3, h = bh & 7;
    const int i = blockIdx.x * 256 + threadIdx.x;
    const int tok = b * S + i;
    float qq[96], acc[64];
    const float* qp = q + (size_t)tok * 768 + h * 96;
    const float scale = 0.10206207261596577f;
#pragma unroll
    for (int d = 0; d < 96; ++d) qq[d] = qp[d] * scale;
#pragma unroll
    for (int d = 0; d < 64; ++d) acc[d] = 0.f;
    float m = -3.0e38f, l = 0.f;
    for (int k = 0; k < S; ++k) {
        const float* kp = kv + (size_t)(b * S + k) * 1024 + h * 128;
        const float* pp = kpe + (size_t)(b * S + k) * 32;
        float s = 0.f;
#pragma unroll
        for (int d = 0; d < 64; ++d) s += qq[d] * kp[d];
#pragma unroll
        for (int d = 0; d < 32; ++d) s += qq[64 + d] * pp[d];
        const float mn = fmaxf(m, s), corr = expf(m - mn), p = expf(s - mn);
        l = l * corr + p;
#pragma unroll
        for (int d = 0; d < 64; ++d) acc[d] = acc[d] * corr + p * kp[64 + d];
        m = mn;
    }
    const float inv = 1.f / l;
    float* op = ob + (size_t)tok * 512 + h * 64;
#pragma unroll
    for (int d = 0; d < 64; ++d) op[d] = acc[d] * inv;
}

__global__ void __launch_bounds__(256) k_xattn(const float* __restrict__ mq, const float* __restrict__ mkv, float* __restrict__ mo) {
    __shared__ float qs[256], ps[256], red[256];
    const int tok = blockIdx.x >> 2, h = blockIdx.x & 3, b = tok / S, t = threadIdx.x;
    qs[t] = mq[(size_t)tok * 1024 + h * 256 + t];
    __syncthreads();
    const float* kp = mkv + (size_t)(b * NMEM + t) * 2048 + h * 256;
    float s = 0.f;
    for (int d = 0; d < 256; ++d) s += qs[d] * kp[d];
    s *= 0.0625f;
    red[t] = s; __syncthreads();
    for (int o = 128; o > 0; o >>= 1) { if (t < o) red[t] = fmaxf(red[t], red[t + o]); __syncthreads(); }
    const float mx = red[0]; __syncthreads();
    const float p = expf(s - mx);
    red[t] = p; ps[t] = p; __syncthreads();
    for (int o = 128; o > 0; o >>= 1) { if (t < o) red[t] += red[t + o]; __syncthreads(); }
    const float inv = 1.f / red[0];
    float o = 0.f;
    for (int mm = 0; mm < 256; ++mm) o += ps[mm] * mkv[(size_t)(b * NMEM + mm) * 2048 + 1024 + h * 256 + t];
    mo[(size_t)tok * 1024 + h * 256 + t] = o * inv;
}

__global__ void k_topk(const float* __restrict__ logits, int* __restrict__ topi, float* __restrict__ topg) {
    const int t = blockIdx.x * 256 + threadIdx.x;
    if (t >= T) return;
    int c0 = -1, c1 = -1, c2 = -1, c3 = -1; float v0 = 0, v1 = 0, v2 = 0, v3 = 0;
    for (int k = 0; k < 4; ++k) {
        float best = -3.0e38f; int bi = 0;
        for (int e = 0; e < 32; ++e) {
            const float v = logits[(size_t)t * 32 + e];
            if (e == c0 || e == c1 || e == c2 || e == c3) continue;
            if (v > best) { best = v; bi = e; }
        }
        if (k == 0) { c0 = bi; v0 = best; } else if (k == 1) { c1 = bi; v1 = best; } else if (k == 2) { c2 = bi; v2 = best; } else { c3 = bi; v3 = best; }
    }
    const float e0 = 1.f, e1 = expf(v1 - v0), e2 = expf(v2 - v0), e3 = expf(v3 - v0), inv = 1.f / (e0 + e1 + e2 + e3);
    topi[t * 4 + 0] = c0; topi[t * 4 + 1] = c1; topi[t * 4 + 2] = c2; topi[t * 4 + 3] = c3;
    topg[t * 4 + 0] = e0 * inv; topg[t * 4 + 1] = e1 * inv; topg[t * 4 + 2] = e2 * inv; topg[t * 4 + 3] = e3 * inv;
}
__global__ void k_moe_count(const int* __restrict__ topi, int* __restrict__ counts) {
    const int a = blockIdx.x * 256 + threadIdx.x;
    if (a < NA) atomicAdd(&counts[topi[a]], 1);
}
__global__ void k_moe_offsets(const int* __restrict__ counts, int* __restrict__ pad_start, int* __restrict__ tile_expert) {
    if (threadIdx.x != 0 || blockIdx.x != 0) return;
    int run = 0;
    for (int e = 0; e < NE; ++e) {
        pad_start[e] = run;
        const int nt = (counts[e] + MT - 1) / MT;
        for (int i = 0; i < nt; ++i) tile_expert[run / MT + i] = e;
        run += nt * MT;
    }
    for (int i = run / MT; i < NTILE; ++i) tile_expert[i] = -1;
}
__global__ void k_fill_i32(int* p, int v, int n) { const int i = blockIdx.x * 256 + threadIdx.x; if (i < n) p[i] = v; }
__global__ void k_moe_scatter(const int* __restrict__ topi, const int* __restrict__ pad_start, int* __restrict__ cursor, int* __restrict__ row_flat) {
    const int a = blockIdx.x * 256 + threadIdx.x;
    if (a >= NA) return;
    const int e = topi[a];
    const int slot = atomicAdd(&cursor[e], 1);
    row_flat[pad_start[e] + slot] = a;
}
__global__ void k_final(const float* __restrict__ h2, const float* __restrict__ ybuf, const float* __restrict__ g, float* __restrict__ out) {
    __shared__ float red[256];
    const int tok = blockIdx.x, t = threadIdx.x;
    float v[4]; float s = 0.f;
#pragma unroll
    for (int c = 0; c < 4; ++c) {
        const int i = t + c * 256;
        float x = h2[(size_t)tok * D + i];
#pragma unroll
        for (int k = 0; k < 4; ++k) x += ybuf[((size_t)tok * 4 + k) * D + i];
        v[c] = x; s += x * x;
    }
    red[t] = s; __syncthreads();
    for (int o = 128; o > 0; o >>= 1) { if (t < o) red[t] += red[t + o]; __syncthreads(); }
    const float r = rsqrtf(red[0] / (float)D + 1e-6f);
#pragma unroll
    for (int c = 0; c < 4; ++c) { const int i = t + c * 256; out[(size_t)tok * D + i] = v[c] * r * g[i]; }
}

void gemm(hipStream_t st, const float* A, int lda, const float* W, int ldw, float* C, int ldc, int M, int N, int K,
          const float* bias = nullptr, const float* R = nullptr) {
    GemmArgs a; memset(&a, 0, sizeof(a)); a.A = A; a.lda = lda; a.W = W; a.ldw = ldw; a.wstride = 0; a.bias = bias; a.bstride = 0; a.tile_expert = nullptr; a.row_flat = nullptr;
    a.gatev = nullptr; a.R = R; a.C = C; a.ldc = ldc; a.M = M; a.N = N; a.K = K; a.mode = 0; a.pad_ = 0;
    hipLaunchKernelGGL(k_sgemm<0>, dim3((N + 63) / 64, M / 64), dim3(256), 0, st, a);
}
}

extern "C" void kernel_launch(void* const* d_in, const int* in_sizes, int n_in, void* d_out, int out_size, void* d_ws, size_t ws_size, hipStream_t stream) {
    const float* x = (const float*)d_in[0];
    const float* mem = (const float*)d_in[1];
    const int* pos = (const int*)d_in[2];
    const float* g_mix = (const float*)d_in[3];
    const float* w_in = (const float*)d_in[4];
    const float* g_q_a = (const float*)d_in[5];
    const float* w_q_b = (const float*)d_in[6];
    const float* g_kv_a = (const float*)d_in[7];
    const float* w_kv_b = (const float*)d_in[8];
    const float* rel_bias = (const float*)d_in[9];
    const float* g_out_a = (const float*)d_in[10];
    const float* g_out_b = (const float*)d_in[11];
    const float* w_o = (const float*)d_in[12];
    const float* g_xattn = (const float*)d_in[13];
    const float* g_mem = (const float*)d_in[14];
    const float* w_mq = (const float*)d_in[15];
    const float* w_mkv = (const float*)d_in[16];
    const float* w_mo = (const float*)d_in[17];
    const float* g_moe = (const float*)d_in[18];
    const float* w_router = (const float*)d_in[19];
    const float* b_router = (const float*)d_in[20];
    const float* w_gate_up = (const float*)d_in[21];
    const float* b_gate_up = (const float*)d_in[22];
    const float* w_down = (const float*)d_in[23];
    const float* b_down = (const float*)d_in[24];
    const float* g_final = (const float*)d_in[25];
    float* out = (float*)d_out;

    float* w = (float*)d_ws; size_t off = 0;
    auto take = [&](size_t n) { float* p = w + off; off += (n + 63) & ~(size_t)63; return p; };
    float* h1 = take((size_t)T * D);
    float* h2 = take((size_t)T * D);
    float* hn = take((size_t)T * D);
    float* mq = take((size_t)T * D);
    float* mo = take((size_t)T * D);
    float* memn = take((size_t)NB * NMEM * D);
    float* mkv = take((size_t)NB * NMEM * 2 * D);
    float* logits = take((size_t)T * NE);
    float* topg = take((size_t)NA);
    int* topi = (int*)take((size_t)NA);
    int* counts = (int*)take(64);
    int* cursor = counts + 32;
    int* pad_start = (int*)take(64);
    int* tile_expert = (int*)take(NTILE);
    int* row_flat = (int*)take(MPAD);
    float* reg = take(0); const size_t reg0 = off;
    float* z = take((size_t)T * INW);
    float* qn = take((size_t)T * 256);
    float* kvn = take((size_t)T * 128);
    float* q = take((size_t)T * 768);
    float* kvb = take((size_t)T * 1024);
    float* kpe = take((size_t)T * 32);
    float* oa = take((size_t)T * 512);
    float* ob = take((size_t)T * 512);
    float* omix = take((size_t)T * D);
    off = reg0;
    float* hmid = take((size_t)MPAD * D);
    float* ybuf = take((size_t)NA * D);
    (void)reg; (void)ws_size; (void)in_sizes; (void)n_in; (void)out_size;

    hipLaunchKernelGGL(k_rmsnorm, dim3(T), dim3(256), 0, stream, x, D, g_mix, hn, D, D);
    gemm(stream, hn, D, w_in, INW, z, INW, T, INW, D);
    hipLaunchKernelGGL(k_dilated, dim3(T * 8 / 256), dim3(256), 0, stream, z, pos, rel_bias, oa);
    hipLaunchKernelGGL(k_rmsnorm, dim3(T), dim3(256), 0, stream, z + 1536, INW, g_q_a, qn, 256, 256);
    hipLaunchKernelGGL(k_rmsnorm, dim3(T), dim3(256), 0, stream, z + 1792, INW, g_kv_a, kvn, 128, 128);
    gemm(stream, qn, 256, w_q_b, 768, q, 768, T, 768, 256);
    gemm(stream, kvn, 128, w_kv_b, 1024, kvb, 1024, T, 1024, 128);
    RopeTab tab; memset(&tab, 0, sizeof(tab));
    for (int j = 0; j < 16; ++j) tab.inv_freq_rev[j] = pow(10000.0, -(double)j / 16.0) / 6.283185307179586476925287;
    hipLaunchKernelGGL(k_rope, dim3(T * 16 / 256), dim3(256), 0, stream, q, z, kpe, pos, tab);
    hipLaunchKernelGGL(k_mla, dim3(S / 256, NB * 8), dim3(256), 0, stream, q, kvb, kpe, ob);
    hipLaunchKernelGGL(k_rmsnorm, dim3(T), dim3(256), 0, stream, oa, 512, g_out_a, omix, D, 512);
    hipLaunchKernelGGL(k_rmsnorm, dim3(T), dim3(256), 0, stream, ob, 512, g_out_b, omix + 512, D, 512);
    gemm(stream, omix, D, w_o, D, h1, D, T, D, D, nullptr, x);
    hipLaunchKernelGGL(k_rmsnorm, dim3(T), dim3(256), 0, stream, h1, D, g_xattn, hn, D, D);
    gemm(stream, hn, D, w_mq, D, mq, D, T, D, D);
    hipLaunchKernelGGL(k_rmsnorm, dim3(NB * NMEM), dim3(256), 0, stream, mem, D, g_mem, memn, D, D);
    gemm(stream, memn, D, w_mkv, 2 * D, mkv, 2 * D, NB * NMEM, 2 * D, D);
    hipLaunchKernelGGL(k_xattn, dim3(T * 4), dim3(256), 0, stream, mq, mkv, mo);
    gemm(stream, mo, D, w_mo, D, h2, D, T, D, D, nullptr, h1);
    hipLaunchKernelGGL(k_rmsnorm, dim3(T), dim3(256), 0, stream, h2, D, g_moe, hn, D, D);
    gemm(stream, hn, D, w_router, NE, logits, NE, T, NE, D, b_router);
    hipLaunchKernelGGL(k_topk, dim3(T / 256), dim3(256), 0, stream, logits, topi, topg);
    hipMemsetAsync(counts, 0, 64 * sizeof(int), stream);
    hipLaunchKernelGGL(k_moe_count, dim3(NA / 256), dim3(256), 0, stream, topi, counts);
    hipLaunchKernelGGL(k_moe_offsets, dim3(1), dim3(64), 0, stream, counts, pad_start, tile_expert);
    hipLaunchKernelGGL(k_fill_i32, dim3((MPAD + 255) / 256), dim3(256), 0, stream, row_flat, -1, MPAD);
    hipLaunchKernelGGL(k_moe_scatter, dim3(NA / 256), dim3(256), 0, stream, topi, pad_start, cursor, row_flat);
    {
        GemmArgs a; memset(&a, 0, sizeof(a)); a.A = hn; a.lda = D; a.W = w_gate_up; a.ldw = 2 * D; a.wstride = (long)D * 2 * D; a.bias = b_gate_up; a.bstride = 2 * D;
        a.tile_expert = tile_expert; a.row_flat = row_flat; a.gatev = nullptr; a.R = nullptr; a.C = hmid; a.ldc = D; a.M = MPAD; a.N = D; a.K = D; a.mode = 1; a.pad_ = 0;
        hipLaunchKernelGGL(k_sgemm<1>, dim3(D / 64, NTILE), dim3(256), 0, stream, a);
        GemmArgs b; memset(&b, 0, sizeof(b)); b.A = hmid; b.lda = D; b.W = w_down; b.ldw = D; b.wstride = (long)D * D; b.bias = b_down; b.bstride = D;
        b.tile_expert = tile_expert; b.row_flat = row_flat; b.gatev = topg; b.R = nullptr; b.C = ybuf; b.ldc = D; b.M = MPAD; b.N = D; b.K = D; b.mode = 2; b.pad_ = 0;
        hipLaunchKernelGGL(k_sgemm<0>, dim3(D / 64, NTILE), dim3(256), 0, stream, b);
    }
    hipLaunchKernelGGL(k_final, dim3(T), dim3(256), 0, stream, h2, ybuf, g_final, out);
}
```

```cpp
#include <hip/hip_runtime.h>
#include <stdint.h>
#include <string.h>
#include <math.h>

namespace {
constexpr int NB = 4, S = 4096, D = 1024, T = NB * S, NMEM = 256, INW = 1952;
constexpr int NE = 32, TOPK = 4, NA = T * TOPK;
constexpr int MT = 64;
constexpr int MPAD = NA + NE * MT;
constexpr int NTILE = MPAD / MT;

__device__ __forceinline__ int rel_bucket(int rel) {
    int n = rel < 0 ? -rel : rel;
    int b;
    if (n < 8) b = n; else if (n < 15) b = 8; else if (n < 27) b = 9; else if (n < 50) b = 10; else if (n < 91) b = 11;
    else if (n < 166) b = 12; else if (n < 305) b = 13; else if (n < 559) b = 14; else b = 15;
    return b + (rel > 0 ? 16 : 0);
}

__global__ void k_rmsnorm(const float* __restrict__ x, int ldx, const float* __restrict__ g, float* __restrict__ y, int ldy, int Dn) {
    __shared__ float red[256];
    const int row = blockIdx.x, t = threadIdx.x;
    const float* xr = x + (size_t)row * ldx;
    float s = 0.f;
    for (int i = t; i < Dn; i += 256) { float v = xr[i]; s += v * v; }
    red[t] = s; __syncthreads();
    for (int o = 128; o > 0; o >>= 1) { if (t < o) red[t] += red[t + o]; __syncthreads(); }
    const float r = rsqrtf(red[0] / (float)Dn + 1e-6f);
    for (int i = t; i < Dn; i += 256) y[(size_t)row * ldy + i] = xr[i] * r * g[i];
}

struct GemmArgs {
    const float* A; const float* W; const float* bias;
    const int* tile_expert;
    const int* row_flat;
    const float* gatev;
    const float* R;
    float* C;
    long wstride, bstride;
    int lda, ldw, ldc, M, N, K;
    int mode;
    int pad_;
};

template <int DUAL>
__global__ void __launch_bounds__(256) k_sgemm(GemmArgs a) {
    __shared__ float As[16][68];
    __shared__ float Ws[16][68];
    __shared__ float Ws2[DUAL ? 16 : 1][68];
    const int t = threadIdx.x, tx = t & 15, ty = t >> 4;
    const int m0 = blockIdx.y * 64, n0 = blockIdx.x * 64;
    int e = 0;
    if (a.tile_expert) { e = a.tile_expert[blockIdx.y]; if (e < 0) return; }
    const float* W = a.W + (size_t)e * a.wstride;
    const float* bias = a.bias ? a.bias + (size_t)e * a.bstride : nullptr;
    const int lr = t >> 2, lk = (t & 3) * 4;
    long arow = m0 + lr;
    if (a.mode == 1) { int f = a.row_flat[m0 + lr]; arow = f >= 0 ? (f >> 2) : 0; }
    const float* Ap = a.A + (size_t)arow * a.lda + lk;
    const int wk = t >> 4, wn = (t & 15) * 4;
    float acc[4][4] = {}, acc2[4][4] = {};
    for (int k0 = 0; k0 < a.K; k0 += 16) {
        const float4 av = *(const float4*)(Ap + k0);
        As[lk + 0][lr] = av.x; As[lk + 1][lr] = av.y; As[lk + 2][lr] = av.z; As[lk + 3][lr] = av.w;
        float4 wv = make_float4(0.f, 0.f, 0.f, 0.f), wv2 = wv;
        if (n0 + wn < a.N) {
            wv = *(const float4*)(W + (size_t)(k0 + wk) * a.ldw + n0 + wn);
            if (DUAL) wv2 = *(const float4*)(W + (size_t)(k0 + wk) * a.ldw + n0 + wn + 1024);
        }
        *(float4*)&Ws[wk][wn] = wv;
        if (DUAL) *(float4*)&Ws2[wk][wn] = wv2;
        __syncthreads();
#pragma unroll
        for (int k = 0; k < 16; ++k) {
            const float4 a4 = *(const float4*)&As[k][ty * 4];
            const float4 w4 = *(const float4*)&Ws[k][tx * 4];
            const float aa[4] = {a4.x, a4.y, a4.z, a4.w}, ww[4] = {w4.x, w4.y, w4.z, w4.w};
#pragma unroll
            for (int i = 0; i < 4; ++i)
#pragma unroll
                for (int j = 0; j < 4; ++j) acc[i][j] += aa[i] * ww[j];
            if (DUAL) {
                const float4 v4 = *(const float4*)&Ws2[k][tx * 4];
                const float vv[4] = {v4.x, v4.y, v4.z, v4.w};
#pragma unroll
                for (int i = 0; i < 4; ++i)
#pragma unroll
                    for (int j = 0; j < 4; ++j) acc2[i][j] += aa[i] * vv[j];
            }
        }
        __syncthreads();
    }
#pragma unroll
    for (int i = 0; i < 4; ++i) {
        const int r = m0 + ty * 4 + i;
        long crow = r; float gsc = 1.f;
        if (a.mode == 2) { const int f = a.row_flat[r]; if (f < 0) continue; crow = f; gsc = a.gatev[f]; }
#pragma unroll
        for (int j = 0; j < 4; ++j) {
            const int n = n0 + tx * 4 + j;
            if (n >= a.N) continue;
            float v = acc[i][j] + (bias ? bias[n] : 0.f);
            if (DUAL) {
                float gte = v, up = acc2[i][j] + bias[n + 1024];
                gte = fminf(gte, 7.0f); up = fminf(fmaxf(up, -7.0f), 7.0f);
                v = (up + 1.0f) * (gte * (1.0f / (1.0f + expf(-1.702f * gte))));
            }
            if (a.mode == 2) { atomicAdd(&a.C[(size_t)(crow >> 2) * a.ldc + n], v * gsc); continue; }
            if (a.R) v += a.R[(size_t)crow * a.ldc + n];
            a.C[(size_t)crow * a.ldc + n] = v;
        }
    }
}

struct RopeTab { double inv_freq_rev[16]; };
__global__ void k_rope(float* __restrict__ q, const float* __restrict__ z, float* __restrict__ kpe, const int* __restrict__ pos, RopeTab tab) {
    const int idx = blockIdx.x * 256 + threadIdx.x;
    if (idx >= T * 16) return;
    const int t = idx >> 4, j = idx & 15;
    const double rev = (double)pos[t] * tab.inv_freq_rev[j];
    const float fr = (float)(rev - floor(rev));
    const float sn = __builtin_amdgcn_sinf(fr), cs = __builtin_amdgcn_cosf(fr);
    {
        const float x1 = z[(size_t)t * INW + 1920 + j], x2 = z[(size_t)t * INW + 1936 + j];
        kpe[(size_t)t * 32 + j] = x1 * cs - x2 * sn; kpe[(size_t)t * 32 + 16 + j] = x1 * sn + x2 * cs;
    }
    for (int h = 0; h < 8; ++h) {
        float* p = q + (size_t)t * 768 + h * 96 + 64;
        const float x1 = p[j], x2 = p[16 + j];
        p[j] = x1 * cs - x2 * sn; p[16 + j] = x1 * sn + x2 * cs;
    }
}

__global__ void __launch_bounds__(256) k_dilated(const float* __restrict__ z, const int* __restrict__ pos, const float* __restrict__ rel_bias, float* __restrict__ oa) {
    const int idx = blockIdx.x * 256 + threadIdx.x;
    const int h = idx & 7, tok = idx >> 3, b = tok / S, i = tok % S;
    float q[64], acc[64];
    const float* qp = z + (size_t)tok * INW + h * 64;
#pragma unroll
    for (int d = 0; d < 64; ++d) { q[d] = qp[d]; acc[d] = 0.f; }
    float m = -3.0e38f, l = 0.f;
    const int qpos = pos[tok];
    for (int g = 0; g < 3; ++g) {
        const int dil = g == 0 ? 1 : (g == 1 ? 4 : 16);
        for (int j = -64; j <= 64; ++j) {
            const int kidx = i + j * dil;
            if (kidx < 0 || kidx >= S) continue;
            const int kt = b * S + kidx;
            const float* kp = z + (size_t)kt * INW + 512 + h * 64;
            const float* vp = z + (size_t)kt * INW + 1024 + h * 64;
            float s = 0.f;
#pragma unroll
            for (int d = 0; d < 64; ++d) s += q[d] * kp[d];
            s = s * 0.125f + rel_bias[rel_bucket(pos[kt] - qpos) * 8 + h];
            const float mn = fmaxf(m, s), corr = expf(m - mn), p = expf(s - mn);
            l = l * corr + p;
#pragma unroll
            for (int d = 0; d < 64; ++d) acc[d] = acc[d] * corr + p * vp[d];
            m = mn;
        }
    }
    const float inv = 1.f / l;
    float* op = oa + (size_t)tok * 512 + h * 64;
#pragma unroll
    for (int d = 0; d < 64; ++d) op[d] = acc[d] * inv;
}

__global__ void __launch_bounds__(256) k_mla(const float* __restrict__ q, const float* __restrict__ kv, const float* __restrict__ kpe, float* __restrict__ ob) {
    const int bh = blockIdx.y, b = bh >> 3, h = bh & 7;
    const int i = blockIdx.x * 256 + threadIdx.x;
    const int tok = b * S + i;
    float qq[96], acc[64];
    const float* qp = q + (size_t)tok * 768 + h * 96;
    const float scale = 0.10206207261596577f;
#pragma unroll
    for (int d = 0; d < 96; ++d) qq[d] = qp[d] * scale;
#pragma unroll
    for (int d = 0; d < 64; ++d) acc[d] = 0.f;
    float m = -3.0e38f, l = 0.f;
    for (int k = 0; k < S; ++k) {
        const float* kp = kv + (size_t)(b * S + k) * 1024 + h * 128;
        const float* pp = kpe + (size_t)(b * S + k) * 32;
        float s = 0.f;
#pragma unroll
        for (int d = 0; d < 64; ++d) s += qq[d] * kp[d];
#pragma unroll
        for (int d = 0; d < 32; ++d) s += qq[64 + d] * pp[d];
        const float mn = fmaxf(m, s), corr = expf(m - mn), p = expf(s - mn);
        l = l * corr + p;
#pragma unroll
        for (int d = 0; d < 64; ++d) acc[d] = acc[d] * corr + p * kp[64 + d];
        m = mn;
    }
    const float inv = 1.f / l;
    float* op = ob + (size_t)tok * 512 + h * 64;
#pragma unroll
    for (int d = 0; d < 64; ++d) op[d] = acc[d] * inv;
}

__global__ void __launch_bounds__(256) k_xattn(const float* __restrict__ mq, const float* __restrict__ mkv, float* __restrict__ mo) {
    __shared__ float qs[256], ps[256], red[256];
    const int tok = blockIdx.x >> 2, h = blockIdx.x & 3, b = tok / S, t = threadIdx.x;
    qs[t] = mq[(size_t)tok * 1024 + h * 256 + t];
    __syncthreads();
    const float* kp = mkv + (size_t)(b * NMEM + t) * 2048 + h * 256;
    float s = 0.f;
    for (int d = 0; d < 256; ++d) s += qs[d] * kp[d];
    s *= 0.0625f;
    red[t] = s; __syncthreads();
    for (int o = 128; o > 0; o >>= 1) { if (t < o) red[t] = fmaxf(red[t], red[t + o]); __syncthreads(); }
    const float mx = red[0]; __syncthreads();
    const float p = expf(s - mx);
    red[t] = p; ps[t] = p; __syncthreads();
    for (int o = 128; o > 0; o >>= 1) { if (t < o) red[t] += red[t + o]; __syncthreads(); }
    const float inv = 1.f / red[0];
    float o = 0.f;
    for (int mm = 0; mm < 256; ++mm) o += ps[mm] * mkv[(size_t)(b * NMEM + mm) * 2048 + 1024 + h * 256 + t];
    mo[(size_t)tok * 1024 + h * 256 + t] = o * inv;
}

__global__ void k_topk(const float* __restrict__ logits, int* __restrict__ topi, float* __restrict__ topg) {
    const int t = blockIdx.x * 256 + threadIdx.x;
    if (t >= T) return;
    int c0 = -1, c1 = -1, c2 = -1, c3 = -1; float v0 = 0, v1 = 0, v2 = 0, v3 = 0;
    for (int k = 0; k < 4; ++k) {
        float best = -3.0e38f; int bi = 0;
        for (int e = 0; e < 32; ++e) {
            const float v = logits[(size_t)t * 32 + e];
            if (e == c0 || e == c1 || e == c2 || e == c3) continue;
            if (v > best) { best = v; bi = e; }
        }
        if (k == 0) { c0 = bi; v0 = best; } else if (k == 1) { c1 = bi; v1 = best; } else if (k == 2) { c2 = bi; v2 = best; } else { c3 = bi; v3 = best; }
    }
    const float e0 = 1.f, e1 = expf(v1 - v0), e2 = expf(v2 - v0), e3 = expf(v3 - v0), inv = 1.f / (e0 + e1 + e2 + e3);
    topi[t * 4 + 0] = c0; topi[t * 4 + 1] = c1; topi[t * 4 + 2] = c2; topi[t * 4 + 3] = c3;
    topg[t * 4 + 0] = e0 * inv; topg[t * 4 + 1] = e1 * inv; topg[t * 4 + 2] = e2 * inv; topg[t * 4 + 3] = e3 * inv;
}
__global__ void k_moe_count(const int* __restrict__ topi, int* __restrict__ counts) {
    const int a = blockIdx.x * 256 + threadIdx.x;
    if (a < NA) atomicAdd(&counts[topi[a]], 1);
}
__global__ void k_moe_offsets(const int* __restrict__ counts, int* __restrict__ pad_start, int* __restrict__ tile_expert) {
    if (threadIdx.x != 0 || blockIdx.x != 0) return;
    int run = 0;
    for (int e = 0; e < NE; ++e) {
        pad_start[e] = run;
        const int nt = (counts[e] + MT - 1) / MT;
        for (int i = 0; i < nt; ++i) tile_expert[run / MT + i] = e;
        run += nt * MT;
    }
    for (int i = run / MT; i < NTILE; ++i) tile_expert[i] = -1;
}
__global__ void k_fill_i32(int* p, int v, int n) { const int i = blockIdx.x * 256 + threadIdx.x; if (i < n) p[i] = v; }
__global__ void k_moe_scatter(const int* __restrict__ topi, const int* __restrict__ pad_start, int* __restrict__ cursor, int* __restrict__ row_flat) {
    const int a = blockIdx.x * 256 + threadIdx.x;
    if (a >= NA) return;
    const int e = topi[a];
    const int slot = atomicAdd(&cursor[e], 1);
    row_flat[pad_start[e] + slot] = a;
}
__global__ void k_final(const float* __restrict__ h2, const float* __restrict__ ybuf, const float* __restrict__ g, float* __restrict__ out) {
    __shared__ float red[256];
    const int tok = blockIdx.x, t = threadIdx.x;
    float v[4]; float s = 0.f;
#pragma unroll
    for (int c = 0; c < 4; ++c) {
        const int i = t + c * 256;
        float x = h2[(size_t)tok * D + i];
#pragma unroll
        for (int k = 0; k < 4; ++k) x += ybuf[((size_t)tok * 4 + k) * D + i];
        v[c] = x; s += x * x;
    }
    red[t] = s; __syncthreads();
    for (int o = 128; o > 0; o >>= 1) { if (t < o) red[t] += red[t + o]; __syncthreads(); }
    const float r = rsqrtf(red[0] / (float)D + 1e-6f);
#pragma unroll
    for (int c = 0; c < 4; ++c) { const int i = t + c * 256; out[(size_t)tok * D + i] = v[c] * r * g[i]; }
}

namespace pg8 {
#define PG8_LAS __attribute__((address_space(3)))
typedef unsigned short bf16_t;
typedef short bf16x8 __attribute__((ext_vector_type(8)));
typedef float f32x4 __attribute__((ext_vector_type(4)));
typedef unsigned u32x4 __attribute__((ext_vector_type(4)));
constexpr int BM = 256, BK = 64, HALF = 128, HTB = HALF * BK * 2  , STAGE_BYTES = 8 * HTB, NXCD = 8, WGM = 8;

__host__ __device__ __forceinline__ int lds_byte(int r, int c) { const int st = (r >> 4) * 2 + (c >> 5), rr = r & 15, cc = c & 31, ob = rr * 64 + cc * 2; return st * 1024 + (ob ^ (((ob >> 9) & 1) << 5)); }
__host__ __device__ __forceinline__ void stage_rc(int b, int& R, int& C) { const int st = b / 1024, sb = b % 1024, swz = sb ^ (((sb >> 9) & 1) << 5); R = (st >> 1) * 16 + swz / 64; C = (st & 1) * 32 + (swz % 64) / 2; }
__host__ __device__ __forceinline__ int perm32(int rho) { const int n = rho >> 4, i = rho & 15; return 8 * (i >> 2) + 4 * n + (i & 3); }

struct Unit { int pm, pn; size_t aoff, boff; };
struct Gemm { const bf16_t* A; const bf16_t* Bt; int lda, ldb, K; };

struct StaticOrder {
    int nM, nN, nwg, G, c; size_t ta, tb;
    __host__ __device__ void init(int M, int N, int lda, int ldb, int G_, int c_) { nM = M / BM; nN = N / BM; nwg = nM * nN; G = G_; c = c_; ta = (size_t)BM * lda * 2; tb = (size_t)BM * ldb * 2; }
    __host__ __device__ bool next(int i, Unit& u) const {
        const long L = (long)i * G + c; if (L >= nwg) return false;
        int wgid = (int)L; { const int q = nwg / NXCD, r = nwg % NXCD, xcd = wgid % NXCD, off = wgid / NXCD; wgid = (xcd < r ? xcd * (q + 1) : r * (q + 1) + (xcd - r) * q) + off; }
        const int nig = WGM * nN, gid = wgid / nig, fm = gid * WGM, gsz = (nM - fm) < WGM ? (nM - fm) : WGM;
        u.pm = fm + ((wgid % nig) % gsz); u.pn = (wgid % nig) / gsz; u.aoff = (size_t)u.pm * ta; u.boff = (size_t)u.pn * tb; return true;
    }
    __device__ __forceinline__ void a_ready(const Unit&) const {}
    __device__ __forceinline__ void done(const Unit&) const {}
};

__device__ __forceinline__ unsigned cvt_pk_bf16(float lo, float hi) { unsigned r; asm volatile("v_cvt_pk_bf16_f32 %0, %1, %2" : "=v"(r) : "v"(lo), "v"(hi)); return r; }
typedef float f32x2 __attribute__((ext_vector_type(2)));

template <class Epi, class Sched, bool ALIGN_EPI = false, bool SP2 = false>
__device__ __forceinline__ void gemm_phase(PG8_LAS unsigned char* lds, const Gemm g, const Sched& S, const Epi& E) {
    const int tid = threadIdx.x, wid = __builtin_amdgcn_readfirstlane(tid >> 6), lane = tid & 63, wr = wid >> 2, wc = wid & 3, fr = lane & 15, fq = lane >> 4;
    const int K = g.K, nt = K / BK;
    unsigned voffA[2], voffB[2];
#pragma unroll
    for (int i = 0; i < 2; ++i) { int R, C; stage_rc(tid * 16 + i * 8192, R, C); const int Rb = Epi::PERM ? ((R & ~31) + perm32(R & 31)) : R;
        voffA[i] = (unsigned)(R * g.lda + C) * 2u; voffB[i] = (unsigned)(Rb * g.ldb + C) * 2u; }
    const size_t kstep = (size_t)(BK * 2);
    const size_t hstepA = (size_t)HALF * g.lda * 2, hstepB = (size_t)HALF * g.ldb * 2;
    const unsigned ldsw = (unsigned)wid * 1024u;
    const int aoff = lds_byte(wr * 64 + fr, fq * 8), boff = lds_byte(wc * 32 + fr, fq * 8);
#define PG8_SA(b, h) (((b) * 2 + (h)) * HTB)
#define PG8_SB(b, h) ((4 + (b) * 2 + (h)) * HTB)
#define PG8_STAGE(bufoff, gbase, voff) do { _Pragma("unroll") for (int _i = 0; _i < 2; ++_i) \
        __builtin_amdgcn_global_load_lds((const unsigned*)((const char*)(gbase) + (voff)[_i]), (PG8_LAS unsigned*)(lds + (bufoff) + ldsw + _i * 8192), 16, 0, 0); } while (0)
#define PG8_LDA(dst, b, h) do { _Pragma("unroll") for (int m = 0; m < 4; ++m) _Pragma("unroll") for (int k = 0; k < 2; ++k) dst[m][k] = *(const PG8_LAS bf16x8*)(lds + PG8_SA(b, h) + aoff + m * 2048 + k * 1024); } while (0)
#define PG8_LDB(dst, b, h) do { _Pragma("unroll") for (int n = 0; n < 2; ++n) _Pragma("unroll") for (int k = 0; k < 2; ++k) dst[n][k] = *(const PG8_LAS bf16x8*)(lds + PG8_SB(b, h) + boff + n * 2048 + k * 1024); } while (0)
#define PG8_MMA(ai, bj, At, Bt) do { __builtin_amdgcn_s_setprio(1); _Pragma("unroll") for (int m = 0; m < 4; ++m) _Pragma("unroll") for (int n = 0; n < 2; ++n) _Pragma("unroll") for (int k = 0; k < 2; ++k) \
        acc[ai][bj][m][n] = __builtin_amdgcn_mfma_f32_16x16x32_bf16(Bt[n][k], At[m][k], acc[ai][bj][m][n], 0, 0, 0); __builtin_amdgcn_s_setprio(0); } while (0)
#define PG8_WAIT_V(n) asm volatile("s_waitcnt vmcnt(" #n ")" ::: "memory")
#define PG8_WAIT_L(n) asm volatile("s_waitcnt lgkmcnt(" #n ")" ::: "memory")
#define PG8_BAR __builtin_amdgcn_s_barrier()
#define PG8_SCHED __builtin_amdgcn_sched_barrier(0)
    Unit cur, nxt; int ui = 0;
    if (!S.next(0, cur)) return;
    f32x4 acc[2][2][4][2];
#pragma unroll
    for (int a = 0; a < 2; ++a)
#pragma unroll
        for (int b = 0; b < 2; ++b)
#pragma unroll
            for (int m = 0; m < 4; ++m)
#pragma unroll
                for (int n = 0; n < 2; ++n) acc[a][b][m][n] = (f32x4){0.f, 0.f, 0.f, 0.f};
    bf16x8 At[4][2], B0[2][2], B1[2][2];
    const char* cA = (const char*)g.A + cur.aoff; const char* cB = (const char*)g.Bt + cur.boff;
    S.a_ready(cur);
    if constexpr (SP2) {
        PG8_STAGE(PG8_SB(0, 0), cB, voffB); PG8_STAGE(PG8_SB(0, 1), cB + hstepB, voffB); PG8_STAGE(PG8_SA(0, 0), cA, voffA); PG8_STAGE(PG8_SA(0, 1), cA + hstepA, voffA);
        if (wr == 1) PG8_BAR;
        PG8_WAIT_V(2); PG8_BAR;
        PG8_STAGE(PG8_SB(1, 0), cB + kstep, voffB); PG8_STAGE(PG8_SA(1, 0), cA + kstep, voffA); PG8_STAGE(PG8_SB(1, 1), cB + hstepB + kstep, voffB);
        PG8_WAIT_V(6); PG8_BAR;
    } else {
        PG8_STAGE(PG8_SB(0, 0), cB, voffB); PG8_STAGE(PG8_SA(0, 0), cA, voffA); PG8_STAGE(PG8_SB(0, 1), cB + hstepB, voffB); PG8_STAGE(PG8_SA(0, 1), cA + hstepA, voffA);
        if (wr == 1) PG8_BAR;
        PG8_WAIT_V(4); PG8_BAR;
        PG8_STAGE(PG8_SB(1, 0), cB + kstep, voffB); PG8_STAGE(PG8_SA(1, 0), cA + kstep, voffA); PG8_STAGE(PG8_SB(1, 1), cB + hstepB + kstep, voffB);
        PG8_WAIT_V(6); PG8_BAR;
    }
    for (;;) {
        const bool has_next = S.next(ui + 1, nxt);
        const char* nA = has_next ? (const char*)g.A + nxt.aoff : cA; const char* nB = has_next ? (const char*)g.Bt + nxt.boff : cB;
        for (int t = 0; t < nt; t += 2) {
            const bool last = (t == nt - 2);
            const char* a1 = cA + (size_t)(t + 1) * kstep;
            const char* a2 = last ? nA : cA + (size_t)(t + 2) * kstep; const char* b2 = last ? nB : cB + (size_t)(t + 2) * kstep;
            const char* a3 = a2 + kstep; const char* b3 = b2 + kstep;
            if (last && has_next) S.a_ready(nxt);
            if constexpr (SP2) {
            PG8_LDB(B0, 0, 0); PG8_LDB(B1, 0, 1); PG8_SCHED; PG8_LDA(At, 0, 0); PG8_STAGE(PG8_SA(1, 1), a1 + hstepA, voffA);
            PG8_WAIT_V(8); PG8_WAIT_L(0); PG8_BAR; PG8_MMA(0, 0, At, B0); PG8_MMA(0, 1, At, B1); PG8_BAR; PG8_SCHED;
            PG8_LDA(At, 0, 1); PG8_STAGE(PG8_SB(0, 0), b2, voffB); PG8_STAGE(PG8_SB(0, 1), b2 + hstepB, voffB); PG8_STAGE(PG8_SA(0, 0), a2, voffA);
            PG8_WAIT_V(8); PG8_WAIT_L(0); PG8_BAR; PG8_MMA(1, 0, At, B0); PG8_MMA(1, 1, At, B1); PG8_BAR; PG8_SCHED;
            PG8_LDB(B0, 1, 0); PG8_LDB(B1, 1, 1); PG8_SCHED; PG8_LDA(At, 1, 0); PG8_STAGE(PG8_SA(0, 1), a2 + hstepA, voffA);
            PG8_WAIT_V(8); PG8_WAIT_L(0); PG8_BAR; PG8_MMA(0, 0, At, B0); PG8_MMA(0, 1, At, B1); PG8_BAR; PG8_SCHED;
            PG8_LDA(At, 1, 1); PG8_STAGE(PG8_SB(1, 0), b3, voffB); PG8_STAGE(PG8_SB(1, 1), b3 + hstepB, voffB); PG8_STAGE(PG8_SA(1, 0), a3, voffA);
            PG8_WAIT_V(8); PG8_WAIT_L(0); PG8_BAR; PG8_MMA(1, 0, At, B0); PG8_MMA(1, 1, At, B1); PG8_BAR; PG8_SCHED;
            } else {
            PG8_LDB(B0, 0, 0); PG8_SCHED; PG8_LDA(At, 0, 0); PG8_STAGE(PG8_SA(1, 1), a1 + hstepA, voffA);
            PG8_WAIT_L(8); PG8_BAR; PG8_WAIT_L(0); PG8_MMA(0, 0, At, B0); PG8_BAR; PG8_SCHED;
            PG8_LDB(B1, 0, 1); PG8_STAGE(PG8_SB(0, 0), b2, voffB);
            PG8_BAR; PG8_WAIT_L(0); PG8_MMA(0, 1, At, B1); PG8_BAR;
            PG8_LDA(At, 0, 1); PG8_STAGE(PG8_SA(0, 0), a2, voffA);
            PG8_BAR; PG8_WAIT_L(0); PG8_MMA(1, 0, At, B0); PG8_BAR; PG8_SCHED;
            PG8_STAGE(PG8_SB(0, 1), b2 + hstepB, voffB);
            PG8_WAIT_V(6); PG8_BAR; PG8_MMA(1, 1, At, B1); PG8_BAR;
            PG8_LDB(B0, 1, 0); PG8_SCHED; PG8_LDA(At, 1, 0); PG8_STAGE(PG8_SA(0, 1), a2 + hstepA, voffA);
            PG8_WAIT_L(8); PG8_BAR; PG8_WAIT_L(0); PG8_MMA(0, 0, At, B0); PG8_BAR; PG8_SCHED;
            PG8_LDB(B1, 1, 1); PG8_STAGE(PG8_SB(1, 0), b3, voffB);
            PG8_BAR; PG8_WAIT_L(0); PG8_MMA(0, 1, At, B1); PG8_BAR;
            PG8_LDA(At, 1, 1); PG8_STAGE(PG8_SA(1, 0), a3, voffA);
            PG8_BAR; PG8_WAIT_L(0); PG8_MMA(1, 0, At, B0); PG8_BAR; PG8_SCHED;
            PG8_STAGE(PG8_SB(1, 1), b3 + hstepB, voffB);
            PG8_WAIT_V(6); PG8_BAR; PG8_MMA(1, 1, At, B1); PG8_BAR;
            }
        }
        if constexpr (ALIGN_EPI) { if (wr == 0) PG8_BAR; }
        if constexpr (!Epi::AFTER_DRAIN) { E(acc, cur, wr, wc, fr, fq); S.done(cur); }
        if (!has_next) break;
#pragma unroll
        for (int a = 0; a < 2; ++a)
#pragma unroll
            for (int b = 0; b < 2; ++b)
#pragma unroll
                for (int m = 0; m < 4; ++m)
#pragma unroll
                    for (int n = 0; n < 2; ++n) acc[a][b][m][n] = (f32x4){0.f, 0.f, 0.f, 0.f};
        cur = nxt; cA = nA; cB = nB; ++ui;
        if constexpr (ALIGN_EPI) { if (wr == 1) PG8_BAR; }
    }
    PG8_WAIT_V(0);
    if constexpr (!ALIGN_EPI) { if (wr == 0) PG8_BAR; }
    PG8_BAR;
    if constexpr (Epi::AFTER_DRAIN) { E.fused(acc, cur, wr, wc, fr, fq, lds, wid, lane); S.done(cur); }
#undef PG8_SA
#undef PG8_SB
#undef PG8_STAGE
#undef PG8_LDA
#undef PG8_LDB
#undef PG8_MMA
#undef PG8_WAIT_V
#undef PG8_WAIT_L
#undef PG8_BAR
#undef PG8_SCHED
}
}
namespace mk {
#define GAS __attribute__((address_space(1)))
#define LAS __attribute__((address_space(3)))
typedef unsigned short bf16_t;
typedef unsigned v4u __attribute__((ext_vector_type(4)));
typedef unsigned v2u __attribute__((ext_vector_type(2)));
typedef float f32x4 __attribute__((ext_vector_type(4)));
#define LDS_WAIT() asm volatile("s_waitcnt lgkmcnt(0)" ::: "memory")
#define VM_WAIT() asm volatile("s_waitcnt vmcnt(0)" ::: "memory")
__device__ __forceinline__ unsigned f2bf(float f) { unsigned u = __builtin_bit_cast(unsigned, f); return (u + 0x7fffu + ((u >> 16) & 1u)) >> 16; }
__device__ __forceinline__ unsigned pk2(float lo, float hi) { return f2bf(lo) | (f2bf(hi) << 16); }
__device__ __forceinline__ float bf2f(unsigned short b) { return __builtin_bit_cast(float, (unsigned)b << 16); }
__device__ __forceinline__ float wave_sum(float v) {
#pragma unroll
    for (int o = 1; o < 64; o <<= 1) v += __shfl_xor(v, o);
    return v;
}

constexpr int NWAVES = 8;
constexpr int LDS_BYTES = 147456;
constexpr int RING_BYTES = 131072;
constexpr int MISC_OFF = RING_BYTES + 320;
constexpr size_t MiB = 1u << 20;
constexpr size_t WS_CTL = 0, CTL_ZERO_BYTES = 1 * MiB;
constexpr size_t WS_WIN = 1 * MiB, WS_WQB = 5 * MiB, WS_WKVB = 5 * MiB + 512 * 1024, WS_WO = 6 * MiB, WS_WMQG = 8 * MiB, WS_WMKV = 10 * MiB, WS_WMO = 14 * MiB;
constexpr size_t WS_RSTDX = 16 * MiB, WS_RSTDM = 16 * MiB + 64 * 1024, WS_SSQQ = 16 * MiB + 256 * 1024, WS_SSQKV = 16 * MiB + 512 * 1024, WS_TBL = 16 * MiB + 768 * 1024;
constexpr size_t WS_SSQH1 = 17 * MiB, WS_SSQH2 = 18 * MiB, WS_ZKPE = 20 * MiB, WS_CS = 22 * MiB;
constexpr size_t WS_XB = 24 * MiB, WS_MEMB = 56 * MiB, WS_KVMEM = 58 * MiB, WS_KPE = 62 * MiB;
constexpr size_t WS_QKVA = 64 * MiB, WS_ZQ = 112 * MiB, WS_ZKV = 120 * MiB, WS_QB = 124 * MiB, WS_KN = 148 * MiB, WS_VB = 164 * MiB;
constexpr size_t WS_WPT = 180 * MiB, WS_VWT = 188 * MiB, WS_H2 = 196 * MiB, WS_H2B = 260 * MiB, WS_ROUTE = 292 * MiB, WS_XS = 296 * MiB;
constexpr size_t WS_OAP = 440 * MiB, WS_LSE = 536 * MiB, WS_OB = 538 * MiB, WS_OMIX = 554 * MiB, WS_HMID = 440 * MiB;
constexpr size_t WS_H1 = 586 * MiB, WS_H1B = 650 * MiB, WS_P = 682 * MiB, WS_YBUF = 586 * MiB;
constexpr size_t WS_WGU = 714 * MiB, WS_WD = 842 * MiB, WS_END = 906 * MiB;

struct Args { const float* in[26]; float* out; unsigned char* ws; int ph_lo, ph_hi, flags, pad; };

__device__ __forceinline__ void cvt_item(const float* W, int K, int N, const float* gain, bf16_t* WT, int mode, LAS float* scr, int item, int lane) {
    const int nblk = N / 32, kb = item / nblk, nb = item % nblk, k0 = 64 * kb, n0 = 32 * nb;
#pragma unroll 8
    for (int i = 0; i < 32; ++i) { const int kk = 2 * i + (lane >> 5); float v = W[(size_t)(k0 + kk) * N + n0 + (lane & 31)]; if (gain) v *= gain[k0 + kk]; scr[kk * 33 + (lane & 31)] = v; }
    LDS_WAIT(); asm volatile("" ::: "memory");
    int drow0 = n0; if (mode == 1) { const int half = n0 >> 10, c = n0 & 1023; drow0 = (c >> 7) * 256 + half * 128 + (c & 127); }
    const int c = lane & 7;
#pragma unroll
    for (int j = 0; j < 4; ++j) { const int n = (lane >> 3) + 8 * j; const LAS float* s = scr + (8 * c) * 33 + n;
        v4u o; o.x = pk2(s[0 * 33], s[1 * 33]); o.y = pk2(s[2 * 33], s[3 * 33]); o.z = pk2(s[4 * 33], s[5 * 33]); o.w = pk2(s[6 * 33], s[7 * 33]);
        *(v4u*)(WT + (size_t)(drow0 + n) * K + k0 + 8 * c) = o; }
    LDS_WAIT(); asm volatile("" ::: "memory");
}
__device__ __forceinline__ void prep_row(const float* xrow, const float* gain, bf16_t* orow, float* rstd_out, int lane) {
    const f32x4* xr = (const f32x4*)xrow + lane;
    f32x4 v[4]; float s = 0.f;
#pragma unroll
    for (int j = 0; j < 4; ++j) { v[j] = xr[64 * j]; s += (v[j].x * v[j].x + v[j].y * v[j].y) + (v[j].z * v[j].z + v[j].w * v[j].w); }
    s = wave_sum(s);
    if (rstd_out && lane == 0) *rstd_out = 1.0f / sqrtf(s * (1.0f / 1024.0f) + 1e-6f);
    if (gain) {
#pragma unroll
        for (int j = 0; j < 4; ++j) v[j] = v[j] * ((const f32x4*)gain)[lane + 64 * j];
    }
    unsigned long long* o8 = (unsigned long long*)orow + lane;
#pragma unroll
    for (int j = 0; j < 4; ++j) o8[64 * j] = (unsigned long long)pk2(v[j].x, v[j].y) | ((unsigned long long)pk2(v[j].z, v[j].w) << 32);
}

__device__ __forceinline__ v4u pack8(const f32x4 a, const f32x4 b) { v4u w; w.x = pk2(a[0], a[1]); w.y = pk2(a[2], a[3]); w.z = pk2(b[0], b[1]); w.w = pk2(b[2], b[3]); return w; }
__device__ __forceinline__ float sq8(const f32x4 a, const f32x4 b) { return (a[0] * a[0] + a[1] * a[1]) + (a[2] * a[2] + a[3] * a[3]) + (b[0] * b[0] + b[1] * b[1]) + (b[2] * b[2] + b[3] * b[3]); }

struct EpiInProj {
    static constexpr bool PERM = true, AFTER_DRAIN = false;
    const float* rstd; bf16_t* qkv; bf16_t* zq; bf16_t* zkv; float* zkpe; float* ssq_q; float* ssq_kv;
    __device__ __forceinline__ void operator()(const pg8::f32x4 (&acc)[2][2][4][2], const pg8::Unit& u, int wr, int wc, int fr, int fq) const {
        const int row0 = u.pm * 256 + wr * 64 + fr;
        const float qs = u.pn < 2 ? 0.125f : 1.0f;
#pragma unroll
        for (int ai = 0; ai < 2; ++ai)
#pragma unroll
            for (int m = 0; m < 4; ++m) {
                const int row = row0 + ai * 128 + m * 16;
                const float rs = rstd[row];
                float ss = 0.f;
#pragma unroll
                for (int bj = 0; bj < 2; ++bj) {
                    const f32x4 v0 = acc[ai][bj][m][0] * rs, v1 = acc[ai][bj][m][1] * rs;
                    const int ct = bj * 128 + wc * 32 + 8 * fq;
                    if (u.pn < 6) { *(v4u*)(qkv + (size_t)row * 1536 + u.pn * 256 + ct) = pack8(v0 * qs, v1 * qs); }
                    else if (u.pn == 6) { *(v4u*)(zq + (size_t)row * 256 + ct) = pack8(v0, v1); ss += sq8(v0, v1); }
                    else if (bj == 0) { *(v4u*)(zkv + (size_t)row * 128 + ct) = pack8(v0, v1); ss += sq8(v0, v1); }
                    else if (wc == 0) { *(f32x4*)(zkpe + (size_t)row * 32 + 8 * fq) = v0; *(f32x4*)(zkpe + (size_t)row * 32 + 8 * fq + 4) = v1; }
                }
                if (u.pn >= 6) { ss += __shfl_xor(ss, 16); ss += __shfl_xor(ss, 32); if (fq == 0) (u.pn == 6 ? ssq_q : ssq_kv)[(size_t)row * 4 + wc] = ss; }
            }
    }
};

__global__ void __launch_bounds__(NWAVES * 64, 2) mk_fwd(Args args) {
    extern __shared__ __attribute__((aligned(16))) unsigned char lds_raw[];
    LAS unsigned char* lds = (LAS unsigned char*)lds_raw;
    const int tid = threadIdx.x, lane = tid & 63, wave = __builtin_amdgcn_readfirstlane(tid >> 6);
    const int G = gridDim.x; const int bx = blockIdx.x; const int vcu = (G % 8 == 0) ? (bx % 8) * (G / 8) + bx / 8 : bx;
    unsigned char* ws = args.ws;
    const int lo = args.ph_lo, hi = args.ph_hi;
#define IN(k) (lo <= (k) && (k) < hi)
    const float* x = args.in[0]; const float* mem = args.in[1]; const float* g_mix = args.in[3]; const float* w_in = args.in[4];
    const float* g_q_a = args.in[5]; const float* w_q_b = args.in[6]; const float* g_kv_a = args.in[7]; const float* w_kv_b = args.in[8];
    const float* w_o = args.in[12]; const float* g_xattn = args.in[13]; const float* g_mem = args.in[14]; const float* w_mq = args.in[15];
    const float* w_mkv = args.in[16]; const float* w_mo = args.in[17]; const float* g_moe = args.in[18];
    const float* w_gate_up = args.in[21]; const float* w_down = args.in[23];
    bf16_t* WinT = (bf16_t*)(ws + WS_WIN); bf16_t* WqbT = (bf16_t*)(ws + WS_WQB); bf16_t* WkvbT = (bf16_t*)(ws + WS_WKVB); bf16_t* WoT = (bf16_t*)(ws + WS_WO);
    bf16_t* Wmqg = (bf16_t*)(ws + WS_WMQG); bf16_t* WmkvT = (bf16_t*)(ws + WS_WMKV); bf16_t* WmoT = (bf16_t*)(ws + WS_WMO);
    bf16_t* WguT = (bf16_t*)(ws + WS_WGU); bf16_t* WdT = (bf16_t*)(ws + WS_WD);
    bf16_t* xb = (bf16_t*)(ws + WS_XB); bf16_t* memb = (bf16_t*)(ws + WS_MEMB);
    float* rstd_x = (float*)(ws + WS_RSTDX); float* rstd_mem = (float*)(ws + WS_RSTDM);

    if (IN(0)) {
        LAS float* scr = (LAS float*)(lds + wave * 16384);
        const int gw = vcu * NWAVES + wave, NGW = G * NWAVES;
        constexpr int I_IN = 16 * 61, I_QB = 4 * 24, I_KVB = 2 * 32, I_O = 16 * 32, I_MKV = 16 * 64, I_MO = 16 * 32, I_GU = 16 * 64, I_D = 16 * 32;
        const int n_exp = (args.flags & 1) ? 32 : 0;
        const int NITEMS = I_IN + I_QB + I_KVB + I_O + I_MKV + I_MO + n_exp * (I_GU + I_D);
        for (int it = gw; it < NITEMS; it += NGW) {
            int r = it;
            if (r < I_IN) { cvt_item(w_in, 1024, 1952, g_mix, WinT, 0, scr, r, lane); continue; } r -= I_IN;
            if (r < I_QB) { cvt_item(w_q_b, 256, 768, g_q_a, WqbT, 0, scr, r, lane); continue; } r -= I_QB;
            if (r < I_KVB) { cvt_item(w_kv_b, 128, 1024, g_kv_a, WkvbT, 0, scr, r, lane); continue; } r -= I_KVB;
            if (r < I_O) { cvt_item(w_o, 1024, 1024, nullptr, WoT, 0, scr, r, lane); continue; } r -= I_O;
            if (r < I_MKV) { cvt_item(w_mkv, 1024, 2048, g_mem, WmkvT, 0, scr, r, lane); continue; } r -= I_MKV;
            if (r < I_MO) { cvt_item(w_mo, 1024, 1024, nullptr, WmoT, 0, scr, r, lane); continue; } r -= I_MO;
            if (r < 32 * I_GU) { const int e = r / I_GU; cvt_item(w_gate_up + (size_t)e * 1024 * 2048, 1024, 2048, g_moe, WguT + (size_t)e * 2048 * 1024, 1, scr, r % I_GU, lane); continue; } r -= 32 * I_GU;
            { const int e = r / I_D; cvt_item(w_down + (size_t)e * 1024 * 1024, 1024, 1024, nullptr, WdT + (size_t)e * 1024 * 1024, 0, scr, r % I_D, lane); }
        }
        for (int i = gw * 64 + lane; i < 96 * 1024 / 8; i += NGW * 64) ((v4u*)(WinT + (size_t)1952 * 1024))[i] = (v4u){0u, 0u, 0u, 0u};
        for (int m = gw; m < T; m += NGW) prep_row(x + (size_t)m * D, nullptr, xb + (size_t)m * D, rstd_x + m, lane);
        for (int m = gw; m < NB * NMEM; m += NGW) prep_row(mem + (size_t)m * D, nullptr, memb + (size_t)m * D, rstd_mem + m, lane);
        for (int m = gw; m < D; m += NGW) {
            const f32x4* xr = (const f32x4*)(w_mq + (size_t)m * D) + lane; const float gc = g_xattn[m];
            unsigned long long* o8 = (unsigned long long*)(Wmqg + (size_t)m * D) + lane;
#pragma unroll
            for (int j = 0; j < 4; ++j) { const f32x4 v = xr[64 * j] * gc; o8[64 * j] = (unsigned long long)pk2(v.x, v.y) | ((unsigned long long)pk2(v.z, v.w) << 32); }
        }
    }
    if (IN(1)) {
        pg8::Gemm g{xb, WinT, 1024, 1024, 1024}; pg8::StaticOrder S; S.init(T, 2048, 1024, 1024, G, bx);
        EpiInProj E{rstd_x, (bf16_t*)(ws + WS_QKVA), (bf16_t*)(ws + WS_ZQ), (bf16_t*)(ws + WS_ZKV), (float*)(ws + WS_ZKPE), (float*)(ws + WS_SSQQ), (float*)(ws + WS_SSQKV)};
        pg8::gemm_phase<EpiInProj, pg8::StaticOrder, true, true>(lds, g, S, E);
    }
#undef IN
}

__global__ void k_glue_z(const unsigned char* ws, float* z) {
    const size_t i = (size_t)blockIdx.x * 256 + threadIdx.x;
    if (i >= (size_t)T * INW) return;
    const int t = (int)(i / INW), c = (int)(i % INW);
    float v;
    if (c < 1536) { v = bf2f(((const bf16_t*)(ws + WS_QKVA))[(size_t)t * 1536 + c]); if (c < 512) v *= 8.0f; }
    else if (c < 1792) v = bf2f(((const bf16_t*)(ws + WS_ZQ))[(size_t)t * 256 + c - 1536]);
    else if (c < 1920) v = bf2f(((const bf16_t*)(ws + WS_ZKV))[(size_t)t * 128 + c - 1792]);
    else v = ((const float*)(ws + WS_ZKPE))[(size_t)t * 32 + c - 1920];
    z[i] = v;
}
}
void gemm(hipStream_t st, const float* A, int lda, const float* W, int ldw, float* C, int ldc, int M, int N, int K,
          const float* bias = nullptr, const float* R = nullptr) {
    GemmArgs a; memset(&a, 0, sizeof(a)); a.A = A; a.lda = lda; a.W = W; a.ldw = ldw; a.bias = bias; a.R = R; a.C = C; a.ldc = ldc; a.M = M; a.N = N; a.K = K; a.mode = 0;
    hipLaunchKernelGGL(k_sgemm<0>, dim3((N + 63) / 64, M / 64), dim3(256), 0, st, a);
}
void launch_mk(hipStream_t st, const mk::Args& base, int lo, int hi, int grid) {
    mk::Args a = base; a.ph_lo = lo; a.ph_hi = hi;
    hipLaunchKernelGGL(mk::mk_fwd, dim3(grid), dim3(mk::NWAVES * 64), mk::LDS_BYTES, st, a);
}
}

extern "C" void kernel_launch(void* const* d_in, const int* in_sizes, int n_in, void* d_out, int out_size, void* d_ws, size_t ws_size, hipStream_t stream) {
    static int grid = 0;
    if (grid == 0) {
        int dev = 0, cus = 0;
        if (hipGetDevice(&dev) != hipSuccess || hipDeviceGetAttribute(&cus, hipDeviceAttributeMultiprocessorCount, dev) != hipSuccess) { grid = -1; return; }
        if (hipFuncSetAttribute((const void*)mk::mk_fwd, hipFuncAttributeMaxDynamicSharedMemorySize, mk::LDS_BYTES) != hipSuccess) { grid = -1; return; }
        grid = cus;
    }
    if (grid < 0) return;
    const float* x = (const float*)d_in[0];
    const float* mem = (const float*)d_in[1];
    const int* pos = (const int*)d_in[2];
    const float* g_q_a = (const float*)d_in[5];
    const float* w_q_b = (const float*)d_in[6];
    const float* g_kv_a = (const float*)d_in[7];
    const float* w_kv_b = (const float*)d_in[8];
    const float* rel_bias = (const float*)d_in[9];
    const float* g_out_a = (const float*)d_in[10];
    const float* g_out_b = (const float*)d_in[11];
    const float* w_o = (const float*)d_in[12];
    const float* g_xattn = (const float*)d_in[13];
    const float* g_mem = (const float*)d_in[14];
    const float* w_mq = (const float*)d_in[15];
    const float* w_mkv = (const float*)d_in[16];
    const float* w_mo = (const float*)d_in[17];
    const float* g_moe = (const float*)d_in[18];
    const float* w_router = (const float*)d_in[19];
    const float* b_router = (const float*)d_in[20];
    const float* w_gate_up = (const float*)d_in[21];
    const float* b_gate_up = (const float*)d_in[22];
    const float* w_down = (const float*)d_in[23];
    const float* b_down = (const float*)d_in[24];
    const float* g_final = (const float*)d_in[25];
    float* out = (float*)d_out;
    (void)ws_size; (void)in_sizes; (void)n_in; (void)out_size;

    (void)hipMemsetAsync((char*)d_ws + mk::WS_CTL, 0, mk::CTL_ZERO_BYTES, stream);
    mk::Args ma; memset(&ma, 0, sizeof(ma));
    for (int i = 0; i < 26; ++i) ma.in[i] = (const float*)d_in[i];
    ma.out = out; ma.ws = (unsigned char*)d_ws; ma.flags = 0;
    launch_mk(stream, ma, 0, 1, grid);
    launch_mk(stream, ma, 1, 2, grid);

    float* w = (float*)((char*)d_ws + 296 * mk::MiB); size_t off = 0;
    auto take = [&](size_t n) { float* p = w + off; off += (n + 63) & ~(size_t)63; return p; };
    float* h1 = take((size_t)T * D);
    float* h2 = take((size_t)T * D);
    float* hn = take((size_t)T * D);
    float* mq = take((size_t)T * D);
    float* mo = take((size_t)T * D);
    float* memn = take((size_t)NB * NMEM * D);
    float* mkv = take((size_t)NB * NMEM * 2 * D);
    float* logits = take((size_t)T * NE);
    float* topg = take((size_t)NA);
    int* topi = (int*)take((size_t)NA);
    int* counts = (int*)take(64);
    int* cursor = counts + 32;
    int* pad_start = (int*)take(64);
    int* tile_expert = (int*)take(NTILE);
    int* row_flat = (int*)take(MPAD);
    const size_t reg0 = off;
    float* z = take((size_t)T * INW);
    float* qn = take((size_t)T * 256);
    float* kvn = take((size_t)T * 128);
    float* q = take((size_t)T * 768);
    float* kvb = take((size_t)T * 1024);
    float* kpe = take((size_t)T * 32);
    float* oa = take((size_t)T * 512);
    float* ob = take((size_t)T * 512);
    float* omix = take((size_t)T * D);
    off = reg0;
    float* hmid = take((size_t)MPAD * D);

    hipLaunchKernelGGL(mk::k_glue_z, dim3((unsigned)(((size_t)T * INW + 255) / 256)), dim3(256), 0, stream, (const unsigned char*)d_ws, z);
    hipLaunchKernelGGL(k_dilated, dim3(T * 8 / 256), dim3(256), 0, stream, z, pos, rel_bias, oa);
    hipLaunchKernelGGL(k_rmsnorm, dim3(T), dim3(256), 0, stream, z + 1536, INW, g_q_a, qn, 256, 256);
    hipLaunchKernelGGL(k_rmsnorm, dim3(T), dim3(256), 0, stream, z + 1792, INW, g_kv_a, kvn, 128, 128);
    gemm(stream, qn, 256, w_q_b, 768, q, 768, T, 768, 256);
    gemm(stream, kvn, 128, w_kv_b, 1024, kvb, 1024, T, 1024, 128);
    RopeTab tab; memset(&tab, 0, sizeof(tab));
    for (int j = 0; j < 16; ++j) tab.inv_freq_rev[j] = pow(10000.0, -(double)j / 16.0) / 6.283185307179586476925287;
    hipLaunchKernelGGL(k_rope, dim3(T * 16 / 256), dim3(256), 0, stream, q, z, kpe, pos, tab);
    hipLaunchKernelGGL(k_mla, dim3(S / 256, NB * 8), dim3(256), 0, stream, q, kvb, kpe, ob);
    hipLaunchKernelGGL(k_rmsnorm, dim3(T), dim3(256), 0, stream, oa, 512, g_out_a, omix, D, 512);
    hipLaunchKernelGGL(k_rmsnorm, dim3(T), dim3(256), 0, stream, ob, 512, g_out_b, omix + 512, D, 512);
    gemm(stream, omix, D, w_o, D, h1, D, T, D, D, nullptr, x);
    hipLaunchKernelGGL(k_rmsnorm, dim3(T), dim3(256), 0, stream, h1, D, g_xattn, hn, D, D);
    gemm(stream, hn, D, w_mq, D, mq, D, T, D, D);
    hipLaunchKernelGGL(k_rmsnorm, dim3(NB * NMEM), dim3(256), 0, stream, mem, D, g_mem, memn, D, D);
    gemm(stream, memn, D, w_mkv, 2 * D, mkv, 2 * D, NB * NMEM, 2 * D, D);
    hipLaunchKernelGGL(k_xattn, dim3(T * 4), dim3(256), 0, stream, mq, mkv, mo);
    gemm(stream, mo, D, w_mo, D, h2, D, T, D, D, nullptr, h1);
    hipLaunchKernelGGL(k_rmsnorm, dim3(T), dim3(256), 0, stream, h2, D, g_moe, hn, D, D);
    gemm(stream, hn, D, w_router, NE, logits, NE, T, NE, D, b_router);
    hipLaunchKernelGGL(k_topk, dim3(T / 256), dim3(256), 0, stream, logits, topi, topg);
    (void)hipMemsetAsync(counts, 0, 64 * sizeof(int), stream);
    hipLaunchKernelGGL(k_moe_count, dim3(NA / 256), dim3(256), 0, stream, topi, counts);
    hipLaunchKernelGGL(k_moe_offsets, dim3(1), dim3(64), 0, stream, counts, pad_start, tile_expert);
    hipLaunchKernelGGL(k_fill_i32, dim3((MPAD + 255) / 256), dim3(256), 0, stream, row_flat, -1, MPAD);
    hipLaunchKernelGGL(k_moe_scatter, dim3(NA / 256), dim3(256), 0, stream, topi, pad_start, cursor, row_flat);
    {
        float* h3 = h1;
        (void)hipMemcpyAsync(h3, h2, (size_t)T * D * sizeof(float), hipMemcpyDeviceToDevice, stream);
        GemmArgs a; memset(&a, 0, sizeof(a)); a.A = hn; a.lda = D; a.W = w_gate_up; a.ldw = 2 * D; a.wstride = (long)D * 2 * D; a.bias = b_gate_up; a.bstride = 2 * D;
        a.tile_expert = tile_expert; a.row_flat = row_flat; a.C = hmid; a.ldc = D; a.M = MPAD; a.N = D; a.K = D; a.mode = 1;
        hipLaunchKernelGGL(k_sgemm<1>, dim3(D / 64, NTILE), dim3(256), 0, stream, a);
        GemmArgs b; memset(&b, 0, sizeof(b)); b.A = hmid; b.lda = D; b.W = w_down; b.ldw = D; b.wstride = (long)D * D; b.bias = b_down; b.bstride = D;
        b.tile_expert = tile_expert; b.row_flat = row_flat; b.gatev = topg; b.C = h3; b.ldc = D; b.M = MPAD; b.N = D; b.K = D; b.mode = 2;
        hipLaunchKernelGGL(k_sgemm<0>, dim3(D / 64, NTILE), dim3(256), 0, stream, b);
        hipLaunchKernelGGL(k_rmsnorm, dim3(T), dim3(256), 0, stream, h3, D, g_final, out, D, D);
    }
}
```

```cpp
#include <hip/hip_runtime.h>
#include <stdint.h>
#include <string.h>
#include <math.h>

namespace {
constexpr int NB = 4, S = 4096, D = 1024, T = NB * S, NMEM = 256, INW = 1952;
constexpr int NE = 32, TOPK = 4, NA = T * TOPK;
constexpr int MT = 64;
constexpr int MPAD = NA + NE * MT;
constexpr int NTILE = MPAD / MT;

__device__ __forceinline__ int rel_bucket(int rel) {
    int n = rel < 0 ? -rel : rel;
    int b;
    if (n < 8) b = n; else if (n < 15) b = 8; else if (n < 27) b = 9; else if (n < 50) b = 10; else if (n < 91) b = 11;
    else if (n < 166) b = 12; else if (n < 305) b = 13; else if (n < 559) b = 14; else b = 15;
    return b + (rel > 0 ? 16 : 0);
}

__global__ void k_rmsnorm(const float* __restrict__ x, int ldx, const float* __restrict__ g, float* __restrict__ y, int ldy, int Dn) {
    __shared__ float red[256];
    const int row = blockIdx.x, t = threadIdx.x;
    const float* xr = x + (size_t)row * ldx;
    float s = 0.f;
    for (int i = t; i < Dn; i += 256) { float v = xr[i]; s += v * v; }
    red[t] = s; __syncthreads();
    for (int o = 128; o > 0; o >>= 1) { if (t < o) red[t] += red[t + o]; __syncthreads(); }
    const float r = rsqrtf(red[0] / (float)Dn + 1e-6f);
    for (int i = t; i < Dn; i += 256) y[(size_t)row * ldy + i] = xr[i] * r * g[i];
}

struct GemmArgs {
    const float* A; const float* W; const float* bias;
    const int* tile_expert;
    const int* row_flat;
    const float* gatev;
    const float* R;
    float* C;
    long wstride, bstride;
    int lda, ldw, ldc, M, N, K;
    int mode;
    int pad_;
};

template <int DUAL>
__global__ void __launch_bounds__(256) k_sgemm(GemmArgs a) {
    __shared__ float As[16][68];
    __shared__ float Ws[16][68];
    __shared__ float Ws2[DUAL ? 16 : 1][68];
    const int t = threadIdx.x, tx = t & 15, ty = t >> 4;
    const int m0 = blockIdx.y * 64, n0 = blockIdx.x * 64;
    int e = 0;
    if (a.tile_expert) { e = a.tile_expert[blockIdx.y]; if (e < 0) return; }
    const float* W = a.W + (size_t)e * a.wstride;
    const float* bias = a.bias ? a.bias + (size_t)e * a.bstride : nullptr;
    const int lr = t >> 2, lk = (t & 3) * 4;
    long arow = m0 + lr;
    if (a.mode == 1) { int f = a.row_flat[m0 + lr]; arow = f >= 0 ? (f >> 2) : 0; }
    const float* Ap = a.A + (size_t)arow * a.lda + lk;
    const int wk = t >> 4, wn = (t & 15) * 4;
    float acc[4][4] = {}, acc2[4][4] = {};
    for (int k0 = 0; k0 < a.K; k0 += 16) {
        const float4 av = *(const float4*)(Ap + k0);
        As[lk + 0][lr] = av.x; As[lk + 1][lr] = av.y; As[lk + 2][lr] = av.z; As[lk + 3][lr] = av.w;
        float4 wv = make_float4(0.f, 0.f, 0.f, 0.f), wv2 = wv;
        if (n0 + wn < a.N) {
            wv = *(const float4*)(W + (size_t)(k0 + wk) * a.ldw + n0 + wn);
            if (DUAL) wv2 = *(const float4*)(W + (size_t)(k0 + wk) * a.ldw + n0 + wn + 1024);
        }
        *(float4*)&Ws[wk][wn] = wv;
        if (DUAL) *(float4*)&Ws2[wk][wn] = wv2;
        __syncthreads();
#pragma unroll
        for (int k = 0; k < 16; ++k) {
            const float4 a4 = *(const float4*)&As[k][ty * 4];
            const float4 w4 = *(const float4*)&Ws[k][tx * 4];
            const float aa[4] = {a4.x, a4.y, a4.z, a4.w}, ww[4] = {w4.x, w4.y, w4.z, w4.w};
#pragma unroll
            for (int i = 0; i < 4; ++i)
#pragma unroll
                for (int j = 0; j < 4; ++j) acc[i][j] += aa[i] * ww[j];
            if (DUAL) {
                const float4 v4 = *(const float4*)&Ws2[k][tx * 4];
                const float vv[4] = {v4.x, v4.y, v4.z, v4.w};
#pragma unroll
                for (int i = 0; i < 4; ++i)
#pragma unroll
                    for (int j = 0; j < 4; ++j) acc2[i][j] += aa[i] * vv[j];
            }
        }
        __syncthreads();
    }
#pragma unroll
    for (int i = 0; i < 4; ++i) {
        const int r = m0 + ty * 4 + i;
        long crow = r; float gsc = 1.f;
        if (a.mode == 2) { const int f = a.row_flat[r]; if (f < 0) continue; crow = f; gsc = a.gatev[f]; }
#pragma unroll
        for (int j = 0; j < 4; ++j) {
            const int n = n0 + tx * 4 + j;
            if (n >= a.N) continue;
            float v = acc[i][j] + (bias ? bias[n] : 0.f);
            if (DUAL) {
                float gte = v, up = acc2[i][j] + bias[n + 1024];
                gte = fminf(gte, 7.0f); up = fminf(fmaxf(up, -7.0f), 7.0f);
                v = (up + 1.0f) * (gte * (1.0f / (1.0f + expf(-1.702f * gte))));
            }
            if (a.mode == 2) { atomicAdd(&a.C[(size_t)(crow >> 2) * a.ldc + n], v * gsc); continue; }
            if (a.R) v += a.R[(size_t)crow * a.ldc + n];
            a.C[(size_t)crow * a.ldc + n] = v;
        }
    }
}

struct RopeTab { double inv_freq_rev[16]; };
__global__ void k_rope(float* __restrict__ q, const float* __restrict__ z, float* __restrict__ kpe, const int* __restrict__ pos, RopeTab tab) {
    const int idx = blockIdx.x * 256 + threadIdx.x;
    if (idx >= T * 16) return;
    const int t = idx >> 4, j = idx & 15;
    const double rev = (double)pos[t] * tab.inv_freq_rev[j];
    const float fr = (float)(rev - floor(rev));
    const float sn = __builtin_amdgcn_sinf(fr), cs = __builtin_amdgcn_cosf(fr);
    {
        const float x1 = z[(size_t)t * INW + 1920 + j], x2 = z[(size_t)t * INW + 1936 + j];
        kpe[(size_t)t * 32 + j] = x1 * cs - x2 * sn; kpe[(size_t)t * 32 + 16 + j] = x1 * sn + x2 * cs;
    }
    for (int h = 0; h < 8; ++h) {
        float* p = q + (size_t)t * 768 + h * 96 + 64;
        const float x1 = p[j], x2 = p[16 + j];
        p[j] = x1 * cs - x2 * sn; p[16 + j] = x1 * sn + x2 * cs;
    }
}

__global__ void __launch_bounds__(256) k_dilated(const float* __restrict__ z, const int* __restrict__ pos, const float* __restrict__ rel_bias, float* __restrict__ oa) {
    const int idx = blockIdx.x * 256 + threadIdx.x;
    const int h = idx & 7, tok = idx >> 3, b = tok / S, i = tok % S;
    float q[64], acc[64];
    const float* qp = z + (size_t)tok * INW + h * 64;
#pragma unroll
    for (int d = 0; d < 64; ++d) { q[d] = qp[d]; acc[d] = 0.f; }
    float m = -3.0e38f, l = 0.f;
    const int qpos = pos[tok];
    for (int g = 0; g < 3; ++g) {
        const int dil = g == 0 ? 1 : (g == 1 ? 4 : 16);
        for (int j = -64; j <= 64; ++j) {
            const int kidx = i + j * dil;
            if (kidx < 0 || kidx >= S) continue;
            const int kt = b * S + kidx;
            const float* kp = z + (size_t)kt * INW + 512 + h * 64;
            const float* vp = z + (size_t)kt * INW + 1024 + h * 64;
            float s = 0.f;
#pragma unroll
            for (int d = 0; d < 64; ++d) s += q[d] * kp[d];
            s = s * 0.125f + rel_bias[rel_bucket(pos[kt] - qpos) * 8 + h];
            const float mn = fmaxf(m, s), corr = expf(m - mn), p = expf(s - mn);
            l = l * corr + p;
#pragma unroll
            for (int d = 0; d < 64; ++d) acc[d] = acc[d] * corr + p * vp[d];
            m = mn;
        }
    }
    const float inv = 1.f / l;
    float* op = oa + (size_t)tok * 512 + h * 64;
#pragma unroll
    for (int d = 0; d < 64; ++d) op[d] = acc[d] * inv;
}

__global__ void __launch_bounds__(256) k_mla(const float* __restrict__ q, const float* __restrict__ kv, const float* __restrict__ kpe, float* __restrict__ ob) {
    const int bh = blockIdx.y, b = bh >> 3, h = bh & 7;
    const int i = blockIdx.x * 256 + threadIdx.x;
    const int tok = b * S + i;
    float qq[96], acc[64];
    const float* qp = q + (size_t)tok * 768 + h * 96;
    const float scale = 0.10206207261596577f;
#pragma unroll
    for (int d = 0; d < 96; ++d) qq[d] = qp[d] * scale;
#pragma unroll
    for (int d = 0; d < 64; ++d) acc[d] = 0.f;
    float m = -3.0e38f, l = 0.f;
    for (int k = 0; k < S; ++k) {
        const float* kp = kv + (size_t)(b * S + k) * 1024 + h * 128;
        const float* pp = kpe + (size_t)(b * S + k) * 32;
        float s = 0.f;
#pragma unroll
        for (int d = 0; d < 64; ++d) s += qq[d] * kp[d];
#pragma unroll
        for (int d = 0; d < 32; ++d) s += qq[64 + d] * pp[d];
        const float mn = fmaxf(m, s), corr = expf(m - mn), p = expf(s - mn);
        l = l * corr + p;
#pragma unroll
        for (int d = 0; d < 64; ++d) acc[d] = acc[d] * corr + p * kp[64 + d];
        m = mn;
    }
    const float inv = 1.f / l;
    float* op = ob + (size_t)tok * 512 + h * 64;
#pragma unroll
    for (int d = 0; d < 64; ++d) op[d] = acc[d] * inv;
}

__global__ void __launch_bounds__(256) k_xattn(const float* __restrict__ mq, const float* __restrict__ mkv, float* __restrict__ mo) {
    __shared__ float qs[256], ps[256], red[256];
    const int tok = blockIdx.x >> 2, h = blockIdx.x & 3, b = tok / S, t = threadIdx.x;
    qs[t] = mq[(size_t)tok * 1024 + h * 256 + t];
    __syncthreads();
    const float* kp = mkv + (size_t)(b * NMEM + t) * 2048 + h * 256;
    float s = 0.f;
    for (int d = 0; d < 256; ++d) s += qs[d] * kp[d];
    s *= 0.0625f;
    red[t] = s; __syncthreads();
    for (int o = 128; o > 0; o >>= 1) { if (t < o) red[t] = fmaxf(red[t], red[t + o]); __syncthreads(); }
    const float mx = red[0]; __syncthreads();
    const float p = expf(s - mx);
    red[t] = p; ps[t] = p; __syncthreads();
    for (int o = 128; o > 0; o >>= 1) { if (t < o) red[t] += red[t + o]; __syncthreads(); }
    const float inv = 1.f / red[0];
    float o = 0.f;
    for (int mm = 0; mm < 256; ++mm) o += ps[mm] * mkv[(size_t)(b * NMEM + mm) * 2048 + 1024 + h * 256 + t];
    mo[(size_t)tok * 1024 + h * 256 + t] = o * inv;
}

__global__ void k_topk(const float* __restrict__ logits, int* __restrict__ topi, float* __restrict__ topg) {
    const int t = blockIdx.x * 256 + threadIdx.x;
    if (t >= T) return;
    int c0 = -1, c1 = -1, c2 = -1, c3 = -1; float v0 = 0, v1 = 0, v2 = 0, v3 = 0;
    for (int k = 0; k < 4; ++k) {
        float best = -3.0e38f; int bi = 0;
        for (int e = 0; e < 32; ++e) {
            const float v = logits[(size_t)t * 32 + e];
            if (e == c0 || e == c1 || e == c2 || e == c3) continue;
            if (v > best) { best = v; bi = e; }
        }
        if (k == 0) { c0 = bi; v0 = best; } else if (k == 1) { c1 = bi; v1 = best; } else if (k == 2) { c2 = bi; v2 = best; } else { c3 = bi; v3 = best; }
    }
    const float e0 = 1.f, e1 = expf(v1 - v0), e2 = expf(v2 - v0), e3 = expf(v3 - v0), inv = 1.f / (e0 + e1 + e2 + e3);
    topi[t * 4 + 0] = c0; topi[t * 4 + 1] = c1; topi[t * 4 + 2] = c2; topi[t * 4 + 3] = c3;
    topg[t * 4 + 0] = e0 * inv; topg[t * 4 + 1] = e1 * inv; topg[t * 4 + 2] = e2 * inv; topg[t * 4 + 3] = e3 * inv;
}
__global__ void k_moe_count(const int* __restrict__ topi, int* __restrict__ counts) {
    const int a = blockIdx.x * 256 + threadIdx.x;
    if (a < NA) atomicAdd(&counts[topi[a]], 1);
}
__global__ void k_moe_offsets(const int* __restrict__ counts, int* __restrict__ pad_start, int* __restrict__ tile_expert) {
    if (threadIdx.x != 0 || blockIdx.x != 0) return;
    int run = 0;
    for (int e = 0; e < NE; ++e) {
        pad_start[e] = run;
        const int nt = (counts[e] + MT - 1) / MT;
        for (int i = 0; i < nt; ++i) tile_expert[run / MT + i] = e;
        run += nt * MT;
    }
    for (int i = run / MT; i < NTILE; ++i) tile_expert[i] = -1;
}
__global__ void k_fill_i32(int* p, int v, int n) { const int i = blockIdx.x * 256 + threadIdx.x; if (i < n) p[i] = v; }
__global__ void k_moe_scatter(const int* __restrict__ topi, const int* __restrict__ pad_start, int* __restrict__ cursor, int* __restrict__ row_flat) {
    const int a = blockIdx.x * 256 + threadIdx.x;
    if (a >= NA) return;
    const int e = topi[a];
    const int slot = atomicAdd(&cursor[e], 1);
    row_flat[pad_start[e] + slot] = a;
}
__global__ void k_final(const float* __restrict__ h2, const float* __restrict__ ybuf, const float* __restrict__ g, float* __restrict__ out) {
    __shared__ float red[256];
    const int tok = blockIdx.x, t = threadIdx.x;
    float v[4]; float s = 0.f;
#pragma unroll
    for (int c = 0; c < 4; ++c) {
        const int i = t + c * 256;
        float x = h2[(size_t)tok * D + i];
#pragma unroll
        for (int k = 0; k < 4; ++k) x += ybuf[((size_t)tok * 4 + k) * D + i];
        v[c] = x; s += x * x;
    }
    red[t] = s; __syncthreads();
    for (int o = 128; o > 0; o >>= 1) { if (t < o) red[t] += red[t + o]; __syncthreads(); }
    const float r = rsqrtf(red[0] / (float)D + 1e-6f);
#pragma unroll
    for (int c = 0; c < 4; ++c) { const int i = t + c * 256; out[(size_t)tok * D + i] = v[c] * r * g[i]; }
}

namespace pg8 {
#define PG8_LAS __attribute__((address_space(3)))
typedef unsigned short bf16_t;
typedef short bf16x8 __attribute__((ext_vector_type(8)));
typedef float f32x4 __attribute__((ext_vector_type(4)));
typedef unsigned u32x4 __attribute__((ext_vector_type(4)));
constexpr int BM = 256, BK = 64, HALF = 128, HTB = HALF * BK * 2  , STAGE_BYTES = 8 * HTB, NXCD = 8, WGM = 8;

__host__ __device__ __forceinline__ int lds_byte(int r, int c) { const int st = (r >> 4) * 2 + (c >> 5), rr = r & 15, cc = c & 31, ob = rr * 64 + cc * 2; return st * 1024 + (ob ^ (((ob >> 9) & 1) << 5)); }
__host__ __device__ __forceinline__ void stage_rc(int b, int& R, int& C) { const int st = b / 1024, sb = b % 1024, swz = sb ^ (((sb >> 9) & 1) << 5); R = (st >> 1) * 16 + swz / 64; C = (st & 1) * 32 + (swz % 64) / 2; }
__host__ __device__ __forceinline__ int perm32(int rho) { const int n = rho >> 4, i = rho & 15; return 8 * (i >> 2) + 4 * n + (i & 3); }

struct Unit { int pm, pn; size_t aoff, boff; };
struct Gemm { const bf16_t* A; const bf16_t* Bt; int lda, ldb, K; };

struct StaticOrder {
    int nM, nN, nwg, G, c; size_t ta, tb;
    __host__ __device__ void init(int M, int N, int lda, int ldb, int G_, int c_) { nM = M / BM; nN = N / BM; nwg = nM * nN; G = G_; c = c_; ta = (size_t)BM * lda * 2; tb = (size_t)BM * ldb * 2; }
    __host__ __device__ bool next(int i, Unit& u) const {
        const long L = (long)i * G + c; if (L >= nwg) return false;
        int wgid = (int)L; { const int q = nwg / NXCD, r = nwg % NXCD, xcd = wgid % NXCD, off = wgid / NXCD; wgid = (xcd < r ? xcd * (q + 1) : r * (q + 1) + (xcd - r) * q) + off; }
        const int nig = WGM * nN, gid = wgid / nig, fm = gid * WGM, gsz = (nM - fm) < WGM ? (nM - fm) : WGM;
        u.pm = fm + ((wgid % nig) % gsz); u.pn = (wgid % nig) / gsz; u.aoff = (size_t)u.pm * ta; u.boff = (size_t)u.pn * tb; return true;
    }
    __device__ __forceinline__ void a_ready(const Unit&) const {}
    __device__ __forceinline__ void done(const Unit&) const {}
};

__device__ __forceinline__ unsigned cvt_pk_bf16(float lo, float hi) { unsigned r; asm volatile("v_cvt_pk_bf16_f32 %0, %1, %2" : "=v"(r) : "v"(lo), "v"(hi)); return r; }
typedef float f32x2 __attribute__((ext_vector_type(2)));

template <class Epi, class Sched, bool ALIGN_EPI = false, bool SP2 = false>
__device__ __forceinline__ void gemm_phase(PG8_LAS unsigned char* lds, const Gemm g, const Sched& S, const Epi& E) {
    const int tid = threadIdx.x, wid = __builtin_amdgcn_readfirstlane(tid >> 6), lane = tid & 63, wr = wid >> 2, wc = wid & 3, fr = lane & 15, fq = lane >> 4;
    const int K = g.K, nt = K / BK;
    unsigned voffA[2], voffB[2];
#pragma unroll
    for (int i = 0; i < 2; ++i) { int R, C; stage_rc(tid * 16 + i * 8192, R, C); const int Rb = Epi::PERM ? ((R & ~31) + perm32(R & 31)) : R;
        voffA[i] = (unsigned)(R * g.lda + C) * 2u; voffB[i] = (unsigned)(Rb * g.ldb + C) * 2u; }
    const size_t kstep = (size_t)(BK * 2);
    const size_t hstepA = (size_t)HALF * g.lda * 2, hstepB = (size_t)HALF * g.ldb * 2;
    const unsigned ldsw = (unsigned)wid * 1024u;
    const int aoff = lds_byte(wr * 64 + fr, fq * 8), boff = lds_byte(wc * 32 + fr, fq * 8);
#define PG8_SA(b, h) (((b) * 2 + (h)) * HTB)
#define PG8_SB(b, h) ((4 + (b) * 2 + (h)) * HTB)
#define PG8_STAGE(bufoff, gbase, voff) do { _Pragma("unroll") for (int _i = 0; _i < 2; ++_i) \
        __builtin_amdgcn_global_load_lds((const unsigned*)((const char*)(gbase) + (voff)[_i]), (PG8_LAS unsigned*)(lds + (bufoff) + ldsw + _i * 8192), 16, 0, 0); } while (0)
#define PG8_LDA(dst, b, h) do { _Pragma("unroll") for (int m = 0; m < 4; ++m) _Pragma("unroll") for (int k = 0; k < 2; ++k) dst[m][k] = *(const PG8_LAS bf16x8*)(lds + PG8_SA(b, h) + aoff + m * 2048 + k * 1024); } while (0)
#define PG8_LDB(dst, b, h) do { _Pragma("unroll") for (int n = 0; n < 2; ++n) _Pragma("unroll") for (int k = 0; k < 2; ++k) dst[n][k] = *(const PG8_LAS bf16x8*)(lds + PG8_SB(b, h) + boff + n * 2048 + k * 1024); } while (0)
#define PG8_MMA(ai, bj, At, Bt) do { __builtin_amdgcn_s_setprio(1); _Pragma("unroll") for (int m = 0; m < 4; ++m) _Pragma("unroll") for (int n = 0; n < 2; ++n) _Pragma("unroll") for (int k = 0; k < 2; ++k) \
        acc[ai][bj][m][n] = __builtin_amdgcn_mfma_f32_16x16x32_bf16(Bt[n][k], At[m][k], acc[ai][bj][m][n], 0, 0, 0); __builtin_amdgcn_s_setprio(0); } while (0)
#define PG8_WAIT_V(n) asm volatile("s_waitcnt vmcnt(" #n ")" ::: "memory")
#define PG8_WAIT_L(n) asm volatile("s_waitcnt lgkmcnt(" #n ")" ::: "memory")
#define PG8_BAR __builtin_amdgcn_s_barrier()
#define PG8_SCHED __builtin_amdgcn_sched_barrier(0)
    Unit cur, nxt; int ui = 0;
    if (!S.next(0, cur)) return;
    f32x4 acc[2][2][4][2];
#pragma unroll
    for (int a = 0; a < 2; ++a)
#pragma unroll
        for (int b = 0; b < 2; ++b)
#pragma unroll
            for (int m = 0; m < 4; ++m)
#pragma unroll
                for (int n = 0; n < 2; ++n) acc[a][b][m][n] = (f32x4){0.f, 0.f, 0.f, 0.f};
    bf16x8 At[4][2], B0[2][2], B1[2][2];
    const char* cA = (const char*)g.A + cur.aoff; const char* cB = (const char*)g.Bt + cur.boff;
    S.a_ready(cur);
    if constexpr (SP2) {
        PG8_STAGE(PG8_SB(0, 0), cB, voffB); PG8_STAGE(PG8_SB(0, 1), cB + hstepB, voffB); PG8_STAGE(PG8_SA(0, 0), cA, voffA); PG8_STAGE(PG8_SA(0, 1), cA + hstepA, voffA);
        if (wr == 1) PG8_BAR;
        PG8_WAIT_V(2); PG8_BAR;
        PG8_STAGE(PG8_SB(1, 0), cB + kstep, voffB); PG8_STAGE(PG8_SA(1, 0), cA + kstep, voffA); PG8_STAGE(PG8_SB(1, 1), cB + hstepB + kstep, voffB);
        PG8_WAIT_V(6); PG8_BAR;
    } else {
        PG8_STAGE(PG8_SB(0, 0), cB, voffB); PG8_STAGE(PG8_SA(0, 0), cA, voffA); PG8_STAGE(PG8_SB(0, 1), cB + hstepB, voffB); PG8_STAGE(PG8_SA(0, 1), cA + hstepA, voffA);
        if (wr == 1) PG8_BAR;
        PG8_WAIT_V(4); PG8_BAR;
        PG8_STAGE(PG8_SB(1, 0), cB + kstep, voffB); PG8_STAGE(PG8_SA(1, 0), cA + kstep, voffA); PG8_STAGE(PG8_SB(1, 1), cB + hstepB + kstep, voffB);
        PG8_WAIT_V(6); PG8_BAR;
    }
    for (;;) {
        const bool has_next = S.next(ui + 1, nxt);
        const char* nA = has_next ? (const char*)g.A + nxt.aoff : cA; const char* nB = has_next ? (const char*)g.Bt + nxt.boff : cB;
        for (int t = 0; t < nt; t += 2) {
            const bool last = (t == nt - 2);
            const char* a1 = cA + (size_t)(t + 1) * kstep;
            const char* a2 = last ? nA : cA + (size_t)(t + 2) * kstep; const char* b2 = last ? nB : cB + (size_t)(t + 2) * kstep;
            const char* a3 = a2 + kstep; const char* b3 = b2 + kstep;
            if (last && has_next) S.a_ready(nxt);
            if constexpr (SP2) {
            PG8_LDB(B0, 0, 0); PG8_LDB(B1, 0, 1); PG8_SCHED; PG8_LDA(At, 0, 0); PG8_STAGE(PG8_SA(1, 1), a1 + hstepA, voffA);
            PG8_WAIT_V(8); PG8_WAIT_L(0); PG8_BAR; PG8_MMA(0, 0, At, B0); PG8_MMA(0, 1, At, B1); PG8_BAR; PG8_SCHED;
            PG8_LDA(At, 0, 1); PG8_STAGE(PG8_SB(0, 0), b2, voffB); PG8_STAGE(PG8_SB(0, 1), b2 + hstepB, voffB); PG8_STAGE(PG8_SA(0, 0), a2, voffA);
            PG8_WAIT_V(8); PG8_WAIT_L(0); PG8_BAR; PG8_MMA(1, 0, At, B0); PG8_MMA(1, 1, At, B1); PG8_BAR; PG8_SCHED;
            PG8_LDB(B0, 1, 0); PG8_LDB(B1, 1, 1); PG8_SCHED; PG8_LDA(At, 1, 0); PG8_STAGE(PG8_SA(0, 1), a2 + hstepA, voffA);
            PG8_WAIT_V(8); PG8_WAIT_L(0); PG8_BAR; PG8_MMA(0, 0, At, B0); PG8_MMA(0, 1, At, B1); PG8_BAR; PG8_SCHED;
            PG8_LDA(At, 1, 1); PG8_STAGE(PG8_SB(1, 0), b3, voffB); PG8_STAGE(PG8_SB(1, 1), b3 + hstepB, voffB); PG8_STAGE(PG8_SA(1, 0), a3, voffA);
            PG8_WAIT_V(8); PG8_WAIT_L(0); PG8_BAR; PG8_MMA(1, 0, At, B0); PG8_MMA(1, 1, At, B1); PG8_BAR; PG8_SCHED;
            } else {
            PG8_LDB(B0, 0, 0); PG8_SCHED; PG8_LDA(At, 0, 0); PG8_STAGE(PG8_SA(1, 1), a1 + hstepA, voffA);
            PG8_WAIT_L(8); PG8_BAR; PG8_WAIT_L(0); PG8_MMA(0, 0, At, B0); PG8_BAR; PG8_SCHED;
            PG8_LDB(B1, 0, 1); PG8_STAGE(PG8_SB(0, 0), b2, voffB);
            PG8_BAR; PG8_WAIT_L(0); PG8_MMA(0, 1, At, B1); PG8_BAR;
            PG8_LDA(At, 0, 1); PG8_STAGE(PG8_SA(0, 0), a2, voffA);
            PG8_BAR; PG8_WAIT_L(0); PG8_MMA(1, 0, At, B0); PG8_BAR; PG8_SCHED;
            PG8_STAGE(PG8_SB(0, 1), b2 + hstepB, voffB);
            PG8_WAIT_V(6); PG8_BAR; PG8_MMA(1, 1, At, B1); PG8_BAR;
            PG8_LDB(B0, 1, 0); PG8_SCHED; PG8_LDA(At, 1, 0); PG8_STAGE(PG8_SA(0, 1), a2 + hstepA, voffA);
            PG8_WAIT_L(8); PG8_BAR; PG8_WAIT_L(0); PG8_MMA(0, 0, At, B0); PG8_BAR; PG8_SCHED;
            PG8_LDB(B1, 1, 1); PG8_STAGE(PG8_SB(1, 0), b3, voffB);
            PG8_BAR; PG8_WAIT_L(0); PG8_MMA(0, 1, At, B1); PG8_BAR;
            PG8_LDA(At, 1, 1); PG8_STAGE(PG8_SA(1, 0), a3, voffA);
            PG8_BAR; PG8_WAIT_L(0); PG8_MMA(1, 0, At, B0); PG8_BAR; PG8_SCHED;
            PG8_STAGE(PG8_SB(1, 1), b3 + hstepB, voffB);
            PG8_WAIT_V(6); PG8_BAR; PG8_MMA(1, 1, At, B1); PG8_BAR;
            }
        }
        if constexpr (ALIGN_EPI) { if (wr == 0) PG8_BAR; }
        if constexpr (!Epi::AFTER_DRAIN) { E(acc, cur, wr, wc, fr, fq); S.done(cur); }
        if (!has_next) break;
#pragma unroll
        for (int a = 0; a < 2; ++a)
#pragma unroll
            for (int b = 0; b < 2; ++b)
#pragma unroll
                for (int m = 0; m < 4; ++m)
#pragma unroll
                    for (int n = 0; n < 2; ++n) acc[a][b][m][n] = (f32x4){0.f, 0.f, 0.f, 0.f};
        cur = nxt; cA = nA; cB = nB; ++ui;
        if constexpr (ALIGN_EPI) { if (wr == 1) PG8_BAR; }
    }
    PG8_WAIT_V(0);
    if constexpr (!ALIGN_EPI) { if (wr == 0) PG8_BAR; }
    PG8_BAR;
    if constexpr (Epi::AFTER_DRAIN) { E.fused(acc, cur, wr, wc, fr, fq, lds, wid, lane); S.done(cur); }
#undef PG8_SA
#undef PG8_SB
#undef PG8_STAGE
#undef PG8_LDA
#undef PG8_LDB
#undef PG8_MMA
#undef PG8_WAIT_V
#undef PG8_WAIT_L
#undef PG8_BAR
#undef PG8_SCHED
}
}
namespace mla {
using bf16x8 = __attribute__((ext_vector_type(8))) short;
using s16x4  = __attribute__((ext_vector_type(4))) short;
using f32x16 = __attribute__((ext_vector_type(16))) float;
using u32x4  = __attribute__((ext_vector_type(4))) unsigned;
constexpr int NW = 8, QBLK = 32, KVBLK = 64;
constexpr float SCALE = 0.10206207261596577f;
constexpr float THR = 8.f;
constexpr int SHM_V = KVBLK * 64 * 2, SHM_K = KVBLK * 256;
constexpr int SHM_ATTN = 2 * SHM_V + 2 * SHM_K + NW * 64 * 4;
#define KSWZ(row, colB) ((row) * 256 + ((colB) ^ (((row) & 7) << 4)))
#define SBAR() __builtin_amdgcn_sched_barrier(0)
__device__ __forceinline__ int crow(int r, int hi) { return (r & 3) + 8 * (r >> 2) + 4 * hi; }
__device__ __forceinline__ unsigned cvtpk(float lo, float hi) { unsigned r; asm volatile("v_cvt_pk_bf16_f32 %0, %1, %2" : "=v"(r) : "v"(lo), "v"(hi)); return r; }

__device__ __forceinline__ void partialSM(f32x16& p0, f32x16& p1, float& m_reg, float& mn, float& alpha) {
  constexpr float C = SCALE * 1.4426950408889634f;
  float pmax = p0[0];
#pragma unroll
  for (int r = 1; r < 16; ++r) pmax = fmaxf(pmax, p0[r]);
#pragma unroll
  for (int r = 0; r < 16; ++r) pmax = fmaxf(pmax, p1[r]);
  { auto rr = __builtin_amdgcn_permlane32_swap(__float_as_uint(pmax), __float_as_uint(pmax), false, false);
    pmax = fmaxf(__uint_as_float(rr[0]), __uint_as_float(rr[1])); }
  if (__builtin_expect(__all(pmax - m_reg <= THR / SCALE), 1)) { mn = m_reg; alpha = 1.f; }
  else { mn = fmaxf(m_reg, pmax); alpha = __builtin_amdgcn_exp2f((m_reg - mn) * C); m_reg = mn; }
  float mnC = -mn * C;
#pragma unroll
  for (int r = 0; r < 16; ++r) p0[r] = fmaf(p0[r], C, mnC);
#pragma unroll
  for (int r = 0; r < 16; ++r) p1[r] = fmaf(p1[r], C, mnC);
#pragma unroll
  for (int r = 0; r < 16; ++r) p0[r] = __builtin_amdgcn_exp2f(p0[r]);
}
__device__ __forceinline__ void finishSM(f32x16& p0, f32x16& p1, float alpha, float& l_reg, bf16x8& pa0, bf16x8& pa1, bf16x8& pa2, bf16x8& pa3) {
#pragma unroll
  for (int r = 0; r < 16; ++r) p1[r] = __builtin_amdgcn_exp2f(p1[r]);
  float ps = 0;
#pragma unroll
  for (int r = 0; r < 16; ++r) ps += p0[r];
#pragma unroll
  for (int r = 0; r < 16; ++r) ps += p1[r];
  { auto rr = __builtin_amdgcn_permlane32_swap(__float_as_uint(ps), __float_as_uint(ps), false, false);
    ps = __uint_as_float(rr[0]) + __uint_as_float(rr[1]); }
  l_reg = l_reg * alpha + ps;
#define PK4(P, BASE, OUT) do { unsigned a0 = cvtpk(P[BASE + 0], P[BASE + 1]), a1 = cvtpk(P[BASE + 2], P[BASE + 3]);   \
    unsigned b0 = cvtpk(P[BASE + 4], P[BASE + 5]), b1 = cvtpk(P[BASE + 6], P[BASE + 7]);                              \
    auto r0 = __builtin_amdgcn_permlane32_swap(a0, b0, false, false); auto r1 = __builtin_amdgcn_permlane32_swap(a1, b1, false, false); \
    u32x4 w = {r0[0], r1[0], r0[1], r1[1]}; OUT = *reinterpret_cast<bf16x8*>(&w); } while (0)
  PK4(p0, 0, pa0); PK4(p0, 8, pa1); PK4(p1, 0, pa2); PK4(p1, 8, pa3);
#undef PK4
}
__device__ __forceinline__ void qkt(f32x16& p0, f32x16& p1, const char* Ks, const bf16x8* qr, int r32, int hi) {
  p0 = f32x16{}; p1 = f32x16{};
#pragma unroll
  for (int d0 = 0; d0 < 6; ++d0) { int cb = (d0 * 16 + hi * 8) * 2;
    bf16x8 b0 = *reinterpret_cast<const bf16x8*>(Ks + KSWZ(r32, cb));
    bf16x8 b1 = *reinterpret_cast<const bf16x8*>(Ks + KSWZ(32 + r32, cb));
    p0 = __builtin_amdgcn_mfma_f32_32x32x16_bf16(b0, qr[d0], p0, 0, 0, 0);
    p1 = __builtin_amdgcn_mfma_f32_32x32x16_bf16(b1, qr[d0], p1, 0, 0, 0); }
}
__device__ __forceinline__ int v_st(int k, int c) { const int kk = (k & ~0xC) | ((k & 4) << 1) | ((k & 8) >> 1); return ((kk >> 3) * 2 + (c >> 5)) * 512 + ((kk & 7) * 32 + (c & 31)) * 2; }
__device__ __forceinline__ int v_rd_base(int lane) { return ((lane & 3) << 3) | (((lane >> 2) & 3) << 6) | (((lane >> 4) & 1) << 5) | (((lane >> 5) & 1) << 8); }
constexpr int v_rd_off(int d0, int ks, int half) { return d0 * 512 + ks * 2048 + half * 1024; }
template <int OFF> __device__ __forceinline__ s16x4 tr_read(int vb) {
  s16x4 r; asm volatile("ds_read_b64_tr_b16 %0, %1 offset:%2" : "=&v"(r) : "v"(vb), "i"(OFF) : "memory"); return r;
}
template <int D0> __device__ __forceinline__ void pv_one(f32x16& od, int vb, bf16x8 pa0, bf16x8 pa1, bf16x8 pa2, bf16x8 pa3) {
  const s16x4 l0 = tr_read<v_rd_off(D0, 0, 0)>(vb), h0 = tr_read<v_rd_off(D0, 0, 1)>(vb), l1 = tr_read<v_rd_off(D0, 1, 0)>(vb), h1 = tr_read<v_rd_off(D0, 1, 1)>(vb);
  const s16x4 l2 = tr_read<v_rd_off(D0, 2, 0)>(vb), h2 = tr_read<v_rd_off(D0, 2, 1)>(vb), l3 = tr_read<v_rd_off(D0, 3, 0)>(vb), h3 = tr_read<v_rd_off(D0, 3, 1)>(vb);
  asm volatile("s_waitcnt lgkmcnt(0)" ::: "memory"); SBAR();
#define PK(L, H) (bf16x8){L[0], L[1], L[2], L[3], H[0], H[1], H[2], H[3]}
  od = __builtin_amdgcn_mfma_f32_32x32x16_bf16(pa0, PK(l0, h0), od, 0, 0, 0);
  od = __builtin_amdgcn_mfma_f32_32x32x16_bf16(pa1, PK(l1, h1), od, 0, 0, 0);
  od = __builtin_amdgcn_mfma_f32_32x32x16_bf16(pa2, PK(l2, h2), od, 0, 0, 0);
  od = __builtin_amdgcn_mfma_f32_32x32x16_bf16(pa3, PK(l3, h3), od, 0, 0, 0);
#undef PK
}
__device__ __forceinline__ void pv_d0(f32x16* o, int vb, bf16x8 pa0, bf16x8 pa1, bf16x8 pa2, bf16x8 pa3) {
  pv_one<0>(o[0], vb, pa0, pa1, pa2, pa3); pv_one<1>(o[1], vb, pa0, pa1, pa2, pa3);
}
__device__ __forceinline__ float bf2f_(short b) { return __builtin_bit_cast(float, (unsigned)(unsigned short)b << 16); }

__device__ __forceinline__ void mla_unit(const unsigned short* __restrict__ Qg, const unsigned short* __restrict__ Kn, const unsigned short* __restrict__ Kpe, const unsigned short* __restrict__ Vg,
                                         const float* __restrict__ cs, float* __restrict__ Og, int q0, int krow0, int h, int seq, char* lds) {
  const int tid = threadIdx.x, wid = tid >> 6, lane = tid & 63, r32 = lane & 31, hi = lane >> 5;
  char* V_lds = lds; char* K_lds = lds + 2 * SHM_V;
  float* ws = (float*)(lds + 2 * SHM_V + 2 * SHM_K) + wid * 64; float* li_l = ws; float* al_l = ws + 32;
  float m_reg = -1e30f, l_reg = 0; f32x16 o[2] = {}; bf16x8 qr[6];
  {
    const int qrow = q0 + wid * QBLK + r32;
    const unsigned short* Qw = Qg + (size_t)qrow * 768 + h * 96 + hi * 8;
#pragma unroll
    for (int d0 = 0; d0 < 6; ++d0) qr[d0] = *reinterpret_cast<const bf16x8*>(Qw + d0 * 16);
    const float* cr = cs + (size_t)qrow * 32 + hi * 8;
    bf16x8 a = qr[4], b = qr[5]; u32x4 wa, wb; float n1[8], n2[8];
#pragma unroll
    for (int e = 0; e < 8; ++e) { const float c_ = cr[e], s_ = cr[16 + e]; const float x1 = bf2f_(a[e]), x2 = bf2f_(b[e]); n1[e] = x1 * c_ - x2 * s_; n2[e] = x1 * s_ + x2 * c_; }
    wa = (u32x4){cvtpk(n1[0], n1[1]), cvtpk(n1[2], n1[3]), cvtpk(n1[4], n1[5]), cvtpk(n1[6], n1[7])};
    wb = (u32x4){cvtpk(n2[0], n2[1]), cvtpk(n2[2], n2[3]), cvtpk(n2[4], n2[5]), cvtpk(n2[6], n2[7])};
    qr[4] = *reinterpret_cast<bf16x8*>(&wa); qr[5] = *reinterpret_cast<bf16x8*>(&wb);
  }
  const int sk = tid >> 3, sc = (tid & 7) * 8, rk = (tid & 255) >> 2, rc = (tid & 3) * 8;
  const int vst = v_st(sk, sc), kst = KSWZ(sk, sc * 2), rst = KSWZ(rk, (64 + rc) * 2);
  const int vb0 = (int)(uintptr_t)V_lds + v_rd_base(lane);
  const unsigned short* Vh = Vg + (size_t)krow0 * 512 + h * 64; const unsigned short* Kh = Kn + (size_t)krow0 * 512 + h * 64; const unsigned short* Rh = Kpe + (size_t)krow0 * 32;
  struct { bf16x8 vs, ks, rs; } sr_[2];
#define SLOAD(i, k0) do { sr_[i].vs = *reinterpret_cast<const bf16x8*>(&Vh[(size_t)((k0) + sk) * 512 + sc]); sr_[i].ks = *reinterpret_cast<const bf16x8*>(&Kh[(size_t)((k0) + sk) * 512 + sc]); \
    sr_[i].rs = *reinterpret_cast<const bf16x8*>(&Rh[(size_t)((k0) + rk) * 32 + rc]); } while (0)
#define SWRITE(b, i) do { *(bf16x8*)(V_lds + (b) * SHM_V + vst) = sr_[i].vs; *(bf16x8*)(K_lds + (b) * SHM_K + kst) = sr_[i].ks; *(bf16x8*)(K_lds + (b) * SHM_K + rst) = sr_[i].rs; } while (0)
#define SWAIT() asm volatile("s_waitcnt vmcnt(3)" ::: "memory")
#define RESC(a) do { if (__any((a) < 1.f)) { if (hi == 0) al_l[r32] = (a); asm volatile("s_waitcnt lgkmcnt(0)" ::: "memory"); \
    _Pragma("unroll") for (int d = 0; d < 2; ++d) _Pragma("unroll") for (int r = 0; r < 16; ++r) o[d][r] *= al_l[crow(r, hi)]; } } while (0)
  f32x16 pA0, pA1, pB0, pB1; float mnA, mnB, alA, alB; bf16x8 pa0, pa1, pa2, pa3; const int NT = seq / KVBLK;
  SLOAD(0, 0); asm volatile("s_waitcnt vmcnt(0)" ::: "memory"); SWRITE(0, 0); __syncthreads();
  qkt(pA0, pA1, K_lds, qr, r32, hi); partialSM(pA0, pA1, m_reg, mnA, alA);
  SLOAD(1, KVBLK); if (2 < NT) SLOAD(0, 2 * KVBLK);
  SWAIT(); SWRITE(1, 1); __syncthreads();
  for (int j = 1; j + 1 < NT; j += 2) {
    SBAR(); qkt(pB0, pB1, K_lds + SHM_K, qr, r32, hi);
    finishSM(pA0, pA1, alA, l_reg, pa0, pa1, pa2, pa3); SBAR();
    SLOAD(1, (j + 2) * KVBLK); SBAR();
    pv_d0(o, vb0, pa0, pa1, pa2, pa3); partialSM(pB0, pB1, m_reg, mnB, alB);
    __syncthreads(); SWAIT(); SWRITE(0, 0);
    RESC(alB); __syncthreads();
    SBAR(); qkt(pA0, pA1, K_lds, qr, r32, hi);
    finishSM(pB0, pB1, alB, l_reg, pa0, pa1, pa2, pa3); SBAR();
    if (j + 3 < NT) SLOAD(0, (j + 3) * KVBLK); SBAR();
    pv_d0(o, vb0 + SHM_V, pa0, pa1, pa2, pa3); partialSM(pA0, pA1, m_reg, mnA, alA);
    __syncthreads(); SWAIT(); SWRITE(1, 1);
    RESC(alA); __syncthreads();
  }
  SBAR(); qkt(pB0, pB1, K_lds + SHM_K, qr, r32, hi);
  finishSM(pA0, pA1, alA, l_reg, pa0, pa1, pa2, pa3); SBAR();
  pv_d0(o, vb0, pa0, pa1, pa2, pa3); partialSM(pB0, pB1, m_reg, mnB, alB);
  __syncthreads(); RESC(alB);
  finishSM(pB0, pB1, alB, l_reg, pa0, pa1, pa2, pa3); SBAR();
  pv_d0(o, vb0 + SHM_V, pa0, pa1, pa2, pa3);
  if (hi == 0) li_l[r32] = l_reg; asm volatile("s_waitcnt lgkmcnt(0)" ::: "memory");
  float rli[16];
#pragma unroll
  for (int r = 0; r < 16; ++r) rli[r] = __builtin_amdgcn_rcpf(li_l[crow(r, hi)]);
  float* Ow = Og + (size_t)(q0 + wid * QBLK) * 512 + h * 64;
#pragma unroll
  for (int r = 0; r < 16; ++r) { int orow = crow(r, hi);
#pragma unroll
    for (int d0 = 0; d0 < 2; ++d0) Ow[(size_t)orow * 512 + d0 * 32 + r32] = o[d0][r] * rli[r]; }
  __syncthreads();
#undef SLOAD
#undef SWRITE
#undef SWAIT
#undef RESC
}
#undef KSWZ
#undef SBAR
}

namespace dil {
using bf16x8 = __attribute__((ext_vector_type(8))) short;
using s16x4  = __attribute__((ext_vector_type(4))) short;
using f32x16 = __attribute__((ext_vector_type(16))) float;
using u32x4  = __attribute__((ext_vector_type(4))) unsigned;
constexpr int TBL_PITCH = 2112;
constexpr int W_TBL = 0, W_K = 8448, W_V = 8448 + 4096, W_POS = 8448 + 8192, W_AL = W_POS + 128, W_BYTES = W_AL + 128;
__device__ __forceinline__ int crow(int r, int hi) { return (r & 3) + 8 * (r >> 2) + 4 * hi; }
__device__ __forceinline__ unsigned cvtpk(float lo, float hi) { unsigned r; asm volatile("v_cvt_pk_bf16_f32 %0, %1, %2" : "=v"(r) : "v"(lo), "v"(hi)); return r; }
#define DKSWZ(row, colB) ((row) * 128 + ((colB) ^ (((row) & 7) << 4)))
__device__ __forceinline__ int v_st(int k, int c) { const int kk = (k & ~0xC) | ((k & 4) << 1) | ((k & 8) >> 1); return ((kk >> 3) * 2 + (c >> 5)) * 512 + ((kk & 7) * 32 + (c & 31)) * 2; }
__device__ __forceinline__ int v_rd_base(int lane) { return ((lane & 3) << 3) | (((lane >> 2) & 3) << 6) | (((lane >> 4) & 1) << 5) | (((lane >> 5) & 1) << 8); }
constexpr int v_rd_off(int d0, int ks, int half) { return d0 * 512 + ks * 2048 + half * 1024; }
template <int OFF> __device__ __forceinline__ s16x4 tr_read(int vb) {
  s16x4 r; asm volatile("ds_read_b64_tr_b16 %0, %1 offset:%2" : "=&v"(r) : "v"(vb), "i"(OFF) : "memory"); return r;
}
template <int D0> __device__ __forceinline__ void pv_one(f32x16& od, int vb, bf16x8 pa0, bf16x8 pa1) {
  const s16x4 l0 = tr_read<v_rd_off(D0, 0, 0)>(vb), h0 = tr_read<v_rd_off(D0, 0, 1)>(vb), l1 = tr_read<v_rd_off(D0, 1, 0)>(vb), h1 = tr_read<v_rd_off(D0, 1, 1)>(vb);
  asm volatile("s_waitcnt lgkmcnt(0)" ::: "memory"); __builtin_amdgcn_sched_barrier(0);
#define PK(L, H) (bf16x8){L[0], L[1], L[2], L[3], H[0], H[1], H[2], H[3]}
  od = __builtin_amdgcn_mfma_f32_32x32x16_bf16(pa0, PK(l0, h0), od, 0, 0, 0);
  od = __builtin_amdgcn_mfma_f32_32x32x16_bf16(pa1, PK(l1, h1), od, 0, 0, 0);
#undef PK
}
struct KVRegs { bf16x8 k[4], v[4]; int pk; };
__device__ __forceinline__ void dil_task(const unsigned short* __restrict__ qkv, const int* __restrict__ pos, float* __restrict__ oap, float* __restrict__ lse,
                                         int b, int h, int g, int r, int ub, char* wl  ) {
  const int lane = threadIdx.x & 63, r32 = lane & 31, hi = lane >> 5;
  const int dl = g == 0 ? 1 : (g == 1 ? 4 : 16), L = S / dl;
  const int u_q = 32 * ub + r32;
  const size_t rowb = (size_t)b * S;
  const int tok_q = r + dl * u_q;
  const float* tblw = (const float*)(wl + W_TBL); int* posw = (int*)(wl + W_POS); float* alw = (float*)(wl + W_AL);
  bf16x8 qr[4];
  { const unsigned short* Qw = qkv + (rowb + tok_q) * 1536 + h * 64 + hi * 8;
#pragma unroll
    for (int d0 = 0; d0 < 4; ++d0) qr[d0] = *reinterpret_cast<const bf16x8*>(Qw + d0 * 16); }
  const int pos_q = pos[rowb + tok_q];
  const int srow = lane >> 1, shalf = (lane & 1) * 32;
  const int vb0 = (int)(uintptr_t)(wl + W_V) + v_rd_base(lane);
  float m_reg = -1e30f, l_reg = 0.f; f32x16 o[2] = {};
  constexpr float LOG2E = 1.4426950408889634f;
  auto load_blk = [&](int kb, KVRegs& R) {
    int up = 32 * (ub - 2 + kb) + srow; up = up < 0 ? 0 : (up >= L ? L - 1 : up);
    const unsigned short* base = qkv + (rowb + r + dl * up) * 1536 + h * 64 + shalf;
#pragma unroll
    for (int c = 0; c < 4; ++c) { R.k[c] = *reinterpret_cast<const bf16x8*>(base + 512 + c * 8); R.v[c] = *reinterpret_cast<const bf16x8*>(base + 1024 + c * 8); }
    int upl = 32 * (ub - 2 + kb) + r32; upl = upl < 0 ? 0 : (upl >= L ? L - 1 : upl);
    R.pk = pos[rowb + r + dl * upl];
  };
  const int kb_lo = (ub >= 2) ? 0 : (2 - ub), kb_hi = (32 * (ub + 3) <= L) ? 4 : (4 - ((32 * (ub + 3) - L) >> 5));
  KVRegs R; load_blk(kb_lo, R);
  for (int kb = kb_lo; kb <= kb_hi; ++kb) {
#pragma unroll
    for (int c = 0; c < 4; ++c) {
      *(bf16x8*)(wl + W_K + DKSWZ(srow, (shalf + c * 8) * 2)) = R.k[c];
      *(bf16x8*)(wl + W_V + v_st(srow, shalf + c * 8)) = R.v[c];
    }
    if (hi == 0) posw[r32] = R.pk;
    if (kb < kb_hi) load_blk(kb + 1, R);
    asm volatile("s_waitcnt lgkmcnt(0)" ::: "memory"); __builtin_amdgcn_sched_barrier(0);
    f32x16 p = {};
#pragma unroll
    for (int d0 = 0; d0 < 4; ++d0) {
      const bf16x8 kf = *reinterpret_cast<const bf16x8*>(wl + W_K + DKSWZ(r32, (d0 * 16 + hi * 8) * 2));
      p = __builtin_amdgcn_mfma_f32_32x32x16_bf16(kf, qr[d0], p, 0, 0, 0);
    }
    const int ub0 = 32 * (ub - 2 + kb);
    float bmax = -INFINITY;
#pragma unroll
    for (int rr = 0; rr < 16; ++rr) {
      const int kk = crow(rr, hi), up = ub0 + kk, du = up - u_q;
      const bool valid = (up >= 0) && (up < L) && (du >= -64) && (du <= 64);
      int rel = posw[kk] - pos_q; rel = rel < -1024 ? -1024 : (rel > 1024 ? 1024 : rel);
      const float sv = valid ? (p[rr] + tblw[rel + 1024]) : -INFINITY;
      p[rr] = sv; bmax = fmaxf(bmax, sv);
    }
    { auto x = __builtin_amdgcn_permlane32_swap(__float_as_uint(bmax), __float_as_uint(bmax), false, false); bmax = fmaxf(__uint_as_float(x[0]), __uint_as_float(x[1])); }
    const float mn = fmaxf(m_reg, bmax), alpha = __builtin_amdgcn_exp2f((m_reg - mn) * LOG2E);
    m_reg = mn;
    float ps = 0.f;
#pragma unroll
    for (int rr = 0; rr < 16; ++rr) { p[rr] = __builtin_amdgcn_exp2f((p[rr] - mn) * LOG2E); ps += p[rr]; }
    { auto x = __builtin_amdgcn_permlane32_swap(__float_as_uint(ps), __float_as_uint(ps), false, false); ps = __uint_as_float(x[0]) + __uint_as_float(x[1]); }
    l_reg = l_reg * alpha + ps;
    if (hi == 0) alw[r32] = alpha;
    asm volatile("s_waitcnt lgkmcnt(0)" ::: "memory");
#pragma unroll
    for (int d = 0; d < 2; ++d)
#pragma unroll
      for (int rr = 0; rr < 16; ++rr) o[d][rr] *= alw[crow(rr, hi)];
    bf16x8 pa0, pa1;
#define PK4(P, BASE, OUT) do { unsigned a0 = cvtpk(P[BASE + 0], P[BASE + 1]), a1 = cvtpk(P[BASE + 2], P[BASE + 3]);   \
    unsigned b0 = cvtpk(P[BASE + 4], P[BASE + 5]), b1 = cvtpk(P[BASE + 6], P[BASE + 7]);                              \
    auto r0 = __builtin_amdgcn_permlane32_swap(a0, b0, false, false); auto r1 = __builtin_amdgcn_permlane32_swap(a1, b1, false, false); \
    u32x4 w = {r0[0], r1[0], r0[1], r1[1]}; OUT = *reinterpret_cast<bf16x8*>(&w); } while (0)
    PK4(p, 0, pa0); PK4(p, 8, pa1);
#undef PK4
    pv_one<0>(o[0], vb0, pa0, pa1); pv_one<1>(o[1], vb0, pa0, pa1);
  }
  float* liw = alw;
  if (hi == 0) liw[r32] = l_reg;
  asm volatile("s_waitcnt lgkmcnt(0)" ::: "memory");
  if (hi == 0) lse[((size_t)g * T + rowb + tok_q) * 8 + h] = m_reg + __logf(l_reg);
  float* Ow = oap + ((size_t)g * T + rowb + r + (size_t)dl * 32 * ub) * 512 + h * 64;
#pragma unroll
  for (int rr = 0; rr < 16; ++rr) { const int orow = crow(rr, hi); const float rl = __builtin_amdgcn_rcpf(liw[orow]);
#pragma unroll
    for (int d0 = 0; d0 < 2; ++d0) Ow[(size_t)orow * dl * 512 + d0 * 32 + r32] = o[d0][rr] * rl; }
  asm volatile("s_waitcnt lgkmcnt(0)" ::: "memory");
}
#undef DKSWZ
}

namespace mk {
#define GAS __attribute__((address_space(1)))
#define LAS __attribute__((address_space(3)))
typedef unsigned short bf16_t;
typedef unsigned v4u __attribute__((ext_vector_type(4)));
typedef unsigned v2u __attribute__((ext_vector_type(2)));
typedef float f32x4 __attribute__((ext_vector_type(4)));
#define LDS_WAIT() asm volatile("s_waitcnt lgkmcnt(0)" ::: "memory")
#define VM_WAIT() asm volatile("s_waitcnt vmcnt(0)" ::: "memory")
__device__ __forceinline__ unsigned f2bf(float f) { unsigned u = __builtin_bit_cast(unsigned, f); return (u + 0x7fffu + ((u >> 16) & 1u)) >> 16; }
__device__ __forceinline__ unsigned pk2(float lo, float hi) { return f2bf(lo) | (f2bf(hi) << 16); }
__device__ __forceinline__ float bf2f(unsigned short b) { return __builtin_bit_cast(float, (unsigned)b << 16); }
__device__ __forceinline__ float wave_sum(float v) {
#pragma unroll
    for (int o = 1; o < 64; o <<= 1) v += __shfl_xor(v, o);
    return v;
}

constexpr int NWAVES = 8;
constexpr int LDS_BYTES = 147456;
constexpr int RING_BYTES = 131072;
constexpr int MISC_OFF = RING_BYTES + 320;
constexpr size_t MiB = 1u << 20;
constexpr size_t WS_CTL = 0, CTL_ZERO_BYTES = 1 * MiB;
constexpr size_t WS_WIN = 1 * MiB, WS_WQB = 5 * MiB, WS_WKVB = 5 * MiB + 512 * 1024, WS_WO = 6 * MiB, WS_WMQG = 8 * MiB, WS_WMKV = 10 * MiB, WS_WMO = 14 * MiB;
constexpr size_t WS_RSTDX = 16 * MiB, WS_RSTDM = 16 * MiB + 64 * 1024, WS_SSQQ = 16 * MiB + 256 * 1024, WS_SSQKV = 16 * MiB + 512 * 1024, WS_TBL = 16 * MiB + 768 * 1024;
constexpr size_t WS_SSQH1 = 17 * MiB, WS_SSQH2 = 18 * MiB, WS_ZKPE = 20 * MiB, WS_CS = 22 * MiB;
constexpr size_t WS_XB = 24 * MiB, WS_MEMB = 56 * MiB, WS_KVMEM = 58 * MiB, WS_KPE = 62 * MiB;
constexpr size_t WS_QKVA = 64 * MiB, WS_ZQ = 112 * MiB, WS_ZKV = 120 * MiB, WS_QB = 124 * MiB, WS_KN = 148 * MiB, WS_VB = 164 * MiB;
constexpr size_t WS_WPT = 180 * MiB, WS_VWT = 188 * MiB, WS_H2 = 196 * MiB, WS_H2B = 260 * MiB, WS_ROUTE = 292 * MiB, WS_XS = 296 * MiB;
constexpr size_t WS_OAP = 440 * MiB, WS_LSE = 536 * MiB, WS_OB = 538 * MiB, WS_OMIX = 570 * MiB, WS_HMID = 440 * MiB;
constexpr size_t WS_H1 = 602 * MiB, WS_H1B = 666 * MiB, WS_P = 698 * MiB, WS_YBUF = 602 * MiB;
constexpr size_t WS_WGU = 730 * MiB, WS_WD = 858 * MiB, WS_END = 922 * MiB;

struct Args { const float* in[26]; float* out; unsigned char* ws; double rope_rev[16]; int ph_lo, ph_hi, flags, pad; };

__device__ __forceinline__ void cvt_item(const float* W, int K, int N, const float* gain, bf16_t* WT, int mode, LAS float* scr, int item, int lane) {
    const int nblk = N / 32, kb = item / nblk, nb = item % nblk, k0 = 64 * kb, n0 = 32 * nb;
#pragma unroll 8
    for (int i = 0; i < 32; ++i) { const int kk = 2 * i + (lane >> 5); float v = W[(size_t)(k0 + kk) * N + n0 + (lane & 31)]; if (gain) v *= gain[k0 + kk]; scr[kk * 33 + (lane & 31)] = v; }
    LDS_WAIT(); asm volatile("" ::: "memory");
    int drow0 = n0; if (mode == 1) { const int half = n0 >> 10, c = n0 & 1023; drow0 = (c >> 7) * 256 + half * 128 + (c & 127); }
    const int c = lane & 7;
#pragma unroll
    for (int j = 0; j < 4; ++j) { const int n = (lane >> 3) + 8 * j; const LAS float* s = scr + (8 * c) * 33 + n;
        v4u o; o.x = pk2(s[0 * 33], s[1 * 33]); o.y = pk2(s[2 * 33], s[3 * 33]); o.z = pk2(s[4 * 33], s[5 * 33]); o.w = pk2(s[6 * 33], s[7 * 33]);
        *(v4u*)(WT + (size_t)(drow0 + n) * K + k0 + 8 * c) = o; }
    LDS_WAIT(); asm volatile("" ::: "memory");
}
__device__ __forceinline__ void prep_row(const float* xrow, const float* gain, bf16_t* orow, float* rstd_out, int lane) {
    const f32x4* xr = (const f32x4*)xrow + lane;
    f32x4 v[4]; float s = 0.f;
#pragma unroll
    for (int j = 0; j < 4; ++j) { v[j] = xr[64 * j]; s += (v[j].x * v[j].x + v[j].y * v[j].y) + (v[j].z * v[j].z + v[j].w * v[j].w); }
    s = wave_sum(s);
    if (rstd_out && lane == 0) *rstd_out = 1.0f / sqrtf(s * (1.0f / 1024.0f) + 1e-6f);
    if (gain) {
#pragma unroll
        for (int j = 0; j < 4; ++j) v[j] = v[j] * ((const f32x4*)gain)[lane + 64 * j];
    }
    unsigned long long* o8 = (unsigned long long*)orow + lane;
#pragma unroll
    for (int j = 0; j < 4; ++j) o8[64 * j] = (unsigned long long)pk2(v[j].x, v[j].y) | ((unsigned long long)pk2(v[j].z, v[j].w) << 32);
}

__device__ __forceinline__ v4u pack8(const f32x4 a, const f32x4 b) { v4u w; w.x = pk2(a[0], a[1]); w.y = pk2(a[2], a[3]); w.z = pk2(b[0], b[1]); w.w = pk2(b[2], b[3]); return w; }
__device__ __forceinline__ float sq8(const f32x4 a, const f32x4 b) { return (a[0] * a[0] + a[1] * a[1]) + (a[2] * a[2] + a[3] * a[3]) + (b[0] * b[0] + b[1] * b[1]) + (b[2] * b[2] + b[3] * b[3]); }

struct EpiInProj {
    static constexpr bool PERM = true, AFTER_DRAIN = false;
    const float* rstd; bf16_t* qkv; bf16_t* zq; bf16_t* zkv; float* zkpe; float* ssq_q; float* ssq_kv;
    __device__ __forceinline__ void operator()(const pg8::f32x4 (&acc)[2][2][4][2], const pg8::Unit& u, int wr, int wc, int fr, int fq) const {
        const int row0 = u.pm * 256 + wr * 64 + fr;
        const float qs = u.pn < 2 ? 0.125f : 1.0f;
#pragma unroll
        for (int ai = 0; ai < 2; ++ai)
#pragma unroll
            for (int m = 0; m < 4; ++m) {
                const int row = row0 + ai * 128 + m * 16;
                const float rs = rstd[row];
                float ss = 0.f;
#pragma unroll
                for (int bj = 0; bj < 2; ++bj) {
                    const f32x4 v0 = acc[ai][bj][m][0] * rs, v1 = acc[ai][bj][m][1] * rs;
                    const int ct = bj * 128 + wc * 32 + 8 * fq;
                    if (u.pn < 6) { *(v4u*)(qkv + (size_t)row * 1536 + u.pn * 256 + ct) = pack8(v0 * qs, v1 * qs); }
                    else if (u.pn == 6) { *(v4u*)(zq + (size_t)row * 256 + ct) = pack8(v0, v1); ss += sq8(v0, v1); }
                    else if (bj == 0) { *(v4u*)(zkv + (size_t)row * 128 + ct) = pack8(v0, v1); ss += sq8(v0, v1); }
                    else if (wc == 0) { *(f32x4*)(zkpe + (size_t)row * 32 + 8 * fq) = v0; *(f32x4*)(zkpe + (size_t)row * 32 + 8 * fq + 4) = v1; }
                }
                if (u.pn >= 6) { ss += __shfl_xor(ss, 16); ss += __shfl_xor(ss, 32); if (fq == 0) (u.pn == 6 ? ssq_q : ssq_kv)[(size_t)row * 4 + wc] = ss; }
            }
    }
};


struct EpiQ {
    static constexpr bool PERM = true, AFTER_DRAIN = false;
    const float* ssq; bf16_t* Q;
    __device__ __forceinline__ void operator()(const pg8::f32x4 (&acc)[2][2][4][2], const pg8::Unit& u, int wr, int wc, int fr, int fq) const {
        const int row0 = u.pm * 256 + wr * 64 + fr;
#pragma unroll
        for (int ai = 0; ai < 2; ++ai)
#pragma unroll
            for (int m = 0; m < 4; ++m) {
                const int row = row0 + ai * 128 + m * 16;
                const f32x4 sp = *(const f32x4*)(ssq + (size_t)row * 4);
                const float rs = 1.0f / sqrtf(((sp[0] + sp[1]) + (sp[2] + sp[3])) * (1.0f / 256.0f) + 1e-6f);
#pragma unroll
                for (int bj = 0; bj < 2; ++bj)
                    *(v4u*)(Q + (size_t)row * 768 + u.pn * 256 + bj * 128 + wc * 32 + 8 * fq) = pack8(acc[ai][bj][m][0] * rs, acc[ai][bj][m][1] * rs);
            }
    }
};
struct EpiKV {
    static constexpr bool PERM = true, AFTER_DRAIN = false;
    const float* ssq; bf16_t* Kn; bf16_t* Vb;
    __device__ __forceinline__ void operator()(const pg8::f32x4 (&acc)[2][2][4][2], const pg8::Unit& u, int wr, int wc, int fr, int fq) const {
        const int row0 = u.pm * 256 + wr * 64 + fr;
        bf16_t* dst = (wc < 2 ? Kn : Vb) + (wc & 1) * 32 + 8 * fq;
#pragma unroll
        for (int ai = 0; ai < 2; ++ai)
#pragma unroll
            for (int m = 0; m < 4; ++m) {
                const int row = row0 + ai * 128 + m * 16;
                const f32x4 sp = *(const f32x4*)(ssq + (size_t)row * 4);
                const float rs = 1.0f / sqrtf(((sp[0] + sp[1]) + (sp[2] + sp[3])) * (1.0f / 128.0f) + 1e-6f);
#pragma unroll
                for (int bj = 0; bj < 2; ++bj)
                    *(v4u*)(dst + (size_t)row * 512 + (u.pn * 2 + bj) * 64) = pack8(acc[ai][bj][m][0] * rs, acc[ai][bj][m][1] * rs);
            }
    }
};
struct EpiRowScale {
    static constexpr bool PERM = true, AFTER_DRAIN = false;
    const float* rs; bf16_t* O; int ldc;
    __device__ __forceinline__ void operator()(const pg8::f32x4 (&acc)[2][2][4][2], const pg8::Unit& u, int wr, int wc, int fr, int fq) const {
        const int row0 = u.pm * 256 + wr * 64 + fr;
#pragma unroll
        for (int ai = 0; ai < 2; ++ai)
#pragma unroll
            for (int m = 0; m < 4; ++m) {
                const int row = row0 + ai * 128 + m * 16;
                const float r = rs[row];
#pragma unroll
                for (int bj = 0; bj < 2; ++bj)
                    *(v4u*)(O + (size_t)row * ldc + u.pn * 256 + bj * 128 + wc * 32 + 8 * fq) = pack8(acc[ai][bj][m][0] * r, acc[ai][bj][m][1] * r);
            }
    }
};

struct EpiResid {
    static constexpr bool PERM = true, AFTER_DRAIN = false;
    const float* base; float* out; bf16_t* outb; float* ssq;
    __device__ __forceinline__ void operator()(const pg8::f32x4 (&acc)[2][2][4][2], const pg8::Unit& u, int wr, int wc, int fr, int fq) const {
        const int row0 = u.pm * 256 + wr * 64 + fr;
#pragma unroll
        for (int ai = 0; ai < 2; ++ai)
#pragma unroll
            for (int m = 0; m < 4; ++m) {
                const int row = row0 + ai * 128 + m * 16;
                float ss = 0.f;
#pragma unroll
                for (int bj = 0; bj < 2; ++bj) {
                    const size_t o = (size_t)row * 1024 + u.pn * 256 + bj * 128 + wc * 32 + 8 * fq;
                    const f32x4 v0 = acc[ai][bj][m][0] + *(const f32x4*)(base + o), v1 = acc[ai][bj][m][1] + *(const f32x4*)(base + o + 4);
                    *(f32x4*)(out + o) = v0; *(f32x4*)(out + o + 4) = v1; *(v4u*)(outb + o) = pack8(v0, v1); ss += sq8(v0, v1);
                }
                ss += __shfl_xor(ss, 16); ss += __shfl_xor(ss, 32);
                if (fq == 0) ssq[(size_t)row * 16 + u.pn * 4 + wc] = ss;
                asm volatile("" ::: "memory");
            }
    }
};
struct EpiPlain {
    static constexpr bool PERM = true, AFTER_DRAIN = false;
    bf16_t* O; int ldc;
    __device__ __forceinline__ void operator()(const pg8::f32x4 (&acc)[2][2][4][2], const pg8::Unit& u, int wr, int wc, int fr, int fq) const {
        const int row0 = u.pm * 256 + wr * 64 + fr;
#pragma unroll
        for (int ai = 0; ai < 2; ++ai)
#pragma unroll
            for (int m = 0; m < 4; ++m)
#pragma unroll
                for (int bj = 0; bj < 2; ++bj)
                    *(v4u*)(O + (size_t)(row0 + ai * 128 + m * 16) * ldc + u.pn * 256 + bj * 128 + wc * 32 + 8 * fq) = pack8(acc[ai][bj][m][0], acc[ai][bj][m][1]);
    }
};
struct EpiSoftmax {
    static constexpr bool PERM = true, AFTER_DRAIN = true;
    bf16_t* P; int rsl_off;
    __device__ __forceinline__ void fused(pg8::f32x4 (&acc)[2][2][4][2], const pg8::Unit& u, int wr, int wc, int fr, int fq, PG8_LAS unsigned char* lds, int wid, int lane) const {
        typedef float f32x2v __attribute__((ext_vector_type(2)));
        const PG8_LAS float* rsl = (const PG8_LAS float*)(lds + rsl_off);
        PG8_LAS f32x2v* X = (PG8_LAS f32x2v*)lds;
        constexpr float L2E = 1.4426950408889634f;
#pragma unroll
        for (int ai = 0; ai < 2; ++ai)
#pragma unroll
            for (int m = 0; m < 4; ++m) {
                const int rt = ai * 128 + wr * 64 + m * 16 + fr;
                const float rs = rsl[rt] * (0.0625f * L2E);
                float mx = -3.0e38f;
#pragma unroll
                for (int bj = 0; bj < 2; ++bj)
#pragma unroll
                    for (int n = 0; n < 2; ++n) { f32x4 v = acc[ai][bj][m][n] * rs; acc[ai][bj][m][n] = v; mx = fmaxf(mx, fmaxf(fmaxf(v[0], v[1]), fmaxf(v[2], v[3]))); }
                mx = fmaxf(mx, __shfl_xor(mx, 16)); mx = fmaxf(mx, __shfl_xor(mx, 32));
                float sm = 0.f;
#pragma unroll
                for (int bj = 0; bj < 2; ++bj)
#pragma unroll
                    for (int n = 0; n < 2; ++n) { const f32x4 v = acc[ai][bj][m][n]; sm += (__builtin_amdgcn_exp2f(v[0] - mx) + __builtin_amdgcn_exp2f(v[1] - mx)) + (__builtin_amdgcn_exp2f(v[2] - mx) + __builtin_amdgcn_exp2f(v[3] - mx)); }
                sm += __shfl_xor(sm, 16); sm += __shfl_xor(sm, 32);
                if (fq == 0) X[rt * 4 + wc] = (f32x2v){mx, sm};
            }
        asm volatile("s_waitcnt lgkmcnt(0)" ::: "memory"); __builtin_amdgcn_s_barrier(); asm volatile("" ::: "memory");
#pragma unroll
        for (int ai = 0; ai < 2; ++ai)
#pragma unroll
            for (int m = 0; m < 4; ++m) {
                const int rt = ai * 128 + wr * 64 + m * 16 + fr;
                const f32x2v x0 = X[rt * 4 + 0], x1 = X[rt * 4 + 1], x2 = X[rt * 4 + 2], x3 = X[rt * 4 + 3];
                const float M = fmaxf(fmaxf(x0.x, x1.x), fmaxf(x2.x, x3.x));
                const float tot = (x0.y * __builtin_amdgcn_exp2f(x0.x - M) + x1.y * __builtin_amdgcn_exp2f(x1.x - M)) + (x2.y * __builtin_amdgcn_exp2f(x2.x - M) + x3.y * __builtin_amdgcn_exp2f(x3.x - M));
                const float inv = 1.0f / tot;
#pragma unroll
                for (int bj = 0; bj < 2; ++bj) {
                    f32x4 a = acc[ai][bj][m][0], b = acc[ai][bj][m][1];
#pragma unroll
                    for (int j = 0; j < 4; ++j) { a[j] = __builtin_amdgcn_exp2f(a[j] - M) * inv; b[j] = __builtin_amdgcn_exp2f(b[j] - M) * inv; }
                    *(v4u*)(P + (size_t)(u.pm * 256 + rt) * 1024 + u.pn * 256 + bj * 128 + wc * 32 + 8 * fq) = pack8(a, b);
                }
            }
    }
};
struct OrderWp {
    int c;
    __device__ bool next(int i, pg8::Unit& u) const { if (i > 0 || c >= 64) return false; const int bhh = c >> 2, pn = c & 3, b = bhh >> 2, h = bhh & 3;
        u.pm = bhh; u.pn = pn; u.aoff = ((size_t)(b * 256) * 2048 + h * 256) * 2; u.boff = ((size_t)(pn * 256) * 1024 + h * 256) * 2; return true; }
    __device__ __forceinline__ void a_ready(const pg8::Unit&) const {}
    __device__ __forceinline__ void done(const pg8::Unit&) const {}
};
struct OrderVw {
    int c;
    __device__ bool next(int i, pg8::Unit& u) const { if (i > 0 || c >= 64) return false; const int b = c >> 4, ct = (c >> 2) & 3, h = c & 3;
        u.pm = b * 4 + ct; u.pn = h; u.aoff = ((size_t)(ct * 256) * 1024 + h * 256) * 2; u.boff = ((size_t)(b * 256) * 2048 + 1024 + h * 256) * 2; return true; }
    __device__ __forceinline__ void a_ready(const pg8::Unit&) const {}
    __device__ __forceinline__ void done(const pg8::Unit&) const {}
};
struct OrderBatch {
    pg8::StaticOrder so;
    __device__ bool next(int i, pg8::Unit& u) const { if (!so.next(i, u)) return false; u.boff = ((size_t)((u.pm >> 4) * 1024 + u.pn * 256) * 1024) * 2; return true; }
    __device__ __forceinline__ void a_ready(const pg8::Unit&) const {}
    __device__ __forceinline__ void done(const pg8::Unit&) const {}
};

constexpr int MPADN = NA + NE * 256, NTILEN = MPADN / 256;
constexpr int CW_GCOUNT = 8192;
constexpr size_t RT_TOPI = 0, RT_TOPG = 256 * 1024, RT_SLOT = 512 * 1024, RT_ROWFLAT = 768 * 1024, RT_RSROW = 1088 * 1024;
constexpr int LX_TEXP = RING_BYTES + 2048;
struct OrderMoe {
    const LAS int* texp; int nper, c, G; size_t ebytes;
    __device__ bool next(int i, pg8::Unit& u) const {
        const int L = i * G + (c & 7) * (G >> 3) + (c >> 3); const int tile = L / nper, pn = L % nper;
        if (tile >= texp[NTILEN]) return false;
        u.pm = tile; u.pn = pn; u.aoff = (size_t)tile * 256 * 1024 * 2; u.boff = (size_t)texp[tile] * ebytes + (size_t)pn * 256 * 1024 * 2; return true; }
    __device__ __forceinline__ void a_ready(const pg8::Unit&) const {}
    __device__ __forceinline__ void done(const pg8::Unit&) const {}
};
__device__ __forceinline__ float swiglu1(float g, float u) { g = fminf(g, 7.0f); u = fminf(fmaxf(u, -7.0f), 7.0f); return (u + 1.0f) * g * __builtin_amdgcn_rcpf(1.0f + __builtin_amdgcn_exp2f(-1.702f * 1.4426950408889634f * g)); }
struct EpiSwiGLU {
    static constexpr bool PERM = true, AFTER_DRAIN = false;
    const float* rs_row; const float* bgu; bf16_t* hmid; const LAS int* texp;
    __device__ __forceinline__ void operator()(const pg8::f32x4 (&acc)[2][2][4][2], const pg8::Unit& u, int wr, int wc, int fr, int fq) const {
        const int row0 = u.pm * 256 + wr * 64 + fr, e = texp[u.pm], c0 = u.pn * 128 + wc * 32 + 8 * fq;
        const float* bg = bgu + (size_t)e * 2048 + c0;
        const f32x4 bg0 = *(const f32x4*)bg, bg1 = *(const f32x4*)(bg + 4), bu0 = *(const f32x4*)(bg + 1024), bu1 = *(const f32x4*)(bg + 1028);
#pragma unroll
        for (int ai = 0; ai < 2; ++ai)
#pragma unroll
            for (int m = 0; m < 4; ++m) {
                const int row = row0 + ai * 128 + m * 16; const float rs = rs_row[row];
                const f32x4 g0 = acc[ai][0][m][0] * rs + bg0, g1 = acc[ai][0][m][1] * rs + bg1, u0 = acc[ai][1][m][0] * rs + bu0, u1 = acc[ai][1][m][1] * rs + bu1;
                f32x4 h0, h1;
#pragma unroll
                for (int j = 0; j < 4; ++j) { h0[j] = swiglu1(g0[j], u0[j]); h1[j] = swiglu1(g1[j], u1[j]); }
                *(v4u*)(hmid + (size_t)row * 1024 + c0) = pack8(h0, h1);
            }
    }
};
struct EpiDown {
    static constexpr bool PERM = true, AFTER_DRAIN = false;
    const int* row_flat; const float* topg; const float* bd; bf16_t* ybuf; const LAS int* texp;
    __device__ __forceinline__ void operator()(const pg8::f32x4 (&acc)[2][2][4][2], const pg8::Unit& u, int wr, int wc, int fr, int fq) const {
        const int row0 = u.pm * 256 + wr * 64 + fr, e = texp[u.pm], c0 = u.pn * 256 + wc * 32 + 8 * fq;
        const float* bp = bd + (size_t)e * 1024 + c0;
        f32x4 bv[2][2];
#pragma unroll
        for (int bj = 0; bj < 2; ++bj) { bv[bj][0] = *(const f32x4*)(bp + bj * 128); bv[bj][1] = *(const f32x4*)(bp + bj * 128 + 4); }
#pragma unroll
        for (int ai = 0; ai < 2; ++ai)
#pragma unroll
            for (int m = 0; m < 4; ++m) {
                const int row = row0 + ai * 128 + m * 16; const int a = row_flat[row];
                if (a >= 0) { const float gt = topg[a];
#pragma unroll
                    for (int bj = 0; bj < 2; ++bj)
                        *(v4u*)(ybuf + (size_t)a * 1024 + c0 + bj * 128) = pack8((acc[ai][bj][m][0] + bv[bj][0]) * gt, (acc[ai][bj][m][1] + bv[bj][1]) * gt); }
            }
    }
};

__device__ __forceinline__ int rel_bucket_d(int rel) {
    int n = rel < 0 ? -rel : rel;
    int b;
    if (n < 8) b = n; else if (n < 15) b = 8; else if (n < 27) b = 9; else if (n < 50) b = 10; else if (n < 91) b = 11;
    else if (n < 166) b = 12; else if (n < 305) b = 13; else if (n < 559) b = 14; else b = 15;
    return b + (rel > 0 ? 16 : 0);
}

__global__ void __launch_bounds__(NWAVES * 64, 2) mk_fwd(Args args) {
    extern __shared__ __attribute__((aligned(16))) unsigned char lds_raw[];
    LAS unsigned char* lds = (LAS unsigned char*)lds_raw;
    const int tid = threadIdx.x, lane = tid & 63, wave = __builtin_amdgcn_readfirstlane(tid >> 6);
    const int G = gridDim.x; const int bx = blockIdx.x; const int vcu = (G % 8 == 0) ? (bx % 8) * (G / 8) + bx / 8 : bx;
    unsigned char* ws = args.ws;
    const int lo = args.ph_lo, hi = args.ph_hi;
#define IN(k) (lo <= (k) && (k) < hi)
    const float* x = args.in[0]; const float* mem = args.in[1]; const float* g_mix = args.in[3]; const float* w_in = args.in[4];
    const float* g_q_a = args.in[5]; const float* w_q_b = args.in[6]; const float* g_kv_a = args.in[7]; const float* w_kv_b = args.in[8];
    const float* w_o = args.in[12]; const float* g_xattn = args.in[13]; const float* g_mem = args.in[14]; const float* w_mq = args.in[15];
    const float* w_mkv = args.in[16]; const float* w_mo = args.in[17]; const float* g_moe = args.in[18];
    const float* w_gate_up = args.in[21]; const float* w_down = args.in[23];
    bf16_t* WinT = (bf16_t*)(ws + WS_WIN); bf16_t* WqbT = (bf16_t*)(ws + WS_WQB); bf16_t* WkvbT = (bf16_t*)(ws + WS_WKVB); bf16_t* WoT = (bf16_t*)(ws + WS_WO);
    bf16_t* Wmqg = (bf16_t*)(ws + WS_WMQG); bf16_t* WmkvT = (bf16_t*)(ws + WS_WMKV); bf16_t* WmoT = (bf16_t*)(ws + WS_WMO);
    bf16_t* WguT = (bf16_t*)(ws + WS_WGU); bf16_t* WdT = (bf16_t*)(ws + WS_WD);
    bf16_t* xb = (bf16_t*)(ws + WS_XB); bf16_t* memb = (bf16_t*)(ws + WS_MEMB);
    float* rstd_x = (float*)(ws + WS_RSTDX); float* rstd_mem = (float*)(ws + WS_RSTDM);

    if (IN(0)) {
        LAS float* scr = (LAS float*)(lds + wave * 16384);
        const int gw = vcu * NWAVES + wave, NGW = G * NWAVES;
        constexpr int I_IN = 16 * 61, I_QB = 4 * 24, I_KVB = 2 * 32, I_O = 16 * 32, I_MKV = 16 * 64, I_MO = 16 * 32, I_GU = 16 * 64, I_D = 16 * 32;
        const int n_exp = (args.flags & 1) ? 32 : 0;
        const int NITEMS = I_IN + I_QB + I_KVB + I_O + I_MKV + I_MO + n_exp * (I_GU + I_D);
        for (int it = gw; it < NITEMS; it += NGW) {
            int r = it;
            if (r < I_IN) { cvt_item(w_in, 1024, 1952, g_mix, WinT, 0, scr, r, lane); continue; } r -= I_IN;
            if (r < I_QB) { cvt_item(w_q_b, 256, 768, g_q_a, WqbT, 0, scr, r, lane); continue; } r -= I_QB;
            if (r < I_KVB) { cvt_item(w_kv_b, 128, 1024, g_kv_a, WkvbT, 0, scr, r, lane); continue; } r -= I_KVB;
            if (r < I_O) { cvt_item(w_o, 1024, 1024, nullptr, WoT, 0, scr, r, lane); continue; } r -= I_O;
            if (r < I_MKV) { cvt_item(w_mkv, 1024, 2048, g_mem, WmkvT, 0, scr, r, lane); continue; } r -= I_MKV;
            if (r < I_MO) { cvt_item(w_mo, 1024, 1024, nullptr, WmoT, 0, scr, r, lane); continue; } r -= I_MO;
            if (r < 32 * I_GU) { const int e = r / I_GU; cvt_item(w_gate_up + (size_t)e * 1024 * 2048, 1024, 2048, g_moe, WguT + (size_t)e * 2048 * 1024, 1, scr, r % I_GU, lane); continue; } r -= 32 * I_GU;
            { const int e = r / I_D; cvt_item(w_down + (size_t)e * 1024 * 1024, 1024, 1024, nullptr, WdT + (size_t)e * 1024 * 1024, 0, scr, r % I_D, lane); }
        }
        for (int i = gw * 64 + lane; i < 96 * 1024 / 8; i += NGW * 64) ((v4u*)(WinT + (size_t)1952 * 1024))[i] = (v4u){0u, 0u, 0u, 0u};
        for (int m = gw; m < T; m += NGW) prep_row(x + (size_t)m * D, nullptr, xb + (size_t)m * D, rstd_x + m, lane);
        for (int m = gw; m < NB * NMEM; m += NGW) prep_row(mem + (size_t)m * D, nullptr, memb + (size_t)m * D, rstd_mem + m, lane);
        for (int m = gw; m < D; m += NGW) {
            const f32x4* xr = (const f32x4*)(w_mq + (size_t)m * D) + lane; const float gc = g_xattn[m];
            unsigned long long* o8 = (unsigned long long*)(Wmqg + (size_t)m * D) + lane;
#pragma unroll
            for (int j = 0; j < 4; ++j) { const f32x4 v = xr[64 * j] * gc; o8[64 * j] = (unsigned long long)pk2(v.x, v.y) | ((unsigned long long)pk2(v.z, v.w) << 32); }
        }
    }
    if (IN(0)) {
        const float* rel_bias = args.in[9]; float* tbl = (float*)(ws + WS_TBL);
        for (int i = bx * 512 + tid; i < 8 * 2049; i += G * 512) { const int h = i / 2049, r = i % 2049; tbl[h * 2112 + r] = rel_bias[rel_bucket_d(r - 1024) * 8 + h]; }
    }
    if (IN(1)) {
        int kx = 1024; asm volatile("" : "+s"(kx)); pg8::Gemm g{xb, WinT, kx, kx, kx}; pg8::StaticOrder S; S.init(T, 2048, 1024, 1024, G, bx);
        EpiInProj E{rstd_x, (bf16_t*)(ws + WS_QKVA), (bf16_t*)(ws + WS_ZQ), (bf16_t*)(ws + WS_ZKV), (float*)(ws + WS_ZKPE), (float*)(ws + WS_SSQQ), (float*)(ws + WS_SSQKV)};
        pg8::gemm_phase<EpiInProj, pg8::StaticOrder, true, true>(lds, g, S, E);
    }
    if (IN(2)) {
        const int* pos = (const int*)args.in[2];
        float* cs = (float*)(ws + WS_CS); const float* zkpe = (const float*)(ws + WS_ZKPE); bf16_t* kpe = (bf16_t*)(ws + WS_KPE);
        for (int i = bx * 512 + tid; i < T * 16; i += G * 512) {
            const int t = i >> 4, j = i & 15;
            const double rev = (double)pos[t] * args.rope_rev[j];
            const float fr_ = (float)(rev - floor(rev));
            const float sn = __builtin_amdgcn_sinf(fr_), c_ = __builtin_amdgcn_cosf(fr_);
            cs[(size_t)t * 32 + j] = c_; cs[(size_t)t * 32 + 16 + j] = sn;
            const float x1 = zkpe[(size_t)t * 32 + j], x2 = zkpe[(size_t)t * 32 + 16 + j];
            kpe[(size_t)t * 32 + j] = (bf16_t)f2bf(x1 * c_ - x2 * sn); kpe[(size_t)t * 32 + 16 + j] = (bf16_t)f2bf(x1 * sn + x2 * c_);
        }
        {   int kq = 256; asm volatile("" : "+s"(kq)); pg8::Gemm g{(const bf16_t*)(ws + WS_ZQ), WqbT, kq, kq, kq}; pg8::StaticOrder S; S.init(T, 768, 256, 256, G, bx);
            EpiQ E{(const float*)(ws + WS_SSQQ), (bf16_t*)(ws + WS_QB)};
            pg8::gemm_phase<EpiQ, pg8::StaticOrder, true, true>(lds, g, S, E); }
        {   int kk = 128; asm volatile("" : "+s"(kk)); pg8::Gemm g{(const bf16_t*)(ws + WS_ZKV), WkvbT, kk, kk, kk}; pg8::StaticOrder S; S.init(T, 1024, 128, 128, G, bx);
            EpiKV E{(const float*)(ws + WS_SSQKV), (bf16_t*)(ws + WS_KN), (bf16_t*)(ws + WS_VB)};
            pg8::gemm_phase<EpiKV, pg8::StaticOrder, true, true>(lds, g, S, E); }
        {   int kx = 1024; asm volatile("" : "+s"(kx)); pg8::Gemm g{memb, WmkvT, kx, kx, kx}; pg8::StaticOrder S; S.init(NB * NMEM, 2048, 1024, 1024, G, (bx + 64) % G);
            EpiRowScale E{rstd_mem, (bf16_t*)(ws + WS_KVMEM), 2048};
            pg8::gemm_phase<EpiRowScale, pg8::StaticOrder, true, true>(lds, g, S, E); }
    }
    if (IN(3)) {
        const unsigned short* Qg = (const unsigned short*)(ws + WS_QB); const unsigned short* Kn = (const unsigned short*)(ws + WS_KN);
        const unsigned short* Kp = (const unsigned short*)(ws + WS_KPE); const unsigned short* Vg = (const unsigned short*)(ws + WS_VB);
        const float* cs = (const float*)(ws + WS_CS); float* Og = (float*)(ws + WS_OB);
        for (int i = 0; ; ++i) {
            int bh, qb;
            if (G == 256) { if (i >= 2) break; const int idx = i * 32 + (bx >> 3); bh = (bx & 7) + 8 * (idx >> 4); qb = idx & 15; }
            else { const int un = i * G + bx; if (un >= 512) break; bh = un >> 4; qb = un & 15; }
            const int b = bh >> 3, h = bh & 7;
            mla::mla_unit(Qg, Kn, Kp, Vg, cs, Og, b * S + qb * 256, b * S, h, S, (char*)lds_raw);
        }
        {
            const unsigned short* qkv = (const unsigned short*)(ws + WS_QKVA); const int* pos = (const int*)args.in[2];
            const float* tbl = (const float*)(ws + WS_TBL); float* oap = (float*)(ws + WS_OAP); float* lse = (float*)(ws + WS_LSE);
            char* wl = (char*)lds_raw + wave * dil::W_BYTES;
            __syncthreads();
            int cur_h = -1;
            for (int i = 0; ; ++i) {
                int bh, k;
                if (G == 256) { if (i >= 6) break; bh = (bx & 7) + 8 * (bx >> 6); k = ((((bx >> 3) & 7) * 6 + i) << 3) + wave; }
                else { const int id = (i * G + bx) * 8 + wave; if (id >= 12288) break; bh = id / 384; k = id % 384; }
                const int b = bh >> 3, h = bh & 7, g = k >> 7, kk = k & 127, nub = g == 0 ? 128 : (g == 1 ? 32 : 8);
                if (h != cur_h) { float* tw = (float*)(wl + dil::W_TBL); for (int j = lane; j < 2049; j += 64) tw[j] = tbl[h * dil::TBL_PITCH + j]; cur_h = h; asm volatile("s_waitcnt vmcnt(0) lgkmcnt(0)" ::: "memory"); }
                dil::dil_task(qkv, pos, oap, lse, b, h, g, kk / nub, kk % nub, wl);
            }
        }
    }
    if (IN(4)) {
        { int kx = 256; asm volatile("" : "+s"(kx));
          if (bx < 64) { pg8::Gemm g{(const bf16_t*)(ws + WS_KVMEM), Wmqg, 2048, 1024, kx}; OrderWp S{bx}; EpiPlain E{(bf16_t*)(ws + WS_WPT), 1024};
              pg8::gemm_phase<EpiPlain, OrderWp, true, true>(lds, g, S, E); }
          else if (bx < 128) { pg8::Gemm g{WmoT, (const bf16_t*)(ws + WS_KVMEM), 1024, 2048, kx}; OrderVw S{bx - 64}; EpiPlain E{(bf16_t*)(ws + WS_VWT), 1024};
              pg8::gemm_phase<EpiPlain, OrderVw, true, true>(lds, g, S, E); } }
        const float* oap = (const float*)(ws + WS_OAP); const float* lse = (const float*)(ws + WS_LSE); const float* obp = (const float*)(ws + WS_OB);
        const float* g_out_a = args.in[10]; const float* g_out_b = args.in[11]; bf16_t* omix = (bf16_t*)(ws + WS_OMIX);
        const int gw = vcu * NWAVES + wave, NGW = G * NWAVES;
        const f32x4 ga0 = *(const f32x4*)(g_out_a + 8 * lane), ga1 = *(const f32x4*)(g_out_a + 8 * lane + 4), gb0 = *(const f32x4*)(g_out_b + 8 * lane), gb1 = *(const f32x4*)(g_out_b + 8 * lane + 4);
        for (int tok = gw; tok < T; tok += NGW) {
            const int head = lane >> 3;
            const float l0 = lse[((size_t)0 * T + tok) * 8 + head], l1 = lse[((size_t)1 * T + tok) * 8 + head], l2 = lse[((size_t)2 * T + tok) * 8 + head];
            const float mx = fmaxf(l0, fmaxf(l1, l2)); float w0 = __expf(l0 - mx), w1 = __expf(l1 - mx), w2 = __expf(l2 - mx); const float wi = 1.0f / (w0 + w1 + w2); w0 *= wi; w1 *= wi; w2 *= wi;
            const f32x4* p0 = (const f32x4*)(oap + ((size_t)0 * T + tok) * 512 + 8 * lane); const f32x4* p1 = (const f32x4*)(oap + ((size_t)1 * T + tok) * 512 + 8 * lane);
            const f32x4* p2 = (const f32x4*)(oap + ((size_t)2 * T + tok) * 512 + 8 * lane); const f32x4* pb = (const f32x4*)(obp + (size_t)tok * 512 + 8 * lane);
            const f32x4 a0 = p0[0] * w0 + p1[0] * w1 + p2[0] * w2, a1 = p0[1] * w0 + p1[1] * w1 + p2[1] * w2, b0 = pb[0], b1 = pb[1];
            const float sa = wave_sum(sq8(a0, a1)), sb = wave_sum(sq8(b0, b1));
            const float ra = 1.0f / sqrtf(sa * (1.0f / 512.0f) + 1e-6f), rb = 1.0f / sqrtf(sb * (1.0f / 512.0f) + 1e-6f);
            *(v4u*)(omix + (size_t)tok * 1024 + 8 * lane) = pack8(a0 * ra * ga0, a1 * ra * ga1);
            *(v4u*)(omix + (size_t)tok * 1024 + 512 + 8 * lane) = pack8(b0 * rb * gb0, b1 * rb * gb1);
        }
    }
    if (IN(5)) {
        int kx = 1024; asm volatile("" : "+s"(kx));
        pg8::Gemm g{(const bf16_t*)(ws + WS_OMIX), WoT, kx, kx, kx}; pg8::StaticOrder S; S.init(T, 1024, 1024, 1024, G, bx);
        EpiResid E{x, (float*)(ws + WS_H1), (bf16_t*)(ws + WS_H1B), (float*)(ws + WS_SSQH1)};
        pg8::gemm_phase<EpiResid, pg8::StaticOrder, true, true>(lds, g, S, E);
    }
    if (IN(6)) {
        int kx = 1024; asm volatile("" : "+s"(kx));
        pg8::Gemm g{(const bf16_t*)(ws + WS_H1B), (const bf16_t*)(ws + WS_WPT), kx, kx, kx}; OrderBatch S; S.so.init(T, 1024, 1024, 1024, G, bx);
        pg8::Unit u0; const bool has = S.next(0, u0);
        LAS float* rsl = (LAS float*)(lds + RING_BYTES + 1024);
        if (has && tid < 256) { const float* sp = (const float*)(ws + WS_SSQH1) + (size_t)(u0.pm * 256 + tid) * 16; float a = 0.f;
#pragma unroll
            for (int j = 0; j < 4; ++j) { const f32x4 v = ((const f32x4*)sp)[j]; a += (v[0] + v[1]) + (v[2] + v[3]); }
            rsl[tid] = 1.0f / sqrtf(a * (1.0f / 1024.0f) + 1e-6f); }
        __syncthreads();
        EpiSoftmax E{(bf16_t*)(ws + WS_P), RING_BYTES + 1024};
        pg8::gemm_phase<EpiSoftmax, OrderBatch, false, true>(lds, g, S, E);
    }
    if (IN(7)) {
        int kx = 1024; asm volatile("" : "+s"(kx));
        pg8::Gemm g{(const bf16_t*)(ws + WS_P), (const bf16_t*)(ws + WS_VWT), kx, kx, kx}; OrderBatch S; S.so.init(T, 1024, 1024, 1024, G, bx);
        EpiResid E{(const float*)(ws + WS_H1), (float*)(ws + WS_H2), (bf16_t*)(ws + WS_H2B), (float*)(ws + WS_SSQH2)};
        pg8::gemm_phase<EpiResid, OrderBatch, true, true>(lds, g, S, E);
    }
    if (IN(8)) {
        typedef float f32x16 __attribute__((ext_vector_type(16)));
        const float* h2 = (const float*)(ws + WS_H2); const float* w_router = args.in[19]; const float* b_router = args.in[20]; const float* ssq2 = (const float*)(ws + WS_SSQH2);
        int* topi = (int*)(ws + WS_ROUTE + RT_TOPI); float* topg = (float*)(ws + WS_ROUTE + RT_TOPG); int* tslot = (int*)(ws + WS_ROUTE + RT_SLOT); int* row_flat = (int*)(ws + WS_ROUTE + RT_ROWFLAT);
        unsigned* gcount = (unsigned*)(ws + WS_CTL) + CW_GCOUNT;
        for (int i = bx * 512 + tid; i < MPADN; i += G * 512) row_flat[i] = -1;
        LAS float* part = (LAS float*)lds;
        LAS float* lgt = (LAS float*)(lds + 32768);
        LAS unsigned* cnt_l = (LAS unsigned*)(lds + 32768 + 64 * 33 * 4);
        for (int ch = bx; ch < T / 64; ch += G) {
            const int tok0 = ch * 64, tb = wave & 1, kq = wave >> 1, kh = lane >> 5, row = tok0 + 32 * tb + (lane & 31);
            if (tid < 32) cnt_l[tid] = 0u;
            f32x16 acc = {};
            const float* ap = h2 + (size_t)row * 1024 + 256 * kq + 4 * kh; const float* gp = g_moe + 256 * kq + 4 * kh; const float* wp = w_router + (size_t)(256 * kq + 4 * kh) * 32 + (lane & 31);
#pragma unroll 4
            for (int j = 0; j < 32; ++j) {
                const f32x4 a4 = *(const f32x4*)(ap + 8 * j), g4 = *(const f32x4*)(gp + 8 * j);
#pragma unroll
                for (int e = 0; e < 4; ++e) acc = __builtin_amdgcn_mfma_f32_32x32x2f32(a4[e] * g4[e], wp[(size_t)(8 * j + e) * 32], acc, 0, 0, 0);
            }
#pragma unroll
            for (int r = 0; r < 16; ++r) part[((kq * 64) + tb * 32 + (r & 3) + 8 * (r >> 2) + 4 * kh) * 32 + (lane & 31)] = acc[r];
            __syncthreads();
            {
                const int tk = tid >> 3, e0 = (tid & 7) * 4; const float* sp = ssq2 + (size_t)(tok0 + tk) * 16; float a = 0.f;
#pragma unroll
                for (int j = 0; j < 4; ++j) { const f32x4 v = ((const f32x4*)sp)[j]; a += (v[0] + v[1]) + (v[2] + v[3]); }
                const float rs = 1.0f / sqrtf(a * (1.0f / 1024.0f) + 1e-6f);
#pragma unroll
                for (int e = 0; e < 4; ++e) lgt[tk * 33 + e0 + e] = rs * ((part[(0 * 64 + tk) * 32 + e0 + e] + part[(1 * 64 + tk) * 32 + e0 + e]) + (part[(2 * 64 + tk) * 32 + e0 + e] + part[(3 * 64 + tk) * 32 + e0 + e])) + b_router[e0 + e];
            }
            __syncthreads();
            int c0 = -1, c1 = -1, c2 = -1, c3 = -1; float v0 = 0.f, v1 = 0.f, v2 = 0.f, v3 = 0.f; unsigned s0 = 0, s1 = 0, s2 = 0, s3 = 0;
            if (tid < 64) {
                for (int k = 0; k < 4; ++k) {
                    float best = -3.0e38f; int bi = 0;
                    for (int e = 0; e < 32; ++e) { const float v = lgt[tid * 33 + e]; if (e == c0 || e == c1 || e == c2 || e == c3) continue; if (v > best) { best = v; bi = e; } }
                    if (k == 0) { c0 = bi; v0 = best; } else if (k == 1) { c1 = bi; v1 = best; } else if (k == 2) { c2 = bi; v2 = best; } else { c3 = bi; v3 = best; }
                }
                s0 = atomicAdd((unsigned*)&cnt_l[c0], 1u); s1 = atomicAdd((unsigned*)&cnt_l[c1], 1u); s2 = atomicAdd((unsigned*)&cnt_l[c2], 1u); s3 = atomicAdd((unsigned*)&cnt_l[c3], 1u);
            }
            __syncthreads();
            if (tid < 32) cnt_l[32 + tid] = __hip_atomic_fetch_add(gcount + tid, cnt_l[tid], __ATOMIC_RELAXED, __HIP_MEMORY_SCOPE_AGENT);
            __syncthreads();
            if (tid < 64) {
                const int t = tok0 + tid;
                const float e1 = __expf(v1 - v0), e2 = __expf(v2 - v0), e3 = __expf(v3 - v0), inv = 1.0f / (1.0f + e1 + e2 + e3);
                *(int4*)(topi + t * 4) = make_int4(c0, c1, c2, c3);
                *(f32x4*)(topg + t * 4) = (f32x4){inv, e1 * inv, e2 * inv, e3 * inv};
                *(int4*)(tslot + t * 4) = make_int4((int)(cnt_l[32 + c0] + s0), (int)(cnt_l[32 + c1] + s1), (int)(cnt_l[32 + c2] + s2), (int)(cnt_l[32 + c3] + s3));
            }
            __syncthreads();
        }
    }
    if (IN(9)) {
        const unsigned* gcount = (const unsigned*)(ws + WS_CTL) + CW_GCOUNT; const int* topi = (const int*)(ws + WS_ROUTE + RT_TOPI); const int* tslot = (const int*)(ws + WS_ROUTE + RT_SLOT);
        int* row_flat = (int*)(ws + WS_ROUTE + RT_ROWFLAT); float* rs_row = (float*)(ws + WS_ROUTE + RT_RSROW); const float* ssq2 = (const float*)(ws + WS_SSQH2);
        const bf16_t* h2b = (const bf16_t*)(ws + WS_H2B); bf16_t* Xs = (bf16_t*)(ws + WS_XS);
        LAS int* ps = (LAS int*)lds;
        if (tid == 0) { int run = 0; for (int e = 0; e < NE; ++e) { ps[e] = run; run += (int)((gcount[e] + 255u) >> 8) << 8; } }
        __syncthreads();
        const int gw = vcu * NWAVES + wave, NGW = G * NWAVES;
        for (int a = gw; a < NA; a += NGW) {
            const int t = a >> 2, e = topi[a], row = ps[e] + tslot[a];
            const v4u* src = (const v4u*)(h2b + (size_t)t * 1024); v4u* dst = (v4u*)(Xs + (size_t)row * 1024);
            dst[lane] = src[lane]; dst[64 + lane] = src[64 + lane];
            if (lane < 16) { float v = ssq2[(size_t)t * 16 + lane]; v += __shfl_xor(v, 1); v += __shfl_xor(v, 2); v += __shfl_xor(v, 4); v += __shfl_xor(v, 8);
                if (lane == 0) { row_flat[row] = a; rs_row[row] = 1.0f / sqrtf(v * (1.0f / 1024.0f) + 1e-6f); } }
        }
    }
    if (IN(10) || IN(11)) {
        const unsigned* gcount = (const unsigned*)(ws + WS_CTL) + CW_GCOUNT; LAS int* texp = (LAS int*)(lds + LX_TEXP);
        __syncthreads();
        if (tid == 0) { int nt = 0; for (int e = 0; e < NE; ++e) { const int n = (int)((gcount[e] + 255u) >> 8); for (int j = 0; j < n; ++j) texp[nt + j] = e; nt += n; } texp[NTILEN] = nt; }
        __syncthreads();
    }
    if (IN(10)) {
        int kx = 1024; asm volatile("" : "+s"(kx));
        pg8::Gemm g{(const bf16_t*)(ws + WS_XS), WguT, kx, kx, kx}; OrderMoe S{(const LAS int*)(lds + LX_TEXP), 8, bx, G, (size_t)2048 * 1024 * 2};
        EpiSwiGLU E{(const float*)(ws + WS_ROUTE + RT_RSROW), args.in[22], (bf16_t*)(ws + WS_HMID), (const LAS int*)(lds + LX_TEXP)};
        pg8::gemm_phase<EpiSwiGLU, OrderMoe, true, true>(lds, g, S, E);
    }
    if (IN(11)) {
        int kx = 1024; asm volatile("" : "+s"(kx));
        pg8::Gemm g{(const bf16_t*)(ws + WS_HMID), WdT, kx, kx, kx}; OrderMoe S{(const LAS int*)(lds + LX_TEXP), 4, bx, G, (size_t)1024 * 1024 * 2};
        EpiDown E{(const int*)(ws + WS_ROUTE + RT_ROWFLAT), (const float*)(ws + WS_ROUTE + RT_TOPG), args.in[24], (bf16_t*)(ws + WS_YBUF), (const LAS int*)(lds + LX_TEXP)};
        pg8::gemm_phase<EpiDown, OrderMoe, true, true>(lds, g, S, E);
    }
    if (IN(12)) {
        const float* h2 = (const float*)(ws + WS_H2); const bf16_t* ybuf = (const bf16_t*)(ws + WS_YBUF); const float* g_final = args.in[25]; float* outp = args.out;
        const int gw = vcu * NWAVES + wave, NGW = G * NWAVES;
        for (int t = gw; t < T; t += NGW) {
            f32x4 v[4]; float ss = 0.f;
#pragma unroll
            for (int j = 0; j < 4; ++j) {
                f32x4 a = *(const f32x4*)(h2 + (size_t)t * 1024 + 256 * j + 4 * lane);
#pragma unroll
                for (int k = 0; k < 4; ++k) { const v2u y = *(const v2u*)(ybuf + ((size_t)t * 4 + k) * 1024 + 256 * j + 4 * lane);
                    a[0] += __builtin_bit_cast(float, y.x << 16); a[1] += __builtin_bit_cast(float, y.x & 0xffff0000u); a[2] += __builtin_bit_cast(float, y.y << 16); a[3] += __builtin_bit_cast(float, y.y & 0xffff0000u); }
                v[j] = a; ss += (a[0] * a[0] + a[1] * a[1]) + (a[2] * a[2] + a[3] * a[3]);
            }
            ss = wave_sum(ss); const float rs = 1.0f / sqrtf(ss * (1.0f / 1024.0f) + 1e-6f);
#pragma unroll
            for (int j = 0; j < 4; ++j) *(f32x4*)(outp + (size_t)t * 1024 + 256 * j + 4 * lane) = v[j] * rs * *(const f32x4*)(g_final + 256 * j + 4 * lane);
        }
    }
#undef IN
}

__global__ void k_glue_z(const unsigned char* ws, float* z) {
    const size_t i = (size_t)blockIdx.x * 256 + threadIdx.x;
    if (i >= (size_t)T * INW) return;
    const int t = (int)(i / INW), c = (int)(i % INW);
    float v;
    if (c < 1536) { v = bf2f(((const bf16_t*)(ws + WS_QKVA))[(size_t)t * 1536 + c]); if (c < 512) v *= 8.0f; }
    else if (c < 1792) v = bf2f(((const bf16_t*)(ws + WS_ZQ))[(size_t)t * 256 + c - 1536]);
    else if (c < 1920) v = bf2f(((const bf16_t*)(ws + WS_ZKV))[(size_t)t * 128 + c - 1792]);
    else v = ((const float*)(ws + WS_ZKPE))[(size_t)t * 32 + c - 1920];
    z[i] = v;
}
__global__ void k_glue_bf16(const bf16_t* src, int lds_, float* dst, int ldd, int cols, size_t n) {
    const size_t i = (size_t)blockIdx.x * 256 + threadIdx.x;
    if (i >= n) return;
    const size_t r = i / cols; const int c = (int)(i % cols);
    dst[r * ldd + c] = bf2f(src[r * lds_ + c]);
}
__global__ void k_glue_kv(const unsigned char* ws, float* kvb) {
    const size_t i = (size_t)blockIdx.x * 256 + threadIdx.x;
    if (i >= (size_t)T * 1024) return;
    const int t = (int)(i >> 10), c = (int)(i & 1023), h = c >> 7, w = c & 127;
    kvb[i] = w < 64 ? bf2f(((const bf16_t*)(ws + WS_KN))[(size_t)t * 512 + h * 64 + w]) : bf2f(((const bf16_t*)(ws + WS_VB))[(size_t)t * 512 + h * 64 + w - 64]);
}
}
void gemm(hipStream_t st, const float* A, int lda, const float* W, int ldw, float* C, int ldc, int M, int N, int K,
          const float* bias = nullptr, const float* R = nullptr) {
    GemmArgs a; memset(&a, 0, sizeof(a)); a.A = A; a.lda = lda; a.W = W; a.ldw = ldw; a.bias = bias; a.R = R; a.C = C; a.ldc = ldc; a.M = M; a.N = N; a.K = K; a.mode = 0;
    hipLaunchKernelGGL(k_sgemm<0>, dim3((N + 63) / 64, M / 64), dim3(256), 0, st, a);
}
void launch_mk(hipStream_t st, const mk::Args& base, int lo, int hi, int grid) {
    mk::Args a = base; a.ph_lo = lo; a.ph_hi = hi;
    hipLaunchKernelGGL(mk::mk_fwd, dim3(grid), dim3(mk::NWAVES * 64), mk::LDS_BYTES, st, a);
}
}

extern "C" void kernel_launch(void* const* d_in, const int* in_sizes, int n_in, void* d_out, int out_size, void* d_ws, size_t ws_size, hipStream_t stream) {
    static int grid = 0;
    if (grid == 0) {
        int dev = 0, cus = 0;
        if (hipGetDevice(&dev) != hipSuccess || hipDeviceGetAttribute(&cus, hipDeviceAttributeMultiprocessorCount, dev) != hipSuccess) { grid = -1; return; }
        if (hipFuncSetAttribute((const void*)mk::mk_fwd, hipFuncAttributeMaxDynamicSharedMemorySize, mk::LDS_BYTES) != hipSuccess) { grid = -1; return; }
        grid = cus;
    }
    if (grid < 0) return;
    const float* x = (const float*)d_in[0];
    const float* mem = (const float*)d_in[1];
    const int* pos = (const int*)d_in[2];
    const float* g_q_a = (const float*)d_in[5];
    const float* w_q_b = (const float*)d_in[6];
    const float* g_kv_a = (const float*)d_in[7];
    const float* w_kv_b = (const float*)d_in[8];
    const float* rel_bias = (const float*)d_in[9];
    const float* g_out_a = (const float*)d_in[10];
    const float* g_out_b = (const float*)d_in[11];
    const float* w_o = (const float*)d_in[12];
    const float* g_xattn = (const float*)d_in[13];
    const float* g_mem = (const float*)d_in[14];
    const float* w_mq = (const float*)d_in[15];
    const float* w_mkv = (const float*)d_in[16];
    const float* w_mo = (const float*)d_in[17];
    const float* g_moe = (const float*)d_in[18];
    const float* w_router = (const float*)d_in[19];
    const float* b_router = (const float*)d_in[20];
    const float* w_gate_up = (const float*)d_in[21];
    const float* b_gate_up = (const float*)d_in[22];
    const float* w_down = (const float*)d_in[23];
    const float* b_down = (const float*)d_in[24];
    const float* g_final = (const float*)d_in[25];
    float* out = (float*)d_out;
    (void)ws_size; (void)in_sizes; (void)n_in; (void)out_size;

    (void)hipMemsetAsync((char*)d_ws + mk::WS_CTL, 0, mk::CTL_ZERO_BYTES, stream);
    mk::Args ma; memset(&ma, 0, sizeof(ma));
    for (int i = 0; i < 26; ++i) ma.in[i] = (const float*)d_in[i];
    ma.out = out; ma.ws = (unsigned char*)d_ws; ma.flags = 1;
    for (int j = 0; j < 16; ++j) ma.rope_rev[j] = pow(10000.0, -(double)j / 16.0) / 6.283185307179586476925287;
    launch_mk(stream, ma, 0, 1, grid);
    launch_mk(stream, ma, 1, 2, grid);
    launch_mk(stream, ma, 2, 3, grid);

    launch_mk(stream, ma, 3, 4, grid);
    launch_mk(stream, ma, 4, 5, grid);
    launch_mk(stream, ma, 5, 6, grid);
    launch_mk(stream, ma, 6, 7, grid);
    launch_mk(stream, ma, 7, 8, grid);
    for (int p = 8; p < 13; ++p) launch_mk(stream, ma, p, p + 1, grid);
}
```

```cpp
#include <hip/hip_runtime.h>
#include <stdint.h>
#include <string.h>
#include <math.h>

namespace {
constexpr int NB = 4, S = 4096, D = 1024, T = NB * S, NMEM = 256, INW = 1952;
constexpr int NE = 32, TOPK = 4, NA = T * TOPK;

namespace pg8 {
#define PG8_LAS __attribute__((address_space(3)))
typedef unsigned short bf16_t;
typedef short bf16x8 __attribute__((ext_vector_type(8)));
typedef float f32x4 __attribute__((ext_vector_type(4)));
typedef unsigned u32x4 __attribute__((ext_vector_type(4)));
constexpr int BM = 256, BK = 64, HALF = 128, HTB = HALF * BK * 2  , STAGE_BYTES = 8 * HTB, NXCD = 8, WGM = 8;

__host__ __device__ __forceinline__ int lds_byte(int r, int c) { const int st = (r >> 4) * 2 + (c >> 5), rr = r & 15, cc = c & 31, ob = rr * 64 + cc * 2; return st * 1024 + (ob ^ (((ob >> 9) & 1) << 5)); }
__host__ __device__ __forceinline__ void stage_rc(int b, int& R, int& C) { const int st = b / 1024, sb = b % 1024, swz = sb ^ (((sb >> 9) & 1) << 5); R = (st >> 1) * 16 + swz / 64; C = (st & 1) * 32 + (swz % 64) / 2; }
__host__ __device__ __forceinline__ int perm32(int rho) { const int n = rho >> 4, i = rho & 15; return 8 * (i >> 2) + 4 * n + (i & 3); }

struct Unit { int pm, pn; size_t aoff, boff; };
struct Gemm { const bf16_t* A; const bf16_t* Bt; int lda, ldb, K; };

struct StaticOrder {
    int nM, nN, nwg, G, c; size_t ta, tb;
    __host__ __device__ __forceinline__ void init(int M, int N, int lda, int ldb, int G_, int c_) { nM = M / BM; nN = N / BM; nwg = nM * nN; G = G_; c = c_; ta = (size_t)BM * lda * 2; tb = (size_t)BM * ldb * 2; }
    __host__ __device__ __forceinline__ bool next(int i, Unit& u) const {
        const long L = (long)i * G + c; if (L >= nwg) return false;
        int wgid = (int)L; { const int q = nwg / NXCD, r = nwg % NXCD, xcd = wgid % NXCD, off = wgid / NXCD; wgid = (xcd < r ? xcd * (q + 1) : r * (q + 1) + (xcd - r) * q) + off; }
        const int nig = WGM * nN, gid = wgid / nig, fm = gid * WGM, gsz = (nM - fm) < WGM ? (nM - fm) : WGM;
        u.pm = fm + ((wgid % nig) % gsz); u.pn = (wgid % nig) / gsz; u.aoff = (size_t)u.pm * ta; u.boff = (size_t)u.pn * tb; return true;
    }
    __device__ __forceinline__ void a_ready(const Unit&) const {}
    __device__ __forceinline__ void done(const Unit&) const {}
};

__device__ __forceinline__ unsigned cvt_pk_bf16(float lo, float hi) { unsigned r; asm volatile("v_cvt_pk_bf16_f32 %0, %1, %2" : "=v"(r) : "v"(lo), "v"(hi)); return r; }
typedef float f32x2 __attribute__((ext_vector_type(2)));

constexpr int GTAB = 135168 + 4096, GTAB_UNITS = 10;
template <class Epi, class Sched, bool ALIGN_EPI = false, bool SP2 = false, bool GATHER = false>
__device__ __forceinline__ void gemm_phase(PG8_LAS unsigned char* lds, const Gemm g, const Sched& S, const Epi& E) {
    const int tid = threadIdx.x, wid = __builtin_amdgcn_readfirstlane(tid >> 6), lane = tid & 63, wr = wid >> 2, wc = wid & 3, fr = lane & 15, fq = lane >> 4;
    static_assert(!GATHER || SP2, "GATHER is implemented for the SP2 loop only");
    const int K = g.K, nt = K / BK;
    unsigned voffA[2], voffB[2];
#pragma unroll
    for (int i = 0; i < 2; ++i) { int R, C; stage_rc(tid * 16 + i * 8192, R, C); const int Rb = Epi::PERM ? ((R & ~31) + perm32(R & 31)) : R;
        voffA[i] = (unsigned)(R * g.lda + C) * 2u; voffB[i] = (unsigned)(Rb * g.ldb + C) * 2u; }
    unsigned gidx[2], gcol[2];
#pragma unroll
    for (int i = 0; i < 2; ++i) { int R, C; stage_rc(tid * 16 + i * 8192, R, C); gidx[i] = (unsigned)R * 2u; gcol[i] = (unsigned)C * 2u; }
    const size_t kstep = (size_t)(BK * 2);
    const size_t hstepA = (size_t)HALF * g.lda * 2, hstepB = (size_t)HALF * g.ldb * 2;
    const unsigned ldsw = (unsigned)wid * 1024u;
    const int aoff = lds_byte(wr * 64 + fr, fq * 8), boff = lds_byte(wc * 32 + fr, fq * 8);
#define PG8_SA(b, h) (((b) * 2 + (h)) * HTB)
#define PG8_SB(b, h) ((4 + (b) * 2 + (h)) * HTB)
#define PG8_STAGE(bufoff, gbase, voff) do { _Pragma("unroll") for (int _i = 0; _i < 2; ++_i) \
        __builtin_amdgcn_global_load_lds((const unsigned*)((const char*)(gbase) + (voff)[_i]), (PG8_LAS unsigned*)(lds + (bufoff) + ldsw + _i * 8192), 16, 0, 0); } while (0)
#define PG8_GTOK(h, sel) do { if constexpr (GATHER) { tk0 = *(const PG8_LAS unsigned short*)(lds + GTAB + (sel) * 512 + (h) * 256 + gidx[0]); tk1 = *(const PG8_LAS unsigned short*)(lds + GTAB + (sel) * 512 + (h) * 256 + gidx[1]); } } while (0)
#define PG8_STAGE_A(bufoff, gbase, h, sel) do { if constexpr (GATHER) { \
        __builtin_amdgcn_global_load_lds((const unsigned*)((const char*)(gbase) + (size_t)tk0 * (size_t)(g.lda * 2) + gcol[0]), (PG8_LAS unsigned*)(lds + (bufoff) + ldsw), 16, 0, 0); \
        __builtin_amdgcn_global_load_lds((const unsigned*)((const char*)(gbase) + (size_t)tk1 * (size_t)(g.lda * 2) + gcol[1]), (PG8_LAS unsigned*)(lds + (bufoff) + ldsw + 8192), 16, 0, 0); } \
    else { PG8_STAGE(bufoff, (gbase) + (h) * hstepA, voffA); } } while (0)
#define PG8_LDA(dst, b, h) do { _Pragma("unroll") for (int m = 0; m < 4; ++m) _Pragma("unroll") for (int k = 0; k < 2; ++k) dst[m][k] = *(const PG8_LAS bf16x8*)(lds + PG8_SA(b, h) + aoff + m * 2048 + k * 1024); } while (0)
#define PG8_LDB(dst, b, h) do { _Pragma("unroll") for (int n = 0; n < 2; ++n) _Pragma("unroll") for (int k = 0; k < 2; ++k) dst[n][k] = *(const PG8_LAS bf16x8*)(lds + PG8_SB(b, h) + boff + n * 2048 + k * 1024); } while (0)
#define PG8_MMA(ai, bj, At, Bt) do { __builtin_amdgcn_s_setprio(1); _Pragma("unroll") for (int m = 0; m < 4; ++m) _Pragma("unroll") for (int n = 0; n < 2; ++n) _Pragma("unroll") for (int k = 0; k < 2; ++k) \
        acc[ai][bj][m][n] = __builtin_amdgcn_mfma_f32_16x16x32_bf16(Bt[n][k], At[m][k], acc[ai][bj][m][n], 0, 0, 0); __builtin_amdgcn_s_setprio(0); } while (0)
#define PG8_WAIT_V(n) asm volatile("s_waitcnt vmcnt(" #n ")" ::: "memory")
#define PG8_WAIT_L(n) asm volatile("s_waitcnt lgkmcnt(" #n ")" ::: "memory")
#define PG8_BAR __builtin_amdgcn_s_barrier()
#define PG8_SCHED __builtin_amdgcn_sched_barrier(0)
    Unit cur, nxt; int ui = 0; unsigned tk0 = 0, tk1 = 0; (void)tk0; (void)tk1;
    if (!S.next(0, cur)) return;
    f32x4 acc[2][2][4][2];
#pragma unroll
    for (int a = 0; a < 2; ++a)
#pragma unroll
        for (int b = 0; b < 2; ++b)
#pragma unroll
            for (int m = 0; m < 4; ++m)
#pragma unroll
                for (int n = 0; n < 2; ++n) acc[a][b][m][n] = (f32x4){0.f, 0.f, 0.f, 0.f};
    bf16x8 At[4][2], B0[2][2], B1[2][2];
    const char* cA = (const char*)g.A + (GATHER ? (size_t)0 : cur.aoff); const char* cB = (const char*)g.Bt + cur.boff;
    S.a_ready(cur);
    if constexpr (SP2) {
        PG8_STAGE(PG8_SB(0, 0), cB, voffB); PG8_STAGE(PG8_SB(0, 1), cB + hstepB, voffB); PG8_GTOK(0, ui); PG8_STAGE_A(PG8_SA(0, 0), cA, 0, ui); PG8_GTOK(1, ui); PG8_STAGE_A(PG8_SA(0, 1), cA, 1, ui);
        if (wr == 1) PG8_BAR;
        PG8_WAIT_V(2); PG8_BAR;
        PG8_STAGE(PG8_SB(1, 0), cB + kstep, voffB); PG8_GTOK(0, ui); PG8_STAGE_A(PG8_SA(1, 0), cA + kstep, 0, ui); PG8_STAGE(PG8_SB(1, 1), cB + hstepB + kstep, voffB);
        PG8_WAIT_V(6); PG8_BAR;
    } else {
        PG8_STAGE(PG8_SB(0, 0), cB, voffB); PG8_STAGE_A(PG8_SA(0, 0), cA, 0, ui); PG8_STAGE(PG8_SB(0, 1), cB + hstepB, voffB); PG8_STAGE_A(PG8_SA(0, 1), cA, 1, ui);
        if (wr == 1) PG8_BAR;
        PG8_WAIT_V(4); PG8_BAR;
        PG8_STAGE(PG8_SB(1, 0), cB + kstep, voffB); PG8_STAGE_A(PG8_SA(1, 0), cA + kstep, 0, ui); PG8_STAGE(PG8_SB(1, 1), cB + hstepB + kstep, voffB);
        PG8_WAIT_V(6); PG8_BAR;
    }
    for (;;) {
        const bool has_next = S.next(ui + 1, nxt);
        const char* nA = has_next ? (const char*)g.A + (GATHER ? (size_t)0 : nxt.aoff) : cA; const char* nB = has_next ? (const char*)g.Bt + nxt.boff : cB;
        for (int t = 0; t < nt; t += 2) {
            const bool last = (t == nt - 2);
            const char* a1 = cA + (size_t)(t + 1) * kstep;
            const char* a2 = last ? nA : cA + (size_t)(t + 2) * kstep; const char* b2 = last ? nB : cB + (size_t)(t + 2) * kstep;
            const char* a3 = a2 + kstep; const char* b3 = b2 + kstep; const int ui2 = (last && has_next) ? ui + 1 : ui; (void)ui2;
            if (last && has_next) S.a_ready(nxt);
            if constexpr (SP2) {
            PG8_GTOK(1, ui); PG8_LDB(B0, 0, 0); PG8_LDB(B1, 0, 1); PG8_SCHED; PG8_LDA(At, 0, 0); PG8_STAGE_A(PG8_SA(1, 1), a1, 1, ui);
            PG8_WAIT_V(8); PG8_WAIT_L(0); PG8_BAR; PG8_MMA(0, 0, At, B0); PG8_MMA(0, 1, At, B1); PG8_BAR; PG8_SCHED;
            PG8_GTOK(0, ui2); PG8_LDA(At, 0, 1); PG8_STAGE(PG8_SB(0, 0), b2, voffB); PG8_STAGE(PG8_SB(0, 1), b2 + hstepB, voffB); PG8_STAGE_A(PG8_SA(0, 0), a2, 0, ui2);
            PG8_WAIT_V(8); PG8_WAIT_L(0); PG8_BAR; PG8_MMA(1, 0, At, B0); PG8_MMA(1, 1, At, B1); PG8_BAR; PG8_SCHED;
            PG8_GTOK(1, ui2); PG8_LDB(B0, 1, 0); PG8_LDB(B1, 1, 1); PG8_SCHED; PG8_LDA(At, 1, 0); PG8_STAGE_A(PG8_SA(0, 1), a2, 1, ui2);
            PG8_WAIT_V(8); PG8_WAIT_L(0); PG8_BAR; PG8_MMA(0, 0, At, B0); PG8_MMA(0, 1, At, B1); PG8_BAR; PG8_SCHED;
            PG8_GTOK(0, ui2); PG8_LDA(At, 1, 1); PG8_STAGE(PG8_SB(1, 0), b3, voffB); PG8_STAGE(PG8_SB(1, 1), b3 + hstepB, voffB); PG8_STAGE_A(PG8_SA(1, 0), a3, 0, ui2);
            PG8_WAIT_V(8); PG8_WAIT_L(0); PG8_BAR; PG8_MMA(1, 0, At, B0); PG8_MMA(1, 1, At, B1); PG8_BAR; PG8_SCHED;
            } else {
            PG8_LDB(B0, 0, 0); PG8_SCHED; PG8_LDA(At, 0, 0); PG8_STAGE_A(PG8_SA(1, 1), a1, 1, ui);
            PG8_WAIT_L(8); PG8_BAR; PG8_WAIT_L(0); PG8_MMA(0, 0, At, B0); PG8_BAR; PG8_SCHED;
            PG8_LDB(B1, 0, 1); PG8_STAGE(PG8_SB(0, 0), b2, voffB);
            PG8_BAR; PG8_WAIT_L(0); PG8_MMA(0, 1, At, B1); PG8_BAR;
            PG8_LDA(At, 0, 1); PG8_STAGE_A(PG8_SA(0, 0), a2, 0, ui2);
            PG8_BAR; PG8_WAIT_L(0); PG8_MMA(1, 0, At, B0); PG8_BAR; PG8_SCHED;
            PG8_STAGE(PG8_SB(0, 1), b2 + hstepB, voffB);
            PG8_WAIT_V(6); PG8_BAR; PG8_MMA(1, 1, At, B1); PG8_BAR;
            PG8_LDB(B0, 1, 0); PG8_SCHED; PG8_LDA(At, 1, 0); PG8_STAGE_A(PG8_SA(0, 1), a2, 1, ui2);
            PG8_WAIT_L(8); PG8_BAR; PG8_WAIT_L(0); PG8_MMA(0, 0, At, B0); PG8_BAR; PG8_SCHED;
            PG8_LDB(B1, 1, 1); PG8_STAGE(PG8_SB(1, 0), b3, voffB);
            PG8_BAR; PG8_WAIT_L(0); PG8_MMA(0, 1, At, B1); PG8_BAR;
            PG8_LDA(At, 1, 1); PG8_STAGE_A(PG8_SA(1, 0), a3, 0, ui2);
            PG8_BAR; PG8_WAIT_L(0); PG8_MMA(1, 0, At, B0); PG8_BAR; PG8_SCHED;
            PG8_STAGE(PG8_SB(1, 1), b3 + hstepB, voffB);
            PG8_WAIT_V(6); PG8_BAR; PG8_MMA(1, 1, At, B1); PG8_BAR;
            }
        }
        if constexpr (ALIGN_EPI) { if (wr == 0) PG8_BAR; }
        if constexpr (!Epi::AFTER_DRAIN) { E(acc, cur, wr, wc, fr, fq); S.done(cur); }
        if (!has_next) break;
#pragma unroll
        for (int a = 0; a < 2; ++a)
#pragma unroll
            for (int b = 0; b < 2; ++b)
#pragma unroll
                for (int m = 0; m < 4; ++m)
#pragma unroll
                    for (int n = 0; n < 2; ++n) acc[a][b][m][n] = (f32x4){0.f, 0.f, 0.f, 0.f};
        cur = nxt; cA = nA; cB = nB; ++ui;
        if constexpr (ALIGN_EPI) { if (wr == 1) PG8_BAR; }
    }
    PG8_WAIT_V(0);
    if constexpr (!ALIGN_EPI) { if (wr == 0) PG8_BAR; }
    PG8_BAR;
    if constexpr (Epi::AFTER_DRAIN) { E.fused(acc, cur, wr, wc, fr, fq, lds, wid, lane); S.done(cur); }
#undef PG8_SA
#undef PG8_SB
#undef PG8_STAGE
#undef PG8_STAGE_A
#undef PG8_GTOK
#undef PG8_LDA
#undef PG8_LDB
#undef PG8_MMA
#undef PG8_WAIT_V
#undef PG8_WAIT_L
#undef PG8_BAR
#undef PG8_SCHED
}
}
namespace mla {
using bf16x8 = __attribute__((ext_vector_type(8))) short;
using s16x4  = __attribute__((ext_vector_type(4))) short;
using f32x16 = __attribute__((ext_vector_type(16))) float;
using u32x4  = __attribute__((ext_vector_type(4))) unsigned;
constexpr int NW = 8, QBLK = 32, KVBLK = 64;
constexpr float SCALE = 0.10206207261596577f;
constexpr float THR = 8.f;
constexpr int SHM_V = KVBLK * 64 * 2, SHM_K = KVBLK * 256;
constexpr int SHM_ATTN = 4 * SHM_V + 4 * SHM_K + NW * 64 * 4;
#define KSWZ(row, colB) ((row) * 256 + ((colB) ^ (((row) & 7) << 4)))
#define SBAR() __builtin_amdgcn_sched_barrier(0)
__device__ __forceinline__ int crow(int r, int hi) { return (r & 3) + 8 * (r >> 2) + 4 * hi; }
__device__ __forceinline__ unsigned cvtpk(float lo, float hi) { unsigned r; asm volatile("v_cvt_pk_bf16_f32 %0, %1, %2" : "=v"(r) : "v"(lo), "v"(hi)); return r; }

__device__ __forceinline__ float max3f(float a, float b, float c) { return __builtin_fmaxf(__builtin_fmaxf(a, b), c); }
template <int ABL> __device__ __forceinline__ void partialSM(f32x16& p0, f32x16& p1, float& m_reg, float& alpha, bool first) {
  float a = max3f(p0[0], p0[1], p0[2]), b = max3f(p0[3], p1[0], p1[1]), c = max3f(p1[2], p1[3], p0[4]), d = max3f(p0[5], p0[6], p0[7]);
  a = max3f(a, p1[4], p1[5]); b = max3f(b, p1[6], p1[7]);
#pragma unroll
  for (int r = 8; r < 16; r += 4) { a = max3f(a, p0[r], p0[r + 1]); b = max3f(b, p0[r + 2], p0[r + 3]); c = max3f(c, p1[r], p1[r + 1]); d = max3f(d, p1[r + 2], p1[r + 3]); }
  float pmax = fmaxf(fmaxf(a, b), fmaxf(c, d));
  { auto rr = __builtin_amdgcn_permlane32_swap(__float_as_uint(pmax), __float_as_uint(pmax), false, false);
    pmax = fmaxf(__uint_as_float(rr[0]), __uint_as_float(rr[1])); }
  if (__builtin_expect(!first && __all(pmax - m_reg <= THR * 1.4426950408889634f), 1)) { alpha = 1.f; }
  else { const float mn = first ? pmax : fmaxf(m_reg, pmax); alpha = first ? 1.f : __builtin_amdgcn_exp2f(m_reg - mn); m_reg = mn; }
#pragma unroll
  for (int r = 0; r < 16; ++r) { p0[r] -= m_reg; p1[r] -= m_reg; }
#pragma unroll
  for (int r = 0; r < 16; ++r) p0[r] = (ABL & 2) ? p0[r] * 0.5f : __builtin_amdgcn_exp2f(p0[r]);
}
template <int ABL> __device__ __forceinline__ void finishSM(f32x16& p0, f32x16& p1, float alpha, float& l_reg, bf16x8& pa0, bf16x8& pa1, bf16x8& pa2, bf16x8& pa3) {
#pragma unroll
  for (int r = 0; r < 16; ++r) p1[r] = (ABL & 2) ? p1[r] * 0.5f : __builtin_amdgcn_exp2f(p1[r]);
  float ps, s0 = 0.f, s1 = 0.f, s2 = 0.f, s3 = 0.f;
#pragma unroll
  for (int r = 0; r < 16; r += 4) { s0 += p0[r]; s1 += p0[r + 1]; s2 += p0[r + 2]; s3 += p0[r + 3]; }
#pragma unroll
  for (int r = 0; r < 16; r += 4) { s0 += p1[r]; s1 += p1[r + 1]; s2 += p1[r + 2]; s3 += p1[r + 3]; }
  ps = (s0 + s1) + (s2 + s3);
  { auto rr = __builtin_amdgcn_permlane32_swap(__float_as_uint(ps), __float_as_uint(ps), false, false);
    ps = __uint_as_float(rr[0]) + __uint_as_float(rr[1]); }
  l_reg = l_reg * alpha + ps;
#define PK4(P, BASE, OUT) do { unsigned a0 = cvtpk(P[BASE + 0], P[BASE + 1]), a1 = cvtpk(P[BASE + 2], P[BASE + 3]);   \
    unsigned b0 = cvtpk(P[BASE + 4], P[BASE + 5]), b1 = cvtpk(P[BASE + 6], P[BASE + 7]);                              \
    auto r0 = __builtin_amdgcn_permlane32_swap(a0, b0, false, false); auto r1 = __builtin_amdgcn_permlane32_swap(a1, b1, false, false); \
    u32x4 w = {r0[0], r1[0], r0[1], r1[1]}; OUT = *reinterpret_cast<bf16x8*>(&w); } while (0)
  PK4(p0, 0, pa0); PK4(p0, 8, pa1); PK4(p1, 0, pa2); PK4(p1, 8, pa3);
#undef PK4
}
__device__ __forceinline__ void qkt(f32x16& p0, f32x16& p1, const char* Ks, const bf16x8* qr, int r32, int hi) {
  p0 = f32x16{}; p1 = f32x16{};
#pragma unroll
  for (int d0 = 0; d0 < 6; ++d0) { int cb = (d0 * 16 + hi * 8) * 2;
    bf16x8 b0 = *reinterpret_cast<const bf16x8*>(Ks + KSWZ(r32, cb));
    bf16x8 b1 = *reinterpret_cast<const bf16x8*>(Ks + KSWZ(32 + r32, cb));
    p0 = __builtin_amdgcn_mfma_f32_32x32x16_bf16(b0, qr[d0], p0, 0, 0, 0);
    p1 = __builtin_amdgcn_mfma_f32_32x32x16_bf16(b1, qr[d0], p1, 0, 0, 0); }
}
__device__ __forceinline__ int v_st(int k, int c) { const int kk = (k & ~0xC) | ((k & 4) << 1) | ((k & 8) >> 1); return ((kk >> 3) * 2 + (c >> 5)) * 512 + ((kk & 7) * 32 + (c & 31)) * 2; }
__device__ __forceinline__ int v_rd_base(int lane) { return ((lane & 3) << 3) | (((lane >> 2) & 3) << 6) | (((lane >> 4) & 1) << 5) | (((lane >> 5) & 1) << 8); }
constexpr int v_rd_off(int d0, int ks, int half) { return d0 * 512 + ks * 2048 + half * 1024; }
template <int OFF> __device__ __forceinline__ s16x4 tr_read(int vb) {
  s16x4 r; asm volatile("ds_read_b64_tr_b16 %0, %1 offset:%2" : "=&v"(r) : "v"(vb), "i"(OFF) : "memory"); return r;
}
#define PK(L, H) (bf16x8){L[0], L[1], L[2], L[3], H[0], H[1], H[2], H[3]}
#define PV_RD(KS, LA, HA, LB, HB) do { LA = tr_read<v_rd_off(0, KS, 0)>(vb); HA = tr_read<v_rd_off(0, KS, 1)>(vb); LB = tr_read<v_rd_off(1, KS, 0)>(vb); HB = tr_read<v_rd_off(1, KS, 1)>(vb); } while (0)
#define PV_MM(PA, LA, HA, LB, HB) do { o[0] = __builtin_amdgcn_mfma_f32_32x32x16_bf16(PA, PK(LA, HA), o[0], 0, 0, 0); o[1] = __builtin_amdgcn_mfma_f32_32x32x16_bf16(PA, PK(LB, HB), o[1], 0, 0, 0); } while (0)
__device__ __forceinline__ void pv_d0(f32x16* o, int vb, bf16x8 pa0, bf16x8 pa1, bf16x8 pa2, bf16x8 pa3) {
  s16x4 la, ha, lb, hb, lc, hc, ld, hd;
  PV_RD(0, la, ha, lb, hb);
  PV_RD(1, lc, hc, ld, hd);
  asm volatile("s_waitcnt lgkmcnt(4)" ::: "memory"); SBAR();
  PV_MM(pa0, la, ha, lb, hb); SBAR();
  PV_RD(2, la, ha, lb, hb);
  asm volatile("s_waitcnt lgkmcnt(4)" ::: "memory"); SBAR();
  PV_MM(pa1, lc, hc, ld, hd); SBAR();
  PV_RD(3, lc, hc, ld, hd);
  asm volatile("s_waitcnt lgkmcnt(4)" ::: "memory"); SBAR();
  PV_MM(pa2, la, ha, lb, hb); SBAR();
  asm volatile("s_waitcnt lgkmcnt(0)" ::: "memory"); SBAR();
  PV_MM(pa3, lc, hc, ld, hd);
}
#undef PV_MM
#undef PV_RD
#undef PK
__device__ __forceinline__ float bf2f_(short b) { return __builtin_bit_cast(float, (unsigned)(unsigned short)b << 16); }

template <int ABL> __device__ __forceinline__ void mla_unit(const unsigned short* __restrict__ Qg, const unsigned short* __restrict__ Kn, const unsigned short* __restrict__ Kpe, const unsigned short* __restrict__ Vg,
                                         const float* __restrict__ cs, unsigned short* __restrict__ Og, int q0, int krow0, int h, int seq, char* lds) {
  const int tid = threadIdx.x, wid = __builtin_amdgcn_readfirstlane(tid >> 6), lane = tid & 63, r32 = lane & 31, hi = lane >> 5;
  char* V_lds = lds; char* K_lds = lds + 4 * SHM_V;
  float* ws = (float*)(lds + 4 * SHM_V + 4 * SHM_K) + wid * 64; float* li_l = ws; float* al_l = ws + 32;
  float m_reg = 0.f, l_reg = 0; f32x16 o[2] = {}; bf16x8 qr[6];
  {
    const int qrow = q0 + wid * QBLK + r32;
    const unsigned short* Qw = Qg + (size_t)qrow * 768 + h * 96 + hi * 8;
#pragma unroll
    for (int d0 = 0; d0 < 6; ++d0) qr[d0] = *reinterpret_cast<const bf16x8*>(Qw + d0 * 16);
    const float* cr = cs + (size_t)qrow * 32 + hi * 8;
    bf16x8 a = qr[4], b = qr[5]; u32x4 wa, wb; float n1[8], n2[8];
#pragma unroll
    for (int e = 0; e < 8; ++e) { const float c_ = cr[e], s_ = cr[16 + e]; const float x1 = bf2f_(a[e]), x2 = bf2f_(b[e]); n1[e] = x1 * c_ - x2 * s_; n2[e] = x1 * s_ + x2 * c_; }
    wa = (u32x4){cvtpk(n1[0], n1[1]), cvtpk(n1[2], n1[3]), cvtpk(n1[4], n1[5]), cvtpk(n1[6], n1[7])};
    wb = (u32x4){cvtpk(n2[0], n2[1]), cvtpk(n2[2], n2[3]), cvtpk(n2[4], n2[5]), cvtpk(n2[6], n2[7])};
    qr[4] = *reinterpret_cast<bf16x8*>(&wa); qr[5] = *reinterpret_cast<bf16x8*>(&wb);
  }
  const int sk = tid >> 3, sc = (tid & 7) * 8, rk = (tid & 255) >> 2, rc = (tid & 3) * 8;
  const int vst = v_st(sk, sc), kst = KSWZ(sk, sc * 2), rst = KSWZ(rk, (64 + rc) * 2);
  const int vb0 = (int)(uintptr_t)V_lds + v_rd_base(lane);
  const unsigned short* Vh = Vg + (size_t)krow0 * 512 + h * 64; const unsigned short* Kh = Kn + (size_t)krow0 * 512 + h * 64; const unsigned short* Rh = Kpe + (size_t)krow0 * 32;
  struct { bf16x8 vs, ks, rs; } sr_[2];
#define SLOAD(i, k0) do { sr_[i].vs = *reinterpret_cast<const bf16x8*>(&Vh[(size_t)((k0) + sk) * 512 + sc]); sr_[i].ks = *reinterpret_cast<const bf16x8*>(&Kh[(size_t)((k0) + sk) * 512 + sc]); \
    sr_[i].rs = *reinterpret_cast<const bf16x8*>(&Rh[(size_t)((k0) + rk) * 32 + rc]); } while (0)
#define SWRITE(b, i) do { *(bf16x8*)(V_lds + (b) * SHM_V + vst) = sr_[i].vs; *(bf16x8*)(K_lds + (b) * SHM_K + kst) = sr_[i].ks; *(bf16x8*)(K_lds + (b) * SHM_K + rst) = sr_[i].rs; } while (0)
#define RESC(a) do { if (__any((a) < 1.f)) { if (hi == 0) al_l[r32] = (a); asm volatile("s_waitcnt lgkmcnt(0)" ::: "memory"); \
    _Pragma("unroll") for (int d = 0; d < 2; ++d) _Pragma("unroll") for (int r = 0; r < 16; ++r) o[d][r] *= al_l[crow(r, hi)]; } } while (0)
#define EBAR() do { asm volatile("s_waitcnt lgkmcnt(0)" ::: "memory"); __builtin_amdgcn_s_barrier(); asm volatile("" ::: "memory"); } while (0)
  f32x16 p0, p1; float al; bf16x8 pa0, pa1, pa2, pa3; const int NT = seq / KVBLK;
  pa0 = pa1 = pa2 = pa3 = bf16x8{};
  SLOAD(0, 0); SLOAD(1, KVBLK); asm volatile("s_waitcnt vmcnt(0)" ::: "memory"); SWRITE(0, 0); SWRITE(1, 1);
  if (2 < NT) SLOAD(0, 2 * KVBLK);
  EBAR();
  if (wid >= 4) EBAR();
  for (int t = 0; t < NT; ++t) {
    SBAR(); qkt(p0, p1, K_lds + (t & 3) * SHM_K, qr, r32, hi); SBAR();
    if (t > 0) pv_d0(o, vb0 + ((t - 1) & 3) * SHM_V, pa0, pa1, pa2, pa3);
    EBAR();
    partialSM<ABL>(p0, p1, m_reg, al, t == 0);
    RESC(al);
    finishSM<ABL>(p0, p1, al, l_reg, pa0, pa1, pa2, pa3);
    if (t + 2 < NT) { asm volatile("s_waitcnt vmcnt(0)" ::: "memory"); SWRITE((t + 2) & 3, 0); }
    if (t + 3 < NT) SLOAD(0, (t + 3) * KVBLK);
    EBAR();
  }
  SBAR(); pv_d0(o, vb0 + ((NT - 1) & 3) * SHM_V, pa0, pa1, pa2, pa3);
  if (wid < 4) EBAR();
#undef EBAR
  if (hi == 0) li_l[r32] = l_reg; asm volatile("s_waitcnt lgkmcnt(0)" ::: "memory");
  float rli[16];
#pragma unroll
  for (int r = 0; r < 16; ++r) rli[r] = __builtin_amdgcn_rcpf(li_l[crow(r, hi)]);
  unsigned short* Ow = Og + (size_t)(q0 + wid * QBLK) * 512 + h * 64;
#pragma unroll
  for (int r = 0; r < 16; ++r) { int orow = crow(r, hi);
#pragma unroll
    for (int d0 = 0; d0 < 2; ++d0) Ow[(size_t)orow * 512 + d0 * 32 + r32] = (unsigned short)cvtpk(o[d0][r] * rli[r], 0.f); }
  __syncthreads();
#undef SLOAD
#undef SWRITE
#undef RESC
}
#undef KSWZ
#undef SBAR
}

namespace dil {
using bf16x8 = __attribute__((ext_vector_type(8))) short;
using s16x4  = __attribute__((ext_vector_type(4))) short;
using f32x16 = __attribute__((ext_vector_type(16))) float;
using u32x4  = __attribute__((ext_vector_type(4))) unsigned;
constexpr int TBL_PITCH = 2112;
constexpr int W_TBL = 0, W_K = 8448, W_V = 8448 + 4096, W_POS = 8448 + 8192, W_AL = W_POS + 128, W_BYTES = W_AL + 128;
__device__ __forceinline__ int crow(int r, int hi) { return (r & 3) + 8 * (r >> 2) + 4 * hi; }
__device__ __forceinline__ unsigned cvtpk(float lo, float hi) { unsigned r; asm volatile("v_cvt_pk_bf16_f32 %0, %1, %2" : "=v"(r) : "v"(lo), "v"(hi)); return r; }
#define DKSWZ(row, colB) ((row) * 128 + ((colB) ^ (((row) & 7) << 4)))
__device__ __forceinline__ int v_st(int k, int c) { const int kk = (k & ~0xC) | ((k & 4) << 1) | ((k & 8) >> 1); return ((kk >> 3) * 2 + (c >> 5)) * 512 + ((kk & 7) * 32 + (c & 31)) * 2; }
__device__ __forceinline__ int v_rd_base(int lane) { return ((lane & 3) << 3) | (((lane >> 2) & 3) << 6) | (((lane >> 4) & 1) << 5) | (((lane >> 5) & 1) << 8); }
constexpr int v_rd_off(int d0, int ks, int half) { return d0 * 512 + ks * 2048 + half * 1024; }
template <int OFF> __device__ __forceinline__ s16x4 tr_read(int vb) {
  s16x4 r; asm volatile("ds_read_b64_tr_b16 %0, %1 offset:%2" : "=&v"(r) : "v"(vb), "i"(OFF) : "memory"); return r;
}
template <int D0> __device__ __forceinline__ void pv_one(f32x16& od, int vb, bf16x8 pa0, bf16x8 pa1) {
  const s16x4 l0 = tr_read<v_rd_off(D0, 0, 0)>(vb), h0 = tr_read<v_rd_off(D0, 0, 1)>(vb), l1 = tr_read<v_rd_off(D0, 1, 0)>(vb), h1 = tr_read<v_rd_off(D0, 1, 1)>(vb);
  asm volatile("s_waitcnt lgkmcnt(0)" ::: "memory"); __builtin_amdgcn_sched_barrier(0);
#define PK(L, H) (bf16x8){L[0], L[1], L[2], L[3], H[0], H[1], H[2], H[3]}
  od = __builtin_amdgcn_mfma_f32_32x32x16_bf16(pa0, PK(l0, h0), od, 0, 0, 0);
  od = __builtin_amdgcn_mfma_f32_32x32x16_bf16(pa1, PK(l1, h1), od, 0, 0, 0);
#undef PK
}
struct KVRegs { bf16x8 k[4], v[4]; int pk; };
struct TaskId { int b, h, g, r, ub; };
__device__ __forceinline__ TaskId task_at(int i, int bx, int G, int wave) {
  TaskId t; int bh, k; t.b = 0; t.h = 0; t.g = 0; t.r = 0; t.ub = -1;
  if (G == 256) { if (i >= 6) return t; bh = (bx & 7) + 8 * (bx >> 6); k = ((((bx >> 3) & 7) * 6 + i) << 3) + wave; }
  else { const int id = (i * G + bx) * 8 + wave; if (id >= 12288) return t; bh = id / 384; k = id % 384; }
  const int g = k >> 7, kk = k & 127, nub = g == 0 ? 128 : (g == 1 ? 32 : 8);
  t.b = bh >> 3; t.h = bh & 7; t.g = g; t.r = kk / nub; t.ub = kk % nub; return t;
}
struct Pre { bf16x8 qr[4]; int pos_q; KVRegs R; };
__device__ __forceinline__ void load_blk(const unsigned short* __restrict__ qkv, const int* __restrict__ pos, const TaskId& t, int kb, KVRegs& R) {
  const int lane = threadIdx.x & 63, r32 = lane & 31, srow = lane >> 1, shalf = (lane & 1) * 32;
  const int dl = t.g == 0 ? 1 : (t.g == 1 ? 4 : 16), L = S / dl; const size_t rowb = (size_t)t.b * S;
  int up = 32 * (t.ub - 2 + kb) + srow; up = up < 0 ? 0 : (up >= L ? L - 1 : up);
  const unsigned short* base = qkv + (rowb + t.r + dl * up) * 1536 + t.h * 64 + shalf;
#pragma unroll
  for (int c = 0; c < 4; ++c) { R.k[c] = *reinterpret_cast<const bf16x8*>(base + 512 + c * 8); R.v[c] = *reinterpret_cast<const bf16x8*>(base + 1024 + c * 8); }
  int upl = 32 * (t.ub - 2 + kb) + r32; upl = upl < 0 ? 0 : (upl >= L ? L - 1 : upl);
  R.pk = pos[rowb + t.r + dl * upl];
}
__device__ __forceinline__ int kb_first(const TaskId& t) { return (t.ub >= 2) ? 0 : (2 - t.ub); }
__device__ __forceinline__ void dil_prefetch(const unsigned short* __restrict__ qkv, const int* __restrict__ pos, const TaskId& t, Pre& P) {
  const int lane = threadIdx.x & 63, r32 = lane & 31, hi = lane >> 5;
  const int dl = t.g == 0 ? 1 : (t.g == 1 ? 4 : 16); const size_t rowb = (size_t)t.b * S; const int tok_q = t.r + dl * (32 * t.ub + r32);
  const unsigned short* Qw = qkv + (rowb + tok_q) * 1536 + t.h * 64 + hi * 8;
#pragma unroll
  for (int d0 = 0; d0 < 4; ++d0) P.qr[d0] = *reinterpret_cast<const bf16x8*>(Qw + d0 * 16);
  P.pos_q = pos[rowb + tok_q];
  load_blk(qkv, pos, t, kb_first(t), P.R);
}
__device__ __forceinline__ void dil_task(const unsigned short* __restrict__ qkv, const int* __restrict__ pos, unsigned short* __restrict__ oap, float* __restrict__ lse,
                                         const TaskId t, Pre& P, bool has_next, const TaskId tn, char* wl  ) {
  const int lane = threadIdx.x & 63, r32 = lane & 31, hi = lane >> 5;
  const int b = t.b, h = t.h, g = t.g, r = t.r, ub = t.ub;
  const int dl = g == 0 ? 1 : (g == 1 ? 4 : 16), L = S / dl;
  const int u_q = 32 * ub + r32;
  const size_t rowb = (size_t)b * S;
  const int tok_q = r + dl * u_q;
  const float* tblw = (const float*)(wl + W_TBL); int* posw = (int*)(wl + W_POS); float* alw = (float*)(wl + W_AL);
  bf16x8 qr[4];
#pragma unroll
  for (int d0 = 0; d0 < 4; ++d0) qr[d0] = P.qr[d0];
  const int pos_q = P.pos_q;
  const int srow = lane >> 1, shalf = (lane & 1) * 32;
  const int vb0 = (int)(uintptr_t)(wl + W_V) + v_rd_base(lane);
  float m_reg = -1e30f, l_reg = 0.f; f32x16 o[2] = {};
  const int kb_lo = kb_first(t), kb_hi = (32 * (ub + 3) <= L) ? 4 : (4 - ((32 * (ub + 3) - L) >> 5));
  KVRegs R = P.R;
  for (int kb = kb_lo; kb <= kb_hi; ++kb) {
#pragma unroll
    for (int c = 0; c < 4; ++c) {
      *(bf16x8*)(wl + W_K + DKSWZ(srow, (shalf + c * 8) * 2)) = R.k[c];
      *(bf16x8*)(wl + W_V + v_st(srow, shalf + c * 8)) = R.v[c];
    }
    if (hi == 0) posw[r32] = R.pk;
    if (kb < kb_hi) load_blk(qkv, pos, t, kb + 1, R);
    asm volatile("s_waitcnt lgkmcnt(0)" ::: "memory"); __builtin_amdgcn_sched_barrier(0);
    f32x16 p = {};
#pragma unroll
    for (int d0 = 0; d0 < 4; ++d0) {
      const bf16x8 kf = *reinterpret_cast<const bf16x8*>(wl + W_K + DKSWZ(r32, (d0 * 16 + hi * 8) * 2));
      p = __builtin_amdgcn_mfma_f32_32x32x16_bf16(kf, qr[d0], p, 0, 0, 0);
    }
    float bmax;
    if (kb == 0 || kb == 4) {
      bmax = -INFINITY;
#pragma unroll
      for (int rr = 0; rr < 16; ++rr) {
        const int kk = crow(rr, hi);
        const bool valid = kb == 0 ? (kk >= r32) : (kk <= r32);
        int rel = posw[kk] - pos_q; rel = rel < -1024 ? -1024 : (rel > 1024 ? 1024 : rel); const int idx = rel + 1024;
        const float sv = valid ? (p[rr] + tblw[idx ^ ((idx >> 5) & 31)]) : -INFINITY;
        p[rr] = sv; bmax = fmaxf(bmax, sv);
      }
    } else {
#pragma unroll
      for (int rr = 0; rr < 16; ++rr) {
        const int kk = crow(rr, hi);
        int rel = posw[kk] - pos_q; rel = rel < -1024 ? -1024 : (rel > 1024 ? 1024 : rel); const int idx = rel + 1024;
        p[rr] += tblw[idx ^ ((idx >> 5) & 31)];
      }
      bmax = fmaxf(fmaxf(p[0], p[1]), fmaxf(p[2], p[3]));
#pragma unroll
      for (int rr = 4; rr < 16; rr += 4) bmax = fmaxf(bmax, fmaxf(fmaxf(p[rr], p[rr + 1]), fmaxf(p[rr + 2], p[rr + 3])));
    }
    { auto x = __builtin_amdgcn_permlane32_swap(__float_as_uint(bmax), __float_as_uint(bmax), false, false); bmax = fmaxf(__uint_as_float(x[0]), __uint_as_float(x[1])); }
    float alpha = 1.f; bool resc = false;
    if (!__all(bmax - m_reg <= 11.5f)) { const float mn = fmaxf(m_reg, bmax); alpha = __builtin_amdgcn_exp2f(m_reg - mn); m_reg = mn; resc = true; }
    float ps = 0.f;
#pragma unroll
    for (int rr = 0; rr < 16; ++rr) p[rr] = __builtin_amdgcn_exp2f(p[rr] - m_reg);
    ps = ((p[0] + p[1]) + (p[2] + p[3])) + ((p[4] + p[5]) + (p[6] + p[7])) + (((p[8] + p[9]) + (p[10] + p[11])) + ((p[12] + p[13]) + (p[14] + p[15])));
    { auto x = __builtin_amdgcn_permlane32_swap(__float_as_uint(ps), __float_as_uint(ps), false, false); ps = __uint_as_float(x[0]) + __uint_as_float(x[1]); }
    l_reg = l_reg * alpha + ps;
    if (resc && kb != kb_lo) {
      if (hi == 0) alw[r32] = alpha;
      asm volatile("s_waitcnt lgkmcnt(0)" ::: "memory");
#pragma unroll
      for (int d = 0; d < 2; ++d)
#pragma unroll
        for (int rr = 0; rr < 16; ++rr) o[d][rr] *= alw[crow(rr, hi)];
    }
    bf16x8 pa0, pa1;
#define PK4(P, BASE, OUT) do { unsigned a0 = cvtpk(P[BASE + 0], P[BASE + 1]), a1 = cvtpk(P[BASE + 2], P[BASE + 3]);   \
    unsigned b0 = cvtpk(P[BASE + 4], P[BASE + 5]), b1 = cvtpk(P[BASE + 6], P[BASE + 7]);                              \
    auto r0 = __builtin_amdgcn_permlane32_swap(a0, b0, false, false); auto r1 = __builtin_amdgcn_permlane32_swap(a1, b1, false, false); \
    u32x4 w = {r0[0], r1[0], r0[1], r1[1]}; OUT = *reinterpret_cast<bf16x8*>(&w); } while (0)
    PK4(p, 0, pa0); PK4(p, 8, pa1);
#undef PK4
    pv_one<0>(o[0], vb0, pa0, pa1); pv_one<1>(o[1], vb0, pa0, pa1);
  }
  if (has_next) dil_prefetch(qkv, pos, tn, P);
  float* liw = alw;
  if (hi == 0) liw[r32] = l_reg;
  asm volatile("s_waitcnt lgkmcnt(0)" ::: "memory");
  if (hi == 0) lse[((size_t)g * T + rowb + tok_q) * 8 + h] = (m_reg + __log2f(l_reg)) * 0.6931471805599453f;
  unsigned short* Ow = oap + ((size_t)g * T + rowb + r + (size_t)dl * 32 * ub) * 512 + h * 64;
#pragma unroll
  for (int rr = 0; rr < 16; ++rr) { const int orow = crow(rr, hi); const float rl = __builtin_amdgcn_rcpf(liw[orow]);
#pragma unroll
    for (int d0 = 0; d0 < 2; ++d0) Ow[(size_t)orow * dl * 512 + d0 * 32 + r32] = (unsigned short)cvtpk(o[d0][rr] * rl, 0.f); }
  asm volatile("s_waitcnt lgkmcnt(0)" ::: "memory");
}
#undef DKSWZ
}

namespace mk {
#define GAS __attribute__((address_space(1)))
#define LAS __attribute__((address_space(3)))
typedef unsigned short bf16_t;
typedef unsigned v4u __attribute__((ext_vector_type(4)));
typedef unsigned v2u __attribute__((ext_vector_type(2)));
typedef float f32x4 __attribute__((ext_vector_type(4)));
#define LDS_WAIT() asm volatile("s_waitcnt lgkmcnt(0)" ::: "memory")
#define VM_WAIT() asm volatile("s_waitcnt vmcnt(0)" ::: "memory")
__device__ __forceinline__ unsigned f2bf(float f) { unsigned u = __builtin_bit_cast(unsigned, f); return (u + 0x7fffu + ((u >> 16) & 1u)) >> 16; }
__device__ __forceinline__ unsigned pk2(float lo, float hi) { return f2bf(lo) | (f2bf(hi) << 16); }
__device__ __forceinline__ float bf2f(unsigned short b) { return __builtin_bit_cast(float, (unsigned)b << 16); }
__device__ __forceinline__ float wave_sum(float v) {
#pragma unroll
    for (int o = 1; o < 64; o <<= 1) v += __shfl_xor(v, o);
    return v;
}

#define XB_TMO      128
#define XB_XCNT(j)  (256  + 64 * (j))
#define XB_XSUB(j)  (1280 + 64 * (j))
#define XB_XGEN(j)  (2304 + 64 * (j))
#define XB_TOP      3328
#define XB_TOPGEN   3392
#define XCD_BAR_WORDS 3456
#define XB_SPIN_CAP (1u << 18)

__device__ __forceinline__ unsigned xb_ld(unsigned* p)              { return __hip_atomic_load(p, __ATOMIC_RELAXED, __HIP_MEMORY_SCOPE_AGENT); }
__device__ __forceinline__ unsigned xb_add(unsigned* p, unsigned v) { return __hip_atomic_fetch_add(p, v, __ATOMIC_RELAXED, __HIP_MEMORY_SCOPE_AGENT); }
__device__ __forceinline__ unsigned xb_xcc_id() { return (unsigned)__builtin_amdgcn_s_getreg((3 << 11) | 20) & 0xFu; }
#define XB_SPIN(cond, bar) do { unsigned _sp = 0; while (cond) { __builtin_amdgcn_s_sleep(1); \
    if ((++_sp & 255u) == 0u) { if (xb_ld(&(bar)[XB_TMO])) break; if (_sp > XB_SPIN_CAP) { atomicAdd(&(bar)[XB_TMO], 1u); break; } } } } while (0)

struct XcdBarrier {
    unsigned* bar; unsigned x;
    volatile LAS unsigned* st;
};

__device__ __forceinline__ XcdBarrier xcd_barrier_post(unsigned* bar, volatile LAS unsigned* st) {
    XcdBarrier b; b.bar = bar; b.x = xb_xcc_id(); b.st = st;
    if (threadIdx.x == 0) (void)xb_add(&bar[XB_XCNT(b.x)], 1u);
    return b;
}
__device__ __forceinline__ void xcd_barrier_complete(unsigned* bar, unsigned x, unsigned& nloc, unsigned& nx) {
    const unsigned G = gridDim.x * gridDim.y * gridDim.z;
    unsigned sum, cnt, mine, sp = 0u;
    for (;;) {
        sum = 0u; cnt = 0u; mine = 0u;
#pragma unroll
        for (unsigned j = 0; j < 16; ++j) { const unsigned c = xb_ld(&bar[XB_XCNT(j)]); sum += c; cnt += (c > 0u) ? 1u : 0u; mine = (j == x) ? c : mine; }
        if (sum == G) break;
        __builtin_amdgcn_s_sleep(1);
        if ((++sp & 255u) == 0u) { if (xb_ld(&bar[XB_TMO])) break; if (sp > XB_SPIN_CAP) { atomicAdd(&bar[XB_TMO], 1u); break; } }
    }
    nloc = mine > 0u ? mine : 1u; nx = cnt > 0u ? cnt : 1u;
}

__device__ __forceinline__ void xcd_barrier(const XcdBarrier& b) {
    asm volatile("s_waitcnt vmcnt(0)" ::: "memory");
    __syncthreads();
    if (threadIdx.x == 0) {
        unsigned* bar = b.bar;
        __builtin_amdgcn_s_waitcnt(0);
        unsigned nloc = b.st[0], nx = b.st[1];
        if (nloc == 0u) { xcd_barrier_complete(bar, b.x, nloc, nx); b.st[0] = nloc; b.st[1] = nx; }
        const unsigned old = xb_add(&bar[XB_XSUB(b.x)], 1u);
        const unsigned gen = old / nloc;
        if (old + 1u == (gen + 1u) * nloc) {
            __builtin_amdgcn_fence(__ATOMIC_RELEASE, "agent");
            asm volatile("s_waitcnt vmcnt(0)" ::: "memory");
            const unsigned og = xb_add(&bar[XB_TOP], 1u);
            const unsigned tg = og / nx;
            if (og + 1u == (tg + 1u) * nx) xb_add(&bar[XB_TOPGEN], 1u);
            else XB_SPIN(xb_ld(&bar[XB_TOPGEN]) == tg, bar);
            __builtin_amdgcn_fence(__ATOMIC_ACQUIRE, "agent");
            xb_add(&bar[XB_XGEN(b.x)], 1u);
            asm volatile("s_waitcnt vmcnt(0)" ::: "memory");
        } else {
            XB_SPIN(xb_ld(&bar[XB_XGEN(b.x)]) == gen, bar);
            __builtin_amdgcn_fence(__ATOMIC_ACQUIRE, "agent");
            asm volatile("s_waitcnt vmcnt(0)" ::: "memory");
        }
    }
    __syncthreads();
}

constexpr int NWAVES = 8;
constexpr int LDS_BYTES = 147456;
constexpr int RING_BYTES = 131072;
constexpr int CTRL_OFF = 135168;
constexpr int MISC_OFF = CTRL_OFF + 320;
constexpr size_t MiB = 1u << 20;
constexpr size_t WS_CTL = 0, CTL_ZERO_BYTES = 1 * MiB;
constexpr int CW_BAR = 16384;
constexpr size_t WS_WIN = 1 * MiB, WS_WQB = 5 * MiB, WS_WKVB = 5 * MiB + 512 * 1024, WS_WO = 6 * MiB, WS_WMQG = 8 * MiB, WS_WMKV = 10 * MiB, WS_WMO = 14 * MiB;
constexpr size_t WS_RSTDX = 16 * MiB, WS_RSTDM = 16 * MiB + 64 * 1024, WS_SSQQ = 16 * MiB + 256 * 1024, WS_SSQKV = 16 * MiB + 512 * 1024, WS_TBL = 16 * MiB + 768 * 1024;
constexpr size_t WS_WRG = 16 * MiB + 896 * 1024;
constexpr size_t WS_SSQH1 = 17 * MiB, WS_SSQH2 = 18 * MiB, WS_ZKPE = 20 * MiB, WS_CS = 22 * MiB;
constexpr size_t WS_XB = 24 * MiB, WS_MEMB = 56 * MiB, WS_KVMEM = 58 * MiB, WS_KPE = 62 * MiB;
constexpr size_t WS_QKVA = 64 * MiB, WS_ZQ = 112 * MiB, WS_ZKV = 120 * MiB, WS_QB = 124 * MiB, WS_KN = 148 * MiB, WS_VB = 164 * MiB;
constexpr size_t WS_WPT = 180 * MiB, WS_VWT = 188 * MiB, WS_H2 = 196 * MiB, WS_H2B = 260 * MiB, WS_ROUTE = 292 * MiB, WS_XS = 296 * MiB;
constexpr size_t WS_HMID = 296 * MiB, WS_OAP = 440 * MiB, WS_LSE = 488 * MiB, WS_OB = 490 * MiB, WS_OMIX = 506 * MiB;
constexpr size_t WS_H1 = 538 * MiB, WS_H1B = 602 * MiB, WS_P = 634 * MiB, WS_YBUF = 666 * MiB;
constexpr size_t WS_WGU = 794 * MiB, WS_WD = 922 * MiB, WS_END = 986 * MiB;

struct Args { const float* in[26]; float* out; unsigned char* ws; double rope_rev[16]; int ph_lo, ph_hi, flags, pad; };

struct CvtDesc { const float* W; const float* gain; bf16_t* WT; int K, N, mode, item; };
__device__ __forceinline__ void cvt_load(const CvtDesc& d, f32x4 (&v)[16], int lane) {
    const int nblk = (d.N + 63) >> 6, kb = d.item / nblk, nb = d.item % nblk, k0 = 64 * kb, n0 = 64 * nb;
    const int lk = lane >> 4, ln = (lane & 15) * 4;
    const bool ok = n0 + ln < d.N;
    const float* wp = d.W + (size_t)(k0 + lk) * d.N + n0 + ln;
#pragma unroll
    for (int i = 0; i < 16; ++i) v[i] = ok ? *(const f32x4*)(wp + (size_t)(4 * i) * d.N) : (f32x4){0.f, 0.f, 0.f, 0.f};
}
__device__ __forceinline__ void cvt_store(const CvtDesc& d, f32x4 (&v)[16], LAS float* scr, int lane) {
    const int nblk = (d.N + 63) >> 6, kb = d.item / nblk, nb = d.item % nblk, k0 = 64 * kb, n0 = 64 * nb;
    const int lk = lane >> 4, ln = (lane & 15) * 4;
    if (d.gain) {
#pragma unroll
        for (int i = 0; i < 16; ++i) v[i] = v[i] * d.gain[k0 + 4 * i + lk];
    }
#pragma unroll
    for (int i = 0; i < 16; ++i) { LAS float* p = scr + (4 * i + lk) * 65 + ln; p[0] = v[i][0]; p[1] = v[i][1]; p[2] = v[i][2]; p[3] = v[i][3]; }
    LDS_WAIT(); asm volatile("" ::: "memory");
    int drow0 = n0; if (d.mode == 1) { const int half = n0 >> 10, c = n0 & 1023; drow0 = (c >> 7) * 256 + half * 128 + (c & 127); }
    const int c = lane & 7;
#pragma unroll
    for (int j = 0; j < 8; ++j) { const int n = (lane >> 3) + 8 * j; const LAS float* sp = scr + (8 * c) * 65 + n;
        v4u o; o.x = pk2(sp[0 * 65], sp[1 * 65]); o.y = pk2(sp[2 * 65], sp[3 * 65]); o.z = pk2(sp[4 * 65], sp[5 * 65]); o.w = pk2(sp[6 * 65], sp[7 * 65]);
        *(v4u*)(d.WT + (size_t)(drow0 + n) * d.K + k0 + 8 * c) = o; }
    LDS_WAIT(); asm volatile("" ::: "memory");
}
__device__ __forceinline__ void prep_rows4(const float* x0, bf16_t* o0, float* rstd_out, int lane) {
    f32x4 v[4][4]; float s[4];
#pragma unroll
    for (int r = 0; r < 4; ++r)
#pragma unroll
        for (int j = 0; j < 4; ++j) v[r][j] = ((const f32x4*)(x0 + (size_t)r * 1024))[lane + 64 * j];
#pragma unroll
    for (int r = 0; r < 4; ++r) { float a = 0.f;
#pragma unroll
        for (int j = 0; j < 4; ++j) a += (v[r][j].x * v[r][j].x + v[r][j].y * v[r][j].y) + (v[r][j].z * v[r][j].z + v[r][j].w * v[r][j].w);
        s[r] = wave_sum(a); }
    if (lane < 4) rstd_out[lane] = 1.0f / sqrtf((lane == 0 ? s[0] : lane == 1 ? s[1] : lane == 2 ? s[2] : s[3]) * (1.0f / 1024.0f) + 1e-6f);
#pragma unroll
    for (int r = 0; r < 4; ++r) { unsigned long long* o8 = (unsigned long long*)(o0 + (size_t)r * 1024) + lane;
#pragma unroll
        for (int j = 0; j < 4; ++j) o8[64 * j] = (unsigned long long)pk2(v[r][j].x, v[r][j].y) | ((unsigned long long)pk2(v[r][j].z, v[r][j].w) << 32); }
}

__device__ __forceinline__ v4u pack8(const f32x4 a, const f32x4 b) { v4u w; w.x = pk2(a[0], a[1]); w.y = pk2(a[2], a[3]); w.z = pk2(b[0], b[1]); w.w = pk2(b[2], b[3]); return w; }
__device__ __forceinline__ float sq8(const f32x4 a, const f32x4 b) { return (a[0] * a[0] + a[1] * a[1]) + (a[2] * a[2] + a[3] * a[3]) + (b[0] * b[0] + b[1] * b[1]) + (b[2] * b[2] + b[3] * b[3]); }

struct EpiInProj {
    static constexpr bool PERM = true, AFTER_DRAIN = false;
    const float* rstd; bf16_t* qkv; bf16_t* zq; bf16_t* zkv; float* zkpe; float* ssq_q; float* ssq_kv;
    __device__ __forceinline__ void operator()(const pg8::f32x4 (&acc)[2][2][4][2], const pg8::Unit& u, int wr, int wc, int fr, int fq) const {
        const int row0 = u.pm * 256 + wr * 64 + fr;
        const float qs = u.pn < 2 ? 0.125f * 1.4426950408889634f : 1.0f;
#pragma unroll
        for (int ai = 0; ai < 2; ++ai)
#pragma unroll
            for (int m = 0; m < 4; ++m) {
                const int row = row0 + ai * 128 + m * 16;
                const float rs = rstd[row];
                float ss = 0.f;
#pragma unroll
                for (int bj = 0; bj < 2; ++bj) {
                    const f32x4 v0 = acc[ai][bj][m][0] * rs, v1 = acc[ai][bj][m][1] * rs;
                    const int ct = bj * 128 + wc * 32 + 8 * fq;
                    if (u.pn < 6) { *(v4u*)(qkv + (size_t)row * 1536 + u.pn * 256 + ct) = pack8(v0 * qs, v1 * qs); }
                    else if (u.pn == 6) { *(v4u*)(zq + (size_t)row * 256 + ct) = pack8(v0, v1); ss += sq8(v0, v1); }
                    else if (bj == 0) { *(v4u*)(zkv + (size_t)row * 128 + ct) = pack8(v0, v1); ss += sq8(v0, v1); }
                    else if (wc == 0) { *(f32x4*)(zkpe + (size_t)row * 32 + 8 * fq) = v0; *(f32x4*)(zkpe + (size_t)row * 32 + 8 * fq + 4) = v1; }
                }
                if (u.pn >= 6) { ss += __shfl_xor(ss, 16); ss += __shfl_xor(ss, 32); if (fq == 0) (u.pn == 6 ? ssq_q : ssq_kv)[(size_t)row * 4 + wc] = ss; }
            }
    }
};


struct EpiQ {
    static constexpr bool PERM = true, AFTER_DRAIN = false;
    const float* ssq; bf16_t* Q;
    __device__ __forceinline__ void operator()(const pg8::f32x4 (&acc)[2][2][4][2], const pg8::Unit& u, int wr, int wc, int fr, int fq) const {
        const int row0 = u.pm * 256 + wr * 64 + fr;
#pragma unroll
        for (int ai = 0; ai < 2; ++ai)
#pragma unroll
            for (int m = 0; m < 4; ++m) {
                const int row = row0 + ai * 128 + m * 16;
                const f32x4 sp = *(const f32x4*)(ssq + (size_t)row * 4);
                const float rs = (0.10206207261596577f * 1.4426950408889634f) / sqrtf(((sp[0] + sp[1]) + (sp[2] + sp[3])) * (1.0f / 256.0f) + 1e-6f);
#pragma unroll
                for (int bj = 0; bj < 2; ++bj)
                    *(v4u*)(Q + (size_t)row * 768 + u.pn * 256 + bj * 128 + wc * 32 + 8 * fq) = pack8(acc[ai][bj][m][0] * rs, acc[ai][bj][m][1] * rs);
            }
    }
};
struct EpiKV {
    static constexpr bool PERM = true, AFTER_DRAIN = false;
    const float* ssq; bf16_t* Kn; bf16_t* Vb;
    __device__ __forceinline__ void operator()(const pg8::f32x4 (&acc)[2][2][4][2], const pg8::Unit& u, int wr, int wc, int fr, int fq) const {
        const int row0 = u.pm * 256 + wr * 64 + fr;
        bf16_t* dst = (wc < 2 ? Kn : Vb) + (wc & 1) * 32 + 8 * fq;
#pragma unroll
        for (int ai = 0; ai < 2; ++ai)
#pragma unroll
            for (int m = 0; m < 4; ++m) {
                const int row = row0 + ai * 128 + m * 16;
                const f32x4 sp = *(const f32x4*)(ssq + (size_t)row * 4);
                const float rs = 1.0f / sqrtf(((sp[0] + sp[1]) + (sp[2] + sp[3])) * (1.0f / 128.0f) + 1e-6f);
#pragma unroll
                for (int bj = 0; bj < 2; ++bj)
                    *(v4u*)(dst + (size_t)row * 512 + (u.pn * 2 + bj) * 64) = pack8(acc[ai][bj][m][0] * rs, acc[ai][bj][m][1] * rs);
            }
    }
};
struct EpiRowScale {
    static constexpr bool PERM = true, AFTER_DRAIN = false;
    const float* rs; bf16_t* O; int ldc;
    __device__ __forceinline__ void operator()(const pg8::f32x4 (&acc)[2][2][4][2], const pg8::Unit& u, int wr, int wc, int fr, int fq) const {
        const int row0 = u.pm * 256 + wr * 64 + fr;
#pragma unroll
        for (int ai = 0; ai < 2; ++ai)
#pragma unroll
            for (int m = 0; m < 4; ++m) {
                const int row = row0 + ai * 128 + m * 16;
                const float r = rs[row];
#pragma unroll
                for (int bj = 0; bj < 2; ++bj)
                    *(v4u*)(O + (size_t)row * ldc + u.pn * 256 + bj * 128 + wc * 32 + 8 * fq) = pack8(acc[ai][bj][m][0] * r, acc[ai][bj][m][1] * r);
            }
    }
};

template <bool BASE_BF16> struct EpiResid {
    static constexpr bool PERM = true, AFTER_DRAIN = false;
    const void* base; bf16_t* outb; float* ssq;
    __device__ __forceinline__ void operator()(const pg8::f32x4 (&acc)[2][2][4][2], const pg8::Unit& u, int wr, int wc, int fr, int fq) const {
        const int row0 = u.pm * 256 + wr * 64 + fr;
#pragma unroll
        for (int ai = 0; ai < 2; ++ai)
#pragma unroll
            for (int m = 0; m < 4; ++m) {
                const int row = row0 + ai * 128 + m * 16;
                float ss = 0.f;
#pragma unroll
                for (int bj = 0; bj < 2; ++bj) {
                    const size_t o = (size_t)row * 1024 + u.pn * 256 + bj * 128 + wc * 32 + 8 * fq;
                    f32x4 b0, b1;
                    if constexpr (BASE_BF16) { const v4u w = *(const v4u*)((const bf16_t*)base + o);
                        b0 = (f32x4){__builtin_bit_cast(float, w[0] << 16), __builtin_bit_cast(float, w[0] & 0xffff0000u), __builtin_bit_cast(float, w[1] << 16), __builtin_bit_cast(float, w[1] & 0xffff0000u)};
                        b1 = (f32x4){__builtin_bit_cast(float, w[2] << 16), __builtin_bit_cast(float, w[2] & 0xffff0000u), __builtin_bit_cast(float, w[3] << 16), __builtin_bit_cast(float, w[3] & 0xffff0000u)}; }
                    else { b0 = *(const f32x4*)((const float*)base + o); b1 = *(const f32x4*)((const float*)base + o + 4); }
                    const f32x4 v0 = acc[ai][bj][m][0] + b0, v1 = acc[ai][bj][m][1] + b1;
                    *(v4u*)(outb + o) = pack8(v0, v1); ss += sq8(v0, v1);
                }
                ss += __shfl_xor(ss, 16); ss += __shfl_xor(ss, 32);
                if (fq == 0) ssq[(size_t)row * 16 + u.pn * 4 + wc] = ss;
                asm volatile("" ::: "memory");
            }
    }
};
struct EpiPlain {
    static constexpr bool PERM = true, AFTER_DRAIN = false;
    bf16_t* O; int ldc;
    __device__ __forceinline__ void operator()(const pg8::f32x4 (&acc)[2][2][4][2], const pg8::Unit& u, int wr, int wc, int fr, int fq) const {
        const int row0 = u.pm * 256 + wr * 64 + fr;
#pragma unroll
        for (int ai = 0; ai < 2; ++ai)
#pragma unroll
            for (int m = 0; m < 4; ++m)
#pragma unroll
                for (int bj = 0; bj < 2; ++bj)
                    *(v4u*)(O + (size_t)(row0 + ai * 128 + m * 16) * ldc + u.pn * 256 + bj * 128 + wc * 32 + 8 * fq) = pack8(acc[ai][bj][m][0], acc[ai][bj][m][1]);
    }
};
struct EpiSoftmax {
    static constexpr bool PERM = true, AFTER_DRAIN = true;
    bf16_t* P; int rsl_off;
    __device__ __forceinline__ void fused(pg8::f32x4 (&acc)[2][2][4][2], const pg8::Unit& u, int wr, int wc, int fr, int fq, PG8_LAS unsigned char* lds, int wid, int lane) const {
        typedef float f32x2v __attribute__((ext_vector_type(2)));
        const PG8_LAS float* rsl = (const PG8_LAS float*)(lds + rsl_off);
        PG8_LAS f32x2v* X = (PG8_LAS f32x2v*)lds;
        constexpr float L2E = 1.4426950408889634f;
#pragma unroll
        for (int ai = 0; ai < 2; ++ai)
#pragma unroll
            for (int m = 0; m < 4; ++m) {
                const int rt = ai * 128 + wr * 64 + m * 16 + fr;
                const float rs = rsl[rt] * (0.0625f * L2E);
                float mx = -3.0e38f;
#pragma unroll
                for (int bj = 0; bj < 2; ++bj)
#pragma unroll
                    for (int n = 0; n < 2; ++n) { f32x4 v = acc[ai][bj][m][n] * rs; acc[ai][bj][m][n] = v; mx = fmaxf(mx, fmaxf(fmaxf(v[0], v[1]), fmaxf(v[2], v[3]))); }
                mx = fmaxf(mx, __shfl_xor(mx, 16)); mx = fmaxf(mx, __shfl_xor(mx, 32));
                float sm = 0.f;
#pragma unroll
                for (int bj = 0; bj < 2; ++bj)
#pragma unroll
                    for (int n = 0; n < 2; ++n) { const f32x4 v = acc[ai][bj][m][n]; sm += (__builtin_amdgcn_exp2f(v[0] - mx) + __builtin_amdgcn_exp2f(v[1] - mx)) + (__builtin_amdgcn_exp2f(v[2] - mx) + __builtin_amdgcn_exp2f(v[3] - mx)); }
                sm += __shfl_xor(sm, 16); sm += __shfl_xor(sm, 32);
                if (fq == 0) X[rt * 4 + wc] = (f32x2v){mx, sm};
            }
        asm volatile("s_waitcnt lgkmcnt(0)" ::: "memory"); __builtin_amdgcn_s_barrier(); asm volatile("" ::: "memory");
#pragma unroll
        for (int ai = 0; ai < 2; ++ai)
#pragma unroll
            for (int m = 0; m < 4; ++m) {
                const int rt = ai * 128 + wr * 64 + m * 16 + fr;
                const f32x2v x0 = X[rt * 4 + 0], x1 = X[rt * 4 + 1], x2 = X[rt * 4 + 2], x3 = X[rt * 4 + 3];
                const float M = fmaxf(fmaxf(x0.x, x1.x), fmaxf(x2.x, x3.x));
                const float tot = (x0.y * __builtin_amdgcn_exp2f(x0.x - M) + x1.y * __builtin_amdgcn_exp2f(x1.x - M)) + (x2.y * __builtin_amdgcn_exp2f(x2.x - M) + x3.y * __builtin_amdgcn_exp2f(x3.x - M));
                const float inv = 1.0f / tot;
#pragma unroll
                for (int bj = 0; bj < 2; ++bj) {
                    f32x4 a = acc[ai][bj][m][0], b = acc[ai][bj][m][1];
#pragma unroll
                    for (int j = 0; j < 4; ++j) { a[j] = __builtin_amdgcn_exp2f(a[j] - M) * inv; b[j] = __builtin_amdgcn_exp2f(b[j] - M) * inv; }
                    *(v4u*)(P + (size_t)(u.pm * 256 + rt) * 1024 + u.pn * 256 + bj * 128 + wc * 32 + 8 * fq) = pack8(a, b);
                }
            }
    }
};
struct OrderWp {
    int c;
    __device__ __forceinline__ bool next(int i, pg8::Unit& u) const { if (i > 0 || c >= 64) return false; const int bhh = c >> 2, pn = c & 3, b = bhh >> 2, h = bhh & 3;
        u.pm = bhh; u.pn = pn; u.aoff = ((size_t)(b * 256) * 2048 + h * 256) * 2; u.boff = ((size_t)(pn * 256) * 1024 + h * 256) * 2; return true; }
    __device__ __forceinline__ void a_ready(const pg8::Unit&) const {}
    __device__ __forceinline__ void done(const pg8::Unit&) const {}
};
struct OrderVw {
    int c;
    __device__ __forceinline__ bool next(int i, pg8::Unit& u) const { if (i > 0 || c >= 64) return false; const int b = c >> 4, ct = (c >> 2) & 3, h = c & 3;
        u.pm = b * 4 + ct; u.pn = h; u.aoff = ((size_t)(ct * 256) * 1024 + h * 256) * 2; u.boff = ((size_t)(b * 256) * 2048 + 1024 + h * 256) * 2; return true; }
    __device__ __forceinline__ void a_ready(const pg8::Unit&) const {}
    __device__ __forceinline__ void done(const pg8::Unit&) const {}
};
struct OrderBatch {
    pg8::StaticOrder so;
    __device__ __forceinline__ bool next(int i, pg8::Unit& u) const { if (!so.next(i, u)) return false; u.boff = ((size_t)((u.pm >> 4) * 1024 + u.pn * 256) * 1024) * 2; return true; }
    __device__ __forceinline__ void a_ready(const pg8::Unit&) const {}
    __device__ __forceinline__ void done(const pg8::Unit&) const {}
};

constexpr int MPADN = NA + NE * 256, NTILEN = MPADN / 256;
constexpr int CW_GCOUNT = 8192;
constexpr size_t RT_TOPI = 0, RT_TOPG = 256 * 1024, RT_SLOT = 512 * 1024, RT_ROWFLAT = 768 * 1024, RT_RSROW = 1088 * 1024, RT_RSTD = 1408 * 1024, RT_CNT = 1536 * 1024, RT_TOT = 1600 * 1024;
constexpr int LX_TEXP = CTRL_OFF + 2048;
struct OrderMoe {
    const LAS int* texp; int nper, c, G; size_t ebytes;
    __device__ __forceinline__ bool next(int i, pg8::Unit& u) const {
        const int L = i * G + (c & 7) * (G >> 3) + (c >> 3); const int tile = L / nper, pn = L % nper;
        if (tile >= texp[NTILEN]) return false;
        u.pm = tile; u.pn = pn; u.aoff = (size_t)tile * 256 * 1024 * 2; u.boff = (size_t)texp[tile] * ebytes + (size_t)pn * 256 * 1024 * 2; return true; }
    __device__ __forceinline__ void a_ready(const pg8::Unit&) const {}
    __device__ __forceinline__ void done(const pg8::Unit&) const {}
};
__device__ __forceinline__ float swiglu1(float g, float u) { g = fminf(g, 7.0f); u = fminf(fmaxf(u, -7.0f), 7.0f); return (u + 1.0f) * g * __builtin_amdgcn_rcpf(1.0f + __builtin_amdgcn_exp2f(-1.702f * 1.4426950408889634f * g)); }
struct EpiSwiGLU {
    static constexpr bool PERM = true, AFTER_DRAIN = false;
    const float* rs_row; const float* bgu; bf16_t* hmid; const LAS int* texp;
    __device__ __forceinline__ void operator()(const pg8::f32x4 (&acc)[2][2][4][2], const pg8::Unit& u, int wr, int wc, int fr, int fq) const {
        const int row0 = u.pm * 256 + wr * 64 + fr, e = texp[u.pm], c0 = u.pn * 128 + wc * 32 + 8 * fq;
        const float* bg = bgu + (size_t)e * 2048 + c0;
        const f32x4 bg0 = *(const f32x4*)bg, bg1 = *(const f32x4*)(bg + 4), bu0 = *(const f32x4*)(bg + 1024), bu1 = *(const f32x4*)(bg + 1028);
#pragma unroll
        for (int ai = 0; ai < 2; ++ai)
#pragma unroll
            for (int m = 0; m < 4; ++m) {
                const int row = row0 + ai * 128 + m * 16; const float rs = rs_row[row];
                const f32x4 g0 = acc[ai][0][m][0] * rs + bg0, g1 = acc[ai][0][m][1] * rs + bg1, u0 = acc[ai][1][m][0] * rs + bu0, u1 = acc[ai][1][m][1] * rs + bu1;
                f32x4 h0, h1;
#pragma unroll
                for (int j = 0; j < 4; ++j) { h0[j] = swiglu1(g0[j], u0[j]); h1[j] = swiglu1(g1[j], u1[j]); }
                *(v4u*)(hmid + (size_t)row * 1024 + c0) = pack8(h0, h1);
            }
    }
};
struct EpiDown {
    static constexpr bool PERM = true, AFTER_DRAIN = false;
    const int* row_flat; const float* topg; const float* bd; bf16_t* ybuf; const LAS int* texp;
    __device__ __forceinline__ void operator()(const pg8::f32x4 (&acc)[2][2][4][2], const pg8::Unit& u, int wr, int wc, int fr, int fq) const {
        const int row0 = u.pm * 256 + wr * 64 + fr, e = texp[u.pm], c0 = u.pn * 256 + wc * 32 + 8 * fq;
        const float* bp = bd + (size_t)e * 1024 + c0;
        f32x4 bv[2][2];
#pragma unroll
        for (int bj = 0; bj < 2; ++bj) { bv[bj][0] = *(const f32x4*)(bp + bj * 128); bv[bj][1] = *(const f32x4*)(bp + bj * 128 + 4); }
#pragma unroll
        for (int ai = 0; ai < 2; ++ai)
#pragma unroll
            for (int m = 0; m < 4; ++m) {
                const int row = row0 + ai * 128 + m * 16; const int a = row_flat[row];
                if (a >= 0) { const float gt = topg[a];
#pragma unroll
                    for (int bj = 0; bj < 2; ++bj)
                        *(v4u*)(ybuf + (size_t)a * 1024 + c0 + bj * 128) = pack8((acc[ai][bj][m][0] + bv[bj][0]) * gt, (acc[ai][bj][m][1] + bv[bj][1]) * gt); }
            }
    }
};

__device__ __forceinline__ int rel_bucket_d(int rel) {
    int n = rel < 0 ? -rel : rel;
    int b;
    if (n < 8) b = n; else if (n < 15) b = 8; else if (n < 27) b = 9; else if (n < 50) b = 10; else if (n < 91) b = 11;
    else if (n < 166) b = 12; else if (n < 305) b = 13; else if (n < 559) b = 14; else b = 15;
    return b + (rel > 0 ? 16 : 0);
}

static_assert(pg8::GTAB == CTRL_OFF + 4096 && pg8::GTAB + pg8::GTAB_UNITS * 512 <= LDS_BYTES && (NTILEN * 8 + 255) / 256 <= pg8::GTAB_UNITS && NWAVES * dil::W_BYTES <= CTRL_OFF && mla::SHM_ATTN <= CTRL_OFF && RING_BYTES <= CTRL_OFF && LX_TEXP + 4 * (NTILEN + 1) <= LDS_BYTES, "LDS map");
__global__ void __launch_bounds__(NWAVES * 64, 2) mk_fwd(Args args) {
    extern __shared__ __attribute__((aligned(16))) unsigned char lds_raw[];
    LAS unsigned char* lds = (LAS unsigned char*)lds_raw;
    const int tid = threadIdx.x, lane = tid & 63, wave = __builtin_amdgcn_readfirstlane(tid >> 6);
    const int G = gridDim.x; const int bx = blockIdx.x; const int vcu = (G % 8 == 0) ? (bx % 8) * (G / 8) + bx / 8 : bx;
    unsigned char* ws = args.ws;
    const int lo = args.ph_lo, hi = args.ph_hi;
#define IN(k) (lo <= (k) && (k) < hi)
#define BOTH(k) (IN(k) && IN((k) + 1))
    for (int u = tid; u < (LDS_BYTES - CTRL_OFF) / 4; u += NWAVES * 64) ((LAS unsigned*)(lds + CTRL_OFF))[u] = 0u;
    __syncthreads();
    XcdBarrier bar; bar.bar = (unsigned*)(ws + WS_CTL) + CW_BAR; bar.x = 0; bar.st = nullptr;
    if (hi - lo > 1) bar = xcd_barrier_post((unsigned*)(ws + WS_CTL) + CW_BAR, (volatile LAS unsigned*)(lds + MISC_OFF) + 8);
#define GRID_BAR(k) do { if (BOTH(k)) xcd_barrier(bar); } while (0)
    const float* x = args.in[0]; const float* mem = args.in[1]; const float* g_mix = args.in[3]; const float* w_in = args.in[4];
    const float* g_q_a = args.in[5]; const float* w_q_b = args.in[6]; const float* g_kv_a = args.in[7]; const float* w_kv_b = args.in[8];
    const float* w_o = args.in[12]; const float* g_xattn = args.in[13]; const float* g_mem = args.in[14]; const float* w_mq = args.in[15];
    const float* w_mkv = args.in[16]; const float* w_mo = args.in[17]; const float* g_moe = args.in[18];
    const float* w_gate_up = args.in[21]; const float* w_down = args.in[23];
    bf16_t* WinT = (bf16_t*)(ws + WS_WIN); bf16_t* WqbT = (bf16_t*)(ws + WS_WQB); bf16_t* WkvbT = (bf16_t*)(ws + WS_WKVB); bf16_t* WoT = (bf16_t*)(ws + WS_WO);
    bf16_t* Wmqg = (bf16_t*)(ws + WS_WMQG); bf16_t* WmkvT = (bf16_t*)(ws + WS_WMKV); bf16_t* WmoT = (bf16_t*)(ws + WS_WMO);
    bf16_t* WguT = (bf16_t*)(ws + WS_WGU); bf16_t* WdT = (bf16_t*)(ws + WS_WD);
    bf16_t* xb = (bf16_t*)(ws + WS_XB); bf16_t* memb = (bf16_t*)(ws + WS_MEMB);
    float* rstd_x = (float*)(ws + WS_RSTDX); float* rstd_mem = (float*)(ws + WS_RSTDM);

    if (IN(0)) {
        LAS float* scr = (LAS float*)(lds + wave * 16640);
        const int gw = vcu * NWAVES + wave, NGW = G * NWAVES;
        constexpr int I_IN = 16 * 31, I_QB = 4 * 12, I_KVB = 2 * 16, I_O = 16 * 16, I_MKV = 16 * 32, I_MO = 16 * 16, I_GU = 16 * 32, I_D = 16 * 16;
        const int n_exp = (args.flags & 1) ? 32 : 0;
        const int NITEMS = I_IN + I_QB + I_KVB + I_O + I_MKV + I_MO + n_exp * (I_GU + I_D);
        auto desc = [&](int it) {
            CvtDesc d; int r = it; d.mode = 0;
            if (r < I_IN) { d.W = w_in; d.K = 1024; d.N = 1952; d.gain = g_mix; d.WT = WinT; }
            else if ((r -= I_IN) < I_QB) { d.W = w_q_b; d.K = 256; d.N = 768; d.gain = g_q_a; d.WT = WqbT; }
            else if ((r -= I_QB) < I_KVB) { d.W = w_kv_b; d.K = 128; d.N = 1024; d.gain = g_kv_a; d.WT = WkvbT; }
            else if ((r -= I_KVB) < I_O) { d.W = w_o; d.K = 1024; d.N = 1024; d.gain = nullptr; d.WT = WoT; }
            else if ((r -= I_O) < I_MKV) { d.W = w_mkv; d.K = 1024; d.N = 2048; d.gain = g_mem; d.WT = WmkvT; }
            else if ((r -= I_MKV) < I_MO) { d.W = w_mo; d.K = 1024; d.N = 1024; d.gain = nullptr; d.WT = WmoT; }
            else if ((r -= I_MO) < 32 * I_GU) { const int e = r / I_GU; r -= e * I_GU; d.W = w_gate_up + (size_t)e * 1024 * 2048; d.K = 1024; d.N = 2048; d.gain = g_moe; d.WT = WguT + (size_t)e * 2048 * 1024; d.mode = 1; }
            else { r -= 32 * I_GU; const int e = r / I_D; r -= e * I_D; d.W = w_down + (size_t)e * 1024 * 1024; d.K = 1024; d.N = 1024; d.gain = nullptr; d.WT = WdT + (size_t)e * 1024 * 1024; }
            d.item = r; return d; };
        {
            f32x4 va[16], vb[16]; CvtDesc dc = desc(0), dn = dc; bool have = false;
            for (int it = gw; ; it += NGW) {
                const bool more = it < NITEMS;
                if (more) { dn = desc(it); cvt_load(dn, vb, lane); }
                if (have) cvt_store(dc, va, scr, lane);
                if (!more) break;
#pragma unroll
                for (int i = 0; i < 16; ++i) va[i] = vb[i];
                dc = dn; have = true;
            }
        }
        for (int i = gw * 64 + lane; i < 64 * 1024 / 8; i += NGW * 64) ((v4u*)(WinT + (size_t)1984 * 1024))[i] = (v4u){0u, 0u, 0u, 0u};
        for (int m = gw * 4; m < T; m += NGW * 4) prep_rows4(x + (size_t)m * D, xb + (size_t)m * D, rstd_x + m, lane);
        for (int m = gw * 4; m < NB * NMEM; m += NGW * 4) prep_rows4(mem + (size_t)m * D, memb + (size_t)m * D, rstd_mem + m, lane);
        { const float* w_router = args.in[19]; float* wrg = (float*)(ws + WS_WRG); for (int i = bx * 512 + tid; i < 1024 * 32; i += G * 512) wrg[i] = w_router[i] * g_moe[i >> 5]; }
        for (int m = gw; m < D; m += NGW) {
            const f32x4* xr = (const f32x4*)(w_mq + (size_t)m * D) + lane; const float gc = g_xattn[m];
            unsigned long long* o8 = (unsigned long long*)(Wmqg + (size_t)m * D) + lane;
#pragma unroll
            for (int j = 0; j < 4; ++j) { const f32x4 v = xr[64 * j] * gc; o8[64 * j] = (unsigned long long)pk2(v.x, v.y) | ((unsigned long long)pk2(v.z, v.w) << 32); }
        }
    }
    if (IN(0)) {
        const float* rel_bias = args.in[9]; float* tbl = (float*)(ws + WS_TBL);
        for (int i = bx * 512 + tid; i < 8 * 2049; i += G * 512) { const int h = i / 2049, r = i % 2049; tbl[h * 2112 + r] = rel_bias[rel_bucket_d(r - 1024) * 8 + h]; }
    }
    GRID_BAR(0);
    if (IN(1)) {
        int kx = 1024; asm volatile("" : "+s"(kx)); pg8::Gemm g{xb, WinT, kx, kx, kx}; pg8::StaticOrder S; S.init(T, 2048, 1024, 1024, G, bx);
        EpiInProj E{rstd_x, (bf16_t*)(ws + WS_QKVA), (bf16_t*)(ws + WS_ZQ), (bf16_t*)(ws + WS_ZKV), (float*)(ws + WS_ZKPE), (float*)(ws + WS_SSQQ), (float*)(ws + WS_SSQKV)};
        pg8::gemm_phase<EpiInProj, pg8::StaticOrder, true, true>(lds, g, S, E);
    }
    GRID_BAR(1);
    if (IN(2)) {
        const int* pos = (const int*)args.in[2];
        float* cs = (float*)(ws + WS_CS); const float* zkpe = (const float*)(ws + WS_ZKPE); bf16_t* kpe = (bf16_t*)(ws + WS_KPE);
        for (int i = bx * 512 + tid; i < T * 16; i += G * 512) {
            const int t = i >> 4, j = i & 15;
            const double rev = (double)pos[t] * args.rope_rev[j];
            const float fr_ = (float)(rev - floor(rev));
            const float sn = __builtin_amdgcn_sinf(fr_), c_ = __builtin_amdgcn_cosf(fr_);
            cs[(size_t)t * 32 + j] = c_; cs[(size_t)t * 32 + 16 + j] = sn;
            const float x1 = zkpe[(size_t)t * 32 + j], x2 = zkpe[(size_t)t * 32 + 16 + j];
            kpe[(size_t)t * 32 + j] = (bf16_t)f2bf(x1 * c_ - x2 * sn); kpe[(size_t)t * 32 + 16 + j] = (bf16_t)f2bf(x1 * sn + x2 * c_);
        }
        {   int kq = 256; asm volatile("" : "+s"(kq)); pg8::Gemm g{(const bf16_t*)(ws + WS_ZQ), WqbT, kq, kq, kq}; pg8::StaticOrder S; S.init(T, 768, 256, 256, G, bx);
            EpiQ E{(const float*)(ws + WS_SSQQ), (bf16_t*)(ws + WS_QB)};
            pg8::gemm_phase<EpiQ, pg8::StaticOrder, true, true>(lds, g, S, E); }
        {   int kk = 128; asm volatile("" : "+s"(kk)); pg8::Gemm g{(const bf16_t*)(ws + WS_ZKV), WkvbT, kk, kk, kk}; const bool memcu = ((bx + 64) % G) < 32 && G > 64; const int bx2 = bx - (bx >= G - 64 + 32 ? 32 : 0);
            pg8::StaticOrder S; S.init(memcu ? 0 : T, 1024, 128, 128, G > 64 ? G - 32 : G, G > 64 ? bx2 : bx);
            EpiKV E{(const float*)(ws + WS_SSQKV), (bf16_t*)(ws + WS_KN), (bf16_t*)(ws + WS_VB)};
            pg8::gemm_phase<EpiKV, pg8::StaticOrder, true, true>(lds, g, S, E); }
        {   int kx = 1024; asm volatile("" : "+s"(kx)); pg8::Gemm g{memb, WmkvT, kx, kx, kx}; pg8::StaticOrder S; S.init(NB * NMEM, 2048, 1024, 1024, G, (bx + 64) % G);
            EpiRowScale E{rstd_mem, (bf16_t*)(ws + WS_KVMEM), 2048};
            pg8::gemm_phase<EpiRowScale, pg8::StaticOrder, true, true>(lds, g, S, E); }
    }
    GRID_BAR(2);
    if (IN(3)) {
        const unsigned short* Qg = (const unsigned short*)(ws + WS_QB); const unsigned short* Kn = (const unsigned short*)(ws + WS_KN);
        const unsigned short* Kp = (const unsigned short*)(ws + WS_KPE); const unsigned short* Vg = (const unsigned short*)(ws + WS_VB);
        const float* cs = (const float*)(ws + WS_CS); unsigned short* Og = (unsigned short*)(ws + WS_OB);
        for (int i = 0; !(args.flags & 8); ++i) {
            int bh, qb;
            if (G == 256) { if (i >= 2) break; const int idx = i * 32 + (bx >> 3); bh = (bx & 7) + 8 * (idx >> 4); qb = idx & 15; }
            else { const int un = i * G + bx; if (un >= 512) break; bh = un >> 4; qb = un & 15; }
            const int b = bh >> 3, h = bh & 7;
#ifdef MLA_ABL
            if (args.flags & 16) mla::mla_unit<MLA_ABL>(Qg, Kn, Kp, Vg, cs, Og, b * S + qb * 256, b * S, h, S, (char*)lds_raw); else
#endif
            mla::mla_unit<0>(Qg, Kn, Kp, Vg, cs, Og, b * S + qb * 256, b * S, h, S, (char*)lds_raw);
        }
        {
            const unsigned short* qkv = (const unsigned short*)(ws + WS_QKVA); const int* pos = (const int*)args.in[2];
            const float* tbl = (const float*)(ws + WS_TBL); unsigned short* oap = (unsigned short*)(ws + WS_OAP); float* lse = (float*)(ws + WS_LSE);
            char* wl = (char*)lds_raw + wave * dil::W_BYTES;
            __syncthreads();
            int cur_h = -1;
            dil::TaskId tc = dil::task_at(0, bx, G, wave), tn = tc; dil::Pre P;
            bool have = !(args.flags & 4) && tc.ub >= 0;
            if (have) dil::dil_prefetch(qkv, pos, tc, P);
            for (int i = 0; have; ++i) {
                tn = dil::task_at(i + 1, bx, G, wave); const bool has_next = tn.ub >= 0;
                if (tc.h != cur_h) { float* tw = (float*)(wl + dil::W_TBL); for (int j = lane; j < 2049; j += 64) tw[j ^ ((j >> 5) & 31)] = tbl[tc.h * dil::TBL_PITCH + j] * 1.4426950408889634f; cur_h = tc.h; asm volatile("s_waitcnt vmcnt(0) lgkmcnt(0)" ::: "memory"); }
                dil::dil_task(qkv, pos, oap, lse, tc, P, has_next, tn, wl);
                tc = tn; have = has_next;
            }
        }
    }
    GRID_BAR(3);
    if (IN(4)) {
        { int kx = 256; asm volatile("" : "+s"(kx));
          if (bx < 64) { pg8::Gemm g{(const bf16_t*)(ws + WS_KVMEM), Wmqg, 2048, 1024, kx}; OrderWp S{bx}; EpiPlain E{(bf16_t*)(ws + WS_WPT), 1024};
              pg8::gemm_phase<EpiPlain, OrderWp, true, true>(lds, g, S, E); }
          else if (bx < 128) { pg8::Gemm g{WmoT, (const bf16_t*)(ws + WS_KVMEM), 1024, 2048, kx}; OrderVw S{bx - 64}; EpiPlain E{(bf16_t*)(ws + WS_VWT), 1024};
              pg8::gemm_phase<EpiPlain, OrderVw, true, true>(lds, g, S, E); } }
        const bf16_t* oap = (const bf16_t*)(ws + WS_OAP); const float* lse = (const float*)(ws + WS_LSE); const bf16_t* obp = (const bf16_t*)(ws + WS_OB);
        const float* g_out_a = args.in[10]; const float* g_out_b = args.in[11]; bf16_t* omix = (bf16_t*)(ws + WS_OMIX);
        const int gw = vcu * NWAVES + wave, NGW = G * NWAVES;
        const f32x4 ga0 = *(const f32x4*)(g_out_a + 8 * lane), ga1 = *(const f32x4*)(g_out_a + 8 * lane + 4), gb0 = *(const f32x4*)(g_out_b + 8 * lane), gb1 = *(const f32x4*)(g_out_b + 8 * lane + 4);
#define UNPK_LO(V_) ((f32x4){__builtin_bit_cast(float, (V_)[0] << 16), __builtin_bit_cast(float, (V_)[0] & 0xffff0000u), __builtin_bit_cast(float, (V_)[1] << 16), __builtin_bit_cast(float, (V_)[1] & 0xffff0000u)})
#define UNPK_HI(V_) ((f32x4){__builtin_bit_cast(float, (V_)[2] << 16), __builtin_bit_cast(float, (V_)[2] & 0xffff0000u), __builtin_bit_cast(float, (V_)[3] << 16), __builtin_bit_cast(float, (V_)[3] & 0xffff0000u)})
        for (int tok = gw; tok < T; tok += NGW) {
            const int head = lane >> 3;
            const float l0 = lse[((size_t)0 * T + tok) * 8 + head], l1 = lse[((size_t)1 * T + tok) * 8 + head], l2 = lse[((size_t)2 * T + tok) * 8 + head];
            const float mx = fmaxf(l0, fmaxf(l1, l2)); float w0 = __expf(l0 - mx), w1 = __expf(l1 - mx), w2 = __expf(l2 - mx); const float wi = 1.0f / (w0 + w1 + w2); w0 *= wi; w1 *= wi; w2 *= wi;
            const v4u q0 = *(const v4u*)(oap + ((size_t)0 * T + tok) * 512 + 8 * lane), q1 = *(const v4u*)(oap + ((size_t)1 * T + tok) * 512 + 8 * lane);
            const v4u q2 = *(const v4u*)(oap + ((size_t)2 * T + tok) * 512 + 8 * lane), qb = *(const v4u*)(obp + (size_t)tok * 512 + 8 * lane);
            const f32x4 a0 = UNPK_LO(q0) * w0 + UNPK_LO(q1) * w1 + UNPK_LO(q2) * w2, a1 = UNPK_HI(q0) * w0 + UNPK_HI(q1) * w1 + UNPK_HI(q2) * w2, b0 = UNPK_LO(qb), b1 = UNPK_HI(qb);
            const float sa = wave_sum(sq8(a0, a1)), sb = wave_sum(sq8(b0, b1));
            const float ra = 1.0f / sqrtf(sa * (1.0f / 512.0f) + 1e-6f), rb = 1.0f / sqrtf(sb * (1.0f / 512.0f) + 1e-6f);
            *(v4u*)(omix + (size_t)tok * 1024 + 8 * lane) = pack8(a0 * ra * ga0, a1 * ra * ga1);
            *(v4u*)(omix + (size_t)tok * 1024 + 512 + 8 * lane) = pack8(b0 * rb * gb0, b1 * rb * gb1);
        }
#undef UNPK_LO
#undef UNPK_HI
    }
    GRID_BAR(4);
    if (IN(5)) {
        int kx = 1024; asm volatile("" : "+s"(kx));
        pg8::Gemm g{(const bf16_t*)(ws + WS_OMIX), WoT, kx, kx, kx}; pg8::StaticOrder S; S.init(T, 1024, 1024, 1024, G, bx);
        EpiResid<false> E{x, (bf16_t*)(ws + WS_H1B), (float*)(ws + WS_SSQH1)};
        pg8::gemm_phase<EpiResid<false>, pg8::StaticOrder, true, true>(lds, g, S, E);
    }
    GRID_BAR(5);
    if (IN(6)) {
        int kx = 1024; asm volatile("" : "+s"(kx));
        pg8::Gemm g{(const bf16_t*)(ws + WS_H1B), (const bf16_t*)(ws + WS_WPT), kx, kx, kx}; OrderBatch S; S.so.init(T, 1024, 1024, 1024, G, bx);
        pg8::Unit u0; const bool has = S.next(0, u0);
        LAS float* rsl = (LAS float*)(lds + CTRL_OFF + 1024);
        if (has && tid < 256) { const float* sp = (const float*)(ws + WS_SSQH1) + (size_t)(u0.pm * 256 + tid) * 16; float a = 0.f;
#pragma unroll
            for (int j = 0; j < 4; ++j) { const f32x4 v = ((const f32x4*)sp)[j]; a += (v[0] + v[1]) + (v[2] + v[3]); }
            rsl[tid] = 1.0f / sqrtf(a * (1.0f / 1024.0f) + 1e-6f); }
        __syncthreads();
        EpiSoftmax E{(bf16_t*)(ws + WS_P), CTRL_OFF + 1024};
        pg8::gemm_phase<EpiSoftmax, OrderBatch, false, true>(lds, g, S, E);
    }
    GRID_BAR(6);
    if (IN(7)) {
        int kx = 1024; asm volatile("" : "+s"(kx));
        pg8::Gemm g{(const bf16_t*)(ws + WS_P), (const bf16_t*)(ws + WS_VWT), kx, kx, kx}; OrderBatch S; S.so.init(T, 1024, 1024, 1024, G, bx);
        EpiResid<true> E{(const bf16_t*)(ws + WS_H1B), (bf16_t*)(ws + WS_H2B), (float*)(ws + WS_SSQH2)};
        pg8::gemm_phase<EpiResid<true>, OrderBatch, true, true>(lds, g, S, E);
    }
    GRID_BAR(7);
    if (IN(8)) {
        typedef float f32x16 __attribute__((ext_vector_type(16)));
        const bf16_t* h2b = (const bf16_t*)(ws + WS_H2B); const float* b_router = args.in[20]; const float* ssq2 = (const float*)(ws + WS_SSQH2);
        int* topi = (int*)(ws + WS_ROUTE + RT_TOPI); float* topg = (float*)(ws + WS_ROUTE + RT_TOPG); int* tslot = (int*)(ws + WS_ROUTE + RT_SLOT); int* row_flat = (int*)(ws + WS_ROUTE + RT_ROWFLAT);
        for (int i = bx * 512 + tid; i < MPADN; i += G * 512) row_flat[i] = -1;
        LAS float* part = (LAS float*)lds;
        LAS float* lgt = (LAS float*)(lds + 32768);
        for (int ch = bx; ch < T / 64; ch += G) {
            const int tok0 = ch * 64, tb = wave & 1, kq = wave >> 1, kh = lane >> 5, row = tok0 + 32 * tb + (lane & 31);
            f32x16 acc = {};
            const bf16_t* ap = h2b + (size_t)row * 1024 + 256 * kq + 4 * kh; const float* wp = (const float*)(ws + WS_WRG) + (size_t)(256 * kq + 4 * kh) * 32 + (lane & 31);
#pragma unroll 4
            for (int j = 0; j < 32; ++j) {
                const v2u aw = *(const v2u*)(ap + 8 * j);
                const f32x4 a4 = (f32x4){__builtin_bit_cast(float, aw.x << 16), __builtin_bit_cast(float, aw.x & 0xffff0000u), __builtin_bit_cast(float, aw.y << 16), __builtin_bit_cast(float, aw.y & 0xffff0000u)};
#pragma unroll
                for (int e = 0; e < 4; ++e) acc = __builtin_amdgcn_mfma_f32_32x32x2f32(a4[e], wp[(size_t)(8 * j + e) * 32], acc, 0, 0, 0);
            }
#pragma unroll
            for (int r = 0; r < 16; ++r) part[((kq * 64) + tb * 32 + (r & 3) + 8 * (r >> 2) + 4 * kh) * 32 + (lane & 31)] = acc[r];
            __syncthreads();
            {
                const int tk = tid >> 3, e0 = (tid & 7) * 4; const float* sp = ssq2 + (size_t)(tok0 + tk) * 16; float a = 0.f;
#pragma unroll
                for (int j = 0; j < 4; ++j) { const f32x4 v = ((const f32x4*)sp)[j]; a += (v[0] + v[1]) + (v[2] + v[3]); }
                const float rs = 1.0f / sqrtf(a * (1.0f / 1024.0f) + 1e-6f);
                if (e0 == 0) ((float*)(ws + WS_ROUTE + RT_RSTD))[tok0 + tk] = rs;
#pragma unroll
                for (int e = 0; e < 4; ++e) lgt[tk * 33 + e0 + e] = rs * ((part[(0 * 64 + tk) * 32 + e0 + e] + part[(1 * 64 + tk) * 32 + e0 + e]) + (part[(2 * 64 + tk) * 32 + e0 + e] + part[(3 * 64 + tk) * 32 + e0 + e])) + b_router[e0 + e];
            }
            __syncthreads();
            if (tid < 64) {
                int c0 = -1, c1 = -1, c2 = -1, c3 = -1; float v0 = 0.f, v1 = 0.f, v2 = 0.f, v3 = 0.f; int s0 = 0, s1 = 0, s2 = 0, s3 = 0;
                for (int k = 0; k < 4; ++k) {
                    float best = -3.0e38f; int bi = 0;
                    for (int e = 0; e < 32; ++e) { const float v = lgt[tid * 33 + e]; if (e == c0 || e == c1 || e == c2 || e == c3) continue; if (v > best) { best = v; bi = e; } }
                    if (k == 0) { c0 = bi; v0 = best; } else if (k == 1) { c1 = bi; v1 = best; } else if (k == 2) { c2 = bi; v2 = best; } else { c3 = bi; v3 = best; }
                }
                const unsigned long long lt = (1ull << lane) - 1ull; int* cntc = (int*)(ws + WS_ROUTE + RT_CNT) + ch * 32;
                for (int e = 0; e < 32; ++e) {
                    const unsigned long long m0 = __ballot(c0 == e), m1 = __ballot(c1 == e), m2 = __ballot(c2 == e), m3 = __ballot(c3 == e);
                    const int before = __popcll(m0 & lt) + __popcll(m1 & lt) + __popcll(m2 & lt) + __popcll(m3 & lt);
                    if (c0 == e) s0 = before; if (c1 == e) s1 = before; if (c2 == e) s2 = before; if (c3 == e) s3 = before;
                    if (lane == e) cntc[e] = __popcll(m0) + __popcll(m1) + __popcll(m2) + __popcll(m3);
                }
                const int t = tok0 + tid;
                const float e1 = __expf(v1 - v0), e2 = __expf(v2 - v0), e3 = __expf(v3 - v0), inv = 1.0f / (1.0f + e1 + e2 + e3);
                *(int4*)(topi + t * 4) = make_int4(c0, c1, c2, c3);
                *(f32x4*)(topg + t * 4) = (f32x4){inv, e1 * inv, e2 * inv, e3 * inv};
                *(int4*)(tslot + t * 4) = make_int4(s0, s1, s2, s3);
            }
            __syncthreads();
        }
    }
    GRID_BAR(8);
    if (IN(9)) {
        const int* topi = (const int*)(ws + WS_ROUTE + RT_TOPI); const int* tslot = (const int*)(ws + WS_ROUTE + RT_SLOT); const int* cnt = (const int*)(ws + WS_ROUTE + RT_CNT);
        int* row_flat = (int*)(ws + WS_ROUTE + RT_ROWFLAT); float* rs_row = (float*)(ws + WS_ROUTE + RT_RSROW); const float* rstd2 = (const float*)(ws + WS_ROUTE + RT_RSTD);
        LAS int* red = (LAS int*)lds;
        for (int base = bx * 512; base < NA; base += G * 512) {
            const int chA = base >> 8, e = tid & 31, part = tid >> 5;
            int tot = 0, pa = 0, pb = 0;
            for (int c = part; c < T / 64; c += 16) { const int v = cnt[c * 32 + e]; tot += v; pa += c < chA ? v : 0; pb += c <= chA ? v : 0; }
            __syncthreads();
            red[(0 * 16 + part) * 32 + e] = tot; red[(1 * 16 + part) * 32 + e] = pa; red[(2 * 16 + part) * 32 + e] = pb;
            __syncthreads();
            if (tid < 96) { const int w = tid >> 5; int a = 0; for (int p = 0; p < 16; ++p) a += red[(w * 16 + p) * 32 + e]; red[1536 + w * 32 + e] = a; }
            __syncthreads();
            if (tid == 0) { int run = 0; for (int q = 0; q < NE; ++q) { red[1632 + q] = run; run += ((red[1536 + q] + 255) >> 8) << 8; } }
            if (bx == 0 && base == 0 && tid < 32) ((int*)(ws + WS_ROUTE + RT_TOT))[tid] = red[1536 + tid];
            __syncthreads();
            const int a = base + tid, ex = topi[a], row = red[1632 + ex] + red[1536 + 32 * (1 + (((a >> 8) - chA) & 1)) + ex] + tslot[a];
            row_flat[row] = a; rs_row[row] = rstd2[a >> 2];
        }
    }
    GRID_BAR(9);
    if (IN(10) || IN(11)) {
        const int* gtot = (const int*)(ws + WS_ROUTE + RT_TOT); LAS int* texp = (LAS int*)(lds + LX_TEXP);
        __syncthreads();
        if (tid == 0) { int nt = 0; for (int e = 0; e < NE; ++e) { const int n = (gtot[e] + 255) >> 8; for (int j = 0; j < n; ++j) texp[nt + j] = e; nt += n; } texp[NTILEN] = nt; }
        __syncthreads();
    }
    if (IN(10)) {
        int kx = 1024; asm volatile("" : "+s"(kx));
        pg8::Gemm g{(const bf16_t*)(ws + WS_H2B), WguT, kx, kx, kx}; OrderMoe S{(const LAS int*)(lds + LX_TEXP), 8, bx, G, (size_t)2048 * 1024 * 2};
        {
            const int* row_flat = (const int*)(ws + WS_ROUTE + RT_ROWFLAT); pg8::Unit u;
            for (int i = 0; i < pg8::GTAB_UNITS; ++i) { if (!S.next(i, u)) break; if (tid < 256) { const int a = row_flat[u.pm * 256 + tid]; ((LAS unsigned short*)(lds + pg8::GTAB))[i * 256 + tid] = (unsigned short)(a >= 0 ? (a >> 2) : 0); } }
            __syncthreads();
        }
        EpiSwiGLU E{(const float*)(ws + WS_ROUTE + RT_RSROW), args.in[22], (bf16_t*)(ws + WS_HMID), (const LAS int*)(lds + LX_TEXP)};
        pg8::gemm_phase<EpiSwiGLU, OrderMoe, true, true, true>(lds, g, S, E);
    }
    GRID_BAR(10);
    if (IN(11)) {
        int kx = 1024; asm volatile("" : "+s"(kx));
        pg8::Gemm g{(const bf16_t*)(ws + WS_HMID), WdT, kx, kx, kx}; OrderMoe S{(const LAS int*)(lds + LX_TEXP), 4, bx, G, (size_t)1024 * 1024 * 2};
        EpiDown E{(const int*)(ws + WS_ROUTE + RT_ROWFLAT), (const float*)(ws + WS_ROUTE + RT_TOPG), args.in[24], (bf16_t*)(ws + WS_YBUF), (const LAS int*)(lds + LX_TEXP)};
        pg8::gemm_phase<EpiDown, OrderMoe, true, true>(lds, g, S, E);
    }
    GRID_BAR(11);
    if (IN(12)) {
        const bf16_t* h2b = (const bf16_t*)(ws + WS_H2B); const bf16_t* ybuf = (const bf16_t*)(ws + WS_YBUF); const float* g_final = args.in[25]; float* outp = args.out;
        const int gw = vcu * NWAVES + wave, NGW = G * NWAVES;
        for (int t = gw; t < T; t += NGW) {
            f32x4 v[4]; float ss = 0.f;
#pragma unroll
            for (int j = 0; j < 4; ++j) {
                const v2u hw = *(const v2u*)(h2b + (size_t)t * 1024 + 256 * j + 4 * lane);
                f32x4 a = (f32x4){__builtin_bit_cast(float, hw.x << 16), __builtin_bit_cast(float, hw.x & 0xffff0000u), __builtin_bit_cast(float, hw.y << 16), __builtin_bit_cast(float, hw.y & 0xffff0000u)};
#pragma unroll
                for (int k = 0; k < 4; ++k) { const v2u y = *(const v2u*)(ybuf + ((size_t)t * 4 + k) * 1024 + 256 * j + 4 * lane);
                    a[0] += __builtin_bit_cast(float, y.x << 16); a[1] += __builtin_bit_cast(float, y.x & 0xffff0000u); a[2] += __builtin_bit_cast(float, y.y << 16); a[3] += __builtin_bit_cast(float, y.y & 0xffff0000u); }
                v[j] = a; ss += (a[0] * a[0] + a[1] * a[1]) + (a[2] * a[2] + a[3] * a[3]);
            }
            ss = wave_sum(ss); const float rs = 1.0f / sqrtf(ss * (1.0f / 1024.0f) + 1e-6f);
#pragma unroll
            for (int j = 0; j < 4; ++j) *(f32x4*)(outp + (size_t)t * 1024 + 256 * j + 4 * lane) = v[j] * rs * *(const f32x4*)(g_final + 256 * j + 4 * lane);
        }
    }
#undef GRID_BAR
#undef BOTH
#undef IN
}

}
void launch_mk(hipStream_t st, const mk::Args& base, int lo, int hi, int grid) {
    mk::Args a = base; a.ph_lo = lo; a.ph_hi = hi;
    hipLaunchKernelGGL(mk::mk_fwd, dim3(grid), dim3(mk::NWAVES * 64), mk::LDS_BYTES, st, a);
}
}

extern "C" void kernel_launch(void* const* d_in, const int* in_sizes, int n_in, void* d_out, int out_size, void* d_ws, size_t ws_size, hipStream_t stream) {
    static int grid = 0;
    if (grid == 0) {
        int dev = 0, cus = 0;
        if (hipGetDevice(&dev) != hipSuccess || hipDeviceGetAttribute(&cus, hipDeviceAttributeMultiprocessorCount, dev) != hipSuccess) { grid = -1; return; }
        if (hipFuncSetAttribute((const void*)mk::mk_fwd, hipFuncAttributeMaxDynamicSharedMemorySize, mk::LDS_BYTES) != hipSuccess) { grid = -1; return; }
        grid = cus;
    }
    if (grid < 0) return;
    const float* x = (const float*)d_in[0];
    const float* mem = (const float*)d_in[1];
    const int* pos = (const int*)d_in[2];
    const float* g_q_a = (const float*)d_in[5];
    const float* w_q_b = (const float*)d_in[6];
    const float* g_kv_a = (const float*)d_in[7];
    const float* w_kv_b = (const float*)d_in[8];
    const float* rel_bias = (const float*)d_in[9];
    const float* g_out_a = (const float*)d_in[10];
    const float* g_out_b = (const float*)d_in[11];
    const float* w_o = (const float*)d_in[12];
    const float* g_xattn = (const float*)d_in[13];
    const float* g_mem = (const float*)d_in[14];
    const float* w_mq = (const float*)d_in[15];
    const float* w_mkv = (const float*)d_in[16];
    const float* w_mo = (const float*)d_in[17];
    const float* g_moe = (const float*)d_in[18];
    const float* w_router = (const float*)d_in[19];
    const float* b_router = (const float*)d_in[20];
    const float* w_gate_up = (const float*)d_in[21];
    const float* b_gate_up = (const float*)d_in[22];
    const float* w_down = (const float*)d_in[23];
    const float* b_down = (const float*)d_in[24];
    const float* g_final = (const float*)d_in[25];
    float* out = (float*)d_out;
    (void)ws_size; (void)in_sizes; (void)n_in; (void)out_size;

    (void)hipMemsetAsync((char*)d_ws + mk::WS_CTL, 0, mk::CTL_ZERO_BYTES, stream);
    mk::Args ma; memset(&ma, 0, sizeof(ma));
    for (int i = 0; i < 26; ++i) ma.in[i] = (const float*)d_in[i];
    ma.out = out; ma.ws = (unsigned char*)d_ws; ma.flags = 1;
    for (int j = 0; j < 16; ++j) ma.rope_rev[j] = pow(10000.0, -(double)j / 16.0) / 6.283185307179586476925287;
#ifndef MK_N_LAUNCHES
#define MK_N_LAUNCHES 1
#endif
    if (MK_N_LAUNCHES == 1) launch_mk(stream, ma, 0, 13, grid);
    else for (int p = 0; p < 13; ++p) launch_mk(stream, ma, p, p + 1, grid);
#ifdef PROBE_MASK
#ifdef PROBE_FLAGS
    ma.flags |= PROBE_FLAGS;
#endif
    for (int r = 0; r < PROBE_N; ++r) for (int p = 0; p < 13; ++p) if ((PROBE_MASK >> p) & 1) launch_mk(stream, ma, p, p + 1, grid);
#endif
}
```

```cpp
#include <hip/hip_runtime.h>
#include <stdint.h>
#include <string.h>
#include <math.h>

namespace {
constexpr int NB = 4, S = 4096, D = 1024, T = NB * S, NMEM = 256, INW = 1952;
constexpr int NE = 32, TOPK = 4, NA = T * TOPK;

namespace pg8 {
#define PG8_LAS __attribute__((address_space(3)))
typedef unsigned short bf16_t;
typedef short bf16x8 __attribute__((ext_vector_type(8)));
typedef float f32x4 __attribute__((ext_vector_type(4)));
typedef unsigned u32x4 __attribute__((ext_vector_type(4)));
constexpr int BM = 256, BK = 64, HALF = 128, HTB = HALF * BK * 2  , STAGE_BYTES = 8 * HTB, NXCD = 8, WGM = 8;

__host__ __device__ __forceinline__ int lds_byte(int r, int c) { const int st = (r >> 4) * 2 + (c >> 5), rr = r & 15, cc = c & 31, ob = rr * 64 + cc * 2; return st * 1024 + (ob ^ (((ob >> 9) & 1) << 5)); }
__host__ __device__ __forceinline__ void stage_rc(int b, int& R, int& C) { const int st = b / 1024, sb = b % 1024, swz = sb ^ (((sb >> 9) & 1) << 5); R = (st >> 1) * 16 + swz / 64; C = (st & 1) * 32 + (swz % 64) / 2; }
__host__ __device__ __forceinline__ int perm32(int rho) { const int n = rho >> 4, i = rho & 15; return 8 * (i >> 2) + 4 * n + (i & 3); }

struct Unit { int pm, pn; size_t aoff, boff; };
struct Gemm { const bf16_t* A; const bf16_t* Bt; int lda, ldb, K; };

struct StaticOrder {
    int nM, nN, nwg, G, c; size_t ta, tb;
    __host__ __device__ __forceinline__ void init(int M, int N, int lda, int ldb, int G_, int c_) { nM = M / BM; nN = N / BM; nwg = nM * nN; G = G_; c = c_; ta = (size_t)BM * lda * 2; tb = (size_t)BM * ldb * 2; }
    __host__ __device__ __forceinline__ bool next(int i, Unit& u) const {
        const long L = (long)i * G + c; if (L >= nwg) return false;
        int wgid = (int)L; { const int q = nwg / NXCD, r = nwg % NXCD, xcd = wgid % NXCD, off = wgid / NXCD; wgid = (xcd < r ? xcd * (q + 1) : r * (q + 1) + (xcd - r) * q) + off; }
        const int nig = WGM * nN, gid = wgid / nig, fm = gid * WGM, gsz = (nM - fm) < WGM ? (nM - fm) : WGM;
        u.pm = fm + ((wgid % nig) % gsz); u.pn = (wgid % nig) / gsz; u.aoff = (size_t)u.pm * ta; u.boff = (size_t)u.pn * tb; return true;
    }
    __device__ __forceinline__ void a_ready(const Unit&) const {}
    __device__ __forceinline__ void done(const Unit&) const {}
};

__device__ __forceinline__ unsigned cvt_pk_bf16(float lo, float hi) { unsigned r; asm volatile("v_cvt_pk_bf16_f32 %0, %1, %2" : "=v"(r) : "v"(lo), "v"(hi)); return r; }
typedef float f32x2 __attribute__((ext_vector_type(2)));

constexpr int GTAB = 135168 + 4096, GTAB_UNITS = 10;
template <class Epi, class Sched, bool ALIGN_EPI = false, bool SP2 = false, bool GATHER = false>
__device__ __forceinline__ void gemm_phase(PG8_LAS unsigned char* lds, const Gemm g, const Sched& S, const Epi& E) {
    const int tid = threadIdx.x, wid = __builtin_amdgcn_readfirstlane(tid >> 6), lane = tid & 63, wr = wid >> 2, wc = wid & 3, fr = lane & 15, fq = lane >> 4;
    static_assert(!GATHER || SP2, "GATHER is implemented for the SP2 loop only");
    const int K = g.K, nt = K / BK;
    unsigned voffA[2], voffB[2];
#pragma unroll
    for (int i = 0; i < 2; ++i) { int R, C; stage_rc(tid * 16 + i * 8192, R, C); const int Rb = Epi::PERM ? ((R & ~31) + perm32(R & 31)) : R;
        voffA[i] = (unsigned)(R * g.lda + C) * 2u; voffB[i] = (unsigned)(Rb * g.ldb + C) * 2u; }
    unsigned gidx[2], gcol[2];
#pragma unroll
    for (int i = 0; i < 2; ++i) { int R, C; stage_rc(tid * 16 + i * 8192, R, C); gidx[i] = (unsigned)R * 2u; gcol[i] = (unsigned)C * 2u; }
    const size_t kstep = (size_t)(BK * 2);
    const size_t hstepA = (size_t)HALF * g.lda * 2, hstepB = (size_t)HALF * g.ldb * 2;
    const unsigned ldsw = (unsigned)wid * 1024u;
    const int aoff = lds_byte(wr * 64 + fr, fq * 8), boff = lds_byte(wc * 32 + fr, fq * 8);
#define PG8_SA(b, h) (((b) * 2 + (h)) * HTB)
#define PG8_SB(b, h) ((4 + (b) * 2 + (h)) * HTB)
#define PG8_STAGE(bufoff, gbase, voff) do { _Pragma("unroll") for (int _i = 0; _i < 2; ++_i) \
        __builtin_amdgcn_global_load_lds((const unsigned*)((const char*)(gbase) + (voff)[_i]), (PG8_LAS unsigned*)(lds + (bufoff) + ldsw + _i * 8192), 16, 0, 0); } while (0)
#define PG8_GTOK(h, sel) do { if constexpr (GATHER) { tk0 = *(const PG8_LAS unsigned short*)(lds + GTAB + (sel) * 512 + (h) * 256 + gidx[0]); tk1 = *(const PG8_LAS unsigned short*)(lds + GTAB + (sel) * 512 + (h) * 256 + gidx[1]); } } while (0)
#define PG8_STAGE_A(bufoff, gbase, h, sel) do { if constexpr (GATHER) { \
        __builtin_amdgcn_global_load_lds((const unsigned*)((const char*)(gbase) + (size_t)tk0 * (size_t)(g.lda * 2) + gcol[0]), (PG8_LAS unsigned*)(lds + (bufoff) + ldsw), 16, 0, 0); \
        __builtin_amdgcn_global_load_lds((const unsigned*)((const char*)(gbase) + (size_t)tk1 * (size_t)(g.lda * 2) + gcol[1]), (PG8_LAS unsigned*)(lds + (bufoff) + ldsw + 8192), 16, 0, 0); } \
    else { PG8_STAGE(bufoff, (gbase) + (h) * hstepA, voffA); } } while (0)
#define PG8_LDA(dst, b, h) do { _Pragma("unroll") for (int m = 0; m < 4; ++m) _Pragma("unroll") for (int k = 0; k < 2; ++k) dst[m][k] = *(const PG8_LAS bf16x8*)(lds + PG8_SA(b, h) + aoff + m * 2048 + k * 1024); } while (0)
#define PG8_LDB(dst, b, h) do { _Pragma("unroll") for (int n = 0; n < 2; ++n) _Pragma("unroll") for (int k = 0; k < 2; ++k) dst[n][k] = *(const PG8_LAS bf16x8*)(lds + PG8_SB(b, h) + boff + n * 2048 + k * 1024); } while (0)
#define PG8_MMA(ai, bj, At, Bt) do { __builtin_amdgcn_s_setprio(1); _Pragma("unroll") for (int m = 0; m < 4; ++m) _Pragma("unroll") for (int n = 0; n < 2; ++n) _Pragma("unroll") for (int k = 0; k < 2; ++k) \
        acc[ai][bj][m][n] = __builtin_amdgcn_mfma_f32_16x16x32_bf16(Bt[n][k], At[m][k], acc[ai][bj][m][n], 0, 0, 0); __builtin_amdgcn_s_setprio(0); } while (0)
#define PG8_WAIT_V(n) asm volatile("s_waitcnt vmcnt(" #n ")" ::: "memory")
#define PG8_WAIT_L(n) asm volatile("s_waitcnt lgkmcnt(" #n ")" ::: "memory")
#define PG8_BAR __builtin_amdgcn_s_barrier()
#define PG8_SCHED __builtin_amdgcn_sched_barrier(0)
    Unit cur, nxt; int ui = 0; unsigned tk0 = 0, tk1 = 0; (void)tk0; (void)tk1;
    if (!S.next(0, cur)) return;
    f32x4 acc[2][2][4][2];
#pragma unroll
    for (int a = 0; a < 2; ++a)
#pragma unroll
        for (int b = 0; b < 2; ++b)
#pragma unroll
            for (int m = 0; m < 4; ++m)
#pragma unroll
                for (int n = 0; n < 2; ++n) acc[a][b][m][n] = (f32x4){0.f, 0.f, 0.f, 0.f};
    bf16x8 At[4][2], B0[2][2], B1[2][2];
    const char* cA = (const char*)g.A + (GATHER ? (size_t)0 : cur.aoff); const char* cB = (const char*)g.Bt + cur.boff;
    S.a_ready(cur);
    if constexpr (SP2) {
        PG8_STAGE(PG8_SB(0, 0), cB, voffB); PG8_STAGE(PG8_SB(0, 1), cB + hstepB, voffB); PG8_GTOK(0, ui); PG8_STAGE_A(PG8_SA(0, 0), cA, 0, ui); PG8_GTOK(1, ui); PG8_STAGE_A(PG8_SA(0, 1), cA, 1, ui);
        if (wr == 1) PG8_BAR;
        PG8_WAIT_V(2); PG8_BAR;
        PG8_STAGE(PG8_SB(1, 0), cB + kstep, voffB); PG8_GTOK(0, ui); PG8_STAGE_A(PG8_SA(1, 0), cA + kstep, 0, ui); PG8_STAGE(PG8_SB(1, 1), cB + hstepB + kstep, voffB);
        PG8_WAIT_V(6); PG8_BAR;
    } else {
        PG8_STAGE(PG8_SB(0, 0), cB, voffB); PG8_STAGE_A(PG8_SA(0, 0), cA, 0, ui); PG8_STAGE(PG8_SB(0, 1), cB + hstepB, voffB); PG8_STAGE_A(PG8_SA(0, 1), cA, 1, ui);
        if (wr == 1) PG8_BAR;
        PG8_WAIT_V(4); PG8_BAR;
        PG8_STAGE(PG8_SB(1, 0), cB + kstep, voffB); PG8_STAGE_A(PG8_SA(1, 0), cA + kstep, 0, ui); PG8_STAGE(PG8_SB(1, 1), cB + hstepB + kstep, voffB);
        PG8_WAIT_V(6); PG8_BAR;
    }
    for (;;) {
        const bool has_next = S.next(ui + 1, nxt);
        const char* nA = has_next ? (const char*)g.A + (GATHER ? (size_t)0 : nxt.aoff) : cA; const char* nB = has_next ? (const char*)g.Bt + nxt.boff : cB;
        for (int t = 0; t < nt; t += 2) {
            const bool last = (t == nt - 2);
            const char* a1 = cA + (size_t)(t + 1) * kstep;
            const char* a2 = last ? nA : cA + (size_t)(t + 2) * kstep; const char* b2 = last ? nB : cB + (size_t)(t + 2) * kstep;
            const char* a3 = a2 + kstep; const char* b3 = b2 + kstep; const int ui2 = (last && has_next) ? ui + 1 : ui; (void)ui2;
            if (last && has_next) S.a_ready(nxt);
            if constexpr (SP2) {
            PG8_GTOK(1, ui); PG8_LDB(B0, 0, 0); PG8_LDB(B1, 0, 1); PG8_SCHED; PG8_LDA(At, 0, 0); PG8_STAGE_A(PG8_SA(1, 1), a1, 1, ui);
            PG8_WAIT_V(8); PG8_WAIT_L(0); PG8_BAR; PG8_MMA(0, 0, At, B0); PG8_MMA(0, 1, At, B1); PG8_BAR; PG8_SCHED;
            PG8_GTOK(0, ui2); PG8_LDA(At, 0, 1); PG8_STAGE(PG8_SB(0, 0), b2, voffB); PG8_STAGE(PG8_SB(0, 1), b2 + hstepB, voffB); PG8_STAGE_A(PG8_SA(0, 0), a2, 0, ui2);
            PG8_WAIT_V(8); PG8_WAIT_L(0); PG8_BAR; PG8_MMA(1, 0, At, B0); PG8_MMA(1, 1, At, B1); PG8_BAR; PG8_SCHED;
            PG8_GTOK(1, ui2); PG8_LDB(B0, 1, 0); PG8_LDB(B1, 1, 1); PG8_SCHED; PG8_LDA(At, 1, 0); PG8_STAGE_A(PG8_SA(0, 1), a2, 1, ui2);
            PG8_WAIT_V(8); PG8_WAIT_L(0); PG8_BAR; PG8_MMA(0, 0, At, B0); PG8_MMA(0, 1, At, B1); PG8_BAR; PG8_SCHED;
            PG8_GTOK(0, ui2); PG8_LDA(At, 1, 1); PG8_STAGE(PG8_SB(1, 0), b3, voffB); PG8_STAGE(PG8_SB(1, 1), b3 + hstepB, voffB); PG8_STAGE_A(PG8_SA(1, 0), a3, 0, ui2);
            PG8_WAIT_V(8); PG8_WAIT_L(0); PG8_BAR; PG8_MMA(1, 0, At, B0); PG8_MMA(1, 1, At, B1); PG8_BAR; PG8_SCHED;
            } else {
            PG8_LDB(B0, 0, 0); PG8_SCHED; PG8_LDA(At, 0, 0); PG8_STAGE_A(PG8_SA(1, 1), a1, 1, ui);
            PG8_WAIT_L(8); PG8_BAR; PG8_WAIT_L(0); PG8_MMA(0, 0, At, B0); PG8_BAR; PG8_SCHED;
            PG8_LDB(B1, 0, 1); PG8_STAGE(PG8_SB(0, 0), b2, voffB);
            PG8_BAR; PG8_WAIT_L(0); PG8_MMA(0, 1, At, B1); PG8_BAR;
            PG8_LDA(At, 0, 1); PG8_STAGE_A(PG8_SA(0, 0), a2, 0, ui2);
            PG8_BAR; PG8_WAIT_L(0); PG8_MMA(1, 0, At, B0); PG8_BAR; PG8_SCHED;
            PG8_STAGE(PG8_SB(0, 1), b2 + hstepB, voffB);
            PG8_WAIT_V(6); PG8_BAR; PG8_MMA(1, 1, At, B1); PG8_BAR;
            PG8_LDB(B0, 1, 0); PG8_SCHED; PG8_LDA(At, 1, 0); PG8_STAGE_A(PG8_SA(0, 1), a2, 1, ui2);
            PG8_WAIT_L(8); PG8_BAR; PG8_WAIT_L(0); PG8_MMA(0, 0, At, B0); PG8_BAR; PG8_SCHED;
            PG8_LDB(B1, 1, 1); PG8_STAGE(PG8_SB(1, 0), b3, voffB);
            PG8_BAR; PG8_WAIT_L(0); PG8_MMA(0, 1, At, B1); PG8_BAR;
            PG8_LDA(At, 1, 1); PG8_STAGE_A(PG8_SA(1, 0), a3, 0, ui2);
            PG8_BAR; PG8_WAIT_L(0); PG8_MMA(1, 0, At, B0); PG8_BAR; PG8_SCHED;
            PG8_STAGE(PG8_SB(1, 1), b3 + hstepB, voffB);
            PG8_WAIT_V(6); PG8_BAR; PG8_MMA(1, 1, At, B1); PG8_BAR;
            }
        }
        if constexpr (ALIGN_EPI) { if (wr == 0) PG8_BAR; }
        if constexpr (!Epi::AFTER_DRAIN) { E(acc, cur, wr, wc, fr, fq); S.done(cur); }
        if (!has_next) break;
#pragma unroll
        for (int a = 0; a < 2; ++a)
#pragma unroll
            for (int b = 0; b < 2; ++b)
#pragma unroll
                for (int m = 0; m < 4; ++m)
#pragma unroll
                    for (int n = 0; n < 2; ++n) acc[a][b][m][n] = (f32x4){0.f, 0.f, 0.f, 0.f};
        cur = nxt; cA = nA; cB = nB; ++ui;
        if constexpr (ALIGN_EPI) { if (wr == 1) PG8_BAR; }
    }
    PG8_WAIT_V(0);
    if constexpr (!ALIGN_EPI) { if (wr == 0) PG8_BAR; }
    PG8_BAR;
    if constexpr (Epi::AFTER_DRAIN) { E.fused(acc, cur, wr, wc, fr, fq, lds, wid, lane); S.done(cur); }
#undef PG8_SA
#undef PG8_SB
#undef PG8_STAGE
#undef PG8_STAGE_A
#undef PG8_GTOK
#undef PG8_LDA
#undef PG8_LDB
#undef PG8_MMA
#undef PG8_WAIT_V
#undef PG8_WAIT_L
#undef PG8_BAR
#undef PG8_SCHED
}
}
namespace mla {
using bf16x8 = __attribute__((ext_vector_type(8))) short;
using s16x4  = __attribute__((ext_vector_type(4))) short;
using f32x16 = __attribute__((ext_vector_type(16))) float;
using u32x4  = __attribute__((ext_vector_type(4))) unsigned;
constexpr int NW = 8, QBLK = 32, KVBLK = 64;
constexpr float SCALE = 0.10206207261596577f;
constexpr float THR = 8.f;
constexpr int SHM_V = KVBLK * 64 * 2, SHM_K = KVBLK * 256;
constexpr int SHM_ATTN = 4 * SHM_V + 4 * SHM_K + NW * 64 * 4;
#define KSWZ(row, colB) ((row) * 256 + ((colB) ^ (((row) & 7) << 4)))
#define SBAR() __builtin_amdgcn_sched_barrier(0)
__device__ __forceinline__ int crow(int r, int hi) { return (r & 3) + 8 * (r >> 2) + 4 * hi; }
__device__ __forceinline__ unsigned cvtpk(float lo, float hi) { unsigned r; asm volatile("v_cvt_pk_bf16_f32 %0, %1, %2" : "=v"(r) : "v"(lo), "v"(hi)); return r; }

__device__ __forceinline__ float max3f(float a, float b, float c) { return __builtin_fmaxf(__builtin_fmaxf(a, b), c); }
template <int ABL> __device__ __forceinline__ void partialSM(f32x16& p0, f32x16& p1, float& m_reg, float& alpha, bool first) {
  float a = max3f(p0[0], p0[1], p0[2]), b = max3f(p0[3], p1[0], p1[1]), c = max3f(p1[2], p1[3], p0[4]), d = max3f(p0[5], p0[6], p0[7]);
  a = max3f(a, p1[4], p1[5]); b = max3f(b, p1[6], p1[7]);
#pragma unroll
  for (int r = 8; r < 16; r += 4) { a = max3f(a, p0[r], p0[r + 1]); b = max3f(b, p0[r + 2], p0[r + 3]); c = max3f(c, p1[r], p1[r + 1]); d = max3f(d, p1[r + 2], p1[r + 3]); }
  float pmax = fmaxf(fmaxf(a, b), fmaxf(c, d));
  { auto rr = __builtin_amdgcn_permlane32_swap(__float_as_uint(pmax), __float_as_uint(pmax), false, false);
    pmax = fmaxf(__uint_as_float(rr[0]), __uint_as_float(rr[1])); }
  if (__builtin_expect(!first && __all(pmax - m_reg <= THR * 1.4426950408889634f), 1)) { alpha = 1.f; }
  else { const float mn = first ? pmax : fmaxf(m_reg, pmax); alpha = first ? 1.f : __builtin_amdgcn_exp2f(m_reg - mn); m_reg = mn; }
#pragma unroll
  for (int r = 0; r < 16; ++r) { p0[r] -= m_reg; p1[r] -= m_reg; }
#pragma unroll
  for (int r = 0; r < 16; ++r) p0[r] = (ABL & 2) ? p0[r] * 0.5f : __builtin_amdgcn_exp2f(p0[r]);
}
template <int ABL> __device__ __forceinline__ void finishSM(f32x16& p0, f32x16& p1, float alpha, float& l_reg, bf16x8& pa0, bf16x8& pa1, bf16x8& pa2, bf16x8& pa3) {
#pragma unroll
  for (int r = 0; r < 16; ++r) p1[r] = (ABL & 2) ? p1[r] * 0.5f : __builtin_amdgcn_exp2f(p1[r]);
  float ps, s0 = 0.f, s1 = 0.f, s2 = 0.f, s3 = 0.f;
#pragma unroll
  for (int r = 0; r < 16; r += 4) { s0 += p0[r]; s1 += p0[r + 1]; s2 += p0[r + 2]; s3 += p0[r + 3]; }
#pragma unroll
  for (int r = 0; r < 16; r += 4) { s0 += p1[r]; s1 += p1[r + 1]; s2 += p1[r + 2]; s3 += p1[r + 3]; }
  ps = (s0 + s1) + (s2 + s3);
  { auto rr = __builtin_amdgcn_permlane32_swap(__float_as_uint(ps), __float_as_uint(ps), false, false);
    ps = __uint_as_float(rr[0]) + __uint_as_float(rr[1]); }
  l_reg = l_reg * alpha + ps;
#define PK4(P, BASE, OUT) do { u32x4 w = {cvtpk(P[BASE + 0], P[BASE + 1]), cvtpk(P[BASE + 2], P[BASE + 3]), cvtpk(P[BASE + 4], P[BASE + 5]), cvtpk(P[BASE + 6], P[BASE + 7])}; \
    OUT = *reinterpret_cast<bf16x8*>(&w); } while (0)
  PK4(p0, 0, pa0); PK4(p0, 8, pa1); PK4(p1, 0, pa2); PK4(p1, 8, pa3);
#undef PK4
}
__device__ __forceinline__ void qkt(f32x16& p0, f32x16& p1, const char* Ks, const bf16x8* qr, int r32, int hi) {
  p0 = f32x16{}; p1 = f32x16{};
#pragma unroll
  for (int d0 = 0; d0 < 6; ++d0) { int cb = (d0 * 16 + hi * 8) * 2;
    bf16x8 b0 = *reinterpret_cast<const bf16x8*>(Ks + KSWZ(r32, cb));
    bf16x8 b1 = *reinterpret_cast<const bf16x8*>(Ks + KSWZ(32 + r32, cb));
    p0 = __builtin_amdgcn_mfma_f32_32x32x16_bf16(b0, qr[d0], p0, 0, 0, 0);
    p1 = __builtin_amdgcn_mfma_f32_32x32x16_bf16(b1, qr[d0], p1, 0, 0, 0); }
}
__device__ __forceinline__ int v_st(int k, int c) { const int kk = k;
  return ((kk >> 3) * 2 + (c >> 5)) * 512 + ((kk & 7) * 32 + (c & 31)) * 2; }
__device__ __forceinline__ int v_rd_base(int lane) { return ((lane & 3) << 3) | (((lane >> 2) & 3) << 6) | (((lane >> 4) & 1) << 5) | (((lane >> 5) & 1) << 8); }
constexpr int v_rd_off(int d0, int ks, int half) { return d0 * 512 + ks * 2048 + half * 1024; }
template <int OFF> __device__ __forceinline__ s16x4 tr_read(int vb) {
  s16x4 r; asm volatile("ds_read_b64_tr_b16 %0, %1 offset:%2" : "=&v"(r) : "v"(vb), "i"(OFF) : "memory"); return r;
}
#define PK(L, H) (bf16x8){L[0], L[1], L[2], L[3], H[0], H[1], H[2], H[3]}
#define PV_RD(KS, LA, HA, LB, HB) do { LA = tr_read<v_rd_off(0, KS, 0)>(vb); HA = tr_read<v_rd_off(0, KS, 1)>(vb); LB = tr_read<v_rd_off(1, KS, 0)>(vb); HB = tr_read<v_rd_off(1, KS, 1)>(vb); } while (0)
#define PV_MM(PA, LA, HA, LB, HB) do { o[0] = __builtin_amdgcn_mfma_f32_32x32x16_bf16(PA, PK(LA, HA), o[0], 0, 0, 0); o[1] = __builtin_amdgcn_mfma_f32_32x32x16_bf16(PA, PK(LB, HB), o[1], 0, 0, 0); } while (0)
__device__ __forceinline__ void pv_d0(f32x16* o, int vb, bf16x8 pa0, bf16x8 pa1, bf16x8 pa2, bf16x8 pa3) {
  s16x4 la, ha, lb, hb, lc, hc, ld, hd;
  PV_RD(0, la, ha, lb, hb);
  PV_RD(1, lc, hc, ld, hd);
  asm volatile("s_waitcnt lgkmcnt(4)" ::: "memory"); SBAR();
  PV_MM(pa0, la, ha, lb, hb); SBAR();
  PV_RD(2, la, ha, lb, hb);
  asm volatile("s_waitcnt lgkmcnt(4)" ::: "memory"); SBAR();
  PV_MM(pa1, lc, hc, ld, hd); SBAR();
  PV_RD(3, lc, hc, ld, hd);
  asm volatile("s_waitcnt lgkmcnt(4)" ::: "memory"); SBAR();
  PV_MM(pa2, la, ha, lb, hb); SBAR();
  asm volatile("s_waitcnt lgkmcnt(0)" ::: "memory"); SBAR();
  PV_MM(pa3, lc, hc, ld, hd);
}
#undef PV_MM
#undef PV_RD
#undef PK
__device__ __forceinline__ float bf2f_(short b) { return __builtin_bit_cast(float, (unsigned)(unsigned short)b << 16); }

template <int ABL> __device__ __forceinline__ void mla_unit(const unsigned short* __restrict__ Qg, const unsigned short* __restrict__ Kn, const unsigned short* __restrict__ Kpe, const unsigned short* __restrict__ Vg,
                                         const float* __restrict__ cs, unsigned short* __restrict__ Og, int q0, int krow0, int h, int seq, char* lds) {
  const int tid = threadIdx.x, wid = __builtin_amdgcn_readfirstlane(tid >> 6), lane = tid & 63, r32 = lane & 31, hi = lane >> 5;
  char* V_lds = lds; char* K_lds = lds + 4 * SHM_V;
  float* ws = (float*)(lds + 4 * SHM_V + 4 * SHM_K) + wid * 64; float* li_l = ws; float* al_l = ws + 32;
  float m_reg = 0.f, l_reg = 0; f32x16 o[2] = {}; bf16x8 qr[6];
  {
    const int qrow = q0 + wid * QBLK + r32;
    const unsigned short* Qw = Qg + (size_t)qrow * 768 + h * 96 + hi * 8;
#pragma unroll
    for (int d0 = 0; d0 < 6; ++d0) qr[d0] = *reinterpret_cast<const bf16x8*>(Qw + d0 * 16);
    const float* cr = cs + (size_t)qrow * 32 + hi * 8;
    bf16x8 a = qr[4], b = qr[5]; u32x4 wa, wb; float n1[8], n2[8];
#pragma unroll
    for (int e = 0; e < 8; ++e) { const float c_ = cr[e], s_ = cr[16 + e]; const float x1 = bf2f_(a[e]), x2 = bf2f_(b[e]); n1[e] = x1 * c_ - x2 * s_; n2[e] = x1 * s_ + x2 * c_; }
    wa = (u32x4){cvtpk(n1[0], n1[1]), cvtpk(n1[2], n1[3]), cvtpk(n1[4], n1[5]), cvtpk(n1[6], n1[7])};
    wb = (u32x4){cvtpk(n2[0], n2[1]), cvtpk(n2[2], n2[3]), cvtpk(n2[4], n2[5]), cvtpk(n2[6], n2[7])};
    qr[4] = *reinterpret_cast<bf16x8*>(&wa); qr[5] = *reinterpret_cast<bf16x8*>(&wb);
  }
  const int sk = tid >> 3, sc = (tid & 7) * 8, rk = (tid & 255) >> 2, rc = (tid & 3) * 8;
  const int vst = v_st(sk, sc), kst = KSWZ(sk, sc * 2), rst = KSWZ(rk, (64 + rc) * 2);
  const int vb0 = (int)(uintptr_t)V_lds + v_rd_base(lane);
  const unsigned short* Vh = Vg + (size_t)krow0 * 512 + h * 64; const unsigned short* Kh = Kn + (size_t)krow0 * 512 + h * 64; const unsigned short* Rh = Kpe + (size_t)krow0 * 32;
  struct { bf16x8 vs, ks, rs; } sr_[2];
#define SLOAD(i, k0) do { sr_[i].vs = *reinterpret_cast<const bf16x8*>(&Vh[(size_t)((k0) + sk) * 512 + sc]); sr_[i].ks = *reinterpret_cast<const bf16x8*>(&Kh[(size_t)((k0) + sk) * 512 + sc]); \
    sr_[i].rs = *reinterpret_cast<const bf16x8*>(&Rh[(size_t)((k0) + rk) * 32 + rc]); } while (0)
#define SWRITE(b, i) do { *(bf16x8*)(V_lds + (b) * SHM_V + vst) = sr_[i].vs; *(bf16x8*)(K_lds + (b) * SHM_K + kst) = sr_[i].ks; *(bf16x8*)(K_lds + (b) * SHM_K + rst) = sr_[i].rs; } while (0)
#define RESC(a) do { if (__any((a) < 1.f)) { if (hi == 0) al_l[r32] = (a); asm volatile("s_waitcnt lgkmcnt(0)" ::: "memory"); \
    _Pragma("unroll") for (int d = 0; d < 2; ++d) _Pragma("unroll") for (int r = 0; r < 16; ++r) o[d][r] *= al_l[crow(r, hi)]; } } while (0)
#define EBAR() do { asm volatile("s_waitcnt lgkmcnt(0)" ::: "memory"); __builtin_amdgcn_s_barrier(); asm volatile("" ::: "memory"); } while (0)
  f32x16 p0, p1; float al; bf16x8 pa0, pa1, pa2, pa3; const int NT = seq / KVBLK;
  pa0 = pa1 = pa2 = pa3 = bf16x8{};
  SLOAD(0, 0); SLOAD(1, KVBLK); asm volatile("s_waitcnt vmcnt(0)" ::: "memory"); SWRITE(0, 0); SWRITE(1, 1);
  if (2 < NT) SLOAD(0, 2 * KVBLK);
  EBAR();
  if (wid >= 4) EBAR();
  for (int t = 0; t < NT; ++t) {
    SBAR(); qkt(p0, p1, K_lds + (t & 3) * SHM_K, qr, r32, hi); SBAR();
    if (t > 0) pv_d0(o, vb0 + ((t - 1) & 3) * SHM_V, pa0, pa1, pa2, pa3);
    EBAR();
    partialSM<ABL>(p0, p1, m_reg, al, t == 0);
    RESC(al);
    finishSM<ABL>(p0, p1, al, l_reg, pa0, pa1, pa2, pa3);
    if (t + 2 < NT) { asm volatile("s_waitcnt vmcnt(0)" ::: "memory"); SWRITE((t + 2) & 3, 0); }
    if (t + 3 < NT) SLOAD(0, (t + 3) * KVBLK);
    EBAR();
  }
  SBAR(); pv_d0(o, vb0 + ((NT - 1) & 3) * SHM_V, pa0, pa1, pa2, pa3);
  if (wid < 4) EBAR();
#undef EBAR
  if (hi == 0) li_l[r32] = l_reg; asm volatile("s_waitcnt lgkmcnt(0)" ::: "memory");
  float rli[16];
#pragma unroll
  for (int r = 0; r < 16; ++r) rli[r] = __builtin_amdgcn_rcpf(li_l[crow(r, hi)]);
  unsigned short* Ow = Og + (size_t)(q0 + wid * QBLK) * 512 + h * 64;
#pragma unroll
  for (int r = 0; r < 16; ++r) { int orow = crow(r, hi);
#pragma unroll
    for (int d0 = 0; d0 < 2; ++d0) Ow[(size_t)orow * 512 + d0 * 32 + r32] = (unsigned short)cvtpk(o[d0][r] * rli[r], 0.f); }
  __syncthreads();
#undef SLOAD
#undef SWRITE
#undef RESC
}
#undef KSWZ
#undef SBAR
}

namespace dil {
using bf16x8 = __attribute__((ext_vector_type(8))) short;
using s16x4  = __attribute__((ext_vector_type(4))) short;
using f32x16 = __attribute__((ext_vector_type(16))) float;
using u32x4  = __attribute__((ext_vector_type(4))) unsigned;
constexpr int TBL_PITCH = 2112;
constexpr int W_TBL = 0, W_K = 8448, W_V = 8448 + 4096, W_POS = 8448 + 8192, W_AL = W_POS + 128, W_BYTES = W_AL + 128;
__device__ __forceinline__ int crow(int r, int hi) { return (r & 3) + 8 * (r >> 2) + 4 * hi; }
__device__ __forceinline__ unsigned cvtpk(float lo, float hi) { unsigned r; asm volatile("v_cvt_pk_bf16_f32 %0, %1, %2" : "=v"(r) : "v"(lo), "v"(hi)); return r; }
#define DKSWZ(row, colB) ((row) * 128 + ((colB) ^ (((row) & 7) << 4)))
__device__ __forceinline__ int v_st(int k, int c) { const int kk = k;
  return ((kk >> 3) * 2 + (c >> 5)) * 512 + ((kk & 7) * 32 + (c & 31)) * 2; }
__device__ __forceinline__ int v_rd_base(int lane) { return ((lane & 3) << 3) | (((lane >> 2) & 3) << 6) | (((lane >> 4) & 1) << 5) | (((lane >> 5) & 1) << 8); }
constexpr int v_rd_off(int d0, int ks, int half) { return d0 * 512 + ks * 2048 + half * 1024; }
template <int OFF> __device__ __forceinline__ s16x4 tr_read(int vb) {
  s16x4 r; asm volatile("ds_read_b64_tr_b16 %0, %1 offset:%2" : "=&v"(r) : "v"(vb), "i"(OFF) : "memory"); return r;
}
template <int D0> __device__ __forceinline__ void pv_one(f32x16& od, int vb, bf16x8 pa0, bf16x8 pa1) {
  const s16x4 l0 = tr_read<v_rd_off(D0, 0, 0)>(vb), h0 = tr_read<v_rd_off(D0, 0, 1)>(vb), l1 = tr_read<v_rd_off(D0, 1, 0)>(vb), h1 = tr_read<v_rd_off(D0, 1, 1)>(vb);
  asm volatile("s_waitcnt lgkmcnt(0)" ::: "memory"); __builtin_amdgcn_sched_barrier(0);
#define PK(L, H) (bf16x8){L[0], L[1], L[2], L[3], H[0], H[1], H[2], H[3]}
  od = __builtin_amdgcn_mfma_f32_32x32x16_bf16(pa0, PK(l0, h0), od, 0, 0, 0);
  od = __builtin_amdgcn_mfma_f32_32x32x16_bf16(pa1, PK(l1, h1), od, 0, 0, 0);
#undef PK
}
struct KVRegs { bf16x8 k[4], v[4]; int pk; };
struct TaskId { int b, h, g, r, ub; };
__device__ __forceinline__ TaskId task_at(int i, int bx, int G, int wave) {
  TaskId t; int bh, k; t.b = 0; t.h = 0; t.g = 0; t.r = 0; t.ub = -1;
  if (G == 256) { if (i >= 6) return t; bh = (bx & 7) + 8 * (bx >> 6); k = ((((bx >> 3) & 7) * 6 + i) << 3) + wave; }
  else { const int id = (i * G + bx) * 8 + wave; if (id >= 12288) return t; bh = id / 384; k = id % 384; }
  const int g = k >> 7, kk = k & 127, nub = g == 0 ? 128 : (g == 1 ? 32 : 8);
  t.b = bh >> 3; t.h = bh & 7; t.g = g; t.r = kk / nub; t.ub = kk % nub; return t;
}
struct Pre { bf16x8 qr[4]; int pos_q; KVRegs R; };
__device__ __forceinline__ void load_blk(const unsigned short* __restrict__ qkv, const int* __restrict__ pos, const TaskId& t, int kb, KVRegs& R) {
  const int lane = threadIdx.x & 63, r32 = lane & 31, srow = lane >> 1, shalf = (lane & 1) * 32;
  const int dl = t.g == 0 ? 1 : (t.g == 1 ? 4 : 16), L = S / dl; const size_t rowb = (size_t)t.b * S;
  int up = 32 * (t.ub - 2 + kb) + srow; up = up < 0 ? 0 : (up >= L ? L - 1 : up);
  const unsigned short* base = qkv + (rowb + t.r + dl * up) * 1536 + t.h * 64 + shalf;
#pragma unroll
  for (int c = 0; c < 4; ++c) { R.k[c] = *reinterpret_cast<const bf16x8*>(base + 512 + c * 8); R.v[c] = *reinterpret_cast<const bf16x8*>(base + 1024 + c * 8); }
  int upl = 32 * (t.ub - 2 + kb) + r32; upl = upl < 0 ? 0 : (upl >= L ? L - 1 : upl);
  R.pk = pos[rowb + t.r + dl * upl];
}
__device__ __forceinline__ int kb_first(const TaskId& t) { return (t.ub >= 2) ? 0 : (2 - t.ub); }
__device__ __forceinline__ void dil_prefetch(const unsigned short* __restrict__ qkv, const int* __restrict__ pos, const TaskId& t, Pre& P) {
  const int lane = threadIdx.x & 63, r32 = lane & 31, hi = lane >> 5;
  const int dl = t.g == 0 ? 1 : (t.g == 1 ? 4 : 16); const size_t rowb = (size_t)t.b * S; const int tok_q = t.r + dl * (32 * t.ub + r32);
  const unsigned short* Qw = qkv + (rowb + tok_q) * 1536 + t.h * 64 + hi * 8;
#pragma unroll
  for (int d0 = 0; d0 < 4; ++d0) P.qr[d0] = *reinterpret_cast<const bf16x8*>(Qw + d0 * 16);
  P.pos_q = pos[rowb + tok_q];
  load_blk(qkv, pos, t, kb_first(t), P.R);
}
__device__ __forceinline__ void dil_task(const unsigned short* __restrict__ qkv, const int* __restrict__ pos, unsigned short* __restrict__ oap, float* __restrict__ lse,
                                         const TaskId t, Pre& P, bool has_next, const TaskId tn, char* wl  ) {
  const int lane = threadIdx.x & 63, r32 = lane & 31, hi = lane >> 5;
  const int b = t.b, h = t.h, g = t.g, r = t.r, ub = t.ub;
  const int dl = g == 0 ? 1 : (g == 1 ? 4 : 16), L = S / dl;
  const int u_q = 32 * ub + r32;
  const size_t rowb = (size_t)b * S;
  const int tok_q = r + dl * u_q;
  const float* tblw = (const float*)(wl + W_TBL); int* posw = (int*)(wl + W_POS); float* alw = (float*)(wl + W_AL);
  bf16x8 qr[4];
#pragma unroll
  for (int d0 = 0; d0 < 4; ++d0) qr[d0] = P.qr[d0];
  const int pos_q = P.pos_q;
  const int srow = lane >> 1, shalf = (lane & 1) * 32;
  const int vb0 = (int)(uintptr_t)(wl + W_V) + v_rd_base(lane);
  float m_reg = -1e30f, l_reg = 0.f; f32x16 o[2] = {};
  const int kb_lo = kb_first(t), kb_hi = (32 * (ub + 3) <= L) ? 4 : (4 - ((32 * (ub + 3) - L) >> 5));
  KVRegs R = P.R;
  for (int kb = kb_lo; kb <= kb_hi; ++kb) {
#pragma unroll
    for (int c = 0; c < 4; ++c) {
      *(bf16x8*)(wl + W_K + DKSWZ(srow, (shalf + c * 8) * 2)) = R.k[c];
      *(bf16x8*)(wl + W_V + v_st(srow, shalf + c * 8)) = R.v[c];
    }
    if (hi == 0) posw[r32] = R.pk;
    if (kb < kb_hi) load_blk(qkv, pos, t, kb + 1, R);
    asm volatile("s_waitcnt lgkmcnt(0)" ::: "memory"); __builtin_amdgcn_sched_barrier(0);
    f32x16 p = {};
#pragma unroll
    for (int d0 = 0; d0 < 4; ++d0) {
      const bf16x8 kf = *reinterpret_cast<const bf16x8*>(wl + W_K + DKSWZ(r32, (d0 * 16 + hi * 8) * 2));
      p = __builtin_amdgcn_mfma_f32_32x32x16_bf16(kf, qr[d0], p, 0, 0, 0);
    }
    float bmax;
    if (kb == 0 || kb == 4) {
      bmax = -INFINITY;
#pragma unroll
      for (int rr = 0; rr < 16; ++rr) {
        const int kk = crow(rr, hi);
        const bool valid = kb == 0 ? (kk >= r32) : (kk <= r32);
        int rel = posw[kk] - pos_q; rel = rel < -1024 ? -1024 : (rel > 1024 ? 1024 : rel); const int idx = rel + 1024;
        const float sv = valid ? (p[rr] + tblw[idx ^ ((idx >> 5) & 31)]) : -INFINITY;
        p[rr] = sv; bmax = fmaxf(bmax, sv);
      }
    } else {
#pragma unroll
      for (int rr = 0; rr < 16; ++rr) {
        const int kk = crow(rr, hi);
        int rel = posw[kk] - pos_q; rel = rel < -1024 ? -1024 : (rel > 1024 ? 1024 : rel); const int idx = rel + 1024;
        p[rr] += tblw[idx ^ ((idx >> 5) & 31)];
      }
      bmax = fmaxf(fmaxf(p[0], p[1]), fmaxf(p[2], p[3]));
#pragma unroll
      for (int rr = 4; rr < 16; rr += 4) bmax = fmaxf(bmax, fmaxf(fmaxf(p[rr], p[rr + 1]), fmaxf(p[rr + 2], p[rr + 3])));
    }
    { auto x = __builtin_amdgcn_permlane32_swap(__float_as_uint(bmax), __float_as_uint(bmax), false, false); bmax = fmaxf(__uint_as_float(x[0]), __uint_as_float(x[1])); }
    float alpha = 1.f; bool resc = false;
    if (!__all(bmax - m_reg <= 11.5f)) { const float mn = fmaxf(m_reg, bmax); alpha = __builtin_amdgcn_exp2f(m_reg - mn); m_reg = mn; resc = true; }
    float ps = 0.f;
#pragma unroll
    for (int rr = 0; rr < 16; ++rr) p[rr] = __builtin_amdgcn_exp2f(p[rr] - m_reg);
    ps = ((p[0] + p[1]) + (p[2] + p[3])) + ((p[4] + p[5]) + (p[6] + p[7])) + (((p[8] + p[9]) + (p[10] + p[11])) + ((p[12] + p[13]) + (p[14] + p[15])));
    { auto x = __builtin_amdgcn_permlane32_swap(__float_as_uint(ps), __float_as_uint(ps), false, false); ps = __uint_as_float(x[0]) + __uint_as_float(x[1]); }
    l_reg = l_reg * alpha + ps;
    if (resc && kb != kb_lo) {
      if (hi == 0) alw[r32] = alpha;
      asm volatile("s_waitcnt lgkmcnt(0)" ::: "memory");
#pragma unroll
      for (int d = 0; d < 2; ++d)
#pragma unroll
        for (int rr = 0; rr < 16; ++rr) o[d][rr] *= alw[crow(rr, hi)];
    }
    bf16x8 pa0, pa1;
#define PK4(P, BASE, OUT) do { u32x4 w = {cvtpk(P[BASE + 0], P[BASE + 1]), cvtpk(P[BASE + 2], P[BASE + 3]), cvtpk(P[BASE + 4], P[BASE + 5]), cvtpk(P[BASE + 6], P[BASE + 7])}; \
    OUT = *reinterpret_cast<bf16x8*>(&w); } while (0)
    PK4(p, 0, pa0); PK4(p, 8, pa1);
#undef PK4
    pv_one<0>(o[0], vb0, pa0, pa1); pv_one<1>(o[1], vb0, pa0, pa1);
  }
  if (has_next) dil_prefetch(qkv, pos, tn, P);
  float* liw = alw;
  if (hi == 0) liw[r32] = l_reg;
  asm volatile("s_waitcnt lgkmcnt(0)" ::: "memory");
  if (hi == 0) lse[((size_t)g * T + rowb + tok_q) * 8 + h] = (m_reg + __log2f(l_reg)) * 0.6931471805599453f;
  unsigned short* Ow = oap + ((size_t)g * T + rowb + r + (size_t)dl * 32 * ub) * 512 + h * 64;
#pragma unroll
  for (int rr = 0; rr < 16; ++rr) { const int orow = crow(rr, hi); const float rl = __builtin_amdgcn_rcpf(liw[orow]);
#pragma unroll
    for (int d0 = 0; d0 < 2; ++d0) Ow[(size_t)orow * dl * 512 + d0 * 32 + r32] = (unsigned short)cvtpk(o[d0][rr] * rl, 0.f); }
  asm volatile("s_waitcnt lgkmcnt(0)" ::: "memory");
}
#undef DKSWZ
}

namespace mk {
#define GAS __attribute__((address_space(1)))
#define LAS __attribute__((address_space(3)))
typedef unsigned short bf16_t;
typedef unsigned v4u __attribute__((ext_vector_type(4)));
typedef unsigned v2u __attribute__((ext_vector_type(2)));
typedef float f32x4 __attribute__((ext_vector_type(4)));
#define LDS_WAIT() asm volatile("s_waitcnt lgkmcnt(0)" ::: "memory")
#define VM_WAIT() asm volatile("s_waitcnt vmcnt(0)" ::: "memory")
__device__ __forceinline__ unsigned f2bf(float f) { unsigned u = __builtin_bit_cast(unsigned, f); return (u + 0x7fffu + ((u >> 16) & 1u)) >> 16; }
__device__ __forceinline__ unsigned pk2(float lo, float hi) { return f2bf(lo) | (f2bf(hi) << 16); }
__device__ __forceinline__ float bf2f(unsigned short b) { return __builtin_bit_cast(float, (unsigned)b << 16); }
__device__ __forceinline__ float wave_sum(float v) {
#pragma unroll
    for (int o = 1; o < 64; o <<= 1) v += __shfl_xor(v, o);
    return v;
}

#define XB_TMO      128
#define XB_XCNT(j)  (256  + 64 * (j))
#define XB_XSUB(j)  (1280 + 64 * (j))
#define XB_XGEN(j)  (2304 + 64 * (j))
#define XB_TOP      3328
#define XB_TOPGEN   3392
#define XCD_BAR_WORDS 3456
#define XB_SPIN_CAP (1u << 18)

__device__ __forceinline__ unsigned xb_ld(unsigned* p)              { return __hip_atomic_load(p, __ATOMIC_RELAXED, __HIP_MEMORY_SCOPE_AGENT); }
__device__ __forceinline__ unsigned xb_add(unsigned* p, unsigned v) { return __hip_atomic_fetch_add(p, v, __ATOMIC_RELAXED, __HIP_MEMORY_SCOPE_AGENT); }
__device__ __forceinline__ unsigned xb_xcc_id() { return (unsigned)__builtin_amdgcn_s_getreg((3 << 11) | 20) & 0xFu; }
#define XB_SPIN(cond, bar) do { unsigned _sp = 0; while (cond) { __builtin_amdgcn_s_sleep(1); \
    if ((++_sp & 255u) == 0u) { if (xb_ld(&(bar)[XB_TMO])) break; if (_sp > XB_SPIN_CAP) { atomicAdd(&(bar)[XB_TMO], 1u); break; } } } } while (0)

struct XcdBarrier {
    unsigned* bar; unsigned x;
    volatile LAS unsigned* st;
};

__device__ __forceinline__ XcdBarrier xcd_barrier_post(unsigned* bar, volatile LAS unsigned* st) {
    XcdBarrier b; b.bar = bar; b.x = xb_xcc_id(); b.st = st;
    if (threadIdx.x == 0) (void)xb_add(&bar[XB_XCNT(b.x)], 1u);
    return b;
}
__device__ __forceinline__ void xcd_barrier_complete(unsigned* bar, unsigned x, unsigned& nloc, unsigned& nx) {
    const unsigned G = gridDim.x * gridDim.y * gridDim.z;
    unsigned sum, cnt, mine, sp = 0u;
    for (;;) {
        sum = 0u; cnt = 0u; mine = 0u;
#pragma unroll
        for (unsigned j = 0; j < 16; ++j) { const unsigned c = xb_ld(&bar[XB_XCNT(j)]); sum += c; cnt += (c > 0u) ? 1u : 0u; mine = (j == x) ? c : mine; }
        if (sum == G) break;
        __builtin_amdgcn_s_sleep(1);
        if ((++sp & 255u) == 0u) { if (xb_ld(&bar[XB_TMO])) break; if (sp > XB_SPIN_CAP) { atomicAdd(&bar[XB_TMO], 1u); break; } }
    }
    nloc = mine > 0u ? mine : 1u; nx = cnt > 0u ? cnt : 1u;
}

__device__ __forceinline__ void xcd_barrier(const XcdBarrier& b) {
    asm volatile("s_waitcnt vmcnt(0)" ::: "memory");
    __syncthreads();
    if (threadIdx.x == 0) {
        unsigned* bar = b.bar;
        __builtin_amdgcn_s_waitcnt(0);
        unsigned nloc = b.st[0], nx = b.st[1];
        if (nloc == 0u) { xcd_barrier_complete(bar, b.x, nloc, nx); b.st[0] = nloc; b.st[1] = nx; }
        const unsigned old = xb_add(&bar[XB_XSUB(b.x)], 1u);
        const unsigned gen = old / nloc;
        if (old + 1u == (gen + 1u) * nloc) {
            __builtin_amdgcn_fence(__ATOMIC_RELEASE, "agent");
            asm volatile("s_waitcnt vmcnt(0)" ::: "memory");
            const unsigned og = xb_add(&bar[XB_TOP], 1u);
            const unsigned tg = og / nx;
            if (og + 1u == (tg + 1u) * nx) xb_add(&bar[XB_TOPGEN], 1u);
            else XB_SPIN(xb_ld(&bar[XB_TOPGEN]) == tg, bar);
            __builtin_amdgcn_fence(__ATOMIC_ACQUIRE, "agent");
            xb_add(&bar[XB_XGEN(b.x)], 1u);
            asm volatile("s_waitcnt vmcnt(0)" ::: "memory");
        } else {
            XB_SPIN(xb_ld(&bar[XB_XGEN(b.x)]) == gen, bar);
            __builtin_amdgcn_fence(__ATOMIC_ACQUIRE, "agent");
            asm volatile("s_waitcnt vmcnt(0)" ::: "memory");
        }
    }
    __syncthreads();
}

constexpr int NWAVES = 8;
constexpr int LDS_BYTES = 147456;
constexpr int RING_BYTES = 131072;
constexpr int CTRL_OFF = 135168;
constexpr int MISC_OFF = CTRL_OFF + 320;
constexpr size_t MiB = 1u << 20;
constexpr size_t WS_CTL = 0, CTL_ZERO_BYTES = 1 * MiB;
constexpr int CW_BAR = 16384;
constexpr size_t WS_WIN = 1 * MiB, WS_WQB = 5 * MiB, WS_WKVB = 5 * MiB + 512 * 1024, WS_WO = 6 * MiB, WS_WMQG = 8 * MiB, WS_WMKV = 10 * MiB, WS_WMO = 14 * MiB;
constexpr size_t WS_RSTDX = 16 * MiB, WS_RSTDM = 16 * MiB + 64 * 1024, WS_SSQQ = 16 * MiB + 256 * 1024, WS_SSQKV = 16 * MiB + 512 * 1024, WS_TBL = 16 * MiB + 768 * 1024;
constexpr size_t WS_WRG = 16 * MiB + 896 * 1024;
constexpr size_t WS_SSQH1 = 17 * MiB, WS_SSQH2 = 18 * MiB, WS_ZKPE = 20 * MiB, WS_CS = 22 * MiB;
constexpr size_t WS_XB = 24 * MiB, WS_MEMB = 56 * MiB, WS_KVMEM = 58 * MiB, WS_KPE = 62 * MiB;
constexpr size_t WS_QKVA = 64 * MiB, WS_ZQ = 112 * MiB, WS_ZKV = 120 * MiB, WS_QB = 124 * MiB, WS_KN = 148 * MiB, WS_VB = 164 * MiB;
constexpr size_t WS_WPT = 180 * MiB, WS_VWT = 188 * MiB, WS_H2 = 196 * MiB, WS_H2B = 260 * MiB, WS_ROUTE = 292 * MiB, WS_XS = 296 * MiB;
constexpr size_t WS_HMID = 296 * MiB, WS_OAP = 440 * MiB, WS_LSE = 488 * MiB, WS_OB = 490 * MiB, WS_OMIX = 506 * MiB;
constexpr size_t WS_H1 = 538 * MiB, WS_H1B = 602 * MiB, WS_P = 634 * MiB, WS_YBUF = 666 * MiB;
constexpr size_t WS_WGU = 794 * MiB, WS_WD = 922 * MiB, WS_END = 986 * MiB;

struct Args { const float* in[26]; float* out; unsigned char* ws; double rope_rev[16]; int ph_lo, ph_hi, flags, pad; };

struct CvtDesc { const float* W; const float* gain; bf16_t* WT; int K, N, mode, item; };
__device__ __forceinline__ void cvt_load(const CvtDesc& d, f32x4 (&v)[16], int lane) {
    const int nblk = (d.N + 63) >> 6, kb = d.item / nblk, nb = d.item % nblk, k0 = 64 * kb, n0 = 64 * nb;
    const int lk = lane >> 4, ln = (lane & 15) * 4;
    const bool ok = n0 + ln < d.N;
    const float* wp = d.W + (size_t)(k0 + lk) * d.N + n0 + ln;
#pragma unroll
    for (int i = 0; i < 16; ++i) v[i] = ok ? *(const f32x4*)(wp + (size_t)(4 * i) * d.N) : (f32x4){0.f, 0.f, 0.f, 0.f};
}
__device__ __forceinline__ void cvt_store(const CvtDesc& d, f32x4 (&v)[16], LAS float* scr, int lane) {
    const int nblk = (d.N + 63) >> 6, kb = d.item / nblk, nb = d.item % nblk, k0 = 64 * kb, n0 = 64 * nb;
    const int lk = lane >> 4, ln = (lane & 15) * 4;
    if (d.gain) {
#pragma unroll
        for (int i = 0; i < 16; ++i) v[i] = v[i] * d.gain[k0 + 4 * i + lk];
    }
#pragma unroll
    for (int i = 0; i < 16; ++i) { LAS float* p = scr + (4 * i + lk) * 65 + ln; p[0] = v[i][0]; p[1] = v[i][1]; p[2] = v[i][2]; p[3] = v[i][3]; }
    LDS_WAIT(); asm volatile("" ::: "memory");
    int drow0 = n0; if (d.mode == 1) { const int half = n0 >> 10, c = n0 & 1023; drow0 = (c >> 7) * 256 + half * 128 + (c & 127); }
    const int c = lane & 7;
#pragma unroll
    for (int j = 0; j < 8; ++j) { const int n = (lane >> 3) + 8 * j; const LAS float* sp = scr + (8 * c) * 65 + n;
        v4u o; o.x = pk2(sp[0 * 65], sp[1 * 65]); o.y = pk2(sp[2 * 65], sp[3 * 65]); o.z = pk2(sp[4 * 65], sp[5 * 65]); o.w = pk2(sp[6 * 65], sp[7 * 65]);
        *(v4u*)(d.WT + (size_t)(drow0 + n) * d.K + k0 + 8 * c) = o; }
    LDS_WAIT(); asm volatile("" ::: "memory");
}
__device__ __forceinline__ void prep_rows4(const float* x0, bf16_t* o0, float* rstd_out, int lane) {
    f32x4 v[4][4]; float s[4];
#pragma unroll
    for (int r = 0; r < 4; ++r)
#pragma unroll
        for (int j = 0; j < 4; ++j) v[r][j] = ((const f32x4*)(x0 + (size_t)r * 1024))[lane + 64 * j];
#pragma unroll
    for (int r = 0; r < 4; ++r) { float a = 0.f;
#pragma unroll
        for (int j = 0; j < 4; ++j) a += (v[r][j].x * v[r][j].x + v[r][j].y * v[r][j].y) + (v[r][j].z * v[r][j].z + v[r][j].w * v[r][j].w);
        s[r] = wave_sum(a); }
    if (lane < 4) rstd_out[lane] = 1.0f / sqrtf((lane == 0 ? s[0] : lane == 1 ? s[1] : lane == 2 ? s[2] : s[3]) * (1.0f / 1024.0f) + 1e-6f);
#pragma unroll
    for (int r = 0; r < 4; ++r) { unsigned long long* o8 = (unsigned long long*)(o0 + (size_t)r * 1024) + lane;
#pragma unroll
        for (int j = 0; j < 4; ++j) o8[64 * j] = (unsigned long long)pk2(v[r][j].x, v[r][j].y) | ((unsigned long long)pk2(v[r][j].z, v[r][j].w) << 32); }
}

__device__ __forceinline__ v4u pack8(const f32x4 a, const f32x4 b) { v4u w; w.x = pk2(a[0], a[1]); w.y = pk2(a[2], a[3]); w.z = pk2(b[0], b[1]); w.w = pk2(b[2], b[3]); return w; }
__device__ __forceinline__ float sq8(const f32x4 a, const f32x4 b) { return (a[0] * a[0] + a[1] * a[1]) + (a[2] * a[2] + a[3] * a[3]) + (b[0] * b[0] + b[1] * b[1]) + (b[2] * b[2] + b[3] * b[3]); }

struct EpiInProj {
    static constexpr bool PERM = true, AFTER_DRAIN = false;
    const float* rstd; bf16_t* qkv; bf16_t* zq; bf16_t* zkv; float* zkpe; float* ssq_q; float* ssq_kv;
    __device__ __forceinline__ void operator()(const pg8::f32x4 (&acc)[2][2][4][2], const pg8::Unit& u, int wr, int wc, int fr, int fq) const {
        const int row0 = u.pm * 256 + wr * 64 + fr;
        const float qs = u.pn < 2 ? 0.125f * 1.4426950408889634f : 1.0f;
#pragma unroll
        for (int ai = 0; ai < 2; ++ai)
#pragma unroll
            for (int m = 0; m < 4; ++m) {
                const int row = row0 + ai * 128 + m * 16;
                const float rs = rstd[row];
                float ss = 0.f;
#pragma unroll
                for (int bj = 0; bj < 2; ++bj) {
                    const f32x4 v0 = acc[ai][bj][m][0] * rs, v1 = acc[ai][bj][m][1] * rs;
                    const int ct = bj * 128 + wc * 32 + 8 * fq;
                    if (u.pn < 6) { *(v4u*)(qkv + (size_t)row * 1536 + u.pn * 256 + ct) = pack8(v0 * qs, v1 * qs); }
                    else if (u.pn == 6) { *(v4u*)(zq + (size_t)row * 256 + ct) = pack8(v0, v1); ss += sq8(v0, v1); }
                    else if (bj == 0) { *(v4u*)(zkv + (size_t)row * 128 + ct) = pack8(v0, v1); ss += sq8(v0, v1); }
                    else if (wc == 0) { *(f32x4*)(zkpe + (size_t)row * 32 + 8 * fq) = v0; *(f32x4*)(zkpe + (size_t)row * 32 + 8 * fq + 4) = v1; }
                }
                if (u.pn >= 6) { ss += __shfl_xor(ss, 16); ss += __shfl_xor(ss, 32); if (fq == 0) (u.pn == 6 ? ssq_q : ssq_kv)[(size_t)row * 4 + wc] = ss; }
            }
    }
};


struct EpiQ {
    static constexpr bool PERM = true, AFTER_DRAIN = false;
    const float* ssq; bf16_t* Q;
    __device__ __forceinline__ void operator()(const pg8::f32x4 (&acc)[2][2][4][2], const pg8::Unit& u, int wr, int wc, int fr, int fq) const {
        const int row0 = u.pm * 256 + wr * 64 + fr;
#pragma unroll
        for (int ai = 0; ai < 2; ++ai)
#pragma unroll
            for (int m = 0; m < 4; ++m) {
                const int row = row0 + ai * 128 + m * 16;
                const f32x4 sp = *(const f32x4*)(ssq + (size_t)row * 4);
                const float rs = (0.10206207261596577f * 1.4426950408889634f) / sqrtf(((sp[0] + sp[1]) + (sp[2] + sp[3])) * (1.0f / 256.0f) + 1e-6f);
#pragma unroll
                for (int bj = 0; bj < 2; ++bj)
                    *(v4u*)(Q + (size_t)row * 768 + u.pn * 256 + bj * 128 + wc * 32 + 8 * fq) = pack8(acc[ai][bj][m][0] * rs, acc[ai][bj][m][1] * rs);
            }
    }
};
struct EpiKV {
    static constexpr bool PERM = true, AFTER_DRAIN = false;
    const float* ssq; bf16_t* Kn; bf16_t* Vb;
    __device__ __forceinline__ void operator()(const pg8::f32x4 (&acc)[2][2][4][2], const pg8::Unit& u, int wr, int wc, int fr, int fq) const {
        const int row0 = u.pm * 256 + wr * 64 + fr;
        bf16_t* dst = (wc < 2 ? Kn : Vb) + (wc & 1) * 32 + 8 * fq;
#pragma unroll
        for (int ai = 0; ai < 2; ++ai)
#pragma unroll
            for (int m = 0; m < 4; ++m) {
                const int row = row0 + ai * 128 + m * 16;
                const f32x4 sp = *(const f32x4*)(ssq + (size_t)row * 4);
                const float rs = 1.0f / sqrtf(((sp[0] + sp[1]) + (sp[2] + sp[3])) * (1.0f / 128.0f) + 1e-6f);
#pragma unroll
                for (int bj = 0; bj < 2; ++bj)
                    *(v4u*)(dst + (size_t)row * 512 + (u.pn * 2 + bj) * 64) = pack8(acc[ai][bj][m][0] * rs, acc[ai][bj][m][1] * rs);
            }
    }
};
struct EpiRowScale {
    static constexpr bool PERM = true, AFTER_DRAIN = false;
    const float* rs; bf16_t* O; int ldc;
    __device__ __forceinline__ void operator()(const pg8::f32x4 (&acc)[2][2][4][2], const pg8::Unit& u, int wr, int wc, int fr, int fq) const {
        const int row0 = u.pm * 256 + wr * 64 + fr;
#pragma unroll
        for (int ai = 0; ai < 2; ++ai)
#pragma unroll
            for (int m = 0; m < 4; ++m) {
                const int row = row0 + ai * 128 + m * 16;
                const float r = rs[row];
#pragma unroll
                for (int bj = 0; bj < 2; ++bj)
                    *(v4u*)(O + (size_t)row * ldc + u.pn * 256 + bj * 128 + wc * 32 + 8 * fq) = pack8(acc[ai][bj][m][0] * r, acc[ai][bj][m][1] * r);
            }
    }
};

template <bool BASE_BF16> struct EpiResid {
    static constexpr bool PERM = true, AFTER_DRAIN = false;
    const void* base; bf16_t* outb; float* ssq;
    __device__ __forceinline__ void operator()(const pg8::f32x4 (&acc)[2][2][4][2], const pg8::Unit& u, int wr, int wc, int fr, int fq) const {
        const int row0 = u.pm * 256 + wr * 64 + fr;
#pragma unroll
        for (int ai = 0; ai < 2; ++ai)
#pragma unroll
            for (int m = 0; m < 4; ++m) {
                const int row = row0 + ai * 128 + m * 16;
                float ss = 0.f;
#pragma unroll
                for (int bj = 0; bj < 2; ++bj) {
                    const size_t o = (size_t)row * 1024 + u.pn * 256 + bj * 128 + wc * 32 + 8 * fq;
                    f32x4 b0, b1;
                    if constexpr (BASE_BF16) { const v4u w = *(const v4u*)((const bf16_t*)base + o);
                        b0 = (f32x4){__builtin_bit_cast(float, w[0] << 16), __builtin_bit_cast(float, w[0] & 0xffff0000u), __builtin_bit_cast(float, w[1] << 16), __builtin_bit_cast(float, w[1] & 0xffff0000u)};
                        b1 = (f32x4){__builtin_bit_cast(float, w[2] << 16), __builtin_bit_cast(float, w[2] & 0xffff0000u), __builtin_bit_cast(float, w[3] << 16), __builtin_bit_cast(float, w[3] & 0xffff0000u)}; }
                    else { b0 = *(const f32x4*)((const float*)base + o); b1 = *(const f32x4*)((const float*)base + o + 4); }
                    const f32x4 v0 = acc[ai][bj][m][0] + b0, v1 = acc[ai][bj][m][1] + b1;
                    *(v4u*)(outb + o) = pack8(v0, v1); ss += sq8(v0, v1);
                }
                ss += __shfl_xor(ss, 16); ss += __shfl_xor(ss, 32);
                if (fq == 0) ssq[(size_t)row * 16 + u.pn * 4 + wc] = ss;
                asm volatile("" ::: "memory");
            }
    }
};
struct EpiPlain {
    static constexpr bool PERM = true, AFTER_DRAIN = false;
    bf16_t* O; int ldc;
    __device__ __forceinline__ void operator()(const pg8::f32x4 (&acc)[2][2][4][2], const pg8::Unit& u, int wr, int wc, int fr, int fq) const {
        const int row0 = u.pm * 256 + wr * 64 + fr;
#pragma unroll
        for (int ai = 0; ai < 2; ++ai)
#pragma unroll
            for (int m = 0; m < 4; ++m)
#pragma unroll
                for (int bj = 0; bj < 2; ++bj)
                    *(v4u*)(O + (size_t)(row0 + ai * 128 + m * 16) * ldc + u.pn * 256 + bj * 128 + wc * 32 + 8 * fq) = pack8(acc[ai][bj][m][0], acc[ai][bj][m][1]);
    }
};
struct EpiSoftmax {
    static constexpr bool PERM = true, AFTER_DRAIN = true;
    bf16_t* P; int rsl_off;
    __device__ __forceinline__ void fused(pg8::f32x4 (&acc)[2][2][4][2], const pg8::Unit& u, int wr, int wc, int fr, int fq, PG8_LAS unsigned char* lds, int wid, int lane) const {
        typedef float f32x2v __attribute__((ext_vector_type(2)));
        const PG8_LAS float* rsl = (const PG8_LAS float*)(lds + rsl_off);
        PG8_LAS f32x2v* X = (PG8_LAS f32x2v*)lds;
        constexpr float L2E = 1.4426950408889634f;
#pragma unroll
        for (int ai = 0; ai < 2; ++ai)
#pragma unroll
            for (int m = 0; m < 4; ++m) {
                const int rt = ai * 128 + wr * 64 + m * 16 + fr;
                const float rs = rsl[rt] * (0.0625f * L2E);
                float mx = -3.0e38f;
#pragma unroll
                for (int bj = 0; bj < 2; ++bj)
#pragma unroll
                    for (int n = 0; n < 2; ++n) { f32x4 v = acc[ai][bj][m][n] * rs; acc[ai][bj][m][n] = v; mx = fmaxf(mx, fmaxf(fmaxf(v[0], v[1]), fmaxf(v[2], v[3]))); }
                mx = fmaxf(mx, __shfl_xor(mx, 16)); mx = fmaxf(mx, __shfl_xor(mx, 32));
                float sm = 0.f;
#pragma unroll
                for (int bj = 0; bj < 2; ++bj)
#pragma unroll
                    for (int n = 0; n < 2; ++n) { const f32x4 v = acc[ai][bj][m][n]; sm += (__builtin_amdgcn_exp2f(v[0] - mx) + __builtin_amdgcn_exp2f(v[1] - mx)) + (__builtin_amdgcn_exp2f(v[2] - mx) + __builtin_amdgcn_exp2f(v[3] - mx)); }
                sm += __shfl_xor(sm, 16); sm += __shfl_xor(sm, 32);
                if (fq == 0) X[rt * 4 + wc] = (f32x2v){mx, sm};
            }
        asm volatile("s_waitcnt lgkmcnt(0)" ::: "memory"); __builtin_amdgcn_s_barrier(); asm volatile("" ::: "memory");
#pragma unroll
        for (int ai = 0; ai < 2; ++ai)
#pragma unroll
            for (int m = 0; m < 4; ++m) {
                const int rt = ai * 128 + wr * 64 + m * 16 + fr;
                const f32x2v x0 = X[rt * 4 + 0], x1 = X[rt * 4 + 1], x2 = X[rt * 4 + 2], x3 = X[rt * 4 + 3];
                const float M = fmaxf(fmaxf(x0.x, x1.x), fmaxf(x2.x, x3.x));
                const float tot = (x0.y * __builtin_amdgcn_exp2f(x0.x - M) + x1.y * __builtin_amdgcn_exp2f(x1.x - M)) + (x2.y * __builtin_amdgcn_exp2f(x2.x - M) + x3.y * __builtin_amdgcn_exp2f(x3.x - M));
                const float inv = 1.0f / tot;
#pragma unroll
                for (int bj = 0; bj < 2; ++bj) {
                    f32x4 a = acc[ai][bj][m][0], b = acc[ai][bj][m][1];
#pragma unroll
                    for (int j = 0; j < 4; ++j) { a[j] = __builtin_amdgcn_exp2f(a[j] - M) * inv; b[j] = __builtin_amdgcn_exp2f(b[j] - M) * inv; }
                    *(v4u*)(P + (size_t)(u.pm * 256 + rt) * 1024 + u.pn * 256 + bj * 128 + wc * 32 + 8 * fq) = pack8(a, b);
                }
            }
    }
};
struct OrderWp {
    int c;
    __device__ __forceinline__ bool next(int i, pg8::Unit& u) const { if (i > 0 || c >= 64) return false; const int bhh = c >> 2, pn = c & 3, b = bhh >> 2, h = bhh & 3;
        u.pm = bhh; u.pn = pn; u.aoff = ((size_t)(b * 256) * 2048 + h * 256) * 2; u.boff = ((size_t)(pn * 256) * 1024 + h * 256) * 2; return true; }
    __device__ __forceinline__ void a_ready(const pg8::Unit&) const {}
    __device__ __forceinline__ void done(const pg8::Unit&) const {}
};
struct OrderVw {
    int c;
    __device__ __forceinline__ bool next(int i, pg8::Unit& u) const { if (i > 0 || c >= 64) return false; const int b = c >> 4, ct = (c >> 2) & 3, h = c & 3;
        u.pm = b * 4 + ct; u.pn = h; u.aoff = ((size_t)(ct * 256) * 1024 + h * 256) * 2; u.boff = ((size_t)(b * 256) * 2048 + 1024 + h * 256) * 2; return true; }
    __device__ __forceinline__ void a_ready(const pg8::Unit&) const {}
    __device__ __forceinline__ void done(const pg8::Unit&) const {}
};
struct OrderBatch {
    pg8::StaticOrder so;
    __device__ __forceinline__ bool next(int i, pg8::Unit& u) const { if (!so.next(i, u)) return false; u.boff = ((size_t)((u.pm >> 4) * 1024 + u.pn * 256) * 1024) * 2; return true; }
    __device__ __forceinline__ void a_ready(const pg8::Unit&) const {}
    __device__ __forceinline__ void done(const pg8::Unit&) const {}
};

constexpr int MPADN = NA + NE * 256, NTILEN = MPADN / 256;
constexpr int CW_GCOUNT = 8192;
constexpr size_t RT_TOPI = 0, RT_TOPG = 256 * 1024, RT_SLOT = 512 * 1024, RT_ROWFLAT = 768 * 1024, RT_RSROW = 1088 * 1024, RT_RSTD = 1408 * 1024, RT_CNT = 1536 * 1024, RT_TOT = 1600 * 1024;
constexpr int LX_TEXP = CTRL_OFF + 2048;
struct OrderMoe {
    const LAS int* texp; int nper, c, G; size_t ebytes;
    __device__ __forceinline__ bool next(int i, pg8::Unit& u) const {
        const int L = i * G + (c & 7) * (G >> 3) + (c >> 3); const int tile = L / nper, pn = L % nper;
        if (tile >= texp[NTILEN]) return false;
        u.pm = tile; u.pn = pn; u.aoff = (size_t)tile * 256 * 1024 * 2; u.boff = (size_t)texp[tile] * ebytes + (size_t)pn * 256 * 1024 * 2; return true; }
    __device__ __forceinline__ void a_ready(const pg8::Unit&) const {}
    __device__ __forceinline__ void done(const pg8::Unit&) const {}
};
__device__ __forceinline__ float swiglu1(float g, float u) { g = fminf(g, 7.0f); u = fminf(fmaxf(u, -7.0f), 7.0f); return (u + 1.0f) * g * __builtin_amdgcn_rcpf(1.0f + __builtin_amdgcn_exp2f(-1.702f * 1.4426950408889634f * g)); }
struct EpiSwiGLU {
    static constexpr bool PERM = true, AFTER_DRAIN = false;
    const float* rs_row; const float* bgu; bf16_t* hmid; const LAS int* texp;
    __device__ __forceinline__ void operator()(const pg8::f32x4 (&acc)[2][2][4][2], const pg8::Unit& u, int wr, int wc, int fr, int fq) const {
        const int row0 = u.pm * 256 + wr * 64 + fr, e = texp[u.pm], c0 = u.pn * 128 + wc * 32 + 8 * fq;
        const float* bg = bgu + (size_t)e * 2048 + c0;
        const f32x4 bg0 = *(const f32x4*)bg, bg1 = *(const f32x4*)(bg + 4), bu0 = *(const f32x4*)(bg + 1024), bu1 = *(const f32x4*)(bg + 1028);
#pragma unroll
        for (int ai = 0; ai < 2; ++ai)
#pragma unroll
            for (int m = 0; m < 4; ++m) {
                const int row = row0 + ai * 128 + m * 16; const float rs = rs_row[row];
                const f32x4 g0 = acc[ai][0][m][0] * rs + bg0, g1 = acc[ai][0][m][1] * rs + bg1, u0 = acc[ai][1][m][0] * rs + bu0, u1 = acc[ai][1][m][1] * rs + bu1;
                f32x4 h0, h1;
#pragma unroll
                for (int j = 0; j < 4; ++j) { h0[j] = swiglu1(g0[j], u0[j]); h1[j] = swiglu1(g1[j], u1[j]); }
                *(v4u*)(hmid + (size_t)row * 1024 + c0) = pack8(h0, h1);
            }
    }
};
struct EpiDown {
    static constexpr bool PERM = true, AFTER_DRAIN = false;
    const int* row_flat; const float* topg; const float* bd; bf16_t* ybuf; const LAS int* texp;
    __device__ __forceinline__ void operator()(const pg8::f32x4 (&acc)[2][2][4][2], const pg8::Unit& u, int wr, int wc, int fr, int fq) const {
        const int row0 = u.pm * 256 + wr * 64 + fr, e = texp[u.pm], c0 = u.pn * 256 + wc * 32 + 8 * fq;
        const float* bp = bd + (size_t)e * 1024 + c0;
        f32x4 bv[2][2];
#pragma unroll
        for (int bj = 0; bj < 2; ++bj) { bv[bj][0] = *(const f32x4*)(bp + bj * 128); bv[bj][1] = *(const f32x4*)(bp + bj * 128 + 4); }
#pragma unroll
        for (int ai = 0; ai < 2; ++ai)
#pragma unroll
            for (int m = 0; m < 4; ++m) {
                const int row = row0 + ai * 128 + m * 16; const int a = row_flat[row];
                if (a >= 0) { const float gt = topg[a];
#pragma unroll
                    for (int bj = 0; bj < 2; ++bj)
                        *(v4u*)(ybuf + (size_t)a * 1024 + c0 + bj * 128) = pack8((acc[ai][bj][m][0] + bv[bj][0]) * gt, (acc[ai][bj][m][1] + bv[bj][1]) * gt); }
            }
    }
};

__device__ __forceinline__ int rel_bucket_d(int rel) {
    int n = rel < 0 ? -rel : rel;
    int b;
    if (n < 8) b = n; else if (n < 15) b = 8; else if (n < 27) b = 9; else if (n < 50) b = 10; else if (n < 91) b = 11;
    else if (n < 166) b = 12; else if (n < 305) b = 13; else if (n < 559) b = 14; else b = 15;
    return b + (rel > 0 ? 16 : 0);
}

static_assert(pg8::GTAB == CTRL_OFF + 4096 && pg8::GTAB + pg8::GTAB_UNITS * 512 <= LDS_BYTES && (NTILEN * 8 + 255) / 256 <= pg8::GTAB_UNITS && NWAVES * dil::W_BYTES <= CTRL_OFF && mla::SHM_ATTN <= CTRL_OFF && RING_BYTES <= CTRL_OFF && LX_TEXP + 4 * (NTILEN + 1) <= LDS_BYTES, "LDS map");
__global__ void __launch_bounds__(NWAVES * 64, 2) mk_fwd(Args args) {
    extern __shared__ __attribute__((aligned(16))) unsigned char lds_raw[];
    LAS unsigned char* lds = (LAS unsigned char*)lds_raw;
    const int tid = threadIdx.x, lane = tid & 63, wave = __builtin_amdgcn_readfirstlane(tid >> 6);
    const int G = gridDim.x; const int bx = blockIdx.x; const int vcu = (G % 8 == 0) ? (bx % 8) * (G / 8) + bx / 8 : bx;
    unsigned char* ws = args.ws;
    const int lo = args.ph_lo, hi = args.ph_hi;
#define IN(k) (lo <= (k) && (k) < hi)
#define BOTH(k) (IN(k) && IN((k) + 1))
    for (int u = tid; u < (LDS_BYTES - CTRL_OFF) / 4; u += NWAVES * 64) ((LAS unsigned*)(lds + CTRL_OFF))[u] = 0u;
    __syncthreads();
    XcdBarrier bar; bar.bar = (unsigned*)(ws + WS_CTL) + CW_BAR; bar.x = 0; bar.st = nullptr;
    if (hi - lo > 1) bar = xcd_barrier_post((unsigned*)(ws + WS_CTL) + CW_BAR, (volatile LAS unsigned*)(lds + MISC_OFF) + 8);
#define GRID_BAR(k) do { if (BOTH(k)) xcd_barrier(bar); } while (0)
    const float* x = args.in[0]; const float* mem = args.in[1]; const float* g_mix = args.in[3]; const float* w_in = args.in[4];
    const float* g_q_a = args.in[5]; const float* w_q_b = args.in[6]; const float* g_kv_a = args.in[7]; const float* w_kv_b = args.in[8];
    const float* w_o = args.in[12]; const float* g_xattn = args.in[13]; const float* g_mem = args.in[14]; const float* w_mq = args.in[15];
    const float* w_mkv = args.in[16]; const float* w_mo = args.in[17]; const float* g_moe = args.in[18];
    const float* w_gate_up = args.in[21]; const float* w_down = args.in[23];
    bf16_t* WinT = (bf16_t*)(ws + WS_WIN); bf16_t* WqbT = (bf16_t*)(ws + WS_WQB); bf16_t* WkvbT = (bf16_t*)(ws + WS_WKVB); bf16_t* WoT = (bf16_t*)(ws + WS_WO);
    bf16_t* Wmqg = (bf16_t*)(ws + WS_WMQG); bf16_t* WmkvT = (bf16_t*)(ws + WS_WMKV); bf16_t* WmoT = (bf16_t*)(ws + WS_WMO);
    bf16_t* WguT = (bf16_t*)(ws + WS_WGU); bf16_t* WdT = (bf16_t*)(ws + WS_WD);
    bf16_t* xb = (bf16_t*)(ws + WS_XB); bf16_t* memb = (bf16_t*)(ws + WS_MEMB);
    float* rstd_x = (float*)(ws + WS_RSTDX); float* rstd_mem = (float*)(ws + WS_RSTDM);

    if (IN(0)) {
        LAS float* scr = (LAS float*)(lds + wave * 16640);
        const int gw = vcu * NWAVES + wave, NGW = G * NWAVES;
        constexpr int I_IN = 16 * 31, I_QB = 4 * 12, I_KVB = 2 * 16, I_O = 16 * 16, I_MKV = 16 * 32, I_MO = 16 * 16, I_GU = 16 * 32, I_D = 16 * 16;
        const int n_exp = (args.flags & 1) ? 32 : 0;
        const int NITEMS = I_IN + I_QB + I_KVB + I_O + I_MKV + I_MO + n_exp * (I_GU + I_D);
        auto desc = [&](int it) {
            CvtDesc d; int r = it; d.mode = 0;
            if (r < I_IN) { d.W = w_in; d.K = 1024; d.N = 1952; d.gain = g_mix; d.WT = WinT; }
            else if ((r -= I_IN) < I_QB) { d.W = w_q_b; d.K = 256; d.N = 768; d.gain = g_q_a; d.WT = WqbT; }
            else if ((r -= I_QB) < I_KVB) { d.W = w_kv_b; d.K = 128; d.N = 1024; d.gain = g_kv_a; d.WT = WkvbT; }
            else if ((r -= I_KVB) < I_O) { d.W = w_o; d.K = 1024; d.N = 1024; d.gain = nullptr; d.WT = WoT; }
            else if ((r -= I_O) < I_MKV) { d.W = w_mkv; d.K = 1024; d.N = 2048; d.gain = g_mem; d.WT = WmkvT; }
            else if ((r -= I_MKV) < I_MO) { d.W = w_mo; d.K = 1024; d.N = 1024; d.gain = nullptr; d.WT = WmoT; }
            else if ((r -= I_MO) < 32 * I_GU) { const int e = r / I_GU; r -= e * I_GU; d.W = w_gate_up + (size_t)e * 1024 * 2048; d.K = 1024; d.N = 2048; d.gain = g_moe; d.WT = WguT + (size_t)e * 2048 * 1024; d.mode = 1; }
            else { r -= 32 * I_GU; const int e = r / I_D; r -= e * I_D; d.W = w_down + (size_t)e * 1024 * 1024; d.K = 1024; d.N = 1024; d.gain = nullptr; d.WT = WdT + (size_t)e * 1024 * 1024; }
            d.item = r; return d; };
        {
            f32x4 va[16], vb[16]; CvtDesc dc = desc(0), dn = dc; bool have = false;
            for (int it = gw; ; it += NGW) {
                const bool more = it < NITEMS;
                if (more) { dn = desc(it); cvt_load(dn, vb, lane); }
                if (have) cvt_store(dc, va, scr, lane);
                if (!more) break;
#pragma unroll
                for (int i = 0; i < 16; ++i) va[i] = vb[i];
                dc = dn; have = true;
            }
        }
        for (int i = gw * 64 + lane; i < 64 * 1024 / 8; i += NGW * 64) ((v4u*)(WinT + (size_t)1984 * 1024))[i] = (v4u){0u, 0u, 0u, 0u};
        for (int m = gw * 4; m < T; m += NGW * 4) prep_rows4(x + (size_t)m * D, xb + (size_t)m * D, rstd_x + m, lane);
        for (int m = gw * 4; m < NB * NMEM; m += NGW * 4) prep_rows4(mem + (size_t)m * D, memb + (size_t)m * D, rstd_mem + m, lane);
        { const float* w_router = args.in[19]; float* wrg = (float*)(ws + WS_WRG); for (int i = bx * 512 + tid; i < 1024 * 32; i += G * 512) wrg[i] = w_router[i] * g_moe[i >> 5]; }
        for (int m = gw; m < D; m += NGW) {
            const f32x4* xr = (const f32x4*)(w_mq + (size_t)m * D) + lane; const float gc = g_xattn[m];
            unsigned long long* o8 = (unsigned long long*)(Wmqg + (size_t)m * D) + lane;
#pragma unroll
            for (int j = 0; j < 4; ++j) { const f32x4 v = xr[64 * j] * gc; o8[64 * j] = (unsigned long long)pk2(v.x, v.y) | ((unsigned long long)pk2(v.z, v.w) << 32); }
        }
    }
    if (IN(0)) {
        const float* rel_bias = args.in[9]; float* tbl = (float*)(ws + WS_TBL);
        for (int i = bx * 512 + tid; i < 8 * 2049; i += G * 512) { const int h = i / 2049, r = i % 2049; tbl[h * 2112 + r] = rel_bias[rel_bucket_d(r - 1024) * 8 + h]; }
    }
    GRID_BAR(0);
    if (IN(1)) {
        int kx = 1024; asm volatile("" : "+s"(kx)); pg8::Gemm g{xb, WinT, kx, kx, kx}; pg8::StaticOrder S; S.init(T, 2048, 1024, 1024, G, bx);
        EpiInProj E{rstd_x, (bf16_t*)(ws + WS_QKVA), (bf16_t*)(ws + WS_ZQ), (bf16_t*)(ws + WS_ZKV), (float*)(ws + WS_ZKPE), (float*)(ws + WS_SSQQ), (float*)(ws + WS_SSQKV)};
        pg8::gemm_phase<EpiInProj, pg8::StaticOrder, true, true>(lds, g, S, E);
    }
    GRID_BAR(1);
    if (IN(2)) {
        const int* pos = (const int*)args.in[2];
        float* cs = (float*)(ws + WS_CS); const float* zkpe = (const float*)(ws + WS_ZKPE); bf16_t* kpe = (bf16_t*)(ws + WS_KPE);
        for (int i = bx * 512 + tid; i < T * 16; i += G * 512) {
            const int t = i >> 4, j = i & 15;
            const double rev = (double)pos[t] * args.rope_rev[j];
            const float fr_ = (float)(rev - floor(rev));
            const float sn = __builtin_amdgcn_sinf(fr_), c_ = __builtin_amdgcn_cosf(fr_);
            cs[(size_t)t * 32 + j] = c_; cs[(size_t)t * 32 + 16 + j] = sn;
            const float x1 = zkpe[(size_t)t * 32 + j], x2 = zkpe[(size_t)t * 32 + 16 + j];
            kpe[(size_t)t * 32 + j] = (bf16_t)f2bf(x1 * c_ - x2 * sn); kpe[(size_t)t * 32 + 16 + j] = (bf16_t)f2bf(x1 * sn + x2 * c_);
        }
        {   int kq = 256; asm volatile("" : "+s"(kq)); pg8::Gemm g{(const bf16_t*)(ws + WS_ZQ), WqbT, kq, kq, kq}; pg8::StaticOrder S; S.init(T, 768, 256, 256, G, bx);
            EpiQ E{(const float*)(ws + WS_SSQQ), (bf16_t*)(ws + WS_QB)};
            pg8::gemm_phase<EpiQ, pg8::StaticOrder, true, true>(lds, g, S, E); }
        {   int kk = 128; asm volatile("" : "+s"(kk)); pg8::Gemm g{(const bf16_t*)(ws + WS_ZKV), WkvbT, kk, kk, kk}; const bool memcu = ((bx + 64) % G) < 32 && G > 64; const int bx2 = bx - (bx >= G - 64 + 32 ? 32 : 0);
            pg8::StaticOrder S; S.init(memcu ? 0 : T, 1024, 128, 128, G > 64 ? G - 32 : G, G > 64 ? bx2 : bx);
            EpiKV E{(const float*)(ws + WS_SSQKV), (bf16_t*)(ws + WS_KN), (bf16_t*)(ws + WS_VB)};
            pg8::gemm_phase<EpiKV, pg8::StaticOrder, true, true>(lds, g, S, E); }
        {   int kx = 1024; asm volatile("" : "+s"(kx)); pg8::Gemm g{memb, WmkvT, kx, kx, kx}; pg8::StaticOrder S; S.init(NB * NMEM, 2048, 1024, 1024, G, (bx + 64) % G);
            EpiRowScale E{rstd_mem, (bf16_t*)(ws + WS_KVMEM), 2048};
            pg8::gemm_phase<EpiRowScale, pg8::StaticOrder, true, true>(lds, g, S, E); }
    }
    GRID_BAR(2);
    if (IN(3)) {
        const unsigned short* Qg = (const unsigned short*)(ws + WS_QB); const unsigned short* Kn = (const unsigned short*)(ws + WS_KN);
        const unsigned short* Kp = (const unsigned short*)(ws + WS_KPE); const unsigned short* Vg = (const unsigned short*)(ws + WS_VB);
        const float* cs = (const float*)(ws + WS_CS); unsigned short* Og = (unsigned short*)(ws + WS_OB);
        for (int i = 0; !(args.flags & 8); ++i) {
            int bh, qb;
            if (G == 256) { if (i >= 2) break; const int idx = i * 32 + (bx >> 3); bh = (bx & 7) + 8 * (idx >> 4); qb = idx & 15; }
            else { const int un = i * G + bx; if (un >= 512) break; bh = un >> 4; qb = un & 15; }
            const int b = bh >> 3, h = bh & 7;
#ifdef MLA_ABL
            if (args.flags & 16) mla::mla_unit<MLA_ABL>(Qg, Kn, Kp, Vg, cs, Og, b * S + qb * 256, b * S, h, S, (char*)lds_raw); else
#endif
            mla::mla_unit<0>(Qg, Kn, Kp, Vg, cs, Og, b * S + qb * 256, b * S, h, S, (char*)lds_raw);
        }
        {
            const unsigned short* qkv = (const unsigned short*)(ws + WS_QKVA); const int* pos = (const int*)args.in[2];
            const float* tbl = (const float*)(ws + WS_TBL); unsigned short* oap = (unsigned short*)(ws + WS_OAP); float* lse = (float*)(ws + WS_LSE);
            char* wl = (char*)lds_raw + wave * dil::W_BYTES;
            __syncthreads();
            int cur_h = -1;
            dil::TaskId tc = dil::task_at(0, bx, G, wave), tn = tc; dil::Pre P;
            bool have = !(args.flags & 4) && tc.ub >= 0;
            if (have) dil::dil_prefetch(qkv, pos, tc, P);
            for (int i = 0; have; ++i) {
                tn = dil::task_at(i + 1, bx, G, wave); const bool has_next = tn.ub >= 0;
                if (tc.h != cur_h) { float* tw = (float*)(wl + dil::W_TBL); for (int j = lane; j < 2049; j += 64) tw[j ^ ((j >> 5) & 31)] = tbl[tc.h * dil::TBL_PITCH + j] * 1.4426950408889634f; cur_h = tc.h; asm volatile("s_waitcnt vmcnt(0) lgkmcnt(0)" ::: "memory"); }
                dil::dil_task(qkv, pos, oap, lse, tc, P, has_next, tn, wl);
                tc = tn; have = has_next;
            }
        }
    }
    GRID_BAR(3);
    if (IN(4)) {
        { int kx = 256; asm volatile("" : "+s"(kx));
          if (bx < 64) { pg8::Gemm g{(const bf16_t*)(ws + WS_KVMEM), Wmqg, 2048, 1024, kx}; OrderWp S{bx}; EpiPlain E{(bf16_t*)(ws + WS_WPT), 1024};
              pg8::gemm_phase<EpiPlain, OrderWp, true, true>(lds, g, S, E); }
          else if (bx < 128) { pg8::Gemm g{WmoT, (const bf16_t*)(ws + WS_KVMEM), 1024, 2048, kx}; OrderVw S{bx - 64}; EpiPlain E{(bf16_t*)(ws + WS_VWT), 1024};
              pg8::gemm_phase<EpiPlain, OrderVw, true, true>(lds, g, S, E); } }
        const bf16_t* oap = (const bf16_t*)(ws + WS_OAP); const float* lse = (const float*)(ws + WS_LSE); const bf16_t* obp = (const bf16_t*)(ws + WS_OB);
        const float* g_out_a = args.in[10]; const float* g_out_b = args.in[11]; bf16_t* omix = (bf16_t*)(ws + WS_OMIX);
        const int gw = vcu * NWAVES + wave, NGW = G * NWAVES;
        const f32x4 ga0 = *(const f32x4*)(g_out_a + 8 * lane), ga1 = *(const f32x4*)(g_out_a + 8 * lane + 4), gb0 = *(const f32x4*)(g_out_b + 8 * lane), gb1 = *(const f32x4*)(g_out_b + 8 * lane + 4);
#define UNPK_LO(V_) ((f32x4){__builtin_bit_cast(float, (V_)[0] << 16), __builtin_bit_cast(float, (V_)[0] & 0xffff0000u), __builtin_bit_cast(float, (V_)[1] << 16), __builtin_bit_cast(float, (V_)[1] & 0xffff0000u)})
#define UNPK_HI(V_) ((f32x4){__builtin_bit_cast(float, (V_)[2] << 16), __builtin_bit_cast(float, (V_)[2] & 0xffff0000u), __builtin_bit_cast(float, (V_)[3] << 16), __builtin_bit_cast(float, (V_)[3] & 0xffff0000u)})
        for (int tok = gw; tok < T; tok += NGW) {
            const int head = lane >> 3;
            const float l0 = lse[((size_t)0 * T + tok) * 8 + head], l1 = lse[((size_t)1 * T + tok) * 8 + head], l2 = lse[((size_t)2 * T + tok) * 8 + head];
            const float mx = fmaxf(l0, fmaxf(l1, l2)); float w0 = __expf(l0 - mx), w1 = __expf(l1 - mx), w2 = __expf(l2 - mx); const float wi = 1.0f / (w0 + w1 + w2); w0 *= wi; w1 *= wi; w2 *= wi;
            const v4u q0 = *(const v4u*)(oap + ((size_t)0 * T + tok) * 512 + 8 * lane), q1 = *(const v4u*)(oap + ((size_t)1 * T + tok) * 512 + 8 * lane);
            const v4u q2 = *(const v4u*)(oap + ((size_t)2 * T + tok) * 512 + 8 * lane), qb = *(const v4u*)(obp + (size_t)tok * 512 + 8 * lane);
            const f32x4 a0 = UNPK_LO(q0) * w0 + UNPK_LO(q1) * w1 + UNPK_LO(q2) * w2, a1 = UNPK_HI(q0) * w0 + UNPK_HI(q1) * w1 + UNPK_HI(q2) * w2, b0 = UNPK_LO(qb), b1 = UNPK_HI(qb);
            const float sa = wave_sum(sq8(a0, a1)), sb = wave_sum(sq8(b0, b1));
            const float ra = 1.0f / sqrtf(sa * (1.0f / 512.0f) + 1e-6f), rb = 1.0f / sqrtf(sb * (1.0f / 512.0f) + 1e-6f);
            *(v4u*)(omix + (size_t)tok * 1024 + 8 * lane) = pack8(a0 * ra * ga0, a1 * ra * ga1);
            *(v4u*)(omix + (size_t)tok * 1024 + 512 + 8 * lane) = pack8(b0 * rb * gb0, b1 * rb * gb1);
        }
#undef UNPK_LO
#undef UNPK_HI
    }
    GRID_BAR(4);
    if (IN(5)) {
        int kx = 1024; asm volatile("" : "+s"(kx));
        pg8::Gemm g{(const bf16_t*)(ws + WS_OMIX), WoT, kx, kx, kx}; pg8::StaticOrder S; S.init(T, 1024, 1024, 1024, G, bx);
        EpiResid<false> E{x, (bf16_t*)(ws + WS_H1B), (float*)(ws + WS_SSQH1)};
        pg8::gemm_phase<EpiResid<false>, pg8::StaticOrder, true, true>(lds, g, S, E);
    }
    GRID_BAR(5);
    if (IN(6)) {
        int kx = 1024; asm volatile("" : "+s"(kx));
        pg8::Gemm g{(const bf16_t*)(ws + WS_H1B), (const bf16_t*)(ws + WS_WPT), kx, kx, kx}; OrderBatch S; S.so.init(T, 1024, 1024, 1024, G, bx);
        pg8::Unit u0; const bool has = S.next(0, u0);
        LAS float* rsl = (LAS float*)(lds + CTRL_OFF + 1024);
        if (has && tid < 256) { const float* sp = (const float*)(ws + WS_SSQH1) + (size_t)(u0.pm * 256 + tid) * 16; float a = 0.f;
#pragma unroll
            for (int j = 0; j < 4; ++j) { const f32x4 v = ((const f32x4*)sp)[j]; a += (v[0] + v[1]) + (v[2] + v[3]); }
            rsl[tid] = 1.0f / sqrtf(a * (1.0f / 1024.0f) + 1e-6f); }
        __syncthreads();
        EpiSoftmax E{(bf16_t*)(ws + WS_P), CTRL_OFF + 1024};
        pg8::gemm_phase<EpiSoftmax, OrderBatch, false, true>(lds, g, S, E);
    }
    GRID_BAR(6);
    if (IN(7)) {
        int kx = 1024; asm volatile("" : "+s"(kx));
        pg8::Gemm g{(const bf16_t*)(ws + WS_P), (const bf16_t*)(ws + WS_VWT), kx, kx, kx}; OrderBatch S; S.so.init(T, 1024, 1024, 1024, G, bx);
        EpiResid<true> E{(const bf16_t*)(ws + WS_H1B), (bf16_t*)(ws + WS_H2B), (float*)(ws + WS_SSQH2)};
        pg8::gemm_phase<EpiResid<true>, OrderBatch, true, true>(lds, g, S, E);
    }
    GRID_BAR(7);
    if (IN(8)) {
        typedef float f32x16 __attribute__((ext_vector_type(16)));
        const bf16_t* h2b = (const bf16_t*)(ws + WS_H2B); const float* b_router = args.in[20]; const float* ssq2 = (const float*)(ws + WS_SSQH2);
        int* topi = (int*)(ws + WS_ROUTE + RT_TOPI); float* topg = (float*)(ws + WS_ROUTE + RT_TOPG); int* tslot = (int*)(ws + WS_ROUTE + RT_SLOT); int* row_flat = (int*)(ws + WS_ROUTE + RT_ROWFLAT);
        for (int i = bx * 512 + tid; i < MPADN; i += G * 512) row_flat[i] = -1;
        LAS float* part = (LAS float*)lds;
        LAS float* lgt = (LAS float*)(lds + 32768);
        for (int ch = bx; ch < T / 64; ch += G) {
            const int tok0 = ch * 64, tb = wave & 1, kq = wave >> 1, kh = lane >> 5, row = tok0 + 32 * tb + (lane & 31);
            f32x16 acc = {};
            const bf16_t* ap = h2b + (size_t)row * 1024 + 256 * kq + 4 * kh; const float* wp = (const float*)(ws + WS_WRG) + (size_t)(256 * kq + 4 * kh) * 32 + (lane & 31);
#pragma unroll 4
            for (int j = 0; j < 32; ++j) {
                const v2u aw = *(const v2u*)(ap + 8 * j);
                const f32x4 a4 = (f32x4){__builtin_bit_cast(float, aw.x << 16), __builtin_bit_cast(float, aw.x & 0xffff0000u), __builtin_bit_cast(float, aw.y << 16), __builtin_bit_cast(float, aw.y & 0xffff0000u)};
#pragma unroll
                for (int e = 0; e < 4; ++e) acc = __builtin_amdgcn_mfma_f32_32x32x2f32(a4[e], wp[(size_t)(8 * j + e) * 32], acc, 0, 0, 0);
            }
#pragma unroll
            for (int r = 0; r < 16; ++r) part[((kq * 64) + tb * 32 + (r & 3) + 8 * (r >> 2) + 4 * kh) * 32 + (lane & 31)] = acc[r];
            __syncthreads();
            {
                const int tk = tid >> 3, e0 = (tid & 7) * 4; const float* sp = ssq2 + (size_t)(tok0 + tk) * 16; float a = 0.f;
#pragma unroll
                for (int j = 0; j < 4; ++j) { const f32x4 v = ((const f32x4*)sp)[j]; a += (v[0] + v[1]) + (v[2] + v[3]); }
                const float rs = 1.0f / sqrtf(a * (1.0f / 1024.0f) + 1e-6f);
                if (e0 == 0) ((float*)(ws + WS_ROUTE + RT_RSTD))[tok0 + tk] = rs;
#pragma unroll
                for (int e = 0; e < 4; ++e) lgt[tk * 33 + e0 + e] = rs * ((part[(0 * 64 + tk) * 32 + e0 + e] + part[(1 * 64 + tk) * 32 + e0 + e]) + (part[(2 * 64 + tk) * 32 + e0 + e] + part[(3 * 64 + tk) * 32 + e0 + e])) + b_router[e0 + e];
            }
            __syncthreads();
            if (tid < 64) {
                int c0 = -1, c1 = -1, c2 = -1, c3 = -1; float v0 = 0.f, v1 = 0.f, v2 = 0.f, v3 = 0.f; int s0 = 0, s1 = 0, s2 = 0, s3 = 0;
                for (int k = 0; k < 4; ++k) {
                    float best = -3.0e38f; int bi = 0;
                    for (int e = 0; e < 32; ++e) { const float v = lgt[tid * 33 + e]; if (e == c0 || e == c1 || e == c2 || e == c3) continue; if (v > best) { best = v; bi = e; } }
                    if (k == 0) { c0 = bi; v0 = best; } else if (k == 1) { c1 = bi; v1 = best; } else if (k == 2) { c2 = bi; v2 = best; } else { c3 = bi; v3 = best; }
                }
                const unsigned long long lt = (1ull << lane) - 1ull; int* cntc = (int*)(ws + WS_ROUTE + RT_CNT) + ch * 32;
                for (int e = 0; e < 32; ++e) {
                    const unsigned long long m0 = __ballot(c0 == e), m1 = __ballot(c1 == e), m2 = __ballot(c2 == e), m3 = __ballot(c3 == e);
                    const int before = __popcll(m0 & lt) + __popcll(m1 & lt) + __popcll(m2 & lt) + __popcll(m3 & lt);
                    if (c0 == e) s0 = before; if (c1 == e) s1 = before; if (c2 == e) s2 = before; if (c3 == e) s3 = before;
                    if (lane == e) cntc[e] = __popcll(m0) + __popcll(m1) + __popcll(m2) + __popcll(m3);
                }
                const int t = tok0 + tid;
                const float e1 = __expf(v1 - v0), e2 = __expf(v2 - v0), e3 = __expf(v3 - v0), inv = 1.0f / (1.0f + e1 + e2 + e3);
                *(int4*)(topi + t * 4) = make_int4(c0, c1, c2, c3);
                *(f32x4*)(topg + t * 4) = (f32x4){inv, e1 * inv, e2 * inv, e3 * inv};
                *(int4*)(tslot + t * 4) = make_int4(s0, s1, s2, s3);
            }
            __syncthreads();
        }
    }
    GRID_BAR(8);
    if (IN(9)) {
        const int* topi = (const int*)(ws + WS_ROUTE + RT_TOPI); const int* tslot = (const int*)(ws + WS_ROUTE + RT_SLOT); const int* cnt = (const int*)(ws + WS_ROUTE + RT_CNT);
        int* row_flat = (int*)(ws + WS_ROUTE + RT_ROWFLAT); float* rs_row = (float*)(ws + WS_ROUTE + RT_RSROW); const float* rstd2 = (const float*)(ws + WS_ROUTE + RT_RSTD);
        LAS int* red = (LAS int*)lds;
        for (int base = bx * 512; base < NA; base += G * 512) {
            const int chA = base >> 8, e = tid & 31, part = tid >> 5;
            int tot = 0, pa = 0, pb = 0;
            for (int c = part; c < T / 64; c += 16) { const int v = cnt[c * 32 + e]; tot += v; pa += c < chA ? v : 0; pb += c <= chA ? v : 0; }
            __syncthreads();
            red[(0 * 16 + part) * 32 + e] = tot; red[(1 * 16 + part) * 32 + e] = pa; red[(2 * 16 + part) * 32 + e] = pb;
            __syncthreads();
            if (tid < 96) { const int w = tid >> 5; int a = 0; for (int p = 0; p < 16; ++p) a += red[(w * 16 + p) * 32 + e]; red[1536 + w * 32 + e] = a; }
            __syncthreads();
            if (tid == 0) { int run = 0; for (int q = 0; q < NE; ++q) { red[1632 + q] = run; run += ((red[1536 + q] + 255) >> 8) << 8; } }
            if (bx == 0 && base == 0 && tid < 32) ((int*)(ws + WS_ROUTE + RT_TOT))[tid] = red[1536 + tid];
            __syncthreads();
            const int a = base + tid, ex = topi[a], row = red[1632 + ex] + red[1536 + 32 * (1 + (((a >> 8) - chA) & 1)) + ex] + tslot[a];
            row_flat[row] = a; rs_row[row] = rstd2[a >> 2];
        }
    }
    GRID_BAR(9);
    if (IN(10) || IN(11)) {
        const int* gtot = (const int*)(ws + WS_ROUTE + RT_TOT); LAS int* texp = (LAS int*)(lds + LX_TEXP);
        __syncthreads();
        if (tid == 0) { int nt = 0; for (int e = 0; e < NE; ++e) { const int n = (gtot[e] + 255) >> 8; for (int j = 0; j < n; ++j) texp[nt + j] = e; nt += n; } texp[NTILEN] = nt; }
        __syncthreads();
    }
    if (IN(10)) {
        int kx = 1024; asm volatile("" : "+s"(kx));
        pg8::Gemm g{(const bf16_t*)(ws + WS_H2B), WguT, kx, kx, kx}; OrderMoe S{(const LAS int*)(lds + LX_TEXP), 8, bx, G, (size_t)2048 * 1024 * 2};
        {
            const int* row_flat = (const int*)(ws + WS_ROUTE + RT_ROWFLAT); pg8::Unit u;
            for (int i = 0; i < pg8::GTAB_UNITS; ++i) { if (!S.next(i, u)) break; if (tid < 256) { const int a = row_flat[u.pm * 256 + tid]; ((LAS unsigned short*)(lds + pg8::GTAB))[i * 256 + tid] = (unsigned short)(a >= 0 ? (a >> 2) : 0); } }
            __syncthreads();
        }
        EpiSwiGLU E{(const float*)(ws + WS_ROUTE + RT_RSROW), args.in[22], (bf16_t*)(ws + WS_HMID), (const LAS int*)(lds + LX_TEXP)};
        pg8::gemm_phase<EpiSwiGLU, OrderMoe, true, true, true>(lds, g, S, E);
    }
    GRID_BAR(10);
    if (IN(11)) {
        int kx = 1024; asm volatile("" : "+s"(kx));
        pg8::Gemm g{(const bf16_t*)(ws + WS_HMID), WdT, kx, kx, kx}; OrderMoe S{(const LAS int*)(lds + LX_TEXP), 4, bx, G, (size_t)1024 * 1024 * 2};
        EpiDown E{(const int*)(ws + WS_ROUTE + RT_ROWFLAT), (const float*)(ws + WS_ROUTE + RT_TOPG), args.in[24], (bf16_t*)(ws + WS_YBUF), (const LAS int*)(lds + LX_TEXP)};
        pg8::gemm_phase<EpiDown, OrderMoe, true, true>(lds, g, S, E);
    }
    GRID_BAR(11);
    if (IN(12)) {
        const bf16_t* h2b = (const bf16_t*)(ws + WS_H2B); const bf16_t* ybuf = (const bf16_t*)(ws + WS_YBUF); const float* g_final = args.in[25]; float* outp = args.out;
        const int gw = vcu * NWAVES + wave, NGW = G * NWAVES;
        for (int t = gw; t < T; t += NGW) {
            f32x4 v[4]; float ss = 0.f;
#pragma unroll
            for (int j = 0; j < 4; ++j) {
                const v2u hw = *(const v2u*)(h2b + (size_t)t * 1024 + 256 * j + 4 * lane);
                f32x4 a = (f32x4){__builtin_bit_cast(float, hw.x << 16), __builtin_bit_cast(float, hw.x & 0xffff0000u), __builtin_bit_cast(float, hw.y << 16), __builtin_bit_cast(float, hw.y & 0xffff0000u)};
#pragma unroll
                for (int k = 0; k < 4; ++k) { const v2u y = *(const v2u*)(ybuf + ((size_t)t * 4 + k) * 1024 + 256 * j + 4 * lane);
                    a[0] += __builtin_bit_cast(float, y.x << 16); a[1] += __builtin_bit_cast(float, y.x & 0xffff0000u); a[2] += __builtin_bit_cast(float, y.y << 16); a[3] += __builtin_bit_cast(float, y.y & 0xffff0000u); }
                v[j] = a; ss += (a[0] * a[0] + a[1] * a[1]) + (a[2] * a[2] + a[3] * a[3]);
            }
            ss = wave_sum(ss); const float rs = 1.0f / sqrtf(ss * (1.0f / 1024.0f) + 1e-6f);
#pragma unroll
            for (int j = 0; j < 4; ++j) *(f32x4*)(outp + (size_t)t * 1024 + 256 * j + 4 * lane) = v[j] * rs * *(const f32x4*)(g_final + 256 * j + 4 * lane);
        }
    }
#undef GRID_BAR
#undef BOTH
#undef IN
}

}
void launch_mk(hipStream_t st, const mk::Args& base, int lo, int hi, int grid) {
    mk::Args a = base; a.ph_lo = lo; a.ph_hi = hi;
    hipLaunchKernelGGL(mk::mk_fwd, dim3(grid), dim3(mk::NWAVES * 64), mk::LDS_BYTES, st, a);
}
}

extern "C" void kernel_launch(void* const* d_in, const int* in_sizes, int n_in, void* d_out, int out_size, void* d_ws, size_t ws_size, hipStream_t stream) {
    static int grid = 0;
    if (grid == 0) {
        int dev = 0, cus = 0;
        if (hipGetDevice(&dev) != hipSuccess || hipDeviceGetAttribute(&cus, hipDeviceAttributeMultiprocessorCount, dev) != hipSuccess) { grid = -1; return; }
        if (hipFuncSetAttribute((const void*)mk::mk_fwd, hipFuncAttributeMaxDynamicSharedMemorySize, mk::LDS_BYTES) != hipSuccess) { grid = -1; return; }
        grid = cus;
    }
    if (grid < 0) return;
    const float* x = (const float*)d_in[0];
    const float* mem = (const float*)d_in[1];
    const int* pos = (const int*)d_in[2];
    const float* g_q_a = (const float*)d_in[5];
    const float* w_q_b = (const float*)d_in[6];
    const float* g_kv_a = (const float*)d_in[7];
    const float* w_kv_b = (const float*)d_in[8];
    const float* rel_bias = (const float*)d_in[9];
    const float* g_out_a = (const float*)d_in[10];
    const float* g_out_b = (const float*)d_in[11];
    const float* w_o = (const float*)d_in[12];
    const float* g_xattn = (const float*)d_in[13];
    const float* g_mem = (const float*)d_in[14];
    const float* w_mq = (const float*)d_in[15];
    const float* w_mkv = (const float*)d_in[16];
    const float* w_mo = (const float*)d_in[17];
    const float* g_moe = (const float*)d_in[18];
    const float* w_router = (const float*)d_in[19];
    const float* b_router = (const float*)d_in[20];
    const float* w_gate_up = (const float*)d_in[21];
    const float* b_gate_up = (const float*)d_in[22];
    const float* w_down = (const float*)d_in[23];
    const float* b_down = (const float*)d_in[24];
    const float* g_final = (const float*)d_in[25];
    float* out = (float*)d_out;
    (void)ws_size; (void)in_sizes; (void)n_in; (void)out_size;

    (void)hipMemsetAsync((char*)d_ws + mk::WS_CTL, 0, mk::CTL_ZERO_BYTES, stream);
    mk::Args ma; memset(&ma, 0, sizeof(ma));
    for (int i = 0; i < 26; ++i) ma.in[i] = (const float*)d_in[i];
    ma.out = out; ma.ws = (unsigned char*)d_ws; ma.flags = 1;
    for (int j = 0; j < 16; ++j) ma.rope_rev[j] = pow(10000.0, -(double)j / 16.0) / 6.283185307179586476925287;
#ifndef MK_N_LAUNCHES
#define MK_N_LAUNCHES 1
#endif
    if (MK_N_LAUNCHES == 1) launch_mk(stream, ma, 0, 13, grid);
    else for (int p = 0; p < 13; ++p) launch_mk(stream, ma, p, p + 1, grid);
#ifdef PROBE_MASK
#ifdef PROBE_FLAGS
    ma.flags |= PROBE_FLAGS;
#endif
    for (int r = 0; r < PROBE_N; ++r) for (int p = 0; p < 13; ++p) if ((PROBE_MASK >> p) & 1) launch_mk(stream, ma, p, p + 1, grid);
#endif
}
```

```cpp
#include <hip/hip_runtime.h>
#include <stdint.h>
#include <string.h>
#include <math.h>

namespace {
constexpr int NB = 4, S = 4096, D = 1024, T = NB * S, NMEM = 256, INW = 1952;
constexpr int NE = 32, TOPK = 4, NA = T * TOPK;

namespace pg8 {
#define PG8_LAS __attribute__((address_space(3)))
typedef unsigned short bf16_t;
typedef short bf16x8 __attribute__((ext_vector_type(8)));
typedef float f32x4 __attribute__((ext_vector_type(4)));
typedef unsigned u32x4 __attribute__((ext_vector_type(4)));
constexpr int BM = 256, BK = 64, HALF = 128, HTB = HALF * BK * 2  , STAGE_BYTES = 8 * HTB, NXCD = 8, WGM = 8;

__host__ __device__ __forceinline__ int lds_byte(int r, int c) { const int st = (r >> 4) * 2 + (c >> 5), rr = r & 15, cc = c & 31, ob = rr * 64 + cc * 2; return st * 1024 + (ob ^ (((ob >> 9) & 1) << 5)); }
__host__ __device__ __forceinline__ void stage_rc(int b, int& R, int& C) { const int st = b / 1024, sb = b % 1024, swz = sb ^ (((sb >> 9) & 1) << 5); R = (st >> 1) * 16 + swz / 64; C = (st & 1) * 32 + (swz % 64) / 2; }
__host__ __device__ __forceinline__ int perm32(int rho) { const int n = rho >> 4, i = rho & 15; return 8 * (i >> 2) + 4 * n + (i & 3); }

struct Unit { int pm, pn; size_t aoff, boff; };
struct Gemm { const bf16_t* A; const bf16_t* Bt; int lda, ldb, K; };

struct StaticOrder {
    int nM, nN, nwg, G, c; size_t ta, tb;
    __host__ __device__ __forceinline__ void init(int M, int N, int lda, int ldb, int G_, int c_) { nM = M / BM; nN = N / BM; nwg = nM * nN; G = G_; c = c_; ta = (size_t)BM * lda * 2; tb = (size_t)BM * ldb * 2; }
    __host__ __device__ __forceinline__ bool next(int i, Unit& u) const {
        const long L = (long)i * G + c; if (L >= nwg) return false;
        int wgid = (int)L; { const int q = nwg / NXCD, r = nwg % NXCD, xcd = wgid % NXCD, off = wgid / NXCD; wgid = (xcd < r ? xcd * (q + 1) : r * (q + 1) + (xcd - r) * q) + off; }
        const int nig = WGM * nN, gid = wgid / nig, fm = gid * WGM, gsz = (nM - fm) < WGM ? (nM - fm) : WGM;
        u.pm = fm + ((wgid % nig) % gsz); u.pn = (wgid % nig) / gsz; u.aoff = (size_t)u.pm * ta; u.boff = (size_t)u.pn * tb; return true;
    }
    __device__ __forceinline__ void a_ready(const Unit&) const {}
    __device__ __forceinline__ void done(const Unit&) const {}
};

__device__ __forceinline__ unsigned cvt_pk_bf16(float lo, float hi) { unsigned r; asm volatile("v_cvt_pk_bf16_f32 %0, %1, %2" : "=v"(r) : "v"(lo), "v"(hi)); return r; }
typedef float f32x2 __attribute__((ext_vector_type(2)));

constexpr int GTAB = 135168 + 4096, GTAB_UNITS = 10;
template <class Epi, class Sched, bool ALIGN_EPI = false, bool SP2 = false, bool GATHER = false>
__device__ __forceinline__ void gemm_phase(PG8_LAS unsigned char* lds, const Gemm g, const Sched& S, const Epi& E) {
    const int tid = threadIdx.x, wid = __builtin_amdgcn_readfirstlane(tid >> 6), lane = tid & 63, wr = wid >> 2, wc = wid & 3, fr = lane & 15, fq = lane >> 4;
    static_assert(!GATHER || SP2, "GATHER is implemented for the SP2 loop only");
    const int K = g.K, nt = K / BK;
    unsigned voffA[2], voffB[2];
#pragma unroll
    for (int i = 0; i < 2; ++i) { int R, C; stage_rc(tid * 16 + i * 8192, R, C); const int Rb = Epi::PERM ? ((R & ~31) + perm32(R & 31)) : R;
        voffA[i] = (unsigned)(R * g.lda + C) * 2u; voffB[i] = (unsigned)(Rb * g.ldb + C) * 2u; }
    unsigned gidx[2], gcol[2];
#pragma unroll
    for (int i = 0; i < 2; ++i) { int R, C; stage_rc(tid * 16 + i * 8192, R, C); gidx[i] = (unsigned)R * 2u; gcol[i] = (unsigned)C * 2u; }
    const size_t kstep = (size_t)(BK * 2);
    const size_t hstepA = (size_t)HALF * g.lda * 2, hstepB = (size_t)HALF * g.ldb * 2;
    const unsigned ldsw = (unsigned)wid * 1024u;
    const int aoff = lds_byte(wr * 64 + fr, fq * 8), boff = lds_byte(wc * 32 + fr, fq * 8);
#define PG8_SA(b, h) (((b) * 2 + (h)) * HTB)
#define PG8_SB(b, h) ((4 + (b) * 2 + (h)) * HTB)
#define PG8_STAGE(bufoff, gbase, voff) do { _Pragma("unroll") for (int _i = 0; _i < 2; ++_i) \
        __builtin_amdgcn_global_load_lds((const unsigned*)((const char*)(gbase) + (voff)[_i]), (PG8_LAS unsigned*)(lds + (bufoff) + ldsw + _i * 8192), 16, 0, 0); } while (0)
#define PG8_GTOK(h, sel) do { if constexpr (GATHER) { tk0 = *(const PG8_LAS unsigned short*)(lds + GTAB + (sel) * 512 + (h) * 256 + gidx[0]); tk1 = *(const PG8_LAS unsigned short*)(lds + GTAB + (sel) * 512 + (h) * 256 + gidx[1]); } } while (0)
#define PG8_STAGE_A(bufoff, gbase, h, sel) do { if constexpr (GATHER) { \
        __builtin_amdgcn_global_load_lds((const unsigned*)((const char*)(gbase) + (size_t)tk0 * (size_t)(g.lda * 2) + gcol[0]), (PG8_LAS unsigned*)(lds + (bufoff) + ldsw), 16, 0, 0); \
        __builtin_amdgcn_global_load_lds((const unsigned*)((const char*)(gbase) + (size_t)tk1 * (size_t)(g.lda * 2) + gcol[1]), (PG8_LAS unsigned*)(lds + (bufoff) + ldsw + 8192), 16, 0, 0); } \
    else { PG8_STAGE(bufoff, (gbase) + (h) * hstepA, voffA); } } while (0)
#define PG8_LDA(dst, b, h) do { _Pragma("unroll") for (int m = 0; m < 4; ++m) _Pragma("unroll") for (int k = 0; k < 2; ++k) dst[m][k] = *(const PG8_LAS bf16x8*)(lds + PG8_SA(b, h) + aoff + m * 2048 + k * 1024); } while (0)
#define PG8_LDB(dst, b, h) do { _Pragma("unroll") for (int n = 0; n < 2; ++n) _Pragma("unroll") for (int k = 0; k < 2; ++k) dst[n][k] = *(const PG8_LAS bf16x8*)(lds + PG8_SB(b, h) + boff + n * 2048 + k * 1024); } while (0)
#define PG8_MMA(ai, bj, At, Bt) do { __builtin_amdgcn_s_setprio(1); _Pragma("unroll") for (int m = 0; m < 4; ++m) _Pragma("unroll") for (int n = 0; n < 2; ++n) _Pragma("unroll") for (int k = 0; k < 2; ++k) \
        acc[ai][bj][m][n] = __builtin_amdgcn_mfma_f32_16x16x32_bf16(Bt[n][k], At[m][k], acc[ai][bj][m][n], 0, 0, 0); __builtin_amdgcn_s_setprio(0); } while (0)
#define PG8_WAIT_V(n) asm volatile("s_waitcnt vmcnt(" #n ")" ::: "memory")
#define PG8_WAIT_L(n) asm volatile("s_waitcnt lgkmcnt(" #n ")" ::: "memory")
#define PG8_BAR __builtin_amdgcn_s_barrier()
#define PG8_SCHED __builtin_amdgcn_sched_barrier(0)
    Unit cur, nxt; int ui = 0; unsigned tk0 = 0, tk1 = 0; (void)tk0; (void)tk1;
    if (!S.next(0, cur)) return;
    f32x4 acc[2][2][4][2];
#pragma unroll
    for (int a = 0; a < 2; ++a)
#pragma unroll
        for (int b = 0; b < 2; ++b)
#pragma unroll
            for (int m = 0; m < 4; ++m)
#pragma unroll
                for (int n = 0; n < 2; ++n) acc[a][b][m][n] = (f32x4){0.f, 0.f, 0.f, 0.f};
    bf16x8 At[4][2], B0[2][2], B1[2][2];
    const char* cA = (const char*)g.A + (GATHER ? (size_t)0 : cur.aoff); const char* cB = (const char*)g.Bt + cur.boff;
    S.a_ready(cur);
    if constexpr (SP2) {
        PG8_STAGE(PG8_SB(0, 0), cB, voffB); PG8_STAGE(PG8_SB(0, 1), cB + hstepB, voffB); PG8_GTOK(0, ui); PG8_STAGE_A(PG8_SA(0, 0), cA, 0, ui); PG8_GTOK(1, ui); PG8_STAGE_A(PG8_SA(0, 1), cA, 1, ui);
        if (wr == 1) PG8_BAR;
        PG8_WAIT_V(2); PG8_BAR;
        PG8_STAGE(PG8_SB(1, 0), cB + kstep, voffB); PG8_GTOK(0, ui); PG8_STAGE_A(PG8_SA(1, 0), cA + kstep, 0, ui); PG8_STAGE(PG8_SB(1, 1), cB + hstepB + kstep, voffB);
        PG8_WAIT_V(6); PG8_BAR;
    } else {
        PG8_STAGE(PG8_SB(0, 0), cB, voffB); PG8_STAGE_A(PG8_SA(0, 0), cA, 0, ui); PG8_STAGE(PG8_SB(0, 1), cB + hstepB, voffB); PG8_STAGE_A(PG8_SA(0, 1), cA, 1, ui);
        if (wr == 1) PG8_BAR;
        PG8_WAIT_V(4); PG8_BAR;
        PG8_STAGE(PG8_SB(1, 0), cB + kstep, voffB); PG8_STAGE_A(PG8_SA(1, 0), cA + kstep, 0, ui); PG8_STAGE(PG8_SB(1, 1), cB + hstepB + kstep, voffB);
        PG8_WAIT_V(6); PG8_BAR;
    }
    for (;;) {
        const bool has_next = S.next(ui + 1, nxt);
        const char* nA = has_next ? (const char*)g.A + (GATHER ? (size_t)0 : nxt.aoff) : cA; const char* nB = has_next ? (const char*)g.Bt + nxt.boff : cB;
        for (int t = 0; t < nt; t += 2) {
            const bool last = (t == nt - 2);
            const char* a1 = cA + (size_t)(t + 1) * kstep;
            const char* a2 = last ? nA : cA + (size_t)(t + 2) * kstep; const char* b2 = last ? nB : cB + (size_t)(t + 2) * kstep;
            const char* a3 = a2 + kstep; const char* b3 = b2 + kstep; const int ui2 = (last && has_next) ? ui + 1 : ui; (void)ui2;
            if (last && has_next) S.a_ready(nxt);
            if constexpr (SP2) {
            PG8_GTOK(1, ui); PG8_LDB(B0, 0, 0); PG8_LDB(B1, 0, 1); PG8_SCHED; PG8_LDA(At, 0, 0); PG8_STAGE_A(PG8_SA(1, 1), a1, 1, ui);
            PG8_WAIT_V(8); PG8_WAIT_L(0); PG8_BAR; PG8_MMA(0, 0, At, B0); PG8_MMA(0, 1, At, B1); PG8_BAR; PG8_SCHED;
            PG8_GTOK(0, ui2); PG8_LDA(At, 0, 1); PG8_STAGE(PG8_SB(0, 0), b2, voffB); PG8_STAGE(PG8_SB(0, 1), b2 + hstepB, voffB); PG8_STAGE_A(PG8_SA(0, 0), a2, 0, ui2);
            PG8_WAIT_V(8); PG8_WAIT_L(0); PG8_BAR; PG8_MMA(1, 0, At, B0); PG8_MMA(1, 1, At, B1); PG8_BAR; PG8_SCHED;
            PG8_GTOK(1, ui2); PG8_LDB(B0, 1, 0); PG8_LDB(B1, 1, 1); PG8_SCHED; PG8_LDA(At, 1, 0); PG8_STAGE_A(PG8_SA(0, 1), a2, 1, ui2);
            PG8_WAIT_V(8); PG8_WAIT_L(0); PG8_BAR; PG8_MMA(0, 0, At, B0); PG8_MMA(0, 1, At, B1); PG8_BAR; PG8_SCHED;
            PG8_GTOK(0, ui2); PG8_LDA(At, 1, 1); PG8_STAGE(PG8_SB(1, 0), b3, voffB); PG8_STAGE(PG8_SB(1, 1), b3 + hstepB, voffB); PG8_STAGE_A(PG8_SA(1, 0), a3, 0, ui2);
            PG8_WAIT_V(8); PG8_WAIT_L(0); PG8_BAR; PG8_MMA(1, 0, At, B0); PG8_MMA(1, 1, At, B1); PG8_BAR; PG8_SCHED;
            } else {
            PG8_LDB(B0, 0, 0); PG8_SCHED; PG8_LDA(At, 0, 0); PG8_STAGE_A(PG8_SA(1, 1), a1, 1, ui);
            PG8_WAIT_L(8); PG8_BAR; PG8_WAIT_L(0); PG8_MMA(0, 0, At, B0); PG8_BAR; PG8_SCHED;
            PG8_LDB(B1, 0, 1); PG8_STAGE(PG8_SB(0, 0), b2, voffB);
            PG8_BAR; PG8_WAIT_L(0); PG8_MMA(0, 1, At, B1); PG8_BAR;
            PG8_LDA(At, 0, 1); PG8_STAGE_A(PG8_SA(0, 0), a2, 0, ui2);
            PG8_BAR; PG8_WAIT_L(0); PG8_MMA(1, 0, At, B0); PG8_BAR; PG8_SCHED;
            PG8_STAGE(PG8_SB(0, 1), b2 + hstepB, voffB);
            PG8_WAIT_V(6); PG8_BAR; PG8_MMA(1, 1, At, B1); PG8_BAR;
            PG8_LDB(B0, 1, 0); PG8_SCHED; PG8_LDA(At, 1, 0); PG8_STAGE_A(PG8_SA(0, 1), a2, 1, ui2);
            PG8_WAIT_L(8); PG8_BAR; PG8_WAIT_L(0); PG8_MMA(0, 0, At, B0); PG8_BAR; PG8_SCHED;
            PG8_LDB(B1, 1, 1); PG8_STAGE(PG8_SB(1, 0), b3, voffB);
            PG8_BAR; PG8_WAIT_L(0); PG8_MMA(0, 1, At, B1); PG8_BAR;
            PG8_LDA(At, 1, 1); PG8_STAGE_A(PG8_SA(1, 0), a3, 0, ui2);
            PG8_BAR; PG8_WAIT_L(0); PG8_MMA(1, 0, At, B0); PG8_BAR; PG8_SCHED;
            PG8_STAGE(PG8_SB(1, 1), b3 + hstepB, voffB);
            PG8_WAIT_V(6); PG8_BAR; PG8_MMA(1, 1, At, B1); PG8_BAR;
            }
        }
        if constexpr (ALIGN_EPI) { if (wr == 0) PG8_BAR; }
        if constexpr (!Epi::AFTER_DRAIN) { E(acc, cur, wr, wc, fr, fq); S.done(cur); }
        if (!has_next) break;
#pragma unroll
        for (int a = 0; a < 2; ++a)
#pragma unroll
            for (int b = 0; b < 2; ++b)
#pragma unroll
                for (int m = 0; m < 4; ++m)
#pragma unroll
                    for (int n = 0; n < 2; ++n) acc[a][b][m][n] = (f32x4){0.f, 0.f, 0.f, 0.f};
        cur = nxt; cA = nA; cB = nB; ++ui;
        if constexpr (ALIGN_EPI) { if (wr == 1) PG8_BAR; }
    }
    PG8_WAIT_V(0);
    if constexpr (!ALIGN_EPI) { if (wr == 0) PG8_BAR; }
    PG8_BAR;
    if constexpr (Epi::AFTER_DRAIN) { E.fused(acc, cur, wr, wc, fr, fq, lds, wid, lane); S.done(cur); }
#undef PG8_SA
#undef PG8_SB
#undef PG8_STAGE
#undef PG8_STAGE_A
#undef PG8_GTOK
#undef PG8_LDA
#undef PG8_LDB
#undef PG8_MMA
#undef PG8_WAIT_V
#undef PG8_WAIT_L
#undef PG8_BAR
#undef PG8_SCHED
}
}
namespace mla {
using bf16x8 = __attribute__((ext_vector_type(8))) short;
using s16x4  = __attribute__((ext_vector_type(4))) short;
using f32x16 = __attribute__((ext_vector_type(16))) float;
using u32x4  = __attribute__((ext_vector_type(4))) unsigned;
constexpr int NW = 8, QBLK = 32, KVBLK = 64;
constexpr float SCALE = 0.10206207261596577f;
constexpr float THR = 8.f;
constexpr int SHM_V = KVBLK * 64 * 2, SHM_K = KVBLK * 256;
constexpr int SHM_ATTN = 4 * SHM_V + 4 * SHM_K + NW * 64 * 4;
#define KSWZ(row, colB) ((row) * 256 + ((colB) ^ (((row) & 7) << 4)))
#define SBAR() __builtin_amdgcn_sched_barrier(0)
__device__ __forceinline__ int crow(int r, int hi) { return (r & 3) + 8 * (r >> 2) + 4 * hi; }
__device__ __forceinline__ unsigned cvtpk(float lo, float hi) { unsigned r; asm volatile("v_cvt_pk_bf16_f32 %0, %1, %2" : "=v"(r) : "v"(lo), "v"(hi)); return r; }

__device__ __forceinline__ float max3f(float a, float b, float c) { return __builtin_fmaxf(__builtin_fmaxf(a, b), c); }
template <int ABL> __device__ __forceinline__ void partialSM(f32x16& p0, f32x16& p1, float& m_reg, float& alpha, bool first) {
  float a = max3f(p0[0], p0[1], p0[2]), b = max3f(p0[3], p1[0], p1[1]), c = max3f(p1[2], p1[3], p0[4]), d = max3f(p0[5], p0[6], p0[7]);
  a = max3f(a, p1[4], p1[5]); b = max3f(b, p1[6], p1[7]);
#pragma unroll
  for (int r = 8; r < 16; r += 4) { a = max3f(a, p0[r], p0[r + 1]); b = max3f(b, p0[r + 2], p0[r + 3]); c = max3f(c, p1[r], p1[r + 1]); d = max3f(d, p1[r + 2], p1[r + 3]); }
  float pmax = fmaxf(fmaxf(a, b), fmaxf(c, d));
  { auto rr = __builtin_amdgcn_permlane32_swap(__float_as_uint(pmax), __float_as_uint(pmax), false, false);
    pmax = fmaxf(__uint_as_float(rr[0]), __uint_as_float(rr[1])); }
  if (__builtin_expect(!first && __all(pmax - m_reg <= THR * 1.4426950408889634f), 1)) { alpha = 1.f; }
  else { const float mn = first ? pmax : fmaxf(m_reg, pmax); alpha = first ? 1.f : __builtin_amdgcn_exp2f(m_reg - mn); m_reg = mn; }
#pragma unroll
  for (int r = 0; r < 16; ++r) { p0[r] -= m_reg; p1[r] -= m_reg; }
#pragma unroll
  for (int r = 0; r < 16; ++r) p0[r] = (ABL & 2) ? p0[r] * 0.5f : __builtin_amdgcn_exp2f(p0[r]);
}
template <int ABL> __device__ __forceinline__ void finishSM(f32x16& p0, f32x16& p1, float alpha, float& l_reg, bf16x8& pa0, bf16x8& pa1, bf16x8& pa2, bf16x8& pa3) {
#pragma unroll
  for (int r = 0; r < 16; ++r) p1[r] = (ABL & 2) ? p1[r] * 0.5f : __builtin_amdgcn_exp2f(p1[r]);
  float ps, s0 = 0.f, s1 = 0.f, s2 = 0.f, s3 = 0.f;
#pragma unroll
  for (int r = 0; r < 16; r += 4) { s0 += p0[r]; s1 += p0[r + 1]; s2 += p0[r + 2]; s3 += p0[r + 3]; }
#pragma unroll
  for (int r = 0; r < 16; r += 4) { s0 += p1[r]; s1 += p1[r + 1]; s2 += p1[r + 2]; s3 += p1[r + 3]; }
  ps = (s0 + s1) + (s2 + s3);
  { auto rr = __builtin_amdgcn_permlane32_swap(__float_as_uint(ps), __float_as_uint(ps), false, false);
    ps = __uint_as_float(rr[0]) + __uint_as_float(rr[1]); }
  l_reg = l_reg * alpha + ps;
#define PK4(P, BASE, OUT) do { u32x4 w = {cvtpk(P[BASE + 0], P[BASE + 1]), cvtpk(P[BASE + 2], P[BASE + 3]), cvtpk(P[BASE + 4], P[BASE + 5]), cvtpk(P[BASE + 6], P[BASE + 7])}; \
    OUT = *reinterpret_cast<bf16x8*>(&w); } while (0)
  PK4(p0, 0, pa0); PK4(p0, 8, pa1); PK4(p1, 0, pa2); PK4(p1, 8, pa3);
#undef PK4
}
__device__ __forceinline__ void qkt(f32x16& p0, f32x16& p1, const char* Ks, const bf16x8* qr, int r32, int hi) {
  p0 = f32x16{}; p1 = f32x16{};
#pragma unroll
  for (int d0 = 0; d0 < 6; ++d0) { int cb = (d0 * 16 + hi * 8) * 2;
    bf16x8 b0 = *reinterpret_cast<const bf16x8*>(Ks + KSWZ(r32, cb));
    bf16x8 b1 = *reinterpret_cast<const bf16x8*>(Ks + KSWZ(32 + r32, cb));
    p0 = __builtin_amdgcn_mfma_f32_32x32x16_bf16(b0, qr[d0], p0, 0, 0, 0);
    p1 = __builtin_amdgcn_mfma_f32_32x32x16_bf16(b1, qr[d0], p1, 0, 0, 0); }
}
__device__ __forceinline__ int v_st(int k, int c) { const int kk = k;
  return ((kk >> 3) * 2 + (c >> 5)) * 512 + ((kk & 7) * 32 + (c & 31)) * 2; }
__device__ __forceinline__ int v_rd_base(int lane) { return ((lane & 3) << 3) | (((lane >> 2) & 3) << 6) | (((lane >> 4) & 1) << 5) | (((lane >> 5) & 1) << 8); }
constexpr int v_rd_off(int d0, int ks, int half) { return d0 * 512 + ks * 2048 + half * 1024; }
template <int OFF> __device__ __forceinline__ s16x4 tr_read(int vb) {
  s16x4 r; asm volatile("ds_read_b64_tr_b16 %0, %1 offset:%2" : "=&v"(r) : "v"(vb), "i"(OFF) : "memory"); return r;
}
#define PK(L, H) (bf16x8){L[0], L[1], L[2], L[3], H[0], H[1], H[2], H[3]}
#define PV_RD(KS, LA, HA, LB, HB) do { LA = tr_read<v_rd_off(0, KS, 0)>(vb); HA = tr_read<v_rd_off(0, KS, 1)>(vb); LB = tr_read<v_rd_off(1, KS, 0)>(vb); HB = tr_read<v_rd_off(1, KS, 1)>(vb); } while (0)
#define PV_MM(PA, LA, HA, LB, HB) do { o[0] = __builtin_amdgcn_mfma_f32_32x32x16_bf16(PA, PK(LA, HA), o[0], 0, 0, 0); o[1] = __builtin_amdgcn_mfma_f32_32x32x16_bf16(PA, PK(LB, HB), o[1], 0, 0, 0); } while (0)
__device__ __forceinline__ void pv_d0(f32x16* o, int vb, bf16x8 pa0, bf16x8 pa1, bf16x8 pa2, bf16x8 pa3) {
  s16x4 la, ha, lb, hb, lc, hc, ld, hd;
  PV_RD(0, la, ha, lb, hb);
  PV_RD(1, lc, hc, ld, hd);
  asm volatile("s_waitcnt lgkmcnt(4)" ::: "memory"); SBAR();
  PV_MM(pa0, la, ha, lb, hb); SBAR();
  PV_RD(2, la, ha, lb, hb);
  asm volatile("s_waitcnt lgkmcnt(4)" ::: "memory"); SBAR();
  PV_MM(pa1, lc, hc, ld, hd); SBAR();
  PV_RD(3, lc, hc, ld, hd);
  asm volatile("s_waitcnt lgkmcnt(4)" ::: "memory"); SBAR();
  PV_MM(pa2, la, ha, lb, hb); SBAR();
  asm volatile("s_waitcnt lgkmcnt(0)" ::: "memory"); SBAR();
  PV_MM(pa3, lc, hc, ld, hd);
}
#undef PV_MM
#undef PV_RD
#undef PK
__device__ __forceinline__ float bf2f_(short b) { return __builtin_bit_cast(float, (unsigned)(unsigned short)b << 16); }

template <int ABL> __device__ __forceinline__ void mla_unit(const unsigned short* __restrict__ Qg, const unsigned short* __restrict__ Kn, const unsigned short* __restrict__ Kpe, const unsigned short* __restrict__ Vg,
                                         const float* __restrict__ cs, unsigned short* __restrict__ Og, int q0, int krow0, int h, int seq, char* lds) {
  const int tid = threadIdx.x, wid = __builtin_amdgcn_readfirstlane(tid >> 6), lane = tid & 63, r32 = lane & 31, hi = lane >> 5;
  char* V_lds = lds; char* K_lds = lds + 4 * SHM_V;
  float* ws = (float*)(lds + 4 * SHM_V + 4 * SHM_K) + wid * 64; float* li_l = ws; float* al_l = ws + 32;
  float m_reg = 0.f, l_reg = 0; f32x16 o[2] = {}; bf16x8 qr[6];
  {
    const int qrow = q0 + wid * QBLK + r32;
    const unsigned short* Qw = Qg + (size_t)qrow * 768 + h * 96 + hi * 8;
#pragma unroll
    for (int d0 = 0; d0 < 6; ++d0) qr[d0] = *reinterpret_cast<const bf16x8*>(Qw + d0 * 16);
    const float* cr = cs + (size_t)qrow * 32 + hi * 8;
    bf16x8 a = qr[4], b = qr[5]; u32x4 wa, wb; float n1[8], n2[8];
#pragma unroll
    for (int e = 0; e < 8; ++e) { const float c_ = cr[e], s_ = cr[16 + e]; const float x1 = bf2f_(a[e]), x2 = bf2f_(b[e]); n1[e] = x1 * c_ - x2 * s_; n2[e] = x1 * s_ + x2 * c_; }
    wa = (u32x4){cvtpk(n1[0], n1[1]), cvtpk(n1[2], n1[3]), cvtpk(n1[4], n1[5]), cvtpk(n1[6], n1[7])};
    wb = (u32x4){cvtpk(n2[0], n2[1]), cvtpk(n2[2], n2[3]), cvtpk(n2[4], n2[5]), cvtpk(n2[6], n2[7])};
    qr[4] = *reinterpret_cast<bf16x8*>(&wa); qr[5] = *reinterpret_cast<bf16x8*>(&wb);
  }
  const int sk = tid >> 3, sc = (tid & 7) * 8, rk = (tid & 255) >> 2, rc = (tid & 3) * 8;
  const int vst = v_st(sk, sc), kst = KSWZ(sk, sc * 2), rst = KSWZ(rk, (64 + rc) * 2);
  const int vb0 = (int)(uintptr_t)V_lds + v_rd_base(lane);
  const unsigned short* Vh = Vg + (size_t)krow0 * 512 + h * 64; const unsigned short* Kh = Kn + (size_t)krow0 * 512 + h * 64; const unsigned short* Rh = Kpe + (size_t)krow0 * 32;
  struct { bf16x8 vs, ks, rs; } sr_[2];
#define SLOAD(i, k0) do { sr_[i].vs = *reinterpret_cast<const bf16x8*>(&Vh[(size_t)((k0) + sk) * 512 + sc]); sr_[i].ks = *reinterpret_cast<const bf16x8*>(&Kh[(size_t)((k0) + sk) * 512 + sc]); \
    sr_[i].rs = *reinterpret_cast<const bf16x8*>(&Rh[(size_t)((k0) + rk) * 32 + rc]); } while (0)
#define SWRITE(b, i) do { *(bf16x8*)(V_lds + (b) * SHM_V + vst) = sr_[i].vs; *(bf16x8*)(K_lds + (b) * SHM_K + kst) = sr_[i].ks; *(bf16x8*)(K_lds + (b) * SHM_K + rst) = sr_[i].rs; } while (0)
#define RESC(a) do { if (__any((a) < 1.f)) { if (hi == 0) al_l[r32] = (a); asm volatile("s_waitcnt lgkmcnt(0)" ::: "memory"); \
    _Pragma("unroll") for (int d = 0; d < 2; ++d) _Pragma("unroll") for (int r = 0; r < 16; ++r) o[d][r] *= al_l[crow(r, hi)]; } } while (0)
#define EBAR() do { asm volatile("s_waitcnt lgkmcnt(0)" ::: "memory"); __builtin_amdgcn_s_barrier(); asm volatile("" ::: "memory"); } while (0)
  f32x16 p0, p1; float al; bf16x8 pa0, pa1, pa2, pa3; const int NT = seq / KVBLK;
  pa0 = pa1 = pa2 = pa3 = bf16x8{};
  SLOAD(0, 0); SLOAD(1, KVBLK); asm volatile("s_waitcnt vmcnt(0)" ::: "memory"); SWRITE(0, 0); SWRITE(1, 1);
  if (2 < NT) SLOAD(0, 2 * KVBLK);
  EBAR();
  if (wid >= 4) EBAR();
  for (int t = 0; t < NT; ++t) {
    SBAR(); qkt(p0, p1, K_lds + (t & 3) * SHM_K, qr, r32, hi); SBAR();
    if (t > 0) pv_d0(o, vb0 + ((t - 1) & 3) * SHM_V, pa0, pa1, pa2, pa3);
    EBAR();
    partialSM<ABL>(p0, p1, m_reg, al, t == 0);
    RESC(al);
    finishSM<ABL>(p0, p1, al, l_reg, pa0, pa1, pa2, pa3);
    if (t + 2 < NT) { asm volatile("s_waitcnt vmcnt(0)" ::: "memory"); SWRITE((t + 2) & 3, 0); }
    if (t + 3 < NT) SLOAD(0, (t + 3) * KVBLK);
    EBAR();
  }
  SBAR(); pv_d0(o, vb0 + ((NT - 1) & 3) * SHM_V, pa0, pa1, pa2, pa3);
  if (wid < 4) EBAR();
#undef EBAR
  if (hi == 0) li_l[r32] = l_reg; asm volatile("s_waitcnt lgkmcnt(0)" ::: "memory");
  float rli[16];
#pragma unroll
  for (int r = 0; r < 16; ++r) rli[r] = __builtin_amdgcn_rcpf(li_l[crow(r, hi)]);
  unsigned short* Ow = Og + (size_t)(q0 + wid * QBLK) * 512 + h * 64;
#pragma unroll
  for (int r = 0; r < 16; ++r) { int orow = crow(r, hi);
#pragma unroll
    for (int d0 = 0; d0 < 2; ++d0) Ow[(size_t)orow * 512 + d0 * 32 + r32] = (unsigned short)cvtpk(o[d0][r] * rli[r], 0.f); }
  __syncthreads();
#undef SLOAD
#undef SWRITE
#undef RESC
}
#undef KSWZ
#undef SBAR
}

namespace dil {
using bf16x8 = __attribute__((ext_vector_type(8))) short;
using s16x4  = __attribute__((ext_vector_type(4))) short;
using f32x16 = __attribute__((ext_vector_type(16))) float;
using u32x4  = __attribute__((ext_vector_type(4))) unsigned;
constexpr int TBL_PITCH = 2112;
constexpr int W_TBL = 0, W_K = 8448, W_V = 8448 + 4096, W_POS = 8448 + 8192, W_AL = W_POS + 128, W_BYTES = W_AL + 128;
__device__ __forceinline__ int crow(int r, int hi) { return (r & 3) + 8 * (r >> 2) + 4 * hi; }
__device__ __forceinline__ unsigned cvtpk(float lo, float hi) { unsigned r; asm volatile("v_cvt_pk_bf16_f32 %0, %1, %2" : "=v"(r) : "v"(lo), "v"(hi)); return r; }
#define DKSWZ(row, colB) ((row) * 128 + ((colB) ^ (((row) & 7) << 4)))
__device__ __forceinline__ int v_st(int k, int c) { const int kk = k;
  return ((kk >> 3) * 2 + (c >> 5)) * 512 + ((kk & 7) * 32 + (c & 31)) * 2; }
__device__ __forceinline__ int v_rd_base(int lane) { return ((lane & 3) << 3) | (((lane >> 2) & 3) << 6) | (((lane >> 4) & 1) << 5) | (((lane >> 5) & 1) << 8); }
constexpr int v_rd_off(int d0, int ks, int half) { return d0 * 512 + ks * 2048 + half * 1024; }
template <int OFF> __device__ __forceinline__ s16x4 tr_read(int vb) {
  s16x4 r; asm volatile("ds_read_b64_tr_b16 %0, %1 offset:%2" : "=&v"(r) : "v"(vb), "i"(OFF) : "memory"); return r;
}
template <int D0> __device__ __forceinline__ void pv_one(f32x16& od, int vb, bf16x8 pa0, bf16x8 pa1) {
  const s16x4 l0 = tr_read<v_rd_off(D0, 0, 0)>(vb), h0 = tr_read<v_rd_off(D0, 0, 1)>(vb), l1 = tr_read<v_rd_off(D0, 1, 0)>(vb), h1 = tr_read<v_rd_off(D0, 1, 1)>(vb);
  asm volatile("s_waitcnt lgkmcnt(0)" ::: "memory"); __builtin_amdgcn_sched_barrier(0);
#define PK(L, H) (bf16x8){L[0], L[1], L[2], L[3], H[0], H[1], H[2], H[3]}
  od = __builtin_amdgcn_mfma_f32_32x32x16_bf16(pa0, PK(l0, h0), od, 0, 0, 0);
  od = __builtin_amdgcn_mfma_f32_32x32x16_bf16(pa1, PK(l1, h1), od, 0, 0, 0);
#undef PK
}
struct KVRegs { bf16x8 k[4], v[4]; int pk; };
struct TaskId { int b, h, g, r, ub; };
__device__ __forceinline__ TaskId task_at(int i, int bx, int G, int wave) {
  TaskId t; int bh, k; t.b = 0; t.h = 0; t.g = 0; t.r = 0; t.ub = -1;
  if (G == 256) { if (i >= 6) return t; bh = (bx & 7) + 8 * (bx >> 6); k = ((((bx >> 3) & 7) * 6 + i) << 3) + wave; }
  else { const int id = (i * G + bx) * 8 + wave; if (id >= 12288) return t; bh = id / 384; k = id % 384; }
  const int g = k >> 7, kk = k & 127, nub = g == 0 ? 128 : (g == 1 ? 32 : 8);
  t.b = bh >> 3; t.h = bh & 7; t.g = g; t.r = kk / nub; t.ub = kk % nub; return t;
}
struct Pre { bf16x8 qr[4]; int pos_q; KVRegs R; };
__device__ __forceinline__ void load_blk(const unsigned short* __restrict__ qkv, const int* __restrict__ pos, const TaskId& t, int kb, KVRegs& R) {
  const int lane = threadIdx.x & 63, r32 = lane & 31, srow = lane >> 1, shalf = (lane & 1) * 32;
  const int dl = t.g == 0 ? 1 : (t.g == 1 ? 4 : 16), L = S / dl; const size_t rowb = (size_t)t.b * S;
  int up = 32 * (t.ub - 2 + kb) + srow; up = up < 0 ? 0 : (up >= L ? L - 1 : up);
  const unsigned short* base = qkv + (rowb + t.r + dl * up) * 1536 + t.h * 64 + shalf;
#pragma unroll
  for (int c = 0; c < 4; ++c) { R.k[c] = *reinterpret_cast<const bf16x8*>(base + 512 + c * 8); R.v[c] = *reinterpret_cast<const bf16x8*>(base + 1024 + c * 8); }
  int upl = 32 * (t.ub - 2 + kb) + r32; upl = upl < 0 ? 0 : (upl >= L ? L - 1 : upl);
  R.pk = pos[rowb + t.r + dl * upl];
}
__device__ __forceinline__ int kb_first(const TaskId& t) { return (t.ub >= 2) ? 0 : (2 - t.ub); }
__device__ __forceinline__ void dil_prefetch(const unsigned short* __restrict__ qkv, const int* __restrict__ pos, const TaskId& t, Pre& P) {
  const int lane = threadIdx.x & 63, r32 = lane & 31, hi = lane >> 5;
  const int dl = t.g == 0 ? 1 : (t.g == 1 ? 4 : 16); const size_t rowb = (size_t)t.b * S; const int tok_q = t.r + dl * (32 * t.ub + r32);
  const unsigned short* Qw = qkv + (rowb + tok_q) * 1536 + t.h * 64 + hi * 8;
#pragma unroll
  for (int d0 = 0; d0 < 4; ++d0) P.qr[d0] = *reinterpret_cast<const bf16x8*>(Qw + d0 * 16);
  P.pos_q = pos[rowb + tok_q];
  load_blk(qkv, pos, t, kb_first(t), P.R);
}
__device__ __forceinline__ void dil_task(const unsigned short* __restrict__ qkv, const int* __restrict__ pos, unsigned short* __restrict__ oap, float* __restrict__ lse,
                                         const TaskId t, Pre& P, bool has_next, const TaskId tn, char* wl  ) {
  const int lane = threadIdx.x & 63, r32 = lane & 31, hi = lane >> 5;
  const int b = t.b, h = t.h, g = t.g, r = t.r, ub = t.ub;
  const int dl = g == 0 ? 1 : (g == 1 ? 4 : 16), L = S / dl;
  const int u_q = 32 * ub + r32;
  const size_t rowb = (size_t)b * S;
  const int tok_q = r + dl * u_q;
  const float* tblw = (const float*)(wl + W_TBL); int* posw = (int*)(wl + W_POS); float* alw = (float*)(wl + W_AL);
  bf16x8 qr[4];
#pragma unroll
  for (int d0 = 0; d0 < 4; ++d0) qr[d0] = P.qr[d0];
  const int pos_q = P.pos_q;
  const int srow = lane >> 1, shalf = (lane & 1) * 32;
  const int vb0 = (int)(uintptr_t)(wl + W_V) + v_rd_base(lane);
  float m_reg = -1e30f, l_reg = 0.f; f32x16 o[2] = {};
  const int kb_lo = kb_first(t), kb_hi = (32 * (ub + 3) <= L) ? 4 : (4 - ((32 * (ub + 3) - L) >> 5));
  KVRegs R = P.R;
  for (int kb = kb_lo; kb <= kb_hi; ++kb) {
#pragma unroll
    for (int c = 0; c < 4; ++c) {
      *(bf16x8*)(wl + W_K + DKSWZ(srow, (shalf + c * 8) * 2)) = R.k[c];
      *(bf16x8*)(wl + W_V + v_st(srow, shalf + c * 8)) = R.v[c];
    }
    if (hi == 0) posw[r32] = R.pk;
    if (kb < kb_hi) load_blk(qkv, pos, t, kb + 1, R);
    asm volatile("s_waitcnt lgkmcnt(0)" ::: "memory"); __builtin_amdgcn_sched_barrier(0);
    f32x16 p = {};
#pragma unroll
    for (int d0 = 0; d0 < 4; ++d0) {
      const bf16x8 kf = *reinterpret_cast<const bf16x8*>(wl + W_K + DKSWZ(r32, (d0 * 16 + hi * 8) * 2));
      p = __builtin_amdgcn_mfma_f32_32x32x16_bf16(kf, qr[d0], p, 0, 0, 0);
    }
    float bmax;
    if (kb == 0 || kb == 4) {
      bmax = -INFINITY;
#pragma unroll
      for (int rr = 0; rr < 16; ++rr) {
        const int kk = crow(rr, hi);
        const bool valid = kb == 0 ? (kk >= r32) : (kk <= r32);
        int rel = posw[kk] - pos_q; rel = rel < -1024 ? -1024 : (rel > 1024 ? 1024 : rel); const int idx = rel + 1024;
        const float sv = valid ? (p[rr] + tblw[idx ^ ((idx >> 5) & 31)]) : -INFINITY;
        p[rr] = sv; bmax = fmaxf(bmax, sv);
      }
    } else {
#pragma unroll
      for (int rr = 0; rr < 16; ++rr) {
        const int kk = crow(rr, hi);
        int rel = posw[kk] - pos_q; rel = rel < -1024 ? -1024 : (rel > 1024 ? 1024 : rel); const int idx = rel + 1024;
        p[rr] += tblw[idx ^ ((idx >> 5) & 31)];
      }
      bmax = fmaxf(fmaxf(p[0], p[1]), fmaxf(p[2], p[3]));
#pragma unroll
      for (int rr = 4; rr < 16; rr += 4) bmax = fmaxf(bmax, fmaxf(fmaxf(p[rr], p[rr + 1]), fmaxf(p[rr + 2], p[rr + 3])));
    }
    { auto x = __builtin_amdgcn_permlane32_swap(__float_as_uint(bmax), __float_as_uint(bmax), false, false); bmax = fmaxf(__uint_as_float(x[0]), __uint_as_float(x[1])); }
    float alpha = 1.f; bool resc = false;
    if (!__all(bmax - m_reg <= 11.5f)) { const float mn = fmaxf(m_reg, bmax); alpha = __builtin_amdgcn_exp2f(m_reg - mn); m_reg = mn; resc = true; }
    float ps = 0.f;
#pragma unroll
    for (int rr = 0; rr < 16; ++rr) p[rr] = __builtin_amdgcn_exp2f(p[rr] - m_reg);
    ps = ((p[0] + p[1]) + (p[2] + p[3])) + ((p[4] + p[5]) + (p[6] + p[7])) + (((p[8] + p[9]) + (p[10] + p[11])) + ((p[12] + p[13]) + (p[14] + p[15])));
    { auto x = __builtin_amdgcn_permlane32_swap(__float_as_uint(ps), __float_as_uint(ps), false, false); ps = __uint_as_float(x[0]) + __uint_as_float(x[1]); }
    l_reg = l_reg * alpha + ps;
    if (resc && kb != kb_lo) {
      if (hi == 0) alw[r32] = alpha;
      asm volatile("s_waitcnt lgkmcnt(0)" ::: "memory");
#pragma unroll
      for (int d = 0; d < 2; ++d)
#pragma unroll
        for (int rr = 0; rr < 16; ++rr) o[d][rr] *= alw[crow(rr, hi)];
    }
    bf16x8 pa0, pa1;
#define PK4(P, BASE, OUT) do { u32x4 w = {cvtpk(P[BASE + 0], P[BASE + 1]), cvtpk(P[BASE + 2], P[BASE + 3]), cvtpk(P[BASE + 4], P[BASE + 5]), cvtpk(P[BASE + 6], P[BASE + 7])}; \
    OUT = *reinterpret_cast<bf16x8*>(&w); } while (0)
    PK4(p, 0, pa0); PK4(p, 8, pa1);
#undef PK4
    pv_one<0>(o[0], vb0, pa0, pa1); pv_one<1>(o[1], vb0, pa0, pa1);
  }
  if (has_next) dil_prefetch(qkv, pos, tn, P);
  float* liw = alw;
  if (hi == 0) liw[r32] = l_reg;
  asm volatile("s_waitcnt lgkmcnt(0)" ::: "memory");
  if (hi == 0) lse[((size_t)g * T + rowb + tok_q) * 8 + h] = (m_reg + __log2f(l_reg)) * 0.6931471805599453f;
  unsigned short* Ow = oap + ((size_t)g * T + rowb + r + (size_t)dl * 32 * ub) * 512 + h * 64;
#pragma unroll
  for (int rr = 0; rr < 16; ++rr) { const int orow = crow(rr, hi); const float rl = __builtin_amdgcn_rcpf(liw[orow]);
#pragma unroll
    for (int d0 = 0; d0 < 2; ++d0) Ow[(size_t)orow * dl * 512 + d0 * 32 + r32] = (unsigned short)cvtpk(o[d0][rr] * rl, 0.f); }
  asm volatile("s_waitcnt lgkmcnt(0)" ::: "memory");
}
#undef DKSWZ
}

namespace mk {
#define GAS __attribute__((address_space(1)))
#define LAS __attribute__((address_space(3)))
typedef unsigned short bf16_t;
typedef unsigned v4u __attribute__((ext_vector_type(4)));
typedef unsigned v2u __attribute__((ext_vector_type(2)));
typedef float f32x4 __attribute__((ext_vector_type(4)));
#define LDS_WAIT() asm volatile("s_waitcnt lgkmcnt(0)" ::: "memory")
#define VM_WAIT() asm volatile("s_waitcnt vmcnt(0)" ::: "memory")
__device__ __forceinline__ unsigned f2bf(float f) { unsigned u = __builtin_bit_cast(unsigned, f); return (u + 0x7fffu + ((u >> 16) & 1u)) >> 16; }
__device__ __forceinline__ unsigned pk2(float lo, float hi) { return f2bf(lo) | (f2bf(hi) << 16); }
__device__ __forceinline__ float bf2f(unsigned short b) { return __builtin_bit_cast(float, (unsigned)b << 16); }
__device__ __forceinline__ float wave_sum(float v) {
#pragma unroll
    for (int o = 1; o < 64; o <<= 1) v += __shfl_xor(v, o);
    return v;
}

#define XB_TMO      128
#define XB_XCNT(j)  (256  + 64 * (j))
#define XB_XSUB(j)  (1280 + 64 * (j))
#define XB_XGEN(j)  (2304 + 64 * (j))
#define XB_TOP      3328
#define XB_TOPGEN   3392
#define XCD_BAR_WORDS 3456
#define XB_SPIN_CAP (1u << 18)

__device__ __forceinline__ unsigned xb_ld(unsigned* p)              { return __hip_atomic_load(p, __ATOMIC_RELAXED, __HIP_MEMORY_SCOPE_AGENT); }
__device__ __forceinline__ unsigned xb_add(unsigned* p, unsigned v) { return __hip_atomic_fetch_add(p, v, __ATOMIC_RELAXED, __HIP_MEMORY_SCOPE_AGENT); }
__device__ __forceinline__ unsigned xb_xcc_id() { return (unsigned)__builtin_amdgcn_s_getreg((3 << 11) | 20) & 0xFu; }
#define XB_SPIN(cond, bar) do { unsigned _sp = 0; while (cond) { __builtin_amdgcn_s_sleep(1); \
    if ((++_sp & 255u) == 0u) { if (xb_ld(&(bar)[XB_TMO])) break; if (_sp > XB_SPIN_CAP) { atomicAdd(&(bar)[XB_TMO], 1u); break; } } } } while (0)

struct XcdBarrier {
    unsigned* bar; unsigned x;
    volatile LAS unsigned* st;
};

__device__ __forceinline__ XcdBarrier xcd_barrier_post(unsigned* bar, volatile LAS unsigned* st) {
    XcdBarrier b; b.bar = bar; b.x = xb_xcc_id(); b.st = st;
    if (threadIdx.x == 0) (void)xb_add(&bar[XB_XCNT(b.x)], 1u);
    return b;
}
__device__ __forceinline__ void xcd_barrier_complete(unsigned* bar, unsigned x, unsigned& nloc, unsigned& nx) {
    const unsigned G = gridDim.x * gridDim.y * gridDim.z;
    unsigned sum, cnt, mine, sp = 0u;
    for (;;) {
        sum = 0u; cnt = 0u; mine = 0u;
#pragma unroll
        for (unsigned j = 0; j < 16; ++j) { const unsigned c = xb_ld(&bar[XB_XCNT(j)]); sum += c; cnt += (c > 0u) ? 1u : 0u; mine = (j == x) ? c : mine; }
        if (sum == G) break;
        __builtin_amdgcn_s_sleep(1);
        if ((++sp & 255u) == 0u) { if (xb_ld(&bar[XB_TMO])) break; if (sp > XB_SPIN_CAP) { atomicAdd(&bar[XB_TMO], 1u); break; } }
    }
    nloc = mine > 0u ? mine : 1u; nx = cnt > 0u ? cnt : 1u;
}

__device__ __forceinline__ void xcd_barrier(const XcdBarrier& b) {
    asm volatile("s_waitcnt vmcnt(0)" ::: "memory");
    __syncthreads();
    if (threadIdx.x == 0) {
        unsigned* bar = b.bar;
        __builtin_amdgcn_s_waitcnt(0);
        unsigned nloc = b.st[0], nx = b.st[1];
        if (nloc == 0u) { xcd_barrier_complete(bar, b.x, nloc, nx); b.st[0] = nloc; b.st[1] = nx; }
        const unsigned old = xb_add(&bar[XB_XSUB(b.x)], 1u);
        const unsigned gen = old / nloc;
        if (old + 1u == (gen + 1u) * nloc) {
            __builtin_amdgcn_fence(__ATOMIC_RELEASE, "agent");
            asm volatile("s_waitcnt vmcnt(0)" ::: "memory");
            const unsigned og = xb_add(&bar[XB_TOP], 1u);
            const unsigned tg = og / nx;
            if (og + 1u == (tg + 1u) * nx) xb_add(&bar[XB_TOPGEN], 1u);
            else XB_SPIN(xb_ld(&bar[XB_TOPGEN]) == tg, bar);
            __builtin_amdgcn_fence(__ATOMIC_ACQUIRE, "agent");
            xb_add(&bar[XB_XGEN(b.x)], 1u);
            asm volatile("s_waitcnt vmcnt(0)" ::: "memory");
        } else {
            XB_SPIN(xb_ld(&bar[XB_XGEN(b.x)]) == gen, bar);
            __builtin_amdgcn_fence(__ATOMIC_ACQUIRE, "agent");
            asm volatile("s_waitcnt vmcnt(0)" ::: "memory");
        }
    }
    __syncthreads();
}

constexpr int NWAVES = 8;
constexpr int LDS_BYTES = 147456;
constexpr int RING_BYTES = 131072;
constexpr int CTRL_OFF = 135168;
constexpr int MISC_OFF = CTRL_OFF + 320;
constexpr size_t MiB = 1u << 20;
constexpr size_t WS_CTL = 0, CTL_ZERO_BYTES = 1 * MiB;
constexpr int CW_BAR = 16384;
constexpr size_t WS_WIN = 1 * MiB, WS_WQB = 5 * MiB, WS_WKVB = 5 * MiB + 512 * 1024, WS_WO = 6 * MiB, WS_WMQG = 8 * MiB, WS_WMKV = 10 * MiB, WS_WMO = 14 * MiB;
constexpr size_t WS_RSTDX = 16 * MiB, WS_RSTDM = 16 * MiB + 64 * 1024, WS_SSQQ = 16 * MiB + 256 * 1024, WS_SSQKV = 16 * MiB + 512 * 1024, WS_TBL = 16 * MiB + 768 * 1024;
constexpr size_t WS_WRG = 16 * MiB + 896 * 1024;
constexpr size_t WS_SSQH1 = 17 * MiB, WS_SSQH2 = 18 * MiB, WS_ZKPE = 20 * MiB, WS_CS = 22 * MiB;
constexpr size_t WS_XB = 24 * MiB, WS_MEMB = 56 * MiB, WS_KVMEM = 58 * MiB, WS_KPE = 62 * MiB;
constexpr size_t WS_QKVA = 64 * MiB, WS_ZQ = 112 * MiB, WS_ZKV = 120 * MiB, WS_QB = 124 * MiB, WS_KN = 148 * MiB, WS_VB = 164 * MiB;
constexpr size_t WS_WPT = 180 * MiB, WS_VWT = 188 * MiB, WS_H2 = 196 * MiB, WS_H2B = 260 * MiB, WS_ROUTE = 292 * MiB, WS_XS = 296 * MiB;
constexpr size_t WS_HMID = 296 * MiB, WS_OAP = 440 * MiB, WS_LSE = 488 * MiB, WS_OB = 490 * MiB, WS_OMIX = 506 * MiB;
constexpr size_t WS_H1 = 538 * MiB, WS_H1B = 602 * MiB, WS_P = 634 * MiB, WS_YBUF = 666 * MiB;
constexpr size_t WS_WGU = 794 * MiB, WS_WD = 922 * MiB, WS_END = 986 * MiB;

struct Args { const float* in[26]; float* out; unsigned char* ws; double rope_rev[16]; int ph_lo, ph_hi, flags, pad; };

struct CvtDesc { const float* W; const float* gain; bf16_t* WT; int K, N, mode, item; };
__device__ __forceinline__ void cvt_load(const CvtDesc& d, f32x4 (&v)[16], int lane) {
    const int nblk = (d.N + 63) >> 6, kb = d.item / nblk, nb = d.item % nblk, k0 = 64 * kb, n0 = 64 * nb;
    const int lk = lane >> 4, ln = (lane & 15) * 4;
    const bool ok = n0 + ln < d.N;
    const float* wp = d.W + (size_t)(k0 + lk) * d.N + n0 + ln;
#pragma unroll
    for (int i = 0; i < 16; ++i) v[i] = ok ? __builtin_nontemporal_load((const f32x4*)(wp + (size_t)(4 * i) * d.N)) : (f32x4){0.f, 0.f, 0.f, 0.f};
}
__device__ __forceinline__ void cvt_store(const CvtDesc& d, f32x4 (&v)[16], LAS float* scr, int lane) {
    const int nblk = (d.N + 63) >> 6, kb = d.item / nblk, nb = d.item % nblk, k0 = 64 * kb, n0 = 64 * nb;
    const int lk = lane >> 4, ln = (lane & 15) * 4;
    if (d.gain) {
#pragma unroll
        for (int i = 0; i < 16; ++i) v[i] = v[i] * d.gain[k0 + 4 * i + lk];
    }
#pragma unroll
    for (int i = 0; i < 16; ++i) { LAS float* p = scr + (4 * i + lk) * 65 + ln; p[0] = v[i][0]; p[1] = v[i][1]; p[2] = v[i][2]; p[3] = v[i][3]; }
    LDS_WAIT(); asm volatile("" ::: "memory");
    int drow0 = n0; if (d.mode == 1) { const int half = n0 >> 10, c = n0 & 1023; drow0 = (c >> 7) * 256 + half * 128 + (c & 127); }
    const int c = lane & 7;
#pragma unroll
    for (int j = 0; j < 8; ++j) { const int n = (lane >> 3) + 8 * j; const LAS float* sp = scr + (8 * c) * 65 + n;
        v4u o; o.x = pk2(sp[0 * 65], sp[1 * 65]); o.y = pk2(sp[2 * 65], sp[3 * 65]); o.z = pk2(sp[4 * 65], sp[5 * 65]); o.w = pk2(sp[6 * 65], sp[7 * 65]);
        __builtin_nontemporal_store(o, (v4u*)(d.WT + (size_t)(drow0 + n) * d.K + k0 + 8 * c)); }
    LDS_WAIT(); asm volatile("" ::: "memory");
}
__device__ __forceinline__ void prep_rows4(const float* x0, bf16_t* o0, float* rstd_out, int lane) {
    f32x4 v[4][4]; float s[4];
#pragma unroll
    for (int r = 0; r < 4; ++r)
#pragma unroll
        for (int j = 0; j < 4; ++j) v[r][j] = ((const f32x4*)(x0 + (size_t)r * 1024))[lane + 64 * j];
#pragma unroll
    for (int r = 0; r < 4; ++r) { float a = 0.f;
#pragma unroll
        for (int j = 0; j < 4; ++j) a += (v[r][j].x * v[r][j].x + v[r][j].y * v[r][j].y) + (v[r][j].z * v[r][j].z + v[r][j].w * v[r][j].w);
        s[r] = wave_sum(a); }
    if (lane < 4) rstd_out[lane] = 1.0f / sqrtf((lane == 0 ? s[0] : lane == 1 ? s[1] : lane == 2 ? s[2] : s[3]) * (1.0f / 1024.0f) + 1e-6f);
#pragma unroll
    for (int r = 0; r < 4; ++r) { unsigned long long* o8 = (unsigned long long*)(o0 + (size_t)r * 1024) + lane;
#pragma unroll
        for (int j = 0; j < 4; ++j) o8[64 * j] = (unsigned long long)pk2(v[r][j].x, v[r][j].y) | ((unsigned long long)pk2(v[r][j].z, v[r][j].w) << 32); }
}

__device__ __forceinline__ v4u pack8(const f32x4 a, const f32x4 b) { v4u w; w.x = pk2(a[0], a[1]); w.y = pk2(a[2], a[3]); w.z = pk2(b[0], b[1]); w.w = pk2(b[2], b[3]); return w; }
__device__ __forceinline__ float sq8(const f32x4 a, const f32x4 b) { return (a[0] * a[0] + a[1] * a[1]) + (a[2] * a[2] + a[3] * a[3]) + (b[0] * b[0] + b[1] * b[1]) + (b[2] * b[2] + b[3] * b[3]); }

struct EpiInProj {
    static constexpr bool PERM = true, AFTER_DRAIN = false;
    const float* rstd; bf16_t* qkv; bf16_t* zq; bf16_t* zkv; float* zkpe; float* ssq_q; float* ssq_kv;
    __device__ __forceinline__ void operator()(const pg8::f32x4 (&acc)[2][2][4][2], const pg8::Unit& u, int wr, int wc, int fr, int fq) const {
        const int row0 = u.pm * 256 + wr * 64 + fr;
        const float qs = u.pn < 2 ? 0.125f * 1.4426950408889634f : 1.0f;
#pragma unroll
        for (int ai = 0; ai < 2; ++ai)
#pragma unroll
            for (int m = 0; m < 4; ++m) {
                const int row = row0 + ai * 128 + m * 16;
                const float rs = rstd[row];
                float ss = 0.f;
#pragma unroll
                for (int bj = 0; bj < 2; ++bj) {
                    const f32x4 v0 = acc[ai][bj][m][0] * rs, v1 = acc[ai][bj][m][1] * rs;
                    const int ct = bj * 128 + wc * 32 + 8 * fq;
                    if (u.pn < 6) { *(v4u*)(qkv + (size_t)row * 1536 + u.pn * 256 + ct) = pack8(v0 * qs, v1 * qs); }
                    else if (u.pn == 6) { *(v4u*)(zq + (size_t)row * 256 + ct) = pack8(v0, v1); ss += sq8(v0, v1); }
                    else if (bj == 0) { *(v4u*)(zkv + (size_t)row * 128 + ct) = pack8(v0, v1); ss += sq8(v0, v1); }
                    else if (wc == 0) { *(f32x4*)(zkpe + (size_t)row * 32 + 8 * fq) = v0; *(f32x4*)(zkpe + (size_t)row * 32 + 8 * fq + 4) = v1; }
                }
                if (u.pn >= 6) { ss += __shfl_xor(ss, 16); ss += __shfl_xor(ss, 32); if (fq == 0) (u.pn == 6 ? ssq_q : ssq_kv)[(size_t)row * 4 + wc] = ss; }
            }
    }
};


struct EpiQ {
    static constexpr bool PERM = true, AFTER_DRAIN = false;
    const float* ssq; bf16_t* Q;
    __device__ __forceinline__ void operator()(const pg8::f32x4 (&acc)[2][2][4][2], const pg8::Unit& u, int wr, int wc, int fr, int fq) const {
        const int row0 = u.pm * 256 + wr * 64 + fr;
#pragma unroll
        for (int ai = 0; ai < 2; ++ai)
#pragma unroll
            for (int m = 0; m < 4; ++m) {
                const int row = row0 + ai * 128 + m * 16;
                const f32x4 sp = *(const f32x4*)(ssq + (size_t)row * 4);
                const float rs = (0.10206207261596577f * 1.4426950408889634f) / sqrtf(((sp[0] + sp[1]) + (sp[2] + sp[3])) * (1.0f / 256.0f) + 1e-6f);
#pragma unroll
                for (int bj = 0; bj < 2; ++bj)
                    *(v4u*)(Q + (size_t)row * 768 + u.pn * 256 + bj * 128 + wc * 32 + 8 * fq) = pack8(acc[ai][bj][m][0] * rs, acc[ai][bj][m][1] * rs);
            }
    }
};
struct EpiKV {
    static constexpr bool PERM = true, AFTER_DRAIN = false;
    const float* ssq; bf16_t* Kn; bf16_t* Vb;
    __device__ __forceinline__ void operator()(const pg8::f32x4 (&acc)[2][2][4][2], const pg8::Unit& u, int wr, int wc, int fr, int fq) const {
        const int row0 = u.pm * 256 + wr * 64 + fr;
        bf16_t* dst = (wc < 2 ? Kn : Vb) + (wc & 1) * 32 + 8 * fq;
#pragma unroll
        for (int ai = 0; ai < 2; ++ai)
#pragma unroll
            for (int m = 0; m < 4; ++m) {
                const int row = row0 + ai * 128 + m * 16;
                const f32x4 sp = *(const f32x4*)(ssq + (size_t)row * 4);
                const float rs = 1.0f / sqrtf(((sp[0] + sp[1]) + (sp[2] + sp[3])) * (1.0f / 128.0f) + 1e-6f);
#pragma unroll
                for (int bj = 0; bj < 2; ++bj)
                    *(v4u*)(dst + (size_t)row * 512 + (u.pn * 2 + bj) * 64) = pack8(acc[ai][bj][m][0] * rs, acc[ai][bj][m][1] * rs);
            }
    }
};
struct EpiRowScale {
    static constexpr bool PERM = true, AFTER_DRAIN = false;
    const float* rs; bf16_t* O; int ldc;
    __device__ __forceinline__ void operator()(const pg8::f32x4 (&acc)[2][2][4][2], const pg8::Unit& u, int wr, int wc, int fr, int fq) const {
        const int row0 = u.pm * 256 + wr * 64 + fr;
#pragma unroll
        for (int ai = 0; ai < 2; ++ai)
#pragma unroll
            for (int m = 0; m < 4; ++m) {
                const int row = row0 + ai * 128 + m * 16;
                const float r = rs[row];
#pragma unroll
                for (int bj = 0; bj < 2; ++bj)
                    *(v4u*)(O + (size_t)row * ldc + u.pn * 256 + bj * 128 + wc * 32 + 8 * fq) = pack8(acc[ai][bj][m][0] * r, acc[ai][bj][m][1] * r);
            }
    }
};

template <bool BASE_BF16> struct EpiResid {
    static constexpr bool PERM = true, AFTER_DRAIN = false;
    const void* base; bf16_t* outb; float* ssq;
    __device__ __forceinline__ void operator()(const pg8::f32x4 (&acc)[2][2][4][2], const pg8::Unit& u, int wr, int wc, int fr, int fq) const {
        const int row0 = u.pm * 256 + wr * 64 + fr;
#pragma unroll
        for (int ai = 0; ai < 2; ++ai)
#pragma unroll
            for (int m = 0; m < 4; ++m) {
                const int row = row0 + ai * 128 + m * 16;
                float ss = 0.f;
#pragma unroll
                for (int bj = 0; bj < 2; ++bj) {
                    const size_t o = (size_t)row * 1024 + u.pn * 256 + bj * 128 + wc * 32 + 8 * fq;
                    f32x4 b0, b1;
                    if constexpr (BASE_BF16) { const v4u w = *(const v4u*)((const bf16_t*)base + o);
                        b0 = (f32x4){__builtin_bit_cast(float, w[0] << 16), __builtin_bit_cast(float, w[0] & 0xffff0000u), __builtin_bit_cast(float, w[1] << 16), __builtin_bit_cast(float, w[1] & 0xffff0000u)};
                        b1 = (f32x4){__builtin_bit_cast(float, w[2] << 16), __builtin_bit_cast(float, w[2] & 0xffff0000u), __builtin_bit_cast(float, w[3] << 16), __builtin_bit_cast(float, w[3] & 0xffff0000u)}; }
                    else { b0 = *(const f32x4*)((const float*)base + o); b1 = *(const f32x4*)((const float*)base + o + 4); }
                    const f32x4 v0 = acc[ai][bj][m][0] + b0, v1 = acc[ai][bj][m][1] + b1;
                    *(v4u*)(outb + o) = pack8(v0, v1); ss += sq8(v0, v1);
                }
                ss += __shfl_xor(ss, 16); ss += __shfl_xor(ss, 32);
                if (fq == 0) ssq[(size_t)row * 16 + u.pn * 4 + wc] = ss;
                asm volatile("" ::: "memory");
            }
    }
};
struct EpiPlain {
    static constexpr bool PERM = true, AFTER_DRAIN = false;
    bf16_t* O; int ldc;
    __device__ __forceinline__ void operator()(const pg8::f32x4 (&acc)[2][2][4][2], const pg8::Unit& u, int wr, int wc, int fr, int fq) const {
        const int row0 = u.pm * 256 + wr * 64 + fr;
#pragma unroll
        for (int ai = 0; ai < 2; ++ai)
#pragma unroll
            for (int m = 0; m < 4; ++m)
#pragma unroll
                for (int bj = 0; bj < 2; ++bj)
                    *(v4u*)(O + (size_t)(row0 + ai * 128 + m * 16) * ldc + u.pn * 256 + bj * 128 + wc * 32 + 8 * fq) = pack8(acc[ai][bj][m][0], acc[ai][bj][m][1]);
    }
};
struct EpiSoftmax {
    static constexpr bool PERM = true, AFTER_DRAIN = true;
    bf16_t* P; int rsl_off;
    __device__ __forceinline__ void fused(pg8::f32x4 (&acc)[2][2][4][2], const pg8::Unit& u, int wr, int wc, int fr, int fq, PG8_LAS unsigned char* lds, int wid, int lane) const {
        typedef float f32x2v __attribute__((ext_vector_type(2)));
        const PG8_LAS float* rsl = (const PG8_LAS float*)(lds + rsl_off);
        PG8_LAS f32x2v* X = (PG8_LAS f32x2v*)lds;
        constexpr float L2E = 1.4426950408889634f;
#pragma unroll
        for (int ai = 0; ai < 2; ++ai)
#pragma unroll
            for (int m = 0; m < 4; ++m) {
                const int rt = ai * 128 + wr * 64 + m * 16 + fr;
                const float rs = rsl[rt] * (0.0625f * L2E);
                float mx = -3.0e38f;
#pragma unroll
                for (int bj = 0; bj < 2; ++bj)
#pragma unroll
                    for (int n = 0; n < 2; ++n) { f32x4 v = acc[ai][bj][m][n] * rs; acc[ai][bj][m][n] = v; mx = fmaxf(mx, fmaxf(fmaxf(v[0], v[1]), fmaxf(v[2], v[3]))); }
                mx = fmaxf(mx, __shfl_xor(mx, 16)); mx = fmaxf(mx, __shfl_xor(mx, 32));
                float sm = 0.f;
#pragma unroll
                for (int bj = 0; bj < 2; ++bj)
#pragma unroll
                    for (int n = 0; n < 2; ++n) { const f32x4 v = acc[ai][bj][m][n]; sm += (__builtin_amdgcn_exp2f(v[0] - mx) + __builtin_amdgcn_exp2f(v[1] - mx)) + (__builtin_amdgcn_exp2f(v[2] - mx) + __builtin_amdgcn_exp2f(v[3] - mx)); }
                sm += __shfl_xor(sm, 16); sm += __shfl_xor(sm, 32);
                if (fq == 0) X[rt * 4 + wc] = (f32x2v){mx, sm};
            }
        asm volatile("s_waitcnt lgkmcnt(0)" ::: "memory"); __builtin_amdgcn_s_barrier(); asm volatile("" ::: "memory");
#pragma unroll
        for (int ai = 0; ai < 2; ++ai)
#pragma unroll
            for (int m = 0; m < 4; ++m) {
                const int rt = ai * 128 + wr * 64 + m * 16 + fr;
                const f32x2v x0 = X[rt * 4 + 0], x1 = X[rt * 4 + 1], x2 = X[rt * 4 + 2], x3 = X[rt * 4 + 3];
                const float M = fmaxf(fmaxf(x0.x, x1.x), fmaxf(x2.x, x3.x));
                const float tot = (x0.y * __builtin_amdgcn_exp2f(x0.x - M) + x1.y * __builtin_amdgcn_exp2f(x1.x - M)) + (x2.y * __builtin_amdgcn_exp2f(x2.x - M) + x3.y * __builtin_amdgcn_exp2f(x3.x - M));
                const float inv = 1.0f / tot;
#pragma unroll
                for (int bj = 0; bj < 2; ++bj) {
                    f32x4 a = acc[ai][bj][m][0], b = acc[ai][bj][m][1];
#pragma unroll
                    for (int j = 0; j < 4; ++j) { a[j] = __builtin_amdgcn_exp2f(a[j] - M) * inv; b[j] = __builtin_amdgcn_exp2f(b[j] - M) * inv; }
                    *(v4u*)(P + (size_t)(u.pm * 256 + rt) * 1024 + u.pn * 256 + bj * 128 + wc * 32 + 8 * fq) = pack8(a, b);
                }
            }
    }
};
struct OrderWp {
    int c;
    __device__ __forceinline__ bool next(int i, pg8::Unit& u) const { if (i > 0 || c >= 64) return false; const int bhh = c >> 2, pn = c & 3, b = bhh >> 2, h = bhh & 3;
        u.pm = bhh; u.pn = pn; u.aoff = ((size_t)(b * 256) * 2048 + h * 256) * 2; u.boff = ((size_t)(pn * 256) * 1024 + h * 256) * 2; return true; }
    __device__ __forceinline__ void a_ready(const pg8::Unit&) const {}
    __device__ __forceinline__ void done(const pg8::Unit&) const {}
};
struct OrderVw {
    int c;
    __device__ __forceinline__ bool next(int i, pg8::Unit& u) const { if (i > 0 || c >= 64) return false; const int b = c >> 4, ct = (c >> 2) & 3, h = c & 3;
        u.pm = b * 4 + ct; u.pn = h; u.aoff = ((size_t)(ct * 256) * 1024 + h * 256) * 2; u.boff = ((size_t)(b * 256) * 2048 + 1024 + h * 256) * 2; return true; }
    __device__ __forceinline__ void a_ready(const pg8::Unit&) const {}
    __device__ __forceinline__ void done(const pg8::Unit&) const {}
};
struct OrderBatch {
    pg8::StaticOrder so;
    __device__ __forceinline__ bool next(int i, pg8::Unit& u) const { if (!so.next(i, u)) return false; u.boff = ((size_t)((u.pm >> 4) * 1024 + u.pn * 256) * 1024) * 2; return true; }
    __device__ __forceinline__ void a_ready(const pg8::Unit&) const {}
    __device__ __forceinline__ void done(const pg8::Unit&) const {}
};

constexpr int MPADN = NA + NE * 256, NTILEN = MPADN / 256;
constexpr int CW_GCOUNT = 8192;
constexpr size_t RT_TOPI = 0, RT_TOPG = 256 * 1024, RT_SLOT = 512 * 1024, RT_ROWFLAT = 768 * 1024, RT_RSROW = 1088 * 1024, RT_RSTD = 1408 * 1024, RT_CNT = 1536 * 1024, RT_TOT = 1600 * 1024;
constexpr int LX_TEXP = CTRL_OFF + 2048;
struct OrderMoe {
    const LAS int* texp; int nper, c, G; size_t ebytes;
    __device__ __forceinline__ bool next(int i, pg8::Unit& u) const {
        const int L = i * G + (c & 7) * (G >> 3) + (c >> 3); const int tile = L / nper, pn = L % nper;
        if (tile >= texp[NTILEN]) return false;
        u.pm = tile; u.pn = pn; u.aoff = (size_t)tile * 256 * 1024 * 2; u.boff = (size_t)texp[tile] * ebytes + (size_t)pn * 256 * 1024 * 2; return true; }
    __device__ __forceinline__ void a_ready(const pg8::Unit&) const {}
    __device__ __forceinline__ void done(const pg8::Unit&) const {}
};
__device__ __forceinline__ float swiglu1(float g, float u) { g = fminf(g, 7.0f); u = fminf(fmaxf(u, -7.0f), 7.0f); return (u + 1.0f) * g * __builtin_amdgcn_rcpf(1.0f + __builtin_amdgcn_exp2f(-1.702f * 1.4426950408889634f * g)); }
struct EpiSwiGLU {
    static constexpr bool PERM = true, AFTER_DRAIN = false;
    const float* rs_row; const float* bgu; bf16_t* hmid; const LAS int* texp;
    __device__ __forceinline__ void operator()(const pg8::f32x4 (&acc)[2][2][4][2], const pg8::Unit& u, int wr, int wc, int fr, int fq) const {
        const int row0 = u.pm * 256 + wr * 64 + fr, e = texp[u.pm], c0 = u.pn * 128 + wc * 32 + 8 * fq;
        const float* bg = bgu + (size_t)e * 2048 + c0;
        const f32x4 bg0 = *(const f32x4*)bg, bg1 = *(const f32x4*)(bg + 4), bu0 = *(const f32x4*)(bg + 1024), bu1 = *(const f32x4*)(bg + 1028);
#pragma unroll
        for (int ai = 0; ai < 2; ++ai)
#pragma unroll
            for (int m = 0; m < 4; ++m) {
                const int row = row0 + ai * 128 + m * 16; const float rs = rs_row[row];
                const f32x4 g0 = acc[ai][0][m][0] * rs + bg0, g1 = acc[ai][0][m][1] * rs + bg1, u0 = acc[ai][1][m][0] * rs + bu0, u1 = acc[ai][1][m][1] * rs + bu1;
                f32x4 h0, h1;
#pragma unroll
                for (int j = 0; j < 4; ++j) { h0[j] = swiglu1(g0[j], u0[j]); h1[j] = swiglu1(g1[j], u1[j]); }
                *(v4u*)(hmid + (size_t)row * 1024 + c0) = pack8(h0, h1);
            }
    }
};
struct EpiDown {
    static constexpr bool PERM = true, AFTER_DRAIN = false;
    const int* row_flat; const float* topg; const float* bd; bf16_t* ybuf; const LAS int* texp;
    __device__ __forceinline__ void operator()(const pg8::f32x4 (&acc)[2][2][4][2], const pg8::Unit& u, int wr, int wc, int fr, int fq) const {
        const int row0 = u.pm * 256 + wr * 64 + fr, e = texp[u.pm], c0 = u.pn * 256 + wc * 32 + 8 * fq;
        const float* bp = bd + (size_t)e * 1024 + c0;
        f32x4 bv[2][2];
#pragma unroll
        for (int bj = 0; bj < 2; ++bj) { bv[bj][0] = *(const f32x4*)(bp + bj * 128); bv[bj][1] = *(const f32x4*)(bp + bj * 128 + 4); }
#pragma unroll
        for (int ai = 0; ai < 2; ++ai)
#pragma unroll
            for (int m = 0; m < 4; ++m) {
                const int row = row0 + ai * 128 + m * 16; const int a = row_flat[row];
                if (a >= 0) { const float gt = topg[a];
#pragma unroll
                    for (int bj = 0; bj < 2; ++bj)
                        *(v4u*)(ybuf + (size_t)a * 1024 + c0 + bj * 128) = pack8((acc[ai][bj][m][0] + bv[bj][0]) * gt, (acc[ai][bj][m][1] + bv[bj][1]) * gt); }
            }
    }
};

__device__ __forceinline__ int rel_bucket_d(int rel) {
    int n = rel < 0 ? -rel : rel;
    int b;
    if (n < 8) b = n; else if (n < 15) b = 8; else if (n < 27) b = 9; else if (n < 50) b = 10; else if (n < 91) b = 11;
    else if (n < 166) b = 12; else if (n < 305) b = 13; else if (n < 559) b = 14; else b = 15;
    return b + (rel > 0 ? 16 : 0);
}

static_assert(pg8::GTAB == CTRL_OFF + 4096 && pg8::GTAB + pg8::GTAB_UNITS * 512 <= LDS_BYTES && (NTILEN * 8 + 255) / 256 <= pg8::GTAB_UNITS && NWAVES * dil::W_BYTES <= CTRL_OFF && mla::SHM_ATTN <= CTRL_OFF && RING_BYTES <= CTRL_OFF && LX_TEXP + 4 * (NTILEN + 1) <= LDS_BYTES, "LDS map");
__global__ void __launch_bounds__(NWAVES * 64, 2) mk_fwd(Args args) {
    extern __shared__ __attribute__((aligned(16))) unsigned char lds_raw[];
    LAS unsigned char* lds = (LAS unsigned char*)lds_raw;
    const int tid = threadIdx.x, lane = tid & 63, wave = __builtin_amdgcn_readfirstlane(tid >> 6);
    const int G = gridDim.x; const int bx = blockIdx.x; const int vcu = (G % 8 == 0) ? (bx % 8) * (G / 8) + bx / 8 : bx;
    unsigned char* ws = args.ws;
    const int lo = args.ph_lo, hi = args.ph_hi;
#define IN(k) (lo <= (k) && (k) < hi)
#define BOTH(k) (IN(k) && IN((k) + 1))
    for (int u = tid; u < (LDS_BYTES - CTRL_OFF) / 4; u += NWAVES * 64) ((LAS unsigned*)(lds + CTRL_OFF))[u] = 0u;
    __syncthreads();
    XcdBarrier bar; bar.bar = (unsigned*)(ws + WS_CTL) + CW_BAR; bar.x = 0; bar.st = nullptr;
    if (hi - lo > 1) bar = xcd_barrier_post((unsigned*)(ws + WS_CTL) + CW_BAR, (volatile LAS unsigned*)(lds + MISC_OFF) + 8);
#define GRID_BAR(k) do { if (BOTH(k)) xcd_barrier(bar); } while (0)
    const float* x = args.in[0]; const float* mem = args.in[1]; const float* g_mix = args.in[3]; const float* w_in = args.in[4];
    const float* g_q_a = args.in[5]; const float* w_q_b = args.in[6]; const float* g_kv_a = args.in[7]; const float* w_kv_b = args.in[8];
    const float* w_o = args.in[12]; const float* g_xattn = args.in[13]; const float* g_mem = args.in[14]; const float* w_mq = args.in[15];
    const float* w_mkv = args.in[16]; const float* w_mo = args.in[17]; const float* g_moe = args.in[18];
    const float* w_gate_up = args.in[21]; const float* w_down = args.in[23];
    bf16_t* WinT = (bf16_t*)(ws + WS_WIN); bf16_t* WqbT = (bf16_t*)(ws + WS_WQB); bf16_t* WkvbT = (bf16_t*)(ws + WS_WKVB); bf16_t* WoT = (bf16_t*)(ws + WS_WO);
    bf16_t* Wmqg = (bf16_t*)(ws + WS_WMQG); bf16_t* WmkvT = (bf16_t*)(ws + WS_WMKV); bf16_t* WmoT = (bf16_t*)(ws + WS_WMO);
    bf16_t* WguT = (bf16_t*)(ws + WS_WGU); bf16_t* WdT = (bf16_t*)(ws + WS_WD);
    bf16_t* xb = (bf16_t*)(ws + WS_XB); bf16_t* memb = (bf16_t*)(ws + WS_MEMB);
    float* rstd_x = (float*)(ws + WS_RSTDX); float* rstd_mem = (float*)(ws + WS_RSTDM);

    if (IN(0)) {
        LAS float* scr = (LAS float*)(lds + wave * 16640);
        const int gw = vcu * NWAVES + wave, NGW = G * NWAVES;
        constexpr int I_IN = 16 * 31, I_QB = 4 * 12, I_KVB = 2 * 16, I_O = 16 * 16, I_MKV = 16 * 32, I_MO = 16 * 16, I_GU = 16 * 32, I_D = 16 * 16;
        const int n_exp = (args.flags & 1) ? 32 : 0;
        const int NITEMS = I_IN + I_QB + I_KVB + I_O + I_MKV + I_MO + n_exp * (I_GU + I_D);
        auto desc = [&](int it) {
            CvtDesc d; int r = it; d.mode = 0;
            if (r < I_IN) { d.W = w_in; d.K = 1024; d.N = 1952; d.gain = g_mix; d.WT = WinT; }
            else if ((r -= I_IN) < I_QB) { d.W = w_q_b; d.K = 256; d.N = 768; d.gain = g_q_a; d.WT = WqbT; }
            else if ((r -= I_QB) < I_KVB) { d.W = w_kv_b; d.K = 128; d.N = 1024; d.gain = g_kv_a; d.WT = WkvbT; }
            else if ((r -= I_KVB) < I_O) { d.W = w_o; d.K = 1024; d.N = 1024; d.gain = nullptr; d.WT = WoT; }
            else if ((r -= I_O) < I_MKV) { d.W = w_mkv; d.K = 1024; d.N = 2048; d.gain = g_mem; d.WT = WmkvT; }
            else if ((r -= I_MKV) < I_MO) { d.W = w_mo; d.K = 1024; d.N = 1024; d.gain = nullptr; d.WT = WmoT; }
            else if ((r -= I_MO) < 32 * I_GU) { const int e = r / I_GU; r -= e * I_GU; d.W = w_gate_up + (size_t)e * 1024 * 2048; d.K = 1024; d.N = 2048; d.gain = g_moe; d.WT = WguT + (size_t)e * 2048 * 1024; d.mode = 1; }
            else { r -= 32 * I_GU; const int e = r / I_D; r -= e * I_D; d.W = w_down + (size_t)e * 1024 * 1024; d.K = 1024; d.N = 1024; d.gain = nullptr; d.WT = WdT + (size_t)e * 1024 * 1024; }
            d.item = r; return d; };
        {
            f32x4 va[16], vb[16]; CvtDesc dc = desc(0), dn = dc; bool have = false;
            for (int it = gw; ; it += NGW) {
                const bool more = it < NITEMS;
                if (more) { dn = desc(it); cvt_load(dn, vb, lane); }
                if (have) cvt_store(dc, va, scr, lane);
                if (!more) break;
#pragma unroll
                for (int i = 0; i < 16; ++i) va[i] = vb[i];
                dc = dn; have = true;
            }
        }
        for (int i = gw * 64 + lane; i < 64 * 1024 / 8; i += NGW * 64) ((v4u*)(WinT + (size_t)1984 * 1024))[i] = (v4u){0u, 0u, 0u, 0u};
        for (int m = gw * 4; m < T; m += NGW * 4) prep_rows4(x + (size_t)m * D, xb + (size_t)m * D, rstd_x + m, lane);
        for (int m = gw * 4; m < NB * NMEM; m += NGW * 4) prep_rows4(mem + (size_t)m * D, memb + (size_t)m * D, rstd_mem + m, lane);
        { const float* w_router = args.in[19]; float* wrg = (float*)(ws + WS_WRG); for (int i = bx * 512 + tid; i < 1024 * 32; i += G * 512) wrg[i] = w_router[i] * g_moe[i >> 5]; }
        for (int m = gw; m < D; m += NGW) {
            const f32x4* xr = (const f32x4*)(w_mq + (size_t)m * D) + lane; const float gc = g_xattn[m];
            unsigned long long* o8 = (unsigned long long*)(Wmqg + (size_t)m * D) + lane;
#pragma unroll
            for (int j = 0; j < 4; ++j) { const f32x4 v = xr[64 * j] * gc; o8[64 * j] = (unsigned long long)pk2(v.x, v.y) | ((unsigned long long)pk2(v.z, v.w) << 32); }
        }
    }
    if (IN(0)) {
        const float* rel_bias = args.in[9]; float* tbl = (float*)(ws + WS_TBL);
        for (int i = bx * 512 + tid; i < 8 * 2049; i += G * 512) { const int h = i / 2049, r = i % 2049; tbl[h * 2112 + r] = rel_bias[rel_bucket_d(r - 1024) * 8 + h]; }
    }
    GRID_BAR(0);
    if (IN(1)) {
        int kx = 1024; asm volatile("" : "+s"(kx)); pg8::Gemm g{xb, WinT, kx, kx, kx}; pg8::StaticOrder S; S.init(T, 2048, 1024, 1024, G, bx);
        EpiInProj E{rstd_x, (bf16_t*)(ws + WS_QKVA), (bf16_t*)(ws + WS_ZQ), (bf16_t*)(ws + WS_ZKV), (float*)(ws + WS_ZKPE), (float*)(ws + WS_SSQQ), (float*)(ws + WS_SSQKV)};
        pg8::gemm_phase<EpiInProj, pg8::StaticOrder, true, true>(lds, g, S, E);
    }
    GRID_BAR(1);
    if (IN(2)) {
        const int* pos = (const int*)args.in[2];
        float* cs = (float*)(ws + WS_CS); const float* zkpe = (const float*)(ws + WS_ZKPE); bf16_t* kpe = (bf16_t*)(ws + WS_KPE);
        for (int i = bx * 512 + tid; i < T * 16; i += G * 512) {
            const int t = i >> 4, j = i & 15;
            const double rev = (double)pos[t] * args.rope_rev[j];
            const float fr_ = (float)(rev - floor(rev));
            const float sn = __builtin_amdgcn_sinf(fr_), c_ = __builtin_amdgcn_cosf(fr_);
            cs[(size_t)t * 32 + j] = c_; cs[(size_t)t * 32 + 16 + j] = sn;
            const float x1 = zkpe[(size_t)t * 32 + j], x2 = zkpe[(size_t)t * 32 + 16 + j];
            kpe[(size_t)t * 32 + j] = (bf16_t)f2bf(x1 * c_ - x2 * sn); kpe[(size_t)t * 32 + 16 + j] = (bf16_t)f2bf(x1 * sn + x2 * c_);
        }
        {   int kq = 256; asm volatile("" : "+s"(kq)); pg8::Gemm g{(const bf16_t*)(ws + WS_ZQ), WqbT, kq, kq, kq}; pg8::StaticOrder S; S.init(T, 768, 256, 256, G, bx);
            EpiQ E{(const float*)(ws + WS_SSQQ), (bf16_t*)(ws + WS_QB)};
            pg8::gemm_phase<EpiQ, pg8::StaticOrder, true, true>(lds, g, S, E); }
        {   int kk = 128; asm volatile("" : "+s"(kk)); pg8::Gemm g{(const bf16_t*)(ws + WS_ZKV), WkvbT, kk, kk, kk}; const bool memcu = ((bx + 64) % G) < 32 && G > 64; const int bx2 = bx - (bx >= G - 64 + 32 ? 32 : 0);
            pg8::StaticOrder S; S.init(memcu ? 0 : T, 1024, 128, 128, G > 64 ? G - 32 : G, G > 64 ? bx2 : bx);
            EpiKV E{(const float*)(ws + WS_SSQKV), (bf16_t*)(ws + WS_KN), (bf16_t*)(ws + WS_VB)};
            pg8::gemm_phase<EpiKV, pg8::StaticOrder, true, true>(lds, g, S, E); }
        {   int kx = 1024; asm volatile("" : "+s"(kx)); pg8::Gemm g{memb, WmkvT, kx, kx, kx}; pg8::StaticOrder S; S.init(NB * NMEM, 2048, 1024, 1024, G, (bx + 64) % G);
            EpiRowScale E{rstd_mem, (bf16_t*)(ws + WS_KVMEM), 2048};
            pg8::gemm_phase<EpiRowScale, pg8::StaticOrder, true, true>(lds, g, S, E); }
    }
    GRID_BAR(2);
    if (IN(3)) {
        const unsigned short* Qg = (const unsigned short*)(ws + WS_QB); const unsigned short* Kn = (const unsigned short*)(ws + WS_KN);
        const unsigned short* Kp = (const unsigned short*)(ws + WS_KPE); const unsigned short* Vg = (const unsigned short*)(ws + WS_VB);
        const float* cs = (const float*)(ws + WS_CS); unsigned short* Og = (unsigned short*)(ws + WS_OB);
        for (int i = 0; !(args.flags & 8); ++i) {
            int bh, qb;
            if (G == 256) { if (i >= 2) break; const int idx = i * 32 + (bx >> 3); bh = (bx & 7) + 8 * (idx >> 4); qb = idx & 15; }
            else { const int un = i * G + bx; if (un >= 512) break; bh = un >> 4; qb = un & 15; }
            const int b = bh >> 3, h = bh & 7;
#ifdef MLA_ABL
            if (args.flags & 16) mla::mla_unit<MLA_ABL>(Qg, Kn, Kp, Vg, cs, Og, b * S + qb * 256, b * S, h, S, (char*)lds_raw); else
#endif
            mla::mla_unit<0>(Qg, Kn, Kp, Vg, cs, Og, b * S + qb * 256, b * S, h, S, (char*)lds_raw);
        }
        {
            const unsigned short* qkv = (const unsigned short*)(ws + WS_QKVA); const int* pos = (const int*)args.in[2];
            const float* tbl = (const float*)(ws + WS_TBL); unsigned short* oap = (unsigned short*)(ws + WS_OAP); float* lse = (float*)(ws + WS_LSE);
            char* wl = (char*)lds_raw + wave * dil::W_BYTES;
            __syncthreads();
            int cur_h = -1;
            dil::TaskId tc = dil::task_at(0, bx, G, wave), tn = tc; dil::Pre P;
            bool have = !(args.flags & 4) && tc.ub >= 0;
            if (have) dil::dil_prefetch(qkv, pos, tc, P);
            for (int i = 0; have; ++i) {
                tn = dil::task_at(i + 1, bx, G, wave); const bool has_next = tn.ub >= 0;
                if (tc.h != cur_h) { float* tw = (float*)(wl + dil::W_TBL); for (int j = lane; j < 2049; j += 64) tw[j ^ ((j >> 5) & 31)] = tbl[tc.h * dil::TBL_PITCH + j] * 1.4426950408889634f; cur_h = tc.h; asm volatile("s_waitcnt vmcnt(0) lgkmcnt(0)" ::: "memory"); }
                dil::dil_task(qkv, pos, oap, lse, tc, P, has_next, tn, wl);
                tc = tn; have = has_next;
            }
        }
    }
    GRID_BAR(3);
    if (IN(4)) {
        { int kx = 256; asm volatile("" : "+s"(kx));
          if (bx < 64) { pg8::Gemm g{(const bf16_t*)(ws + WS_KVMEM), Wmqg, 2048, 1024, kx}; OrderWp S{bx}; EpiPlain E{(bf16_t*)(ws + WS_WPT), 1024};
              pg8::gemm_phase<EpiPlain, OrderWp, true, true>(lds, g, S, E); }
          else if (bx < 128) { pg8::Gemm g{WmoT, (const bf16_t*)(ws + WS_KVMEM), 1024, 2048, kx}; OrderVw S{bx - 64}; EpiPlain E{(bf16_t*)(ws + WS_VWT), 1024};
              pg8::gemm_phase<EpiPlain, OrderVw, true, true>(lds, g, S, E); } }
        const bf16_t* oap = (const bf16_t*)(ws + WS_OAP); const float* lse = (const float*)(ws + WS_LSE); const bf16_t* obp = (const bf16_t*)(ws + WS_OB);
        const float* g_out_a = args.in[10]; const float* g_out_b = args.in[11]; bf16_t* omix = (bf16_t*)(ws + WS_OMIX);
        const int gw = vcu * NWAVES + wave, NGW = G * NWAVES;
        const f32x4 ga0 = *(const f32x4*)(g_out_a + 8 * lane), ga1 = *(const f32x4*)(g_out_a + 8 * lane + 4), gb0 = *(const f32x4*)(g_out_b + 8 * lane), gb1 = *(const f32x4*)(g_out_b + 8 * lane + 4);
#define UNPK_LO(V_) ((f32x4){__builtin_bit_cast(float, (V_)[0] << 16), __builtin_bit_cast(float, (V_)[0] & 0xffff0000u), __builtin_bit_cast(float, (V_)[1] << 16), __builtin_bit_cast(float, (V_)[1] & 0xffff0000u)})
#define UNPK_HI(V_) ((f32x4){__builtin_bit_cast(float, (V_)[2] << 16), __builtin_bit_cast(float, (V_)[2] & 0xffff0000u), __builtin_bit_cast(float, (V_)[3] << 16), __builtin_bit_cast(float, (V_)[3] & 0xffff0000u)})
        for (int tok = gw; tok < T; tok += NGW) {
            const int head = lane >> 3;
            const float l0 = lse[((size_t)0 * T + tok) * 8 + head], l1 = lse[((size_t)1 * T + tok) * 8 + head], l2 = lse[((size_t)2 * T + tok) * 8 + head];
            const float mx = fmaxf(l0, fmaxf(l1, l2)); float w0 = __expf(l0 - mx), w1 = __expf(l1 - mx), w2 = __expf(l2 - mx); const float wi = 1.0f / (w0 + w1 + w2); w0 *= wi; w1 *= wi; w2 *= wi;
            const v4u q0 = *(const v4u*)(oap + ((size_t)0 * T + tok) * 512 + 8 * lane), q1 = *(const v4u*)(oap + ((size_t)1 * T + tok) * 512 + 8 * lane);
            const v4u q2 = *(const v4u*)(oap + ((size_t)2 * T + tok) * 512 + 8 * lane), qb = *(const v4u*)(obp + (size_t)tok * 512 + 8 * lane);
            const f32x4 a0 = UNPK_LO(q0) * w0 + UNPK_LO(q1) * w1 + UNPK_LO(q2) * w2, a1 = UNPK_HI(q0) * w0 + UNPK_HI(q1) * w1 + UNPK_HI(q2) * w2, b0 = UNPK_LO(qb), b1 = UNPK_HI(qb);
            const float sa = wave_sum(sq8(a0, a1)), sb = wave_sum(sq8(b0, b1));
            const float ra = 1.0f / sqrtf(sa * (1.0f / 512.0f) + 1e-6f), rb = 1.0f / sqrtf(sb * (1.0f / 512.0f) + 1e-6f);
            *(v4u*)(omix + (size_t)tok * 1024 + 8 * lane) = pack8(a0 * ra * ga0, a1 * ra * ga1);
            *(v4u*)(omix + (size_t)tok * 1024 + 512 + 8 * lane) = pack8(b0 * rb * gb0, b1 * rb * gb1);
        }
#undef UNPK_LO
#undef UNPK_HI
    }
    GRID_BAR(4);
    if (IN(5)) {
        int kx = 1024; asm volatile("" : "+s"(kx));
        pg8::Gemm g{(const bf16_t*)(ws + WS_OMIX), WoT, kx, kx, kx}; pg8::StaticOrder S; S.init(T, 1024, 1024, 1024, G, bx);
        EpiResid<false> E{x, (bf16_t*)(ws + WS_H1B), (float*)(ws + WS_SSQH1)};
        pg8::gemm_phase<EpiResid<false>, pg8::StaticOrder, true, true>(lds, g, S, E);
    }
    GRID_BAR(5);
    if (IN(6)) {
        int kx = 1024; asm volatile("" : "+s"(kx));
        pg8::Gemm g{(const bf16_t*)(ws + WS_H1B), (const bf16_t*)(ws + WS_WPT), kx, kx, kx}; OrderBatch S; S.so.init(T, 1024, 1024, 1024, G, bx);
        pg8::Unit u0; const bool has = S.next(0, u0);
        LAS float* rsl = (LAS float*)(lds + CTRL_OFF + 1024);
        if (has && tid < 256) { const float* sp = (const float*)(ws + WS_SSQH1) + (size_t)(u0.pm * 256 + tid) * 16; float a = 0.f;
#pragma unroll
            for (int j = 0; j < 4; ++j) { const f32x4 v = ((const f32x4*)sp)[j]; a += (v[0] + v[1]) + (v[2] + v[3]); }
            rsl[tid] = 1.0f / sqrtf(a * (1.0f / 1024.0f) + 1e-6f); }
        __syncthreads();
        EpiSoftmax E{(bf16_t*)(ws + WS_P), CTRL_OFF + 1024};
        pg8::gemm_phase<EpiSoftmax, OrderBatch, false, true>(lds, g, S, E);
    }
    GRID_BAR(6);
    if (IN(7)) {
        int kx = 1024; asm volatile("" : "+s"(kx));
        pg8::Gemm g{(const bf16_t*)(ws + WS_P), (const bf16_t*)(ws + WS_VWT), kx, kx, kx}; OrderBatch S; S.so.init(T, 1024, 1024, 1024, G, bx);
        EpiResid<true> E{(const bf16_t*)(ws + WS_H1B), (bf16_t*)(ws + WS_H2B), (float*)(ws + WS_SSQH2)};
        pg8::gemm_phase<EpiResid<true>, OrderBatch, true, true>(lds, g, S, E);
    }
    GRID_BAR(7);
    if (IN(8)) {
        typedef float f32x16 __attribute__((ext_vector_type(16)));
        const bf16_t* h2b = (const bf16_t*)(ws + WS_H2B); const float* b_router = args.in[20]; const float* ssq2 = (const float*)(ws + WS_SSQH2);
        int* topi = (int*)(ws + WS_ROUTE + RT_TOPI); float* topg = (float*)(ws + WS_ROUTE + RT_TOPG); int* tslot = (int*)(ws + WS_ROUTE + RT_SLOT); int* row_flat = (int*)(ws + WS_ROUTE + RT_ROWFLAT);
        for (int i = bx * 512 + tid; i < MPADN; i += G * 512) row_flat[i] = -1;
        LAS float* part = (LAS float*)lds;
        LAS float* lgt = (LAS float*)(lds + 32768);
        for (int ch = bx; ch < T / 64; ch += G) {
            const int tok0 = ch * 64, tb = wave & 1, kq = wave >> 1, kh = lane >> 5, row = tok0 + 32 * tb + (lane & 31);
            f32x16 acc = {};
            const bf16_t* ap = h2b + (size_t)row * 1024 + 256 * kq + 4 * kh; const float* wp = (const float*)(ws + WS_WRG) + (size_t)(256 * kq + 4 * kh) * 32 + (lane & 31);
#pragma unroll 8
            for (int j = 0; j < 32; ++j) {
                const v2u aw = *(const v2u*)(ap + 8 * j);
                const f32x4 a4 = (f32x4){__builtin_bit_cast(float, aw.x << 16), __builtin_bit_cast(float, aw.x & 0xffff0000u), __builtin_bit_cast(float, aw.y << 16), __builtin_bit_cast(float, aw.y & 0xffff0000u)};
#pragma unroll
                for (int e = 0; e < 4; ++e) acc = __builtin_amdgcn_mfma_f32_32x32x2f32(a4[e], wp[(size_t)(8 * j + e) * 32], acc, 0, 0, 0);
            }
#pragma unroll
            for (int r = 0; r < 16; ++r) part[((kq * 64) + tb * 32 + (r & 3) + 8 * (r >> 2) + 4 * kh) * 32 + (lane & 31)] = acc[r];
            __syncthreads();
            {
                const int tk = tid >> 3, e0 = (tid & 7) * 4; const float* sp = ssq2 + (size_t)(tok0 + tk) * 16; float a = 0.f;
#pragma unroll
                for (int j = 0; j < 4; ++j) { const f32x4 v = ((const f32x4*)sp)[j]; a += (v[0] + v[1]) + (v[2] + v[3]); }
                const float rs = 1.0f / sqrtf(a * (1.0f / 1024.0f) + 1e-6f);
                if (e0 == 0) ((float*)(ws + WS_ROUTE + RT_RSTD))[tok0 + tk] = rs;
#pragma unroll
                for (int e = 0; e < 4; ++e) lgt[tk * 33 + e0 + e] = rs * ((part[(0 * 64 + tk) * 32 + e0 + e] + part[(1 * 64 + tk) * 32 + e0 + e]) + (part[(2 * 64 + tk) * 32 + e0 + e] + part[(3 * 64 + tk) * 32 + e0 + e])) + b_router[e0 + e];
            }
            __syncthreads();
            if (tid < 64) {
                int c0 = -1, c1 = -1, c2 = -1, c3 = -1; float v0 = 0.f, v1 = 0.f, v2 = 0.f, v3 = 0.f; int s0 = 0, s1 = 0, s2 = 0, s3 = 0;
                for (int k = 0; k < 4; ++k) {
                    float best = -3.0e38f; int bi = 0;
                    for (int e = 0; e < 32; ++e) { const float v = lgt[tid * 33 + e]; if (e == c0 || e == c1 || e == c2 || e == c3) continue; if (v > best) { best = v; bi = e; } }
                    if (k == 0) { c0 = bi; v0 = best; } else if (k == 1) { c1 = bi; v1 = best; } else if (k == 2) { c2 = bi; v2 = best; } else { c3 = bi; v3 = best; }
                }
                const unsigned long long lt = (1ull << lane) - 1ull; int* cntc = (int*)(ws + WS_ROUTE + RT_CNT) + ch * 32;
                for (int e = 0; e < 32; ++e) {
                    const unsigned long long m0 = __ballot(c0 == e), m1 = __ballot(c1 == e), m2 = __ballot(c2 == e), m3 = __ballot(c3 == e);
                    const int before = __popcll(m0 & lt) + __popcll(m1 & lt) + __popcll(m2 & lt) + __popcll(m3 & lt);
                    if (c0 == e) s0 = before; if (c1 == e) s1 = before; if (c2 == e) s2 = before; if (c3 == e) s3 = before;
                    if (lane == e) cntc[e] = __popcll(m0) + __popcll(m1) + __popcll(m2) + __popcll(m3);
                }
                const int t = tok0 + tid;
                const float e1 = __expf(v1 - v0), e2 = __expf(v2 - v0), e3 = __expf(v3 - v0), inv = 1.0f / (1.0f + e1 + e2 + e3);
                *(int4*)(topi + t * 4) = make_int4(c0, c1, c2, c3);
                *(f32x4*)(topg + t * 4) = (f32x4){inv, e1 * inv, e2 * inv, e3 * inv};
                *(int4*)(tslot + t * 4) = make_int4(s0, s1, s2, s3);
            }
            __syncthreads();
        }
    }
    GRID_BAR(8);
    if (IN(9)) {
        const int* topi = (const int*)(ws + WS_ROUTE + RT_TOPI); const int* tslot = (const int*)(ws + WS_ROUTE + RT_SLOT); const int* cnt = (const int*)(ws + WS_ROUTE + RT_CNT);
        int* row_flat = (int*)(ws + WS_ROUTE + RT_ROWFLAT); float* rs_row = (float*)(ws + WS_ROUTE + RT_RSROW); const float* rstd2 = (const float*)(ws + WS_ROUTE + RT_RSTD);
        LAS int* red = (LAS int*)lds;
        for (int base = bx * 512; base < NA; base += G * 512) {
            const int chA = base >> 8, e = tid & 31, part = tid >> 5;
            int tot = 0, pa = 0, pb = 0;
            for (int c = part; c < T / 64; c += 16) { const int v = cnt[c * 32 + e]; tot += v; pa += c < chA ? v : 0; pb += c <= chA ? v : 0; }
            __syncthreads();
            red[(0 * 16 + part) * 32 + e] = tot; red[(1 * 16 + part) * 32 + e] = pa; red[(2 * 16 + part) * 32 + e] = pb;
            __syncthreads();
            if (tid < 96) { const int w = tid >> 5; int a = 0; for (int p = 0; p < 16; ++p) a += red[(w * 16 + p) * 32 + e]; red[1536 + w * 32 + e] = a; }
            __syncthreads();
            if (tid == 0) { int run = 0; for (int q = 0; q < NE; ++q) { red[1632 + q] = run; run += ((red[1536 + q] + 255) >> 8) << 8; } }
            if (bx == 0 && base == 0 && tid < 32) ((int*)(ws + WS_ROUTE + RT_TOT))[tid] = red[1536 + tid];
            __syncthreads();
            const int a = base + tid, ex = topi[a], row = red[1632 + ex] + red[1536 + 32 * (1 + (((a >> 8) - chA) & 1)) + ex] + tslot[a];
            row_flat[row] = a; rs_row[row] = rstd2[a >> 2];
        }
    }
    GRID_BAR(9);
    if (IN(10) || IN(11)) {
        const int* gtot = (const int*)(ws + WS_ROUTE + RT_TOT); LAS int* texp = (LAS int*)(lds + LX_TEXP);
        __syncthreads();
        if (tid == 0) { int nt = 0; for (int e = 0; e < NE; ++e) { const int n = (gtot[e] + 255) >> 8; for (int j = 0; j < n; ++j) texp[nt + j] = e; nt += n; } texp[NTILEN] = nt; }
        __syncthreads();
    }
    if (IN(10)) {
        int kx = 1024; asm volatile("" : "+s"(kx));
        pg8::Gemm g{(const bf16_t*)(ws + WS_H2B), WguT, kx, kx, kx}; OrderMoe S{(const LAS int*)(lds + LX_TEXP), 8, bx, G, (size_t)2048 * 1024 * 2};
        {
            const int* row_flat = (const int*)(ws + WS_ROUTE + RT_ROWFLAT); pg8::Unit u;
            for (int i = 0; i < pg8::GTAB_UNITS; ++i) { if (!S.next(i, u)) break; if (tid < 256) { const int a = row_flat[u.pm * 256 + tid]; ((LAS unsigned short*)(lds + pg8::GTAB))[i * 256 + tid] = (unsigned short)(a >= 0 ? (a >> 2) : 0); } }
            __syncthreads();
        }
        EpiSwiGLU E{(const float*)(ws + WS_ROUTE + RT_RSROW), args.in[22], (bf16_t*)(ws + WS_HMID), (const LAS int*)(lds + LX_TEXP)};
        pg8::gemm_phase<EpiSwiGLU, OrderMoe, true, true, true>(lds, g, S, E);
    }
    GRID_BAR(10);
    if (IN(11)) {
        int kx = 1024; asm volatile("" : "+s"(kx));
        pg8::Gemm g{(const bf16_t*)(ws + WS_HMID), WdT, kx, kx, kx}; OrderMoe S{(const LAS int*)(lds + LX_TEXP), 4, bx, G, (size_t)1024 * 1024 * 2};
        EpiDown E{(const int*)(ws + WS_ROUTE + RT_ROWFLAT), (const float*)(ws + WS_ROUTE + RT_TOPG), args.in[24], (bf16_t*)(ws + WS_YBUF), (const LAS int*)(lds + LX_TEXP)};
        pg8::gemm_phase<EpiDown, OrderMoe, true, true>(lds, g, S, E);
    }
    GRID_BAR(11);
    if (IN(12)) {
        const bf16_t* h2b = (const bf16_t*)(ws + WS_H2B); const bf16_t* ybuf = (const bf16_t*)(ws + WS_YBUF); const float* g_final = args.in[25]; float* outp = args.out;
        const int gw = vcu * NWAVES + wave, NGW = G * NWAVES;
        for (int t = gw; t < T; t += NGW) {
            f32x4 v[4]; float ss = 0.f;
#pragma unroll
            for (int j = 0; j < 4; ++j) {
                const v2u hw = *(const v2u*)(h2b + (size_t)t * 1024 + 256 * j + 4 * lane);
                f32x4 a = (f32x4){__builtin_bit_cast(float, hw.x << 16), __builtin_bit_cast(float, hw.x & 0xffff0000u), __builtin_bit_cast(float, hw.y << 16), __builtin_bit_cast(float, hw.y & 0xffff0000u)};
#pragma unroll
                for (int k = 0; k < 4; ++k) { const v2u y = *(const v2u*)(ybuf + ((size_t)t * 4 + k) * 1024 + 256 * j + 4 * lane);
                    a[0] += __builtin_bit_cast(float, y.x << 16); a[1] += __builtin_bit_cast(float, y.x & 0xffff0000u); a[2] += __builtin_bit_cast(float, y.y << 16); a[3] += __builtin_bit_cast(float, y.y & 0xffff0000u); }
                v[j] = a; ss += (a[0] * a[0] + a[1] * a[1]) + (a[2] * a[2] + a[3] * a[3]);
            }
            ss = wave_sum(ss); const float rs = 1.0f / sqrtf(ss * (1.0f / 1024.0f) + 1e-6f);
#pragma unroll
            for (int j = 0; j < 4; ++j) *(f32x4*)(outp + (size_t)t * 1024 + 256 * j + 4 * lane) = v[j] * rs * *(const f32x4*)(g_final + 256 * j + 4 * lane);
        }
    }
#undef GRID_BAR
#undef BOTH
#undef IN
}

}
void launch_mk(hipStream_t st, const mk::Args& base, int lo, int hi, int grid) {
    mk::Args a = base; a.ph_lo = lo; a.ph_hi = hi;
    hipLaunchKernelGGL(mk::mk_fwd, dim3(grid), dim3(mk::NWAVES * 64), mk::LDS_BYTES, st, a);
}
}

extern "C" void kernel_launch(void* const* d_in, const int* in_sizes, int n_in, void* d_out, int out_size, void* d_ws, size_t ws_size, hipStream_t stream) {
    static int grid = 0;
    if (grid == 0) {
        int dev = 0, cus = 0;
        if (hipGetDevice(&dev) != hipSuccess || hipDeviceGetAttribute(&cus, hipDeviceAttributeMultiprocessorCount, dev) != hipSuccess) { grid = -1; return; }
        if (hipFuncSetAttribute((const void*)mk::mk_fwd, hipFuncAttributeMaxDynamicSharedMemorySize, mk::LDS_BYTES) != hipSuccess) { grid = -1; return; }
        grid = cus >= 256 ? 256 : cus;
    }
    if (grid < 0) return;
    const float* x = (const float*)d_in[0];
    const float* mem = (const float*)d_in[1];
    const int* pos = (const int*)d_in[2];
    const float* g_q_a = (const float*)d_in[5];
    const float* w_q_b = (const float*)d_in[6];
    const float* g_kv_a = (const float*)d_in[7];
    const float* w_kv_b = (const float*)d_in[8];
    const float* rel_bias = (const float*)d_in[9];
    const float* g_out_a = (const float*)d_in[10];
    const float* g_out_b = (const float*)d_in[11];
    const float* w_o = (const float*)d_in[12];
    const float* g_xattn = (const float*)d_in[13];
    const float* g_mem = (const float*)d_in[14];
    const float* w_mq = (const float*)d_in[15];
    const float* w_mkv = (const float*)d_in[16];
    const float* w_mo = (const float*)d_in[17];
    const float* g_moe = (const float*)d_in[18];
    const float* w_router = (const float*)d_in[19];
    const float* b_router = (const float*)d_in[20];
    const float* w_gate_up = (const float*)d_in[21];
    const float* b_gate_up = (const float*)d_in[22];
    const float* w_down = (const float*)d_in[23];
    const float* b_down = (const float*)d_in[24];
    const float* g_final = (const float*)d_in[25];
    float* out = (float*)d_out;
    (void)ws_size; (void)in_sizes; (void)n_in; (void)out_size;

    (void)hipMemsetAsync((char*)d_ws + mk::WS_CTL, 0, mk::CTL_ZERO_BYTES, stream);
    mk::Args ma; memset(&ma, 0, sizeof(ma));
    for (int i = 0; i < 26; ++i) ma.in[i] = (const float*)d_in[i];
    ma.out = out; ma.ws = (unsigned char*)d_ws; ma.flags = 1;
    for (int j = 0; j < 16; ++j) ma.rope_rev[j] = pow(10000.0, -(double)j / 16.0) / 6.283185307179586476925287;
#ifndef MK_N_LAUNCHES
#define MK_N_LAUNCHES 1
#endif
    if (MK_N_LAUNCHES == 1) launch_mk(stream, ma, 0, 13, grid);
    else for (int p = 0; p < 13; ++p) launch_mk(stream, ma, p, p + 1, grid);
#ifdef PROBE_MASK
#ifdef PROBE_FLAGS
    ma.flags |= PROBE_FLAGS;
#endif
    for (int r = 0; r < PROBE_N; ++r) for (int p = 0; p < 13; ++p) if ((PROBE_MASK >> p) & 1) launch_mk(stream, ma, p, p + 1, grid);
#endif
}
```

```cpp
#include <hip/hip_runtime.h>
#include <stdint.h>
#include <string.h>
#include <math.h>

namespace {
constexpr int NB = 4, S = 4096, D = 1024, T = NB * S, NMEM = 256, INW = 1952;
constexpr int NE = 32, TOPK = 4, NA = T * TOPK;

namespace pg8 {
#define PG8_LAS __attribute__((address_space(3)))
typedef unsigned short bf16_t;
typedef short bf16x8 __attribute__((ext_vector_type(8)));
typedef float f32x4 __attribute__((ext_vector_type(4)));
typedef unsigned u32x4 __attribute__((ext_vector_type(4)));
constexpr int BM = 256, BK = 64, HALF = 128, HTB = HALF * BK * 2  , STAGE_BYTES = 8 * HTB, NXCD = 8, WGM = 8;

__host__ __device__ __forceinline__ int lds_byte(int r, int c) { const int st = (r >> 4) * 2 + (c >> 5), rr = r & 15, cc = c & 31, ob = rr * 64 + cc * 2; return st * 1024 + (ob ^ (((ob >> 9) & 1) << 5)); }
__host__ __device__ __forceinline__ void stage_rc(int b, int& R, int& C) { const int st = b / 1024, sb = b % 1024, swz = sb ^ (((sb >> 9) & 1) << 5); R = (st >> 1) * 16 + swz / 64; C = (st & 1) * 32 + (swz % 64) / 2; }
__host__ __device__ __forceinline__ int perm32(int rho) { const int n = rho >> 4, i = rho & 15; return 8 * (i >> 2) + 4 * n + (i & 3); }

struct Unit { int pm, pn; size_t aoff, boff; };
struct Gemm { const bf16_t* A; const bf16_t* Bt; int lda, ldb, K; };

struct StaticOrder {
    int nM, nN, nwg, G, c; size_t ta, tb;
    __host__ __device__ __forceinline__ void init(int M, int N, int lda, int ldb, int G_, int c_) { nM = M / BM; nN = N / BM; nwg = nM * nN; G = G_; c = c_; ta = (size_t)BM * lda * 2; tb = (size_t)BM * ldb * 2; }
    __host__ __device__ __forceinline__ bool next(int i, Unit& u) const {
        const long L = (long)i * G + c; if (L >= nwg) return false;
        int wgid = (int)L; { const int q = nwg / NXCD, r = nwg % NXCD, xcd = wgid % NXCD, off = wgid / NXCD; wgid = (xcd < r ? xcd * (q + 1) : r * (q + 1) + (xcd - r) * q) + off; }
        const int nig = WGM * nN, gid = wgid / nig, fm = gid * WGM, gsz = (nM - fm) < WGM ? (nM - fm) : WGM;
        u.pm = fm + ((wgid % nig) % gsz); u.pn = (wgid % nig) / gsz; u.aoff = (size_t)u.pm * ta; u.boff = (size_t)u.pn * tb; return true;
    }
    __device__ __forceinline__ void a_ready(const Unit&) const {}
    __device__ __forceinline__ void done(const Unit&) const {}
};

__device__ __forceinline__ unsigned cvt_pk_bf16(float lo, float hi) { unsigned r; asm volatile("v_cvt_pk_bf16_f32 %0, %1, %2" : "=v"(r) : "v"(lo), "v"(hi)); return r; }
typedef float f32x2 __attribute__((ext_vector_type(2)));

constexpr int GTAB = 135168 + 4096, GTAB_UNITS = 10;
template <class Epi, class Sched, bool ALIGN_EPI = false, bool SP2 = false, bool GATHER = false>
__device__ __forceinline__ void gemm_phase(PG8_LAS unsigned char* lds, const Gemm g, const Sched& S, const Epi& E) {
    const int tid = threadIdx.x, wid = __builtin_amdgcn_readfirstlane(tid >> 6), lane = tid & 63, wr = wid >> 2, wc = wid & 3, fr = lane & 15, fq = lane >> 4;
    static_assert(!GATHER || SP2, "GATHER is implemented for the SP2 loop only");
    const int K = g.K, nt = K / BK;
    unsigned voffA[2], voffB[2];
#pragma unroll
    for (int i = 0; i < 2; ++i) { int R, C; stage_rc(tid * 16 + i * 8192, R, C); const int Rb = Epi::PERM ? ((R & ~31) + perm32(R & 31)) : R;
        voffA[i] = (unsigned)(R * g.lda + C) * 2u; voffB[i] = (unsigned)(Rb * g.ldb + C) * 2u; }
    unsigned gidx[2], gcol[2];
#pragma unroll
    for (int i = 0; i < 2; ++i) { int R, C; stage_rc(tid * 16 + i * 8192, R, C); gidx[i] = (unsigned)R * 2u; gcol[i] = (unsigned)C * 2u; }
    const size_t kstep = (size_t)(BK * 2);
    const size_t hstepA = (size_t)HALF * g.lda * 2, hstepB = (size_t)HALF * g.ldb * 2;
    const unsigned ldsw = (unsigned)wid * 1024u;
    const int aoff = lds_byte(wr * 64 + fr, fq * 8), boff = lds_byte(wc * 32 + fr, fq * 8);
#define PG8_SA(b, h) (((b) * 2 + (h)) * HTB)
#define PG8_SB(b, h) ((4 + (b) * 2 + (h)) * HTB)
#define PG8_STAGE(bufoff, gbase, voff) do { _Pragma("unroll") for (int _i = 0; _i < 2; ++_i) \
        __builtin_amdgcn_global_load_lds((const unsigned*)((const char*)(gbase) + (voff)[_i]), (PG8_LAS unsigned*)(lds + (bufoff) + ldsw + _i * 8192), 16, 0, 0); } while (0)
#define PG8_GTOK(h, sel) do { if constexpr (GATHER) { tk0 = *(const PG8_LAS unsigned short*)(lds + GTAB + (sel) * 512 + (h) * 256 + gidx[0]); tk1 = *(const PG8_LAS unsigned short*)(lds + GTAB + (sel) * 512 + (h) * 256 + gidx[1]); } } while (0)
#define PG8_STAGE_A(bufoff, gbase, h, sel) do { if constexpr (GATHER) { \
        __builtin_amdgcn_global_load_lds((const unsigned*)((const char*)(gbase) + (size_t)tk0 * (size_t)(g.lda * 2) + gcol[0]), (PG8_LAS unsigned*)(lds + (bufoff) + ldsw), 16, 0, 0); \
        __builtin_amdgcn_global_load_lds((const unsigned*)((const char*)(gbase) + (size_t)tk1 * (size_t)(g.lda * 2) + gcol[1]), (PG8_LAS unsigned*)(lds + (bufoff) + ldsw + 8192), 16, 0, 0); } \
    else { PG8_STAGE(bufoff, (gbase) + (h) * hstepA, voffA); } } while (0)
#define PG8_LDA(dst, b, h) do { _Pragma("unroll") for (int m = 0; m < 4; ++m) _Pragma("unroll") for (int k = 0; k < 2; ++k) dst[m][k] = *(const PG8_LAS bf16x8*)(lds + PG8_SA(b, h) + aoff + m * 2048 + k * 1024); } while (0)
#define PG8_LDB(dst, b, h) do { _Pragma("unroll") for (int n = 0; n < 2; ++n) _Pragma("unroll") for (int k = 0; k < 2; ++k) dst[n][k] = *(const PG8_LAS bf16x8*)(lds + PG8_SB(b, h) + boff + n * 2048 + k * 1024); } while (0)
#define PG8_MMA(ai, bj, At, Bt) do { __builtin_amdgcn_s_setprio(1); _Pragma("unroll") for (int m = 0; m < 4; ++m) _Pragma("unroll") for (int n = 0; n < 2; ++n) _Pragma("unroll") for (int k = 0; k < 2; ++k) \
        acc[ai][bj][m][n] = __builtin_amdgcn_mfma_f32_16x16x32_bf16(Bt[n][k], At[m][k], acc[ai][bj][m][n], 0, 0, 0); __builtin_amdgcn_s_setprio(0); } while (0)
#define PG8_WAIT_V(n) asm volatile("s_waitcnt vmcnt(" #n ")" ::: "memory")
#define PG8_WAIT_L(n) asm volatile("s_waitcnt lgkmcnt(" #n ")" ::: "memory")
#define PG8_BAR __builtin_amdgcn_s_barrier()
#define PG8_SCHED __builtin_amdgcn_sched_barrier(0)
    Unit cur, nxt; int ui = 0; unsigned tk0 = 0, tk1 = 0; (void)tk0; (void)tk1;
    if (!S.next(0, cur)) return;
    f32x4 acc[2][2][4][2];
#pragma unroll
    for (int a = 0; a < 2; ++a)
#pragma unroll
        for (int b = 0; b < 2; ++b)
#pragma unroll
            for (int m = 0; m < 4; ++m)
#pragma unroll
                for (int n = 0; n < 2; ++n) acc[a][b][m][n] = (f32x4){0.f, 0.f, 0.f, 0.f};
    bf16x8 At[4][2], B0[2][2], B1[2][2];
    const char* cA = (const char*)g.A + (GATHER ? (size_t)0 : cur.aoff); const char* cB = (const char*)g.Bt + cur.boff;
    S.a_ready(cur);
    if constexpr (SP2) {
        PG8_STAGE(PG8_SB(0, 0), cB, voffB); PG8_STAGE(PG8_SB(0, 1), cB + hstepB, voffB); PG8_GTOK(0, ui); PG8_STAGE_A(PG8_SA(0, 0), cA, 0, ui); PG8_GTOK(1, ui); PG8_STAGE_A(PG8_SA(0, 1), cA, 1, ui);
        if (wr == 1) PG8_BAR;
        PG8_WAIT_V(2); PG8_BAR;
        PG8_STAGE(PG8_SB(1, 0), cB + kstep, voffB); PG8_GTOK(0, ui); PG8_STAGE_A(PG8_SA(1, 0), cA + kstep, 0, ui); PG8_STAGE(PG8_SB(1, 1), cB + hstepB + kstep, voffB);
        PG8_WAIT_V(6); PG8_BAR;
    } else {
        PG8_STAGE(PG8_SB(0, 0), cB, voffB); PG8_STAGE_A(PG8_SA(0, 0), cA, 0, ui); PG8_STAGE(PG8_SB(0, 1), cB + hstepB, voffB); PG8_STAGE_A(PG8_SA(0, 1), cA, 1, ui);
        if (wr == 1) PG8_BAR;
        PG8_WAIT_V(4); PG8_BAR;
        PG8_STAGE(PG8_SB(1, 0), cB + kstep, voffB); PG8_STAGE_A(PG8_SA(1, 0), cA + kstep, 0, ui); PG8_STAGE(PG8_SB(1, 1), cB + hstepB + kstep, voffB);
        PG8_WAIT_V(6); PG8_BAR;
    }
    for (;;) {
        const bool has_next = S.next(ui + 1, nxt);
        const char* nA = has_next ? (const char*)g.A + (GATHER ? (size_t)0 : nxt.aoff) : cA; const char* nB = has_next ? (const char*)g.Bt + nxt.boff : cB;
        for (int t = 0; t < nt; t += 2) {
            const bool last = (t == nt - 2);
            const char* a1 = cA + (size_t)(t + 1) * kstep;
            const char* a2 = last ? nA : cA + (size_t)(t + 2) * kstep; const char* b2 = last ? nB : cB + (size_t)(t + 2) * kstep;
            const char* a3 = a2 + kstep; const char* b3 = b2 + kstep; const int ui2 = (last && has_next) ? ui + 1 : ui; (void)ui2;
            if (last && has_next) S.a_ready(nxt);
            if constexpr (SP2) {
            PG8_GTOK(1, ui); PG8_LDB(B0, 0, 0); PG8_LDB(B1, 0, 1); PG8_SCHED; PG8_LDA(At, 0, 0); PG8_STAGE_A(PG8_SA(1, 1), a1, 1, ui);
            PG8_WAIT_V(8); PG8_WAIT_L(0); PG8_BAR; PG8_MMA(0, 0, At, B0); PG8_MMA(0, 1, At, B1); PG8_BAR; PG8_SCHED;
            PG8_GTOK(0, ui2); PG8_LDA(At, 0, 1); PG8_STAGE(PG8_SB(0, 0), b2, voffB); PG8_STAGE(PG8_SB(0, 1), b2 + hstepB, voffB); PG8_STAGE_A(PG8_SA(0, 0), a2, 0, ui2);
            PG8_WAIT_V(8); PG8_WAIT_L(0); PG8_BAR; PG8_MMA(1, 0, At, B0); PG8_MMA(1, 1, At, B1); PG8_BAR; PG8_SCHED;
            PG8_GTOK(1, ui2); PG8_LDB(B0, 1, 0); PG8_LDB(B1, 1, 1); PG8_SCHED; PG8_LDA(At, 1, 0); PG8_STAGE_A(PG8_SA(0, 1), a2, 1, ui2);
            PG8_WAIT_V(8); PG8_WAIT_L(0); PG8_BAR; PG8_MMA(0, 0, At, B0); PG8_MMA(0, 1, At, B1); PG8_BAR; PG8_SCHED;
            PG8_GTOK(0, ui2); PG8_LDA(At, 1, 1); PG8_STAGE(PG8_SB(1, 0), b3, voffB); PG8_STAGE(PG8_SB(1, 1), b3 + hstepB, voffB); PG8_STAGE_A(PG8_SA(1, 0), a3, 0, ui2);
            PG8_WAIT_V(8); PG8_WAIT_L(0); PG8_BAR; PG8_MMA(1, 0, At, B0); PG8_MMA(1, 1, At, B1); PG8_BAR; PG8_SCHED;
            } else {
            PG8_LDB(B0, 0, 0); PG8_SCHED; PG8_LDA(At, 0, 0); PG8_STAGE_A(PG8_SA(1, 1), a1, 1, ui);
            PG8_WAIT_L(8); PG8_BAR; PG8_WAIT_L(0); PG8_MMA(0, 0, At, B0); PG8_BAR; PG8_SCHED;
            PG8_LDB(B1, 0, 1); PG8_STAGE(PG8_SB(0, 0), b2, voffB);
            PG8_BAR; PG8_WAIT_L(0); PG8_MMA(0, 1, At, B1); PG8_BAR;
            PG8_LDA(At, 0, 1); PG8_STAGE_A(PG8_SA(0, 0), a2, 0, ui2);
            PG8_BAR; PG8_WAIT_L(0); PG8_MMA(1, 0, At, B0); PG8_BAR; PG8_SCHED;
            PG8_STAGE(PG8_SB(0, 1), b2 + hstepB, voffB);
            PG8_WAIT_V(6); PG8_BAR; PG8_MMA(1, 1, At, B1); PG8_BAR;
            PG8_LDB(B0, 1, 0); PG8_SCHED; PG8_LDA(At, 1, 0); PG8_STAGE_A(PG8_SA(0, 1), a2, 1, ui2);
            PG8_WAIT_L(8); PG8_BAR; PG8_WAIT_L(0); PG8_MMA(0, 0, At, B0); PG8_BAR; PG8_SCHED;
            PG8_LDB(B1, 1, 1); PG8_STAGE(PG8_SB(1, 0), b3, voffB);
            PG8_BAR; PG8_WAIT_L(0); PG8_MMA(0, 1, At, B1); PG8_BAR;
            PG8_LDA(At, 1, 1); PG8_STAGE_A(PG8_SA(1, 0), a3, 0, ui2);
            PG8_BAR; PG8_WAIT_L(0); PG8_MMA(1, 0, At, B0); PG8_BAR; PG8_SCHED;
            PG8_STAGE(PG8_SB(1, 1), b3 + hstepB, voffB);
            PG8_WAIT_V(6); PG8_BAR; PG8_MMA(1, 1, At, B1); PG8_BAR;
            }
        }
        if constexpr (ALIGN_EPI) { if (wr == 0) PG8_BAR; }
        if constexpr (!Epi::AFTER_DRAIN) { E(acc, cur, wr, wc, fr, fq); S.done(cur); }
        if (!has_next) break;
#pragma unroll
        for (int a = 0; a < 2; ++a)
#pragma unroll
            for (int b = 0; b < 2; ++b)
#pragma unroll
                for (int m = 0; m < 4; ++m)
#pragma unroll
                    for (int n = 0; n < 2; ++n) acc[a][b][m][n] = (f32x4){0.f, 0.f, 0.f, 0.f};
        cur = nxt; cA = nA; cB = nB; ++ui;
        if constexpr (ALIGN_EPI) { if (wr == 1) PG8_BAR; }
    }
    PG8_WAIT_V(0);
    if constexpr (!ALIGN_EPI) { if (wr == 0) PG8_BAR; }
    PG8_BAR;
    if constexpr (Epi::AFTER_DRAIN) { E.fused(acc, cur, wr, wc, fr, fq, lds, wid, lane); S.done(cur); }
#undef PG8_SA
#undef PG8_SB
#undef PG8_STAGE
#undef PG8_STAGE_A
#undef PG8_GTOK
#undef PG8_LDA
#undef PG8_LDB
#undef PG8_MMA
#undef PG8_WAIT_V
#undef PG8_WAIT_L
#undef PG8_BAR
#undef PG8_SCHED
}
}
namespace mla {
using bf16x8 = __attribute__((ext_vector_type(8))) short;
using s16x4  = __attribute__((ext_vector_type(4))) short;
using f32x16 = __attribute__((ext_vector_type(16))) float;
using u32x4  = __attribute__((ext_vector_type(4))) unsigned;
constexpr int NW = 8, QBLK = 32, KVBLK = 64;
constexpr float SCALE = 0.10206207261596577f;
constexpr float THR = 8.f;
constexpr int SHM_V = KVBLK * 64 * 2, SHM_K = KVBLK * 256;
constexpr int SHM_ATTN = 4 * SHM_V + 4 * SHM_K + NW * 64 * 4;
#define KSWZ(row, colB) ((row) * 256 + ((colB) ^ (((row) & 7) << 4)))
#define SBAR() __builtin_amdgcn_sched_barrier(0)
__device__ __forceinline__ int crow(int r, int hi) { return (r & 3) + 8 * (r >> 2) + 4 * hi; }
__device__ __forceinline__ unsigned cvtpk(float lo, float hi) { unsigned r; asm volatile("v_cvt_pk_bf16_f32 %0, %1, %2" : "=v"(r) : "v"(lo), "v"(hi)); return r; }

__device__ __forceinline__ float max3f(float a, float b, float c) { return __builtin_fmaxf(__builtin_fmaxf(a, b), c); }
template <int ABL> __device__ __forceinline__ void partialSM(f32x16& p0, f32x16& p1, float& m_reg, float& alpha, bool first) {
  float a = max3f(p0[0], p0[1], p0[2]), b = max3f(p0[3], p1[0], p1[1]), c = max3f(p1[2], p1[3], p0[4]), d = max3f(p0[5], p0[6], p0[7]);
  a = max3f(a, p1[4], p1[5]); b = max3f(b, p1[6], p1[7]);
#pragma unroll
  for (int r = 8; r < 16; r += 4) { a = max3f(a, p0[r], p0[r + 1]); b = max3f(b, p0[r + 2], p0[r + 3]); c = max3f(c, p1[r], p1[r + 1]); d = max3f(d, p1[r + 2], p1[r + 3]); }
  float pmax = fmaxf(fmaxf(a, b), fmaxf(c, d));
  { auto rr = __builtin_amdgcn_permlane32_swap(__float_as_uint(pmax), __float_as_uint(pmax), false, false);
    pmax = fmaxf(__uint_as_float(rr[0]), __uint_as_float(rr[1])); }
  if (__builtin_expect(!first && __all(pmax - m_reg <= THR * 1.4426950408889634f), 1)) { alpha = 1.f; }
  else { const float mn = first ? pmax : fmaxf(m_reg, pmax); alpha = first ? 1.f : __builtin_amdgcn_exp2f(m_reg - mn); m_reg = mn; }
#pragma unroll
  for (int r = 0; r < 16; ++r) { p0[r] -= m_reg; p1[r] -= m_reg; }
#pragma unroll
  for (int r = 0; r < 16; ++r) p0[r] = (ABL & 2) ? p0[r] * 0.5f : __builtin_amdgcn_exp2f(p0[r]);
}
template <int ABL> __device__ __forceinline__ void finishSM(f32x16& p0, f32x16& p1, float alpha, float& l_reg, bf16x8& pa0, bf16x8& pa1, bf16x8& pa2, bf16x8& pa3) {
#pragma unroll
  for (int r = 0; r < 16; ++r) p1[r] = (ABL & 2) ? p1[r] * 0.5f : __builtin_amdgcn_exp2f(p1[r]);
  float ps, s0 = 0.f, s1 = 0.f, s2 = 0.f, s3 = 0.f;
#pragma unroll
  for (int r = 0; r < 16; r += 4) { s0 += p0[r]; s1 += p0[r + 1]; s2 += p0[r + 2]; s3 += p0[r + 3]; }
#pragma unroll
  for (int r = 0; r < 16; r += 4) { s0 += p1[r]; s1 += p1[r + 1]; s2 += p1[r + 2]; s3 += p1[r + 3]; }
  ps = (s0 + s1) + (s2 + s3);
  { auto rr = __builtin_amdgcn_permlane32_swap(__float_as_uint(ps), __float_as_uint(ps), false, false);
    ps = __uint_as_float(rr[0]) + __uint_as_float(rr[1]); }
  l_reg = l_reg * alpha + ps;
#define PK4(P, BASE, OUT) do { u32x4 w = {cvtpk(P[BASE + 0], P[BASE + 1]), cvtpk(P[BASE + 2], P[BASE + 3]), cvtpk(P[BASE + 4], P[BASE + 5]), cvtpk(P[BASE + 6], P[BASE + 7])}; \
    OUT = *reinterpret_cast<bf16x8*>(&w); } while (0)
  PK4(p0, 0, pa0); PK4(p0, 8, pa1); PK4(p1, 0, pa2); PK4(p1, 8, pa3);
#undef PK4
}
__device__ __forceinline__ void qkt(f32x16& p0, f32x16& p1, const char* Ks, const bf16x8* qr, int r32, int hi) {
  p0 = f32x16{}; p1 = f32x16{};
#pragma unroll
  for (int d0 = 0; d0 < 6; ++d0) { int cb = (d0 * 16 + hi * 8) * 2;
    bf16x8 b0 = *reinterpret_cast<const bf16x8*>(Ks + KSWZ(r32, cb));
    bf16x8 b1 = *reinterpret_cast<const bf16x8*>(Ks + KSWZ(32 + r32, cb));
    p0 = __builtin_amdgcn_mfma_f32_32x32x16_bf16(b0, qr[d0], p0, 0, 0, 0);
    p1 = __builtin_amdgcn_mfma_f32_32x32x16_bf16(b1, qr[d0], p1, 0, 0, 0); }
}
__device__ __forceinline__ int v_st(int k, int c) { const int kk = k;
  return ((kk >> 3) * 2 + (c >> 5)) * 512 + ((kk & 7) * 32 + (c & 31)) * 2; }
__device__ __forceinline__ int v_rd_base(int lane) { return ((lane & 3) << 3) | (((lane >> 2) & 3) << 6) | (((lane >> 4) & 1) << 5) | (((lane >> 5) & 1) << 8); }
constexpr int v_rd_off(int d0, int ks, int half) { return d0 * 512 + ks * 2048 + half * 1024; }
template <int OFF> __device__ __forceinline__ s16x4 tr_read(int vb) {
  s16x4 r; asm volatile("ds_read_b64_tr_b16 %0, %1 offset:%2" : "=&v"(r) : "v"(vb), "i"(OFF) : "memory"); return r;
}
#define PK(L, H) (bf16x8){L[0], L[1], L[2], L[3], H[0], H[1], H[2], H[3]}
#define PV_RD(KS, LA, HA, LB, HB) do { LA = tr_read<v_rd_off(0, KS, 0)>(vb); HA = tr_read<v_rd_off(0, KS, 1)>(vb); LB = tr_read<v_rd_off(1, KS, 0)>(vb); HB = tr_read<v_rd_off(1, KS, 1)>(vb); } while (0)
#define PV_MM(PA, LA, HA, LB, HB) do { o[0] = __builtin_amdgcn_mfma_f32_32x32x16_bf16(PA, PK(LA, HA), o[0], 0, 0, 0); o[1] = __builtin_amdgcn_mfma_f32_32x32x16_bf16(PA, PK(LB, HB), o[1], 0, 0, 0); } while (0)
__device__ __forceinline__ void pv_d0(f32x16* o, int vb, bf16x8 pa0, bf16x8 pa1, bf16x8 pa2, bf16x8 pa3) {
  s16x4 la, ha, lb, hb, lc, hc, ld, hd;
  PV_RD(0, la, ha, lb, hb);
  PV_RD(1, lc, hc, ld, hd);
  asm volatile("s_waitcnt lgkmcnt(4)" ::: "memory"); SBAR();
  PV_MM(pa0, la, ha, lb, hb); SBAR();
  PV_RD(2, la, ha, lb, hb);
  asm volatile("s_waitcnt lgkmcnt(4)" ::: "memory"); SBAR();
  PV_MM(pa1, lc, hc, ld, hd); SBAR();
  PV_RD(3, lc, hc, ld, hd);
  asm volatile("s_waitcnt lgkmcnt(4)" ::: "memory"); SBAR();
  PV_MM(pa2, la, ha, lb, hb); SBAR();
  asm volatile("s_waitcnt lgkmcnt(0)" ::: "memory"); SBAR();
  PV_MM(pa3, lc, hc, ld, hd);
}
#undef PV_MM
#undef PV_RD
#undef PK
__device__ __forceinline__ float bf2f_(short b) { return __builtin_bit_cast(float, (unsigned)(unsigned short)b << 16); }

template <int ABL> __device__ __forceinline__ void mla_unit(const unsigned short* __restrict__ Qg, const unsigned short* __restrict__ Kn, const unsigned short* __restrict__ Kpe, const unsigned short* __restrict__ Vg,
                                         const float* __restrict__ cs, unsigned short* __restrict__ Og, int q0, int krow0, int h, int seq, char* lds) {
  const int tid = threadIdx.x, wid = __builtin_amdgcn_readfirstlane(tid >> 6), lane = tid & 63, r32 = lane & 31, hi = lane >> 5;
  char* V_lds = lds; char* K_lds = lds + 4 * SHM_V;
  float* ws = (float*)(lds + 4 * SHM_V + 4 * SHM_K) + wid * 64; float* li_l = ws; float* al_l = ws + 32;
  float m_reg = 0.f, l_reg = 0; f32x16 o[2] = {}; bf16x8 qr[6];
  {
    const int qrow = q0 + wid * QBLK + r32;
    const unsigned short* Qw = Qg + (size_t)qrow * 768 + h * 96 + hi * 8;
#pragma unroll
    for (int d0 = 0; d0 < 6; ++d0) qr[d0] = *reinterpret_cast<const bf16x8*>(Qw + d0 * 16);
    const float* cr = cs + (size_t)qrow * 32 + hi * 8;
    bf16x8 a = qr[4], b = qr[5]; u32x4 wa, wb; float n1[8], n2[8];
#pragma unroll
    for (int e = 0; e < 8; ++e) { const float c_ = cr[e], s_ = cr[16 + e]; const float x1 = bf2f_(a[e]), x2 = bf2f_(b[e]); n1[e] = x1 * c_ - x2 * s_; n2[e] = x1 * s_ + x2 * c_; }
    wa = (u32x4){cvtpk(n1[0], n1[1]), cvtpk(n1[2], n1[3]), cvtpk(n1[4], n1[5]), cvtpk(n1[6], n1[7])};
    wb = (u32x4){cvtpk(n2[0], n2[1]), cvtpk(n2[2], n2[3]), cvtpk(n2[4], n2[5]), cvtpk(n2[6], n2[7])};
    qr[4] = *reinterpret_cast<bf16x8*>(&wa); qr[5] = *reinterpret_cast<bf16x8*>(&wb);
  }
  const int sk = tid >> 3, sc = (tid & 7) * 8, rk = (tid & 255) >> 2, rc = (tid & 3) * 8;
  const int vst = v_st(sk, sc), kst = KSWZ(sk, sc * 2), rst = KSWZ(rk, (64 + rc) * 2);
  const int vb0 = (int)(uintptr_t)V_lds + v_rd_base(lane);
  const unsigned short* Vh = Vg + (size_t)krow0 * 512 + h * 64; const unsigned short* Kh = Kn + (size_t)krow0 * 512 + h * 64; const unsigned short* Rh = Kpe + (size_t)krow0 * 32;
  struct { bf16x8 vs, ks, rs; } sr_[2];
#define SLOAD(i, k0) do { sr_[i].vs = *reinterpret_cast<const bf16x8*>(&Vh[(size_t)((k0) + sk) * 512 + sc]); sr_[i].ks = *reinterpret_cast<const bf16x8*>(&Kh[(size_t)((k0) + sk) * 512 + sc]); \
    sr_[i].rs = *reinterpret_cast<const bf16x8*>(&Rh[(size_t)((k0) + rk) * 32 + rc]); } while (0)
#define SWRITE(b, i) do { *(bf16x8*)(V_lds + (b) * SHM_V + vst) = sr_[i].vs; *(bf16x8*)(K_lds + (b) * SHM_K + kst) = sr_[i].ks; *(bf16x8*)(K_lds + (b) * SHM_K + rst) = sr_[i].rs; } while (0)
#define RESC(a) do { if (__any((a) < 1.f)) { if (hi == 0) al_l[r32] = (a); asm volatile("s_waitcnt lgkmcnt(0)" ::: "memory"); \
    _Pragma("unroll") for (int d = 0; d < 2; ++d) _Pragma("unroll") for (int r = 0; r < 16; ++r) o[d][r] *= al_l[crow(r, hi)]; } } while (0)
#define EBAR() do { asm volatile("s_waitcnt lgkmcnt(0)" ::: "memory"); __builtin_amdgcn_s_barrier(); asm volatile("" ::: "memory"); } while (0)
  f32x16 p0, p1; float al; bf16x8 pa0, pa1, pa2, pa3; const int NT = seq / KVBLK;
  pa0 = pa1 = pa2 = pa3 = bf16x8{};
  SLOAD(0, 0); SLOAD(1, KVBLK); asm volatile("s_waitcnt vmcnt(0)" ::: "memory"); SWRITE(0, 0); SWRITE(1, 1);
  if (2 < NT) SLOAD(0, 2 * KVBLK);
  EBAR();
  if (wid >= 4) EBAR();
  for (int t = 0; t < NT; ++t) {
    SBAR(); qkt(p0, p1, K_lds + (t & 3) * SHM_K, qr, r32, hi); SBAR();
    if (t > 0) pv_d0(o, vb0 + ((t - 1) & 3) * SHM_V, pa0, pa1, pa2, pa3);
    EBAR();
    partialSM<ABL>(p0, p1, m_reg, al, t == 0);
    RESC(al);
    finishSM<ABL>(p0, p1, al, l_reg, pa0, pa1, pa2, pa3);
    if (t + 2 < NT) { asm volatile("s_waitcnt vmcnt(0)" ::: "memory"); SWRITE((t + 2) & 3, 0); }
    if (t + 3 < NT) SLOAD(0, (t + 3) * KVBLK);
    EBAR();
  }
  SBAR(); pv_d0(o, vb0 + ((NT - 1) & 3) * SHM_V, pa0, pa1, pa2, pa3);
  if (wid < 4) EBAR();
#undef EBAR
  if (hi == 0) li_l[r32] = l_reg; asm volatile("s_waitcnt lgkmcnt(0)" ::: "memory");
  float rli[16];
#pragma unroll
  for (int r = 0; r < 16; ++r) rli[r] = __builtin_amdgcn_rcpf(li_l[crow(r, hi)]);
  unsigned short* Ow = Og + (size_t)(q0 + wid * QBLK) * 512 + h * 64;
#pragma unroll
  for (int r = 0; r < 16; ++r) { int orow = crow(r, hi);
#pragma unroll
    for (int d0 = 0; d0 < 2; ++d0) Ow[(size_t)orow * 512 + d0 * 32 + r32] = (unsigned short)cvtpk(o[d0][r] * rli[r], 0.f); }
  __syncthreads();
#undef SLOAD
#undef SWRITE
#undef RESC
}
#undef KSWZ
#undef SBAR
}

namespace dil {
using bf16x8 = __attribute__((ext_vector_type(8))) short;
using s16x4  = __attribute__((ext_vector_type(4))) short;
using f32x16 = __attribute__((ext_vector_type(16))) float;
using u32x4  = __attribute__((ext_vector_type(4))) unsigned;
constexpr int TBL_PITCH = 2112;
constexpr int W_TBL = 0, W_K = 8448, W_V = 8448 + 4096, W_POS = 8448 + 8192, W_AL = W_POS + 128, W_BYTES = W_AL + 128;
__device__ __forceinline__ int crow(int r, int hi) { return (r & 3) + 8 * (r >> 2) + 4 * hi; }
__device__ __forceinline__ unsigned cvtpk(float lo, float hi) { unsigned r; asm volatile("v_cvt_pk_bf16_f32 %0, %1, %2" : "=v"(r) : "v"(lo), "v"(hi)); return r; }
#define DKSWZ(row, colB) ((row) * 128 + ((colB) ^ (((row) & 7) << 4)))
__device__ __forceinline__ int v_st(int k, int c) { const int kk = k;
  return ((kk >> 3) * 2 + (c >> 5)) * 512 + ((kk & 7) * 32 + (c & 31)) * 2; }
__device__ __forceinline__ int v_rd_base(int lane) { return ((lane & 3) << 3) | (((lane >> 2) & 3) << 6) | (((lane >> 4) & 1) << 5) | (((lane >> 5) & 1) << 8); }
constexpr int v_rd_off(int d0, int ks, int half) { return d0 * 512 + ks * 2048 + half * 1024; }
template <int OFF> __device__ __forceinline__ s16x4 tr_read(int vb) {
  s16x4 r; asm volatile("ds_read_b64_tr_b16 %0, %1 offset:%2" : "=&v"(r) : "v"(vb), "i"(OFF) : "memory"); return r;
}
template <int D0> __device__ __forceinline__ void pv_one(f32x16& od, int vb, bf16x8 pa0, bf16x8 pa1) {
  const s16x4 l0 = tr_read<v_rd_off(D0, 0, 0)>(vb), h0 = tr_read<v_rd_off(D0, 0, 1)>(vb), l1 = tr_read<v_rd_off(D0, 1, 0)>(vb), h1 = tr_read<v_rd_off(D0, 1, 1)>(vb);
  asm volatile("s_waitcnt lgkmcnt(0)" ::: "memory"); __builtin_amdgcn_sched_barrier(0);
#define PK(L, H) (bf16x8){L[0], L[1], L[2], L[3], H[0], H[1], H[2], H[3]}
  od = __builtin_amdgcn_mfma_f32_32x32x16_bf16(pa0, PK(l0, h0), od, 0, 0, 0);
  od = __builtin_amdgcn_mfma_f32_32x32x16_bf16(pa1, PK(l1, h1), od, 0, 0, 0);
#undef PK
}
struct KVRegs { bf16x8 k[4], v[4]; int pk; };
struct TaskId { int b, h, g, r, ub; };
__device__ __forceinline__ TaskId task_at(int i, int bx, int G, int wave) {
  TaskId t; int bh, k; t.b = 0; t.h = 0; t.g = 0; t.r = 0; t.ub = -1;
  if (G == 256) { if (i >= 6) return t; bh = (bx & 7) + 8 * (bx >> 6); k = ((((bx >> 3) & 7) * 6 + i) << 3) + wave; }
  else { const int id = (i * G + bx) * 8 + wave; if (id >= 12288) return t; bh = id / 384; k = id % 384; }
  const int g = k >> 7, kk = k & 127, nub = g == 0 ? 128 : (g == 1 ? 32 : 8);
  t.b = bh >> 3; t.h = bh & 7; t.g = g; t.r = kk / nub; t.ub = kk % nub; return t;
}
struct Pre { bf16x8 qr[4]; int pos_q; KVRegs R; };
__device__ __forceinline__ void load_blk(const unsigned short* __restrict__ qkv, const int* __restrict__ pos, const TaskId& t, int kb, KVRegs& R) {
  const int lane = threadIdx.x & 63, r32 = lane & 31, srow = lane >> 1, shalf = (lane & 1) * 32;
  const int dl = t.g == 0 ? 1 : (t.g == 1 ? 4 : 16), L = S / dl; const size_t rowb = (size_t)t.b * S;
  int up = 32 * (t.ub - 2 + kb) + srow; up = up < 0 ? 0 : (up >= L ? L - 1 : up);
  const unsigned short* base = qkv + (rowb + t.r + dl * up) * 1536 + t.h * 64 + shalf;
#pragma unroll
  for (int c = 0; c < 4; ++c) { R.k[c] = *reinterpret_cast<const bf16x8*>(base + 512 + c * 8); R.v[c] = *reinterpret_cast<const bf16x8*>(base + 1024 + c * 8); }
  int upl = 32 * (t.ub - 2 + kb) + r32; upl = upl < 0 ? 0 : (upl >= L ? L - 1 : upl);
  R.pk = pos[rowb + t.r + dl * upl];
}
__device__ __forceinline__ int kb_first(const TaskId& t) { return (t.ub >= 2) ? 0 : (2 - t.ub); }
__device__ __forceinline__ void dil_prefetch(const unsigned short* __restrict__ qkv, const int* __restrict__ pos, const TaskId& t, Pre& P) {
  const int lane = threadIdx.x & 63, r32 = lane & 31, hi = lane >> 5;
  const int dl = t.g == 0 ? 1 : (t.g == 1 ? 4 : 16); const size_t rowb = (size_t)t.b * S; const int tok_q = t.r + dl * (32 * t.ub + r32);
  const unsigned short* Qw = qkv + (rowb + tok_q) * 1536 + t.h * 64 + hi * 8;
#pragma unroll
  for (int d0 = 0; d0 < 4; ++d0) P.qr[d0] = *reinterpret_cast<const bf16x8*>(Qw + d0 * 16);
  P.pos_q = pos[rowb + tok_q];
  load_blk(qkv, pos, t, kb_first(t), P.R);
}
__device__ __forceinline__ void dil_task(const unsigned short* __restrict__ qkv, const int* __restrict__ pos, unsigned short* __restrict__ oap, float* __restrict__ lse,
                                         const TaskId t, Pre& P, bool has_next, const TaskId tn, char* wl  ) {
  const int lane = threadIdx.x & 63, r32 = lane & 31, hi = lane >> 5;
  const int b = t.b, h = t.h, g = t.g, r = t.r, ub = t.ub;
  const int dl = g == 0 ? 1 : (g == 1 ? 4 : 16), L = S / dl;
  const int u_q = 32 * ub + r32;
  const size_t rowb = (size_t)b * S;
  const int tok_q = r + dl * u_q;
  const float* tblw = (const float*)(wl + W_TBL); int* posw = (int*)(wl + W_POS); float* alw = (float*)(wl + W_AL);
  bf16x8 qr[4];
#pragma unroll
  for (int d0 = 0; d0 < 4; ++d0) qr[d0] = P.qr[d0];
  const int pos_q = P.pos_q;
  const int srow = lane >> 1, shalf = (lane & 1) * 32;
  const int vb0 = (int)(uintptr_t)(wl + W_V) + v_rd_base(lane);
  float m_reg = -1e30f, l_reg = 0.f; f32x16 o[2] = {};
  const int kb_lo = kb_first(t), kb_hi = (32 * (ub + 3) <= L) ? 4 : (4 - ((32 * (ub + 3) - L) >> 5));
  KVRegs R = P.R;
  for (int kb = kb_lo; kb <= kb_hi; ++kb) {
#pragma unroll
    for (int c = 0; c < 4; ++c) {
      *(bf16x8*)(wl + W_K + DKSWZ(srow, (shalf + c * 8) * 2)) = R.k[c];
      *(bf16x8*)(wl + W_V + v_st(srow, shalf + c * 8)) = R.v[c];
    }
    if (hi == 0) posw[r32] = R.pk;
    if (kb < kb_hi) load_blk(qkv, pos, t, kb + 1, R);
    asm volatile("s_waitcnt lgkmcnt(0)" ::: "memory"); __builtin_amdgcn_sched_barrier(0);
    f32x16 p = {};
#pragma unroll
    for (int d0 = 0; d0 < 4; ++d0) {
      const bf16x8 kf = *reinterpret_cast<const bf16x8*>(wl + W_K + DKSWZ(r32, (d0 * 16 + hi * 8) * 2));
      p = __builtin_amdgcn_mfma_f32_32x32x16_bf16(kf, qr[d0], p, 0, 0, 0);
    }
    float bmax;
    {
      int idx[16];
#pragma unroll
      for (int rr = 0; rr < 16; ++rr) { int rel = posw[crow(rr, hi)] - pos_q; rel = rel < -1024 ? -1024 : (rel > 1024 ? 1024 : rel); const int i_ = rel + 1024; idx[rr] = i_ ^ ((i_ >> 5) & 31); }
#pragma unroll
      for (int rr = 0; rr < 16; ++rr) p[rr] += tblw[idx[rr]];
    }
    if (kb == 0) {
#pragma unroll
      for (int rr = 0; rr < 16; ++rr) p[rr] = crow(rr, hi) >= r32 ? p[rr] : -INFINITY;
    } else if (kb == 4) {
#pragma unroll
      for (int rr = 0; rr < 16; ++rr) p[rr] = crow(rr, hi) <= r32 ? p[rr] : -INFINITY;
    }
    bmax = fmaxf(fmaxf(p[0], p[1]), fmaxf(p[2], p[3]));
#pragma unroll
    for (int rr = 4; rr < 16; rr += 4) bmax = fmaxf(bmax, fmaxf(fmaxf(p[rr], p[rr + 1]), fmaxf(p[rr + 2], p[rr + 3])));
    { auto x = __builtin_amdgcn_permlane32_swap(__float_as_uint(bmax), __float_as_uint(bmax), false, false); bmax = fmaxf(__uint_as_float(x[0]), __uint_as_float(x[1])); }
    float alpha = 1.f; bool resc = false;
    if (!__all(bmax - m_reg <= 11.5f)) { const float mn = fmaxf(m_reg, bmax); alpha = __builtin_amdgcn_exp2f(m_reg - mn); m_reg = mn; resc = true; }
    float ps = 0.f;
#pragma unroll
    for (int rr = 0; rr < 16; ++rr) p[rr] = __builtin_amdgcn_exp2f(p[rr] - m_reg);
    ps = ((p[0] + p[1]) + (p[2] + p[3])) + ((p[4] + p[5]) + (p[6] + p[7])) + (((p[8] + p[9]) + (p[10] + p[11])) + ((p[12] + p[13]) + (p[14] + p[15])));
    { auto x = __builtin_amdgcn_permlane32_swap(__float_as_uint(ps), __float_as_uint(ps), false, false); ps = __uint_as_float(x[0]) + __uint_as_float(x[1]); }
    l_reg = l_reg * alpha + ps;
    if (resc && kb != kb_lo) {
      if (hi == 0) alw[r32] = alpha;
      asm volatile("s_waitcnt lgkmcnt(0)" ::: "memory");
#pragma unroll
      for (int d = 0; d < 2; ++d)
#pragma unroll
        for (int rr = 0; rr < 16; ++rr) o[d][rr] *= alw[crow(rr, hi)];
    }
    bf16x8 pa0, pa1;
#define PK4(P, BASE, OUT) do { u32x4 w = {cvtpk(P[BASE + 0], P[BASE + 1]), cvtpk(P[BASE + 2], P[BASE + 3]), cvtpk(P[BASE + 4], P[BASE + 5]), cvtpk(P[BASE + 6], P[BASE + 7])}; \
    OUT = *reinterpret_cast<bf16x8*>(&w); } while (0)
    PK4(p, 0, pa0); PK4(p, 8, pa1);
#undef PK4
    pv_one<0>(o[0], vb0, pa0, pa1); pv_one<1>(o[1], vb0, pa0, pa1);
  }
  if (has_next) dil_prefetch(qkv, pos, tn, P);
  float* liw = alw;
  if (hi == 0) liw[r32] = l_reg;
  asm volatile("s_waitcnt lgkmcnt(0)" ::: "memory");
  if (hi == 0) lse[((size_t)g * T + rowb + tok_q) * 8 + h] = (m_reg + __log2f(l_reg)) * 0.6931471805599453f;
  unsigned short* Ow = oap + ((size_t)g * T + rowb + r + (size_t)dl * 32 * ub) * 512 + h * 64;
  char* ot = wl + W_K;
#pragma unroll
  for (int rr = 0; rr < 16; ++rr) { const int orow = crow(rr, hi); const float rl = __builtin_amdgcn_rcpf(liw[orow]);
#pragma unroll
    for (int d0 = 0; d0 < 2; ++d0) *(unsigned short*)(ot + orow * 144 + (d0 * 32 + r32) * 2) = (unsigned short)cvtpk(o[d0][rr] * rl, 0.f); }
  asm volatile("s_waitcnt lgkmcnt(0)" ::: "memory");
#pragma unroll
  for (int ps = 0; ps < 4; ++ps) { const int orow = ps * 8 + (lane >> 3), c = lane & 7;
    const u32x4 w = *(const u32x4*)(ot + orow * 144 + c * 16);
    *(u32x4*)(Ow + (size_t)orow * dl * 512 + c * 8) = w; }
  asm volatile("s_waitcnt lgkmcnt(0)" ::: "memory");
}
#undef DKSWZ
}

namespace mk {
#define GAS __attribute__((address_space(1)))
#define LAS __attribute__((address_space(3)))
typedef unsigned short bf16_t;
typedef unsigned v4u __attribute__((ext_vector_type(4)));
typedef unsigned v2u __attribute__((ext_vector_type(2)));
typedef float f32x4 __attribute__((ext_vector_type(4)));
#define LDS_WAIT() asm volatile("s_waitcnt lgkmcnt(0)" ::: "memory")
#define VM_WAIT() asm volatile("s_waitcnt vmcnt(0)" ::: "memory")
__device__ __forceinline__ unsigned f2bf(float f) { unsigned u = __builtin_bit_cast(unsigned, f); return (u + 0x7fffu + ((u >> 16) & 1u)) >> 16; }
__device__ __forceinline__ unsigned pk2(float lo, float hi) { return f2bf(lo) | (f2bf(hi) << 16); }
__device__ __forceinline__ float bf2f(unsigned short b) { return __builtin_bit_cast(float, (unsigned)b << 16); }
__device__ __forceinline__ float wave_sum(float v) {
#pragma unroll
    for (int o = 1; o < 64; o <<= 1) v += __shfl_xor(v, o);
    return v;
}

#define XB_TMO      128
#define XB_XCNT(j)  (256  + 64 * (j))
#define XB_XSUB(j)  (1280 + 64 * (j))
#define XB_XGEN(j)  (2304 + 64 * (j))
#define XB_TOP      3328
#define XB_TOPGEN   3392
#define XCD_BAR_WORDS 3456
#define XB_SPIN_CAP (1u << 18)

__device__ __forceinline__ unsigned xb_ld(unsigned* p)              { return __hip_atomic_load(p, __ATOMIC_RELAXED, __HIP_MEMORY_SCOPE_AGENT); }
__device__ __forceinline__ unsigned xb_add(unsigned* p, unsigned v) { return __hip_atomic_fetch_add(p, v, __ATOMIC_RELAXED, __HIP_MEMORY_SCOPE_AGENT); }
__device__ __forceinline__ unsigned xb_xcc_id() { return (unsigned)__builtin_amdgcn_s_getreg((3 << 11) | 20) & 0xFu; }
#define XB_SPIN(cond, bar) do { unsigned _sp = 0; while (cond) { __builtin_amdgcn_s_sleep(1); \
    if ((++_sp & 255u) == 0u) { if (xb_ld(&(bar)[XB_TMO])) break; if (_sp > XB_SPIN_CAP) { atomicAdd(&(bar)[XB_TMO], 1u); break; } } } } while (0)

struct XcdBarrier {
    unsigned* bar; unsigned x;
    volatile LAS unsigned* st;
};

__device__ __forceinline__ XcdBarrier xcd_barrier_post(unsigned* bar, volatile LAS unsigned* st) {
    XcdBarrier b; b.bar = bar; b.x = xb_xcc_id(); b.st = st;
    if (threadIdx.x == 0) (void)xb_add(&bar[XB_XCNT(b.x)], 1u);
    return b;
}
__device__ __forceinline__ void xcd_barrier_complete(unsigned* bar, unsigned x, unsigned& nloc, unsigned& nx) {
    const unsigned G = gridDim.x * gridDim.y * gridDim.z;
    unsigned sum, cnt, mine, sp = 0u;
    for (;;) {
        sum = 0u; cnt = 0u; mine = 0u;
#pragma unroll
        for (unsigned j = 0; j < 16; ++j) { const unsigned c = xb_ld(&bar[XB_XCNT(j)]); sum += c; cnt += (c > 0u) ? 1u : 0u; mine = (j == x) ? c : mine; }
        if (sum == G) break;
        __builtin_amdgcn_s_sleep(1);
        if ((++sp & 255u) == 0u) { if (xb_ld(&bar[XB_TMO])) break; if (sp > XB_SPIN_CAP) { atomicAdd(&bar[XB_TMO], 1u); break; } }
    }
    nloc = mine > 0u ? mine : 1u; nx = cnt > 0u ? cnt : 1u;
}

__device__ __forceinline__ void xcd_barrier(const XcdBarrier& b) {
    asm volatile("s_waitcnt vmcnt(0)" ::: "memory");
    __syncthreads();
    if (threadIdx.x == 0) {
        unsigned* bar = b.bar;
        __builtin_amdgcn_s_waitcnt(0);
        unsigned nloc = b.st[0], nx = b.st[1];
        if (nloc == 0u) { xcd_barrier_complete(bar, b.x, nloc, nx); b.st[0] = nloc; b.st[1] = nx; }
        const unsigned old = xb_add(&bar[XB_XSUB(b.x)], 1u);
        const unsigned gen = old / nloc;
        if (old + 1u == (gen + 1u) * nloc) {
            __builtin_amdgcn_fence(__ATOMIC_RELEASE, "agent");
            asm volatile("s_waitcnt vmcnt(0)" ::: "memory");
            const unsigned og = xb_add(&bar[XB_TOP], 1u);
            const unsigned tg = og / nx;
            if (og + 1u == (tg + 1u) * nx) xb_add(&bar[XB_TOPGEN], 1u);
            else XB_SPIN(xb_ld(&bar[XB_TOPGEN]) == tg, bar);
            __builtin_amdgcn_fence(__ATOMIC_ACQUIRE, "agent");
            xb_add(&bar[XB_XGEN(b.x)], 1u);
            asm volatile("s_waitcnt vmcnt(0)" ::: "memory");
        } else {
            XB_SPIN(xb_ld(&bar[XB_XGEN(b.x)]) == gen, bar);
            __builtin_amdgcn_fence(__ATOMIC_ACQUIRE, "agent");
            asm volatile("s_waitcnt vmcnt(0)" ::: "memory");
        }
    }
    __syncthreads();
}

constexpr int NWAVES = 8;
constexpr int LDS_BYTES = 147456;
constexpr int RING_BYTES = 131072;
constexpr int CTRL_OFF = 135168;
constexpr int MISC_OFF = CTRL_OFF + 320;
constexpr size_t MiB = 1u << 20;
constexpr size_t WS_CTL = 0, CTL_ZERO_BYTES = 1 * MiB;
constexpr int CW_BAR = 16384;
constexpr size_t WS_WIN = 1 * MiB, WS_WQB = 5 * MiB, WS_WKVB = 5 * MiB + 512 * 1024, WS_WO = 6 * MiB, WS_WMQG = 8 * MiB, WS_WMKV = 10 * MiB, WS_WMO = 14 * MiB;
constexpr size_t WS_RSTDX = 16 * MiB, WS_RSTDM = 16 * MiB + 64 * 1024, WS_SSQQ = 16 * MiB + 256 * 1024, WS_SSQKV = 16 * MiB + 512 * 1024, WS_TBL = 16 * MiB + 768 * 1024;
constexpr size_t WS_WRG = 16 * MiB + 896 * 1024;
constexpr size_t WS_SSQH1 = 17 * MiB, WS_SSQH2 = 18 * MiB, WS_ZKPE = 20 * MiB, WS_CS = 22 * MiB;
constexpr size_t WS_XB = 24 * MiB, WS_MEMB = 56 * MiB, WS_KVMEM = 58 * MiB, WS_KPE = 62 * MiB;
constexpr size_t WS_QKVA = 64 * MiB, WS_ZQ = 112 * MiB, WS_ZKV = 120 * MiB, WS_QB = 124 * MiB, WS_KN = 148 * MiB, WS_VB = 164 * MiB;
constexpr size_t WS_WPT = 180 * MiB, WS_VWT = 188 * MiB, WS_H2 = 196 * MiB, WS_H2B = 260 * MiB, WS_ROUTE = 292 * MiB, WS_XS = 296 * MiB;
constexpr size_t WS_HMID = 296 * MiB, WS_OAP = 440 * MiB, WS_LSE = 488 * MiB, WS_OB = 490 * MiB, WS_OMIX = 506 * MiB;
constexpr size_t WS_H1 = 538 * MiB, WS_H1B = 602 * MiB, WS_P = 634 * MiB, WS_YBUF = 666 * MiB;
constexpr size_t WS_WGU = 794 * MiB, WS_WD = 922 * MiB, WS_END = 986 * MiB;

struct Args { const float* in[26]; float* out; unsigned char* ws; double rope_rev[16]; int ph_lo, ph_hi, flags, pad; };

struct CvtDesc { const float* W; const float* gain; bf16_t* WT; int K, N, mode, item; };
__device__ __forceinline__ void cvt_load(const CvtDesc& d, f32x4 (&v)[16], int lane) {
    const int nblk = (d.N + 63) >> 6, kb = d.item / nblk, nb = d.item % nblk, k0 = 64 * kb, n0 = 64 * nb;
    const int lk = lane >> 4, ln = (lane & 15) * 4;
    const bool ok = n0 + ln < d.N;
    const float* wp = d.W + (size_t)(k0 + lk) * d.N + n0 + ln;
#pragma unroll
    for (int i = 0; i < 16; ++i) v[i] = ok ? __builtin_nontemporal_load((const f32x4*)(wp + (size_t)(4 * i) * d.N)) : (f32x4){0.f, 0.f, 0.f, 0.f};
}
__device__ __forceinline__ void cvt_store(const CvtDesc& d, f32x4 (&v)[16], LAS float* scr, int lane) {
    const int nblk = (d.N + 63) >> 6, kb = d.item / nblk, nb = d.item % nblk, k0 = 64 * kb, n0 = 64 * nb;
    const int lk = lane >> 4, ln = (lane & 15) * 4;
    if (d.gain) {
#pragma unroll
        for (int i = 0; i < 16; ++i) v[i] = v[i] * d.gain[k0 + 4 * i + lk];
    }
#pragma unroll
    for (int i = 0; i < 16; ++i) { LAS float* p = scr + (4 * i + lk) * 65 + ln; p[0] = v[i][0]; p[1] = v[i][1]; p[2] = v[i][2]; p[3] = v[i][3]; }
    LDS_WAIT(); asm volatile("" ::: "memory");
    int drow0 = n0; if (d.mode == 1) { const int half = n0 >> 10, c = n0 & 1023; drow0 = (c >> 7) * 256 + half * 128 + (c & 127); }
    const int c = lane & 7;
#pragma unroll
    for (int j = 0; j < 8; ++j) { const int n = (lane >> 3) + 8 * j; const LAS float* sp = scr + (8 * c) * 65 + n;
        v4u o; o.x = pk2(sp[0 * 65], sp[1 * 65]); o.y = pk2(sp[2 * 65], sp[3 * 65]); o.z = pk2(sp[4 * 65], sp[5 * 65]); o.w = pk2(sp[6 * 65], sp[7 * 65]);
        __builtin_nontemporal_store(o, (v4u*)(d.WT + (size_t)(drow0 + n) * d.K + k0 + 8 * c)); }
    LDS_WAIT(); asm volatile("" ::: "memory");
}
__device__ __forceinline__ void prep_rows4(const float* x0, bf16_t* o0, float* rstd_out, int lane) {
    f32x4 v[4][4]; float s[4];
#pragma unroll
    for (int r = 0; r < 4; ++r)
#pragma unroll
        for (int j = 0; j < 4; ++j) v[r][j] = ((const f32x4*)(x0 + (size_t)r * 1024))[lane + 64 * j];
#pragma unroll
    for (int r = 0; r < 4; ++r) { float a = 0.f;
#pragma unroll
        for (int j = 0; j < 4; ++j) a += (v[r][j].x * v[r][j].x + v[r][j].y * v[r][j].y) + (v[r][j].z * v[r][j].z + v[r][j].w * v[r][j].w);
        s[r] = wave_sum(a); }
    if (lane < 4) rstd_out[lane] = 1.0f / sqrtf((lane == 0 ? s[0] : lane == 1 ? s[1] : lane == 2 ? s[2] : s[3]) * (1.0f / 1024.0f) + 1e-6f);
#pragma unroll
    for (int r = 0; r < 4; ++r) { unsigned long long* o8 = (unsigned long long*)(o0 + (size_t)r * 1024) + lane;
#pragma unroll
        for (int j = 0; j < 4; ++j) o8[64 * j] = (unsigned long long)pk2(v[r][j].x, v[r][j].y) | ((unsigned long long)pk2(v[r][j].z, v[r][j].w) << 32); }
}

__device__ __forceinline__ v4u pack8(const f32x4 a, const f32x4 b) { v4u w; w.x = pk2(a[0], a[1]); w.y = pk2(a[2], a[3]); w.z = pk2(b[0], b[1]); w.w = pk2(b[2], b[3]); return w; }
__device__ __forceinline__ float sq8(const f32x4 a, const f32x4 b) { return (a[0] * a[0] + a[1] * a[1]) + (a[2] * a[2] + a[3] * a[3]) + (b[0] * b[0] + b[1] * b[1]) + (b[2] * b[2] + b[3] * b[3]); }

struct EpiInProj {
    static constexpr bool PERM = true, AFTER_DRAIN = false;
    const float* rstd; bf16_t* qkv; bf16_t* zq; bf16_t* zkv; float* zkpe; float* ssq_q; float* ssq_kv;
    __device__ __forceinline__ void operator()(const pg8::f32x4 (&acc)[2][2][4][2], const pg8::Unit& u, int wr, int wc, int fr, int fq) const {
        const int row0 = u.pm * 256 + wr * 64 + fr;
        const float qs = u.pn < 2 ? 0.125f * 1.4426950408889634f : 1.0f;
#pragma unroll
        for (int ai = 0; ai < 2; ++ai)
#pragma unroll
            for (int m = 0; m < 4; ++m) {
                const int row = row0 + ai * 128 + m * 16;
                const float rs = rstd[row];
                float ss = 0.f;
#pragma unroll
                for (int bj = 0; bj < 2; ++bj) {
                    const f32x4 v0 = acc[ai][bj][m][0] * rs, v1 = acc[ai][bj][m][1] * rs;
                    const int ct = bj * 128 + wc * 32 + 8 * fq;
                    if (u.pn < 6) { *(v4u*)(qkv + (size_t)row * 1536 + u.pn * 256 + ct) = pack8(v0 * qs, v1 * qs); }
                    else if (u.pn == 6) { *(v4u*)(zq + (size_t)row * 256 + ct) = pack8(v0, v1); ss += sq8(v0, v1); }
                    else if (bj == 0) { *(v4u*)(zkv + (size_t)row * 128 + ct) = pack8(v0, v1); ss += sq8(v0, v1); }
                    else if (wc == 0) { *(f32x4*)(zkpe + (size_t)row * 32 + 8 * fq) = v0; *(f32x4*)(zkpe + (size_t)row * 32 + 8 * fq + 4) = v1; }
                }
                if (u.pn >= 6) { ss += __shfl_xor(ss, 16); ss += __shfl_xor(ss, 32); if (fq == 0) (u.pn == 6 ? ssq_q : ssq_kv)[(size_t)row * 4 + wc] = ss; }
            }
    }
};


struct EpiQ {
    static constexpr bool PERM = true, AFTER_DRAIN = false;
    const float* ssq; bf16_t* Q;
    __device__ __forceinline__ void operator()(const pg8::f32x4 (&acc)[2][2][4][2], const pg8::Unit& u, int wr, int wc, int fr, int fq) const {
        const int row0 = u.pm * 256 + wr * 64 + fr;
#pragma unroll
        for (int ai = 0; ai < 2; ++ai)
#pragma unroll
            for (int m = 0; m < 4; ++m) {
                const int row = row0 + ai * 128 + m * 16;
                const f32x4 sp = *(const f32x4*)(ssq + (size_t)row * 4);
                const float rs = (0.10206207261596577f * 1.4426950408889634f) / sqrtf(((sp[0] + sp[1]) + (sp[2] + sp[3])) * (1.0f / 256.0f) + 1e-6f);
#pragma unroll
                for (int bj = 0; bj < 2; ++bj)
                    *(v4u*)(Q + (size_t)row * 768 + u.pn * 256 + bj * 128 + wc * 32 + 8 * fq) = pack8(acc[ai][bj][m][0] * rs, acc[ai][bj][m][1] * rs);
            }
    }
};
struct EpiKV {
    static constexpr bool PERM = true, AFTER_DRAIN = false;
    const float* ssq; bf16_t* Kn; bf16_t* Vb;
    __device__ __forceinline__ void operator()(const pg8::f32x4 (&acc)[2][2][4][2], const pg8::Unit& u, int wr, int wc, int fr, int fq) const {
        const int row0 = u.pm * 256 + wr * 64 + fr;
        bf16_t* dst = (wc < 2 ? Kn : Vb) + (wc & 1) * 32 + 8 * fq;
#pragma unroll
        for (int ai = 0; ai < 2; ++ai)
#pragma unroll
            for (int m = 0; m < 4; ++m) {
                const int row = row0 + ai * 128 + m * 16;
                const f32x4 sp = *(const f32x4*)(ssq + (size_t)row * 4);
                const float rs = 1.0f / sqrtf(((sp[0] + sp[1]) + (sp[2] + sp[3])) * (1.0f / 128.0f) + 1e-6f);
#pragma unroll
                for (int bj = 0; bj < 2; ++bj)
                    *(v4u*)(dst + (size_t)row * 512 + (u.pn * 2 + bj) * 64) = pack8(acc[ai][bj][m][0] * rs, acc[ai][bj][m][1] * rs);
            }
    }
};
struct EpiRowScale {
    static constexpr bool PERM = true, AFTER_DRAIN = false;
    const float* rs; bf16_t* O; int ldc;
    __device__ __forceinline__ void operator()(const pg8::f32x4 (&acc)[2][2][4][2], const pg8::Unit& u, int wr, int wc, int fr, int fq) const {
        const int row0 = u.pm * 256 + wr * 64 + fr;
#pragma unroll
        for (int ai = 0; ai < 2; ++ai)
#pragma unroll
            for (int m = 0; m < 4; ++m) {
                const int row = row0 + ai * 128 + m * 16;
                const float r = rs[row];
#pragma unroll
                for (int bj = 0; bj < 2; ++bj)
                    *(v4u*)(O + (size_t)row * ldc + u.pn * 256 + bj * 128 + wc * 32 + 8 * fq) = pack8(acc[ai][bj][m][0] * r, acc[ai][bj][m][1] * r);
            }
    }
};

template <bool BASE_BF16> struct EpiResid {
    static constexpr bool PERM = true, AFTER_DRAIN = false;
    const void* base; bf16_t* outb; float* ssq;
    __device__ __forceinline__ void operator()(const pg8::f32x4 (&acc)[2][2][4][2], const pg8::Unit& u, int wr, int wc, int fr, int fq) const {
        const int row0 = u.pm * 256 + wr * 64 + fr;
#pragma unroll
        for (int ai = 0; ai < 2; ++ai)
#pragma unroll
            for (int m = 0; m < 4; ++m) {
                const int row = row0 + ai * 128 + m * 16;
                float ss = 0.f;
#pragma unroll
                for (int bj = 0; bj < 2; ++bj) {
                    const size_t o = (size_t)row * 1024 + u.pn * 256 + bj * 128 + wc * 32 + 8 * fq;
                    f32x4 b0, b1;
                    if constexpr (BASE_BF16) { const v4u w = *(const v4u*)((const bf16_t*)base + o);
                        b0 = (f32x4){__builtin_bit_cast(float, w[0] << 16), __builtin_bit_cast(float, w[0] & 0xffff0000u), __builtin_bit_cast(float, w[1] << 16), __builtin_bit_cast(float, w[1] & 0xffff0000u)};
                        b1 = (f32x4){__builtin_bit_cast(float, w[2] << 16), __builtin_bit_cast(float, w[2] & 0xffff0000u), __builtin_bit_cast(float, w[3] << 16), __builtin_bit_cast(float, w[3] & 0xffff0000u)}; }
                    else { b0 = *(const f32x4*)((const float*)base + o); b1 = *(const f32x4*)((const float*)base + o + 4); }
                    const f32x4 v0 = acc[ai][bj][m][0] + b0, v1 = acc[ai][bj][m][1] + b1;
                    *(v4u*)(outb + o) = pack8(v0, v1); ss += sq8(v0, v1);
                }
                ss += __shfl_xor(ss, 16); ss += __shfl_xor(ss, 32);
                if (fq == 0) ssq[(size_t)row * 16 + u.pn * 4 + wc] = ss;
                asm volatile("" ::: "memory");
            }
    }
};
struct EpiPlain {
    static constexpr bool PERM = true, AFTER_DRAIN = false;
    bf16_t* O; int ldc;
    __device__ __forceinline__ void operator()(const pg8::f32x4 (&acc)[2][2][4][2], const pg8::Unit& u, int wr, int wc, int fr, int fq) const {
        const int row0 = u.pm * 256 + wr * 64 + fr;
#pragma unroll
        for (int ai = 0; ai < 2; ++ai)
#pragma unroll
            for (int m = 0; m < 4; ++m)
#pragma unroll
                for (int bj = 0; bj < 2; ++bj)
                    *(v4u*)(O + (size_t)(row0 + ai * 128 + m * 16) * ldc + u.pn * 256 + bj * 128 + wc * 32 + 8 * fq) = pack8(acc[ai][bj][m][0], acc[ai][bj][m][1]);
    }
};
struct EpiSoftmax {
    static constexpr bool PERM = true, AFTER_DRAIN = true;
    bf16_t* P; int rsl_off;
    __device__ __forceinline__ void fused(pg8::f32x4 (&acc)[2][2][4][2], const pg8::Unit& u, int wr, int wc, int fr, int fq, PG8_LAS unsigned char* lds, int wid, int lane) const {
        typedef float f32x2v __attribute__((ext_vector_type(2)));
        const PG8_LAS float* rsl = (const PG8_LAS float*)(lds + rsl_off);
        PG8_LAS f32x2v* X = (PG8_LAS f32x2v*)lds;
        constexpr float L2E = 1.4426950408889634f;
#pragma unroll
        for (int ai = 0; ai < 2; ++ai)
#pragma unroll
            for (int m = 0; m < 4; ++m) {
                const int rt = ai * 128 + wr * 64 + m * 16 + fr;
                const float rs = rsl[rt] * (0.0625f * L2E);
                float mx = -3.0e38f;
#pragma unroll
                for (int bj = 0; bj < 2; ++bj)
#pragma unroll
                    for (int n = 0; n < 2; ++n) { f32x4 v = acc[ai][bj][m][n] * rs; acc[ai][bj][m][n] = v; mx = fmaxf(mx, fmaxf(fmaxf(v[0], v[1]), fmaxf(v[2], v[3]))); }
                mx = fmaxf(mx, __shfl_xor(mx, 16)); mx = fmaxf(mx, __shfl_xor(mx, 32));
                float sm = 0.f;
#pragma unroll
                for (int bj = 0; bj < 2; ++bj)
#pragma unroll
                    for (int n = 0; n < 2; ++n) { const f32x4 v = acc[ai][bj][m][n]; sm += (__builtin_amdgcn_exp2f(v[0] - mx) + __builtin_amdgcn_exp2f(v[1] - mx)) + (__builtin_amdgcn_exp2f(v[2] - mx) + __builtin_amdgcn_exp2f(v[3] - mx)); }
                sm += __shfl_xor(sm, 16); sm += __shfl_xor(sm, 32);
                if (fq == 0) X[rt * 4 + wc] = (f32x2v){mx, sm};
            }
        asm volatile("s_waitcnt lgkmcnt(0)" ::: "memory"); __builtin_amdgcn_s_barrier(); asm volatile("" ::: "memory");
#pragma unroll
        for (int ai = 0; ai < 2; ++ai)
#pragma unroll
            for (int m = 0; m < 4; ++m) {
                const int rt = ai * 128 + wr * 64 + m * 16 + fr;
                const f32x2v x0 = X[rt * 4 + 0], x1 = X[rt * 4 + 1], x2 = X[rt * 4 + 2], x3 = X[rt * 4 + 3];
                const float M = fmaxf(fmaxf(x0.x, x1.x), fmaxf(x2.x, x3.x));
                const float tot = (x0.y * __builtin_amdgcn_exp2f(x0.x - M) + x1.y * __builtin_amdgcn_exp2f(x1.x - M)) + (x2.y * __builtin_amdgcn_exp2f(x2.x - M) + x3.y * __builtin_amdgcn_exp2f(x3.x - M));
                const float inv = 1.0f / tot;
#pragma unroll
                for (int bj = 0; bj < 2; ++bj) {
                    f32x4 a = acc[ai][bj][m][0], b = acc[ai][bj][m][1];
#pragma unroll
                    for (int j = 0; j < 4; ++j) { a[j] = __builtin_amdgcn_exp2f(a[j] - M) * inv; b[j] = __builtin_amdgcn_exp2f(b[j] - M) * inv; }
                    *(v4u*)(P + (size_t)(u.pm * 256 + rt) * 1024 + u.pn * 256 + bj * 128 + wc * 32 + 8 * fq) = pack8(a, b);
                }
            }
    }
};
struct OrderWp {
    int c;
    __device__ __forceinline__ bool next(int i, pg8::Unit& u) const { if (i > 0 || c >= 64) return false; const int bhh = c >> 2, pn = c & 3, b = bhh >> 2, h = bhh & 3;
        u.pm = bhh; u.pn = pn; u.aoff = ((size_t)(b * 256) * 2048 + h * 256) * 2; u.boff = ((size_t)(pn * 256) * 1024 + h * 256) * 2; return true; }
    __device__ __forceinline__ void a_ready(const pg8::Unit&) const {}
    __device__ __forceinline__ void done(const pg8::Unit&) const {}
};
struct OrderVw {
    int c;
    __device__ __forceinline__ bool next(int i, pg8::Unit& u) const { if (i > 0 || c >= 64) return false; const int b = c >> 4, ct = (c >> 2) & 3, h = c & 3;
        u.pm = b * 4 + ct; u.pn = h; u.aoff = ((size_t)(ct * 256) * 1024 + h * 256) * 2; u.boff = ((size_t)(b * 256) * 2048 + 1024 + h * 256) * 2; return true; }
    __device__ __forceinline__ void a_ready(const pg8::Unit&) const {}
    __device__ __forceinline__ void done(const pg8::Unit&) const {}
};
struct OrderBatch {
    pg8::StaticOrder so;
    __device__ __forceinline__ bool next(int i, pg8::Unit& u) const { if (!so.next(i, u)) return false; u.boff = ((size_t)((u.pm >> 4) * 1024 + u.pn * 256) * 1024) * 2; return true; }
    __device__ __forceinline__ void a_ready(const pg8::Unit&) const {}
    __device__ __forceinline__ void done(const pg8::Unit&) const {}
};

constexpr int MPADN = NA + NE * 256, NTILEN = MPADN / 256;
constexpr int CW_GCOUNT = 8192;
constexpr size_t RT_TOPI = 0, RT_TOPG = 256 * 1024, RT_SLOT = 512 * 1024, RT_ROWFLAT = 768 * 1024, RT_RSROW = 1088 * 1024, RT_RSTD = 1408 * 1024, RT_CNT = 1536 * 1024, RT_TOT = 1600 * 1024;
constexpr int LX_TEXP = CTRL_OFF + 2048;
struct OrderMoe {
    const LAS int* texp; int nper, c, G; size_t ebytes;
    __device__ __forceinline__ bool next(int i, pg8::Unit& u) const {
        const int L = i * G + (c & 7) * (G >> 3) + (c >> 3); const int tile = L / nper, pn = L % nper;
        if (tile >= texp[NTILEN]) return false;
        u.pm = tile; u.pn = pn; u.aoff = (size_t)tile * 256 * 1024 * 2; u.boff = (size_t)texp[tile] * ebytes + (size_t)pn * 256 * 1024 * 2; return true; }
    __device__ __forceinline__ void a_ready(const pg8::Unit&) const {}
    __device__ __forceinline__ void done(const pg8::Unit&) const {}
};
__device__ __forceinline__ float swiglu1(float g, float u) { g = fminf(g, 7.0f); u = fminf(fmaxf(u, -7.0f), 7.0f); return (u + 1.0f) * g * __builtin_amdgcn_rcpf(1.0f + __builtin_amdgcn_exp2f(-1.702f * 1.4426950408889634f * g)); }
struct EpiSwiGLU {
    static constexpr bool PERM = true, AFTER_DRAIN = false;
    const float* rs_row; const float* bgu; bf16_t* hmid; const LAS int* texp;
    __device__ __forceinline__ void operator()(const pg8::f32x4 (&acc)[2][2][4][2], const pg8::Unit& u, int wr, int wc, int fr, int fq) const {
        const int row0 = u.pm * 256 + wr * 64 + fr, e = texp[u.pm], c0 = u.pn * 128 + wc * 32 + 8 * fq;
        const float* bg = bgu + (size_t)e * 2048 + c0;
        const f32x4 bg0 = *(const f32x4*)bg, bg1 = *(const f32x4*)(bg + 4), bu0 = *(const f32x4*)(bg + 1024), bu1 = *(const f32x4*)(bg + 1028);
#pragma unroll
        for (int ai = 0; ai < 2; ++ai)
#pragma unroll
            for (int m = 0; m < 4; ++m) {
                const int row = row0 + ai * 128 + m * 16; const float rs = rs_row[row];
                const f32x4 g0 = acc[ai][0][m][0] * rs + bg0, g1 = acc[ai][0][m][1] * rs + bg1, u0 = acc[ai][1][m][0] * rs + bu0, u1 = acc[ai][1][m][1] * rs + bu1;
                f32x4 h0, h1;
#pragma unroll
                for (int j = 0; j < 4; ++j) { h0[j] = swiglu1(g0[j], u0[j]); h1[j] = swiglu1(g1[j], u1[j]); }
                *(v4u*)(hmid + (size_t)row * 1024 + c0) = pack8(h0, h1);
            }
    }
};
struct EpiDown {
    static constexpr bool PERM = true, AFTER_DRAIN = false;
    const int* row_flat; const float* topg; const float* bd; bf16_t* ybuf; const LAS int* texp;
    __device__ __forceinline__ void operator()(const pg8::f32x4 (&acc)[2][2][4][2], const pg8::Unit& u, int wr, int wc, int fr, int fq) const {
        const int row0 = u.pm * 256 + wr * 64 + fr, e = texp[u.pm], c0 = u.pn * 256 + wc * 32 + 8 * fq;
        const float* bp = bd + (size_t)e * 1024 + c0;
        f32x4 bv[2][2];
#pragma unroll
        for (int bj = 0; bj < 2; ++bj) { bv[bj][0] = *(const f32x4*)(bp + bj * 128); bv[bj][1] = *(const f32x4*)(bp + bj * 128 + 4); }
#pragma unroll
        for (int ai = 0; ai < 2; ++ai)
#pragma unroll
            for (int m = 0; m < 4; ++m) {
                const int row = row0 + ai * 128 + m * 16; const int a = row_flat[row];
                if (a >= 0) { const float gt = topg[a];
#pragma unroll
                    for (int bj = 0; bj < 2; ++bj)
                        *(v4u*)(ybuf + (size_t)a * 1024 + c0 + bj * 128) = pack8((acc[ai][bj][m][0] + bv[bj][0]) * gt, (acc[ai][bj][m][1] + bv[bj][1]) * gt); }
            }
    }
};

__device__ __forceinline__ int rel_bucket_d(int rel) {
    int n = rel < 0 ? -rel : rel;
    int b;
    if (n < 8) b = n; else if (n < 15) b = 8; else if (n < 27) b = 9; else if (n < 50) b = 10; else if (n < 91) b = 11;
    else if (n < 166) b = 12; else if (n < 305) b = 13; else if (n < 559) b = 14; else b = 15;
    return b + (rel > 0 ? 16 : 0);
}

static_assert(pg8::GTAB == CTRL_OFF + 4096 && pg8::GTAB + pg8::GTAB_UNITS * 512 <= LDS_BYTES && (NTILEN * 8 + 255) / 256 <= pg8::GTAB_UNITS && NWAVES * dil::W_BYTES <= CTRL_OFF && mla::SHM_ATTN <= CTRL_OFF && RING_BYTES <= CTRL_OFF && LX_TEXP + 4 * (NTILEN + 1) <= LDS_BYTES, "LDS map");
__global__ void __launch_bounds__(NWAVES * 64, 2) mk_fwd(Args args) {
    extern __shared__ __attribute__((aligned(16))) unsigned char lds_raw[];
    LAS unsigned char* lds = (LAS unsigned char*)lds_raw;
    const int tid = threadIdx.x, lane = tid & 63, wave = __builtin_amdgcn_readfirstlane(tid >> 6);
    const int G = gridDim.x; const int bx = blockIdx.x; const int vcu = (G % 8 == 0) ? (bx % 8) * (G / 8) + bx / 8 : bx;
    unsigned char* ws = args.ws;
    const int lo = args.ph_lo, hi = args.ph_hi;
#define IN(k) (lo <= (k) && (k) < hi)
#define BOTH(k) (IN(k) && IN((k) + 1))
    for (int u = tid; u < (LDS_BYTES - CTRL_OFF) / 4; u += NWAVES * 64) ((LAS unsigned*)(lds + CTRL_OFF))[u] = 0u;
    __syncthreads();
    XcdBarrier bar; bar.bar = (unsigned*)(ws + WS_CTL) + CW_BAR; bar.x = 0; bar.st = nullptr;
    if (hi - lo > 1) bar = xcd_barrier_post((unsigned*)(ws + WS_CTL) + CW_BAR, (volatile LAS unsigned*)(lds + MISC_OFF) + 8);
#define GRID_BAR(k) do { if (BOTH(k)) xcd_barrier(bar); } while (0)
    const float* x = args.in[0]; const float* mem = args.in[1]; const float* g_mix = args.in[3]; const float* w_in = args.in[4];
    const float* g_q_a = args.in[5]; const float* w_q_b = args.in[6]; const float* g_kv_a = args.in[7]; const float* w_kv_b = args.in[8];
    const float* w_o = args.in[12]; const float* g_xattn = args.in[13]; const float* g_mem = args.in[14]; const float* w_mq = args.in[15];
    const float* w_mkv = args.in[16]; const float* w_mo = args.in[17]; const float* g_moe = args.in[18];
    const float* w_gate_up = args.in[21]; const float* w_down = args.in[23];
    bf16_t* WinT = (bf16_t*)(ws + WS_WIN); bf16_t* WqbT = (bf16_t*)(ws + WS_WQB); bf16_t* WkvbT = (bf16_t*)(ws + WS_WKVB); bf16_t* WoT = (bf16_t*)(ws + WS_WO);
    bf16_t* Wmqg = (bf16_t*)(ws + WS_WMQG); bf16_t* WmkvT = (bf16_t*)(ws + WS_WMKV); bf16_t* WmoT = (bf16_t*)(ws + WS_WMO);
    bf16_t* WguT = (bf16_t*)(ws + WS_WGU); bf16_t* WdT = (bf16_t*)(ws + WS_WD);
    bf16_t* xb = (bf16_t*)(ws + WS_XB); bf16_t* memb = (bf16_t*)(ws + WS_MEMB);
    float* rstd_x = (float*)(ws + WS_RSTDX); float* rstd_mem = (float*)(ws + WS_RSTDM);

    if (IN(0)) {
        LAS float* scr = (LAS float*)(lds + wave * 16640);
        const int gw = vcu * NWAVES + wave, NGW = G * NWAVES;
        constexpr int I_IN = 16 * 31, I_QB = 4 * 12, I_KVB = 2 * 16, I_O = 16 * 16, I_MKV = 16 * 32, I_MO = 16 * 16, I_GU = 16 * 32, I_D = 16 * 16;
        const int n_exp = (args.flags & 1) ? 32 : 0;
        const int NITEMS = I_IN + I_QB + I_KVB + I_O + I_MKV + I_MO + n_exp * (I_GU + I_D);
        auto desc = [&](int it) {
            CvtDesc d; int r = it; d.mode = 0;
            if (r < I_IN) { d.W = w_in; d.K = 1024; d.N = 1952; d.gain = g_mix; d.WT = WinT; }
            else if ((r -= I_IN) < I_QB) { d.W = w_q_b; d.K = 256; d.N = 768; d.gain = g_q_a; d.WT = WqbT; }
            else if ((r -= I_QB) < I_KVB) { d.W = w_kv_b; d.K = 128; d.N = 1024; d.gain = g_kv_a; d.WT = WkvbT; }
            else if ((r -= I_KVB) < I_O) { d.W = w_o; d.K = 1024; d.N = 1024; d.gain = nullptr; d.WT = WoT; }
            else if ((r -= I_O) < I_MKV) { d.W = w_mkv; d.K = 1024; d.N = 2048; d.gain = g_mem; d.WT = WmkvT; }
            else if ((r -= I_MKV) < I_MO) { d.W = w_mo; d.K = 1024; d.N = 1024; d.gain = nullptr; d.WT = WmoT; }
            else if ((r -= I_MO) < 32 * I_GU) { const int e = r / I_GU; r -= e * I_GU; d.W = w_gate_up + (size_t)e * 1024 * 2048; d.K = 1024; d.N = 2048; d.gain = g_moe; d.WT = WguT + (size_t)e * 2048 * 1024; d.mode = 1; }
            else { r -= 32 * I_GU; const int e = r / I_D; r -= e * I_D; d.W = w_down + (size_t)e * 1024 * 1024; d.K = 1024; d.N = 1024; d.gain = nullptr; d.WT = WdT + (size_t)e * 1024 * 1024; }
            d.item = r; return d; };
        {
            f32x4 va[16], vb[16]; CvtDesc dc = desc(0), dn = dc; bool have = false;
            for (int it = gw; ; it += NGW) {
                const bool more = it < NITEMS;
                if (more) { dn = desc(it); cvt_load(dn, vb, lane); }
                if (have) cvt_store(dc, va, scr, lane);
                if (!more) break;
#pragma unroll
                for (int i = 0; i < 16; ++i) va[i] = vb[i];
                dc = dn; have = true;
            }
        }
        for (int i = gw * 64 + lane; i < 64 * 1024 / 8; i += NGW * 64) ((v4u*)(WinT + (size_t)1984 * 1024))[i] = (v4u){0u, 0u, 0u, 0u};
        for (int m = gw * 4; m < T; m += NGW * 4) prep_rows4(x + (size_t)m * D, xb + (size_t)m * D, rstd_x + m, lane);
        for (int m = gw * 4; m < NB * NMEM; m += NGW * 4) prep_rows4(mem + (size_t)m * D, memb + (size_t)m * D, rstd_mem + m, lane);
        { const float* w_router = args.in[19]; float* wrg = (float*)(ws + WS_WRG); for (int i = bx * 512 + tid; i < 1024 * 32; i += G * 512) wrg[i] = w_router[i] * g_moe[i >> 5]; }
        for (int m = gw; m < D; m += NGW) {
            const f32x4* xr = (const f32x4*)(w_mq + (size_t)m * D) + lane; const float gc = g_xattn[m];
            unsigned long long* o8 = (unsigned long long*)(Wmqg + (size_t)m * D) + lane;
#pragma unroll
            for (int j = 0; j < 4; ++j) { const f32x4 v = xr[64 * j] * gc; o8[64 * j] = (unsigned long long)pk2(v.x, v.y) | ((unsigned long long)pk2(v.z, v.w) << 32); }
        }
    }
    if (IN(0)) {
        const float* rel_bias = args.in[9]; float* tbl = (float*)(ws + WS_TBL);
        for (int i = bx * 512 + tid; i < 8 * 2049; i += G * 512) { const int h = i / 2049, r = i % 2049; tbl[h * 2112 + r] = rel_bias[rel_bucket_d(r - 1024) * 8 + h]; }
    }
    GRID_BAR(0);
    if (IN(1)) {
        int kx = 1024; asm volatile("" : "+s"(kx)); pg8::Gemm g{xb, WinT, kx, kx, kx}; pg8::StaticOrder S; S.init(T, 2048, 1024, 1024, G, bx);
        EpiInProj E{rstd_x, (bf16_t*)(ws + WS_QKVA), (bf16_t*)(ws + WS_ZQ), (bf16_t*)(ws + WS_ZKV), (float*)(ws + WS_ZKPE), (float*)(ws + WS_SSQQ), (float*)(ws + WS_SSQKV)};
        pg8::gemm_phase<EpiInProj, pg8::StaticOrder, true, true>(lds, g, S, E);
    }
    GRID_BAR(1);
    if (IN(2)) {
        const int* pos = (const int*)args.in[2];
        float* cs = (float*)(ws + WS_CS); const float* zkpe = (const float*)(ws + WS_ZKPE); bf16_t* kpe = (bf16_t*)(ws + WS_KPE);
        for (int i = bx * 512 + tid; i < T * 16; i += G * 512) {
            const int t = i >> 4, j = i & 15;
            const double rev = (double)pos[t] * args.rope_rev[j];
            const float fr_ = (float)(rev - floor(rev));
            const float sn = __builtin_amdgcn_sinf(fr_), c_ = __builtin_amdgcn_cosf(fr_);
            cs[(size_t)t * 32 + j] = c_; cs[(size_t)t * 32 + 16 + j] = sn;
            const float x1 = zkpe[(size_t)t * 32 + j], x2 = zkpe[(size_t)t * 32 + 16 + j];
            kpe[(size_t)t * 32 + j] = (bf16_t)f2bf(x1 * c_ - x2 * sn); kpe[(size_t)t * 32 + 16 + j] = (bf16_t)f2bf(x1 * sn + x2 * c_);
        }
        {   int kq = 256; asm volatile("" : "+s"(kq)); pg8::Gemm g{(const bf16_t*)(ws + WS_ZQ), WqbT, kq, kq, kq}; pg8::StaticOrder S; S.init(T, 768, 256, 256, G, bx);
            EpiQ E{(const float*)(ws + WS_SSQQ), (bf16_t*)(ws + WS_QB)};
            pg8::gemm_phase<EpiQ, pg8::StaticOrder, true, true>(lds, g, S, E); }
        {   int kk = 128; asm volatile("" : "+s"(kk)); pg8::Gemm g{(const bf16_t*)(ws + WS_ZKV), WkvbT, kk, kk, kk}; const bool memcu = ((bx + 64) % G) < 32 && G > 64; const int bx2 = bx - (bx >= G - 64 + 32 ? 32 : 0);
            pg8::StaticOrder S; S.init(memcu ? 0 : T, 1024, 128, 128, G > 64 ? G - 32 : G, G > 64 ? bx2 : bx);
            EpiKV E{(const float*)(ws + WS_SSQKV), (bf16_t*)(ws + WS_KN), (bf16_t*)(ws + WS_VB)};
            pg8::gemm_phase<EpiKV, pg8::StaticOrder, true, true>(lds, g, S, E); }
        {   int kx = 1024; asm volatile("" : "+s"(kx)); pg8::Gemm g{memb, WmkvT, kx, kx, kx}; pg8::StaticOrder S; S.init(NB * NMEM, 2048, 1024, 1024, G, (bx + 64) % G);
            EpiRowScale E{rstd_mem, (bf16_t*)(ws + WS_KVMEM), 2048};
            pg8::gemm_phase<EpiRowScale, pg8::StaticOrder, true, true>(lds, g, S, E); }
    }
    GRID_BAR(2);
    if (IN(3)) {
        const unsigned short* Qg = (const unsigned short*)(ws + WS_QB); const unsigned short* Kn = (const unsigned short*)(ws + WS_KN);
        const unsigned short* Kp = (const unsigned short*)(ws + WS_KPE); const unsigned short* Vg = (const unsigned short*)(ws + WS_VB);
        const float* cs = (const float*)(ws + WS_CS); unsigned short* Og = (unsigned short*)(ws + WS_OB);
        for (int i = 0; !(args.flags & 8); ++i) {
            int bh, qb;
            if (G == 256) { if (i >= 2) break; const int idx = i * 32 + (bx >> 3); bh = (bx & 7) + 8 * (idx >> 4); qb = idx & 15; }
            else { const int un = i * G + bx; if (un >= 512) break; bh = un >> 4; qb = un & 15; }
            const int b = bh >> 3, h = bh & 7;
#ifdef MLA_ABL
            if (args.flags & 16) mla::mla_unit<MLA_ABL>(Qg, Kn, Kp, Vg, cs, Og, b * S + qb * 256, b * S, h, S, (char*)lds_raw); else
#endif
            mla::mla_unit<0>(Qg, Kn, Kp, Vg, cs, Og, b * S + qb * 256, b * S, h, S, (char*)lds_raw);
        }
        {
            const unsigned short* qkv = (const unsigned short*)(ws + WS_QKVA); const int* pos = (const int*)args.in[2];
            const float* tbl = (const float*)(ws + WS_TBL); unsigned short* oap = (unsigned short*)(ws + WS_OAP); float* lse = (float*)(ws + WS_LSE);
            char* wl = (char*)lds_raw + wave * dil::W_BYTES;
            __syncthreads();
            int cur_h = -1;
            dil::TaskId tc = dil::task_at(0, bx, G, wave), tn = tc; dil::Pre P;
            bool have = !(args.flags & 4) && tc.ub >= 0;
            if (have) dil::dil_prefetch(qkv, pos, tc, P);
            for (int i = 0; have; ++i) {
                tn = dil::task_at(i + 1, bx, G, wave); const bool has_next = tn.ub >= 0;
                if (tc.h != cur_h) { float* tw = (float*)(wl + dil::W_TBL); for (int j = lane; j < 2049; j += 64) tw[j ^ ((j >> 5) & 31)] = tbl[tc.h * dil::TBL_PITCH + j] * 1.4426950408889634f; cur_h = tc.h; asm volatile("s_waitcnt vmcnt(0) lgkmcnt(0)" ::: "memory"); }
                dil::dil_task(qkv, pos, oap, lse, tc, P, has_next, tn, wl);
                tc = tn; have = has_next;
            }
        }
    }
    GRID_BAR(3);
    if (IN(4)) {
        { int kx = 256; asm volatile("" : "+s"(kx));
          if (bx < 64) { pg8::Gemm g{(const bf16_t*)(ws + WS_KVMEM), Wmqg, 2048, 1024, kx}; OrderWp S{bx}; EpiPlain E{(bf16_t*)(ws + WS_WPT), 1024};
              pg8::gemm_phase<EpiPlain, OrderWp, true, true>(lds, g, S, E); }
          else if (bx < 128) { pg8::Gemm g{WmoT, (const bf16_t*)(ws + WS_KVMEM), 1024, 2048, kx}; OrderVw S{bx - 64}; EpiPlain E{(bf16_t*)(ws + WS_VWT), 1024};
              pg8::gemm_phase<EpiPlain, OrderVw, true, true>(lds, g, S, E); } }
        const bf16_t* oap = (const bf16_t*)(ws + WS_OAP); const float* lse = (const float*)(ws + WS_LSE); const bf16_t* obp = (const bf16_t*)(ws + WS_OB);
        const float* g_out_a = args.in[10]; const float* g_out_b = args.in[11]; bf16_t* omix = (bf16_t*)(ws + WS_OMIX);
        const int gw = vcu * NWAVES + wave, NGW = G * NWAVES;
        const f32x4 ga0 = *(const f32x4*)(g_out_a + 8 * lane), ga1 = *(const f32x4*)(g_out_a + 8 * lane + 4), gb0 = *(const f32x4*)(g_out_b + 8 * lane), gb1 = *(const f32x4*)(g_out_b + 8 * lane + 4);
#define UNPK_LO(V_) ((f32x4){__builtin_bit_cast(float, (V_)[0] << 16), __builtin_bit_cast(float, (V_)[0] & 0xffff0000u), __builtin_bit_cast(float, (V_)[1] << 16), __builtin_bit_cast(float, (V_)[1] & 0xffff0000u)})
#define UNPK_HI(V_) ((f32x4){__builtin_bit_cast(float, (V_)[2] << 16), __builtin_bit_cast(float, (V_)[2] & 0xffff0000u), __builtin_bit_cast(float, (V_)[3] << 16), __builtin_bit_cast(float, (V_)[3] & 0xffff0000u)})
        for (int tok = gw; tok < T; tok += NGW) {
            const int head = lane >> 3;
            const float l0 = lse[((size_t)0 * T + tok) * 8 + head], l1 = lse[((size_t)1 * T + tok) * 8 + head], l2 = lse[((size_t)2 * T + tok) * 8 + head];
            const float mx = fmaxf(l0, fmaxf(l1, l2)); float w0 = __expf(l0 - mx), w1 = __expf(l1 - mx), w2 = __expf(l2 - mx); const float wi = 1.0f / (w0 + w1 + w2); w0 *= wi; w1 *= wi; w2 *= wi;
            const v4u q0 = *(const v4u*)(oap + ((size_t)0 * T + tok) * 512 + 8 * lane), q1 = *(const v4u*)(oap + ((size_t)1 * T + tok) * 512 + 8 * lane);
            const v4u q2 = *(const v4u*)(oap + ((size_t)2 * T + tok) * 512 + 8 * lane), qb = *(const v4u*)(obp + (size_t)tok * 512 + 8 * lane);
            const f32x4 a0 = UNPK_LO(q0) * w0 + UNPK_LO(q1) * w1 + UNPK_LO(q2) * w2, a1 = UNPK_HI(q0) * w0 + UNPK_HI(q1) * w1 + UNPK_HI(q2) * w2, b0 = UNPK_LO(qb), b1 = UNPK_HI(qb);
            const float sa = wave_sum(sq8(a0, a1)), sb = wave_sum(sq8(b0, b1));
            const float ra = 1.0f / sqrtf(sa * (1.0f / 512.0f) + 1e-6f), rb = 1.0f / sqrtf(sb * (1.0f / 512.0f) + 1e-6f);
            *(v4u*)(omix + (size_t)tok * 1024 + 8 * lane) = pack8(a0 * ra * ga0, a1 * ra * ga1);
            *(v4u*)(omix + (size_t)tok * 1024 + 512 + 8 * lane) = pack8(b0 * rb * gb0, b1 * rb * gb1);
        }
#undef UNPK_LO
#undef UNPK_HI
    }
    GRID_BAR(4);
    if (IN(5)) {
        int kx = 1024; asm volatile("" : "+s"(kx));
        pg8::Gemm g{(const bf16_t*)(ws + WS_OMIX), WoT, kx, kx, kx}; pg8::StaticOrder S; S.init(T, 1024, 1024, 1024, G, bx);
        EpiResid<false> E{x, (bf16_t*)(ws + WS_H1B), (float*)(ws + WS_SSQH1)};
        pg8::gemm_phase<EpiResid<false>, pg8::StaticOrder, true, true>(lds, g, S, E);
    }
    GRID_BAR(5);
    if (IN(6)) {
        int kx = 1024; asm volatile("" : "+s"(kx));
        pg8::Gemm g{(const bf16_t*)(ws + WS_H1B), (const bf16_t*)(ws + WS_WPT), kx, kx, kx}; OrderBatch S; S.so.init(T, 1024, 1024, 1024, G, bx);
        pg8::Unit u0; const bool has = S.next(0, u0);
        LAS float* rsl = (LAS float*)(lds + CTRL_OFF + 1024);
        if (has && tid < 256) { const float* sp = (const float*)(ws + WS_SSQH1) + (size_t)(u0.pm * 256 + tid) * 16; float a = 0.f;
#pragma unroll
            for (int j = 0; j < 4; ++j) { const f32x4 v = ((const f32x4*)sp)[j]; a += (v[0] + v[1]) + (v[2] + v[3]); }
            rsl[tid] = 1.0f / sqrtf(a * (1.0f / 1024.0f) + 1e-6f); }
        __syncthreads();
        EpiSoftmax E{(bf16_t*)(ws + WS_P), CTRL_OFF + 1024};
        pg8::gemm_phase<EpiSoftmax, OrderBatch, false, true>(lds, g, S, E);
    }
    GRID_BAR(6);
    if (IN(7)) {
        int kx = 1024; asm volatile("" : "+s"(kx));
        pg8::Gemm g{(const bf16_t*)(ws + WS_P), (const bf16_t*)(ws + WS_VWT), kx, kx, kx}; OrderBatch S; S.so.init(T, 1024, 1024, 1024, G, bx);
        EpiResid<true> E{(const bf16_t*)(ws + WS_H1B), (bf16_t*)(ws + WS_H2B), (float*)(ws + WS_SSQH2)};
        pg8::gemm_phase<EpiResid<true>, OrderBatch, true, true>(lds, g, S, E);
    }
    GRID_BAR(7);
    if (IN(8)) {
        typedef float f32x16 __attribute__((ext_vector_type(16)));
        const bf16_t* h2b = (const bf16_t*)(ws + WS_H2B); const float* b_router = args.in[20]; const float* ssq2 = (const float*)(ws + WS_SSQH2);
        int* topi = (int*)(ws + WS_ROUTE + RT_TOPI); float* topg = (float*)(ws + WS_ROUTE + RT_TOPG); int* tslot = (int*)(ws + WS_ROUTE + RT_SLOT); int* row_flat = (int*)(ws + WS_ROUTE + RT_ROWFLAT);
        for (int i = bx * 512 + tid; i < MPADN; i += G * 512) row_flat[i] = -1;
        LAS float* part = (LAS float*)lds;
        LAS float* lgt = (LAS float*)(lds + 32768);
        for (int ch = bx; ch < T / 64; ch += G) {
            const int tok0 = ch * 64, tb = wave & 1, kq = wave >> 1, kh = lane >> 5, row = tok0 + 32 * tb + (lane & 31);
            f32x16 acc = {};
            const bf16_t* ap = h2b + (size_t)row * 1024 + 256 * kq + 4 * kh; const float* wp = (const float*)(ws + WS_WRG) + (size_t)(256 * kq + 4 * kh) * 32 + (lane & 31);
#pragma unroll 8
            for (int j = 0; j < 32; ++j) {
                const v2u aw = *(const v2u*)(ap + 8 * j);
                const f32x4 a4 = (f32x4){__builtin_bit_cast(float, aw.x << 16), __builtin_bit_cast(float, aw.x & 0xffff0000u), __builtin_bit_cast(float, aw.y << 16), __builtin_bit_cast(float, aw.y & 0xffff0000u)};
#pragma unroll
                for (int e = 0; e < 4; ++e) acc = __builtin_amdgcn_mfma_f32_32x32x2f32(a4[e], wp[(size_t)(8 * j + e) * 32], acc, 0, 0, 0);
            }
#pragma unroll
            for (int r = 0; r < 16; ++r) part[((kq * 64) + tb * 32 + (r & 3) + 8 * (r >> 2) + 4 * kh) * 32 + (lane & 31)] = acc[r];
            __syncthreads();
            {
                const int tk = tid >> 3, e0 = (tid & 7) * 4; const float* sp = ssq2 + (size_t)(tok0 + tk) * 16; float a = 0.f;
#pragma unroll
                for (int j = 0; j < 4; ++j) { const f32x4 v = ((const f32x4*)sp)[j]; a += (v[0] + v[1]) + (v[2] + v[3]); }
                const float rs = 1.0f / sqrtf(a * (1.0f / 1024.0f) + 1e-6f);
                if (e0 == 0) ((float*)(ws + WS_ROUTE + RT_RSTD))[tok0 + tk] = rs;
#pragma unroll
                for (int e = 0; e < 4; ++e) lgt[tk * 33 + e0 + e] = rs * ((part[(0 * 64 + tk) * 32 + e0 + e] + part[(1 * 64 + tk) * 32 + e0 + e]) + (part[(2 * 64 + tk) * 32 + e0 + e] + part[(3 * 64 + tk) * 32 + e0 + e])) + b_router[e0 + e];
            }
            __syncthreads();
            if (tid < 64) {
                int c0 = -1, c1 = -1, c2 = -1, c3 = -1; float v0 = 0.f, v1 = 0.f, v2 = 0.f, v3 = 0.f; int s0 = 0, s1 = 0, s2 = 0, s3 = 0;
                for (int k = 0; k < 4; ++k) {
                    float best = -3.0e38f; int bi = 0;
                    for (int e = 0; e < 32; ++e) { const float v = lgt[tid * 33 + e]; if (e == c0 || e == c1 || e == c2 || e == c3) continue; if (v > best) { best = v; bi = e; } }
                    if (k == 0) { c0 = bi; v0 = best; } else if (k == 1) { c1 = bi; v1 = best; } else if (k == 2) { c2 = bi; v2 = best; } else { c3 = bi; v3 = best; }
                }
                const unsigned long long lt = (1ull << lane) - 1ull; int* cntc = (int*)(ws + WS_ROUTE + RT_CNT) + ch * 32;
                for (int e = 0; e < 32; ++e) {
                    const unsigned long long m0 = __ballot(c0 == e), m1 = __ballot(c1 == e), m2 = __ballot(c2 == e), m3 = __ballot(c3 == e);
                    const int before = __popcll(m0 & lt) + __popcll(m1 & lt) + __popcll(m2 & lt) + __popcll(m3 & lt);
                    if (c0 == e) s0 = before; if (c1 == e) s1 = before; if (c2 == e) s2 = before; if (c3 == e) s3 = before;
                    if (lane == e) cntc[e] = __popcll(m0) + __popcll(m1) + __popcll(m2) + __popcll(m3);
                }
                const int t = tok0 + tid;
                const float e1 = __expf(v1 - v0), e2 = __expf(v2 - v0), e3 = __expf(v3 - v0), inv = 1.0f / (1.0f + e1 + e2 + e3);
                *(int4*)(topi + t * 4) = make_int4(c0, c1, c2, c3);
                *(f32x4*)(topg + t * 4) = (f32x4){inv, e1 * inv, e2 * inv, e3 * inv};
                *(int4*)(tslot + t * 4) = make_int4(s0, s1, s2, s3);
            }
            __syncthreads();
        }
    }
    GRID_BAR(8);
    if (IN(9)) {
        const int* topi = (const int*)(ws + WS_ROUTE + RT_TOPI); const int* tslot = (const int*)(ws + WS_ROUTE + RT_SLOT); const int* cnt = (const int*)(ws + WS_ROUTE + RT_CNT);
        int* row_flat = (int*)(ws + WS_ROUTE + RT_ROWFLAT); float* rs_row = (float*)(ws + WS_ROUTE + RT_RSROW); const float* rstd2 = (const float*)(ws + WS_ROUTE + RT_RSTD);
        LAS int* red = (LAS int*)lds;
        for (int base = bx * 512; base < NA; base += G * 512) {
            const int chA = base >> 8, e = tid & 31, part = tid >> 5;
            int tot = 0, pa = 0, pb = 0;
            for (int c = part; c < T / 64; c += 16) { const int v = cnt[c * 32 + e]; tot += v; pa += c < chA ? v : 0; pb += c <= chA ? v : 0; }
            __syncthreads();
            red[(0 * 16 + part) * 32 + e] = tot; red[(1 * 16 + part) * 32 + e] = pa; red[(2 * 16 + part) * 32 + e] = pb;
            __syncthreads();
            if (tid < 96) { const int w = tid >> 5; int a = 0; for (int p = 0; p < 16; ++p) a += red[(w * 16 + p) * 32 + e]; red[1536 + w * 32 + e] = a; }
            __syncthreads();
            if (tid == 0) { int run = 0; for (int q = 0; q < NE; ++q) { red[1632 + q] = run; run += ((red[1536 + q] + 255) >> 8) << 8; } }
            if (bx == 0 && base == 0 && tid < 32) ((int*)(ws + WS_ROUTE + RT_TOT))[tid] = red[1536 + tid];
            __syncthreads();
            const int a = base + tid, ex = topi[a], row = red[1632 + ex] + red[1536 + 32 * (1 + (((a >> 8) - chA) & 1)) + ex] + tslot[a];
            row_flat[row] = a; rs_row[row] = rstd2[a >> 2];
        }
    }
    GRID_BAR(9);
    if (IN(10) || IN(11)) {
        const int* gtot = (const int*)(ws + WS_ROUTE + RT_TOT); LAS int* texp = (LAS int*)(lds + LX_TEXP);
        __syncthreads();
        if (tid == 0) { int nt = 0; for (int e = 0; e < NE; ++e) { const int n = (gtot[e] + 255) >> 8; for (int j = 0; j < n; ++j) texp[nt + j] = e; nt += n; } texp[NTILEN] = nt; }
        __syncthreads();
    }
    if (IN(10)) {
        int kx = 1024; asm volatile("" : "+s"(kx));
        pg8::Gemm g{(const bf16_t*)(ws + WS_H2B), WguT, kx, kx, kx}; OrderMoe S{(const LAS int*)(lds + LX_TEXP), 8, bx, G, (size_t)2048 * 1024 * 2};
        {
            const int* row_flat = (const int*)(ws + WS_ROUTE + RT_ROWFLAT); pg8::Unit u;
            for (int i = 0; i < pg8::GTAB_UNITS; ++i) { if (!S.next(i, u)) break; if (tid < 256) { const int a = row_flat[u.pm * 256 + tid]; ((LAS unsigned short*)(lds + pg8::GTAB))[i * 256 + tid] = (unsigned short)(a >= 0 ? (a >> 2) : 0); } }
            __syncthreads();
        }
        EpiSwiGLU E{(const float*)(ws + WS_ROUTE + RT_RSROW), args.in[22], (bf16_t*)(ws + WS_HMID), (const LAS int*)(lds + LX_TEXP)};
        pg8::gemm_phase<EpiSwiGLU, OrderMoe, true, true, true>(lds, g, S, E);
    }
    GRID_BAR(10);
    if (IN(11)) {
        int kx = 1024; asm volatile("" : "+s"(kx));
        pg8::Gemm g{(const bf16_t*)(ws + WS_HMID), WdT, kx, kx, kx}; OrderMoe S{(const LAS int*)(lds + LX_TEXP), 4, bx, G, (size_t)1024 * 1024 * 2};
        EpiDown E{(const int*)(ws + WS_ROUTE + RT_ROWFLAT), (const float*)(ws + WS_ROUTE + RT_TOPG), args.in[24], (bf16_t*)(ws + WS_YBUF), (const LAS int*)(lds + LX_TEXP)};
        pg8::gemm_phase<EpiDown, OrderMoe, true, true>(lds, g, S, E);
    }
    GRID_BAR(11);
    if (IN(12)) {
        const bf16_t* h2b = (const bf16_t*)(ws + WS_H2B); const bf16_t* ybuf = (const bf16_t*)(ws + WS_YBUF); const float* g_final = args.in[25]; float* outp = args.out;
        const int gw = vcu * NWAVES + wave, NGW = G * NWAVES;
        for (int t = gw; t < T; t += NGW) {
            f32x4 v[4]; float ss = 0.f;
#pragma unroll
            for (int j = 0; j < 4; ++j) {
                const v2u hw = *(const v2u*)(h2b + (size_t)t * 1024 + 256 * j + 4 * lane);
                f32x4 a = (f32x4){__builtin_bit_cast(float, hw.x << 16), __builtin_bit_cast(float, hw.x & 0xffff0000u), __builtin_bit_cast(float, hw.y << 16), __builtin_bit_cast(float, hw.y & 0xffff0000u)};
#pragma unroll
                for (int k = 0; k < 4; ++k) { const v2u y = *(const v2u*)(ybuf + ((size_t)t * 4 + k) * 1024 + 256 * j + 4 * lane);
                    a[0] += __builtin_bit_cast(float, y.x << 16); a[1] += __builtin_bit_cast(float, y.x & 0xffff0000u); a[2] += __builtin_bit_cast(float, y.y << 16); a[3] += __builtin_bit_cast(float, y.y & 0xffff0000u); }
                v[j] = a; ss += (a[0] * a[0] + a[1] * a[1]) + (a[2] * a[2] + a[3] * a[3]);
            }
            ss = wave_sum(ss); const float rs = 1.0f / sqrtf(ss * (1.0f / 1024.0f) + 1e-6f);
#pragma unroll
            for (int j = 0; j < 4; ++j) *(f32x4*)(outp + (size_t)t * 1024 + 256 * j + 4 * lane) = v[j] * rs * *(const f32x4*)(g_final + 256 * j + 4 * lane);
        }
    }
#undef GRID_BAR
#undef BOTH
#undef IN
}

}
void launch_mk(hipStream_t st, const mk::Args& base, int lo, int hi, int grid) {
    mk::Args a = base; a.ph_lo = lo; a.ph_hi = hi;
    hipLaunchKernelGGL(mk::mk_fwd, dim3(grid), dim3(mk::NWAVES * 64), mk::LDS_BYTES, st, a);
}
}

extern "C" void kernel_launch(void* const* d_in, const int* in_sizes, int n_in, void* d_out, int out_size, void* d_ws, size_t ws_size, hipStream_t stream) {
    static int grid = 0;
    if (grid == 0) {
        int dev = 0, cus = 0;
        if (hipGetDevice(&dev) != hipSuccess || hipDeviceGetAttribute(&cus, hipDeviceAttributeMultiprocessorCount, dev) != hipSuccess) { grid = -1; return; }
        if (hipFuncSetAttribute((const void*)mk::mk_fwd, hipFuncAttributeMaxDynamicSharedMemorySize, mk::LDS_BYTES) != hipSuccess) { grid = -1; return; }
        grid = cus >= 256 ? 256 : cus;
    }
    if (grid < 0) return;
    const float* x = (const float*)d_in[0];
    const float* mem = (const float*)d_in[1];
    const int* pos = (const int*)d_in[2];
    const float* g_q_a = (const float*)d_in[5];
    const float* w_q_b = (const float*)d_in[6];
    const float* g_kv_a = (const float*)d_in[7];
    const float* w_kv_b = (const float*)d_in[8];
    const float* rel_bias = (const float*)d_in[9];
    const float* g_out_a = (const float*)d_in[10];
    const float* g_out_b = (const float*)d_in[11];
    const float* w_o = (const float*)d_in[12];
    const float* g_xattn = (const float*)d_in[13];
    const float* g_mem = (const float*)d_in[14];
    const float* w_mq = (const float*)d_in[15];
    const float* w_mkv = (const float*)d_in[16];
    const float* w_mo = (const float*)d_in[17];
    const float* g_moe = (const float*)d_in[18];
    const float* w_router = (const float*)d_in[19];
    const float* b_router = (const float*)d_in[20];
    const float* w_gate_up = (const float*)d_in[21];
    const float* b_gate_up = (const float*)d_in[22];
    const float* w_down = (const float*)d_in[23];
    const float* b_down = (const float*)d_in[24];
    const float* g_final = (const float*)d_in[25];
    float* out = (float*)d_out;
    (void)ws_size; (void)in_sizes; (void)n_in; (void)out_size;

    (void)hipMemsetAsync((char*)d_ws + mk::WS_CTL, 0, mk::CTL_ZERO_BYTES, stream);
    mk::Args ma; memset(&ma, 0, sizeof(ma));
    for (int i = 0; i < 26; ++i) ma.in[i] = (const float*)d_in[i];
    ma.out = out; ma.ws = (unsigned char*)d_ws; ma.flags = 1;
    for (int j = 0; j < 16; ++j) ma.rope_rev[j] = pow(10000.0, -(double)j / 16.0) / 6.283185307179586476925287;
#ifndef MK_N_LAUNCHES
#define MK_N_LAUNCHES 1
#endif
    if (MK_N_LAUNCHES == 1) launch_mk(stream, ma, 0, 13, grid);
    else for (int p = 0; p < 13; ++p) launch_mk(stream, ma, p, p + 1, grid);
#ifdef PROBE_MASK
#ifdef PROBE_FLAGS
    ma.flags |= PROBE_FLAGS;
#endif
    for (int r = 0; r < PROBE_N; ++r) for (int p = 0; p < 13; ++p) if ((PROBE_MASK >> p) & 1) launch_mk(stream, ma, p, p + 1, grid);
#endif
}
```

```cpp
#include <hip/hip_runtime.h>
#include <stdint.h>
#include <string.h>
#include <math.h>

namespace {
constexpr int NB = 4, S = 4096, D = 1024, T = NB * S, NMEM = 256, INW = 1952;
constexpr int NE = 32, TOPK = 4, NA = T * TOPK;

namespace pg8 {
#define PG8_LAS __attribute__((address_space(3)))
typedef unsigned short bf16_t;
typedef short bf16x8 __attribute__((ext_vector_type(8)));
typedef float f32x4 __attribute__((ext_vector_type(4)));
typedef unsigned u32x4 __attribute__((ext_vector_type(4)));
constexpr int BM = 256, BK = 64, HALF = 128, HTB = HALF * BK * 2  , STAGE_BYTES = 8 * HTB, NXCD = 8, WGM = 8;

__host__ __device__ __forceinline__ int lds_byte(int r, int c) { const int st = (r >> 4) * 2 + (c >> 5), rr = r & 15, cc = c & 31, ob = rr * 64 + cc * 2; return st * 1024 + (ob ^ (((ob >> 9) & 1) << 5)); }
__host__ __device__ __forceinline__ void stage_rc(int b, int& R, int& C) { const int st = b / 1024, sb = b % 1024, swz = sb ^ (((sb >> 9) & 1) << 5); R = (st >> 1) * 16 + swz / 64; C = (st & 1) * 32 + (swz % 64) / 2; }
__host__ __device__ __forceinline__ int perm32(int rho) { const int n = rho >> 4, i = rho & 15; return 8 * (i >> 2) + 4 * n + (i & 3); }

struct Unit { int pm, pn; size_t aoff, boff; };
struct Gemm { const bf16_t* A; const bf16_t* Bt; int lda, ldb, K; };

struct StaticOrder {
    int nM, nN, nwg, G, c; size_t ta, tb;
    __host__ __device__ __forceinline__ void init(int M, int N, int lda, int ldb, int G_, int c_) { nM = M / BM; nN = N / BM; nwg = nM * nN; G = G_; c = c_; ta = (size_t)BM * lda * 2; tb = (size_t)BM * ldb * 2; }
    __host__ __device__ __forceinline__ bool next(int i, Unit& u) const {
        const long L = (long)i * G + c; if (L >= nwg) return false;
        int wgid = (int)L; { const int q = nwg / NXCD, r = nwg % NXCD, xcd = wgid % NXCD, off = wgid / NXCD; wgid = (xcd < r ? xcd * (q + 1) : r * (q + 1) + (xcd - r) * q) + off; }
        const int nig = WGM * nN, gid = wgid / nig, fm = gid * WGM, gsz = (nM - fm) < WGM ? (nM - fm) : WGM;
        u.pm = fm + ((wgid % nig) % gsz); u.pn = (wgid % nig) / gsz; u.aoff = (size_t)u.pm * ta; u.boff = (size_t)u.pn * tb; return true;
    }
    __device__ __forceinline__ void a_ready(const Unit&) const {}
    __device__ __forceinline__ void done(const Unit&) const {}
};

__device__ __forceinline__ unsigned cvt_pk_bf16(float lo, float hi) { unsigned r; asm volatile("v_cvt_pk_bf16_f32 %0, %1, %2" : "=v"(r) : "v"(lo), "v"(hi)); return r; }
typedef float f32x2 __attribute__((ext_vector_type(2)));

constexpr int GTAB = 135168 + 4096, GTAB_UNITS = 10;
template <class Epi, class Sched, bool ALIGN_EPI = false, bool SP2 = false, bool GATHER = false>
__device__ __forceinline__ void gemm_phase(PG8_LAS unsigned char* lds, const Gemm g, const Sched& S, const Epi& E) {
    const int tid = threadIdx.x, wid = __builtin_amdgcn_readfirstlane(tid >> 6), lane = tid & 63, wr = wid >> 2, wc = wid & 3, fr = lane & 15, fq = lane >> 4;
    static_assert(!GATHER || SP2, "GATHER is implemented for the SP2 loop only");
    const int K = g.K, nt = K / BK;
    unsigned voffA[2], voffB[2];
#pragma unroll
    for (int i = 0; i < 2; ++i) { int R, C; stage_rc(tid * 16 + i * 8192, R, C); const int Rb = Epi::PERM ? ((R & ~31) + perm32(R & 31)) : R;
        voffA[i] = (unsigned)(R * g.lda + C) * 2u; voffB[i] = (unsigned)(Rb * g.ldb + C) * 2u; }
    unsigned gidx[2], gcol[2];
#pragma unroll
    for (int i = 0; i < 2; ++i) { int R, C; stage_rc(tid * 16 + i * 8192, R, C); gidx[i] = (unsigned)R * 2u; gcol[i] = (unsigned)C * 2u; }
    const size_t kstep = (size_t)(BK * 2);
    const size_t hstepA = (size_t)HALF * g.lda * 2, hstepB = (size_t)HALF * g.ldb * 2;
    const unsigned ldsw = (unsigned)wid * 1024u;
    const int aoff = lds_byte(wr * 64 + fr, fq * 8), boff = lds_byte(wc * 32 + fr, fq * 8);
#define PG8_SA(b, h) (((b) * 2 + (h)) * HTB)
#define PG8_SB(b, h) ((4 + (b) * 2 + (h)) * HTB)
#define PG8_STAGE(bufoff, gbase, voff) do { _Pragma("unroll") for (int _i = 0; _i < 2; ++_i) \
        __builtin_amdgcn_global_load_lds((const unsigned*)((const char*)(gbase) + (voff)[_i]), (PG8_LAS unsigned*)(lds + (bufoff) + ldsw + _i * 8192), 16, 0, 0); } while (0)
#define PG8_GTOK(h, sel) do { if constexpr (GATHER) { tk0 = *(const PG8_LAS unsigned short*)(lds + GTAB + (sel) * 512 + (h) * 256 + gidx[0]); tk1 = *(const PG8_LAS unsigned short*)(lds + GTAB + (sel) * 512 + (h) * 256 + gidx[1]); } } while (0)
#define PG8_STAGE_A(bufoff, gbase, h, sel) do { if constexpr (GATHER) { \
        __builtin_amdgcn_global_load_lds((const unsigned*)((const char*)(gbase) + (size_t)tk0 * (size_t)(g.lda * 2) + gcol[0]), (PG8_LAS unsigned*)(lds + (bufoff) + ldsw), 16, 0, 0); \
        __builtin_amdgcn_global_load_lds((const unsigned*)((const char*)(gbase) + (size_t)tk1 * (size_t)(g.lda * 2) + gcol[1]), (PG8_LAS unsigned*)(lds + (bufoff) + ldsw + 8192), 16, 0, 0); } \
    else { PG8_STAGE(bufoff, (gbase) + (h) * hstepA, voffA); } } while (0)
#define PG8_LDA(dst, b, h) do { _Pragma("unroll") for (int m = 0; m < 4; ++m) _Pragma("unroll") for (int k = 0; k < 2; ++k) dst[m][k] = *(const PG8_LAS bf16x8*)(lds + PG8_SA(b, h) + aoff + m * 2048 + k * 1024); } while (0)
#define PG8_LDB(dst, b, h) do { _Pragma("unroll") for (int n = 0; n < 2; ++n) _Pragma("unroll") for (int k = 0; k < 2; ++k) dst[n][k] = *(const PG8_LAS bf16x8*)(lds + PG8_SB(b, h) + boff + n * 2048 + k * 1024); } while (0)
#define PG8_MMA(ai, bj, At, Bt) do { __builtin_amdgcn_s_setprio(1); _Pragma("unroll") for (int m = 0; m < 4; ++m) _Pragma("unroll") for (int n = 0; n < 2; ++n) _Pragma("unroll") for (int k = 0; k < 2; ++k) \
        acc[ai][bj][m][n] = __builtin_amdgcn_mfma_f32_16x16x32_bf16(Bt[n][k], At[m][k], acc[ai][bj][m][n], 0, 0, 0); __builtin_amdgcn_s_setprio(0); } while (0)
#define PG8_WAIT_V(n) asm volatile("s_waitcnt vmcnt(" #n ")" ::: "memory")
#define PG8_WAIT_L(n) asm volatile("s_waitcnt lgkmcnt(" #n ")" ::: "memory")
#define PG8_BAR __builtin_amdgcn_s_barrier()
#define PG8_SCHED __builtin_amdgcn_sched_barrier(0)
    Unit cur, nxt; int ui = 0; unsigned tk0 = 0, tk1 = 0; (void)tk0; (void)tk1;
    if (!S.next(0, cur)) return;
    f32x4 acc[2][2][4][2];
#pragma unroll
    for (int a = 0; a < 2; ++a)
#pragma unroll
        for (int b = 0; b < 2; ++b)
#pragma unroll
            for (int m = 0; m < 4; ++m)
#pragma unroll
                for (int n = 0; n < 2; ++n) acc[a][b][m][n] = (f32x4){0.f, 0.f, 0.f, 0.f};
    bf16x8 At[4][2], B0[2][2], B1[2][2];
    const char* cA = (const char*)g.A + (GATHER ? (size_t)0 : cur.aoff); const char* cB = (const char*)g.Bt + cur.boff;
    S.a_ready(cur);
    if constexpr (SP2) {
        PG8_STAGE(PG8_SB(0, 0), cB, voffB); PG8_STAGE(PG8_SB(0, 1), cB + hstepB, voffB); PG8_GTOK(0, ui); PG8_STAGE_A(PG8_SA(0, 0), cA, 0, ui); PG8_GTOK(1, ui); PG8_STAGE_A(PG8_SA(0, 1), cA, 1, ui);
        if (wr == 1) PG8_BAR;
        PG8_WAIT_V(2); PG8_BAR;
        PG8_STAGE(PG8_SB(1, 0), cB + kstep, voffB); PG8_GTOK(0, ui); PG8_STAGE_A(PG8_SA(1, 0), cA + kstep, 0, ui); PG8_STAGE(PG8_SB(1, 1), cB + hstepB + kstep, voffB);
        PG8_WAIT_V(6); PG8_BAR;
    } else {
        PG8_STAGE(PG8_SB(0, 0), cB, voffB); PG8_STAGE_A(PG8_SA(0, 0), cA, 0, ui); PG8_STAGE(PG8_SB(0, 1), cB + hstepB, voffB); PG8_STAGE_A(PG8_SA(0, 1), cA, 1, ui);
        if (wr == 1) PG8_BAR;
        PG8_WAIT_V(4); PG8_BAR;
        PG8_STAGE(PG8_SB(1, 0), cB + kstep, voffB); PG8_STAGE_A(PG8_SA(1, 0), cA + kstep, 0, ui); PG8_STAGE(PG8_SB(1, 1), cB + hstepB + kstep, voffB);
        PG8_WAIT_V(6); PG8_BAR;
    }
    for (;;) {
        const bool has_next = S.next(ui + 1, nxt);
        const char* nA = has_next ? (const char*)g.A + (GATHER ? (size_t)0 : nxt.aoff) : cA; const char* nB = has_next ? (const char*)g.Bt + nxt.boff : cB;
        for (int t = 0; t < nt; t += 2) {
            const bool last = (t == nt - 2);
            const char* a1 = cA + (size_t)(t + 1) * kstep;
            const char* a2 = last ? nA : cA + (size_t)(t + 2) * kstep; const char* b2 = last ? nB : cB + (size_t)(t + 2) * kstep;
            const char* a3 = a2 + kstep; const char* b3 = b2 + kstep; const int ui2 = (last && has_next) ? ui + 1 : ui; (void)ui2;
            if (last && has_next) S.a_ready(nxt);
            if constexpr (SP2) {
            PG8_GTOK(1, ui); PG8_LDB(B0, 0, 0); PG8_LDB(B1, 0, 1); PG8_SCHED; PG8_LDA(At, 0, 0); PG8_STAGE_A(PG8_SA(1, 1), a1, 1, ui);
            PG8_WAIT_V(8); PG8_WAIT_L(0); PG8_BAR; PG8_MMA(0, 0, At, B0); PG8_MMA(0, 1, At, B1); PG8_BAR; PG8_SCHED;
            PG8_GTOK(0, ui2); PG8_LDA(At, 0, 1); PG8_STAGE(PG8_SB(0, 0), b2, voffB); PG8_STAGE(PG8_SB(0, 1), b2 + hstepB, voffB); PG8_STAGE_A(PG8_SA(0, 0), a2, 0, ui2);
            PG8_WAIT_V(8); PG8_WAIT_L(0); PG8_BAR; PG8_MMA(1, 0, At, B0); PG8_MMA(1, 1, At, B1); PG8_BAR; PG8_SCHED;
            PG8_GTOK(1, ui2); PG8_LDB(B0, 1, 0); PG8_LDB(B1, 1, 1); PG8_SCHED; PG8_LDA(At, 1, 0); PG8_STAGE_A(PG8_SA(0, 1), a2, 1, ui2);
            PG8_WAIT_V(8); PG8_WAIT_L(0); PG8_BAR; PG8_MMA(0, 0, At, B0); PG8_MMA(0, 1, At, B1); PG8_BAR; PG8_SCHED;
            PG8_GTOK(0, ui2); PG8_LDA(At, 1, 1); PG8_STAGE(PG8_SB(1, 0), b3, voffB); PG8_STAGE(PG8_SB(1, 1), b3 + hstepB, voffB); PG8_STAGE_A(PG8_SA(1, 0), a3, 0, ui2);
            PG8_WAIT_V(8); PG8_WAIT_L(0); PG8_BAR; PG8_MMA(1, 0, At, B0); PG8_MMA(1, 1, At, B1); PG8_BAR; PG8_SCHED;
            } else {
            PG8_LDB(B0, 0, 0); PG8_SCHED; PG8_LDA(At, 0, 0); PG8_STAGE_A(PG8_SA(1, 1), a1, 1, ui);
            PG8_WAIT_L(8); PG8_BAR; PG8_WAIT_L(0); PG8_MMA(0, 0, At, B0); PG8_BAR; PG8_SCHED;
            PG8_LDB(B1, 0, 1); PG8_STAGE(PG8_SB(0, 0), b2, voffB);
            PG8_BAR; PG8_WAIT_L(0); PG8_MMA(0, 1, At, B1); PG8_BAR;
            PG8_LDA(At, 0, 1); PG8_STAGE_A(PG8_SA(0, 0), a2, 0, ui2);
            PG8_BAR; PG8_WAIT_L(0); PG8_MMA(1, 0, At, B0); PG8_BAR; PG8_SCHED;
            PG8_STAGE(PG8_SB(0, 1), b2 + hstepB, voffB);
            PG8_WAIT_V(6); PG8_BAR; PG8_MMA(1, 1, At, B1); PG8_BAR;
            PG8_LDB(B0, 1, 0); PG8_SCHED; PG8_LDA(At, 1, 0); PG8_STAGE_A(PG8_SA(0, 1), a2, 1, ui2);
            PG8_WAIT_L(8); PG8_BAR; PG8_WAIT_L(0); PG8_MMA(0, 0, At, B0); PG8_BAR; PG8_SCHED;
            PG8_LDB(B1, 1, 1); PG8_STAGE(PG8_SB(1, 0), b3, voffB);
            PG8_BAR; PG8_WAIT_L(0); PG8_MMA(0, 1, At, B1); PG8_BAR;
            PG8_LDA(At, 1, 1); PG8_STAGE_A(PG8_SA(1, 0), a3, 0, ui2);
            PG8_BAR; PG8_WAIT_L(0); PG8_MMA(1, 0, At, B0); PG8_BAR; PG8_SCHED;
            PG8_STAGE(PG8_SB(1, 1), b3 + hstepB, voffB);
            PG8_WAIT_V(6); PG8_BAR; PG8_MMA(1, 1, At, B1); PG8_BAR;
            }
        }
        if constexpr (ALIGN_EPI) { if (wr == 0) PG8_BAR; }
        if constexpr (!Epi::AFTER_DRAIN) { E(acc, cur, wr, wc, fr, fq); S.done(cur); }
        if (!has_next) break;
#pragma unroll
        for (int a = 0; a < 2; ++a)
#pragma unroll
            for (int b = 0; b < 2; ++b)
#pragma unroll
                for (int m = 0; m < 4; ++m)
#pragma unroll
                    for (int n = 0; n < 2; ++n) acc[a][b][m][n] = (f32x4){0.f, 0.f, 0.f, 0.f};
        cur = nxt; cA = nA; cB = nB; ++ui;
        if constexpr (ALIGN_EPI) { if (wr == 1) PG8_BAR; }
    }
    PG8_WAIT_V(0);
    if constexpr (!ALIGN_EPI) { if (wr == 0) PG8_BAR; }
    PG8_BAR;
    if constexpr (Epi::AFTER_DRAIN) { E.fused(acc, cur, wr, wc, fr, fq, lds, wid, lane); S.done(cur); }
#undef PG8_SA
#undef PG8_SB
#undef PG8_STAGE
#undef PG8_STAGE_A
#undef PG8_GTOK
#undef PG8_LDA
#undef PG8_LDB
#undef PG8_MMA
#undef PG8_WAIT_V
#undef PG8_WAIT_L
#undef PG8_BAR
#undef PG8_SCHED
}
}
namespace mla {
using bf16x8 = __attribute__((ext_vector_type(8))) short;
using s16x4  = __attribute__((ext_vector_type(4))) short;
using f32x16 = __attribute__((ext_vector_type(16))) float;
using u32x4  = __attribute__((ext_vector_type(4))) unsigned;
constexpr int NW = 8, QBLK = 32, KVBLK = 64;
constexpr float SCALE = 0.10206207261596577f;
constexpr float THR = 8.f;
constexpr int SHM_V = KVBLK * 64 * 2, SHM_K = KVBLK * 256;
constexpr int SHM_ATTN = 4 * SHM_V + 4 * SHM_K + NW * 64 * 4;
#define KSWZ(row, colB) ((row) * 256 + ((colB) ^ (((row) & 7) << 4)))
#define SBAR() __builtin_amdgcn_sched_barrier(0)
__device__ __forceinline__ int crow(int r, int hi) { return (r & 3) + 8 * (r >> 2) + 4 * hi; }
__device__ __forceinline__ unsigned cvtpk(float lo, float hi) { unsigned r; asm volatile("v_cvt_pk_bf16_f32 %0, %1, %2" : "=v"(r) : "v"(lo), "v"(hi)); return r; }

__device__ __forceinline__ float max3f(float a, float b, float c) { return __builtin_fmaxf(__builtin_fmaxf(a, b), c); }
template <int ABL> __device__ __forceinline__ void partialSM(f32x16& p0, f32x16& p1, float& m_reg, float& alpha, bool first) {
  float a = max3f(p0[0], p0[1], p0[2]), b = max3f(p0[3], p1[0], p1[1]), c = max3f(p1[2], p1[3], p0[4]), d = max3f(p0[5], p0[6], p0[7]);
  a = max3f(a, p1[4], p1[5]); b = max3f(b, p1[6], p1[7]);
#pragma unroll
  for (int r = 8; r < 16; r += 4) { a = max3f(a, p0[r], p0[r + 1]); b = max3f(b, p0[r + 2], p0[r + 3]); c = max3f(c, p1[r], p1[r + 1]); d = max3f(d, p1[r + 2], p1[r + 3]); }
  float pmax = fmaxf(fmaxf(a, b), fmaxf(c, d));
  { auto rr = __builtin_amdgcn_permlane32_swap(__float_as_uint(pmax), __float_as_uint(pmax), false, false);
    pmax = fmaxf(__uint_as_float(rr[0]), __uint_as_float(rr[1])); }
  if (__builtin_expect(!first && __all(pmax - m_reg <= THR * 1.4426950408889634f), 1)) { alpha = 1.f; }
  else { const float mn = first ? pmax : fmaxf(m_reg, pmax); alpha = first ? 1.f : __builtin_amdgcn_exp2f(m_reg - mn); m_reg = mn; }
#pragma unroll
  for (int r = 0; r < 16; ++r) { p0[r] -= m_reg; p1[r] -= m_reg; }
#pragma unroll
  for (int r = 0; r < 16; ++r) p0[r] = (ABL & 2) ? p0[r] * 0.5f : __builtin_amdgcn_exp2f(p0[r]);
}
template <int ABL> __device__ __forceinline__ void finishSM(f32x16& p0, f32x16& p1, float alpha, float& l_reg, bf16x8& pa0, bf16x8& pa1, bf16x8& pa2, bf16x8& pa3) {
#pragma unroll
  for (int r = 0; r < 16; ++r) p1[r] = (ABL & 2) ? p1[r] * 0.5f : __builtin_amdgcn_exp2f(p1[r]);
  float ps, s0 = 0.f, s1 = 0.f, s2 = 0.f, s3 = 0.f;
#pragma unroll
  for (int r = 0; r < 16; r += 4) { s0 += p0[r]; s1 += p0[r + 1]; s2 += p0[r + 2]; s3 += p0[r + 3]; }
#pragma unroll
  for (int r = 0; r < 16; r += 4) { s0 += p1[r]; s1 += p1[r + 1]; s2 += p1[r + 2]; s3 += p1[r + 3]; }
  ps = (s0 + s1) + (s2 + s3);
  { auto rr = __builtin_amdgcn_permlane32_swap(__float_as_uint(ps), __float_as_uint(ps), false, false);
    ps = __uint_as_float(rr[0]) + __uint_as_float(rr[1]); }
  l_reg = l_reg * alpha + ps;
#define PK4(P, BASE, OUT) do { u32x4 w = {cvtpk(P[BASE + 0], P[BASE + 1]), cvtpk(P[BASE + 2], P[BASE + 3]), cvtpk(P[BASE + 4], P[BASE + 5]), cvtpk(P[BASE + 6], P[BASE + 7])}; \
    OUT = *reinterpret_cast<bf16x8*>(&w); } while (0)
  PK4(p0, 0, pa0); PK4(p0, 8, pa1); PK4(p1, 0, pa2); PK4(p1, 8, pa3);
#undef PK4
}
__device__ __forceinline__ void qkt(f32x16& p0, f32x16& p1, const char* Ks, const bf16x8* qr, int r32, int hi) {
  p0 = f32x16{}; p1 = f32x16{};
#pragma unroll
  for (int d0 = 0; d0 < 6; ++d0) { int cb = (d0 * 16 + hi * 8) * 2;
    bf16x8 b0 = *reinterpret_cast<const bf16x8*>(Ks + KSWZ(r32, cb));
    bf16x8 b1 = *reinterpret_cast<const bf16x8*>(Ks + KSWZ(32 + r32, cb));
    p0 = __builtin_amdgcn_mfma_f32_32x32x16_bf16(b0, qr[d0], p0, 0, 0, 0);
    p1 = __builtin_amdgcn_mfma_f32_32x32x16_bf16(b1, qr[d0], p1, 0, 0, 0); }
}
__device__ __forceinline__ int v_st(int k, int c) { const int kk = k;
  return ((kk >> 3) * 2 + (c >> 5)) * 512 + ((kk & 7) * 32 + (c & 31)) * 2; }
__device__ __forceinline__ int v_rd_base(int lane) { return ((lane & 3) << 3) | (((lane >> 2) & 3) << 6) | (((lane >> 4) & 1) << 5) | (((lane >> 5) & 1) << 8); }
constexpr int v_rd_off(int d0, int ks, int half) { return d0 * 512 + ks * 2048 + half * 1024; }
template <int OFF> __device__ __forceinline__ s16x4 tr_read(int vb) {
  s16x4 r; asm volatile("ds_read_b64_tr_b16 %0, %1 offset:%2" : "=&v"(r) : "v"(vb), "i"(OFF) : "memory"); return r;
}
#define PK(L, H) (bf16x8){L[0], L[1], L[2], L[3], H[0], H[1], H[2], H[3]}
#define PV_RD(KS, LA, HA, LB, HB) do { LA = tr_read<v_rd_off(0, KS, 0)>(vb); HA = tr_read<v_rd_off(0, KS, 1)>(vb); LB = tr_read<v_rd_off(1, KS, 0)>(vb); HB = tr_read<v_rd_off(1, KS, 1)>(vb); } while (0)
#define PV_MM(PA, LA, HA, LB, HB) do { o[0] = __builtin_amdgcn_mfma_f32_32x32x16_bf16(PA, PK(LA, HA), o[0], 0, 0, 0); o[1] = __builtin_amdgcn_mfma_f32_32x32x16_bf16(PA, PK(LB, HB), o[1], 0, 0, 0); } while (0)
__device__ __forceinline__ void pv_d0(f32x16* o, int vb, bf16x8 pa0, bf16x8 pa1, bf16x8 pa2, bf16x8 pa3) {
  s16x4 la, ha, lb, hb, lc, hc, ld, hd;
  PV_RD(0, la, ha, lb, hb);
  PV_RD(1, lc, hc, ld, hd);
  asm volatile("s_waitcnt lgkmcnt(4)" ::: "memory"); SBAR();
  PV_MM(pa0, la, ha, lb, hb); SBAR();
  PV_RD(2, la, ha, lb, hb);
  asm volatile("s_waitcnt lgkmcnt(4)" ::: "memory"); SBAR();
  PV_MM(pa1, lc, hc, ld, hd); SBAR();
  PV_RD(3, lc, hc, ld, hd);
  asm volatile("s_waitcnt lgkmcnt(4)" ::: "memory"); SBAR();
  PV_MM(pa2, la, ha, lb, hb); SBAR();
  asm volatile("s_waitcnt lgkmcnt(0)" ::: "memory"); SBAR();
  PV_MM(pa3, lc, hc, ld, hd);
}
#undef PV_MM
#undef PV_RD
#undef PK
__device__ __forceinline__ float bf2f_(short b) { return __builtin_bit_cast(float, (unsigned)(unsigned short)b << 16); }

template <int ABL> __device__ __forceinline__ void mla_unit(const unsigned short* __restrict__ Qg, const unsigned short* __restrict__ Kn, const unsigned short* __restrict__ Kpe, const unsigned short* __restrict__ Vg,
                                         const float* __restrict__ cs, unsigned short* __restrict__ Og, int q0, int krow0, int h, int seq, char* lds) {
  const int tid = threadIdx.x, wid = __builtin_amdgcn_readfirstlane(tid >> 6), lane = tid & 63, r32 = lane & 31, hi = lane >> 5;
  char* V_lds = lds; char* K_lds = lds + 4 * SHM_V;
  float* ws = (float*)(lds + 4 * SHM_V + 4 * SHM_K) + wid * 64; float* li_l = ws; float* al_l = ws + 32;
  float m_reg = 0.f, l_reg = 0; f32x16 o[2] = {}; bf16x8 qr[6];
  {
    const int qrow = q0 + wid * QBLK + r32;
    const unsigned short* Qw = Qg + (size_t)qrow * 768 + h * 96 + hi * 8;
#pragma unroll
    for (int d0 = 0; d0 < 6; ++d0) qr[d0] = *reinterpret_cast<const bf16x8*>(Qw + d0 * 16);
    const float* cr = cs + (size_t)qrow * 32 + hi * 8;
    bf16x8 a = qr[4], b = qr[5]; u32x4 wa, wb; float n1[8], n2[8];
#pragma unroll
    for (int e = 0; e < 8; ++e) { const float c_ = cr[e], s_ = cr[16 + e]; const float x1 = bf2f_(a[e]), x2 = bf2f_(b[e]); n1[e] = x1 * c_ - x2 * s_; n2[e] = x1 * s_ + x2 * c_; }
    wa = (u32x4){cvtpk(n1[0], n1[1]), cvtpk(n1[2], n1[3]), cvtpk(n1[4], n1[5]), cvtpk(n1[6], n1[7])};
    wb = (u32x4){cvtpk(n2[0], n2[1]), cvtpk(n2[2], n2[3]), cvtpk(n2[4], n2[5]), cvtpk(n2[6], n2[7])};
    qr[4] = *reinterpret_cast<bf16x8*>(&wa); qr[5] = *reinterpret_cast<bf16x8*>(&wb);
  }
  const int sk = tid >> 3, sc = (tid & 7) * 8, rk = (tid & 255) >> 2, rc = (tid & 3) * 8;
  const int vst = v_st(sk, sc), kst = KSWZ(sk, sc * 2), rst = KSWZ(rk, (64 + rc) * 2);
  const int vb0 = (int)(uintptr_t)V_lds + v_rd_base(lane);
  const unsigned short* Vh = Vg + (size_t)krow0 * 512 + h * 64; const unsigned short* Kh = Kn + (size_t)krow0 * 512 + h * 64; const unsigned short* Rh = Kpe + (size_t)krow0 * 32;
  struct { bf16x8 vs, ks, rs; } sr_[2];
#define SLOAD(i, k0) do { sr_[i].vs = *reinterpret_cast<const bf16x8*>(&Vh[(size_t)((k0) + sk) * 512 + sc]); sr_[i].ks = *reinterpret_cast<const bf16x8*>(&Kh[(size_t)((k0) + sk) * 512 + sc]); \
    sr_[i].rs = *reinterpret_cast<const bf16x8*>(&Rh[(size_t)((k0) + rk) * 32 + rc]); } while (0)
#define SWRITE(b, i) do { *(bf16x8*)(V_lds + (b) * SHM_V + vst) = sr_[i].vs; *(bf16x8*)(K_lds + (b) * SHM_K + kst) = sr_[i].ks; *(bf16x8*)(K_lds + (b) * SHM_K + rst) = sr_[i].rs; } while (0)
#define RESC(a) do { if (__any((a) < 1.f)) { if (hi == 0) al_l[r32] = (a); asm volatile("s_waitcnt lgkmcnt(0)" ::: "memory"); \
    _Pragma("unroll") for (int d = 0; d < 2; ++d) _Pragma("unroll") for (int r = 0; r < 16; ++r) o[d][r] *= al_l[crow(r, hi)]; } } while (0)
#define EBAR() do { asm volatile("s_waitcnt lgkmcnt(0)" ::: "memory"); __builtin_amdgcn_s_barrier(); asm volatile("" ::: "memory"); } while (0)
  f32x16 p0, p1; float al; bf16x8 pa0, pa1, pa2, pa3; const int NT = seq / KVBLK;
  pa0 = pa1 = pa2 = pa3 = bf16x8{};
  SLOAD(0, 0); SLOAD(1, KVBLK); asm volatile("s_waitcnt vmcnt(0)" ::: "memory"); SWRITE(0, 0); SWRITE(1, 1);
  if (2 < NT) SLOAD(0, 2 * KVBLK);
  EBAR();
  if (wid >= 4) EBAR();
  for (int t = 0; t < NT; ++t) {
    SBAR(); __builtin_amdgcn_s_setprio(3); qkt(p0, p1, K_lds + (t & 3) * SHM_K, qr, r32, hi); SBAR();
    if (t > 0) pv_d0(o, vb0 + ((t - 1) & 3) * SHM_V, pa0, pa1, pa2, pa3);
    __builtin_amdgcn_s_setprio(0); EBAR();
    partialSM<ABL>(p0, p1, m_reg, al, t == 0);
    RESC(al);
    finishSM<ABL>(p0, p1, al, l_reg, pa0, pa1, pa2, pa3);
    if (t + 2 < NT) { asm volatile("s_waitcnt vmcnt(0)" ::: "memory"); SWRITE((t + 2) & 3, 0); }
    if (t + 3 < NT) SLOAD(0, (t + 3) * KVBLK);
    EBAR();
  }
  SBAR(); pv_d0(o, vb0 + ((NT - 1) & 3) * SHM_V, pa0, pa1, pa2, pa3);
  if (wid < 4) EBAR();
#undef EBAR
  if (hi == 0) li_l[r32] = l_reg; asm volatile("s_waitcnt lgkmcnt(0)" ::: "memory");
  float rli[16];
#pragma unroll
  for (int r = 0; r < 16; ++r) rli[r] = __builtin_amdgcn_rcpf(li_l[crow(r, hi)]);
  unsigned short* Ow = Og + (size_t)(q0 + wid * QBLK) * 512 + h * 64;
#pragma unroll
  for (int r = 0; r < 16; ++r) { int orow = crow(r, hi);
#pragma unroll
    for (int d0 = 0; d0 < 2; ++d0) Ow[(size_t)orow * 512 + d0 * 32 + r32] = (unsigned short)cvtpk(o[d0][r] * rli[r], 0.f); }
  __syncthreads();
#undef SLOAD
#undef SWRITE
#undef RESC
}
#undef KSWZ
#undef SBAR
}

namespace dil {
using bf16x8 = __attribute__((ext_vector_type(8))) short;
using s16x4  = __attribute__((ext_vector_type(4))) short;
using f32x16 = __attribute__((ext_vector_type(16))) float;
using u32x4  = __attribute__((ext_vector_type(4))) unsigned;
constexpr int TBL_PITCH = 2112;
constexpr int W_TBL = 0, W_K = 8448, W_V = 8448 + 4096, W_POS = 8448 + 8192, W_AL = W_POS + 128, W_BYTES = W_AL + 128;
__device__ __forceinline__ int crow(int r, int hi) { return (r & 3) + 8 * (r >> 2) + 4 * hi; }
__device__ __forceinline__ unsigned cvtpk(float lo, float hi) { unsigned r; asm volatile("v_cvt_pk_bf16_f32 %0, %1, %2" : "=v"(r) : "v"(lo), "v"(hi)); return r; }
#define DKSWZ(row, colB) ((row) * 128 + ((colB) ^ (((row) & 7) << 4)))
__device__ __forceinline__ int v_st(int k, int c) { const int kk = k;
  return ((kk >> 3) * 2 + (c >> 5)) * 512 + ((kk & 7) * 32 + (c & 31)) * 2; }
__device__ __forceinline__ int v_rd_base(int lane) { return ((lane & 3) << 3) | (((lane >> 2) & 3) << 6) | (((lane >> 4) & 1) << 5) | (((lane >> 5) & 1) << 8); }
constexpr int v_rd_off(int d0, int ks, int half) { return d0 * 512 + ks * 2048 + half * 1024; }
template <int OFF> __device__ __forceinline__ s16x4 tr_read(int vb) {
  s16x4 r; asm volatile("ds_read_b64_tr_b16 %0, %1 offset:%2" : "=&v"(r) : "v"(vb), "i"(OFF) : "memory"); return r;
}
template <int D0> __device__ __forceinline__ void pv_one(f32x16& od, int vb, bf16x8 pa0, bf16x8 pa1) {
  const s16x4 l0 = tr_read<v_rd_off(D0, 0, 0)>(vb), h0 = tr_read<v_rd_off(D0, 0, 1)>(vb), l1 = tr_read<v_rd_off(D0, 1, 0)>(vb), h1 = tr_read<v_rd_off(D0, 1, 1)>(vb);
  asm volatile("s_waitcnt lgkmcnt(0)" ::: "memory"); __builtin_amdgcn_sched_barrier(0);
#define PK(L, H) (bf16x8){L[0], L[1], L[2], L[3], H[0], H[1], H[2], H[3]}
  od = __builtin_amdgcn_mfma_f32_32x32x16_bf16(pa0, PK(l0, h0), od, 0, 0, 0);
  od = __builtin_amdgcn_mfma_f32_32x32x16_bf16(pa1, PK(l1, h1), od, 0, 0, 0);
#undef PK
}
struct KVRegs { bf16x8 k[4], v[4]; int pk; };
struct TaskId { int b, h, g, r, ub; };
__device__ __forceinline__ TaskId task_at(int i, int bx, int G, int wave) {
  TaskId t; int bh, k; t.b = 0; t.h = 0; t.g = 0; t.r = 0; t.ub = -1;
  if (G == 256) { if (i >= 6) return t; bh = (bx & 7) + 8 * (bx >> 6); k = ((((bx >> 3) & 7) * 6 + i) << 3) + wave; }
  else { const int id = (i * G + bx) * 8 + wave; if (id >= 12288) return t; bh = id / 384; k = id % 384; }
  const int g = k >> 7, kk = k & 127, nub = g == 0 ? 128 : (g == 1 ? 32 : 8);
  t.b = bh >> 3; t.h = bh & 7; t.g = g; t.r = kk / nub; t.ub = kk % nub; return t;
}
struct Pre { bf16x8 qr[4]; int pos_q; KVRegs R; };
__device__ __forceinline__ void load_blk(const unsigned short* __restrict__ qkv, const int* __restrict__ pos, const TaskId& t, int kb, KVRegs& R) {
  const int lane = threadIdx.x & 63, r32 = lane & 31, srow = lane >> 1, shalf = (lane & 1) * 32;
  const int dl = t.g == 0 ? 1 : (t.g == 1 ? 4 : 16), L = S / dl; const size_t rowb = (size_t)t.b * S;
  int up = 32 * (t.ub - 2 + kb) + srow; up = up < 0 ? 0 : (up >= L ? L - 1 : up);
  const unsigned short* base = qkv + (rowb + t.r + dl * up) * 1536 + t.h * 64 + shalf;
#pragma unroll
  for (int c = 0; c < 4; ++c) { R.k[c] = *reinterpret_cast<const bf16x8*>(base + 512 + c * 8); R.v[c] = *reinterpret_cast<const bf16x8*>(base + 1024 + c * 8); }
  int upl = 32 * (t.ub - 2 + kb) + r32; upl = upl < 0 ? 0 : (upl >= L ? L - 1 : upl);
  R.pk = pos[rowb + t.r + dl * upl];
}
__device__ __forceinline__ int kb_first(const TaskId& t) { return (t.ub >= 2) ? 0 : (2 - t.ub); }
__device__ __forceinline__ void dil_prefetch(const unsigned short* __restrict__ qkv, const int* __restrict__ pos, const TaskId& t, Pre& P) {
  const int lane = threadIdx.x & 63, r32 = lane & 31, hi = lane >> 5;
  const int dl = t.g == 0 ? 1 : (t.g == 1 ? 4 : 16); const size_t rowb = (size_t)t.b * S; const int tok_q = t.r + dl * (32 * t.ub + r32);
  const unsigned short* Qw = qkv + (rowb + tok_q) * 1536 + t.h * 64 + hi * 8;
#pragma unroll
  for (int d0 = 0; d0 < 4; ++d0) P.qr[d0] = *reinterpret_cast<const bf16x8*>(Qw + d0 * 16);
  P.pos_q = pos[rowb + tok_q];
  load_blk(qkv, pos, t, kb_first(t), P.R);
}
__device__ __forceinline__ void dil_task(const unsigned short* __restrict__ qkv, const int* __restrict__ pos, unsigned short* __restrict__ oap, float* __restrict__ lse,
                                         const TaskId t, Pre& P, bool has_next, const TaskId tn, char* wl  ) {
  const int lane = threadIdx.x & 63, r32 = lane & 31, hi = lane >> 5;
  const int b = t.b, h = t.h, g = t.g, r = t.r, ub = t.ub;
  const int dl = g == 0 ? 1 : (g == 1 ? 4 : 16), L = S / dl;
  const int u_q = 32 * ub + r32;
  const size_t rowb = (size_t)b * S;
  const int tok_q = r + dl * u_q;
  const float* tblw = (const float*)(wl + W_TBL); int* posw = (int*)(wl + W_POS); float* alw = (float*)(wl + W_AL);
  bf16x8 qr[4];
#pragma unroll
  for (int d0 = 0; d0 < 4; ++d0) qr[d0] = P.qr[d0];
  const int pos_q = P.pos_q;
  const int srow = lane >> 1, shalf = (lane & 1) * 32;
  const int vb0 = (int)(uintptr_t)(wl + W_V) + v_rd_base(lane);
  float m_reg = -1e30f, l_reg = 0.f; f32x16 o[2] = {};
  const int kb_lo = kb_first(t), kb_hi = (32 * (ub + 3) <= L) ? 4 : (4 - ((32 * (ub + 3) - L) >> 5));
  KVRegs R = P.R;
  for (int kb = kb_lo; kb <= kb_hi; ++kb) {
#pragma unroll
    for (int c = 0; c < 4; ++c) {
      *(bf16x8*)(wl + W_K + DKSWZ(srow, (shalf + c * 8) * 2)) = R.k[c];
      *(bf16x8*)(wl + W_V + v_st(srow, shalf + c * 8)) = R.v[c];
    }
    if (hi == 0) posw[r32] = R.pk;
    if (kb < kb_hi) load_blk(qkv, pos, t, kb + 1, R);
    asm volatile("s_waitcnt lgkmcnt(0)" ::: "memory"); __builtin_amdgcn_sched_barrier(0);
    f32x16 p = {};
#pragma unroll
    for (int d0 = 0; d0 < 4; ++d0) {
      const bf16x8 kf = *reinterpret_cast<const bf16x8*>(wl + W_K + DKSWZ(r32, (d0 * 16 + hi * 8) * 2));
      p = __builtin_amdgcn_mfma_f32_32x32x16_bf16(kf, qr[d0], p, 0, 0, 0);
    }
    float bmax;
    {
      int idx[16];
#pragma unroll
      for (int rr = 0; rr < 16; ++rr) { int rel = posw[crow(rr, hi)] - pos_q; rel = rel < -1024 ? -1024 : (rel > 1024 ? 1024 : rel); const int i_ = rel + 1024; idx[rr] = i_ ^ ((i_ >> 5) & 31); }
#pragma unroll
      for (int rr = 0; rr < 16; ++rr) p[rr] += tblw[idx[rr]];
    }
    if (kb == 0) {
#pragma unroll
      for (int rr = 0; rr < 16; ++rr) p[rr] = crow(rr, hi) >= r32 ? p[rr] : -INFINITY;
    } else if (kb == 4) {
#pragma unroll
      for (int rr = 0; rr < 16; ++rr) p[rr] = crow(rr, hi) <= r32 ? p[rr] : -INFINITY;
    }
    bmax = fmaxf(fmaxf(p[0], p[1]), fmaxf(p[2], p[3]));
#pragma unroll
    for (int rr = 4; rr < 16; rr += 4) bmax = fmaxf(bmax, fmaxf(fmaxf(p[rr], p[rr + 1]), fmaxf(p[rr + 2], p[rr + 3])));
    { auto x = __builtin_amdgcn_permlane32_swap(__float_as_uint(bmax), __float_as_uint(bmax), false, false); bmax = fmaxf(__uint_as_float(x[0]), __uint_as_float(x[1])); }
    float alpha = 1.f; bool resc = false;
    if (!__all(bmax - m_reg <= 11.5f)) { const float mn = fmaxf(m_reg, bmax); alpha = __builtin_amdgcn_exp2f(m_reg - mn); m_reg = mn; resc = true; }
    float ps = 0.f;
#pragma unroll
    for (int rr = 0; rr < 16; ++rr) p[rr] = __builtin_amdgcn_exp2f(p[rr] - m_reg);
    ps = ((p[0] + p[1]) + (p[2] + p[3])) + ((p[4] + p[5]) + (p[6] + p[7])) + (((p[8] + p[9]) + (p[10] + p[11])) + ((p[12] + p[13]) + (p[14] + p[15])));
    { auto x = __builtin_amdgcn_permlane32_swap(__float_as_uint(ps), __float_as_uint(ps), false, false); ps = __uint_as_float(x[0]) + __uint_as_float(x[1]); }
    l_reg = l_reg * alpha + ps;
    if (resc && kb != kb_lo) {
      if (hi == 0) alw[r32] = alpha;
      asm volatile("s_waitcnt lgkmcnt(0)" ::: "memory");
#pragma unroll
      for (int d = 0; d < 2; ++d)
#pragma unroll
        for (int rr = 0; rr < 16; ++rr) o[d][rr] *= alw[crow(rr, hi)];
    }
    bf16x8 pa0, pa1;
#define PK4(P, BASE, OUT) do { u32x4 w = {cvtpk(P[BASE + 0], P[BASE + 1]), cvtpk(P[BASE + 2], P[BASE + 3]), cvtpk(P[BASE + 4], P[BASE + 5]), cvtpk(P[BASE + 6], P[BASE + 7])}; \
    OUT = *reinterpret_cast<bf16x8*>(&w); } while (0)
    PK4(p, 0, pa0); PK4(p, 8, pa1);
#undef PK4
    pv_one<0>(o[0], vb0, pa0, pa1); pv_one<1>(o[1], vb0, pa0, pa1);
  }
  if (has_next) dil_prefetch(qkv, pos, tn, P);
  float* liw = alw;
  if (hi == 0) liw[r32] = l_reg;
  asm volatile("s_waitcnt lgkmcnt(0)" ::: "memory");
  if (hi == 0) lse[((size_t)g * T + rowb + tok_q) * 8 + h] = (m_reg + __log2f(l_reg)) * 0.6931471805599453f;
  unsigned short* Ow = oap + ((size_t)g * T + rowb + r + (size_t)dl * 32 * ub) * 512 + h * 64;
  char* ot = wl + W_K;
#pragma unroll
  for (int rr = 0; rr < 16; ++rr) { const int orow = crow(rr, hi); const float rl = __builtin_amdgcn_rcpf(liw[orow]);
#pragma unroll
    for (int d0 = 0; d0 < 2; ++d0) *(unsigned short*)(ot + orow * 144 + (d0 * 32 + r32) * 2) = (unsigned short)cvtpk(o[d0][rr] * rl, 0.f); }
  asm volatile("s_waitcnt lgkmcnt(0)" ::: "memory");
#pragma unroll
  for (int ps = 0; ps < 4; ++ps) { const int orow = ps * 8 + (lane >> 3), c = lane & 7;
    const u32x4 w = *(const u32x4*)(ot + orow * 144 + c * 16);
    *(u32x4*)(Ow + (size_t)orow * dl * 512 + c * 8) = w; }
  asm volatile("s_waitcnt lgkmcnt(0)" ::: "memory");
}
#undef DKSWZ
}

namespace mk {
#define GAS __attribute__((address_space(1)))
#define LAS __attribute__((address_space(3)))
typedef unsigned short bf16_t;
typedef unsigned v4u __attribute__((ext_vector_type(4)));
typedef unsigned v2u __attribute__((ext_vector_type(2)));
typedef float f32x4 __attribute__((ext_vector_type(4)));
#define LDS_WAIT() asm volatile("s_waitcnt lgkmcnt(0)" ::: "memory")
#define VM_WAIT() asm volatile("s_waitcnt vmcnt(0)" ::: "memory")
__device__ __forceinline__ unsigned f2bf(float f) { unsigned u = __builtin_bit_cast(unsigned, f); return (u + 0x7fffu + ((u >> 16) & 1u)) >> 16; }
__device__ __forceinline__ unsigned pk2(float lo, float hi) { return f2bf(lo) | (f2bf(hi) << 16); }
__device__ __forceinline__ float bf2f(unsigned short b) { return __builtin_bit_cast(float, (unsigned)b << 16); }
__device__ __forceinline__ float wave_sum(float v) {
#pragma unroll
    for (int o = 1; o < 64; o <<= 1) v += __shfl_xor(v, o);
    return v;
}

#define XB_TMO      128
#define XB_XCNT(j)  (256  + 64 * (j))
#define XB_XSUB(j)  (1280 + 64 * (j))
#define XB_XGEN(j)  (2304 + 64 * (j))
#define XB_TOP      3328
#define XB_TOPGEN   3392
#define XCD_BAR_WORDS 3456
#define XB_SPIN_CAP (1u << 18)

__device__ __forceinline__ unsigned xb_ld(unsigned* p)              { return __hip_atomic_load(p, __ATOMIC_RELAXED, __HIP_MEMORY_SCOPE_AGENT); }
__device__ __forceinline__ unsigned xb_add(unsigned* p, unsigned v) { return __hip_atomic_fetch_add(p, v, __ATOMIC_RELAXED, __HIP_MEMORY_SCOPE_AGENT); }
__device__ __forceinline__ unsigned xb_xcc_id() { return (unsigned)__builtin_amdgcn_s_getreg((3 << 11) | 20) & 0xFu; }
#define XB_SPIN(cond, bar) do { unsigned _sp = 0; while (cond) { __builtin_amdgcn_s_sleep(1); \
    if ((++_sp & 255u) == 0u) { if (xb_ld(&(bar)[XB_TMO])) break; if (_sp > XB_SPIN_CAP) { atomicAdd(&(bar)[XB_TMO], 1u); break; } } } } while (0)

struct XcdBarrier {
    unsigned* bar; unsigned x;
    volatile LAS unsigned* st;
};

__device__ __forceinline__ XcdBarrier xcd_barrier_post(unsigned* bar, volatile LAS unsigned* st) {
    XcdBarrier b; b.bar = bar; b.x = xb_xcc_id(); b.st = st;
    if (threadIdx.x == 0) (void)xb_add(&bar[XB_XCNT(b.x)], 1u);
    return b;
}
__device__ __forceinline__ void xcd_barrier_complete(unsigned* bar, unsigned x, unsigned& nloc, unsigned& nx) {
    const unsigned G = gridDim.x * gridDim.y * gridDim.z;
    unsigned sum, cnt, mine, sp = 0u;
    for (;;) {
        sum = 0u; cnt = 0u; mine = 0u;
#pragma unroll
        for (unsigned j = 0; j < 16; ++j) { const unsigned c = xb_ld(&bar[XB_XCNT(j)]); sum += c; cnt += (c > 0u) ? 1u : 0u; mine = (j == x) ? c : mine; }
        if (sum == G) break;
        __builtin_amdgcn_s_sleep(1);
        if ((++sp & 255u) == 0u) { if (xb_ld(&bar[XB_TMO])) break; if (sp > XB_SPIN_CAP) { atomicAdd(&bar[XB_TMO], 1u); break; } }
    }
    nloc = mine > 0u ? mine : 1u; nx = cnt > 0u ? cnt : 1u;
}

__device__ __forceinline__ void xcd_barrier(const XcdBarrier& b) {
    asm volatile("s_waitcnt vmcnt(0)" ::: "memory");
    __syncthreads();
    if (threadIdx.x == 0) {
        unsigned* bar = b.bar;
        __builtin_amdgcn_s_waitcnt(0);
        unsigned nloc = b.st[0], nx = b.st[1];
        if (nloc == 0u) { xcd_barrier_complete(bar, b.x, nloc, nx); b.st[0] = nloc; b.st[1] = nx; }
        const unsigned old = xb_add(&bar[XB_XSUB(b.x)], 1u);
        const unsigned gen = old / nloc;
        if (old + 1u == (gen + 1u) * nloc) {
            __builtin_amdgcn_fence(__ATOMIC_RELEASE, "agent");
            asm volatile("s_waitcnt vmcnt(0)" ::: "memory");
            const unsigned og = xb_add(&bar[XB_TOP], 1u);
            const unsigned tg = og / nx;
            if (og + 1u == (tg + 1u) * nx) xb_add(&bar[XB_TOPGEN], 1u);
            else XB_SPIN(xb_ld(&bar[XB_TOPGEN]) == tg, bar);
            __builtin_amdgcn_fence(__ATOMIC_ACQUIRE, "agent");
            xb_add(&bar[XB_XGEN(b.x)], 1u);
            asm volatile("s_waitcnt vmcnt(0)" ::: "memory");
        } else {
            XB_SPIN(xb_ld(&bar[XB_XGEN(b.x)]) == gen, bar);
            __builtin_amdgcn_fence(__ATOMIC_ACQUIRE, "agent");
            asm volatile("s_waitcnt vmcnt(0)" ::: "memory");
        }
    }
    __syncthreads();
}

constexpr int NWAVES = 8;
constexpr int LDS_BYTES = 147456;
constexpr int RING_BYTES = 131072;
constexpr int CTRL_OFF = 135168;
constexpr int MISC_OFF = CTRL_OFF + 320;
constexpr size_t MiB = 1u << 20;
constexpr size_t WS_CTL = 0, CTL_ZERO_BYTES = 1 * MiB;
constexpr int CW_BAR = 16384;
constexpr size_t WS_WIN = 1 * MiB, WS_WQB = 5 * MiB, WS_WKVB = 5 * MiB + 512 * 1024, WS_WO = 6 * MiB, WS_WMQG = 8 * MiB, WS_WMKV = 10 * MiB, WS_WMO = 14 * MiB;
constexpr size_t WS_RSTDX = 16 * MiB, WS_RSTDM = 16 * MiB + 64 * 1024, WS_SSQQ = 16 * MiB + 256 * 1024, WS_SSQKV = 16 * MiB + 512 * 1024, WS_TBL = 16 * MiB + 768 * 1024;
constexpr size_t WS_WRG = 16 * MiB + 896 * 1024;
constexpr size_t WS_SSQH1 = 17 * MiB, WS_SSQH2 = 18 * MiB, WS_ZKPE = 20 * MiB, WS_CS = 22 * MiB;
constexpr size_t WS_XB = 24 * MiB, WS_MEMB = 56 * MiB, WS_KVMEM = 58 * MiB, WS_KPE = 62 * MiB;
constexpr size_t WS_QKVA = 64 * MiB, WS_ZQ = 112 * MiB, WS_ZKV = 120 * MiB, WS_QB = 124 * MiB, WS_KN = 148 * MiB, WS_VB = 164 * MiB;
constexpr size_t WS_WPT = 180 * MiB, WS_VWT = 188 * MiB, WS_H2 = 196 * MiB, WS_H2B = 260 * MiB, WS_ROUTE = 292 * MiB, WS_XS = 296 * MiB;
constexpr size_t WS_HMID = 296 * MiB, WS_OAP = 440 * MiB, WS_LSE = 488 * MiB, WS_OB = 490 * MiB, WS_OMIX = 506 * MiB;
constexpr size_t WS_H1 = 538 * MiB, WS_H1B = 602 * MiB, WS_P = 634 * MiB, WS_YBUF = 666 * MiB;
constexpr size_t WS_WGU = 794 * MiB, WS_WD = 922 * MiB, WS_END = 986 * MiB;

struct Args { const float* in[26]; float* out; unsigned char* ws; double rope_rev[16]; int ph_lo, ph_hi, flags, pad; };

struct CvtDesc { const float* W; const float* gain; bf16_t* WT; int K, N, mode, item; };
__device__ __forceinline__ void cvt_load(const CvtDesc& d, f32x4 (&v)[16], int lane) {
    const int nblk = (d.N + 63) >> 6, kb = d.item / nblk, nb = d.item % nblk, k0 = 64 * kb, n0 = 64 * nb;
    const int lk = lane >> 4, ln = (lane & 15) * 4;
    const bool ok = n0 + ln < d.N;
    const float* wp = d.W + (size_t)(k0 + lk) * d.N + n0 + ln;
#pragma unroll
    for (int i = 0; i < 16; ++i) v[i] = ok ? __builtin_nontemporal_load((const f32x4*)(wp + (size_t)(4 * i) * d.N)) : (f32x4){0.f, 0.f, 0.f, 0.f};
}
__device__ __forceinline__ void cvt_store(const CvtDesc& d, f32x4 (&v)[16], LAS float* scr, int lane) {
    const int nblk = (d.N + 63) >> 6, kb = d.item / nblk, nb = d.item % nblk, k0 = 64 * kb, n0 = 64 * nb;
    const int lk = lane >> 4, ln = (lane & 15) * 4;
    if (d.gain) {
#pragma unroll
        for (int i = 0; i < 16; ++i) v[i] = v[i] * d.gain[k0 + 4 * i + lk];
    }
#pragma unroll
    for (int i = 0; i < 16; ++i) { LAS float* p = scr + (4 * i + lk) * 65 + ln; p[0] = v[i][0]; p[1] = v[i][1]; p[2] = v[i][2]; p[3] = v[i][3]; }
    LDS_WAIT(); asm volatile("" ::: "memory");
    int drow0 = n0; if (d.mode == 1) { const int half = n0 >> 10, c = n0 & 1023; drow0 = (c >> 7) * 256 + half * 128 + (c & 127); }
    const int c = lane & 7;
#pragma unroll
    for (int j = 0; j < 8; ++j) { const int n = (lane >> 3) + 8 * j; const LAS float* sp = scr + (8 * c) * 65 + n;
        v4u o; o.x = pk2(sp[0 * 65], sp[1 * 65]); o.y = pk2(sp[2 * 65], sp[3 * 65]); o.z = pk2(sp[4 * 65], sp[5 * 65]); o.w = pk2(sp[6 * 65], sp[7 * 65]);
        __builtin_nontemporal_store(o, (v4u*)(d.WT + (size_t)(drow0 + n) * d.K + k0 + 8 * c)); }
    LDS_WAIT(); asm volatile("" ::: "memory");
}
__device__ __forceinline__ void prep_rows4(const float* x0, bf16_t* o0, float* rstd_out, int lane) {
    f32x4 v[4][4]; float s[4];
#pragma unroll
    for (int r = 0; r < 4; ++r)
#pragma unroll
        for (int j = 0; j < 4; ++j) v[r][j] = ((const f32x4*)(x0 + (size_t)r * 1024))[lane + 64 * j];
#pragma unroll
    for (int r = 0; r < 4; ++r) { float a = 0.f;
#pragma unroll
        for (int j = 0; j < 4; ++j) a += (v[r][j].x * v[r][j].x + v[r][j].y * v[r][j].y) + (v[r][j].z * v[r][j].z + v[r][j].w * v[r][j].w);
        s[r] = wave_sum(a); }
    if (lane < 4) rstd_out[lane] = 1.0f / sqrtf((lane == 0 ? s[0] : lane == 1 ? s[1] : lane == 2 ? s[2] : s[3]) * (1.0f / 1024.0f) + 1e-6f);
#pragma unroll
    for (int r = 0; r < 4; ++r) { unsigned long long* o8 = (unsigned long long*)(o0 + (size_t)r * 1024) + lane;
#pragma unroll
        for (int j = 0; j < 4; ++j) o8[64 * j] = (unsigned long long)pk2(v[r][j].x, v[r][j].y) | ((unsigned long long)pk2(v[r][j].z, v[r][j].w) << 32); }
}

__device__ __forceinline__ v4u pack8(const f32x4 a, const f32x4 b) { v4u w; w.x = pk2(a[0], a[1]); w.y = pk2(a[2], a[3]); w.z = pk2(b[0], b[1]); w.w = pk2(b[2], b[3]); return w; }
__device__ __forceinline__ float sq8(const f32x4 a, const f32x4 b) { return (a[0] * a[0] + a[1] * a[1]) + (a[2] * a[2] + a[3] * a[3]) + (b[0] * b[0] + b[1] * b[1]) + (b[2] * b[2] + b[3] * b[3]); }

struct EpiInProj {
    static constexpr bool PERM = true, AFTER_DRAIN = false;
    const float* rstd; bf16_t* qkv; bf16_t* zq; bf16_t* zkv; float* zkpe; float* ssq_q; float* ssq_kv;
    __device__ __forceinline__ void operator()(const pg8::f32x4 (&acc)[2][2][4][2], const pg8::Unit& u, int wr, int wc, int fr, int fq) const {
        const int row0 = u.pm * 256 + wr * 64 + fr;
        const float qs = u.pn < 2 ? 0.125f * 1.4426950408889634f : 1.0f;
#pragma unroll
        for (int ai = 0; ai < 2; ++ai)
#pragma unroll
            for (int m = 0; m < 4; ++m) {
                const int row = row0 + ai * 128 + m * 16;
                const float rs = rstd[row];
                float ss = 0.f;
#pragma unroll
                for (int bj = 0; bj < 2; ++bj) {
                    const f32x4 v0 = acc[ai][bj][m][0] * rs, v1 = acc[ai][bj][m][1] * rs;
                    const int ct = bj * 128 + wc * 32 + 8 * fq;
                    if (u.pn < 6) { *(v4u*)(qkv + (size_t)row * 1536 + u.pn * 256 + ct) = pack8(v0 * qs, v1 * qs); }
                    else if (u.pn == 6) { *(v4u*)(zq + (size_t)row * 256 + ct) = pack8(v0, v1); ss += sq8(v0, v1); }
                    else if (bj == 0) { *(v4u*)(zkv + (size_t)row * 128 + ct) = pack8(v0, v1); ss += sq8(v0, v1); }
                    else if (wc == 0) { *(f32x4*)(zkpe + (size_t)row * 32 + 8 * fq) = v0; *(f32x4*)(zkpe + (size_t)row * 32 + 8 * fq + 4) = v1; }
                }
                if (u.pn >= 6) { ss += __shfl_xor(ss, 16); ss += __shfl_xor(ss, 32); if (fq == 0) (u.pn == 6 ? ssq_q : ssq_kv)[(size_t)row * 4 + wc] = ss; }
            }
    }
};


struct EpiQ {
    static constexpr bool PERM = true, AFTER_DRAIN = false;
    const float* ssq; bf16_t* Q;
    __device__ __forceinline__ void operator()(const pg8::f32x4 (&acc)[2][2][4][2], const pg8::Unit& u, int wr, int wc, int fr, int fq) const {
        const int row0 = u.pm * 256 + wr * 64 + fr;
#pragma unroll
        for (int ai = 0; ai < 2; ++ai)
#pragma unroll
            for (int m = 0; m < 4; ++m) {
                const int row = row0 + ai * 128 + m * 16;
                const f32x4 sp = *(const f32x4*)(ssq + (size_t)row * 4);
                const float rs = (0.10206207261596577f * 1.4426950408889634f) / sqrtf(((sp[0] + sp[1]) + (sp[2] + sp[3])) * (1.0f / 256.0f) + 1e-6f);
#pragma unroll
                for (int bj = 0; bj < 2; ++bj)
                    *(v4u*)(Q + (size_t)row * 768 + u.pn * 256 + bj * 128 + wc * 32 + 8 * fq) = pack8(acc[ai][bj][m][0] * rs, acc[ai][bj][m][1] * rs);
            }
    }
};
struct EpiKV {
    static constexpr bool PERM = true, AFTER_DRAIN = false;
    const float* ssq; bf16_t* Kn; bf16_t* Vb;
    __device__ __forceinline__ void operator()(const pg8::f32x4 (&acc)[2][2][4][2], const pg8::Unit& u, int wr, int wc, int fr, int fq) const {
        const int row0 = u.pm * 256 + wr * 64 + fr;
        bf16_t* dst = (wc < 2 ? Kn : Vb) + (wc & 1) * 32 + 8 * fq;
#pragma unroll
        for (int ai = 0; ai < 2; ++ai)
#pragma unroll
            for (int m = 0; m < 4; ++m) {
                const int row = row0 + ai * 128 + m * 16;
                const f32x4 sp = *(const f32x4*)(ssq + (size_t)row * 4);
                const float rs = 1.0f / sqrtf(((sp[0] + sp[1]) + (sp[2] + sp[3])) * (1.0f / 128.0f) + 1e-6f);
#pragma unroll
                for (int bj = 0; bj < 2; ++bj)
                    *(v4u*)(dst + (size_t)row * 512 + (u.pn * 2 + bj) * 64) = pack8(acc[ai][bj][m][0] * rs, acc[ai][bj][m][1] * rs);
            }
    }
};
struct EpiRowScale {
    static constexpr bool PERM = true, AFTER_DRAIN = false;
    const float* rs; bf16_t* O; int ldc;
    __device__ __forceinline__ void operator()(const pg8::f32x4 (&acc)[2][2][4][2], const pg8::Unit& u, int wr, int wc, int fr, int fq) const {
        const int row0 = u.pm * 256 + wr * 64 + fr;
#pragma unroll
        for (int ai = 0; ai < 2; ++ai)
#pragma unroll
            for (int m = 0; m < 4; ++m) {
                const int row = row0 + ai * 128 + m * 16;
                const float r = rs[row];
#pragma unroll
                for (int bj = 0; bj < 2; ++bj)
                    *(v4u*)(O + (size_t)row * ldc + u.pn * 256 + bj * 128 + wc * 32 + 8 * fq) = pack8(acc[ai][bj][m][0] * r, acc[ai][bj][m][1] * r);
            }
    }
};

template <bool BASE_BF16> struct EpiResid {
    static constexpr bool PERM = true, AFTER_DRAIN = false;
    const void* base; bf16_t* outb; float* ssq;
    __device__ __forceinline__ void operator()(const pg8::f32x4 (&acc)[2][2][4][2], const pg8::Unit& u, int wr, int wc, int fr, int fq) const {
        const int row0 = u.pm * 256 + wr * 64 + fr;
#pragma unroll
        for (int ai = 0; ai < 2; ++ai)
#pragma unroll
            for (int m = 0; m < 4; ++m) {
                const int row = row0 + ai * 128 + m * 16;
                float ss = 0.f;
#pragma unroll
                for (int bj = 0; bj < 2; ++bj) {
                    const size_t o = (size_t)row * 1024 + u.pn * 256 + bj * 128 + wc * 32 + 8 * fq;
                    f32x4 b0, b1;
                    if constexpr (BASE_BF16) { const v4u w = *(const v4u*)((const bf16_t*)base + o);
                        b0 = (f32x4){__builtin_bit_cast(float, w[0] << 16), __builtin_bit_cast(float, w[0] & 0xffff0000u), __builtin_bit_cast(float, w[1] << 16), __builtin_bit_cast(float, w[1] & 0xffff0000u)};
                        b1 = (f32x4){__builtin_bit_cast(float, w[2] << 16), __builtin_bit_cast(float, w[2] & 0xffff0000u), __builtin_bit_cast(float, w[3] << 16), __builtin_bit_cast(float, w[3] & 0xffff0000u)}; }
                    else { b0 = *(const f32x4*)((const float*)base + o); b1 = *(const f32x4*)((const float*)base + o + 4); }
                    const f32x4 v0 = acc[ai][bj][m][0] + b0, v1 = acc[ai][bj][m][1] + b1;
                    *(v4u*)(outb + o) = pack8(v0, v1); ss += sq8(v0, v1);
                }
                ss += __shfl_xor(ss, 16); ss += __shfl_xor(ss, 32);
                if (fq == 0) ssq[(size_t)row * 16 + u.pn * 4 + wc] = ss;
                asm volatile("" ::: "memory");
            }
    }
};
struct EpiPlain {
    static constexpr bool PERM = true, AFTER_DRAIN = false;
    bf16_t* O; int ldc;
    __device__ __forceinline__ void operator()(const pg8::f32x4 (&acc)[2][2][4][2], const pg8::Unit& u, int wr, int wc, int fr, int fq) const {
        const int row0 = u.pm * 256 + wr * 64 + fr;
#pragma unroll
        for (int ai = 0; ai < 2; ++ai)
#pragma unroll
            for (int m = 0; m < 4; ++m)
#pragma unroll
                for (int bj = 0; bj < 2; ++bj)
                    *(v4u*)(O + (size_t)(row0 + ai * 128 + m * 16) * ldc + u.pn * 256 + bj * 128 + wc * 32 + 8 * fq) = pack8(acc[ai][bj][m][0], acc[ai][bj][m][1]);
    }
};
struct EpiSoftmax {
    static constexpr bool PERM = true, AFTER_DRAIN = true;
    bf16_t* P; int rsl_off;
    __device__ __forceinline__ void fused(pg8::f32x4 (&acc)[2][2][4][2], const pg8::Unit& u, int wr, int wc, int fr, int fq, PG8_LAS unsigned char* lds, int wid, int lane) const {
        typedef float f32x2v __attribute__((ext_vector_type(2)));
        const PG8_LAS float* rsl = (const PG8_LAS float*)(lds + rsl_off);
        PG8_LAS f32x2v* X = (PG8_LAS f32x2v*)lds;
        constexpr float L2E = 1.4426950408889634f;
#pragma unroll
        for (int ai = 0; ai < 2; ++ai)
#pragma unroll
            for (int m = 0; m < 4; ++m) {
                const int rt = ai * 128 + wr * 64 + m * 16 + fr;
                const float rs = rsl[rt] * (0.0625f * L2E);
                float mx = -3.0e38f;
#pragma unroll
                for (int bj = 0; bj < 2; ++bj)
#pragma unroll
                    for (int n = 0; n < 2; ++n) { f32x4 v = acc[ai][bj][m][n] * rs; acc[ai][bj][m][n] = v; mx = fmaxf(mx, fmaxf(fmaxf(v[0], v[1]), fmaxf(v[2], v[3]))); }
                mx = fmaxf(mx, __shfl_xor(mx, 16)); mx = fmaxf(mx, __shfl_xor(mx, 32));
                float sm = 0.f;
#pragma unroll
                for (int bj = 0; bj < 2; ++bj)
#pragma unroll
                    for (int n = 0; n < 2; ++n) { const f32x4 v = acc[ai][bj][m][n]; sm += (__builtin_amdgcn_exp2f(v[0] - mx) + __builtin_amdgcn_exp2f(v[1] - mx)) + (__builtin_amdgcn_exp2f(v[2] - mx) + __builtin_amdgcn_exp2f(v[3] - mx)); }
                sm += __shfl_xor(sm, 16); sm += __shfl_xor(sm, 32);
                if (fq == 0) X[rt * 4 + wc] = (f32x2v){mx, sm};
            }
        asm volatile("s_waitcnt lgkmcnt(0)" ::: "memory"); __builtin_amdgcn_s_barrier(); asm volatile("" ::: "memory");
#pragma unroll
        for (int ai = 0; ai < 2; ++ai)
#pragma unroll
            for (int m = 0; m < 4; ++m) {
                const int rt = ai * 128 + wr * 64 + m * 16 + fr;
                const f32x2v x0 = X[rt * 4 + 0], x1 = X[rt * 4 + 1], x2 = X[rt * 4 + 2], x3 = X[rt * 4 + 3];
                const float M = fmaxf(fmaxf(x0.x, x1.x), fmaxf(x2.x, x3.x));
                const float tot = (x0.y * __builtin_amdgcn_exp2f(x0.x - M) + x1.y * __builtin_amdgcn_exp2f(x1.x - M)) + (x2.y * __builtin_amdgcn_exp2f(x2.x - M) + x3.y * __builtin_amdgcn_exp2f(x3.x - M));
                const float inv = 1.0f / tot;
#pragma unroll
                for (int bj = 0; bj < 2; ++bj) {
                    f32x4 a = acc[ai][bj][m][0], b = acc[ai][bj][m][1];
#pragma unroll
                    for (int j = 0; j < 4; ++j) { a[j] = __builtin_amdgcn_exp2f(a[j] - M) * inv; b[j] = __builtin_amdgcn_exp2f(b[j] - M) * inv; }
                    *(v4u*)(P + (size_t)(u.pm * 256 + rt) * 1024 + u.pn * 256 + bj * 128 + wc * 32 + 8 * fq) = pack8(a, b);
                }
            }
    }
};
struct OrderWp {
    int c;
    __device__ __forceinline__ bool next(int i, pg8::Unit& u) const { if (i > 0 || c >= 64) return false; const int bhh = c >> 2, pn = c & 3, b = bhh >> 2, h = bhh & 3;
        u.pm = bhh; u.pn = pn; u.aoff = ((size_t)(b * 256) * 2048 + h * 256) * 2; u.boff = ((size_t)(pn * 256) * 1024 + h * 256) * 2; return true; }
    __device__ __forceinline__ void a_ready(const pg8::Unit&) const {}
    __device__ __forceinline__ void done(const pg8::Unit&) const {}
};
struct OrderVw {
    int c;
    __device__ __forceinline__ bool next(int i, pg8::Unit& u) const { if (i > 0 || c >= 64) return false; const int b = c >> 4, ct = (c >> 2) & 3, h = c & 3;
        u.pm = b * 4 + ct; u.pn = h; u.aoff = ((size_t)(ct * 256) * 1024 + h * 256) * 2; u.boff = ((size_t)(b * 256) * 2048 + 1024 + h * 256) * 2; return true; }
    __device__ __forceinline__ void a_ready(const pg8::Unit&) const {}
    __device__ __forceinline__ void done(const pg8::Unit&) const {}
};
struct OrderBatch {
    pg8::StaticOrder so;
    __device__ __forceinline__ bool next(int i, pg8::Unit& u) const { if (!so.next(i, u)) return false; u.boff = ((size_t)((u.pm >> 4) * 1024 + u.pn * 256) * 1024) * 2; return true; }
    __device__ __forceinline__ void a_ready(const pg8::Unit&) const {}
    __device__ __forceinline__ void done(const pg8::Unit&) const {}
};

constexpr int MPADN = NA + NE * 256, NTILEN = MPADN / 256;
constexpr int CW_GCOUNT = 8192;
constexpr size_t RT_TOPI = 0, RT_TOPG = 256 * 1024, RT_SLOT = 512 * 1024, RT_ROWFLAT = 768 * 1024, RT_RSROW = 1088 * 1024, RT_RSTD = 1408 * 1024, RT_CNT = 1536 * 1024, RT_TOT = 1600 * 1024;
constexpr int LX_TEXP = CTRL_OFF + 2048;
struct OrderMoe {
    const LAS int* texp; int nper, c, G; size_t ebytes;
    __device__ __forceinline__ bool next(int i, pg8::Unit& u) const {
        const int L = i * G + (c & 7) * (G >> 3) + (c >> 3); const int tile = L / nper, pn = L % nper;
        if (tile >= texp[NTILEN]) return false;
        u.pm = tile; u.pn = pn; u.aoff = (size_t)tile * 256 * 1024 * 2; u.boff = (size_t)texp[tile] * ebytes + (size_t)pn * 256 * 1024 * 2; return true; }
    __device__ __forceinline__ void a_ready(const pg8::Unit&) const {}
    __device__ __forceinline__ void done(const pg8::Unit&) const {}
};
__device__ __forceinline__ float swiglu1(float g, float u) { g = fminf(g, 7.0f); u = fminf(fmaxf(u, -7.0f), 7.0f); return (u + 1.0f) * g * __builtin_amdgcn_rcpf(1.0f + __builtin_amdgcn_exp2f(-1.702f * 1.4426950408889634f * g)); }
struct EpiSwiGLU {
    static constexpr bool PERM = true, AFTER_DRAIN = false;
    const float* rs_row; const float* bgu; bf16_t* hmid; const LAS int* texp;
    __device__ __forceinline__ void operator()(const pg8::f32x4 (&acc)[2][2][4][2], const pg8::Unit& u, int wr, int wc, int fr, int fq) const {
        const int row0 = u.pm * 256 + wr * 64 + fr, e = texp[u.pm], c0 = u.pn * 128 + wc * 32 + 8 * fq;
        const float* bg = bgu + (size_t)e * 2048 + c0;
        const f32x4 bg0 = *(const f32x4*)bg, bg1 = *(const f32x4*)(bg + 4), bu0 = *(const f32x4*)(bg + 1024), bu1 = *(const f32x4*)(bg + 1028);
#pragma unroll
        for (int ai = 0; ai < 2; ++ai)
#pragma unroll
            for (int m = 0; m < 4; ++m) {
                const int row = row0 + ai * 128 + m * 16; const float rs = rs_row[row];
                const f32x4 g0 = acc[ai][0][m][0] * rs + bg0, g1 = acc[ai][0][m][1] * rs + bg1, u0 = acc[ai][1][m][0] * rs + bu0, u1 = acc[ai][1][m][1] * rs + bu1;
                f32x4 h0, h1;
#pragma unroll
                for (int j = 0; j < 4; ++j) { h0[j] = swiglu1(g0[j], u0[j]); h1[j] = swiglu1(g1[j], u1[j]); }
                *(v4u*)(hmid + (size_t)row * 1024 + c0) = pack8(h0, h1);
            }
    }
};
struct EpiDown {
    static constexpr bool PERM = true, AFTER_DRAIN = false;
    const int* row_flat; const float* topg; const float* bd; bf16_t* ybuf; const LAS int* texp;
    __device__ __forceinline__ void operator()(const pg8::f32x4 (&acc)[2][2][4][2], const pg8::Unit& u, int wr, int wc, int fr, int fq) const {
        const int row0 = u.pm * 256 + wr * 64 + fr, e = texp[u.pm], c0 = u.pn * 256 + wc * 32 + 8 * fq;
        const float* bp = bd + (size_t)e * 1024 + c0;
        f32x4 bv[2][2];
#pragma unroll
        for (int bj = 0; bj < 2; ++bj) { bv[bj][0] = *(const f32x4*)(bp + bj * 128); bv[bj][1] = *(const f32x4*)(bp + bj * 128 + 4); }
#pragma unroll
        for (int ai = 0; ai < 2; ++ai)
#pragma unroll
            for (int m = 0; m < 4; ++m) {
                const int row = row0 + ai * 128 + m * 16; const int a = row_flat[row];
                if (a >= 0) { const float gt = topg[a];
#pragma unroll
                    for (int bj = 0; bj < 2; ++bj)
                        *(v4u*)(ybuf + (size_t)a * 1024 + c0 + bj * 128) = pack8((acc[ai][bj][m][0] + bv[bj][0]) * gt, (acc[ai][bj][m][1] + bv[bj][1]) * gt); }
            }
    }
};

__device__ __forceinline__ int rel_bucket_d(int rel) {
    int n = rel < 0 ? -rel : rel;
    int b;
    if (n < 8) b = n; else if (n < 15) b = 8; else if (n < 27) b = 9; else if (n < 50) b = 10; else if (n < 91) b = 11;
    else if (n < 166) b = 12; else if (n < 305) b = 13; else if (n < 559) b = 14; else b = 15;
    return b + (rel > 0 ? 16 : 0);
}

static_assert(pg8::GTAB == CTRL_OFF + 4096 && pg8::GTAB + pg8::GTAB_UNITS * 512 <= LDS_BYTES && (NTILEN * 8 + 255) / 256 <= pg8::GTAB_UNITS && NWAVES * dil::W_BYTES <= CTRL_OFF && mla::SHM_ATTN <= CTRL_OFF && RING_BYTES <= CTRL_OFF && LX_TEXP + 4 * (NTILEN + 1) <= LDS_BYTES, "LDS map");
__global__ void __launch_bounds__(NWAVES * 64, 2) mk_fwd(Args args) {
    extern __shared__ __attribute__((aligned(16))) unsigned char lds_raw[];
    LAS unsigned char* lds = (LAS unsigned char*)lds_raw;
    const int tid = threadIdx.x, lane = tid & 63, wave = __builtin_amdgcn_readfirstlane(tid >> 6);
    const int G = gridDim.x; const int bx = blockIdx.x; const int vcu = (G % 8 == 0) ? (bx % 8) * (G / 8) + bx / 8 : bx;
    unsigned char* ws = args.ws;
    const int lo = args.ph_lo, hi = args.ph_hi;
#define IN(k) (lo <= (k) && (k) < hi)
#define BOTH(k) (IN(k) && IN((k) + 1))
    for (int u = tid; u < (LDS_BYTES - CTRL_OFF) / 4; u += NWAVES * 64) ((LAS unsigned*)(lds + CTRL_OFF))[u] = 0u;
    __syncthreads();
    XcdBarrier bar; bar.bar = (unsigned*)(ws + WS_CTL) + CW_BAR; bar.x = 0; bar.st = nullptr;
    if (hi - lo > 1) bar = xcd_barrier_post((unsigned*)(ws + WS_CTL) + CW_BAR, (volatile LAS unsigned*)(lds + MISC_OFF) + 8);
#define GRID_BAR(k) do { if (BOTH(k)) xcd_barrier(bar); } while (0)
    const float* x = args.in[0]; const float* mem = args.in[1]; const float* g_mix = args.in[3]; const float* w_in = args.in[4];
    const float* g_q_a = args.in[5]; const float* w_q_b = args.in[6]; const float* g_kv_a = args.in[7]; const float* w_kv_b = args.in[8];
    const float* w_o = args.in[12]; const float* g_xattn = args.in[13]; const float* g_mem = args.in[14]; const float* w_mq = args.in[15];
    const float* w_mkv = args.in[16]; const float* w_mo = args.in[17]; const float* g_moe = args.in[18];
    const float* w_gate_up = args.in[21]; const float* w_down = args.in[23];
    bf16_t* WinT = (bf16_t*)(ws + WS_WIN); bf16_t* WqbT = (bf16_t*)(ws + WS_WQB); bf16_t* WkvbT = (bf16_t*)(ws + WS_WKVB); bf16_t* WoT = (bf16_t*)(ws + WS_WO);
    bf16_t* Wmqg = (bf16_t*)(ws + WS_WMQG); bf16_t* WmkvT = (bf16_t*)(ws + WS_WMKV); bf16_t* WmoT = (bf16_t*)(ws + WS_WMO);
    bf16_t* WguT = (bf16_t*)(ws + WS_WGU); bf16_t* WdT = (bf16_t*)(ws + WS_WD);
    bf16_t* xb = (bf16_t*)(ws + WS_XB); bf16_t* memb = (bf16_t*)(ws + WS_MEMB);
    float* rstd_x = (float*)(ws + WS_RSTDX); float* rstd_mem = (float*)(ws + WS_RSTDM);

    if (IN(0)) {
        LAS float* scr = (LAS float*)(lds + wave * 16640);
        const int gw = vcu * NWAVES + wave, NGW = G * NWAVES;
        constexpr int I_IN = 16 * 31, I_QB = 4 * 12, I_KVB = 2 * 16, I_O = 16 * 16, I_MKV = 16 * 32, I_MO = 16 * 16, I_GU = 16 * 32, I_D = 16 * 16;
        const int n_exp = (args.flags & 1) ? 32 : 0;
        const int NITEMS = I_IN + I_QB + I_KVB + I_O + I_MKV + I_MO + n_exp * (I_GU + I_D);
        auto desc = [&](int it) {
            CvtDesc d; int r = it; d.mode = 0;
            if (r < I_IN) { d.W = w_in; d.K = 1024; d.N = 1952; d.gain = g_mix; d.WT = WinT; }
            else if ((r -= I_IN) < I_QB) { d.W = w_q_b; d.K = 256; d.N = 768; d.gain = g_q_a; d.WT = WqbT; }
            else if ((r -= I_QB) < I_KVB) { d.W = w_kv_b; d.K = 128; d.N = 1024; d.gain = g_kv_a; d.WT = WkvbT; }
            else if ((r -= I_KVB) < I_O) { d.W = w_o; d.K = 1024; d.N = 1024; d.gain = nullptr; d.WT = WoT; }
            else if ((r -= I_O) < I_MKV) { d.W = w_mkv; d.K = 1024; d.N = 2048; d.gain = g_mem; d.WT = WmkvT; }
            else if ((r -= I_MKV) < I_MO) { d.W = w_mo; d.K = 1024; d.N = 1024; d.gain = nullptr; d.WT = WmoT; }
            else if ((r -= I_MO) < 32 * I_GU) { const int e = r / I_GU; r -= e * I_GU; d.W = w_gate_up + (size_t)e * 1024 * 2048; d.K = 1024; d.N = 2048; d.gain = g_moe; d.WT = WguT + (size_t)e * 2048 * 1024; d.mode = 1; }
            else { r -= 32 * I_GU; const int e = r / I_D; r -= e * I_D; d.W = w_down + (size_t)e * 1024 * 1024; d.K = 1024; d.N = 1024; d.gain = nullptr; d.WT = WdT + (size_t)e * 1024 * 1024; }
            d.item = r; return d; };
        {
            f32x4 va[16], vb[16]; CvtDesc dc = desc(0), dn = dc; bool have = false;
            for (int it = gw; ; it += NGW) {
                const bool more = it < NITEMS;
                if (more) { dn = desc(it); cvt_load(dn, vb, lane); }
                if (have) cvt_store(dc, va, scr, lane);
                if (!more) break;
#pragma unroll
                for (int i = 0; i < 16; ++i) va[i] = vb[i];
                dc = dn; have = true;
            }
        }
        for (int i = gw * 64 + lane; i < 64 * 1024 / 8; i += NGW * 64) ((v4u*)(WinT + (size_t)1984 * 1024))[i] = (v4u){0u, 0u, 0u, 0u};
        for (int m = gw * 4; m < T; m += NGW * 4) prep_rows4(x + (size_t)m * D, xb + (size_t)m * D, rstd_x + m, lane);
        for (int m = gw * 4; m < NB * NMEM; m += NGW * 4) prep_rows4(mem + (size_t)m * D, memb + (size_t)m * D, rstd_mem + m, lane);
        { const float* w_router = args.in[19]; float* wrg = (float*)(ws + WS_WRG); for (int i = bx * 512 + tid; i < 1024 * 32; i += G * 512) wrg[i] = w_router[i] * g_moe[i >> 5]; }
        for (int m = gw; m < D; m += NGW) {
            const f32x4* xr = (const f32x4*)(w_mq + (size_t)m * D) + lane; const float gc = g_xattn[m];
            unsigned long long* o8 = (unsigned long long*)(Wmqg + (size_t)m * D) + lane;
#pragma unroll
            for (int j = 0; j < 4; ++j) { const f32x4 v = xr[64 * j] * gc; o8[64 * j] = (unsigned long long)pk2(v.x, v.y) | ((unsigned long long)pk2(v.z, v.w) << 32); }
        }
    }
    if (IN(0)) {
        const float* rel_bias = args.in[9]; float* tbl = (float*)(ws + WS_TBL);
        for (int i = bx * 512 + tid; i < 8 * 2049; i += G * 512) { const int h = i / 2049, r = i % 2049; tbl[h * 2112 + r] = rel_bias[rel_bucket_d(r - 1024) * 8 + h]; }
    }
    GRID_BAR(0);
    if (IN(1)) {
        int kx = 1024; asm volatile("" : "+s"(kx)); pg8::Gemm g{xb, WinT, kx, kx, kx}; pg8::StaticOrder S; S.init(T, 2048, 1024, 1024, G, bx);
        EpiInProj E{rstd_x, (bf16_t*)(ws + WS_QKVA), (bf16_t*)(ws + WS_ZQ), (bf16_t*)(ws + WS_ZKV), (float*)(ws + WS_ZKPE), (float*)(ws + WS_SSQQ), (float*)(ws + WS_SSQKV)};
        pg8::gemm_phase<EpiInProj, pg8::StaticOrder, true, true>(lds, g, S, E);
    }
    GRID_BAR(1);
    if (IN(2)) {
        const int* pos = (const int*)args.in[2];
        float* cs = (float*)(ws + WS_CS); const float* zkpe = (const float*)(ws + WS_ZKPE); bf16_t* kpe = (bf16_t*)(ws + WS_KPE);
        for (int i = bx * 512 + tid; i < T * 16; i += G * 512) {
            const int t = i >> 4, j = i & 15;
            const double rev = (double)pos[t] * args.rope_rev[j];
            const float fr_ = (float)(rev - floor(rev));
            const float sn = __builtin_amdgcn_sinf(fr_), c_ = __builtin_amdgcn_cosf(fr_);
            cs[(size_t)t * 32 + j] = c_; cs[(size_t)t * 32 + 16 + j] = sn;
            const float x1 = zkpe[(size_t)t * 32 + j], x2 = zkpe[(size_t)t * 32 + 16 + j];
            kpe[(size_t)t * 32 + j] = (bf16_t)f2bf(x1 * c_ - x2 * sn); kpe[(size_t)t * 32 + 16 + j] = (bf16_t)f2bf(x1 * sn + x2 * c_);
        }
        {   int kq = 256; asm volatile("" : "+s"(kq)); pg8::Gemm g{(const bf16_t*)(ws + WS_ZQ), WqbT, kq, kq, kq}; pg8::StaticOrder S; S.init(T, 768, 256, 256, G, bx);
            EpiQ E{(const float*)(ws + WS_SSQQ), (bf16_t*)(ws + WS_QB)};
            pg8::gemm_phase<EpiQ, pg8::StaticOrder, true, true>(lds, g, S, E); }
        {   int kk = 128; asm volatile("" : "+s"(kk)); pg8::Gemm g{(const bf16_t*)(ws + WS_ZKV), WkvbT, kk, kk, kk}; const bool memcu = ((bx + 64) % G) < 32 && G > 64; const int bx2 = bx - (bx >= G - 64 + 32 ? 32 : 0);
            pg8::StaticOrder S; S.init(memcu ? 0 : T, 1024, 128, 128, G > 64 ? G - 32 : G, G > 64 ? bx2 : bx);
            EpiKV E{(const float*)(ws + WS_SSQKV), (bf16_t*)(ws + WS_KN), (bf16_t*)(ws + WS_VB)};
            pg8::gemm_phase<EpiKV, pg8::StaticOrder, true, true>(lds, g, S, E); }
        {   int kx = 1024; asm volatile("" : "+s"(kx)); pg8::Gemm g{memb, WmkvT, kx, kx, kx}; pg8::StaticOrder S; S.init(NB * NMEM, 2048, 1024, 1024, G, (bx + 64) % G);
            EpiRowScale E{rstd_mem, (bf16_t*)(ws + WS_KVMEM), 2048};
            pg8::gemm_phase<EpiRowScale, pg8::StaticOrder, true, true>(lds, g, S, E); }
    }
    GRID_BAR(2);
    if (IN(3)) {
        const unsigned short* Qg = (const unsigned short*)(ws + WS_QB); const unsigned short* Kn = (const unsigned short*)(ws + WS_KN);
        const unsigned short* Kp = (const unsigned short*)(ws + WS_KPE); const unsigned short* Vg = (const unsigned short*)(ws + WS_VB);
        const float* cs = (const float*)(ws + WS_CS); unsigned short* Og = (unsigned short*)(ws + WS_OB);
        for (int i = 0; !(args.flags & 8); ++i) {
            int bh, qb;
            if (G == 256) { if (i >= 2) break; const int idx = i * 32 + (bx >> 3); bh = (bx & 7) + 8 * (idx >> 4); qb = idx & 15; }
            else { const int un = i * G + bx; if (un >= 512) break; bh = un >> 4; qb = un & 15; }
            const int b = bh >> 3, h = bh & 7;
#ifdef MLA_ABL
            if (args.flags & 16) mla::mla_unit<MLA_ABL>(Qg, Kn, Kp, Vg, cs, Og, b * S + qb * 256, b * S, h, S, (char*)lds_raw); else
#endif
            mla::mla_unit<0>(Qg, Kn, Kp, Vg, cs, Og, b * S + qb * 256, b * S, h, S, (char*)lds_raw);
        }
        {
            const unsigned short* qkv = (const unsigned short*)(ws + WS_QKVA); const int* pos = (const int*)args.in[2];
            const float* tbl = (const float*)(ws + WS_TBL); unsigned short* oap = (unsigned short*)(ws + WS_OAP); float* lse = (float*)(ws + WS_LSE);
            char* wl = (char*)lds_raw + wave * dil::W_BYTES;
            __syncthreads();
            int cur_h = -1;
            dil::TaskId tc = dil::task_at(0, bx, G, wave), tn = tc; dil::Pre P;
            bool have = !(args.flags & 4) && tc.ub >= 0;
            if (have) dil::dil_prefetch(qkv, pos, tc, P);
            for (int i = 0; have; ++i) {
                tn = dil::task_at(i + 1, bx, G, wave); const bool has_next = tn.ub >= 0;
                if (tc.h != cur_h) { float* tw = (float*)(wl + dil::W_TBL); for (int j = lane; j < 2049; j += 64) tw[j ^ ((j >> 5) & 31)] = tbl[tc.h * dil::TBL_PITCH + j] * 1.4426950408889634f; cur_h = tc.h; asm volatile("s_waitcnt vmcnt(0) lgkmcnt(0)" ::: "memory"); }
                dil::dil_task(qkv, pos, oap, lse, tc, P, has_next, tn, wl);
                tc = tn; have = has_next;
            }
        }
    }
    GRID_BAR(3);
    if (IN(4)) {
        { int kx = 256; asm volatile("" : "+s"(kx));
          if (bx < 64) { pg8::Gemm g{(const bf16_t*)(ws + WS_KVMEM), Wmqg, 2048, 1024, kx}; OrderWp S{bx}; EpiPlain E{(bf16_t*)(ws + WS_WPT), 1024};
              pg8::gemm_phase<EpiPlain, OrderWp, true, true>(lds, g, S, E); }
          else if (bx < 128) { pg8::Gemm g{WmoT, (const bf16_t*)(ws + WS_KVMEM), 1024, 2048, kx}; OrderVw S{bx - 64}; EpiPlain E{(bf16_t*)(ws + WS_VWT), 1024};
              pg8::gemm_phase<EpiPlain, OrderVw, true, true>(lds, g, S, E); } }
        const bf16_t* oap = (const bf16_t*)(ws + WS_OAP); const float* lse = (const float*)(ws + WS_LSE); const bf16_t* obp = (const bf16_t*)(ws + WS_OB);
        const float* g_out_a = args.in[10]; const float* g_out_b = args.in[11]; bf16_t* omix = (bf16_t*)(ws + WS_OMIX);
        const int gw = vcu * NWAVES + wave, NGW = G * NWAVES;
        const f32x4 ga0 = *(const f32x4*)(g_out_a + 8 * lane), ga1 = *(const f32x4*)(g_out_a + 8 * lane + 4), gb0 = *(const f32x4*)(g_out_b + 8 * lane), gb1 = *(const f32x4*)(g_out_b + 8 * lane + 4);
#define UNPK_LO(V_) ((f32x4){__builtin_bit_cast(float, (V_)[0] << 16), __builtin_bit_cast(float, (V_)[0] & 0xffff0000u), __builtin_bit_cast(float, (V_)[1] << 16), __builtin_bit_cast(float, (V_)[1] & 0xffff0000u)})
#define UNPK_HI(V_) ((f32x4){__builtin_bit_cast(float, (V_)[2] << 16), __builtin_bit_cast(float, (V_)[2] & 0xffff0000u), __builtin_bit_cast(float, (V_)[3] << 16), __builtin_bit_cast(float, (V_)[3] & 0xffff0000u)})
        for (int tok = gw; tok < T; tok += NGW) {
            const int head = lane >> 3;
            const float l0 = lse[((size_t)0 * T + tok) * 8 + head], l1 = lse[((size_t)1 * T + tok) * 8 + head], l2 = lse[((size_t)2 * T + tok) * 8 + head];
            const float mx = fmaxf(l0, fmaxf(l1, l2)); float w0 = __expf(l0 - mx), w1 = __expf(l1 - mx), w2 = __expf(l2 - mx); const float wi = 1.0f / (w0 + w1 + w2); w0 *= wi; w1 *= wi; w2 *= wi;
            const v4u q0 = *(const v4u*)(oap + ((size_t)0 * T + tok) * 512 + 8 * lane), q1 = *(const v4u*)(oap + ((size_t)1 * T + tok) * 512 + 8 * lane);
            const v4u q2 = *(const v4u*)(oap + ((size_t)2 * T + tok) * 512 + 8 * lane), qb = *(const v4u*)(obp + (size_t)tok * 512 + 8 * lane);
            const f32x4 a0 = UNPK_LO(q0) * w0 + UNPK_LO(q1) * w1 + UNPK_LO(q2) * w2, a1 = UNPK_HI(q0) * w0 + UNPK_HI(q1) * w1 + UNPK_HI(q2) * w2, b0 = UNPK_LO(qb), b1 = UNPK_HI(qb);
            const float sa = wave_sum(sq8(a0, a1)), sb = wave_sum(sq8(b0, b1));
            const float ra = 1.0f / sqrtf(sa * (1.0f / 512.0f) + 1e-6f), rb = 1.0f / sqrtf(sb * (1.0f / 512.0f) + 1e-6f);
            *(v4u*)(omix + (size_t)tok * 1024 + 8 * lane) = pack8(a0 * ra * ga0, a1 * ra * ga1);
            *(v4u*)(omix + (size_t)tok * 1024 + 512 + 8 * lane) = pack8(b0 * rb * gb0, b1 * rb * gb1);
        }
#undef UNPK_LO
#undef UNPK_HI
    }
    GRID_BAR(4);
    if (IN(5)) {
        int kx = 1024; asm volatile("" : "+s"(kx));
        pg8::Gemm g{(const bf16_t*)(ws + WS_OMIX), WoT, kx, kx, kx}; pg8::StaticOrder S; S.init(T, 1024, 1024, 1024, G, bx);
        EpiResid<false> E{x, (bf16_t*)(ws + WS_H1B), (float*)(ws + WS_SSQH1)};
        pg8::gemm_phase<EpiResid<false>, pg8::StaticOrder, true, true>(lds, g, S, E);
    }
    GRID_BAR(5);
    if (IN(6)) {
        int kx = 1024; asm volatile("" : "+s"(kx));
        pg8::Gemm g{(const bf16_t*)(ws + WS_H1B), (const bf16_t*)(ws + WS_WPT), kx, kx, kx}; OrderBatch S; S.so.init(T, 1024, 1024, 1024, G, bx);
        pg8::Unit u0; const bool has = S.next(0, u0);
        LAS float* rsl = (LAS float*)(lds + CTRL_OFF + 1024);
        if (has && tid < 256) { const float* sp = (const float*)(ws + WS_SSQH1) + (size_t)(u0.pm * 256 + tid) * 16; float a = 0.f;
#pragma unroll
            for (int j = 0; j < 4; ++j) { const f32x4 v = ((const f32x4*)sp)[j]; a += (v[0] + v[1]) + (v[2] + v[3]); }
            rsl[tid] = 1.0f / sqrtf(a * (1.0f / 1024.0f) + 1e-6f); }
        __syncthreads();
        EpiSoftmax E{(bf16_t*)(ws + WS_P), CTRL_OFF + 1024};
        pg8::gemm_phase<EpiSoftmax, OrderBatch, false, true>(lds, g, S, E);
    }
    GRID_BAR(6);
    if (IN(7)) {
        int kx = 1024; asm volatile("" : "+s"(kx));
        pg8::Gemm g{(const bf16_t*)(ws + WS_P), (const bf16_t*)(ws + WS_VWT), kx, kx, kx}; OrderBatch S; S.so.init(T, 1024, 1024, 1024, G, bx);
        EpiResid<true> E{(const bf16_t*)(ws + WS_H1B), (bf16_t*)(ws + WS_H2B), (float*)(ws + WS_SSQH2)};
        pg8::gemm_phase<EpiResid<true>, OrderBatch, true, true>(lds, g, S, E);
    }
    GRID_BAR(7);
    if (IN(8)) {
        typedef float f32x16 __attribute__((ext_vector_type(16)));
        const bf16_t* h2b = (const bf16_t*)(ws + WS_H2B); const float* b_router = args.in[20]; const float* ssq2 = (const float*)(ws + WS_SSQH2);
        int* topi = (int*)(ws + WS_ROUTE + RT_TOPI); float* topg = (float*)(ws + WS_ROUTE + RT_TOPG); int* tslot = (int*)(ws + WS_ROUTE + RT_SLOT); int* row_flat = (int*)(ws + WS_ROUTE + RT_ROWFLAT);
        for (int i = bx * 512 + tid; i < MPADN; i += G * 512) row_flat[i] = -1;
        LAS float* part = (LAS float*)lds;
        LAS float* lgt = (LAS float*)(lds + 32768);
        for (int ch = bx; ch < T / 64; ch += G) {
            const int tok0 = ch * 64, tb = wave & 1, kq = wave >> 1, kh = lane >> 5, row = tok0 + 32 * tb + (lane & 31);
            f32x16 acc = {};
            const bf16_t* ap = h2b + (size_t)row * 1024 + 256 * kq + 4 * kh; const float* wp = (const float*)(ws + WS_WRG) + (size_t)(256 * kq + 4 * kh) * 32 + (lane & 31);
#pragma unroll 8
            for (int j = 0; j < 32; ++j) {
                const v2u aw = *(const v2u*)(ap + 8 * j);
                const f32x4 a4 = (f32x4){__builtin_bit_cast(float, aw.x << 16), __builtin_bit_cast(float, aw.x & 0xffff0000u), __builtin_bit_cast(float, aw.y << 16), __builtin_bit_cast(float, aw.y & 0xffff0000u)};
#pragma unroll
                for (int e = 0; e < 4; ++e) acc = __builtin_amdgcn_mfma_f32_32x32x2f32(a4[e], wp[(size_t)(8 * j + e) * 32], acc, 0, 0, 0);
            }
#pragma unroll
            for (int r = 0; r < 16; ++r) part[((kq * 64) + tb * 32 + (r & 3) + 8 * (r >> 2) + 4 * kh) * 32 + (lane & 31)] = acc[r];
            __syncthreads();
            {
                const int tk = tid >> 3, e0 = (tid & 7) * 4; const float* sp = ssq2 + (size_t)(tok0 + tk) * 16; float a = 0.f;
#pragma unroll
                for (int j = 0; j < 4; ++j) { const f32x4 v = ((const f32x4*)sp)[j]; a += (v[0] + v[1]) + (v[2] + v[3]); }
                const float rs = 1.0f / sqrtf(a * (1.0f / 1024.0f) + 1e-6f);
                if (e0 == 0) ((float*)(ws + WS_ROUTE + RT_RSTD))[tok0 + tk] = rs;
#pragma unroll
                for (int e = 0; e < 4; ++e) lgt[tk * 33 + e0 + e] = rs * ((part[(0 * 64 + tk) * 32 + e0 + e] + part[(1 * 64 + tk) * 32 + e0 + e]) + (part[(2 * 64 + tk) * 32 + e0 + e] + part[(3 * 64 + tk) * 32 + e0 + e])) + b_router[e0 + e];
            }
            __syncthreads();
            if (tid < 64) {
                int c0 = -1, c1 = -1, c2 = -1, c3 = -1; float v0 = 0.f, v1 = 0.f, v2 = 0.f, v3 = 0.f; int s0 = 0, s1 = 0, s2 = 0, s3 = 0;
                for (int k = 0; k < 4; ++k) {
                    float best = -3.0e38f; int bi = 0;
                    for (int e = 0; e < 32; ++e) { const float v = lgt[tid * 33 + e]; if (e == c0 || e == c1 || e == c2 || e == c3) continue; if (v > best) { best = v; bi = e; } }
                    if (k == 0) { c0 = bi; v0 = best; } else if (k == 1) { c1 = bi; v1 = best; } else if (k == 2) { c2 = bi; v2 = best; } else { c3 = bi; v3 = best; }
                }
                const unsigned long long lt = (1ull << lane) - 1ull; int* cntc = (int*)(ws + WS_ROUTE + RT_CNT) + ch * 32;
                for (int e = 0; e < 32; ++e) {
                    const unsigned long long m0 = __ballot(c0 == e), m1 = __ballot(c1 == e), m2 = __ballot(c2 == e), m3 = __ballot(c3 == e);
                    const int before = __popcll(m0 & lt) + __popcll(m1 & lt) + __popcll(m2 & lt) + __popcll(m3 & lt);
                    if (c0 == e) s0 = before; if (c1 == e) s1 = before; if (c2 == e) s2 = before; if (c3 == e) s3 = before;
                    if (lane == e) cntc[e] = __popcll(m0) + __popcll(m1) + __popcll(m2) + __popcll(m3);
                }
                const int t = tok0 + tid;
                const float e1 = __expf(v1 - v0), e2 = __expf(v2 - v0), e3 = __expf(v3 - v0), inv = 1.0f / (1.0f + e1 + e2 + e3);
                *(int4*)(topi + t * 4) = make_int4(c0, c1, c2, c3);
                *(f32x4*)(topg + t * 4) = (f32x4){inv, e1 * inv, e2 * inv, e3 * inv};
                *(int4*)(tslot + t * 4) = make_int4(s0, s1, s2, s3);
            }
            __syncthreads();
        }
    }
    GRID_BAR(8);
    if (IN(9)) {
        const int* topi = (const int*)(ws + WS_ROUTE + RT_TOPI); const int* tslot = (const int*)(ws + WS_ROUTE + RT_SLOT); const int* cnt = (const int*)(ws + WS_ROUTE + RT_CNT);
        int* row_flat = (int*)(ws + WS_ROUTE + RT_ROWFLAT); float* rs_row = (float*)(ws + WS_ROUTE + RT_RSROW); const float* rstd2 = (const float*)(ws + WS_ROUTE + RT_RSTD);
        LAS int* red = (LAS int*)lds;
        for (int base = bx * 512; base < NA; base += G * 512) {
            const int chA = base >> 8, e = tid & 31, part = tid >> 5;
            int tot = 0, pa = 0, pb = 0;
            for (int c = part; c < T / 64; c += 16) { const int v = cnt[c * 32 + e]; tot += v; pa += c < chA ? v : 0; pb += c <= chA ? v : 0; }
            __syncthreads();
            red[(0 * 16 + part) * 32 + e] = tot; red[(1 * 16 + part) * 32 + e] = pa; red[(2 * 16 + part) * 32 + e] = pb;
            __syncthreads();
            if (tid < 96) { const int w = tid >> 5; int a = 0; for (int p = 0; p < 16; ++p) a += red[(w * 16 + p) * 32 + e]; red[1536 + w * 32 + e] = a; }
            __syncthreads();
            if (tid == 0) { int run = 0; for (int q = 0; q < NE; ++q) { red[1632 + q] = run; run += ((red[1536 + q] + 255) >> 8) << 8; } }
            if (bx == 0 && base == 0 && tid < 32) ((int*)(ws + WS_ROUTE + RT_TOT))[tid] = red[1536 + tid];
            __syncthreads();
            const int a = base + tid, ex = topi[a], row = red[1632 + ex] + red[1536 + 32 * (1 + (((a >> 8) - chA) & 1)) + ex] + tslot[a];
            row_flat[row] = a; rs_row[row] = rstd2[a >> 2];
        }
    }
    GRID_BAR(9);
    if (IN(10) || IN(11)) {
        const int* gtot = (const int*)(ws + WS_ROUTE + RT_TOT); LAS int* texp = (LAS int*)(lds + LX_TEXP);
        __syncthreads();
        if (tid == 0) { int nt = 0; for (int e = 0; e < NE; ++e) { const int n = (gtot[e] + 255) >> 8; for (int j = 0; j < n; ++j) texp[nt + j] = e; nt += n; } texp[NTILEN] = nt; }
        __syncthreads();
    }
    if (IN(10)) {
        int kx = 1024; asm volatile("" : "+s"(kx));
        pg8::Gemm g{(const bf16_t*)(ws + WS_H2B), WguT, kx, kx, kx}; OrderMoe S{(const LAS int*)(lds + LX_TEXP), 8, bx, G, (size_t)2048 * 1024 * 2};
        {
            const int* row_flat = (const int*)(ws + WS_ROUTE + RT_ROWFLAT); pg8::Unit u;
            for (int i = 0; i < pg8::GTAB_UNITS; ++i) { if (!S.next(i, u)) break; if (tid < 256) { const int a = row_flat[u.pm * 256 + tid]; ((LAS unsigned short*)(lds + pg8::GTAB))[i * 256 + tid] = (unsigned short)(a >= 0 ? (a >> 2) : 0); } }
            __syncthreads();
        }
        EpiSwiGLU E{(const float*)(ws + WS_ROUTE + RT_RSROW), args.in[22], (bf16_t*)(ws + WS_HMID), (const LAS int*)(lds + LX_TEXP)};
        pg8::gemm_phase<EpiSwiGLU, OrderMoe, true, true, true>(lds, g, S, E);
    }
    GRID_BAR(10);
    if (IN(11)) {
        int kx = 1024; asm volatile("" : "+s"(kx));
        pg8::Gemm g{(const bf16_t*)(ws + WS_HMID), WdT, kx, kx, kx}; OrderMoe S{(const LAS int*)(lds + LX_TEXP), 4, bx, G, (size_t)1024 * 1024 * 2};
        EpiDown E{(const int*)(ws + WS_ROUTE + RT_ROWFLAT), (const float*)(ws + WS_ROUTE + RT_TOPG), args.in[24], (bf16_t*)(ws + WS_YBUF), (const LAS int*)(lds + LX_TEXP)};
        pg8::gemm_phase<EpiDown, OrderMoe, true, true>(lds, g, S, E);
    }
    GRID_BAR(11);
    if (IN(12)) {
        const bf16_t* h2b = (const bf16_t*)(ws + WS_H2B); const bf16_t* ybuf = (const bf16_t*)(ws + WS_YBUF); const float* g_final = args.in[25]; float* outp = args.out;
        const int gw = vcu * NWAVES + wave, NGW = G * NWAVES;
        for (int t = gw; t < T; t += NGW) {
            f32x4 v[4]; float ss = 0.f;
#pragma unroll
            for (int j = 0; j < 4; ++j) {
                const v2u hw = *(const v2u*)(h2b + (size_t)t * 1024 + 256 * j + 4 * lane);
                f32x4 a = (f32x4){__builtin_bit_cast(float, hw.x << 16), __builtin_bit_cast(float, hw.x & 0xffff0000u), __builtin_bit_cast(float, hw.y << 16), __builtin_bit_cast(float, hw.y & 0xffff0000u)};
#pragma unroll
                for (int k = 0; k < 4; ++k) { const v2u y = *(const v2u*)(ybuf + ((size_t)t * 4 + k) * 1024 + 256 * j + 4 * lane);
                    a[0] += __builtin_bit_cast(float, y.x << 16); a[1] += __builtin_bit_cast(float, y.x & 0xffff0000u); a[2] += __builtin_bit_cast(float, y.y << 16); a[3] += __builtin_bit_cast(float, y.y & 0xffff0000u); }
                v[j] = a; ss += (a[0] * a[0] + a[1] * a[1]) + (a[2] * a[2] + a[3] * a[3]);
            }
            ss = wave_sum(ss); const float rs = 1.0f / sqrtf(ss * (1.0f / 1024.0f) + 1e-6f);
#pragma unroll
            for (int j = 0; j < 4; ++j) *(f32x4*)(outp + (size_t)t * 1024 + 256 * j + 4 * lane) = v[j] * rs * *(const f32x4*)(g_final + 256 * j + 4 * lane);
        }
    }
#undef GRID_BAR
#undef BOTH
#undef IN
}

}
void launch_mk(hipStream_t st, const mk::Args& base, int lo, int hi, int grid) {
    mk::Args a = base; a.ph_lo = lo; a.ph_hi = hi;
    hipLaunchKernelGGL(mk::mk_fwd, dim3(grid), dim3(mk::NWAVES * 64), mk::LDS_BYTES, st, a);
}
}

extern "C" void kernel_launch(void* const* d_in, const int* in_sizes, int n_in, void* d_out, int out_size, void* d_ws, size_t ws_size, hipStream_t stream) {
    static int grid = 0;
    if (grid == 0) {
        int dev = 0, cus = 0;
        if (hipGetDevice(&dev) != hipSuccess || hipDeviceGetAttribute(&cus, hipDeviceAttributeMultiprocessorCount, dev) != hipSuccess) { grid = -1; return; }
        if (hipFuncSetAttribute((const void*)mk::mk_fwd, hipFuncAttributeMaxDynamicSharedMemorySize, mk::LDS_BYTES) != hipSuccess) { grid = -1; return; }
        grid = cus >= 256 ? 256 : cus;
    }
    if (grid < 0) return;
    const float* x = (const float*)d_in[0];
    const float* mem = (const float*)d_in[1];
    const int* pos = (const int*)d_in[2];
    const float* g_q_a = (const float*)d_in[5];
    const float* w_q_b = (const float*)d_in[6];
    const float* g_kv_a = (const float*)d_in[7];
    const float* w_kv_b = (const float*)d_in[8];
    const float* rel_bias = (const float*)d_in[9];
    const float* g_out_a = (const float*)d_in[10];
    const float* g_out_b = (const float*)d_in[11];
    const float* w_o = (const float*)d_in[12];
    const float* g_xattn = (const float*)d_in[13];
    const float* g_mem = (const float*)d_in[14];
    const float* w_mq = (const float*)d_in[15];
    const float* w_mkv = (const float*)d_in[16];
    const float* w_mo = (const float*)d_in[17];
    const float* g_moe = (const float*)d_in[18];
    const float* w_router = (const float*)d_in[19];
    const float* b_router = (const float*)d_in[20];
    const float* w_gate_up = (const float*)d_in[21];
    const float* b_gate_up = (const float*)d_in[22];
    const float* w_down = (const float*)d_in[23];
    const float* b_down = (const float*)d_in[24];
    const float* g_final = (const float*)d_in[25];
    float* out = (float*)d_out;
    (void)ws_size; (void)in_sizes; (void)n_in; (void)out_size;

    (void)hipMemsetAsync((char*)d_ws + mk::WS_CTL, 0, mk::CTL_ZERO_BYTES, stream);
    mk::Args ma; memset(&ma, 0, sizeof(ma));
    for (int i = 0; i < 26; ++i) ma.in[i] = (const float*)d_in[i];
    ma.out = out; ma.ws = (unsigned char*)d_ws; ma.flags = 1;
    for (int j = 0; j < 16; ++j) ma.rope_rev[j] = pow(10000.0, -(double)j / 16.0) / 6.283185307179586476925287;
#ifndef MK_N_LAUNCHES
#define MK_N_LAUNCHES 1
#endif
    if (MK_N_LAUNCHES == 1) launch_mk(stream, ma, 0, 13, grid);
    else for (int p = 0; p < 13; ++p) launch_mk(stream, ma, p, p + 1, grid);
#ifdef PROBE_MASK
#ifdef PROBE_FLAGS
    ma.flags |= PROBE_FLAGS;
#endif
    for (int r = 0; r < PROBE_N; ++r) for (int p = 0; p < 13; ++p) if ((PROBE_MASK >> p) & 1) launch_mk(stream, ma, p, p + 1, grid);
#endif
}
```

```cpp
#include <hip/hip_runtime.h>
#include <stdint.h>
#include <string.h>
#include <math.h>

namespace {
constexpr int NB = 4, S = 4096, D = 1024, T = NB * S, NMEM = 256, INW = 1952;
constexpr int NE = 32, TOPK = 4, NA = T * TOPK;

namespace pg8 {
#define PG8_LAS __attribute__((address_space(3)))
typedef unsigned short bf16_t;
typedef short bf16x8 __attribute__((ext_vector_type(8)));
typedef float f32x4 __attribute__((ext_vector_type(4)));
typedef unsigned u32x4 __attribute__((ext_vector_type(4)));
constexpr int BM = 256, BK = 64, HALF = 128, HTB = HALF * BK * 2  , STAGE_BYTES = 8 * HTB, NXCD = 8, WGM = 8;

__host__ __device__ __forceinline__ int lds_byte(int r, int c) { const int st = (r >> 4) * 2 + (c >> 5), rr = r & 15, cc = c & 31, ob = rr * 64 + cc * 2; return st * 1024 + (ob ^ (((ob >> 9) & 1) << 5)); }
__host__ __device__ __forceinline__ void stage_rc(int b, int& R, int& C) { const int st = b / 1024, sb = b % 1024, swz = sb ^ (((sb >> 9) & 1) << 5); R = (st >> 1) * 16 + swz / 64; C = (st & 1) * 32 + (swz % 64) / 2; }
__host__ __device__ __forceinline__ int perm32(int rho) { const int n = rho >> 4, i = rho & 15; return 8 * (i >> 2) + 4 * n + (i & 3); }

struct Unit { int pm, pn; size_t aoff, boff; };
struct Gemm { const bf16_t* A; const bf16_t* Bt; int lda, ldb, K; };

struct StaticOrder {
    int nM, nN, nwg, G, c; size_t ta, tb;
    __host__ __device__ __forceinline__ void init(int M, int N, int lda, int ldb, int G_, int c_) { nM = M / BM; nN = N / BM; nwg = nM * nN; G = G_; c = c_; ta = (size_t)BM * lda * 2; tb = (size_t)BM * ldb * 2; }
    __host__ __device__ __forceinline__ bool next(int i, Unit& u) const {
        const long L = (long)i * G + c; if (L >= nwg) return false;
        int wgid = (int)L; { const int q = nwg / NXCD, r = nwg % NXCD, xcd = wgid % NXCD, off = wgid / NXCD; wgid = (xcd < r ? xcd * (q + 1) : r * (q + 1) + (xcd - r) * q) + off; }
        const int nig = WGM * nN, gid = wgid / nig, fm = gid * WGM, gsz = (nM - fm) < WGM ? (nM - fm) : WGM;
        u.pm = fm + ((wgid % nig) % gsz); u.pn = (wgid % nig) / gsz; u.aoff = (size_t)u.pm * ta; u.boff = (size_t)u.pn * tb; return true;
    }
    __device__ __forceinline__ void a_ready(const Unit&) const {}
    __device__ __forceinline__ void done(const Unit&) const {}
};

__device__ __forceinline__ unsigned cvt_pk_bf16(float lo, float hi) { unsigned r; asm volatile("v_cvt_pk_bf16_f32 %0, %1, %2" : "=v"(r) : "v"(lo), "v"(hi)); return r; }
typedef float f32x2 __attribute__((ext_vector_type(2)));

constexpr int GTAB = 135168 + 4096, GTAB_UNITS = 10;
template <class Epi, class Sched, bool ALIGN_EPI = false, bool SP2 = false, bool GATHER = false>
__device__ __forceinline__ void gemm_phase(PG8_LAS unsigned char* lds, const Gemm g, const Sched& S, const Epi& E) {
    const int tid = threadIdx.x, wid = __builtin_amdgcn_readfirstlane(tid >> 6), lane = tid & 63, wr = wid >> 2, wc = wid & 3, fr = lane & 15, fq = lane >> 4;
    static_assert(!GATHER || SP2, "GATHER is implemented for the SP2 loop only");
    const int K = g.K, nt = K / BK;
    unsigned voffA[2], voffB[2];
#pragma unroll
    for (int i = 0; i < 2; ++i) { int R, C; stage_rc(tid * 16 + i * 8192, R, C); const int Rb = Epi::PERM ? ((R & ~31) + perm32(R & 31)) : R;
        voffA[i] = (unsigned)(R * g.lda + C) * 2u; voffB[i] = (unsigned)(Rb * g.ldb + C) * 2u; }
    unsigned gidx[2], gcol[2];
#pragma unroll
    for (int i = 0; i < 2; ++i) { int R, C; stage_rc(tid * 16 + i * 8192, R, C); gidx[i] = (unsigned)R * 2u; gcol[i] = (unsigned)C * 2u; }
    const size_t kstep = (size_t)(BK * 2);
    const size_t hstepA = (size_t)HALF * g.lda * 2, hstepB = (size_t)HALF * g.ldb * 2;
    const unsigned ldsw = (unsigned)wid * 1024u;
    const int aoff = lds_byte(wr * 64 + fr, fq * 8), boff = lds_byte(wc * 32 + fr, fq * 8);
#define PG8_SA(b, h) (((b) * 2 + (h)) * HTB)
#define PG8_SB(b, h) ((4 + (b) * 2 + (h)) * HTB)
#define PG8_STAGE(bufoff, gbase, voff) do { _Pragma("unroll") for (int _i = 0; _i < 2; ++_i) \
        __builtin_amdgcn_global_load_lds((const unsigned*)((const char*)(gbase) + (voff)[_i]), (PG8_LAS unsigned*)(lds + (bufoff) + ldsw + _i * 8192), 16, 0, 0); } while (0)
#define PG8_GTOK(h, sel) do { if constexpr (GATHER) { tk0 = *(const PG8_LAS unsigned short*)(lds + GTAB + (sel) * 512 + (h) * 256 + gidx[0]); tk1 = *(const PG8_LAS unsigned short*)(lds + GTAB + (sel) * 512 + (h) * 256 + gidx[1]); } } while (0)
#define PG8_STAGE_A(bufoff, gbase, h, sel) do { if constexpr (GATHER) { \
        __builtin_amdgcn_global_load_lds((const unsigned*)((const char*)(gbase) + (size_t)tk0 * (size_t)(g.lda * 2) + gcol[0]), (PG8_LAS unsigned*)(lds + (bufoff) + ldsw), 16, 0, 0); \
        __builtin_amdgcn_global_load_lds((const unsigned*)((const char*)(gbase) + (size_t)tk1 * (size_t)(g.lda * 2) + gcol[1]), (PG8_LAS unsigned*)(lds + (bufoff) + ldsw + 8192), 16, 0, 0); } \
    else { PG8_STAGE(bufoff, (gbase) + (h) * hstepA, voffA); } } while (0)
#define PG8_LDA(dst, b, h) do { _Pragma("unroll") for (int m = 0; m < 4; ++m) _Pragma("unroll") for (int k = 0; k < 2; ++k) dst[m][k] = *(const PG8_LAS bf16x8*)(lds + PG8_SA(b, h) + aoff + m * 2048 + k * 1024); } while (0)
#define PG8_LDB(dst, b, h) do { _Pragma("unroll") for (int n = 0; n < 2; ++n) _Pragma("unroll") for (int k = 0; k < 2; ++k) dst[n][k] = *(const PG8_LAS bf16x8*)(lds + PG8_SB(b, h) + boff + n * 2048 + k * 1024); } while (0)
#define PG8_MMA(ai, bj, At, Bt) do { __builtin_amdgcn_s_setprio(1); _Pragma("unroll") for (int m = 0; m < 4; ++m) _Pragma("unroll") for (int n = 0; n < 2; ++n) _Pragma("unroll") for (int k = 0; k < 2; ++k) \
        acc[ai][bj][m][n] = __builtin_amdgcn_mfma_f32_16x16x32_bf16(Bt[n][k], At[m][k], acc[ai][bj][m][n], 0, 0, 0); __builtin_amdgcn_s_setprio(0); } while (0)
#define PG8_WAIT_V(n) asm volatile("s_waitcnt vmcnt(" #n ")" ::: "memory")
#define PG8_WAIT_L(n) asm volatile("s_waitcnt lgkmcnt(" #n ")" ::: "memory")
#define PG8_BAR __builtin_amdgcn_s_barrier()
#define PG8_SCHED __builtin_amdgcn_sched_barrier(0)
    Unit cur, nxt; int ui = 0; unsigned tk0 = 0, tk1 = 0; (void)tk0; (void)tk1;
    if (!S.next(0, cur)) return;
    f32x4 acc[2][2][4][2];
#pragma unroll
    for (int a = 0; a < 2; ++a)
#pragma unroll
        for (int b = 0; b < 2; ++b)
#pragma unroll
            for (int m = 0; m < 4; ++m)
#pragma unroll
                for (int n = 0; n < 2; ++n) acc[a][b][m][n] = (f32x4){0.f, 0.f, 0.f, 0.f};
    bf16x8 At[4][2], B0[2][2], B1[2][2];
    const char* cA = (const char*)g.A + (GATHER ? (size_t)0 : cur.aoff); const char* cB = (const char*)g.Bt + cur.boff;
    S.a_ready(cur);
    if constexpr (SP2) {
        PG8_STAGE(PG8_SB(0, 0), cB, voffB); PG8_STAGE(PG8_SB(0, 1), cB + hstepB, voffB); PG8_GTOK(0, ui); PG8_STAGE_A(PG8_SA(0, 0), cA, 0, ui); PG8_GTOK(1, ui); PG8_STAGE_A(PG8_SA(0, 1), cA, 1, ui);
        if (wr == 1) PG8_BAR;
        PG8_WAIT_V(2); PG8_BAR;
        PG8_STAGE(PG8_SB(1, 0), cB + kstep, voffB); PG8_GTOK(0, ui); PG8_STAGE_A(PG8_SA(1, 0), cA + kstep, 0, ui); PG8_STAGE(PG8_SB(1, 1), cB + hstepB + kstep, voffB);
        PG8_WAIT_V(6); PG8_BAR;
    } else {
        PG8_STAGE(PG8_SB(0, 0), cB, voffB); PG8_STAGE_A(PG8_SA(0, 0), cA, 0, ui); PG8_STAGE(PG8_SB(0, 1), cB + hstepB, voffB); PG8_STAGE_A(PG8_SA(0, 1), cA, 1, ui);
        if (wr == 1) PG8_BAR;
        PG8_WAIT_V(4); PG8_BAR;
        PG8_STAGE(PG8_SB(1, 0), cB + kstep, voffB); PG8_STAGE_A(PG8_SA(1, 0), cA + kstep, 0, ui); PG8_STAGE(PG8_SB(1, 1), cB + hstepB + kstep, voffB);
        PG8_WAIT_V(6); PG8_BAR;
    }
    for (;;) {
        const bool has_next = S.next(ui + 1, nxt);
        const char* nA = has_next ? (const char*)g.A + (GATHER ? (size_t)0 : nxt.aoff) : cA; const char* nB = has_next ? (const char*)g.Bt + nxt.boff : cB;
        for (int t = 0; t < nt; t += 2) {
            const bool last = (t == nt - 2);
            const char* a1 = cA + (size_t)(t + 1) * kstep;
            const char* a2 = last ? nA : cA + (size_t)(t + 2) * kstep; const char* b2 = last ? nB : cB + (size_t)(t + 2) * kstep;
            const char* a3 = a2 + kstep; const char* b3 = b2 + kstep; const int ui2 = (last && has_next) ? ui + 1 : ui; (void)ui2;
            if (last && has_next) S.a_ready(nxt);
            if constexpr (SP2) {
            PG8_GTOK(1, ui); PG8_LDB(B0, 0, 0); PG8_LDB(B1, 0, 1); PG8_SCHED; PG8_LDA(At, 0, 0); PG8_STAGE_A(PG8_SA(1, 1), a1, 1, ui);
            PG8_WAIT_V(8); PG8_WAIT_L(0); PG8_BAR; PG8_MMA(0, 0, At, B0); PG8_MMA(0, 1, At, B1); PG8_BAR; PG8_SCHED;
            PG8_GTOK(0, ui2); PG8_LDA(At, 0, 1); PG8_STAGE(PG8_SB(0, 0), b2, voffB); PG8_STAGE(PG8_SB(0, 1), b2 + hstepB, voffB); PG8_STAGE_A(PG8_SA(0, 0), a2, 0, ui2);
            PG8_WAIT_V(8); PG8_WAIT_L(0); PG8_BAR; PG8_MMA(1, 0, At, B0); PG8_MMA(1, 1, At, B1); PG8_BAR; PG8_SCHED;
            PG8_GTOK(1, ui2); PG8_LDB(B0, 1, 0); PG8_LDB(B1, 1, 1); PG8_SCHED; PG8_LDA(At, 1, 0); PG8_STAGE_A(PG8_SA(0, 1), a2, 1, ui2);
            PG8_WAIT_V(8); PG8_WAIT_L(0); PG8_BAR; PG8_MMA(0, 0, At, B0); PG8_MMA(0, 1, At, B1); PG8_BAR; PG8_SCHED;
            PG8_GTOK(0, ui2); PG8_LDA(At, 1, 1); PG8_STAGE(PG8_SB(1, 0), b3, voffB); PG8_STAGE(PG8_SB(1, 1), b3 + hstepB, voffB); PG8_STAGE_A(PG8_SA(1, 0), a3, 0, ui2);
            PG8_WAIT_V(8); PG8_WAIT_L(0); PG8_BAR; PG8_MMA(1, 0, At, B0); PG8_MMA(1, 1, At, B1); PG8_BAR; PG8_SCHED;
            } else {
            PG8_LDB(B0, 0, 0); PG8_SCHED; PG8_LDA(At, 0, 0); PG8_STAGE_A(PG8_SA(1, 1), a1, 1, ui);
            PG8_WAIT_L(8); PG8_BAR; PG8_WAIT_L(0); PG8_MMA(0, 0, At, B0); PG8_BAR; PG8_SCHED;
            PG8_LDB(B1, 0, 1); PG8_STAGE(PG8_SB(0, 0), b2, voffB);
            PG8_BAR; PG8_WAIT_L(0); PG8_MMA(0, 1, At, B1); PG8_BAR;
            PG8_LDA(At, 0, 1); PG8_STAGE_A(PG8_SA(0, 0), a2, 0, ui2);
            PG8_BAR; PG8_WAIT_L(0); PG8_MMA(1, 0, At, B0); PG8_BAR; PG8_SCHED;
            PG8_STAGE(PG8_SB(0, 1), b2 + hstepB, voffB);
            PG8_WAIT_V(6); PG8_BAR; PG8_MMA(1, 1, At, B1); PG8_BAR;
            PG8_LDB(B0, 1, 0); PG8_SCHED; PG8_LDA(At, 1, 0); PG8_STAGE_A(PG8_SA(0, 1), a2, 1, ui2);
            PG8_WAIT_L(8); PG8_BAR; PG8_WAIT_L(0); PG8_MMA(0, 0, At, B0); PG8_BAR; PG8_SCHED;
            PG8_LDB(B1, 1, 1); PG8_STAGE(PG8_SB(1, 0), b3, voffB);
            PG8_BAR; PG8_WAIT_L(0); PG8_MMA(0, 1, At, B1); PG8_BAR;
            PG8_LDA(At, 1, 1); PG8_STAGE_A(PG8_SA(1, 0), a3, 0, ui2);
            PG8_BAR; PG8_WAIT_L(0); PG8_MMA(1, 0, At, B0); PG8_BAR; PG8_SCHED;
            PG8_STAGE(PG8_SB(1, 1), b3 + hstepB, voffB);
            PG8_WAIT_V(6); PG8_BAR; PG8_MMA(1, 1, At, B1); PG8_BAR;
            }
        }
        if constexpr (ALIGN_EPI) { if (wr == 0) PG8_BAR; }
        if constexpr (!Epi::AFTER_DRAIN) { E(acc, cur, wr, wc, fr, fq); S.done(cur); }
        if (!has_next) break;
#pragma unroll
        for (int a = 0; a < 2; ++a)
#pragma unroll
            for (int b = 0; b < 2; ++b)
#pragma unroll
                for (int m = 0; m < 4; ++m)
#pragma unroll
                    for (int n = 0; n < 2; ++n) acc[a][b][m][n] = (f32x4){0.f, 0.f, 0.f, 0.f};
        cur = nxt; cA = nA; cB = nB; ++ui;
        if constexpr (ALIGN_EPI) { if (wr == 1) PG8_BAR; }
    }
    PG8_WAIT_V(0);
    if constexpr (!ALIGN_EPI) { if (wr == 0) PG8_BAR; }
    PG8_BAR;
    if constexpr (Epi::AFTER_DRAIN) { E.fused(acc, cur, wr, wc, fr, fq, lds, wid, lane); S.done(cur); }
#undef PG8_SA
#undef PG8_SB
#undef PG8_STAGE
#undef PG8_STAGE_A
#undef PG8_GTOK
#undef PG8_LDA
#undef PG8_LDB
#undef PG8_MMA
#undef PG8_WAIT_V
#undef PG8_WAIT_L
#undef PG8_BAR
#undef PG8_SCHED
}
}
namespace mla {
using bf16x8 = __attribute__((ext_vector_type(8))) short;
using s16x4  = __attribute__((ext_vector_type(4))) short;
using f32x16 = __attribute__((ext_vector_type(16))) float;
using u32x4  = __attribute__((ext_vector_type(4))) unsigned;
constexpr int NW = 8, QBLK = 32, KVBLK = 64;
constexpr float SCALE = 0.10206207261596577f;
constexpr float THR = 8.f;
constexpr int SHM_V = KVBLK * 64 * 2, SHM_K = KVBLK * 256;
constexpr int SHM_ATTN = 4 * SHM_V + 4 * SHM_K + NW * 64 * 4;
#define KSWZ(row, colB) ((row) * 256 + ((colB) ^ (((row) & 7) << 4)))
#define SBAR() __builtin_amdgcn_sched_barrier(0)
__device__ __forceinline__ int crow(int r, int hi) { return (r & 3) + 8 * (r >> 2) + 4 * hi; }
__device__ __forceinline__ unsigned cvtpk(float lo, float hi) { unsigned r; asm volatile("v_cvt_pk_bf16_f32 %0, %1, %2" : "=v"(r) : "v"(lo), "v"(hi)); return r; }

__device__ __forceinline__ float max3f(float a, float b, float c) { return __builtin_fmaxf(__builtin_fmaxf(a, b), c); }
template <int ABL> __device__ __forceinline__ void partialSM(f32x16& p0, f32x16& p1, float& m_reg, float& alpha, bool first) {
  float a = max3f(p0[0], p0[1], p0[2]), b = max3f(p0[3], p1[0], p1[1]), c = max3f(p1[2], p1[3], p0[4]), d = max3f(p0[5], p0[6], p0[7]);
  a = max3f(a, p1[4], p1[5]); b = max3f(b, p1[6], p1[7]);
#pragma unroll
  for (int r = 8; r < 16; r += 4) { a = max3f(a, p0[r], p0[r + 1]); b = max3f(b, p0[r + 2], p0[r + 3]); c = max3f(c, p1[r], p1[r + 1]); d = max3f(d, p1[r + 2], p1[r + 3]); }
  float pmax = fmaxf(fmaxf(a, b), fmaxf(c, d));
  { auto rr = __builtin_amdgcn_permlane32_swap(__float_as_uint(pmax), __float_as_uint(pmax), false, false);
    pmax = fmaxf(__uint_as_float(rr[0]), __uint_as_float(rr[1])); }
  if (__builtin_expect(!first && __all(pmax - m_reg <= THR * 1.4426950408889634f), 1)) { alpha = 1.f; }
  else { const float mn = first ? pmax : fmaxf(m_reg, pmax); alpha = first ? 1.f : __builtin_amdgcn_exp2f(m_reg - mn); m_reg = mn; }
#pragma unroll
  for (int r = 0; r < 16; ++r) { p0[r] -= m_reg; p1[r] -= m_reg; }
#pragma unroll
  for (int r = 0; r < 16; ++r) p0[r] = (ABL & 2) ? p0[r] * 0.5f : __builtin_amdgcn_exp2f(p0[r]);
}
template <int ABL> __device__ __forceinline__ void finishSM(f32x16& p0, f32x16& p1, float alpha, float& l_reg, bf16x8& pa0, bf16x8& pa1, bf16x8& pa2, bf16x8& pa3) {
#pragma unroll
  for (int r = 0; r < 16; ++r) p1[r] = (ABL & 2) ? p1[r] * 0.5f : __builtin_amdgcn_exp2f(p1[r]);
  float ps, s0 = 0.f, s1 = 0.f, s2 = 0.f, s3 = 0.f;
#pragma unroll
  for (int r = 0; r < 16; r += 4) { s0 += p0[r]; s1 += p0[r + 1]; s2 += p0[r + 2]; s3 += p0[r + 3]; }
#pragma unroll
  for (int r = 0; r < 16; r += 4) { s0 += p1[r]; s1 += p1[r + 1]; s2 += p1[r + 2]; s3 += p1[r + 3]; }
  ps = (s0 + s1) + (s2 + s3);
  { auto rr = __builtin_amdgcn_permlane32_swap(__float_as_uint(ps), __float_as_uint(ps), false, false);
    ps = __uint_as_float(rr[0]) + __uint_as_float(rr[1]); }
  l_reg = l_reg * alpha + ps;
#define PK4(P, BASE, OUT) do { u32x4 w = {cvtpk(P[BASE + 0], P[BASE + 1]), cvtpk(P[BASE + 2], P[BASE + 3]), cvtpk(P[BASE + 4], P[BASE + 5]), cvtpk(P[BASE + 6], P[BASE + 7])}; \
    OUT = *reinterpret_cast<bf16x8*>(&w); } while (0)
  PK4(p0, 0, pa0); PK4(p0, 8, pa1); PK4(p1, 0, pa2); PK4(p1, 8, pa3);
#undef PK4
}
__device__ __forceinline__ void qkt(f32x16& p0, f32x16& p1, const char* Ks, const bf16x8* qr, int r32, int hi) {
  p0 = f32x16{}; p1 = f32x16{};
#pragma unroll
  for (int d0 = 0; d0 < 6; ++d0) { int cb = (d0 * 16 + hi * 8) * 2;
    bf16x8 b0 = *reinterpret_cast<const bf16x8*>(Ks + KSWZ(r32, cb));
    bf16x8 b1 = *reinterpret_cast<const bf16x8*>(Ks + KSWZ(32 + r32, cb));
    p0 = __builtin_amdgcn_mfma_f32_32x32x16_bf16(b0, qr[d0], p0, 0, 0, 0);
    p1 = __builtin_amdgcn_mfma_f32_32x32x16_bf16(b1, qr[d0], p1, 0, 0, 0); }
}
__device__ __forceinline__ int v_st(int k, int c) { const int kk = k;
  return ((kk >> 3) * 2 + (c >> 5)) * 512 + ((kk & 7) * 32 + (c & 31)) * 2; }
__device__ __forceinline__ int v_rd_base(int lane) { return ((lane & 3) << 3) | (((lane >> 2) & 3) << 6) | (((lane >> 4) & 1) << 5) | (((lane >> 5) & 1) << 8); }
constexpr int v_rd_off(int d0, int ks, int half) { return d0 * 512 + ks * 2048 + half * 1024; }
template <int OFF> __device__ __forceinline__ s16x4 tr_read(int vb) {
  s16x4 r; asm volatile("ds_read_b64_tr_b16 %0, %1 offset:%2" : "=&v"(r) : "v"(vb), "i"(OFF) : "memory"); return r;
}
#define PK(L, H) (bf16x8){L[0], L[1], L[2], L[3], H[0], H[1], H[2], H[3]}
#define PV_RD(KS, LA, HA, LB, HB) do { LA = tr_read<v_rd_off(0, KS, 0)>(vb); HA = tr_read<v_rd_off(0, KS, 1)>(vb); LB = tr_read<v_rd_off(1, KS, 0)>(vb); HB = tr_read<v_rd_off(1, KS, 1)>(vb); } while (0)
#define PV_MM(PA, LA, HA, LB, HB) do { o[0] = __builtin_amdgcn_mfma_f32_32x32x16_bf16(PA, PK(LA, HA), o[0], 0, 0, 0); o[1] = __builtin_amdgcn_mfma_f32_32x32x16_bf16(PA, PK(LB, HB), o[1], 0, 0, 0); } while (0)
__device__ __forceinline__ void pv_d0(f32x16* o, int vb, bf16x8 pa0, bf16x8 pa1, bf16x8 pa2, bf16x8 pa3) {
  s16x4 la, ha, lb, hb, lc, hc, ld, hd;
  PV_RD(0, la, ha, lb, hb);
  PV_RD(1, lc, hc, ld, hd);
  asm volatile("s_waitcnt lgkmcnt(4)" ::: "memory"); SBAR();
  PV_MM(pa0, la, ha, lb, hb); SBAR();
  PV_RD(2, la, ha, lb, hb);
  asm volatile("s_waitcnt lgkmcnt(4)" ::: "memory"); SBAR();
  PV_MM(pa1, lc, hc, ld, hd); SBAR();
  PV_RD(3, lc, hc, ld, hd);
  asm volatile("s_waitcnt lgkmcnt(4)" ::: "memory"); SBAR();
  PV_MM(pa2, la, ha, lb, hb); SBAR();
  asm volatile("s_waitcnt lgkmcnt(0)" ::: "memory"); SBAR();
  PV_MM(pa3, lc, hc, ld, hd);
}
#undef PV_MM
#undef PV_RD
#undef PK
__device__ __forceinline__ float bf2f_(short b) { return __builtin_bit_cast(float, (unsigned)(unsigned short)b << 16); }

template <int ABL> __device__ __forceinline__ void mla_unit(const unsigned short* __restrict__ Qg, const unsigned short* __restrict__ Kn, const unsigned short* __restrict__ Kpe, const unsigned short* __restrict__ Vg,
                                         const float* __restrict__ cs, unsigned short* __restrict__ Og, int q0, int krow0, int h, int seq, char* lds) {
  const int tid = threadIdx.x, wid = __builtin_amdgcn_readfirstlane(tid >> 6), lane = tid & 63, r32 = lane & 31, hi = lane >> 5;
  char* V_lds = lds; char* K_lds = lds + 4 * SHM_V;
  float* ws = (float*)(lds + 4 * SHM_V + 4 * SHM_K) + wid * 64; float* li_l = ws; float* al_l = ws + 32;
  float m_reg = 0.f, l_reg = 0; f32x16 o[2] = {}; bf16x8 qr[6];
  {
    const int qrow = q0 + wid * QBLK + r32;
    const unsigned short* Qw = Qg + (size_t)qrow * 768 + h * 96 + hi * 8;
#pragma unroll
    for (int d0 = 0; d0 < 6; ++d0) qr[d0] = *reinterpret_cast<const bf16x8*>(Qw + d0 * 16);
    const float* cr = cs + (size_t)qrow * 32 + hi * 8;
    bf16x8 a = qr[4], b = qr[5]; u32x4 wa, wb; float n1[8], n2[8];
#pragma unroll
    for (int e = 0; e < 8; ++e) { const float c_ = cr[e], s_ = cr[16 + e]; const float x1 = bf2f_(a[e]), x2 = bf2f_(b[e]); n1[e] = x1 * c_ - x2 * s_; n2[e] = x1 * s_ + x2 * c_; }
    wa = (u32x4){cvtpk(n1[0], n1[1]), cvtpk(n1[2], n1[3]), cvtpk(n1[4], n1[5]), cvtpk(n1[6], n1[7])};
    wb = (u32x4){cvtpk(n2[0], n2[1]), cvtpk(n2[2], n2[3]), cvtpk(n2[4], n2[5]), cvtpk(n2[6], n2[7])};
    qr[4] = *reinterpret_cast<bf16x8*>(&wa); qr[5] = *reinterpret_cast<bf16x8*>(&wb);
  }
  const int sk = tid >> 3, sc = (tid & 7) * 8, rk = (tid & 255) >> 2, rc = (tid & 3) * 8;
  const int vst = v_st(sk, sc), kst = KSWZ(sk, sc * 2), rst = KSWZ(rk, (64 + rc) * 2);
  const int vb0 = (int)(uintptr_t)V_lds + v_rd_base(lane);
  const unsigned short* Vh = Vg + (size_t)krow0 * 512 + h * 64; const unsigned short* Kh = Kn + (size_t)krow0 * 512 + h * 64; const unsigned short* Rh = Kpe + (size_t)krow0 * 32;
  struct { bf16x8 vs, ks, rs; } sr_[2];
#define SLOAD(i, k0) do { sr_[i].vs = *reinterpret_cast<const bf16x8*>(&Vh[(size_t)((k0) + sk) * 512 + sc]); sr_[i].ks = *reinterpret_cast<const bf16x8*>(&Kh[(size_t)((k0) + sk) * 512 + sc]); \
    sr_[i].rs = *reinterpret_cast<const bf16x8*>(&Rh[(size_t)((k0) + rk) * 32 + rc]); } while (0)
#define SWRITE(b, i) do { *(bf16x8*)(V_lds + (b) * SHM_V + vst) = sr_[i].vs; *(bf16x8*)(K_lds + (b) * SHM_K + kst) = sr_[i].ks; *(bf16x8*)(K_lds + (b) * SHM_K + rst) = sr_[i].rs; } while (0)
#define RESC(a) do { if (__any((a) < 1.f)) { if (hi == 0) al_l[r32] = (a); asm volatile("s_waitcnt lgkmcnt(0)" ::: "memory"); \
    _Pragma("unroll") for (int d = 0; d < 2; ++d) _Pragma("unroll") for (int r = 0; r < 16; ++r) o[d][r] *= al_l[crow(r, hi)]; } } while (0)
#define EBAR() do { asm volatile("s_waitcnt lgkmcnt(0)" ::: "memory"); __builtin_amdgcn_s_barrier(); asm volatile("" ::: "memory"); } while (0)
  f32x16 p0, p1; float al; bf16x8 pa0, pa1, pa2, pa3; const int NT = seq / KVBLK;
  pa0 = pa1 = pa2 = pa3 = bf16x8{};
  SLOAD(0, 0); SLOAD(1, KVBLK); asm volatile("s_waitcnt vmcnt(0)" ::: "memory"); SWRITE(0, 0); SWRITE(1, 1);
  if (2 < NT) SLOAD(0, 2 * KVBLK);
  EBAR();
  if (wid >= 4) EBAR();
  for (int t = 0; t < NT; ++t) {
    SBAR(); __builtin_amdgcn_s_setprio(3); qkt(p0, p1, K_lds + (t & 3) * SHM_K, qr, r32, hi); SBAR();
    if (t > 0) pv_d0(o, vb0 + ((t - 1) & 3) * SHM_V, pa0, pa1, pa2, pa3);
    __builtin_amdgcn_s_setprio(0); EBAR();
    partialSM<ABL>(p0, p1, m_reg, al, t == 0);
    RESC(al);
    finishSM<ABL>(p0, p1, al, l_reg, pa0, pa1, pa2, pa3);
    if (t + 2 < NT) { asm volatile("s_waitcnt vmcnt(0)" ::: "memory"); SWRITE((t + 2) & 3, 0); }
    if (t + 3 < NT) SLOAD(0, (t + 3) * KVBLK);
    EBAR();
  }
  SBAR(); pv_d0(o, vb0 + ((NT - 1) & 3) * SHM_V, pa0, pa1, pa2, pa3);
  if (wid < 4) EBAR();
#undef EBAR
  if (hi == 0) li_l[r32] = l_reg; asm volatile("s_waitcnt lgkmcnt(0)" ::: "memory");
  float rli[16];
#pragma unroll
  for (int r = 0; r < 16; ++r) rli[r] = __builtin_amdgcn_rcpf(li_l[crow(r, hi)]);
  unsigned short* Ow = Og + (size_t)(q0 + wid * QBLK) * 512 + h * 64;
#pragma unroll
  for (int r = 0; r < 16; ++r) { int orow = crow(r, hi);
#pragma unroll
    for (int d0 = 0; d0 < 2; ++d0) Ow[(size_t)orow * 512 + d0 * 32 + r32] = (unsigned short)cvtpk(o[d0][r] * rli[r], 0.f); }
  __syncthreads();
#undef SLOAD
#undef SWRITE
#undef RESC
}
#undef KSWZ
#undef SBAR
}

namespace dil {
using bf16x8 = __attribute__((ext_vector_type(8))) short;
using s16x4  = __attribute__((ext_vector_type(4))) short;
using f32x16 = __attribute__((ext_vector_type(16))) float;
using u32x4  = __attribute__((ext_vector_type(4))) unsigned;
constexpr int TBL_PITCH = 2112;
constexpr int W_TBL = 0, W_K = 8448, W_V = 8448 + 4096, W_POS = 8448 + 8192, W_AL = W_POS + 128, W_BYTES = W_AL + 128;
__device__ __forceinline__ int crow(int r, int hi) { return (r & 3) + 8 * (r >> 2) + 4 * hi; }
__device__ __forceinline__ unsigned cvtpk(float lo, float hi) { unsigned r; asm volatile("v_cvt_pk_bf16_f32 %0, %1, %2" : "=v"(r) : "v"(lo), "v"(hi)); return r; }
#define DKSWZ(row, colB) ((row) * 128 + ((colB) ^ (((row) & 7) << 4)))
__device__ __forceinline__ int v_st(int k, int c) { const int kk = k;
  return ((kk >> 3) * 2 + (c >> 5)) * 512 + ((kk & 7) * 32 + (c & 31)) * 2; }
__device__ __forceinline__ int v_rd_base(int lane) { return ((lane & 3) << 3) | (((lane >> 2) & 3) << 6) | (((lane >> 4) & 1) << 5) | (((lane >> 5) & 1) << 8); }
constexpr int v_rd_off(int d0, int ks, int half) { return d0 * 512 + ks * 2048 + half * 1024; }
template <int OFF> __device__ __forceinline__ s16x4 tr_read(int vb) {
  s16x4 r; asm volatile("ds_read_b64_tr_b16 %0, %1 offset:%2" : "=&v"(r) : "v"(vb), "i"(OFF) : "memory"); return r;
}
template <int D0> __device__ __forceinline__ void pv_one(f32x16& od, int vb, bf16x8 pa0, bf16x8 pa1) {
  const s16x4 l0 = tr_read<v_rd_off(D0, 0, 0)>(vb), h0 = tr_read<v_rd_off(D0, 0, 1)>(vb), l1 = tr_read<v_rd_off(D0, 1, 0)>(vb), h1 = tr_read<v_rd_off(D0, 1, 1)>(vb);
  asm volatile("s_waitcnt lgkmcnt(0)" ::: "memory"); __builtin_amdgcn_sched_barrier(0);
#define PK(L, H) (bf16x8){L[0], L[1], L[2], L[3], H[0], H[1], H[2], H[3]}
  od = __builtin_amdgcn_mfma_f32_32x32x16_bf16(pa0, PK(l0, h0), od, 0, 0, 0);
  od = __builtin_amdgcn_mfma_f32_32x32x16_bf16(pa1, PK(l1, h1), od, 0, 0, 0);
#undef PK
}
struct KVRegs { bf16x8 k[4], v[4]; int pk; };
struct TaskId { int b, h, g, r, ub; };
__device__ __forceinline__ TaskId task_at(int i, int bx, int G, int wave) {
  TaskId t; int bh, k; t.b = 0; t.h = 0; t.g = 0; t.r = 0; t.ub = -1;
  if (G == 256) { if (i >= 6) return t; bh = (bx & 7) + 8 * (bx >> 6); k = ((((bx >> 3) & 7) * 6 + i) << 3) + wave; }
  else { const int id = (i * G + bx) * 8 + wave; if (id >= 12288) return t; bh = id / 384; k = id % 384; }
  const int g = k >> 7, kk = k & 127, nub = g == 0 ? 128 : (g == 1 ? 32 : 8);
  t.b = bh >> 3; t.h = bh & 7; t.g = g; t.r = kk / nub; t.ub = kk % nub; return t;
}
struct Pre { bf16x8 qr[4]; int pos_q; KVRegs R; };
__device__ __forceinline__ void load_blk(const unsigned short* __restrict__ qkv, const int* __restrict__ pos, const TaskId& t, int kb, KVRegs& R) {
  const int lane = threadIdx.x & 63, r32 = lane & 31, srow = lane >> 1, shalf = (lane & 1) * 32;
  const int dl = t.g == 0 ? 1 : (t.g == 1 ? 4 : 16), L = S / dl; const size_t rowb = (size_t)t.b * S;
  int up = 32 * (t.ub - 2 + kb) + srow; up = up < 0 ? 0 : (up >= L ? L - 1 : up);
  const unsigned short* base = qkv + (rowb + t.r + dl * up) * 1536 + t.h * 64 + shalf;
#pragma unroll
  for (int c = 0; c < 4; ++c) { R.k[c] = *reinterpret_cast<const bf16x8*>(base + 512 + c * 8); R.v[c] = *reinterpret_cast<const bf16x8*>(base + 1024 + c * 8); }
  int upl = 32 * (t.ub - 2 + kb) + r32; upl = upl < 0 ? 0 : (upl >= L ? L - 1 : upl);
  R.pk = pos[rowb + t.r + dl * upl];
}
__device__ __forceinline__ int kb_first(const TaskId& t) { return (t.ub >= 2) ? 0 : (2 - t.ub); }
__device__ __forceinline__ void dil_prefetch(const unsigned short* __restrict__ qkv, const int* __restrict__ pos, const TaskId& t, Pre& P) {
  const int lane = threadIdx.x & 63, r32 = lane & 31, hi = lane >> 5;
  const int dl = t.g == 0 ? 1 : (t.g == 1 ? 4 : 16); const size_t rowb = (size_t)t.b * S; const int tok_q = t.r + dl * (32 * t.ub + r32);
  const unsigned short* Qw = qkv + (rowb + tok_q) * 1536 + t.h * 64 + hi * 8;
#pragma unroll
  for (int d0 = 0; d0 < 4; ++d0) P.qr[d0] = *reinterpret_cast<const bf16x8*>(Qw + d0 * 16);
  P.pos_q = pos[rowb + tok_q];
  load_blk(qkv, pos, t, kb_first(t), P.R);
}
__device__ __forceinline__ void dil_task(const unsigned short* __restrict__ qkv, const int* __restrict__ pos, unsigned short* __restrict__ oap, float* __restrict__ lse,
                                         const TaskId t, Pre& P, bool has_next, const TaskId tn, char* wl  ) {
  const int lane = threadIdx.x & 63, r32 = lane & 31, hi = lane >> 5;
  const int b = t.b, h = t.h, g = t.g, r = t.r, ub = t.ub;
  const int dl = g == 0 ? 1 : (g == 1 ? 4 : 16), L = S / dl;
  const int u_q = 32 * ub + r32;
  const size_t rowb = (size_t)b * S;
  const int tok_q = r + dl * u_q;
  const float* tblw = (const float*)(wl + W_TBL); int* posw = (int*)(wl + W_POS); float* alw = (float*)(wl + W_AL);
  bf16x8 qr[4];
#pragma unroll
  for (int d0 = 0; d0 < 4; ++d0) qr[d0] = P.qr[d0];
  const int pos_q = P.pos_q;
  const int srow = lane >> 1, shalf = (lane & 1) * 32;
  const int vb0 = (int)(uintptr_t)(wl + W_V) + v_rd_base(lane);
  float m_reg = -1e30f, l_reg = 0.f; f32x16 o[2] = {};
  const int kb_lo = kb_first(t), kb_hi = (32 * (ub + 3) <= L) ? 4 : (4 - ((32 * (ub + 3) - L) >> 5));
  KVRegs R = P.R;
  for (int kb = kb_lo; kb <= kb_hi; ++kb) {
#pragma unroll
    for (int c = 0; c < 4; ++c) {
      *(bf16x8*)(wl + W_K + DKSWZ(srow, (shalf + c * 8) * 2)) = R.k[c];
      *(bf16x8*)(wl + W_V + v_st(srow, shalf + c * 8)) = R.v[c];
    }
    if (hi == 0) posw[r32] = R.pk;
    if (kb < kb_hi) load_blk(qkv, pos, t, kb + 1, R);
    asm volatile("s_waitcnt lgkmcnt(0)" ::: "memory"); __builtin_amdgcn_sched_barrier(0);
    f32x16 p = {};
#pragma unroll
    for (int d0 = 0; d0 < 4; ++d0) {
      const bf16x8 kf = *reinterpret_cast<const bf16x8*>(wl + W_K + DKSWZ(r32, (d0 * 16 + hi * 8) * 2));
      p = __builtin_amdgcn_mfma_f32_32x32x16_bf16(kf, qr[d0], p, 0, 0, 0);
    }
    float bmax;
    {
      int idx[16];
#pragma unroll
      for (int rr = 0; rr < 16; ++rr) { int rel = posw[crow(rr, hi)] - pos_q; rel = rel < -1024 ? -1024 : (rel > 1024 ? 1024 : rel); const int i_ = rel + 1024; idx[rr] = i_ ^ ((i_ >> 5) & 31); }
#pragma unroll
      for (int rr = 0; rr < 16; ++rr) p[rr] += tblw[idx[rr]];
    }
    if (kb == 0) {
#pragma unroll
      for (int rr = 0; rr < 16; ++rr) p[rr] = crow(rr, hi) >= r32 ? p[rr] : -INFINITY;
    } else if (kb == 4) {
#pragma unroll
      for (int rr = 0; rr < 16; ++rr) p[rr] = crow(rr, hi) <= r32 ? p[rr] : -INFINITY;
    }
    bmax = fmaxf(fmaxf(p[0], p[1]), fmaxf(p[2], p[3]));
#pragma unroll
    for (int rr = 4; rr < 16; rr += 4) bmax = fmaxf(bmax, fmaxf(fmaxf(p[rr], p[rr + 1]), fmaxf(p[rr + 2], p[rr + 3])));
    { auto x = __builtin_amdgcn_permlane32_swap(__float_as_uint(bmax), __float_as_uint(bmax), false, false); bmax = fmaxf(__uint_as_float(x[0]), __uint_as_float(x[1])); }
    float alpha = 1.f; bool resc = false;
    if (!__all(bmax - m_reg <= 11.5f)) { const float mn = fmaxf(m_reg, bmax); alpha = __builtin_amdgcn_exp2f(m_reg - mn); m_reg = mn; resc = true; }
    float ps = 0.f;
#pragma unroll
    for (int rr = 0; rr < 16; ++rr) p[rr] = __builtin_amdgcn_exp2f(p[rr] - m_reg);
    ps = ((p[0] + p[1]) + (p[2] + p[3])) + ((p[4] + p[5]) + (p[6] + p[7])) + (((p[8] + p[9]) + (p[10] + p[11])) + ((p[12] + p[13]) + (p[14] + p[15])));
    { auto x = __builtin_amdgcn_permlane32_swap(__float_as_uint(ps), __float_as_uint(ps), false, false); ps = __uint_as_float(x[0]) + __uint_as_float(x[1]); }
    l_reg = l_reg * alpha + ps;
    if (resc && kb != kb_lo) {
      if (hi == 0) alw[r32] = alpha;
      asm volatile("s_waitcnt lgkmcnt(0)" ::: "memory");
#pragma unroll
      for (int d = 0; d < 2; ++d)
#pragma unroll
        for (int rr = 0; rr < 16; ++rr) o[d][rr] *= alw[crow(rr, hi)];
    }
    bf16x8 pa0, pa1;
#define PK4(P, BASE, OUT) do { u32x4 w = {cvtpk(P[BASE + 0], P[BASE + 1]), cvtpk(P[BASE + 2], P[BASE + 3]), cvtpk(P[BASE + 4], P[BASE + 5]), cvtpk(P[BASE + 6], P[BASE + 7])}; \
    OUT = *reinterpret_cast<bf16x8*>(&w); } while (0)
    PK4(p, 0, pa0); PK4(p, 8, pa1);
#undef PK4
    pv_one<0>(o[0], vb0, pa0, pa1); pv_one<1>(o[1], vb0, pa0, pa1);
  }
  if (has_next) dil_prefetch(qkv, pos, tn, P);
  float* liw = alw;
  if (hi == 0) liw[r32] = l_reg;
  asm volatile("s_waitcnt lgkmcnt(0)" ::: "memory");
  if (hi == 0) lse[((size_t)g * T + rowb + tok_q) * 8 + h] = (m_reg + __log2f(l_reg)) * 0.6931471805599453f;
  unsigned short* Ow = oap + ((size_t)g * T + rowb + r + (size_t)dl * 32 * ub) * 512 + h * 64;
  char* ot = wl + W_K;
#pragma unroll
  for (int rr = 0; rr < 16; ++rr) { const int orow = crow(rr, hi); const float rl = __builtin_amdgcn_rcpf(liw[orow]);
#pragma unroll
    for (int d0 = 0; d0 < 2; ++d0) *(unsigned short*)(ot + orow * 144 + (d0 * 32 + r32) * 2) = (unsigned short)cvtpk(o[d0][rr] * rl, 0.f); }
  asm volatile("s_waitcnt lgkmcnt(0)" ::: "memory");
#pragma unroll
  for (int ps = 0; ps < 4; ++ps) { const int orow = ps * 8 + (lane >> 3), c = lane & 7;
    const u32x4 w = *(const u32x4*)(ot + orow * 144 + c * 16);
    *(u32x4*)(Ow + (size_t)orow * dl * 512 + c * 8) = w; }
  asm volatile("s_waitcnt lgkmcnt(0)" ::: "memory");
}
#undef DKSWZ
}

namespace mk {
#define GAS __attribute__((address_space(1)))
#define LAS __attribute__((address_space(3)))
typedef unsigned short bf16_t;
typedef unsigned v4u __attribute__((ext_vector_type(4)));
typedef unsigned v2u __attribute__((ext_vector_type(2)));
typedef float f32x4 __attribute__((ext_vector_type(4)));
#define LDS_WAIT() asm volatile("s_waitcnt lgkmcnt(0)" ::: "memory")
#define VM_WAIT() asm volatile("s_waitcnt vmcnt(0)" ::: "memory")
__device__ __forceinline__ unsigned f2bf(float f) { unsigned u = __builtin_bit_cast(unsigned, f); return (u + 0x7fffu + ((u >> 16) & 1u)) >> 16; }
typedef float f32x2_t __attribute__((ext_vector_type(2))); typedef __bf16 bf16x2_t __attribute__((ext_vector_type(2)));
__device__ __forceinline__ unsigned pk2(float lo, float hi) { const f32x2_t v = {lo, hi}; const bf16x2_t b = __builtin_convertvector(v, bf16x2_t); return __builtin_bit_cast(unsigned, b); }
__device__ __forceinline__ float bf2f(unsigned short b) { return __builtin_bit_cast(float, (unsigned)b << 16); }
__device__ __forceinline__ float wave_sum(float v) {
#pragma unroll
    for (int o = 1; o < 64; o <<= 1) v += __shfl_xor(v, o);
    return v;
}

#define XB_TMO      128
#define XB_XCNT(j)  (256  + 64 * (j))
#define XB_XSUB(j)  (1280 + 64 * (j))
#define XB_XGEN(j)  (2304 + 64 * (j))
#define XB_TOP      3328
#define XB_TOPGEN   3392
#define XCD_BAR_WORDS 3456
#define XB_SPIN_CAP (1u << 18)

__device__ __forceinline__ unsigned xb_ld(unsigned* p)              { return __hip_atomic_load(p, __ATOMIC_RELAXED, __HIP_MEMORY_SCOPE_AGENT); }
__device__ __forceinline__ unsigned xb_add(unsigned* p, unsigned v) { return __hip_atomic_fetch_add(p, v, __ATOMIC_RELAXED, __HIP_MEMORY_SCOPE_AGENT); }
__device__ __forceinline__ unsigned xb_xcc_id() { return (unsigned)__builtin_amdgcn_s_getreg((3 << 11) | 20) & 0xFu; }
#define XB_SPIN(cond, bar) do { unsigned _sp = 0; while (cond) { __builtin_amdgcn_s_sleep(1); \
    if ((++_sp & 255u) == 0u) { if (xb_ld(&(bar)[XB_TMO])) break; if (_sp > XB_SPIN_CAP) { atomicAdd(&(bar)[XB_TMO], 1u); break; } } } } while (0)

struct XcdBarrier {
    unsigned* bar; unsigned x;
    volatile LAS unsigned* st;
};

__device__ __forceinline__ XcdBarrier xcd_barrier_post(unsigned* bar, volatile LAS unsigned* st) {
    XcdBarrier b; b.bar = bar; b.x = xb_xcc_id(); b.st = st;
    if (threadIdx.x == 0) (void)xb_add(&bar[XB_XCNT(b.x)], 1u);
    return b;
}
__device__ __forceinline__ void xcd_barrier_complete(unsigned* bar, unsigned x, unsigned& nloc, unsigned& nx) {
    const unsigned G = gridDim.x * gridDim.y * gridDim.z;
    unsigned sum, cnt, mine, sp = 0u;
    for (;;) {
        sum = 0u; cnt = 0u; mine = 0u;
#pragma unroll
        for (unsigned j = 0; j < 16; ++j) { const unsigned c = xb_ld(&bar[XB_XCNT(j)]); sum += c; cnt += (c > 0u) ? 1u : 0u; mine = (j == x) ? c : mine; }
        if (sum == G) break;
        __builtin_amdgcn_s_sleep(1);
        if ((++sp & 255u) == 0u) { if (xb_ld(&bar[XB_TMO])) break; if (sp > XB_SPIN_CAP) { atomicAdd(&bar[XB_TMO], 1u); break; } }
    }
    nloc = mine > 0u ? mine : 1u; nx = cnt > 0u ? cnt : 1u;
}

__device__ __forceinline__ void xcd_barrier(const XcdBarrier& b) {
    asm volatile("s_waitcnt vmcnt(0)" ::: "memory");
    __syncthreads();
    if (threadIdx.x == 0) {
        unsigned* bar = b.bar;
        __builtin_amdgcn_s_waitcnt(0);
        unsigned nloc = b.st[0], nx = b.st[1];
        if (nloc == 0u) { xcd_barrier_complete(bar, b.x, nloc, nx); b.st[0] = nloc; b.st[1] = nx; }
        const unsigned old = xb_add(&bar[XB_XSUB(b.x)], 1u);
        const unsigned gen = old / nloc;
        if (old + 1u == (gen + 1u) * nloc) {
            __builtin_amdgcn_fence(__ATOMIC_RELEASE, "agent");
            asm volatile("s_waitcnt vmcnt(0)" ::: "memory");
            const unsigned og = xb_add(&bar[XB_TOP], 1u);
            const unsigned tg = og / nx;
            if (og + 1u == (tg + 1u) * nx) xb_add(&bar[XB_TOPGEN], 1u);
            else XB_SPIN(xb_ld(&bar[XB_TOPGEN]) == tg, bar);
            __builtin_amdgcn_fence(__ATOMIC_ACQUIRE, "agent");
            xb_add(&bar[XB_XGEN(b.x)], 1u);
            asm volatile("s_waitcnt vmcnt(0)" ::: "memory");
        } else {
            XB_SPIN(xb_ld(&bar[XB_XGEN(b.x)]) == gen, bar);
            __builtin_amdgcn_fence(__ATOMIC_ACQUIRE, "agent");
            asm volatile("s_waitcnt vmcnt(0)" ::: "memory");
        }
    }
    __syncthreads();
}

constexpr int NWAVES = 8;
constexpr int LDS_BYTES = 147456;
constexpr int RING_BYTES = 131072;
constexpr int CTRL_OFF = 135168;
constexpr int MISC_OFF = CTRL_OFF + 320;
constexpr size_t MiB = 1u << 20;
constexpr size_t WS_CTL = 0, CTL_ZERO_BYTES = 1 * MiB;
constexpr int CW_BAR = 16384;
constexpr size_t WS_WIN = 1 * MiB, WS_WQB = 5 * MiB, WS_WKVB = 5 * MiB + 512 * 1024, WS_WO = 6 * MiB, WS_WMQG = 8 * MiB, WS_WMKV = 10 * MiB, WS_WMO = 14 * MiB;
constexpr size_t WS_RSTDX = 16 * MiB, WS_RSTDM = 16 * MiB + 64 * 1024, WS_SSQQ = 16 * MiB + 256 * 1024, WS_SSQKV = 16 * MiB + 512 * 1024, WS_TBL = 16 * MiB + 768 * 1024;
constexpr size_t WS_WRG = 16 * MiB + 896 * 1024;
constexpr size_t WS_SSQH1 = 17 * MiB, WS_SSQH2 = 18 * MiB, WS_ZKPE = 20 * MiB, WS_CS = 22 * MiB;
constexpr size_t WS_XB = 24 * MiB, WS_MEMB = 56 * MiB, WS_KVMEM = 58 * MiB, WS_KPE = 62 * MiB;
constexpr size_t WS_QKVA = 64 * MiB, WS_ZQ = 112 * MiB, WS_ZKV = 120 * MiB, WS_QB = 124 * MiB, WS_KN = 148 * MiB, WS_VB = 164 * MiB;
constexpr size_t WS_WPT = 180 * MiB, WS_VWT = 188 * MiB, WS_H2 = 196 * MiB, WS_H2B = 260 * MiB, WS_ROUTE = 292 * MiB, WS_XS = 296 * MiB;
constexpr size_t WS_HMID = 296 * MiB, WS_OAP = 440 * MiB, WS_LSE = 488 * MiB, WS_OB = 490 * MiB, WS_OMIX = 506 * MiB;
constexpr size_t WS_H1 = 538 * MiB, WS_H1B = 602 * MiB, WS_P = 634 * MiB, WS_YBUF = 666 * MiB;
constexpr size_t WS_WGU = 794 * MiB, WS_WD = 922 * MiB, WS_END = 986 * MiB;

struct Args { const float* in[26]; float* out; unsigned char* ws; double rope_rev[16]; int ph_lo, ph_hi, flags, pad; };

struct CvtDesc { const float* W; const float* gain; bf16_t* WT; int K, N, mode, item; };
__device__ __forceinline__ void cvt_load(const CvtDesc& d, f32x4 (&v)[16], int lane) {
    const int nblk = (d.N + 63) >> 6, kb = d.item / nblk, nb = d.item % nblk, k0 = 64 * kb, n0 = 64 * nb;
    const int lk = lane >> 4, ln = (lane & 15) * 4;
    const bool ok = n0 + ln < d.N;
    const float* wp = d.W + (size_t)(k0 + lk) * d.N + n0 + ln;
#pragma unroll
    for (int i = 0; i < 16; ++i) v[i] = ok ? __builtin_nontemporal_load((const f32x4*)(wp + (size_t)(4 * i) * d.N)) : (f32x4){0.f, 0.f, 0.f, 0.f};
}
__device__ __forceinline__ void cvt_store(const CvtDesc& d, f32x4 (&v)[16], LAS float* scr, int lane) {
    const int nblk = (d.N + 63) >> 6, kb = d.item / nblk, nb = d.item % nblk, k0 = 64 * kb, n0 = 64 * nb;
    const int lk = lane >> 4, ln = (lane & 15) * 4;
    if (d.gain) {
#pragma unroll
        for (int i = 0; i < 16; ++i) v[i] = v[i] * d.gain[k0 + 4 * i + lk];
    }
#pragma unroll
    for (int i = 0; i < 16; ++i) { LAS float* p = scr + (4 * i + lk) * 65 + ln; p[0] = v[i][0]; p[1] = v[i][1]; p[2] = v[i][2]; p[3] = v[i][3]; }
    LDS_WAIT(); asm volatile("" ::: "memory");
    int drow0 = n0; if (d.mode == 1) { const int half = n0 >> 10, c = n0 & 1023; drow0 = (c >> 7) * 256 + half * 128 + (c & 127); }
    const int c = lane & 7;
#pragma unroll
    for (int j = 0; j < 8; ++j) { const int n = (lane >> 3) + 8 * j; const LAS float* sp = scr + (8 * c) * 65 + n;
        v4u o; o.x = pk2(sp[0 * 65], sp[1 * 65]); o.y = pk2(sp[2 * 65], sp[3 * 65]); o.z = pk2(sp[4 * 65], sp[5 * 65]); o.w = pk2(sp[6 * 65], sp[7 * 65]);
        __builtin_nontemporal_store(o, (v4u*)(d.WT + (size_t)(drow0 + n) * d.K + k0 + 8 * c)); }
    LDS_WAIT(); asm volatile("" ::: "memory");
}
__device__ __forceinline__ void prep_rows4(const float* x0, bf16_t* o0, float* rstd_out, int lane) {
    f32x4 v[4][4]; float s[4];
#pragma unroll
    for (int r = 0; r < 4; ++r)
#pragma unroll
        for (int j = 0; j < 4; ++j) v[r][j] = ((const f32x4*)(x0 + (size_t)r * 1024))[lane + 64 * j];
#pragma unroll
    for (int r = 0; r < 4; ++r) { float a = 0.f;
#pragma unroll
        for (int j = 0; j < 4; ++j) a += (v[r][j].x * v[r][j].x + v[r][j].y * v[r][j].y) + (v[r][j].z * v[r][j].z + v[r][j].w * v[r][j].w);
        s[r] = wave_sum(a); }
    if (lane < 4) rstd_out[lane] = 1.0f / sqrtf((lane == 0 ? s[0] : lane == 1 ? s[1] : lane == 2 ? s[2] : s[3]) * (1.0f / 1024.0f) + 1e-6f);
#pragma unroll
    for (int r = 0; r < 4; ++r) { unsigned long long* o8 = (unsigned long long*)(o0 + (size_t)r * 1024) + lane;
#pragma unroll
        for (int j = 0; j < 4; ++j) o8[64 * j] = (unsigned long long)pk2(v[r][j].x, v[r][j].y) | ((unsigned long long)pk2(v[r][j].z, v[r][j].w) << 32); }
}

__device__ __forceinline__ v4u pack8(const f32x4 a, const f32x4 b) { v4u w; w.x = pk2(a[0], a[1]); w.y = pk2(a[2], a[3]); w.z = pk2(b[0], b[1]); w.w = pk2(b[2], b[3]); return w; }
__device__ __forceinline__ float sq8(const f32x4 a, const f32x4 b) { return (a[0] * a[0] + a[1] * a[1]) + (a[2] * a[2] + a[3] * a[3]) + (b[0] * b[0] + b[1] * b[1]) + (b[2] * b[2] + b[3] * b[3]); }

struct EpiInProj {
    static constexpr bool PERM = true, AFTER_DRAIN = false;
    const float* rstd; bf16_t* qkv; bf16_t* zq; bf16_t* zkv; float* zkpe; float* ssq_q; float* ssq_kv;
    __device__ __forceinline__ void operator()(const pg8::f32x4 (&acc)[2][2][4][2], const pg8::Unit& u, int wr, int wc, int fr, int fq) const {
        const int row0 = u.pm * 256 + wr * 64 + fr;
        const float qs = u.pn < 2 ? 0.125f * 1.4426950408889634f : 1.0f;
#pragma unroll
        for (int ai = 0; ai < 2; ++ai)
#pragma unroll
            for (int m = 0; m < 4; ++m) {
                const int row = row0 + ai * 128 + m * 16;
                const float rs = rstd[row];
                float ss = 0.f;
#pragma unroll
                for (int bj = 0; bj < 2; ++bj) {
                    const f32x4 v0 = acc[ai][bj][m][0] * rs, v1 = acc[ai][bj][m][1] * rs;
                    const int ct = bj * 128 + wc * 32 + 8 * fq;
                    if (u.pn < 6) { *(v4u*)(qkv + (size_t)row * 1536 + u.pn * 256 + ct) = pack8(v0 * qs, v1 * qs); }
                    else if (u.pn == 6) { *(v4u*)(zq + (size_t)row * 256 + ct) = pack8(v0, v1); ss += sq8(v0, v1); }
                    else if (bj == 0) { *(v4u*)(zkv + (size_t)row * 128 + ct) = pack8(v0, v1); ss += sq8(v0, v1); }
                    else if (wc == 0) { *(f32x4*)(zkpe + (size_t)row * 32 + 8 * fq) = v0; *(f32x4*)(zkpe + (size_t)row * 32 + 8 * fq + 4) = v1; }
                }
                if (u.pn >= 6) { ss += __shfl_xor(ss, 16); ss += __shfl_xor(ss, 32); if (fq == 0) (u.pn == 6 ? ssq_q : ssq_kv)[(size_t)row * 4 + wc] = ss; }
            }
    }
};


struct EpiQ {
    static constexpr bool PERM = true, AFTER_DRAIN = false;
    const float* ssq; bf16_t* Q;
    __device__ __forceinline__ void operator()(const pg8::f32x4 (&acc)[2][2][4][2], const pg8::Unit& u, int wr, int wc, int fr, int fq) const {
        const int row0 = u.pm * 256 + wr * 64 + fr;
#pragma unroll
        for (int ai = 0; ai < 2; ++ai)
#pragma unroll
            for (int m = 0; m < 4; ++m) {
                const int row = row0 + ai * 128 + m * 16;
                const f32x4 sp = *(const f32x4*)(ssq + (size_t)row * 4);
                const float rs = (0.10206207261596577f * 1.4426950408889634f) / sqrtf(((sp[0] + sp[1]) + (sp[2] + sp[3])) * (1.0f / 256.0f) + 1e-6f);
#pragma unroll
                for (int bj = 0; bj < 2; ++bj)
                    *(v4u*)(Q + (size_t)row * 768 + u.pn * 256 + bj * 128 + wc * 32 + 8 * fq) = pack8(acc[ai][bj][m][0] * rs, acc[ai][bj][m][1] * rs);
            }
    }
};
struct EpiKV {
    static constexpr bool PERM = true, AFTER_DRAIN = false;
    const float* ssq; bf16_t* Kn; bf16_t* Vb;
    __device__ __forceinline__ void operator()(const pg8::f32x4 (&acc)[2][2][4][2], const pg8::Unit& u, int wr, int wc, int fr, int fq) const {
        const int row0 = u.pm * 256 + wr * 64 + fr;
        bf16_t* dst = (wc < 2 ? Kn : Vb) + (wc & 1) * 32 + 8 * fq;
#pragma unroll
        for (int ai = 0; ai < 2; ++ai)
#pragma unroll
            for (int m = 0; m < 4; ++m) {
                const int row = row0 + ai * 128 + m * 16;
                const f32x4 sp = *(const f32x4*)(ssq + (size_t)row * 4);
                const float rs = 1.0f / sqrtf(((sp[0] + sp[1]) + (sp[2] + sp[3])) * (1.0f / 128.0f) + 1e-6f);
#pragma unroll
                for (int bj = 0; bj < 2; ++bj)
                    *(v4u*)(dst + (size_t)row * 512 + (u.pn * 2 + bj) * 64) = pack8(acc[ai][bj][m][0] * rs, acc[ai][bj][m][1] * rs);
            }
    }
};
struct EpiRowScale {
    static constexpr bool PERM = true, AFTER_DRAIN = false;
    const float* rs; bf16_t* O; int ldc;
    __device__ __forceinline__ void operator()(const pg8::f32x4 (&acc)[2][2][4][2], const pg8::Unit& u, int wr, int wc, int fr, int fq) const {
        const int row0 = u.pm * 256 + wr * 64 + fr;
#pragma unroll
        for (int ai = 0; ai < 2; ++ai)
#pragma unroll
            for (int m = 0; m < 4; ++m) {
                const int row = row0 + ai * 128 + m * 16;
                const float r = rs[row];
#pragma unroll
                for (int bj = 0; bj < 2; ++bj)
                    *(v4u*)(O + (size_t)row * ldc + u.pn * 256 + bj * 128 + wc * 32 + 8 * fq) = pack8(acc[ai][bj][m][0] * r, acc[ai][bj][m][1] * r);
            }
    }
};

template <bool BASE_BF16> struct EpiResid {
    static constexpr bool PERM = true, AFTER_DRAIN = false;
    const void* base; bf16_t* outb; float* ssq;
    __device__ __forceinline__ void operator()(const pg8::f32x4 (&acc)[2][2][4][2], const pg8::Unit& u, int wr, int wc, int fr, int fq) const {
        const int row0 = u.pm * 256 + wr * 64 + fr;
#pragma unroll
        for (int ai = 0; ai < 2; ++ai)
#pragma unroll
            for (int m = 0; m < 4; ++m) {
                const int row = row0 + ai * 128 + m * 16;
                float ss = 0.f;
#pragma unroll
                for (int bj = 0; bj < 2; ++bj) {
                    const size_t o = (size_t)row * 1024 + u.pn * 256 + bj * 128 + wc * 32 + 8 * fq;
                    f32x4 b0, b1;
                    if constexpr (BASE_BF16) { const v4u w = *(const v4u*)((const bf16_t*)base + o);
                        b0 = (f32x4){__builtin_bit_cast(float, w[0] << 16), __builtin_bit_cast(float, w[0] & 0xffff0000u), __builtin_bit_cast(float, w[1] << 16), __builtin_bit_cast(float, w[1] & 0xffff0000u)};
                        b1 = (f32x4){__builtin_bit_cast(float, w[2] << 16), __builtin_bit_cast(float, w[2] & 0xffff0000u), __builtin_bit_cast(float, w[3] << 16), __builtin_bit_cast(float, w[3] & 0xffff0000u)}; }
                    else { b0 = *(const f32x4*)((const float*)base + o); b1 = *(const f32x4*)((const float*)base + o + 4); }
                    const f32x4 v0 = acc[ai][bj][m][0] + b0, v1 = acc[ai][bj][m][1] + b1;
                    *(v4u*)(outb + o) = pack8(v0, v1); ss += sq8(v0, v1);
                }
                ss += __shfl_xor(ss, 16); ss += __shfl_xor(ss, 32);
                if (fq == 0) ssq[(size_t)row * 16 + u.pn * 4 + wc] = ss;
                asm volatile("" ::: "memory");
            }
    }
};
struct EpiPlain {
    static constexpr bool PERM = true, AFTER_DRAIN = false;
    bf16_t* O; int ldc;
    __device__ __forceinline__ void operator()(const pg8::f32x4 (&acc)[2][2][4][2], const pg8::Unit& u, int wr, int wc, int fr, int fq) const {
        const int row0 = u.pm * 256 + wr * 64 + fr;
#pragma unroll
        for (int ai = 0; ai < 2; ++ai)
#pragma unroll
            for (int m = 0; m < 4; ++m)
#pragma unroll
                for (int bj = 0; bj < 2; ++bj)
                    *(v4u*)(O + (size_t)(row0 + ai * 128 + m * 16) * ldc + u.pn * 256 + bj * 128 + wc * 32 + 8 * fq) = pack8(acc[ai][bj][m][0], acc[ai][bj][m][1]);
    }
};
struct EpiSoftmax {
    static constexpr bool PERM = true, AFTER_DRAIN = true;
    bf16_t* P; int rsl_off;
    __device__ __forceinline__ void fused(pg8::f32x4 (&acc)[2][2][4][2], const pg8::Unit& u, int wr, int wc, int fr, int fq, PG8_LAS unsigned char* lds, int wid, int lane) const {
        typedef float f32x2v __attribute__((ext_vector_type(2)));
        const PG8_LAS float* rsl = (const PG8_LAS float*)(lds + rsl_off);
        PG8_LAS f32x2v* X = (PG8_LAS f32x2v*)lds;
        constexpr float L2E = 1.4426950408889634f;
#pragma unroll
        for (int ai = 0; ai < 2; ++ai)
#pragma unroll
            for (int m = 0; m < 4; ++m) {
                const int rt = ai * 128 + wr * 64 + m * 16 + fr;
                const float rs = rsl[rt] * (0.0625f * L2E);
                float mx = -3.0e38f;
#pragma unroll
                for (int bj = 0; bj < 2; ++bj)
#pragma unroll
                    for (int n = 0; n < 2; ++n) { f32x4 v = acc[ai][bj][m][n] * rs; acc[ai][bj][m][n] = v; mx = fmaxf(mx, fmaxf(fmaxf(v[0], v[1]), fmaxf(v[2], v[3]))); }
                mx = fmaxf(mx, __shfl_xor(mx, 16)); mx = fmaxf(mx, __shfl_xor(mx, 32));
                float sm = 0.f;
#pragma unroll
                for (int bj = 0; bj < 2; ++bj)
#pragma unroll
                    for (int n = 0; n < 2; ++n) { const f32x4 v = acc[ai][bj][m][n]; sm += (__builtin_amdgcn_exp2f(v[0] - mx) + __builtin_amdgcn_exp2f(v[1] - mx)) + (__builtin_amdgcn_exp2f(v[2] - mx) + __builtin_amdgcn_exp2f(v[3] - mx)); }
                sm += __shfl_xor(sm, 16); sm += __shfl_xor(sm, 32);
                if (fq == 0) X[rt * 4 + wc] = (f32x2v){mx, sm};
            }
        asm volatile("s_waitcnt lgkmcnt(0)" ::: "memory"); __builtin_amdgcn_s_barrier(); asm volatile("" ::: "memory");
#pragma unroll
        for (int ai = 0; ai < 2; ++ai)
#pragma unroll
            for (int m = 0; m < 4; ++m) {
                const int rt = ai * 128 + wr * 64 + m * 16 + fr;
                const f32x2v x0 = X[rt * 4 + 0], x1 = X[rt * 4 + 1], x2 = X[rt * 4 + 2], x3 = X[rt * 4 + 3];
                const float M = fmaxf(fmaxf(x0.x, x1.x), fmaxf(x2.x, x3.x));
                const float tot = (x0.y * __builtin_amdgcn_exp2f(x0.x - M) + x1.y * __builtin_amdgcn_exp2f(x1.x - M)) + (x2.y * __builtin_amdgcn_exp2f(x2.x - M) + x3.y * __builtin_amdgcn_exp2f(x3.x - M));
                const float inv = 1.0f / tot;
#pragma unroll
                for (int bj = 0; bj < 2; ++bj) {
                    f32x4 a = acc[ai][bj][m][0], b = acc[ai][bj][m][1];
#pragma unroll
                    for (int j = 0; j < 4; ++j) { a[j] = __builtin_amdgcn_exp2f(a[j] - M) * inv; b[j] = __builtin_amdgcn_exp2f(b[j] - M) * inv; }
                    *(v4u*)(P + (size_t)(u.pm * 256 + rt) * 1024 + u.pn * 256 + bj * 128 + wc * 32 + 8 * fq) = pack8(a, b);
                }
            }
    }
};
struct OrderWp {
    int c;
    __device__ __forceinline__ bool next(int i, pg8::Unit& u) const { if (i > 0 || c >= 64) return false; const int bhh = c >> 2, pn = c & 3, b = bhh >> 2, h = bhh & 3;
        u.pm = bhh; u.pn = pn; u.aoff = ((size_t)(b * 256) * 2048 + h * 256) * 2; u.boff = ((size_t)(pn * 256) * 1024 + h * 256) * 2; return true; }
    __device__ __forceinline__ void a_ready(const pg8::Unit&) const {}
    __device__ __forceinline__ void done(const pg8::Unit&) const {}
};
struct OrderVw {
    int c;
    __device__ __forceinline__ bool next(int i, pg8::Unit& u) const { if (i > 0 || c >= 64) return false; const int b = c >> 4, ct = (c >> 2) & 3, h = c & 3;
        u.pm = b * 4 + ct; u.pn = h; u.aoff = ((size_t)(ct * 256) * 1024 + h * 256) * 2; u.boff = ((size_t)(b * 256) * 2048 + 1024 + h * 256) * 2; return true; }
    __device__ __forceinline__ void a_ready(const pg8::Unit&) const {}
    __device__ __forceinline__ void done(const pg8::Unit&) const {}
};
struct OrderBatch {
    pg8::StaticOrder so;
    __device__ __forceinline__ bool next(int i, pg8::Unit& u) const { if (!so.next(i, u)) return false; u.boff = ((size_t)((u.pm >> 4) * 1024 + u.pn * 256) * 1024) * 2; return true; }
    __device__ __forceinline__ void a_ready(const pg8::Unit&) const {}
    __device__ __forceinline__ void done(const pg8::Unit&) const {}
};

constexpr int MPADN = NA + NE * 256, NTILEN = MPADN / 256;
constexpr int CW_GCOUNT = 8192;
constexpr size_t RT_TOPI = 0, RT_TOPG = 256 * 1024, RT_SLOT = 512 * 1024, RT_ROWFLAT = 768 * 1024, RT_RSROW = 1088 * 1024, RT_RSTD = 1408 * 1024, RT_CNT = 1536 * 1024, RT_TOT = 1600 * 1024;
constexpr int LX_TEXP = CTRL_OFF + 2048;
struct OrderMoe {
    const LAS int* texp; int nper, c, G; size_t ebytes;
    __device__ __forceinline__ bool next(int i, pg8::Unit& u) const {
        const int L = i * G + (c & 7) * (G >> 3) + (c >> 3); const int tile = L / nper, pn = L % nper;
        if (tile >= texp[NTILEN]) return false;
        u.pm = tile; u.pn = pn; u.aoff = (size_t)tile * 256 * 1024 * 2; u.boff = (size_t)texp[tile] * ebytes + (size_t)pn * 256 * 1024 * 2; return true; }
    __device__ __forceinline__ void a_ready(const pg8::Unit&) const {}
    __device__ __forceinline__ void done(const pg8::Unit&) const {}
};
__device__ __forceinline__ float swiglu1(float g, float u) { g = fminf(g, 7.0f); u = fminf(fmaxf(u, -7.0f), 7.0f); return (u + 1.0f) * g * __builtin_amdgcn_rcpf(1.0f + __builtin_amdgcn_exp2f(-1.702f * 1.4426950408889634f * g)); }
struct EpiSwiGLU {
    static constexpr bool PERM = true, AFTER_DRAIN = false;
    const float* rs_row; const float* bgu; bf16_t* hmid; const LAS int* texp;
    __device__ __forceinline__ void operator()(const pg8::f32x4 (&acc)[2][2][4][2], const pg8::Unit& u, int wr, int wc, int fr, int fq) const {
        const int row0 = u.pm * 256 + wr * 64 + fr, e = texp[u.pm], c0 = u.pn * 128 + wc * 32 + 8 * fq;
        const float* bg = bgu + (size_t)e * 2048 + c0;
        const f32x4 bg0 = *(const f32x4*)bg, bg1 = *(const f32x4*)(bg + 4), bu0 = *(const f32x4*)(bg + 1024), bu1 = *(const f32x4*)(bg + 1028);
#pragma unroll
        for (int ai = 0; ai < 2; ++ai)
#pragma unroll
            for (int m = 0; m < 4; ++m) {
                const int row = row0 + ai * 128 + m * 16; const float rs = rs_row[row];
                const f32x4 g0 = acc[ai][0][m][0] * rs + bg0, g1 = acc[ai][0][m][1] * rs + bg1, u0 = acc[ai][1][m][0] * rs + bu0, u1 = acc[ai][1][m][1] * rs + bu1;
                f32x4 h0, h1;
#pragma unroll
                for (int j = 0; j < 4; ++j) { h0[j] = swiglu1(g0[j], u0[j]); h1[j] = swiglu1(g1[j], u1[j]); }
                *(v4u*)(hmid + (size_t)row * 1024 + c0) = pack8(h0, h1);
            }
    }
};
struct EpiDown {
    static constexpr bool PERM = true, AFTER_DRAIN = false;
    const int* row_flat; const float* topg; const float* bd; bf16_t* ybuf; const LAS int* texp;
    __device__ __forceinline__ void operator()(const pg8::f32x4 (&acc)[2][2][4][2], const pg8::Unit& u, int wr, int wc, int fr, int fq) const {
        const int row0 = u.pm * 256 + wr * 64 + fr, e = texp[u.pm], c0 = u.pn * 256 + wc * 32 + 8 * fq;
        const float* bp = bd + (size_t)e * 1024 + c0;
        f32x4 bv[2][2];
#pragma unroll
        for (int bj = 0; bj < 2; ++bj) { bv[bj][0] = *(const f32x4*)(bp + bj * 128); bv[bj][1] = *(const f32x4*)(bp + bj * 128 + 4); }
#pragma unroll
        for (int ai = 0; ai < 2; ++ai)
#pragma unroll
            for (int m = 0; m < 4; ++m) {
                const int row = row0 + ai * 128 + m * 16; const int a = row_flat[row];
                if (a >= 0) { const float gt = topg[a];
#pragma unroll
                    for (int bj = 0; bj < 2; ++bj)
                        *(v4u*)(ybuf + (size_t)a * 1024 + c0 + bj * 128) = pack8((acc[ai][bj][m][0] + bv[bj][0]) * gt, (acc[ai][bj][m][1] + bv[bj][1]) * gt); }
            }
    }
};

__device__ __forceinline__ int rel_bucket_d(int rel) {
    int n = rel < 0 ? -rel : rel;
    int b;
    if (n < 8) b = n; else if (n < 15) b = 8; else if (n < 27) b = 9; else if (n < 50) b = 10; else if (n < 91) b = 11;
    else if (n < 166) b = 12; else if (n < 305) b = 13; else if (n < 559) b = 14; else b = 15;
    return b + (rel > 0 ? 16 : 0);
}

static_assert(pg8::GTAB == CTRL_OFF + 4096 && pg8::GTAB + pg8::GTAB_UNITS * 512 <= LDS_BYTES && (NTILEN * 8 + 255) / 256 <= pg8::GTAB_UNITS && NWAVES * dil::W_BYTES <= CTRL_OFF && mla::SHM_ATTN <= CTRL_OFF && RING_BYTES <= CTRL_OFF && LX_TEXP + 4 * (NTILEN + 1) <= LDS_BYTES, "LDS map");
__global__ void __launch_bounds__(NWAVES * 64, 2) mk_fwd(Args args) {
    extern __shared__ __attribute__((aligned(16))) unsigned char lds_raw[];
    LAS unsigned char* lds = (LAS unsigned char*)lds_raw;
    const int tid = threadIdx.x, lane = tid & 63, wave = __builtin_amdgcn_readfirstlane(tid >> 6);
    const int G = gridDim.x; const int bx = blockIdx.x; const int vcu = (G % 8 == 0) ? (bx % 8) * (G / 8) + bx / 8 : bx;
    unsigned char* ws = args.ws;
    const int lo = args.ph_lo, hi = args.ph_hi;
#define IN(k) (lo <= (k) && (k) < hi)
#define BOTH(k) (IN(k) && IN((k) + 1))
    for (int u = tid; u < (LDS_BYTES - CTRL_OFF) / 4; u += NWAVES * 64) ((LAS unsigned*)(lds + CTRL_OFF))[u] = 0u;
    __syncthreads();
    XcdBarrier bar; bar.bar = (unsigned*)(ws + WS_CTL) + CW_BAR; bar.x = 0; bar.st = nullptr;
    if (hi - lo > 1) bar = xcd_barrier_post((unsigned*)(ws + WS_CTL) + CW_BAR, (volatile LAS unsigned*)(lds + MISC_OFF) + 8);
#define GRID_BAR(k) do { if (BOTH(k)) xcd_barrier(bar); } while (0)
    const float* x = args.in[0]; const float* mem = args.in[1]; const float* g_mix = args.in[3]; const float* w_in = args.in[4];
    const float* g_q_a = args.in[5]; const float* w_q_b = args.in[6]; const float* g_kv_a = args.in[7]; const float* w_kv_b = args.in[8];
    const float* w_o = args.in[12]; const float* g_xattn = args.in[13]; const float* g_mem = args.in[14]; const float* w_mq = args.in[15];
    const float* w_mkv = args.in[16]; const float* w_mo = args.in[17]; const float* g_moe = args.in[18];
    const float* w_gate_up = args.in[21]; const float* w_down = args.in[23];
    bf16_t* WinT = (bf16_t*)(ws + WS_WIN); bf16_t* WqbT = (bf16_t*)(ws + WS_WQB); bf16_t* WkvbT = (bf16_t*)(ws + WS_WKVB); bf16_t* WoT = (bf16_t*)(ws + WS_WO);
    bf16_t* Wmqg = (bf16_t*)(ws + WS_WMQG); bf16_t* WmkvT = (bf16_t*)(ws + WS_WMKV); bf16_t* WmoT = (bf16_t*)(ws + WS_WMO);
    bf16_t* WguT = (bf16_t*)(ws + WS_WGU); bf16_t* WdT = (bf16_t*)(ws + WS_WD);
    bf16_t* xb = (bf16_t*)(ws + WS_XB); bf16_t* memb = (bf16_t*)(ws + WS_MEMB);
    float* rstd_x = (float*)(ws + WS_RSTDX); float* rstd_mem = (float*)(ws + WS_RSTDM);

    if (IN(0)) {
        LAS float* scr = (LAS float*)(lds + wave * 16640);
        const int gw = vcu * NWAVES + wave, NGW = G * NWAVES;
        constexpr int I_IN = 16 * 31, I_QB = 4 * 12, I_KVB = 2 * 16, I_O = 16 * 16, I_MKV = 16 * 32, I_MO = 16 * 16, I_GU = 16 * 32, I_D = 16 * 16;
        const int n_exp = (args.flags & 1) ? 32 : 0;
        const int NITEMS = I_IN + I_QB + I_KVB + I_O + I_MKV + I_MO + n_exp * (I_GU + I_D);
        auto desc = [&](int it) {
            CvtDesc d; int r = it; d.mode = 0;
            if (r < I_IN) { d.W = w_in; d.K = 1024; d.N = 1952; d.gain = g_mix; d.WT = WinT; }
            else if ((r -= I_IN) < I_QB) { d.W = w_q_b; d.K = 256; d.N = 768; d.gain = g_q_a; d.WT = WqbT; }
            else if ((r -= I_QB) < I_KVB) { d.W = w_kv_b; d.K = 128; d.N = 1024; d.gain = g_kv_a; d.WT = WkvbT; }
            else if ((r -= I_KVB) < I_O) { d.W = w_o; d.K = 1024; d.N = 1024; d.gain = nullptr; d.WT = WoT; }
            else if ((r -= I_O) < I_MKV) { d.W = w_mkv; d.K = 1024; d.N = 2048; d.gain = g_mem; d.WT = WmkvT; }
            else if ((r -= I_MKV) < I_MO) { d.W = w_mo; d.K = 1024; d.N = 1024; d.gain = nullptr; d.WT = WmoT; }
            else if ((r -= I_MO) < 32 * I_GU) { const int e = r / I_GU; r -= e * I_GU; d.W = w_gate_up + (size_t)e * 1024 * 2048; d.K = 1024; d.N = 2048; d.gain = g_moe; d.WT = WguT + (size_t)e * 2048 * 1024; d.mode = 1; }
            else { r -= 32 * I_GU; const int e = r / I_D; r -= e * I_D; d.W = w_down + (size_t)e * 1024 * 1024; d.K = 1024; d.N = 1024; d.gain = nullptr; d.WT = WdT + (size_t)e * 1024 * 1024; }
            d.item = r; return d; };
        {
            f32x4 va[16], vb[16]; CvtDesc dc = desc(0), dn = dc; bool have = false;
            for (int it = gw; ; it += NGW) {
                const bool more = it < NITEMS;
                if (more) { dn = desc(it); cvt_load(dn, vb, lane); }
                if (have) cvt_store(dc, va, scr, lane);
                if (!more) break;
#pragma unroll
                for (int i = 0; i < 16; ++i) va[i] = vb[i];
                dc = dn; have = true;
            }
        }
        for (int i = gw * 64 + lane; i < 64 * 1024 / 8; i += NGW * 64) ((v4u*)(WinT + (size_t)1984 * 1024))[i] = (v4u){0u, 0u, 0u, 0u};
        for (int m = gw * 4; m < T; m += NGW * 4) prep_rows4(x + (size_t)m * D, xb + (size_t)m * D, rstd_x + m, lane);
        for (int m = gw * 4; m < NB * NMEM; m += NGW * 4) prep_rows4(mem + (size_t)m * D, memb + (size_t)m * D, rstd_mem + m, lane);
        { const float* w_router = args.in[19]; float* wrg = (float*)(ws + WS_WRG); for (int i = bx * 512 + tid; i < 1024 * 32; i += G * 512) wrg[i] = w_router[i] * g_moe[i >> 5]; }
        for (int m = gw; m < D; m += NGW) {
            const f32x4* xr = (const f32x4*)(w_mq + (size_t)m * D) + lane; const float gc = g_xattn[m];
            unsigned long long* o8 = (unsigned long long*)(Wmqg + (size_t)m * D) + lane;
#pragma unroll
            for (int j = 0; j < 4; ++j) { const f32x4 v = xr[64 * j] * gc; o8[64 * j] = (unsigned long long)pk2(v.x, v.y) | ((unsigned long long)pk2(v.z, v.w) << 32); }
        }
    }
    if (IN(0)) {
        const float* rel_bias = args.in[9]; float* tbl = (float*)(ws + WS_TBL);
        for (int i = bx * 512 + tid; i < 8 * 2049; i += G * 512) { const int h = i / 2049, r = i % 2049; tbl[h * 2112 + r] = rel_bias[rel_bucket_d(r - 1024) * 8 + h]; }
    }
    GRID_BAR(0);
    if (IN(1)) {
        int kx = 1024; asm volatile("" : "+s"(kx)); pg8::Gemm g{xb, WinT, kx, kx, kx}; pg8::StaticOrder S; S.init(T, 2048, 1024, 1024, G, bx);
        EpiInProj E{rstd_x, (bf16_t*)(ws + WS_QKVA), (bf16_t*)(ws + WS_ZQ), (bf16_t*)(ws + WS_ZKV), (float*)(ws + WS_ZKPE), (float*)(ws + WS_SSQQ), (float*)(ws + WS_SSQKV)};
        pg8::gemm_phase<EpiInProj, pg8::StaticOrder, true, true>(lds, g, S, E);
    }
    GRID_BAR(1);
    if (IN(2)) {
        const int* pos = (const int*)args.in[2];
        float* cs = (float*)(ws + WS_CS); const float* zkpe = (const float*)(ws + WS_ZKPE); bf16_t* kpe = (bf16_t*)(ws + WS_KPE);
        for (int i = bx * 512 + tid; i < T * 16; i += G * 512) {
            const int t = i >> 4, j = i & 15;
            const double rev = (double)pos[t] * args.rope_rev[j];
            const float fr_ = (float)(rev - floor(rev));
            const float sn = __builtin_amdgcn_sinf(fr_), c_ = __builtin_amdgcn_cosf(fr_);
            cs[(size_t)t * 32 + j] = c_; cs[(size_t)t * 32 + 16 + j] = sn;
            const float x1 = zkpe[(size_t)t * 32 + j], x2 = zkpe[(size_t)t * 32 + 16 + j];
            kpe[(size_t)t * 32 + j] = (bf16_t)f2bf(x1 * c_ - x2 * sn); kpe[(size_t)t * 32 + 16 + j] = (bf16_t)f2bf(x1 * sn + x2 * c_);
        }
        {   int kq = 256; asm volatile("" : "+s"(kq)); pg8::Gemm g{(const bf16_t*)(ws + WS_ZQ), WqbT, kq, kq, kq}; pg8::StaticOrder S; S.init(T, 768, 256, 256, G, bx);
            EpiQ E{(const float*)(ws + WS_SSQQ), (bf16_t*)(ws + WS_QB)};
            pg8::gemm_phase<EpiQ, pg8::StaticOrder, true, true>(lds, g, S, E); }
        {   int kk = 128; asm volatile("" : "+s"(kk)); pg8::Gemm g{(const bf16_t*)(ws + WS_ZKV), WkvbT, kk, kk, kk}; const bool memcu = ((bx + 64) % G) < 32 && G > 64; const int bx2 = bx - (bx >= G - 64 + 32 ? 32 : 0);
            pg8::StaticOrder S; S.init(memcu ? 0 : T, 1024, 128, 128, G > 64 ? G - 32 : G, G > 64 ? bx2 : bx);
            EpiKV E{(const float*)(ws + WS_SSQKV), (bf16_t*)(ws + WS_KN), (bf16_t*)(ws + WS_VB)};
            pg8::gemm_phase<EpiKV, pg8::StaticOrder, true, true>(lds, g, S, E); }
        {   int kx = 1024; asm volatile("" : "+s"(kx)); pg8::Gemm g{memb, WmkvT, kx, kx, kx}; pg8::StaticOrder S; S.init(NB * NMEM, 2048, 1024, 1024, G, (bx + 64) % G);
            EpiRowScale E{rstd_mem, (bf16_t*)(ws + WS_KVMEM), 2048};
            pg8::gemm_phase<EpiRowScale, pg8::StaticOrder, true, true>(lds, g, S, E); }
    }
    GRID_BAR(2);
    if (IN(3)) {
        const unsigned short* Qg = (const unsigned short*)(ws + WS_QB); const unsigned short* Kn = (const unsigned short*)(ws + WS_KN);
        const unsigned short* Kp = (const unsigned short*)(ws + WS_KPE); const unsigned short* Vg = (const unsigned short*)(ws + WS_VB);
        const float* cs = (const float*)(ws + WS_CS); unsigned short* Og = (unsigned short*)(ws + WS_OB);
        for (int i = 0; !(args.flags & 8); ++i) {
            int bh, qb;
            if (G == 256) { if (i >= 2) break; const int idx = i * 32 + (bx >> 3); bh = (bx & 7) + 8 * (idx >> 4); qb = idx & 15; }
            else { const int un = i * G + bx; if (un >= 512) break; bh = un >> 4; qb = un & 15; }
            const int b = bh >> 3, h = bh & 7;
#ifdef MLA_ABL
            if (args.flags & 16) mla::mla_unit<MLA_ABL>(Qg, Kn, Kp, Vg, cs, Og, b * S + qb * 256, b * S, h, S, (char*)lds_raw); else
#endif
            mla::mla_unit<0>(Qg, Kn, Kp, Vg, cs, Og, b * S + qb * 256, b * S, h, S, (char*)lds_raw);
        }
        {
            const unsigned short* qkv = (const unsigned short*)(ws + WS_QKVA); const int* pos = (const int*)args.in[2];
            const float* tbl = (const float*)(ws + WS_TBL); unsigned short* oap = (unsigned short*)(ws + WS_OAP); float* lse = (float*)(ws + WS_LSE);
            char* wl = (char*)lds_raw + wave * dil::W_BYTES;
            __syncthreads();
            int cur_h = -1;
            dil::TaskId tc = dil::task_at(0, bx, G, wave), tn = tc; dil::Pre P;
            bool have = !(args.flags & 4) && tc.ub >= 0;
            if (have) dil::dil_prefetch(qkv, pos, tc, P);
            for (int i = 0; have; ++i) {
                tn = dil::task_at(i + 1, bx, G, wave); const bool has_next = tn.ub >= 0;
                if (tc.h != cur_h) { float* tw = (float*)(wl + dil::W_TBL); for (int j = lane; j < 2049; j += 64) tw[j ^ ((j >> 5) & 31)] = tbl[tc.h * dil::TBL_PITCH + j] * 1.4426950408889634f; cur_h = tc.h; asm volatile("s_waitcnt vmcnt(0) lgkmcnt(0)" ::: "memory"); }
                dil::dil_task(qkv, pos, oap, lse, tc, P, has_next, tn, wl);
                tc = tn; have = has_next;
            }
        }
    }
    GRID_BAR(3);
    if (IN(4)) {
        { int kx = 256; asm volatile("" : "+s"(kx));
          if (bx < 64) { pg8::Gemm g{(const bf16_t*)(ws + WS_KVMEM), Wmqg, 2048, 1024, kx}; OrderWp S{bx}; EpiPlain E{(bf16_t*)(ws + WS_WPT), 1024};
              pg8::gemm_phase<EpiPlain, OrderWp, true, true>(lds, g, S, E); }
          else if (bx < 128) { pg8::Gemm g{WmoT, (const bf16_t*)(ws + WS_KVMEM), 1024, 2048, kx}; OrderVw S{bx - 64}; EpiPlain E{(bf16_t*)(ws + WS_VWT), 1024};
              pg8::gemm_phase<EpiPlain, OrderVw, true, true>(lds, g, S, E); } }
        const bf16_t* oap = (const bf16_t*)(ws + WS_OAP); const float* lse = (const float*)(ws + WS_LSE); const bf16_t* obp = (const bf16_t*)(ws + WS_OB);
        const float* g_out_a = args.in[10]; const float* g_out_b = args.in[11]; bf16_t* omix = (bf16_t*)(ws + WS_OMIX);
        const int gw = vcu * NWAVES + wave, NGW = G * NWAVES;
        const f32x4 ga0 = *(const f32x4*)(g_out_a + 8 * lane), ga1 = *(const f32x4*)(g_out_a + 8 * lane + 4), gb0 = *(const f32x4*)(g_out_b + 8 * lane), gb1 = *(const f32x4*)(g_out_b + 8 * lane + 4);
#define UNPK_LO(V_) ((f32x4){__builtin_bit_cast(float, (V_)[0] << 16), __builtin_bit_cast(float, (V_)[0] & 0xffff0000u), __builtin_bit_cast(float, (V_)[1] << 16), __builtin_bit_cast(float, (V_)[1] & 0xffff0000u)})
#define UNPK_HI(V_) ((f32x4){__builtin_bit_cast(float, (V_)[2] << 16), __builtin_bit_cast(float, (V_)[2] & 0xffff0000u), __builtin_bit_cast(float, (V_)[3] << 16), __builtin_bit_cast(float, (V_)[3] & 0xffff0000u)})
        for (int tok = gw; tok < T; tok += NGW) {
            const int head = lane >> 3;
            const float l0 = lse[((size_t)0 * T + tok) * 8 + head], l1 = lse[((size_t)1 * T + tok) * 8 + head], l2 = lse[((size_t)2 * T + tok) * 8 + head];
            const float mx = fmaxf(l0, fmaxf(l1, l2)); float w0 = __expf(l0 - mx), w1 = __expf(l1 - mx), w2 = __expf(l2 - mx); const float wi = 1.0f / (w0 + w1 + w2); w0 *= wi; w1 *= wi; w2 *= wi;
            const v4u q0 = *(const v4u*)(oap + ((size_t)0 * T + tok) * 512 + 8 * lane), q1 = *(const v4u*)(oap + ((size_t)1 * T + tok) * 512 + 8 * lane);
            const v4u q2 = *(const v4u*)(oap + ((size_t)2 * T + tok) * 512 + 8 * lane), qb = *(const v4u*)(obp + (size_t)tok * 512 + 8 * lane);
            const f32x4 a0 = UNPK_LO(q0) * w0 + UNPK_LO(q1) * w1 + UNPK_LO(q2) * w2, a1 = UNPK_HI(q0) * w0 + UNPK_HI(q1) * w1 + UNPK_HI(q2) * w2, b0 = UNPK_LO(qb), b1 = UNPK_HI(qb);
            const float sa = wave_sum(sq8(a0, a1)), sb = wave_sum(sq8(b0, b1));
            const float ra = 1.0f / sqrtf(sa * (1.0f / 512.0f) + 1e-6f), rb = 1.0f / sqrtf(sb * (1.0f / 512.0f) + 1e-6f);
            *(v4u*)(omix + (size_t)tok * 1024 + 8 * lane) = pack8(a0 * ra * ga0, a1 * ra * ga1);
            *(v4u*)(omix + (size_t)tok * 1024 + 512 + 8 * lane) = pack8(b0 * rb * gb0, b1 * rb * gb1);
        }
#undef UNPK_LO
#undef UNPK_HI
    }
    GRID_BAR(4);
    if (IN(5)) {
        int kx = 1024; asm volatile("" : "+s"(kx));
        pg8::Gemm g{(const bf16_t*)(ws + WS_OMIX), WoT, kx, kx, kx}; pg8::StaticOrder S; S.init(T, 1024, 1024, 1024, G, bx);
        EpiResid<false> E{x, (bf16_t*)(ws + WS_H1B), (float*)(ws + WS_SSQH1)};
        pg8::gemm_phase<EpiResid<false>, pg8::StaticOrder, true, true>(lds, g, S, E);
    }
    GRID_BAR(5);
    if (IN(6)) {
        int kx = 1024; asm volatile("" : "+s"(kx));
        pg8::Gemm g{(const bf16_t*)(ws + WS_H1B), (const bf16_t*)(ws + WS_WPT), kx, kx, kx}; OrderBatch S; S.so.init(T, 1024, 1024, 1024, G, bx);
        pg8::Unit u0; const bool has = S.next(0, u0);
        LAS float* rsl = (LAS float*)(lds + CTRL_OFF + 1024);
        if (has && tid < 256) { const float* sp = (const float*)(ws + WS_SSQH1) + (size_t)(u0.pm * 256 + tid) * 16; float a = 0.f;
#pragma unroll
            for (int j = 0; j < 4; ++j) { const f32x4 v = ((const f32x4*)sp)[j]; a += (v[0] + v[1]) + (v[2] + v[3]); }
            rsl[tid] = 1.0f / sqrtf(a * (1.0f / 1024.0f) + 1e-6f); }
        __syncthreads();
        EpiSoftmax E{(bf16_t*)(ws + WS_P), CTRL_OFF + 1024};
        pg8::gemm_phase<EpiSoftmax, OrderBatch, false, true>(lds, g, S, E);
    }
    GRID_BAR(6);
    if (IN(7)) {
        int kx = 1024; asm volatile("" : "+s"(kx));
        pg8::Gemm g{(const bf16_t*)(ws + WS_P), (const bf16_t*)(ws + WS_VWT), kx, kx, kx}; OrderBatch S; S.so.init(T, 1024, 1024, 1024, G, bx);
        EpiResid<true> E{(const bf16_t*)(ws + WS_H1B), (bf16_t*)(ws + WS_H2B), (float*)(ws + WS_SSQH2)};
        pg8::gemm_phase<EpiResid<true>, OrderBatch, true, true>(lds, g, S, E);
    }
    GRID_BAR(7);
    if (IN(8)) {
        typedef float f32x16 __attribute__((ext_vector_type(16)));
        const bf16_t* h2b = (const bf16_t*)(ws + WS_H2B); const float* b_router = args.in[20]; const float* ssq2 = (const float*)(ws + WS_SSQH2);
        int* topi = (int*)(ws + WS_ROUTE + RT_TOPI); float* topg = (float*)(ws + WS_ROUTE + RT_TOPG); int* tslot = (int*)(ws + WS_ROUTE + RT_SLOT); int* row_flat = (int*)(ws + WS_ROUTE + RT_ROWFLAT);
        for (int i = bx * 512 + tid; i < MPADN; i += G * 512) row_flat[i] = -1;
        LAS float* part = (LAS float*)lds;
        LAS float* lgt = (LAS float*)(lds + 32768);
        for (int ch = bx; ch < T / 64; ch += G) {
            const int tok0 = ch * 64, tb = wave & 1, kq = wave >> 1, kh = lane >> 5, row = tok0 + 32 * tb + (lane & 31);
            f32x16 acc = {};
            const bf16_t* ap = h2b + (size_t)row * 1024 + 256 * kq + 4 * kh; const float* wp = (const float*)(ws + WS_WRG) + (size_t)(256 * kq + 4 * kh) * 32 + (lane & 31);
#pragma unroll 8
            for (int j = 0; j < 32; ++j) {
                const v2u aw = *(const v2u*)(ap + 8 * j);
                const f32x4 a4 = (f32x4){__builtin_bit_cast(float, aw.x << 16), __builtin_bit_cast(float, aw.x & 0xffff0000u), __builtin_bit_cast(float, aw.y << 16), __builtin_bit_cast(float, aw.y & 0xffff0000u)};
#pragma unroll
                for (int e = 0; e < 4; ++e) acc = __builtin_amdgcn_mfma_f32_32x32x2f32(a4[e], wp[(size_t)(8 * j + e) * 32], acc, 0, 0, 0);
            }
#pragma unroll
            for (int r = 0; r < 16; ++r) part[((kq * 64) + tb * 32 + (r & 3) + 8 * (r >> 2) + 4 * kh) * 32 + (lane & 31)] = acc[r];
            __syncthreads();
            {
                const int tk = tid >> 3, e0 = (tid & 7) * 4; const float* sp = ssq2 + (size_t)(tok0 + tk) * 16; float a = 0.f;
#pragma unroll
                for (int j = 0; j < 4; ++j) { const f32x4 v = ((const f32x4*)sp)[j]; a += (v[0] + v[1]) + (v[2] + v[3]); }
                const float rs = 1.0f / sqrtf(a * (1.0f / 1024.0f) + 1e-6f);
                if (e0 == 0) ((float*)(ws + WS_ROUTE + RT_RSTD))[tok0 + tk] = rs;
#pragma unroll
                for (int e = 0; e < 4; ++e) lgt[tk * 33 + e0 + e] = rs * ((part[(0 * 64 + tk) * 32 + e0 + e] + part[(1 * 64 + tk) * 32 + e0 + e]) + (part[(2 * 64 + tk) * 32 + e0 + e] + part[(3 * 64 + tk) * 32 + e0 + e])) + b_router[e0 + e];
            }
            __syncthreads();
            if (tid < 64) {
                int c0 = -1, c1 = -1, c2 = -1, c3 = -1; float v0 = 0.f, v1 = 0.f, v2 = 0.f, v3 = 0.f; int s0 = 0, s1 = 0, s2 = 0, s3 = 0;
                for (int k = 0; k < 4; ++k) {
                    float best = -3.0e38f; int bi = 0;
                    for (int e = 0; e < 32; ++e) { const float v = lgt[tid * 33 + e]; if (e == c0 || e == c1 || e == c2 || e == c3) continue; if (v > best) { best = v; bi = e; } }
                    if (k == 0) { c0 = bi; v0 = best; } else if (k == 1) { c1 = bi; v1 = best; } else if (k == 2) { c2 = bi; v2 = best; } else { c3 = bi; v3 = best; }
                }
                const unsigned long long lt = (1ull << lane) - 1ull; int* cntc = (int*)(ws + WS_ROUTE + RT_CNT) + ch * 32;
                for (int e = 0; e < 32; ++e) {
                    const unsigned long long m0 = __ballot(c0 == e), m1 = __ballot(c1 == e), m2 = __ballot(c2 == e), m3 = __ballot(c3 == e);
                    const int before = __popcll(m0 & lt) + __popcll(m1 & lt) + __popcll(m2 & lt) + __popcll(m3 & lt);
                    if (c0 == e) s0 = before; if (c1 == e) s1 = before; if (c2 == e) s2 = before; if (c3 == e) s3 = before;
                    if (lane == e) cntc[e] = __popcll(m0) + __popcll(m1) + __popcll(m2) + __popcll(m3);
                }
                const int t = tok0 + tid;
                const float e1 = __expf(v1 - v0), e2 = __expf(v2 - v0), e3 = __expf(v3 - v0), inv = 1.0f / (1.0f + e1 + e2 + e3);
                *(int4*)(topi + t * 4) = make_int4(c0, c1, c2, c3);
                *(f32x4*)(topg + t * 4) = (f32x4){inv, e1 * inv, e2 * inv, e3 * inv};
                *(int4*)(tslot + t * 4) = make_int4(s0, s1, s2, s3);
            }
            __syncthreads();
        }
    }
    GRID_BAR(8);
    if (IN(9)) {
        const int* topi = (const int*)(ws + WS_ROUTE + RT_TOPI); const int* tslot = (const int*)(ws + WS_ROUTE + RT_SLOT); const int* cnt = (const int*)(ws + WS_ROUTE + RT_CNT);
        int* row_flat = (int*)(ws + WS_ROUTE + RT_ROWFLAT); float* rs_row = (float*)(ws + WS_ROUTE + RT_RSROW); const float* rstd2 = (const float*)(ws + WS_ROUTE + RT_RSTD);
        LAS int* red = (LAS int*)lds;
        for (int base = bx * 512; base < NA; base += G * 512) {
            const int chA = base >> 8, e = tid & 31, part = tid >> 5;
            int tot = 0, pa = 0, pb = 0;
            for (int c = part; c < T / 64; c += 16) { const int v = cnt[c * 32 + e]; tot += v; pa += c < chA ? v : 0; pb += c <= chA ? v : 0; }
            __syncthreads();
            red[(0 * 16 + part) * 32 + e] = tot; red[(1 * 16 + part) * 32 + e] = pa; red[(2 * 16 + part) * 32 + e] = pb;
            __syncthreads();
            if (tid < 96) { const int w = tid >> 5; int a = 0; for (int p = 0; p < 16; ++p) a += red[(w * 16 + p) * 32 + e]; red[1536 + w * 32 + e] = a; }
            __syncthreads();
            if (tid == 0) { int run = 0; for (int q = 0; q < NE; ++q) { red[1632 + q] = run; run += ((red[1536 + q] + 255) >> 8) << 8; } }
            if (bx == 0 && base == 0 && tid < 32) ((int*)(ws + WS_ROUTE + RT_TOT))[tid] = red[1536 + tid];
            __syncthreads();
            const int a = base + tid, ex = topi[a], row = red[1632 + ex] + red[1536 + 32 * (1 + (((a >> 8) - chA) & 1)) + ex] + tslot[a];
            row_flat[row] = a; rs_row[row] = rstd2[a >> 2];
        }
    }
    GRID_BAR(9);
    if (IN(10) || IN(11)) {
        const int* gtot = (const int*)(ws + WS_ROUTE + RT_TOT); LAS int* texp = (LAS int*)(lds + LX_TEXP);
        __syncthreads();
        if (tid == 0) { int nt = 0; for (int e = 0; e < NE; ++e) { const int n = (gtot[e] + 255) >> 8; for (int j = 0; j < n; ++j) texp[nt + j] = e; nt += n; } texp[NTILEN] = nt; }
        __syncthreads();
    }
    if (IN(10)) {
        int kx = 1024; asm volatile("" : "+s"(kx));
        pg8::Gemm g{(const bf16_t*)(ws + WS_H2B), WguT, kx, kx, kx}; OrderMoe S{(const LAS int*)(lds + LX_TEXP), 8, bx, G, (size_t)2048 * 1024 * 2};
        {
            const int* row_flat = (const int*)(ws + WS_ROUTE + RT_ROWFLAT); pg8::Unit u;
            for (int i = 0; i < pg8::GTAB_UNITS; ++i) { if (!S.next(i, u)) break; if (tid < 256) { const int a = row_flat[u.pm * 256 + tid]; ((LAS unsigned short*)(lds + pg8::GTAB))[i * 256 + tid] = (unsigned short)(a >= 0 ? (a >> 2) : 0); } }
            __syncthreads();
        }
        EpiSwiGLU E{(const float*)(ws + WS_ROUTE + RT_RSROW), args.in[22], (bf16_t*)(ws + WS_HMID), (const LAS int*)(lds + LX_TEXP)};
        pg8::gemm_phase<EpiSwiGLU, OrderMoe, true, true, true>(lds, g, S, E);
    }
    GRID_BAR(10);
    if (IN(11)) {
        int kx = 1024; asm volatile("" : "+s"(kx));
        pg8::Gemm g{(const bf16_t*)(ws + WS_HMID), WdT, kx, kx, kx}; OrderMoe S{(const LAS int*)(lds + LX_TEXP), 4, bx, G, (size_t)1024 * 1024 * 2};
        EpiDown E{(const int*)(ws + WS_ROUTE + RT_ROWFLAT), (const float*)(ws + WS_ROUTE + RT_TOPG), args.in[24], (bf16_t*)(ws + WS_YBUF), (const LAS int*)(lds + LX_TEXP)};
        pg8::gemm_phase<EpiDown, OrderMoe, true, true>(lds, g, S, E);
    }
    GRID_BAR(11);
    if (IN(12)) {
        const bf16_t* h2b = (const bf16_t*)(ws + WS_H2B); const bf16_t* ybuf = (const bf16_t*)(ws + WS_YBUF); const float* g_final = args.in[25]; float* outp = args.out;
        const int gw = vcu * NWAVES + wave, NGW = G * NWAVES;
        for (int t = gw; t < T; t += NGW) {
            f32x4 v[4]; float ss = 0.f;
#pragma unroll
            for (int j = 0; j < 4; ++j) {
                const v2u hw = *(const v2u*)(h2b + (size_t)t * 1024 + 256 * j + 4 * lane);
                f32x4 a = (f32x4){__builtin_bit_cast(float, hw.x << 16), __builtin_bit_cast(float, hw.x & 0xffff0000u), __builtin_bit_cast(float, hw.y << 16), __builtin_bit_cast(float, hw.y & 0xffff0000u)};
#pragma unroll
                for (int k = 0; k < 4; ++k) { const v2u y = *(const v2u*)(ybuf + ((size_t)t * 4 + k) * 1024 + 256 * j + 4 * lane);
                    a[0] += __builtin_bit_cast(float, y.x << 16); a[1] += __builtin_bit_cast(float, y.x & 0xffff0000u); a[2] += __builtin_bit_cast(float, y.y << 16); a[3] += __builtin_bit_cast(float, y.y & 0xffff0000u); }
                v[j] = a; ss += (a[0] * a[0] + a[1] * a[1]) + (a[2] * a[2] + a[3] * a[3]);
            }
            ss = wave_sum(ss); const float rs = 1.0f / sqrtf(ss * (1.0f / 1024.0f) + 1e-6f);
#pragma unroll
            for (int j = 0; j < 4; ++j) *(f32x4*)(outp + (size_t)t * 1024 + 256 * j + 4 * lane) = v[j] * rs * *(const f32x4*)(g_final + 256 * j + 4 * lane);
        }
    }
#undef GRID_BAR
#undef BOTH
#undef IN
}

}
void launch_mk(hipStream_t st, const mk::Args& base, int lo, int hi, int grid) {
    mk::Args a = base; a.ph_lo = lo; a.ph_hi = hi;
    hipLaunchKernelGGL(mk::mk_fwd, dim3(grid), dim3(mk::NWAVES * 64), mk::LDS_BYTES, st, a);
}
}

extern "C" void kernel_launch(void* const* d_in, const int* in_sizes, int n_in, void* d_out, int out_size, void* d_ws, size_t ws_size, hipStream_t stream) {
    static int grid = 0;
    if (grid == 0) {
        int dev = 0, cus = 0;
        if (hipGetDevice(&dev) != hipSuccess || hipDeviceGetAttribute(&cus, hipDeviceAttributeMultiprocessorCount, dev) != hipSuccess) { grid = -1; return; }
        if (hipFuncSetAttribute((const void*)mk::mk_fwd, hipFuncAttributeMaxDynamicSharedMemorySize, mk::LDS_BYTES) != hipSuccess) { grid = -1; return; }
        grid = cus >= 256 ? 256 : cus;
    }
    if (grid < 0) return;
    const float* x = (const float*)d_in[0];
    const float* mem = (const float*)d_in[1];
    const int* pos = (const int*)d_in[2];
    const float* g_q_a = (const float*)d_in[5];
    const float* w_q_b = (const float*)d_in[6];
    const float* g_kv_a = (const float*)d_in[7];
    const float* w_kv_b = (const float*)d_in[8];
    const float* rel_bias = (const float*)d_in[9];
    const float* g_out_a = (const float*)d_in[10];
    const float* g_out_b = (const float*)d_in[11];
    const float* w_o = (const float*)d_in[12];
    const float* g_xattn = (const float*)d_in[13];
    const float* g_mem = (const float*)d_in[14];
    const float* w_mq = (const float*)d_in[15];
    const float* w_mkv = (const float*)d_in[16];
    const float* w_mo = (const float*)d_in[17];
    const float* g_moe = (const float*)d_in[18];
    const float* w_router = (const float*)d_in[19];
    const float* b_router = (const float*)d_in[20];
    const float* w_gate_up = (const float*)d_in[21];
    const float* b_gate_up = (const float*)d_in[22];
    const float* w_down = (const float*)d_in[23];
    const float* b_down = (const float*)d_in[24];
    const float* g_final = (const float*)d_in[25];
    float* out = (float*)d_out;
    (void)ws_size; (void)in_sizes; (void)n_in; (void)out_size;

    (void)hipMemsetAsync((char*)d_ws + mk::WS_CTL, 0, mk::CTL_ZERO_BYTES, stream);
    mk::Args ma; memset(&ma, 0, sizeof(ma));
    for (int i = 0; i < 26; ++i) ma.in[i] = (const float*)d_in[i];
    ma.out = out; ma.ws = (unsigned char*)d_ws; ma.flags = 1;
    for (int j = 0; j < 16; ++j) ma.rope_rev[j] = pow(10000.0, -(double)j / 16.0) / 6.283185307179586476925287;
#ifndef MK_N_LAUNCHES
#define MK_N_LAUNCHES 1
#endif
    if (MK_N_LAUNCHES == 1) launch_mk(stream, ma, 0, 13, grid);
    else for (int p = 0; p < 13; ++p) launch_mk(stream, ma, p, p + 1, grid);
#ifdef PROBE_MASK
#ifdef PROBE_FLAGS
    ma.flags |= PROBE_FLAGS;
#endif
    for (int r = 0; r < PROBE_N; ++r) for (int p = 0; p < 13; ++p) if ((PROBE_MASK >> p) & 1) launch_mk(stream, ma, p, p + 1, grid);
#endif
}
```

```cpp
#include <hip/hip_runtime.h>
#include <stdint.h>
#include <string.h>
#include <math.h>

namespace {
constexpr int NB = 4, S = 4096, D = 1024, T = NB * S, NMEM = 256, INW = 1952;
constexpr int NE = 32, TOPK = 4, NA = T * TOPK;

namespace pg8 {
#define PG8_LAS __attribute__((address_space(3)))
typedef unsigned short bf16_t;
typedef short bf16x8 __attribute__((ext_vector_type(8)));
typedef float f32x4 __attribute__((ext_vector_type(4)));
typedef unsigned u32x4 __attribute__((ext_vector_type(4)));
constexpr int BM = 256, BK = 64, HALF = 128, HTB = HALF * BK * 2  , STAGE_BYTES = 8 * HTB, NXCD = 8, WGM = 8;

__host__ __device__ __forceinline__ int lds_byte(int r, int c) { const int st = (r >> 4) * 2 + (c >> 5), rr = r & 15, cc = c & 31, ob = rr * 64 + cc * 2; return st * 1024 + (ob ^ (((ob >> 9) & 1) << 5)); }
__host__ __device__ __forceinline__ void stage_rc(int b, int& R, int& C) { const int st = b / 1024, sb = b % 1024, swz = sb ^ (((sb >> 9) & 1) << 5); R = (st >> 1) * 16 + swz / 64; C = (st & 1) * 32 + (swz % 64) / 2; }
__host__ __device__ __forceinline__ int perm32(int rho) { const int n = rho >> 4, i = rho & 15; return 8 * (i >> 2) + 4 * n + (i & 3); }

struct Unit { int pm, pn; size_t aoff, boff; };
struct Gemm { const bf16_t* A; const bf16_t* Bt; int lda, ldb, K; };

struct StaticOrder {
    int nM, nN, nwg, G, c; size_t ta, tb;
    __host__ __device__ __forceinline__ void init(int M, int N, int lda, int ldb, int G_, int c_) { nM = M / BM; nN = N / BM; nwg = nM * nN; G = G_; c = c_; ta = (size_t)BM * lda * 2; tb = (size_t)BM * ldb * 2; }
    __host__ __device__ __forceinline__ bool next(int i, Unit& u) const {
        const long L = (long)i * G + c; if (L >= nwg) return false;
        int wgid = (int)L; { const int q = nwg / NXCD, r = nwg % NXCD, xcd = wgid % NXCD, off = wgid / NXCD; wgid = (xcd < r ? xcd * (q + 1) : r * (q + 1) + (xcd - r) * q) + off; }
        const int nig = WGM * nN, gid = wgid / nig, fm = gid * WGM, gsz = (nM - fm) < WGM ? (nM - fm) : WGM;
        u.pm = fm + ((wgid % nig) % gsz); u.pn = (wgid % nig) / gsz; u.aoff = (size_t)u.pm * ta; u.boff = (size_t)u.pn * tb; return true;
    }
    __device__ __forceinline__ void a_ready(const Unit&) const {}
    __device__ __forceinline__ void done(const Unit&) const {}
};

__device__ __forceinline__ unsigned cvt_pk_bf16(float lo, float hi) { unsigned r; asm volatile("v_cvt_pk_bf16_f32 %0, %1, %2" : "=v"(r) : "v"(lo), "v"(hi)); return r; }
typedef float f32x2 __attribute__((ext_vector_type(2)));

constexpr int GTAB = 135168 + 4096, GTAB_UNITS = 10;
template <class Epi, class Sched, bool ALIGN_EPI = false, bool SP2 = false, bool GATHER = false>
__device__ __forceinline__ void gemm_phase(PG8_LAS unsigned char* lds, const Gemm g, const Sched& S, const Epi& E) {
    const int tid = threadIdx.x, wid = __builtin_amdgcn_readfirstlane(tid >> 6), lane = tid & 63, wr = wid >> 2, wc = wid & 3, fr = lane & 15, fq = lane >> 4;
    static_assert(!GATHER || SP2, "GATHER is implemented for the SP2 loop only");
    const int K = g.K, nt = K / BK;
    unsigned voffA[2], voffB[2];
#pragma unroll
    for (int i = 0; i < 2; ++i) { int R, C; stage_rc(tid * 16 + i * 8192, R, C); const int Rb = Epi::PERM ? ((R & ~31) + perm32(R & 31)) : R;
        voffA[i] = (unsigned)(R * g.lda + C) * 2u; voffB[i] = (unsigned)(Rb * g.ldb + C) * 2u; }
    unsigned gidx[2], gcol[2];
#pragma unroll
    for (int i = 0; i < 2; ++i) { int R, C; stage_rc(tid * 16 + i * 8192, R, C); gidx[i] = (unsigned)R * 2u; gcol[i] = (unsigned)C * 2u; }
    const size_t kstep = (size_t)(BK * 2);
    const size_t hstepA = (size_t)HALF * g.lda * 2, hstepB = (size_t)HALF * g.ldb * 2;
    const unsigned ldsw = (unsigned)wid * 1024u;
    const int aoff = lds_byte(wr * 64 + fr, fq * 8), boff = lds_byte(wc * 32 + fr, fq * 8);
#define PG8_SA(b, h) (((b) * 2 + (h)) * HTB)
#define PG8_SB(b, h) ((4 + (b) * 2 + (h)) * HTB)
#define PG8_STAGE(bufoff, gbase, voff) do { _Pragma("unroll") for (int _i = 0; _i < 2; ++_i) \
        __builtin_amdgcn_global_load_lds((const unsigned*)((const char*)(gbase) + (voff)[_i]), (PG8_LAS unsigned*)(lds + (bufoff) + ldsw + _i * 8192), 16, 0, 0); } while (0)
#define PG8_GTOK(h, sel) do { if constexpr (GATHER) { tk0 = *(const PG8_LAS unsigned short*)(lds + GTAB + (sel) * 512 + (h) * 256 + gidx[0]); tk1 = *(const PG8_LAS unsigned short*)(lds + GTAB + (sel) * 512 + (h) * 256 + gidx[1]); } } while (0)
#define PG8_STAGE_A(bufoff, gbase, h, sel) do { if constexpr (GATHER) { \
        __builtin_amdgcn_global_load_lds((const unsigned*)((const char*)(gbase) + (size_t)tk0 * (size_t)(g.lda * 2) + gcol[0]), (PG8_LAS unsigned*)(lds + (bufoff) + ldsw), 16, 0, 0); \
        __builtin_amdgcn_global_load_lds((const unsigned*)((const char*)(gbase) + (size_t)tk1 * (size_t)(g.lda * 2) + gcol[1]), (PG8_LAS unsigned*)(lds + (bufoff) + ldsw + 8192), 16, 0, 0); } \
    else { PG8_STAGE(bufoff, (gbase) + (h) * hstepA, voffA); } } while (0)
#define PG8_LDA(dst, b, h) do { _Pragma("unroll") for (int m = 0; m < 4; ++m) _Pragma("unroll") for (int k = 0; k < 2; ++k) dst[m][k] = *(const PG8_LAS bf16x8*)(lds + PG8_SA(b, h) + aoff + m * 2048 + k * 1024); } while (0)
#define PG8_LDB(dst, b, h) do { _Pragma("unroll") for (int n = 0; n < 2; ++n) _Pragma("unroll") for (int k = 0; k < 2; ++k) dst[n][k] = *(const PG8_LAS bf16x8*)(lds + PG8_SB(b, h) + boff + n * 2048 + k * 1024); } while (0)
#define PG8_MMA(ai, bj, At, Bt) do { __builtin_amdgcn_s_setprio(1); _Pragma("unroll") for (int m = 0; m < 4; ++m) _Pragma("unroll") for (int n = 0; n < 2; ++n) _Pragma("unroll") for (int k = 0; k < 2; ++k) \
        acc[ai][bj][m][n] = __builtin_amdgcn_mfma_f32_16x16x32_bf16(Bt[n][k], At[m][k], acc[ai][bj][m][n], 0, 0, 0); __builtin_amdgcn_s_setprio(0); } while (0)
#define PG8_WAIT_V(n) asm volatile("s_waitcnt vmcnt(" #n ")" ::: "memory")
#define PG8_WAIT_L(n) asm volatile("s_waitcnt lgkmcnt(" #n ")" ::: "memory")
#define PG8_BAR __builtin_amdgcn_s_barrier()
#define PG8_SCHED __builtin_amdgcn_sched_barrier(0)
    Unit cur, nxt; int ui = 0; unsigned tk0 = 0, tk1 = 0; (void)tk0; (void)tk1;
    if (!S.next(0, cur)) return;
    f32x4 acc[2][2][4][2];
#pragma unroll
    for (int a = 0; a < 2; ++a)
#pragma unroll
        for (int b = 0; b < 2; ++b)
#pragma unroll
            for (int m = 0; m < 4; ++m)
#pragma unroll
                for (int n = 0; n < 2; ++n) acc[a][b][m][n] = (f32x4){0.f, 0.f, 0.f, 0.f};
    bf16x8 At[4][2], B0[2][2], B1[2][2];
    const char* cA = (const char*)g.A + (GATHER ? (size_t)0 : cur.aoff); const char* cB = (const char*)g.Bt + cur.boff;
    S.a_ready(cur);
    if constexpr (SP2) {
        PG8_STAGE(PG8_SB(0, 0), cB, voffB); PG8_STAGE(PG8_SB(0, 1), cB + hstepB, voffB); PG8_GTOK(0, ui); PG8_STAGE_A(PG8_SA(0, 0), cA, 0, ui); PG8_GTOK(1, ui); PG8_STAGE_A(PG8_SA(0, 1), cA, 1, ui);
        if (wr == 1) PG8_BAR;
        PG8_WAIT_V(2); PG8_BAR;
        PG8_STAGE(PG8_SB(1, 0), cB + kstep, voffB); PG8_GTOK(0, ui); PG8_STAGE_A(PG8_SA(1, 0), cA + kstep, 0, ui); PG8_STAGE(PG8_SB(1, 1), cB + hstepB + kstep, voffB);
        PG8_WAIT_V(6); PG8_BAR;
    } else {
        PG8_STAGE(PG8_SB(0, 0), cB, voffB); PG8_STAGE_A(PG8_SA(0, 0), cA, 0, ui); PG8_STAGE(PG8_SB(0, 1), cB + hstepB, voffB); PG8_STAGE_A(PG8_SA(0, 1), cA, 1, ui);
        if (wr == 1) PG8_BAR;
        PG8_WAIT_V(4); PG8_BAR;
        PG8_STAGE(PG8_SB(1, 0), cB + kstep, voffB); PG8_STAGE_A(PG8_SA(1, 0), cA + kstep, 0, ui); PG8_STAGE(PG8_SB(1, 1), cB + hstepB + kstep, voffB);
        PG8_WAIT_V(6); PG8_BAR;
    }
    for (;;) {
        const bool has_next = S.next(ui + 1, nxt);
        const char* nA = has_next ? (const char*)g.A + (GATHER ? (size_t)0 : nxt.aoff) : cA; const char* nB = has_next ? (const char*)g.Bt + nxt.boff : cB;
        for (int t = 0; t < nt; t += 2) {
            const bool last = (t == nt - 2);
            const char* a1 = cA + (size_t)(t + 1) * kstep;
            const char* a2 = last ? nA : cA + (size_t)(t + 2) * kstep; const char* b2 = last ? nB : cB + (size_t)(t + 2) * kstep;
            const char* a3 = a2 + kstep; const char* b3 = b2 + kstep; const int ui2 = (last && has_next) ? ui + 1 : ui; (void)ui2;
            if (last && has_next) S.a_ready(nxt);
            if constexpr (SP2) {
            PG8_GTOK(1, ui); PG8_LDB(B0, 0, 0); PG8_LDB(B1, 0, 1); PG8_SCHED; PG8_LDA(At, 0, 0); PG8_STAGE_A(PG8_SA(1, 1), a1, 1, ui);
            PG8_WAIT_V(8); PG8_WAIT_L(0); PG8_BAR; PG8_MMA(0, 0, At, B0); PG8_MMA(0, 1, At, B1); PG8_BAR; PG8_SCHED;
            PG8_GTOK(0, ui2); PG8_LDA(At, 0, 1); PG8_STAGE(PG8_SB(0, 0), b2, voffB); PG8_STAGE(PG8_SB(0, 1), b2 + hstepB, voffB); PG8_STAGE_A(PG8_SA(0, 0), a2, 0, ui2);
            PG8_WAIT_V(8); PG8_WAIT_L(0); PG8_BAR; PG8_MMA(1, 0, At, B0); PG8_MMA(1, 1, At, B1); PG8_BAR; PG8_SCHED;
            PG8_GTOK(1, ui2); PG8_LDB(B0, 1, 0); PG8_LDB(B1, 1, 1); PG8_SCHED; PG8_LDA(At, 1, 0); PG8_STAGE_A(PG8_SA(0, 1), a2, 1, ui2);
            PG8_WAIT_V(8); PG8_WAIT_L(0); PG8_BAR; PG8_MMA(0, 0, At, B0); PG8_MMA(0, 1, At, B1); PG8_BAR; PG8_SCHED;
            PG8_GTOK(0, ui2); PG8_LDA(At, 1, 1); PG8_STAGE(PG8_SB(1, 0), b3, voffB); PG8_STAGE(PG8_SB(1, 1), b3 + hstepB, voffB); PG8_STAGE_A(PG8_SA(1, 0), a3, 0, ui2);
            PG8_WAIT_V(8); PG8_WAIT_L(0); PG8_BAR; PG8_MMA(1, 0, At, B0); PG8_MMA(1, 1, At, B1); PG8_BAR; PG8_SCHED;
            } else {
            PG8_LDB(B0, 0, 0); PG8_SCHED; PG8_LDA(At, 0, 0); PG8_STAGE_A(PG8_SA(1, 1), a1, 1, ui);
            PG8_WAIT_L(8); PG8_BAR; PG8_WAIT_L(0); PG8_MMA(0, 0, At, B0); PG8_BAR; PG8_SCHED;
            PG8_LDB(B1, 0, 1); PG8_STAGE(PG8_SB(0, 0), b2, voffB);
            PG8_BAR; PG8_WAIT_L(0); PG8_MMA(0, 1, At, B1); PG8_BAR;
            PG8_LDA(At, 0, 1); PG8_STAGE_A(PG8_SA(0, 0), a2, 0, ui2);
            PG8_BAR; PG8_WAIT_L(0); PG8_MMA(1, 0, At, B0); PG8_BAR; PG8_SCHED;
            PG8_STAGE(PG8_SB(0, 1), b2 + hstepB, voffB);
            PG8_WAIT_V(6); PG8_BAR; PG8_MMA(1, 1, At, B1); PG8_BAR;
            PG8_LDB(B0, 1, 0); PG8_SCHED; PG8_LDA(At, 1, 0); PG8_STAGE_A(PG8_SA(0, 1), a2, 1, ui2);
            PG8_WAIT_L(8); PG8_BAR; PG8_WAIT_L(0); PG8_MMA(0, 0, At, B0); PG8_BAR; PG8_SCHED;
            PG8_LDB(B1, 1, 1); PG8_STAGE(PG8_SB(1, 0), b3, voffB);
            PG8_BAR; PG8_WAIT_L(0); PG8_MMA(0, 1, At, B1); PG8_BAR;
            PG8_LDA(At, 1, 1); PG8_STAGE_A(PG8_SA(1, 0), a3, 0, ui2);
            PG8_BAR; PG8_WAIT_L(0); PG8_MMA(1, 0, At, B0); PG8_BAR; PG8_SCHED;
            PG8_STAGE(PG8_SB(1, 1), b3 + hstepB, voffB);
            PG8_WAIT_V(6); PG8_BAR; PG8_MMA(1, 1, At, B1); PG8_BAR;
            }
        }
        if constexpr (ALIGN_EPI) { if (wr == 0) PG8_BAR; }
        if constexpr (!Epi::AFTER_DRAIN) { E(acc, cur, wr, wc, fr, fq); S.done(cur); }
        if (!has_next) break;
#pragma unroll
        for (int a = 0; a < 2; ++a)
#pragma unroll
            for (int b = 0; b < 2; ++b)
#pragma unroll
                for (int m = 0; m < 4; ++m)
#pragma unroll
                    for (int n = 0; n < 2; ++n) acc[a][b][m][n] = (f32x4){0.f, 0.f, 0.f, 0.f};
        cur = nxt; cA = nA; cB = nB; ++ui;
        if constexpr (ALIGN_EPI) { if (wr == 1) PG8_BAR; }
    }
    PG8_WAIT_V(0);
    if constexpr (!ALIGN_EPI) { if (wr == 0) PG8_BAR; }
    PG8_BAR;
    if constexpr (Epi::AFTER_DRAIN) { E.fused(acc, cur, wr, wc, fr, fq, lds, wid, lane); S.done(cur); }
#undef PG8_SA
#undef PG8_SB
#undef PG8_STAGE
#undef PG8_STAGE_A
#undef PG8_GTOK
#undef PG8_LDA
#undef PG8_LDB
#undef PG8_MMA
#undef PG8_WAIT_V
#undef PG8_WAIT_L
#undef PG8_BAR
#undef PG8_SCHED
}
}
namespace mla {
using bf16x8 = __attribute__((ext_vector_type(8))) short;
using s16x4  = __attribute__((ext_vector_type(4))) short;
using f32x16 = __attribute__((ext_vector_type(16))) float;
using u32x4  = __attribute__((ext_vector_type(4))) unsigned;
constexpr int NW = 8, QBLK = 32, KVBLK = 64;
constexpr float SCALE = 0.10206207261596577f;
constexpr float THR = 8.f;
constexpr int SHM_V = KVBLK * 64 * 2, SHM_K = KVBLK * 256;
constexpr int SHM_ATTN = 4 * SHM_V + 4 * SHM_K + NW * 64 * 4;
#define KSWZ(row, colB) ((row) * 256 + ((colB) ^ (((row) & 7) << 4)))
#define SBAR() __builtin_amdgcn_sched_barrier(0)
__device__ __forceinline__ int crow(int r, int hi) { return (r & 3) + 8 * (r >> 2) + 4 * hi; }
__device__ __forceinline__ unsigned cvtpk(float lo, float hi) { unsigned r; asm volatile("v_cvt_pk_bf16_f32 %0, %1, %2" : "=v"(r) : "v"(lo), "v"(hi)); return r; }

__device__ __forceinline__ float max3f(float a, float b, float c) { return __builtin_fmaxf(__builtin_fmaxf(a, b), c); }
template <int ABL> __device__ __forceinline__ void partialSM(f32x16& p0, f32x16& p1, float& m_reg, float& alpha, bool first) {
  float a = max3f(p0[0], p0[1], p0[2]), b = max3f(p0[3], p1[0], p1[1]), c = max3f(p1[2], p1[3], p0[4]), d = max3f(p0[5], p0[6], p0[7]);
  a = max3f(a, p1[4], p1[5]); b = max3f(b, p1[6], p1[7]);
#pragma unroll
  for (int r = 8; r < 16; r += 4) { a = max3f(a, p0[r], p0[r + 1]); b = max3f(b, p0[r + 2], p0[r + 3]); c = max3f(c, p1[r], p1[r + 1]); d = max3f(d, p1[r + 2], p1[r + 3]); }
  float pmax = fmaxf(fmaxf(a, b), fmaxf(c, d));
  { auto rr = __builtin_amdgcn_permlane32_swap(__float_as_uint(pmax), __float_as_uint(pmax), false, false);
    pmax = fmaxf(__uint_as_float(rr[0]), __uint_as_float(rr[1])); }
  if (__builtin_expect(!first && __all(pmax - m_reg <= THR * 1.4426950408889634f), 1)) { alpha = 1.f; }
  else { const float mn = first ? pmax : fmaxf(m_reg, pmax); alpha = first ? 1.f : __builtin_amdgcn_exp2f(m_reg - mn); m_reg = mn; }
#pragma unroll
  for (int r = 0; r < 16; ++r) { p0[r] -= m_reg; p1[r] -= m_reg; }
#pragma unroll
  for (int r = 0; r < 16; ++r) p0[r] = (ABL & 2) ? p0[r] * 0.5f : __builtin_amdgcn_exp2f(p0[r]);
}
template <int ABL> __device__ __forceinline__ void finishSM(f32x16& p0, f32x16& p1, float alpha, float& l_reg, bf16x8& pa0, bf16x8& pa1, bf16x8& pa2, bf16x8& pa3) {
#pragma unroll
  for (int r = 0; r < 16; ++r) p1[r] = (ABL & 2) ? p1[r] * 0.5f : __builtin_amdgcn_exp2f(p1[r]);
  float ps, s0 = 0.f, s1 = 0.f, s2 = 0.f, s3 = 0.f;
#pragma unroll
  for (int r = 0; r < 16; r += 4) { s0 += p0[r]; s1 += p0[r + 1]; s2 += p0[r + 2]; s3 += p0[r + 3]; }
#pragma unroll
  for (int r = 0; r < 16; r += 4) { s0 += p1[r]; s1 += p1[r + 1]; s2 += p1[r + 2]; s3 += p1[r + 3]; }
  ps = (s0 + s1) + (s2 + s3);
  { auto rr = __builtin_amdgcn_permlane32_swap(__float_as_uint(ps), __float_as_uint(ps), false, false);
    ps = __uint_as_float(rr[0]) + __uint_as_float(rr[1]); }
  l_reg = l_reg * alpha + ps;
#define PK4(P, BASE, OUT) do { u32x4 w = {cvtpk(P[BASE + 0], P[BASE + 1]), cvtpk(P[BASE + 2], P[BASE + 3]), cvtpk(P[BASE + 4], P[BASE + 5]), cvtpk(P[BASE + 6], P[BASE + 7])}; \
    OUT = *reinterpret_cast<bf16x8*>(&w); } while (0)
  PK4(p0, 0, pa0); PK4(p0, 8, pa1); PK4(p1, 0, pa2); PK4(p1, 8, pa3);
#undef PK4
}
__device__ __forceinline__ void qkt(f32x16& p0, f32x16& p1, const char* Ks, const bf16x8* qr, int r32, int hi) {
  p0 = f32x16{}; p1 = f32x16{};
#pragma unroll
  for (int d0 = 0; d0 < 6; ++d0) { int cb = (d0 * 16 + hi * 8) * 2;
    bf16x8 b0 = *reinterpret_cast<const bf16x8*>(Ks + KSWZ(r32, cb));
    bf16x8 b1 = *reinterpret_cast<const bf16x8*>(Ks + KSWZ(32 + r32, cb));
    p0 = __builtin_amdgcn_mfma_f32_32x32x16_bf16(b0, qr[d0], p0, 0, 0, 0);
    p1 = __builtin_amdgcn_mfma_f32_32x32x16_bf16(b1, qr[d0], p1, 0, 0, 0); }
}
__device__ __forceinline__ int v_st(int k, int c) { const int kk = k;
  return ((kk >> 3) * 2 + (c >> 5)) * 512 + ((kk & 7) * 32 + (c & 31)) * 2; }
__device__ __forceinline__ int v_rd_base(int lane) { return ((lane & 3) << 3) | (((lane >> 2) & 3) << 6) | (((lane >> 4) & 1) << 5) | (((lane >> 5) & 1) << 8); }
constexpr int v_rd_off(int d0, int ks, int half) { return d0 * 512 + ks * 2048 + half * 1024; }
template <int OFF> __device__ __forceinline__ s16x4 tr_read(int vb) {
  s16x4 r; asm volatile("ds_read_b64_tr_b16 %0, %1 offset:%2" : "=&v"(r) : "v"(vb), "i"(OFF) : "memory"); return r;
}
#define PK(L, H) (bf16x8){L[0], L[1], L[2], L[3], H[0], H[1], H[2], H[3]}
#define PV_RD(KS, LA, HA, LB, HB) do { LA = tr_read<v_rd_off(0, KS, 0)>(vb); HA = tr_read<v_rd_off(0, KS, 1)>(vb); LB = tr_read<v_rd_off(1, KS, 0)>(vb); HB = tr_read<v_rd_off(1, KS, 1)>(vb); } while (0)
#define PV_MM(PA, LA, HA, LB, HB) do { o[0] = __builtin_amdgcn_mfma_f32_32x32x16_bf16(PA, PK(LA, HA), o[0], 0, 0, 0); o[1] = __builtin_amdgcn_mfma_f32_32x32x16_bf16(PA, PK(LB, HB), o[1], 0, 0, 0); } while (0)
__device__ __forceinline__ void pv_d0(f32x16* o, int vb, bf16x8 pa0, bf16x8 pa1, bf16x8 pa2, bf16x8 pa3) {
  s16x4 la, ha, lb, hb, lc, hc, ld, hd;
  PV_RD(0, la, ha, lb, hb);
  PV_RD(1, lc, hc, ld, hd);
  asm volatile("s_waitcnt lgkmcnt(4)" ::: "memory"); SBAR();
  PV_MM(pa0, la, ha, lb, hb); SBAR();
  PV_RD(2, la, ha, lb, hb);
  asm volatile("s_waitcnt lgkmcnt(4)" ::: "memory"); SBAR();
  PV_MM(pa1, lc, hc, ld, hd); SBAR();
  PV_RD(3, lc, hc, ld, hd);
  asm volatile("s_waitcnt lgkmcnt(4)" ::: "memory"); SBAR();
  PV_MM(pa2, la, ha, lb, hb); SBAR();
  asm volatile("s_waitcnt lgkmcnt(0)" ::: "memory"); SBAR();
  PV_MM(pa3, lc, hc, ld, hd);
}
#undef PV_MM
#undef PV_RD
#undef PK
__device__ __forceinline__ float bf2f_(short b) { return __builtin_bit_cast(float, (unsigned)(unsigned short)b << 16); }

template <int ABL> __device__ __forceinline__ void mla_unit(const unsigned short* __restrict__ Qg, const unsigned short* __restrict__ Kn, const unsigned short* __restrict__ Kpe, const unsigned short* __restrict__ Vg,
                                         const float* __restrict__ cs, unsigned short* __restrict__ Og, int q0, int krow0, int h, int seq, char* lds) {
  const int tid = threadIdx.x, wid = __builtin_amdgcn_readfirstlane(tid >> 6), lane = tid & 63, r32 = lane & 31, hi = lane >> 5;
  char* V_lds = lds; char* K_lds = lds + 4 * SHM_V;
  float* ws = (float*)(lds + 4 * SHM_V + 4 * SHM_K) + wid * 64; float* li_l = ws; float* al_l = ws + 32;
  float m_reg = 0.f, l_reg = 0; f32x16 o[2] = {}; bf16x8 qr[6];
  {
    const int qrow = q0 + wid * QBLK + r32;
    const unsigned short* Qw = Qg + (size_t)qrow * 768 + h * 96 + hi * 8;
#pragma unroll
    for (int d0 = 0; d0 < 6; ++d0) qr[d0] = *reinterpret_cast<const bf16x8*>(Qw + d0 * 16);
    const float* cr = cs + (size_t)qrow * 32 + hi * 8;
    bf16x8 a = qr[4], b = qr[5]; u32x4 wa, wb; float n1[8], n2[8];
#pragma unroll
    for (int e = 0; e < 8; ++e) { const float c_ = cr[e], s_ = cr[16 + e]; const float x1 = bf2f_(a[e]), x2 = bf2f_(b[e]); n1[e] = x1 * c_ - x2 * s_; n2[e] = x1 * s_ + x2 * c_; }
    wa = (u32x4){cvtpk(n1[0], n1[1]), cvtpk(n1[2], n1[3]), cvtpk(n1[4], n1[5]), cvtpk(n1[6], n1[7])};
    wb = (u32x4){cvtpk(n2[0], n2[1]), cvtpk(n2[2], n2[3]), cvtpk(n2[4], n2[5]), cvtpk(n2[6], n2[7])};
    qr[4] = *reinterpret_cast<bf16x8*>(&wa); qr[5] = *reinterpret_cast<bf16x8*>(&wb);
  }
  const int sk = tid >> 3, sc = (tid & 7) * 8, rk = (tid & 255) >> 2, rc = (tid & 3) * 8;
  const int vst = v_st(sk, sc), kst = KSWZ(sk, sc * 2), rst = KSWZ(rk, (64 + rc) * 2);
  const int vb0 = (int)(uintptr_t)V_lds + v_rd_base(lane);
  const unsigned short* Vh = Vg + (size_t)krow0 * 512 + h * 64; const unsigned short* Kh = Kn + (size_t)krow0 * 512 + h * 64; const unsigned short* Rh = Kpe + (size_t)krow0 * 32;
  struct { bf16x8 vs, ks, rs; } sr_[2];
#define SLOAD(i, k0) do { sr_[i].vs = *reinterpret_cast<const bf16x8*>(&Vh[(size_t)((k0) + sk) * 512 + sc]); sr_[i].ks = *reinterpret_cast<const bf16x8*>(&Kh[(size_t)((k0) + sk) * 512 + sc]); \
    sr_[i].rs = *reinterpret_cast<const bf16x8*>(&Rh[(size_t)((k0) + rk) * 32 + rc]); } while (0)
#define SWRITE(b, i) do { *(bf16x8*)(V_lds + (b) * SHM_V + vst) = sr_[i].vs; *(bf16x8*)(K_lds + (b) * SHM_K + kst) = sr_[i].ks; *(bf16x8*)(K_lds + (b) * SHM_K + rst) = sr_[i].rs; } while (0)
#define RESC(a) do { if (__any((a) < 1.f)) { if (hi == 0) al_l[r32] = (a); asm volatile("s_waitcnt lgkmcnt(0)" ::: "memory"); \
    _Pragma("unroll") for (int d = 0; d < 2; ++d) _Pragma("unroll") for (int r = 0; r < 16; ++r) o[d][r] *= al_l[crow(r, hi)]; } } while (0)
#define EBAR() do { asm volatile("s_waitcnt lgkmcnt(0)" ::: "memory"); __builtin_amdgcn_s_barrier(); asm volatile("" ::: "memory"); } while (0)
  f32x16 p0, p1; float al; bf16x8 pa0, pa1, pa2, pa3; const int NT = seq / KVBLK;
  pa0 = pa1 = pa2 = pa3 = bf16x8{};
  SLOAD(0, 0); SLOAD(1, KVBLK); asm volatile("s_waitcnt vmcnt(0)" ::: "memory"); SWRITE(0, 0); SWRITE(1, 1);
  if (2 < NT) SLOAD(0, 2 * KVBLK);
  EBAR();
  if (wid >= 4) EBAR();
  for (int t = 0; t < NT; ++t) {
    SBAR(); __builtin_amdgcn_s_setprio(3); qkt(p0, p1, K_lds + (t & 3) * SHM_K, qr, r32, hi); SBAR();
    if (t > 0) pv_d0(o, vb0 + ((t - 1) & 3) * SHM_V, pa0, pa1, pa2, pa3);
    __builtin_amdgcn_s_setprio(0); EBAR();
    partialSM<ABL>(p0, p1, m_reg, al, t == 0);
    RESC(al);
    finishSM<ABL>(p0, p1, al, l_reg, pa0, pa1, pa2, pa3);
    if (t + 2 < NT) { asm volatile("s_waitcnt vmcnt(0)" ::: "memory"); SWRITE((t + 2) & 3, 0); }
    if (t + 3 < NT) SLOAD(0, (t + 3) * KVBLK);
    EBAR();
  }
  SBAR(); pv_d0(o, vb0 + ((NT - 1) & 3) * SHM_V, pa0, pa1, pa2, pa3);
  if (wid < 4) EBAR();
#undef EBAR
  if (hi == 0) li_l[r32] = l_reg; asm volatile("s_waitcnt lgkmcnt(0)" ::: "memory");
  float rli[16];
#pragma unroll
  for (int r = 0; r < 16; ++r) rli[r] = __builtin_amdgcn_rcpf(li_l[crow(r, hi)]);
  unsigned short* Ow = Og + (size_t)(q0 + wid * QBLK) * 512 + h * 64;
#pragma unroll
  for (int r = 0; r < 16; ++r) { int orow = crow(r, hi);
#pragma unroll
    for (int d0 = 0; d0 < 2; ++d0) Ow[(size_t)orow * 512 + d0 * 32 + r32] = (unsigned short)cvtpk(o[d0][r] * rli[r], 0.f); }
  __syncthreads();
#undef SLOAD
#undef SWRITE
#undef RESC
}
#undef KSWZ
#undef SBAR
}

namespace dil {
using bf16x8 = __attribute__((ext_vector_type(8))) short;
using s16x4  = __attribute__((ext_vector_type(4))) short;
using f32x16 = __attribute__((ext_vector_type(16))) float;
using u32x4  = __attribute__((ext_vector_type(4))) unsigned;
constexpr int TBL_PITCH = 2112;
constexpr int W_TBL = 0, W_K = 8448, W_V = 8448 + 4096, W_POS = 8448 + 8192, W_AL = W_POS + 128, W_BYTES = W_AL + 128;
__device__ __forceinline__ int crow(int r, int hi) { return (r & 3) + 8 * (r >> 2) + 4 * hi; }
__device__ __forceinline__ unsigned cvtpk(float lo, float hi) { unsigned r; asm volatile("v_cvt_pk_bf16_f32 %0, %1, %2" : "=v"(r) : "v"(lo), "v"(hi)); return r; }
#define DKSWZ(row, colB) ((row) * 128 + ((colB) ^ (((row) & 7) << 4)))
__device__ __forceinline__ int v_st(int k, int c) { const int kk = k;
  return ((kk >> 3) * 2 + (c >> 5)) * 512 + ((kk & 7) * 32 + (c & 31)) * 2; }
__device__ __forceinline__ int v_rd_base(int lane) { return ((lane & 3) << 3) | (((lane >> 2) & 3) << 6) | (((lane >> 4) & 1) << 5) | (((lane >> 5) & 1) << 8); }
constexpr int v_rd_off(int d0, int ks, int half) { return d0 * 512 + ks * 2048 + half * 1024; }
template <int OFF> __device__ __forceinline__ s16x4 tr_read(int vb) {
  s16x4 r; asm volatile("ds_read_b64_tr_b16 %0, %1 offset:%2" : "=&v"(r) : "v"(vb), "i"(OFF) : "memory"); return r;
}
template <int D0> __device__ __forceinline__ void pv_one(f32x16& od, int vb, bf16x8 pa0, bf16x8 pa1) {
  const s16x4 l0 = tr_read<v_rd_off(D0, 0, 0)>(vb), h0 = tr_read<v_rd_off(D0, 0, 1)>(vb), l1 = tr_read<v_rd_off(D0, 1, 0)>(vb), h1 = tr_read<v_rd_off(D0, 1, 1)>(vb);
  asm volatile("s_waitcnt lgkmcnt(0)" ::: "memory"); __builtin_amdgcn_sched_barrier(0);
#define PK(L, H) (bf16x8){L[0], L[1], L[2], L[3], H[0], H[1], H[2], H[3]}
  od = __builtin_amdgcn_mfma_f32_32x32x16_bf16(pa0, PK(l0, h0), od, 0, 0, 0);
  od = __builtin_amdgcn_mfma_f32_32x32x16_bf16(pa1, PK(l1, h1), od, 0, 0, 0);
#undef PK
}
struct KVRegs { bf16x8 k[4], v[4]; int pk; };
struct TaskId { int b, h, g, r, ub; };
__device__ __forceinline__ TaskId task_at(int i, int bx, int G, int wave) {
  TaskId t; int bh, k; t.b = 0; t.h = 0; t.g = 0; t.r = 0; t.ub = -1;
  if (G == 256) { if (i >= 6) return t; bh = (bx & 7) + 8 * (bx >> 6); k = ((((bx >> 3) & 7) * 6 + i) << 3) + wave; }
  else { const int id = (i * G + bx) * 8 + wave; if (id >= 12288) return t; bh = id / 384; k = id % 384; }
  const int g = k >> 7, kk = k & 127, nub = g == 0 ? 128 : (g == 1 ? 32 : 8);
  t.b = bh >> 3; t.h = bh & 7; t.g = g; t.r = kk / nub; t.ub = kk % nub; return t;
}
struct Pre { bf16x8 qr[4]; int pos_q; KVRegs R; };
__device__ __forceinline__ void load_blk(const unsigned short* __restrict__ qkv, const int* __restrict__ pos, const TaskId& t, int kb, KVRegs& R) {
  const int lane = threadIdx.x & 63, r32 = lane & 31, srow = lane >> 1, shalf = (lane & 1) * 32;
  const int dl = t.g == 0 ? 1 : (t.g == 1 ? 4 : 16), L = S / dl; const size_t rowb = (size_t)t.b * S;
  int up = 32 * (t.ub - 2 + kb) + srow; up = up < 0 ? 0 : (up >= L ? L - 1 : up);
  const unsigned short* base = qkv + (rowb + t.r + dl * up) * 1536 + t.h * 64 + shalf;
#pragma unroll
  for (int c = 0; c < 4; ++c) { R.k[c] = *reinterpret_cast<const bf16x8*>(base + 512 + c * 8); R.v[c] = *reinterpret_cast<const bf16x8*>(base + 1024 + c * 8); }
  int upl = 32 * (t.ub - 2 + kb) + r32; upl = upl < 0 ? 0 : (upl >= L ? L - 1 : upl);
  R.pk = pos[rowb + t.r + dl * upl];
}
__device__ __forceinline__ int kb_first(const TaskId& t) { return (t.ub >= 2) ? 0 : (2 - t.ub); }
__device__ __forceinline__ void dil_prefetch(const unsigned short* __restrict__ qkv, const int* __restrict__ pos, const TaskId& t, Pre& P) {
  const int lane = threadIdx.x & 63, r32 = lane & 31, hi = lane >> 5;
  const int dl = t.g == 0 ? 1 : (t.g == 1 ? 4 : 16); const size_t rowb = (size_t)t.b * S; const int tok_q = t.r + dl * (32 * t.ub + r32);
  const unsigned short* Qw = qkv + (rowb + tok_q) * 1536 + t.h * 64 + hi * 8;
#pragma unroll
  for (int d0 = 0; d0 < 4; ++d0) P.qr[d0] = *reinterpret_cast<const bf16x8*>(Qw + d0 * 16);
  P.pos_q = pos[rowb + tok_q];
  load_blk(qkv, pos, t, kb_first(t), P.R);
}
__device__ __forceinline__ void dil_task(const unsigned short* __restrict__ qkv, const int* __restrict__ pos, unsigned short* __restrict__ oap, float* __restrict__ lse,
                                         const TaskId t, Pre& P, bool has_next, const TaskId tn, char* wl  ) {
  const int lane = threadIdx.x & 63, r32 = lane & 31, hi = lane >> 5;
  const int b = t.b, h = t.h, g = t.g, r = t.r, ub = t.ub;
  const int dl = g == 0 ? 1 : (g == 1 ? 4 : 16), L = S / dl;
  const int u_q = 32 * ub + r32;
  const size_t rowb = (size_t)b * S;
  const int tok_q = r + dl * u_q;
  const float* tblw = (const float*)(wl + W_TBL); int* posw = (int*)(wl + W_POS); float* alw = (float*)(wl + W_AL);
  bf16x8 qr[4];
#pragma unroll
  for (int d0 = 0; d0 < 4; ++d0) qr[d0] = P.qr[d0];
  const int pos_q = P.pos_q;
  const int srow = lane >> 1, shalf = (lane & 1) * 32;
  const int vb0 = (int)(uintptr_t)(wl + W_V) + v_rd_base(lane);
  float m_reg = -1e30f, l_reg = 0.f; f32x16 o[2] = {};
  const int kb_lo = kb_first(t), kb_hi = (32 * (ub + 3) <= L) ? 4 : (4 - ((32 * (ub + 3) - L) >> 5));
  KVRegs R = P.R;
  for (int kb = kb_lo; kb <= kb_hi; ++kb) {
#pragma unroll
    for (int c = 0; c < 4; ++c) {
      *(bf16x8*)(wl + W_K + DKSWZ(srow, (shalf + c * 8) * 2)) = R.k[c];
      *(bf16x8*)(wl + W_V + v_st(srow, shalf + c * 8)) = R.v[c];
    }
    if (hi == 0) posw[r32] = R.pk;
    if (kb < kb_hi) load_blk(qkv, pos, t, kb + 1, R);
    asm volatile("s_waitcnt lgkmcnt(0)" ::: "memory"); __builtin_amdgcn_sched_barrier(0);
    f32x16 p = {};
#pragma unroll
    for (int d0 = 0; d0 < 4; ++d0) {
      const bf16x8 kf = *reinterpret_cast<const bf16x8*>(wl + W_K + DKSWZ(r32, (d0 * 16 + hi * 8) * 2));
      p = __builtin_amdgcn_mfma_f32_32x32x16_bf16(kf, qr[d0], p, 0, 0, 0);
    }
    float bmax;
    {
      int idx[16];
#pragma unroll
      for (int rr = 0; rr < 16; ++rr) { int rel = posw[crow(rr, hi)] - pos_q; rel = rel < -1024 ? -1024 : (rel > 1024 ? 1024 : rel); const int i_ = rel + 1024; idx[rr] = i_ ^ ((i_ >> 5) & 31); }
#pragma unroll
      for (int rr = 0; rr < 16; ++rr) p[rr] += tblw[idx[rr]];
    }
    if (kb == 0) {
#pragma unroll
      for (int rr = 0; rr < 16; ++rr) p[rr] = crow(rr, hi) >= r32 ? p[rr] : -INFINITY;
    } else if (kb == 4) {
#pragma unroll
      for (int rr = 0; rr < 16; ++rr) p[rr] = crow(rr, hi) <= r32 ? p[rr] : -INFINITY;
    }
    bmax = fmaxf(fmaxf(p[0], p[1]), fmaxf(p[2], p[3]));
#pragma unroll
    for (int rr = 4; rr < 16; rr += 4) bmax = fmaxf(bmax, fmaxf(fmaxf(p[rr], p[rr + 1]), fmaxf(p[rr + 2], p[rr + 3])));
    { auto x = __builtin_amdgcn_permlane32_swap(__float_as_uint(bmax), __float_as_uint(bmax), false, false); bmax = fmaxf(__uint_as_float(x[0]), __uint_as_float(x[1])); }
    float alpha = 1.f; bool resc = false;
    if (!__all(bmax - m_reg <= 11.5f)) { const float mn = fmaxf(m_reg, bmax); alpha = __builtin_amdgcn_exp2f(m_reg - mn); m_reg = mn; resc = true; }
    float ps = 0.f;
#pragma unroll
    for (int rr = 0; rr < 16; ++rr) p[rr] = __builtin_amdgcn_exp2f(p[rr] - m_reg);
    ps = ((p[0] + p[1]) + (p[2] + p[3])) + ((p[4] + p[5]) + (p[6] + p[7])) + (((p[8] + p[9]) + (p[10] + p[11])) + ((p[12] + p[13]) + (p[14] + p[15])));
    { auto x = __builtin_amdgcn_permlane32_swap(__float_as_uint(ps), __float_as_uint(ps), false, false); ps = __uint_as_float(x[0]) + __uint_as_float(x[1]); }
    l_reg = l_reg * alpha + ps;
    if (resc && kb != kb_lo) {
      if (hi == 0) alw[r32] = alpha;
      asm volatile("s_waitcnt lgkmcnt(0)" ::: "memory");
#pragma unroll
      for (int d = 0; d < 2; ++d)
#pragma unroll
        for (int rr = 0; rr < 16; ++rr) o[d][rr] *= alw[crow(rr, hi)];
    }
    bf16x8 pa0, pa1;
#define PK4(P, BASE, OUT) do { u32x4 w = {cvtpk(P[BASE + 0], P[BASE + 1]), cvtpk(P[BASE + 2], P[BASE + 3]), cvtpk(P[BASE + 4], P[BASE + 5]), cvtpk(P[BASE + 6], P[BASE + 7])}; \
    OUT = *reinterpret_cast<bf16x8*>(&w); } while (0)
    PK4(p, 0, pa0); PK4(p, 8, pa1);
#undef PK4
    pv_one<0>(o[0], vb0, pa0, pa1); pv_one<1>(o[1], vb0, pa0, pa1);
  }
  if (has_next) dil_prefetch(qkv, pos, tn, P);
  float* liw = alw;
  if (hi == 0) liw[r32] = l_reg;
  asm volatile("s_waitcnt lgkmcnt(0)" ::: "memory");
  if (hi == 0) lse[((size_t)g * T + rowb + tok_q) * 8 + h] = (m_reg + __log2f(l_reg)) * 0.6931471805599453f;
  unsigned short* Ow = oap + ((size_t)g * T + rowb + r + (size_t)dl * 32 * ub) * 512 + h * 64;
  char* ot = wl + W_K;
#pragma unroll
  for (int rr = 0; rr < 16; ++rr) { const int orow = crow(rr, hi); const float rl = __builtin_amdgcn_rcpf(liw[orow]);
#pragma unroll
    for (int d0 = 0; d0 < 2; ++d0) *(unsigned short*)(ot + orow * 144 + (d0 * 32 + r32) * 2) = (unsigned short)cvtpk(o[d0][rr] * rl, 0.f); }
  asm volatile("s_waitcnt lgkmcnt(0)" ::: "memory");
#pragma unroll
  for (int ps = 0; ps < 4; ++ps) { const int orow = ps * 8 + (lane >> 3), c = lane & 7;
    const u32x4 w = *(const u32x4*)(ot + orow * 144 + c * 16);
    *(u32x4*)(Ow + (size_t)orow * dl * 512 + c * 8) = w; }
  asm volatile("s_waitcnt lgkmcnt(0)" ::: "memory");
}
#undef DKSWZ
}

namespace mk {
#define GAS __attribute__((address_space(1)))
#define LAS __attribute__((address_space(3)))
typedef unsigned short bf16_t;
typedef unsigned v4u __attribute__((ext_vector_type(4)));
typedef unsigned v2u __attribute__((ext_vector_type(2)));
typedef float f32x4 __attribute__((ext_vector_type(4)));
#define LDS_WAIT() asm volatile("s_waitcnt lgkmcnt(0)" ::: "memory")
#define VM_WAIT() asm volatile("s_waitcnt vmcnt(0)" ::: "memory")
__device__ __forceinline__ unsigned f2bf(float f) { unsigned u = __builtin_bit_cast(unsigned, f); return (u + 0x7fffu + ((u >> 16) & 1u)) >> 16; }
typedef float f32x2_t __attribute__((ext_vector_type(2))); typedef __bf16 bf16x2_t __attribute__((ext_vector_type(2)));
__device__ __forceinline__ unsigned pk2(float lo, float hi) { const f32x2_t v = {lo, hi}; const bf16x2_t b = __builtin_convertvector(v, bf16x2_t); return __builtin_bit_cast(unsigned, b); }
__device__ __forceinline__ float bf2f(unsigned short b) { return __builtin_bit_cast(float, (unsigned)b << 16); }
__device__ __forceinline__ float wave_sum(float v) {
#pragma unroll
    for (int o = 1; o < 64; o <<= 1) v += __shfl_xor(v, o);
    return v;
}

#define XB_TMO      128
#define XB_XCNT(j)  (256  + 64 * (j))
#define XB_XSUB(j)  (1280 + 64 * (j))
#define XB_XGEN(j)  (2304 + 64 * (j))
#define XB_TOP      3328
#define XB_TOPGEN   3392
#define XCD_BAR_WORDS 3456
#define XB_SPIN_CAP (1u << 18)

__device__ __forceinline__ unsigned xb_ld(unsigned* p)              { return __hip_atomic_load(p, __ATOMIC_RELAXED, __HIP_MEMORY_SCOPE_AGENT); }
__device__ __forceinline__ unsigned xb_add(unsigned* p, unsigned v) { return __hip_atomic_fetch_add(p, v, __ATOMIC_RELAXED, __HIP_MEMORY_SCOPE_AGENT); }
__device__ __forceinline__ unsigned xb_xcc_id() { return (unsigned)__builtin_amdgcn_s_getreg((3 << 11) | 20) & 0xFu; }
#define XB_SPIN(cond, bar) do { unsigned _sp = 0; while (cond) { __builtin_amdgcn_s_sleep(1); \
    if ((++_sp & 255u) == 0u) { if (xb_ld(&(bar)[XB_TMO])) break; if (_sp > XB_SPIN_CAP) { atomicAdd(&(bar)[XB_TMO], 1u); break; } } } } while (0)

struct XcdBarrier {
    unsigned* bar; unsigned x;
    volatile LAS unsigned* st;
};

__device__ __forceinline__ XcdBarrier xcd_barrier_post(unsigned* bar, volatile LAS unsigned* st) {
    XcdBarrier b; b.bar = bar; b.x = xb_xcc_id(); b.st = st;
    if (threadIdx.x == 0) (void)xb_add(&bar[XB_XCNT(b.x)], 1u);
    return b;
}
__device__ __forceinline__ void xcd_barrier_complete(unsigned* bar, unsigned x, unsigned& nloc, unsigned& nx) {
    const unsigned G = gridDim.x * gridDim.y * gridDim.z;
    unsigned sum, cnt, mine, sp = 0u;
    for (;;) {
        sum = 0u; cnt = 0u; mine = 0u;
#pragma unroll
        for (unsigned j = 0; j < 16; ++j) { const unsigned c = xb_ld(&bar[XB_XCNT(j)]); sum += c; cnt += (c > 0u) ? 1u : 0u; mine = (j == x) ? c : mine; }
        if (sum == G) break;
        __builtin_amdgcn_s_sleep(1);
        if ((++sp & 255u) == 0u) { if (xb_ld(&bar[XB_TMO])) break; if (sp > XB_SPIN_CAP) { atomicAdd(&bar[XB_TMO], 1u); break; } }
    }
    nloc = mine > 0u ? mine : 1u; nx = cnt > 0u ? cnt : 1u;
}

__device__ __forceinline__ void xcd_barrier(const XcdBarrier& b) {
    asm volatile("s_waitcnt vmcnt(0)" ::: "memory");
    __syncthreads();
    if (threadIdx.x == 0) {
        unsigned* bar = b.bar;
        __builtin_amdgcn_s_waitcnt(0);
        unsigned nloc = b.st[0], nx = b.st[1];
        if (nloc == 0u) { xcd_barrier_complete(bar, b.x, nloc, nx); b.st[0] = nloc; b.st[1] = nx; }
        const unsigned old = xb_add(&bar[XB_XSUB(b.x)], 1u);
        const unsigned gen = old / nloc;
        if (old + 1u == (gen + 1u) * nloc) {
            __builtin_amdgcn_fence(__ATOMIC_RELEASE, "agent");
            asm volatile("s_waitcnt vmcnt(0)" ::: "memory");
            const unsigned og = xb_add(&bar[XB_TOP], 1u);
            const unsigned tg = og / nx;
            if (og + 1u == (tg + 1u) * nx) xb_add(&bar[XB_TOPGEN], 1u);
            else XB_SPIN(xb_ld(&bar[XB_TOPGEN]) == tg, bar);
            __builtin_amdgcn_fence(__ATOMIC_ACQUIRE, "agent");
            xb_add(&bar[XB_XGEN(b.x)], 1u);
            asm volatile("s_waitcnt vmcnt(0)" ::: "memory");
        } else {
            XB_SPIN(xb_ld(&bar[XB_XGEN(b.x)]) == gen, bar);
            __builtin_amdgcn_fence(__ATOMIC_ACQUIRE, "agent");
            asm volatile("s_waitcnt vmcnt(0)" ::: "memory");
        }
    }
    __syncthreads();
}

constexpr int NWAVES = 8;
constexpr int LDS_BYTES = 147456;
constexpr int RING_BYTES = 131072;
constexpr int CTRL_OFF = 135168;
constexpr int MISC_OFF = CTRL_OFF + 320;
constexpr size_t MiB = 1u << 20;
constexpr size_t WS_CTL = 0, CTL_ZERO_BYTES = 1 * MiB;
constexpr int CW_BAR = 16384;
constexpr size_t WS_WIN = 1 * MiB, WS_WQB = 5 * MiB, WS_WKVB = 5 * MiB + 512 * 1024, WS_WO = 6 * MiB, WS_WMQG = 8 * MiB, WS_WMKV = 10 * MiB, WS_WMO = 14 * MiB;
constexpr size_t WS_RSTDX = 16 * MiB, WS_RSTDM = 16 * MiB + 64 * 1024, WS_SSQQ = 16 * MiB + 256 * 1024, WS_SSQKV = 16 * MiB + 512 * 1024, WS_TBL = 16 * MiB + 768 * 1024;
constexpr size_t WS_WRG = 16 * MiB + 896 * 1024;
constexpr size_t WS_SSQH1 = 17 * MiB, WS_SSQH2 = 18 * MiB, WS_ZKPE = 20 * MiB, WS_CS = 22 * MiB;
constexpr size_t WS_XB = 24 * MiB, WS_MEMB = 56 * MiB, WS_KVMEM = 58 * MiB, WS_KPE = 62 * MiB;
constexpr size_t WS_QKVA = 64 * MiB, WS_ZQ = 112 * MiB, WS_ZKV = 120 * MiB, WS_QB = 124 * MiB, WS_KN = 148 * MiB, WS_VB = 164 * MiB;
constexpr size_t WS_WPT = 180 * MiB, WS_VWT = 188 * MiB, WS_H2 = 196 * MiB, WS_H2B = 260 * MiB, WS_ROUTE = 292 * MiB, WS_XS = 296 * MiB;
constexpr size_t WS_HMID = 296 * MiB, WS_OAP = 440 * MiB, WS_LSE = 488 * MiB, WS_OB = 490 * MiB, WS_OMIX = 506 * MiB;
constexpr size_t WS_H1 = 538 * MiB, WS_H1B = 602 * MiB, WS_P = 634 * MiB, WS_YBUF = 666 * MiB;
constexpr size_t WS_WGU = 794 * MiB, WS_WD = 922 * MiB, WS_END = 986 * MiB;

struct Args { const float* in[26]; float* out; unsigned char* ws; double rope_rev[16]; int ph_lo, ph_hi, flags, pad; };

struct CvtDesc { const float* W; const float* gain; bf16_t* WT; int K, N, mode, item; };
__device__ __forceinline__ void cvt_load(const CvtDesc& d, f32x4 (&v)[16], int lane) {
    const int nblk = (d.N + 63) >> 6, kb = d.item / nblk, nb = d.item % nblk, k0 = 64 * kb, n0 = 64 * nb;
    const int lk = lane >> 4, ln = (lane & 15) * 4;
    const bool ok = n0 + ln < d.N;
    const float* wp = d.W + (size_t)(k0 + lk) * d.N + n0 + ln;
#pragma unroll
    for (int i = 0; i < 16; ++i) v[i] = ok ? __builtin_nontemporal_load((const f32x4*)(wp + (size_t)(4 * i) * d.N)) : (f32x4){0.f, 0.f, 0.f, 0.f};
}
__device__ __forceinline__ void cvt_store(const CvtDesc& d, f32x4 (&v)[16], LAS float* scr, int lane) {
    const int nblk = (d.N + 63) >> 6, kb = d.item / nblk, nb = d.item % nblk, k0 = 64 * kb, n0 = 64 * nb;
    const int lk = lane >> 4, ln = (lane & 15) * 4;
    if (d.gain) {
#pragma unroll
        for (int i = 0; i < 16; ++i) v[i] = v[i] * d.gain[k0 + 4 * i + lk];
    }
#pragma unroll
    for (int i = 0; i < 16; ++i) { LAS float* p = scr + (4 * i + lk) * 65 + ln; p[0] = v[i][0]; p[1] = v[i][1]; p[2] = v[i][2]; p[3] = v[i][3]; }
    LDS_WAIT(); asm volatile("" ::: "memory");
    int drow0 = n0; if (d.mode == 1) { const int half = n0 >> 10, c = n0 & 1023; drow0 = (c >> 7) * 256 + half * 128 + (c & 127); }
    const int c = lane & 7;
#pragma unroll
    for (int j = 0; j < 8; ++j) { const int n = (lane >> 3) + 8 * j; const LAS float* sp = scr + (8 * c) * 65 + n;
        v4u o; o.x = pk2(sp[0 * 65], sp[1 * 65]); o.y = pk2(sp[2 * 65], sp[3 * 65]); o.z = pk2(sp[4 * 65], sp[5 * 65]); o.w = pk2(sp[6 * 65], sp[7 * 65]);
        __builtin_nontemporal_store(o, (v4u*)(d.WT + (size_t)(drow0 + n) * d.K + k0 + 8 * c)); }
    LDS_WAIT(); asm volatile("" ::: "memory");
}
__device__ __forceinline__ void prep_rows4(const float* x0, bf16_t* o0, float* rstd_out, int lane) {
    f32x4 v[4][4]; float s[4];
#pragma unroll
    for (int r = 0; r < 4; ++r)
#pragma unroll
        for (int j = 0; j < 4; ++j) v[r][j] = ((const f32x4*)(x0 + (size_t)r * 1024))[lane + 64 * j];
#pragma unroll
    for (int r = 0; r < 4; ++r) { float a = 0.f;
#pragma unroll
        for (int j = 0; j < 4; ++j) a += (v[r][j].x * v[r][j].x + v[r][j].y * v[r][j].y) + (v[r][j].z * v[r][j].z + v[r][j].w * v[r][j].w);
        s[r] = wave_sum(a); }
    if (lane < 4) rstd_out[lane] = 1.0f / sqrtf((lane == 0 ? s[0] : lane == 1 ? s[1] : lane == 2 ? s[2] : s[3]) * (1.0f / 1024.0f) + 1e-6f);
#pragma unroll
    for (int r = 0; r < 4; ++r) { unsigned long long* o8 = (unsigned long long*)(o0 + (size_t)r * 1024) + lane;
#pragma unroll
        for (int j = 0; j < 4; ++j) o8[64 * j] = (unsigned long long)pk2(v[r][j].x, v[r][j].y) | ((unsigned long long)pk2(v[r][j].z, v[r][j].w) << 32); }
}

__device__ __forceinline__ v4u pack8(const f32x4 a, const f32x4 b) { v4u w; w.x = pk2(a[0], a[1]); w.y = pk2(a[2], a[3]); w.z = pk2(b[0], b[1]); w.w = pk2(b[2], b[3]); return w; }
__device__ __forceinline__ float sq8(const f32x4 a, const f32x4 b) { return (a[0] * a[0] + a[1] * a[1]) + (a[2] * a[2] + a[3] * a[3]) + (b[0] * b[0] + b[1] * b[1]) + (b[2] * b[2] + b[3] * b[3]); }

struct EpiInProj {
    static constexpr bool PERM = true, AFTER_DRAIN = false;
    const float* rstd; bf16_t* qkv; bf16_t* zq; bf16_t* zkv; float* zkpe; float* ssq_q; float* ssq_kv;
    __device__ __forceinline__ void operator()(const pg8::f32x4 (&acc)[2][2][4][2], const pg8::Unit& u, int wr, int wc, int fr, int fq) const {
        const int row0 = u.pm * 256 + wr * 64 + fr;
        const float qs = u.pn < 2 ? 0.125f * 1.4426950408889634f : 1.0f;
        float rsv[8];
#pragma unroll
        for (int q = 0; q < 8; ++q) rsv[q] = rstd[row0 + (q >> 2) * 128 + (q & 3) * 16];
#pragma unroll
        for (int ai = 0; ai < 2; ++ai)
#pragma unroll
            for (int m = 0; m < 4; ++m) {
                const int row = row0 + ai * 128 + m * 16;
                const float rs = rsv[ai * 4 + m];
                float ss = 0.f;
#pragma unroll
                for (int bj = 0; bj < 2; ++bj) {
                    const f32x4 v0 = acc[ai][bj][m][0] * rs, v1 = acc[ai][bj][m][1] * rs;
                    const int ct = bj * 128 + wc * 32 + 8 * fq;
                    if (u.pn < 6) { *(v4u*)(qkv + (size_t)row * 1536 + u.pn * 256 + ct) = pack8(v0 * qs, v1 * qs); }
                    else if (u.pn == 6) { *(v4u*)(zq + (size_t)row * 256 + ct) = pack8(v0, v1); ss += sq8(v0, v1); }
                    else if (bj == 0) { *(v4u*)(zkv + (size_t)row * 128 + ct) = pack8(v0, v1); ss += sq8(v0, v1); }
                    else if (wc == 0) { *(f32x4*)(zkpe + (size_t)row * 32 + 8 * fq) = v0; *(f32x4*)(zkpe + (size_t)row * 32 + 8 * fq + 4) = v1; }
                }
                if (u.pn >= 6) { ss += __shfl_xor(ss, 16); ss += __shfl_xor(ss, 32); if (fq == 0) (u.pn == 6 ? ssq_q : ssq_kv)[(size_t)row * 4 + wc] = ss; }
            }
    }
};


struct EpiQ {
    static constexpr bool PERM = true, AFTER_DRAIN = false;
    const float* ssq; bf16_t* Q;
    __device__ __forceinline__ void operator()(const pg8::f32x4 (&acc)[2][2][4][2], const pg8::Unit& u, int wr, int wc, int fr, int fq) const {
        const int row0 = u.pm * 256 + wr * 64 + fr;
#pragma unroll
        for (int ai = 0; ai < 2; ++ai)
#pragma unroll
            for (int m = 0; m < 4; ++m) {
                const int row = row0 + ai * 128 + m * 16;
                const f32x4 sp = *(const f32x4*)(ssq + (size_t)row * 4);
                const float rs = (0.10206207261596577f * 1.4426950408889634f) / sqrtf(((sp[0] + sp[1]) + (sp[2] + sp[3])) * (1.0f / 256.0f) + 1e-6f);
#pragma unroll
                for (int bj = 0; bj < 2; ++bj)
                    *(v4u*)(Q + (size_t)row * 768 + u.pn * 256 + bj * 128 + wc * 32 + 8 * fq) = pack8(acc[ai][bj][m][0] * rs, acc[ai][bj][m][1] * rs);
            }
    }
};
struct EpiKV {
    static constexpr bool PERM = true, AFTER_DRAIN = false;
    const float* ssq; bf16_t* Kn; bf16_t* Vb;
    __device__ __forceinline__ void operator()(const pg8::f32x4 (&acc)[2][2][4][2], const pg8::Unit& u, int wr, int wc, int fr, int fq) const {
        const int row0 = u.pm * 256 + wr * 64 + fr;
        bf16_t* dst = (wc < 2 ? Kn : Vb) + (wc & 1) * 32 + 8 * fq;
#pragma unroll
        for (int ai = 0; ai < 2; ++ai)
#pragma unroll
            for (int m = 0; m < 4; ++m) {
                const int row = row0 + ai * 128 + m * 16;
                const f32x4 sp = *(const f32x4*)(ssq + (size_t)row * 4);
                const float rs = 1.0f / sqrtf(((sp[0] + sp[1]) + (sp[2] + sp[3])) * (1.0f / 128.0f) + 1e-6f);
#pragma unroll
                for (int bj = 0; bj < 2; ++bj)
                    *(v4u*)(dst + (size_t)row * 512 + (u.pn * 2 + bj) * 64) = pack8(acc[ai][bj][m][0] * rs, acc[ai][bj][m][1] * rs);
            }
    }
};
struct EpiRowScale {
    static constexpr bool PERM = true, AFTER_DRAIN = false;
    const float* rs; bf16_t* O; int ldc;
    __device__ __forceinline__ void operator()(const pg8::f32x4 (&acc)[2][2][4][2], const pg8::Unit& u, int wr, int wc, int fr, int fq) const {
        const int row0 = u.pm * 256 + wr * 64 + fr;
#pragma unroll
        for (int ai = 0; ai < 2; ++ai)
#pragma unroll
            for (int m = 0; m < 4; ++m) {
                const int row = row0 + ai * 128 + m * 16;
                const float r = rs[row];
#pragma unroll
                for (int bj = 0; bj < 2; ++bj)
                    *(v4u*)(O + (size_t)row * ldc + u.pn * 256 + bj * 128 + wc * 32 + 8 * fq) = pack8(acc[ai][bj][m][0] * r, acc[ai][bj][m][1] * r);
            }
    }
};

template <bool BASE_BF16> struct EpiResid {
    static constexpr bool PERM = true, AFTER_DRAIN = false;
    const void* base; bf16_t* outb; float* ssq;
    __device__ __forceinline__ void operator()(const pg8::f32x4 (&acc)[2][2][4][2], const pg8::Unit& u, int wr, int wc, int fr, int fq) const {
        const int row0 = u.pm * 256 + wr * 64 + fr;
#pragma unroll
        for (int ai = 0; ai < 2; ++ai)
#pragma unroll
            for (int m = 0; m < 4; ++m) {
                const int row = row0 + ai * 128 + m * 16;
                float ss = 0.f;
#pragma unroll
                for (int bj = 0; bj < 2; ++bj) {
                    const size_t o = (size_t)row * 1024 + u.pn * 256 + bj * 128 + wc * 32 + 8 * fq;
                    f32x4 b0, b1;
                    if constexpr (BASE_BF16) { const v4u w = *(const v4u*)((const bf16_t*)base + o);
                        b0 = (f32x4){__builtin_bit_cast(float, w[0] << 16), __builtin_bit_cast(float, w[0] & 0xffff0000u), __builtin_bit_cast(float, w[1] << 16), __builtin_bit_cast(float, w[1] & 0xffff0000u)};
                        b1 = (f32x4){__builtin_bit_cast(float, w[2] << 16), __builtin_bit_cast(float, w[2] & 0xffff0000u), __builtin_bit_cast(float, w[3] << 16), __builtin_bit_cast(float, w[3] & 0xffff0000u)}; }
                    else { b0 = *(const f32x4*)((const float*)base + o); b1 = *(const f32x4*)((const float*)base + o + 4); }
                    const f32x4 v0 = acc[ai][bj][m][0] + b0, v1 = acc[ai][bj][m][1] + b1;
                    *(v4u*)(outb + o) = pack8(v0, v1); ss += sq8(v0, v1);
                }
                ss += __shfl_xor(ss, 16); ss += __shfl_xor(ss, 32);
                if (fq == 0) ssq[(size_t)row * 16 + u.pn * 4 + wc] = ss;
                asm volatile("" ::: "memory");
            }
    }
};
struct EpiPlain {
    static constexpr bool PERM = true, AFTER_DRAIN = false;
    bf16_t* O; int ldc;
    __device__ __forceinline__ void operator()(const pg8::f32x4 (&acc)[2][2][4][2], const pg8::Unit& u, int wr, int wc, int fr, int fq) const {
        const int row0 = u.pm * 256 + wr * 64 + fr;
#pragma unroll
        for (int ai = 0; ai < 2; ++ai)
#pragma unroll
            for (int m = 0; m < 4; ++m)
#pragma unroll
                for (int bj = 0; bj < 2; ++bj)
                    *(v4u*)(O + (size_t)(row0 + ai * 128 + m * 16) * ldc + u.pn * 256 + bj * 128 + wc * 32 + 8 * fq) = pack8(acc[ai][bj][m][0], acc[ai][bj][m][1]);
    }
};
struct EpiSoftmax {
    static constexpr bool PERM = true, AFTER_DRAIN = true;
    bf16_t* P; int rsl_off;
    __device__ __forceinline__ void fused(pg8::f32x4 (&acc)[2][2][4][2], const pg8::Unit& u, int wr, int wc, int fr, int fq, PG8_LAS unsigned char* lds, int wid, int lane) const {
        typedef float f32x2v __attribute__((ext_vector_type(2)));
        const PG8_LAS float* rsl = (const PG8_LAS float*)(lds + rsl_off);
        PG8_LAS f32x2v* X = (PG8_LAS f32x2v*)lds;
        constexpr float L2E = 1.4426950408889634f;
#pragma unroll
        for (int ai = 0; ai < 2; ++ai)
#pragma unroll
            for (int m = 0; m < 4; ++m) {
                const int rt = ai * 128 + wr * 64 + m * 16 + fr;
                const float rs = rsl[rt] * (0.0625f * L2E);
                float mx = -3.0e38f;
#pragma unroll
                for (int bj = 0; bj < 2; ++bj)
#pragma unroll
                    for (int n = 0; n < 2; ++n) { f32x4 v = acc[ai][bj][m][n] * rs; acc[ai][bj][m][n] = v; mx = fmaxf(mx, fmaxf(fmaxf(v[0], v[1]), fmaxf(v[2], v[3]))); }
                mx = fmaxf(mx, __shfl_xor(mx, 16)); mx = fmaxf(mx, __shfl_xor(mx, 32));
                float sm = 0.f;
#pragma unroll
                for (int bj = 0; bj < 2; ++bj)
#pragma unroll
                    for (int n = 0; n < 2; ++n) { const f32x4 v = acc[ai][bj][m][n]; sm += (__builtin_amdgcn_exp2f(v[0] - mx) + __builtin_amdgcn_exp2f(v[1] - mx)) + (__builtin_amdgcn_exp2f(v[2] - mx) + __builtin_amdgcn_exp2f(v[3] - mx)); }
                sm += __shfl_xor(sm, 16); sm += __shfl_xor(sm, 32);
                if (fq == 0) X[rt * 4 + wc] = (f32x2v){mx, sm};
            }
        asm volatile("s_waitcnt lgkmcnt(0)" ::: "memory"); __builtin_amdgcn_s_barrier(); asm volatile("" ::: "memory");
#pragma unroll
        for (int ai = 0; ai < 2; ++ai)
#pragma unroll
            for (int m = 0; m < 4; ++m) {
                const int rt = ai * 128 + wr * 64 + m * 16 + fr;
                const f32x2v x0 = X[rt * 4 + 0], x1 = X[rt * 4 + 1], x2 = X[rt * 4 + 2], x3 = X[rt * 4 + 3];
                const float M = fmaxf(fmaxf(x0.x, x1.x), fmaxf(x2.x, x3.x));
                const float tot = (x0.y * __builtin_amdgcn_exp2f(x0.x - M) + x1.y * __builtin_amdgcn_exp2f(x1.x - M)) + (x2.y * __builtin_amdgcn_exp2f(x2.x - M) + x3.y * __builtin_amdgcn_exp2f(x3.x - M));
                const float inv = 1.0f / tot;
#pragma unroll
                for (int bj = 0; bj < 2; ++bj) {
                    f32x4 a = acc[ai][bj][m][0], b = acc[ai][bj][m][1];
#pragma unroll
                    for (int j = 0; j < 4; ++j) { a[j] = __builtin_amdgcn_exp2f(a[j] - M) * inv; b[j] = __builtin_amdgcn_exp2f(b[j] - M) * inv; }
                    *(v4u*)(P + (size_t)(u.pm * 256 + rt) * 1024 + u.pn * 256 + bj * 128 + wc * 32 + 8 * fq) = pack8(a, b);
                }
            }
    }
};
struct OrderWp {
    int c;
    __device__ __forceinline__ bool next(int i, pg8::Unit& u) const { if (i > 0 || c >= 64) return false; const int bhh = c >> 2, pn = c & 3, b = bhh >> 2, h = bhh & 3;
        u.pm = bhh; u.pn = pn; u.aoff = ((size_t)(b * 256) * 2048 + h * 256) * 2; u.boff = ((size_t)(pn * 256) * 1024 + h * 256) * 2; return true; }
    __device__ __forceinline__ void a_ready(const pg8::Unit&) const {}
    __device__ __forceinline__ void done(const pg8::Unit&) const {}
};
struct OrderVw {
    int c;
    __device__ __forceinline__ bool next(int i, pg8::Unit& u) const { if (i > 0 || c >= 64) return false; const int b = c >> 4, ct = (c >> 2) & 3, h = c & 3;
        u.pm = b * 4 + ct; u.pn = h; u.aoff = ((size_t)(ct * 256) * 1024 + h * 256) * 2; u.boff = ((size_t)(b * 256) * 2048 + 1024 + h * 256) * 2; return true; }
    __device__ __forceinline__ void a_ready(const pg8::Unit&) const {}
    __device__ __forceinline__ void done(const pg8::Unit&) const {}
};
struct OrderBatch {
    pg8::StaticOrder so;
    __device__ __forceinline__ bool next(int i, pg8::Unit& u) const { if (!so.next(i, u)) return false; u.boff = ((size_t)((u.pm >> 4) * 1024 + u.pn * 256) * 1024) * 2; return true; }
    __device__ __forceinline__ void a_ready(const pg8::Unit&) const {}
    __device__ __forceinline__ void done(const pg8::Unit&) const {}
};

constexpr int MPADN = NA + NE * 256, NTILEN = MPADN / 256;
constexpr int CW_GCOUNT = 8192;
constexpr size_t RT_TOPI = 0, RT_TOPG = 256 * 1024, RT_SLOT = 512 * 1024, RT_ROWFLAT = 768 * 1024, RT_RSROW = 1088 * 1024, RT_RSTD = 1408 * 1024, RT_CNT = 1536 * 1024, RT_TOT = 1600 * 1024, RT_RGATE = 1664 * 1024;
constexpr int LX_TEXP = CTRL_OFF + 2048;
struct OrderMoe {
    const LAS int* texp; int nper, c, G; size_t ebytes;
    __device__ __forceinline__ bool next(int i, pg8::Unit& u) const {
        const int L = i * G + (c & 7) * (G >> 3) + (c >> 3); const int tile = L / nper, pn = L % nper;
        if (tile >= texp[NTILEN]) return false;
        u.pm = tile; u.pn = pn; u.aoff = (size_t)tile * 256 * 1024 * 2; u.boff = (size_t)texp[tile] * ebytes + (size_t)pn * 256 * 1024 * 2; return true; }
    __device__ __forceinline__ void a_ready(const pg8::Unit&) const {}
    __device__ __forceinline__ void done(const pg8::Unit&) const {}
};
__device__ __forceinline__ float swiglu1(float g, float u) { g = fminf(g, 7.0f); u = fminf(fmaxf(u, -7.0f), 7.0f); return (u + 1.0f) * g * __builtin_amdgcn_rcpf(1.0f + __builtin_amdgcn_exp2f(-1.702f * 1.4426950408889634f * g)); }
struct EpiSwiGLU {
    static constexpr bool PERM = true, AFTER_DRAIN = false;
    const float* rs_row; const float* bgu; bf16_t* hmid; const LAS int* texp;
    __device__ __forceinline__ void operator()(const pg8::f32x4 (&acc)[2][2][4][2], const pg8::Unit& u, int wr, int wc, int fr, int fq) const {
        const int row0 = u.pm * 256 + wr * 64 + fr, e = texp[u.pm], c0 = u.pn * 128 + wc * 32 + 8 * fq;
        const float* bg = bgu + (size_t)e * 2048 + c0;
        const f32x4 bg0 = *(const f32x4*)bg, bg1 = *(const f32x4*)(bg + 4), bu0 = *(const f32x4*)(bg + 1024), bu1 = *(const f32x4*)(bg + 1028);
        float rsv[8];
#pragma unroll
        for (int q = 0; q < 8; ++q) rsv[q] = rs_row[row0 + (q >> 2) * 128 + (q & 3) * 16];
#pragma unroll
        for (int ai = 0; ai < 2; ++ai)
#pragma unroll
            for (int m = 0; m < 4; ++m) {
                const int row = row0 + ai * 128 + m * 16; const float rs = rsv[ai * 4 + m];
                const f32x4 g0 = acc[ai][0][m][0] * rs + bg0, g1 = acc[ai][0][m][1] * rs + bg1, u0 = acc[ai][1][m][0] * rs + bu0, u1 = acc[ai][1][m][1] * rs + bu1;
                f32x4 h0, h1;
#pragma unroll
                for (int j = 0; j < 4; ++j) { h0[j] = swiglu1(g0[j], u0[j]); h1[j] = swiglu1(g1[j], u1[j]); }
                *(v4u*)(hmid + (size_t)row * 1024 + c0) = pack8(h0, h1);
            }
    }
};
struct EpiDown {
    static constexpr bool PERM = true, AFTER_DRAIN = false;
    const int* row_flat; const float* topg; const float* bd; bf16_t* ybuf; const LAS int* texp;
    __device__ __forceinline__ void operator()(const pg8::f32x4 (&acc)[2][2][4][2], const pg8::Unit& u, int wr, int wc, int fr, int fq) const {
        const int row0 = u.pm * 256 + wr * 64 + fr, e = texp[u.pm], c0 = u.pn * 256 + wc * 32 + 8 * fq;
        const float* bp = bd + (size_t)e * 1024 + c0;
        f32x4 bv[2][2];
#pragma unroll
        for (int bj = 0; bj < 2; ++bj) { bv[bj][0] = *(const f32x4*)(bp + bj * 128); bv[bj][1] = *(const f32x4*)(bp + bj * 128 + 4); }
        int av[8]; float gv[8];
#pragma unroll
        for (int q = 0; q < 8; ++q) { const int row = row0 + (q >> 2) * 128 + (q & 3) * 16; av[q] = row_flat[row]; gv[q] = topg[row]; }
#pragma unroll
        for (int ai = 0; ai < 2; ++ai)
#pragma unroll
            for (int m = 0; m < 4; ++m) {
                const int a = av[ai * 4 + m];
                if (a >= 0) { const float gt = gv[ai * 4 + m];
#pragma unroll
                    for (int bj = 0; bj < 2; ++bj)
                        *(v4u*)(ybuf + (size_t)a * 1024 + c0 + bj * 128) = pack8((acc[ai][bj][m][0] + bv[bj][0]) * gt, (acc[ai][bj][m][1] + bv[bj][1]) * gt); }
            }
    }
};

__device__ __forceinline__ int rel_bucket_d(int rel) {
    int n = rel < 0 ? -rel : rel;
    int b;
    if (n < 8) b = n; else if (n < 15) b = 8; else if (n < 27) b = 9; else if (n < 50) b = 10; else if (n < 91) b = 11;
    else if (n < 166) b = 12; else if (n < 305) b = 13; else if (n < 559) b = 14; else b = 15;
    return b + (rel > 0 ? 16 : 0);
}

static_assert(pg8::GTAB == CTRL_OFF + 4096 && pg8::GTAB + pg8::GTAB_UNITS * 512 <= LDS_BYTES && (NTILEN * 8 + 255) / 256 <= pg8::GTAB_UNITS && NWAVES * dil::W_BYTES <= CTRL_OFF && mla::SHM_ATTN <= CTRL_OFF && RING_BYTES <= CTRL_OFF && LX_TEXP + 4 * (NTILEN + 1) <= LDS_BYTES, "LDS map");
__global__ void __launch_bounds__(NWAVES * 64, 2) mk_fwd(Args args) {
    extern __shared__ __attribute__((aligned(16))) unsigned char lds_raw[];
    LAS unsigned char* lds = (LAS unsigned char*)lds_raw;
    const int tid = threadIdx.x, lane = tid & 63, wave = __builtin_amdgcn_readfirstlane(tid >> 6);
    const int G = gridDim.x; const int bx = blockIdx.x; const int vcu = (G % 8 == 0) ? (bx % 8) * (G / 8) + bx / 8 : bx;
    unsigned char* ws = args.ws;
    const int lo = args.ph_lo, hi = args.ph_hi;
#define IN(k) (lo <= (k) && (k) < hi)
#define BOTH(k) (IN(k) && IN((k) + 1))
    for (int u = tid; u < (LDS_BYTES - CTRL_OFF) / 4; u += NWAVES * 64) ((LAS unsigned*)(lds + CTRL_OFF))[u] = 0u;
    __syncthreads();
    XcdBarrier bar; bar.bar = (unsigned*)(ws + WS_CTL) + CW_BAR; bar.x = 0; bar.st = nullptr;
    if (hi - lo > 1) bar = xcd_barrier_post((unsigned*)(ws + WS_CTL) + CW_BAR, (volatile LAS unsigned*)(lds + MISC_OFF) + 8);
#define GRID_BAR(k) do { if (BOTH(k)) xcd_barrier(bar); } while (0)
    const float* x = args.in[0]; const float* mem = args.in[1]; const float* g_mix = args.in[3]; const float* w_in = args.in[4];
    const float* g_q_a = args.in[5]; const float* w_q_b = args.in[6]; const float* g_kv_a = args.in[7]; const float* w_kv_b = args.in[8];
    const float* w_o = args.in[12]; const float* g_xattn = args.in[13]; const float* g_mem = args.in[14]; const float* w_mq = args.in[15];
    const float* w_mkv = args.in[16]; const float* w_mo = args.in[17]; const float* g_moe = args.in[18];
    const float* w_gate_up = args.in[21]; const float* w_down = args.in[23];
    bf16_t* WinT = (bf16_t*)(ws + WS_WIN); bf16_t* WqbT = (bf16_t*)(ws + WS_WQB); bf16_t* WkvbT = (bf16_t*)(ws + WS_WKVB); bf16_t* WoT = (bf16_t*)(ws + WS_WO);
    bf16_t* Wmqg = (bf16_t*)(ws + WS_WMQG); bf16_t* WmkvT = (bf16_t*)(ws + WS_WMKV); bf16_t* WmoT = (bf16_t*)(ws + WS_WMO);
    bf16_t* WguT = (bf16_t*)(ws + WS_WGU); bf16_t* WdT = (bf16_t*)(ws + WS_WD);
    bf16_t* xb = (bf16_t*)(ws + WS_XB); bf16_t* memb = (bf16_t*)(ws + WS_MEMB);
    float* rstd_x = (float*)(ws + WS_RSTDX); float* rstd_mem = (float*)(ws + WS_RSTDM);

    if (IN(0)) {
        LAS float* scr = (LAS float*)(lds + wave * 16640);
        const int gw = vcu * NWAVES + wave, NGW = G * NWAVES;
        constexpr int I_IN = 16 * 31, I_QB = 4 * 12, I_KVB = 2 * 16, I_O = 16 * 16, I_MKV = 16 * 32, I_MO = 16 * 16, I_GU = 16 * 32, I_D = 16 * 16;
        const int n_exp = (args.flags & 1) ? 32 : 0;
        const int NITEMS = I_IN + I_QB + I_KVB + I_O + I_MKV + I_MO + n_exp * (I_GU + I_D);
        auto desc = [&](int it) {
            CvtDesc d; int r = it; d.mode = 0;
            if (r < I_IN) { d.W = w_in; d.K = 1024; d.N = 1952; d.gain = g_mix; d.WT = WinT; }
            else if ((r -= I_IN) < I_QB) { d.W = w_q_b; d.K = 256; d.N = 768; d.gain = g_q_a; d.WT = WqbT; }
            else if ((r -= I_QB) < I_KVB) { d.W = w_kv_b; d.K = 128; d.N = 1024; d.gain = g_kv_a; d.WT = WkvbT; }
            else if ((r -= I_KVB) < I_O) { d.W = w_o; d.K = 1024; d.N = 1024; d.gain = nullptr; d.WT = WoT; }
            else if ((r -= I_O) < I_MKV) { d.W = w_mkv; d.K = 1024; d.N = 2048; d.gain = g_mem; d.WT = WmkvT; }
            else if ((r -= I_MKV) < I_MO) { d.W = w_mo; d.K = 1024; d.N = 1024; d.gain = nullptr; d.WT = WmoT; }
            else if ((r -= I_MO) < 32 * I_GU) { const int e = r / I_GU; r -= e * I_GU; d.W = w_gate_up + (size_t)e * 1024 * 2048; d.K = 1024; d.N = 2048; d.gain = g_moe; d.WT = WguT + (size_t)e * 2048 * 1024; d.mode = 1; }
            else { r -= 32 * I_GU; const int e = r / I_D; r -= e * I_D; d.W = w_down + (size_t)e * 1024 * 1024; d.K = 1024; d.N = 1024; d.gain = nullptr; d.WT = WdT + (size_t)e * 1024 * 1024; }
            d.item = r; return d; };
        {
            f32x4 va[16], vb[16]; CvtDesc dc = desc(0), dn = dc; bool have = false;
            for (int it = gw; ; it += NGW) {
                const bool more = it < NITEMS;
                if (more) { dn = desc(it); cvt_load(dn, vb, lane); }
                if (have) cvt_store(dc, va, scr, lane);
                if (!more) break;
#pragma unroll
                for (int i = 0; i < 16; ++i) va[i] = vb[i];
                dc = dn; have = true;
            }
        }
        for (int i = gw * 64 + lane; i < 64 * 1024 / 8; i += NGW * 64) ((v4u*)(WinT + (size_t)1984 * 1024))[i] = (v4u){0u, 0u, 0u, 0u};
        for (int m = gw * 4; m < T; m += NGW * 4) prep_rows4(x + (size_t)m * D, xb + (size_t)m * D, rstd_x + m, lane);
        for (int m = gw * 4; m < NB * NMEM; m += NGW * 4) prep_rows4(mem + (size_t)m * D, memb + (size_t)m * D, rstd_mem + m, lane);
        { const float* w_router = args.in[19]; float* wrg = (float*)(ws + WS_WRG); for (int i = bx * 512 + tid; i < 1024 * 32; i += G * 512) wrg[i] = w_router[i] * g_moe[i >> 5]; }
        for (int m = gw; m < D; m += NGW) {
            const f32x4* xr = (const f32x4*)(w_mq + (size_t)m * D) + lane; const float gc = g_xattn[m];
            unsigned long long* o8 = (unsigned long long*)(Wmqg + (size_t)m * D) + lane;
#pragma unroll
            for (int j = 0; j < 4; ++j) { const f32x4 v = xr[64 * j] * gc; o8[64 * j] = (unsigned long long)pk2(v.x, v.y) | ((unsigned long long)pk2(v.z, v.w) << 32); }
        }
    }
    if (IN(0)) {
        const float* rel_bias = args.in[9]; float* tbl = (float*)(ws + WS_TBL);
        for (int i = bx * 512 + tid; i < 8 * 2049; i += G * 512) { const int h = i / 2049, r = i % 2049; tbl[h * 2112 + r] = rel_bias[rel_bucket_d(r - 1024) * 8 + h]; }
    }
    GRID_BAR(0);
    if (IN(1)) {
        int kx = 1024; asm volatile("" : "+s"(kx)); pg8::Gemm g{xb, WinT, kx, kx, kx}; pg8::StaticOrder S; S.init(T, 2048, 1024, 1024, G, bx);
        EpiInProj E{rstd_x, (bf16_t*)(ws + WS_QKVA), (bf16_t*)(ws + WS_ZQ), (bf16_t*)(ws + WS_ZKV), (float*)(ws + WS_ZKPE), (float*)(ws + WS_SSQQ), (float*)(ws + WS_SSQKV)};
        pg8::gemm_phase<EpiInProj, pg8::StaticOrder, true, true>(lds, g, S, E);
    }
    GRID_BAR(1);
    if (IN(2)) {
        const int* pos = (const int*)args.in[2];
        float* cs = (float*)(ws + WS_CS); const float* zkpe = (const float*)(ws + WS_ZKPE); bf16_t* kpe = (bf16_t*)(ws + WS_KPE);
        for (int i = bx * 512 + tid; i < T * 16; i += G * 512) {
            const int t = i >> 4, j = i & 15;
            const double rev = (double)pos[t] * args.rope_rev[j];
            const float fr_ = (float)(rev - floor(rev));
            const float sn = __builtin_amdgcn_sinf(fr_), c_ = __builtin_amdgcn_cosf(fr_);
            cs[(size_t)t * 32 + j] = c_; cs[(size_t)t * 32 + 16 + j] = sn;
            const float x1 = zkpe[(size_t)t * 32 + j], x2 = zkpe[(size_t)t * 32 + 16 + j];
            kpe[(size_t)t * 32 + j] = (bf16_t)f2bf(x1 * c_ - x2 * sn); kpe[(size_t)t * 32 + 16 + j] = (bf16_t)f2bf(x1 * sn + x2 * c_);
        }
        {   int kq = 256; asm volatile("" : "+s"(kq)); pg8::Gemm g{(const bf16_t*)(ws + WS_ZQ), WqbT, kq, kq, kq}; pg8::StaticOrder S; S.init(T, 768, 256, 256, G, bx);
            EpiQ E{(const float*)(ws + WS_SSQQ), (bf16_t*)(ws + WS_QB)};
            pg8::gemm_phase<EpiQ, pg8::StaticOrder, true, true>(lds, g, S, E); }
        {   int kk = 128; asm volatile("" : "+s"(kk)); pg8::Gemm g{(const bf16_t*)(ws + WS_ZKV), WkvbT, kk, kk, kk}; const bool memcu = ((bx + 64) % G) < 32 && G > 64; const int bx2 = bx - (bx >= G - 64 + 32 ? 32 : 0);
            pg8::StaticOrder S; S.init(memcu ? 0 : T, 1024, 128, 128, G > 64 ? G - 32 : G, G > 64 ? bx2 : bx);
            EpiKV E{(const float*)(ws + WS_SSQKV), (bf16_t*)(ws + WS_KN), (bf16_t*)(ws + WS_VB)};
            pg8::gemm_phase<EpiKV, pg8::StaticOrder, true, true>(lds, g, S, E); }
        {   int kx = 1024; asm volatile("" : "+s"(kx)); pg8::Gemm g{memb, WmkvT, kx, kx, kx}; pg8::StaticOrder S; S.init(NB * NMEM, 2048, 1024, 1024, G, (bx + 64) % G);
            EpiRowScale E{rstd_mem, (bf16_t*)(ws + WS_KVMEM), 2048};
            pg8::gemm_phase<EpiRowScale, pg8::StaticOrder, true, true>(lds, g, S, E); }
    }
    GRID_BAR(2);
    if (IN(3)) {
        const unsigned short* Qg = (const unsigned short*)(ws + WS_QB); const unsigned short* Kn = (const unsigned short*)(ws + WS_KN);
        const unsigned short* Kp = (const unsigned short*)(ws + WS_KPE); const unsigned short* Vg = (const unsigned short*)(ws + WS_VB);
        const float* cs = (const float*)(ws + WS_CS); unsigned short* Og = (unsigned short*)(ws + WS_OB);
        for (int i = 0; !(args.flags & 8); ++i) {
            int bh, qb;
            if (G == 256) { if (i >= 2) break; const int idx = i * 32 + (bx >> 3); bh = (bx & 7) + 8 * (idx >> 4); qb = idx & 15; }
            else { const int un = i * G + bx; if (un >= 512) break; bh = un >> 4; qb = un & 15; }
            const int b = bh >> 3, h = bh & 7;
#ifdef MLA_ABL
            if (args.flags & 16) mla::mla_unit<MLA_ABL>(Qg, Kn, Kp, Vg, cs, Og, b * S + qb * 256, b * S, h, S, (char*)lds_raw); else
#endif
            mla::mla_unit<0>(Qg, Kn, Kp, Vg, cs, Og, b * S + qb * 256, b * S, h, S, (char*)lds_raw);
        }
        {
            const unsigned short* qkv = (const unsigned short*)(ws + WS_QKVA); const int* pos = (const int*)args.in[2];
            const float* tbl = (const float*)(ws + WS_TBL); unsigned short* oap = (unsigned short*)(ws + WS_OAP); float* lse = (float*)(ws + WS_LSE);
            char* wl = (char*)lds_raw + wave * dil::W_BYTES;
            __syncthreads();
            int cur_h = -1;
            dil::TaskId tc = dil::task_at(0, bx, G, wave), tn = tc; dil::Pre P;
            bool have = !(args.flags & 4) && tc.ub >= 0;
            if (have) dil::dil_prefetch(qkv, pos, tc, P);
            for (int i = 0; have; ++i) {
                tn = dil::task_at(i + 1, bx, G, wave); const bool has_next = tn.ub >= 0;
                if (tc.h != cur_h) { float* tw = (float*)(wl + dil::W_TBL); for (int j = lane; j < 2049; j += 64) tw[j ^ ((j >> 5) & 31)] = tbl[tc.h * dil::TBL_PITCH + j] * 1.4426950408889634f; cur_h = tc.h; asm volatile("s_waitcnt vmcnt(0) lgkmcnt(0)" ::: "memory"); }
                dil::dil_task(qkv, pos, oap, lse, tc, P, has_next, tn, wl);
                tc = tn; have = has_next;
            }
        }
    }
    GRID_BAR(3);
    if (IN(4)) {
        { int kx = 256; asm volatile("" : "+s"(kx));
          if (bx < 64) { pg8::Gemm g{(const bf16_t*)(ws + WS_KVMEM), Wmqg, 2048, 1024, kx}; OrderWp S{bx}; EpiPlain E{(bf16_t*)(ws + WS_WPT), 1024};
              pg8::gemm_phase<EpiPlain, OrderWp, true, true>(lds, g, S, E); }
          else if (bx < 128) { pg8::Gemm g{WmoT, (const bf16_t*)(ws + WS_KVMEM), 1024, 2048, kx}; OrderVw S{bx - 64}; EpiPlain E{(bf16_t*)(ws + WS_VWT), 1024};
              pg8::gemm_phase<EpiPlain, OrderVw, true, true>(lds, g, S, E); } }
        const bf16_t* oap = (const bf16_t*)(ws + WS_OAP); const float* lse = (const float*)(ws + WS_LSE); const bf16_t* obp = (const bf16_t*)(ws + WS_OB);
        const float* g_out_a = args.in[10]; const float* g_out_b = args.in[11]; bf16_t* omix = (bf16_t*)(ws + WS_OMIX);
        const int gw = vcu * NWAVES + wave, NGW = G * NWAVES;
        const f32x4 ga0 = *(const f32x4*)(g_out_a + 8 * lane), ga1 = *(const f32x4*)(g_out_a + 8 * lane + 4), gb0 = *(const f32x4*)(g_out_b + 8 * lane), gb1 = *(const f32x4*)(g_out_b + 8 * lane + 4);
#define UNPK_LO(V_) ((f32x4){__builtin_bit_cast(float, (V_)[0] << 16), __builtin_bit_cast(float, (V_)[0] & 0xffff0000u), __builtin_bit_cast(float, (V_)[1] << 16), __builtin_bit_cast(float, (V_)[1] & 0xffff0000u)})
#define UNPK_HI(V_) ((f32x4){__builtin_bit_cast(float, (V_)[2] << 16), __builtin_bit_cast(float, (V_)[2] & 0xffff0000u), __builtin_bit_cast(float, (V_)[3] << 16), __builtin_bit_cast(float, (V_)[3] & 0xffff0000u)})
        for (int tok = gw; tok < T; tok += NGW) {
            const int head = lane >> 3;
            const float l0 = lse[((size_t)0 * T + tok) * 8 + head], l1 = lse[((size_t)1 * T + tok) * 8 + head], l2 = lse[((size_t)2 * T + tok) * 8 + head];
            const float mx = fmaxf(l0, fmaxf(l1, l2)); float w0 = __expf(l0 - mx), w1 = __expf(l1 - mx), w2 = __expf(l2 - mx); const float wi = 1.0f / (w0 + w1 + w2); w0 *= wi; w1 *= wi; w2 *= wi;
            const v4u q0 = *(const v4u*)(oap + ((size_t)0 * T + tok) * 512 + 8 * lane), q1 = *(const v4u*)(oap + ((size_t)1 * T + tok) * 512 + 8 * lane);
            const v4u q2 = *(const v4u*)(oap + ((size_t)2 * T + tok) * 512 + 8 * lane), qb = *(const v4u*)(obp + (size_t)tok * 512 + 8 * lane);
            const f32x4 a0 = UNPK_LO(q0) * w0 + UNPK_LO(q1) * w1 + UNPK_LO(q2) * w2, a1 = UNPK_HI(q0) * w0 + UNPK_HI(q1) * w1 + UNPK_HI(q2) * w2, b0 = UNPK_LO(qb), b1 = UNPK_HI(qb);
            const float sa = wave_sum(sq8(a0, a1)), sb = wave_sum(sq8(b0, b1));
            const float ra = 1.0f / sqrtf(sa * (1.0f / 512.0f) + 1e-6f), rb = 1.0f / sqrtf(sb * (1.0f / 512.0f) + 1e-6f);
            *(v4u*)(omix + (size_t)tok * 1024 + 8 * lane) = pack8(a0 * ra * ga0, a1 * ra * ga1);
            *(v4u*)(omix + (size_t)tok * 1024 + 512 + 8 * lane) = pack8(b0 * rb * gb0, b1 * rb * gb1);
        }
#undef UNPK_LO
#undef UNPK_HI
    }
    GRID_BAR(4);
    if (IN(5)) {
        int kx = 1024; asm volatile("" : "+s"(kx));
        pg8::Gemm g{(const bf16_t*)(ws + WS_OMIX), WoT, kx, kx, kx}; pg8::StaticOrder S; S.init(T, 1024, 1024, 1024, G, bx);
        EpiResid<false> E{x, (bf16_t*)(ws + WS_H1B), (float*)(ws + WS_SSQH1)};
        pg8::gemm_phase<EpiResid<false>, pg8::StaticOrder, true, true>(lds, g, S, E);
    }
    GRID_BAR(5);
    if (IN(6)) {
        int kx = 1024; asm volatile("" : "+s"(kx));
        pg8::Gemm g{(const bf16_t*)(ws + WS_H1B), (const bf16_t*)(ws + WS_WPT), kx, kx, kx}; OrderBatch S; S.so.init(T, 1024, 1024, 1024, G, bx);
        pg8::Unit u0; const bool has = S.next(0, u0);
        LAS float* rsl = (LAS float*)(lds + CTRL_OFF + 1024);
        if (has && tid < 256) { const float* sp = (const float*)(ws + WS_SSQH1) + (size_t)(u0.pm * 256 + tid) * 16; float a = 0.f;
#pragma unroll
            for (int j = 0; j < 4; ++j) { const f32x4 v = ((const f32x4*)sp)[j]; a += (v[0] + v[1]) + (v[2] + v[3]); }
            rsl[tid] = 1.0f / sqrtf(a * (1.0f / 1024.0f) + 1e-6f); }
        __syncthreads();
        EpiSoftmax E{(bf16_t*)(ws + WS_P), CTRL_OFF + 1024};
        pg8::gemm_phase<EpiSoftmax, OrderBatch, false, true>(lds, g, S, E);
    }
    GRID_BAR(6);
    if (IN(7)) {
        int kx = 1024; asm volatile("" : "+s"(kx));
        pg8::Gemm g{(const bf16_t*)(ws + WS_P), (const bf16_t*)(ws + WS_VWT), kx, kx, kx}; OrderBatch S; S.so.init(T, 1024, 1024, 1024, G, bx);
        EpiResid<true> E{(const bf16_t*)(ws + WS_H1B), (bf16_t*)(ws + WS_H2B), (float*)(ws + WS_SSQH2)};
        pg8::gemm_phase<EpiResid<true>, OrderBatch, true, true>(lds, g, S, E);
    }
    GRID_BAR(7);
    if (IN(8)) {
        typedef float f32x16 __attribute__((ext_vector_type(16)));
        const bf16_t* h2b = (const bf16_t*)(ws + WS_H2B); const float* b_router = args.in[20]; const float* ssq2 = (const float*)(ws + WS_SSQH2);
        int* topi = (int*)(ws + WS_ROUTE + RT_TOPI); float* topg = (float*)(ws + WS_ROUTE + RT_TOPG); int* tslot = (int*)(ws + WS_ROUTE + RT_SLOT); int* row_flat = (int*)(ws + WS_ROUTE + RT_ROWFLAT);
        for (int i = bx * 512 + tid; i < MPADN; i += G * 512) row_flat[i] = -1;
        LAS float* part = (LAS float*)lds;
        LAS float* lgt = (LAS float*)(lds + 32768);
        for (int ch = bx; ch < T / 64; ch += G) {
            const int tok0 = ch * 64, tb = wave & 1, kq = wave >> 1, kh = lane >> 5, row = tok0 + 32 * tb + (lane & 31);
            f32x16 acc = {};
            const bf16_t* ap = h2b + (size_t)row * 1024 + 256 * kq + 4 * kh; const float* wp = (const float*)(ws + WS_WRG) + (size_t)(256 * kq + 4 * kh) * 32 + (lane & 31);
#pragma unroll 8
            for (int j = 0; j < 32; ++j) {
                const v2u aw = *(const v2u*)(ap + 8 * j);
                const f32x4 a4 = (f32x4){__builtin_bit_cast(float, aw.x << 16), __builtin_bit_cast(float, aw.x & 0xffff0000u), __builtin_bit_cast(float, aw.y << 16), __builtin_bit_cast(float, aw.y & 0xffff0000u)};
#pragma unroll
                for (int e = 0; e < 4; ++e) acc = __builtin_amdgcn_mfma_f32_32x32x2f32(a4[e], wp[(size_t)(8 * j + e) * 32], acc, 0, 0, 0);
            }
#pragma unroll
            for (int r = 0; r < 16; ++r) part[((kq * 64) + tb * 32 + (r & 3) + 8 * (r >> 2) + 4 * kh) * 32 + (lane & 31)] = acc[r];
            __syncthreads();
            {
                const int tk = tid >> 3, e0 = (tid & 7) * 4; const float* sp = ssq2 + (size_t)(tok0 + tk) * 16; float a = 0.f;
#pragma unroll
                for (int j = 0; j < 4; ++j) { const f32x4 v = ((const f32x4*)sp)[j]; a += (v[0] + v[1]) + (v[2] + v[3]); }
                const float rs = 1.0f / sqrtf(a * (1.0f / 1024.0f) + 1e-6f);
                if (e0 == 0) ((float*)(ws + WS_ROUTE + RT_RSTD))[tok0 + tk] = rs;
#pragma unroll
                for (int e = 0; e < 4; ++e) lgt[tk * 33 + e0 + e] = rs * ((part[(0 * 64 + tk) * 32 + e0 + e] + part[(1 * 64 + tk) * 32 + e0 + e]) + (part[(2 * 64 + tk) * 32 + e0 + e] + part[(3 * 64 + tk) * 32 + e0 + e])) + b_router[e0 + e];
            }
            __syncthreads();
            if (tid < 64) {
                int c0 = -1, c1 = -1, c2 = -1, c3 = -1; float v0 = 0.f, v1 = 0.f, v2 = 0.f, v3 = 0.f; int s0 = 0, s1 = 0, s2 = 0, s3 = 0;
                for (int k = 0; k < 4; ++k) {
                    float best = -3.0e38f; int bi = 0;
                    for (int e = 0; e < 32; ++e) { const float v = lgt[tid * 33 + e]; if (e == c0 || e == c1 || e == c2 || e == c3) continue; if (v > best) { best = v; bi = e; } }
                    if (k == 0) { c0 = bi; v0 = best; } else if (k == 1) { c1 = bi; v1 = best; } else if (k == 2) { c2 = bi; v2 = best; } else { c3 = bi; v3 = best; }
                }
                const unsigned long long lt = (1ull << lane) - 1ull; int* cntc = (int*)(ws + WS_ROUTE + RT_CNT) + ch * 32;
                for (int e = 0; e < 32; ++e) {
                    const unsigned long long m0 = __ballot(c0 == e), m1 = __ballot(c1 == e), m2 = __ballot(c2 == e), m3 = __ballot(c3 == e);
                    const int before = __popcll(m0 & lt) + __popcll(m1 & lt) + __popcll(m2 & lt) + __popcll(m3 & lt);
                    if (c0 == e) s0 = before; if (c1 == e) s1 = before; if (c2 == e) s2 = before; if (c3 == e) s3 = before;
                    if (lane == e) cntc[e] = __popcll(m0) + __popcll(m1) + __popcll(m2) + __popcll(m3);
                }
                const int t = tok0 + tid;
                const float e1 = __expf(v1 - v0), e2 = __expf(v2 - v0), e3 = __expf(v3 - v0), inv = 1.0f / (1.0f + e1 + e2 + e3);
                *(int4*)(topi + t * 4) = make_int4(c0, c1, c2, c3);
                *(f32x4*)(topg + t * 4) = (f32x4){inv, e1 * inv, e2 * inv, e3 * inv};
                *(int4*)(tslot + t * 4) = make_int4(s0, s1, s2, s3);
            }
            __syncthreads();
        }
    }
    GRID_BAR(8);
    if (IN(9)) {
        const int* topi = (const int*)(ws + WS_ROUTE + RT_TOPI); const int* tslot = (const int*)(ws + WS_ROUTE + RT_SLOT); const int* cnt = (const int*)(ws + WS_ROUTE + RT_CNT);
        int* row_flat = (int*)(ws + WS_ROUTE + RT_ROWFLAT); float* rs_row = (float*)(ws + WS_ROUTE + RT_RSROW); const float* rstd2 = (const float*)(ws + WS_ROUTE + RT_RSTD);
        LAS int* red = (LAS int*)lds;
        for (int base = bx * 512; base < NA; base += G * 512) {
            const int chA = base >> 8, e = tid & 31, part = tid >> 5;
            int tot = 0, pa = 0, pb = 0;
            for (int c = part; c < T / 64; c += 16) { const int v = cnt[c * 32 + e]; tot += v; pa += c < chA ? v : 0; pb += c <= chA ? v : 0; }
            __syncthreads();
            red[(0 * 16 + part) * 32 + e] = tot; red[(1 * 16 + part) * 32 + e] = pa; red[(2 * 16 + part) * 32 + e] = pb;
            __syncthreads();
            if (tid < 96) { const int w = tid >> 5; int a = 0; for (int p = 0; p < 16; ++p) a += red[(w * 16 + p) * 32 + e]; red[1536 + w * 32 + e] = a; }
            __syncthreads();
            if (tid == 0) { int run = 0; for (int q = 0; q < NE; ++q) { red[1632 + q] = run; run += ((red[1536 + q] + 255) >> 8) << 8; } }
            if (bx == 0 && base == 0 && tid < 32) ((int*)(ws + WS_ROUTE + RT_TOT))[tid] = red[1536 + tid];
            __syncthreads();
            const int a = base + tid, ex = topi[a], row = red[1632 + ex] + red[1536 + 32 * (1 + (((a >> 8) - chA) & 1)) + ex] + tslot[a];
            row_flat[row] = a; rs_row[row] = rstd2[a >> 2]; ((float*)(ws + WS_ROUTE + RT_RGATE))[row] = ((const float*)(ws + WS_ROUTE + RT_TOPG))[a];
        }
    }
    GRID_BAR(9);
    if (IN(10) || IN(11)) {
        const int* gtot = (const int*)(ws + WS_ROUTE + RT_TOT); LAS int* texp = (LAS int*)(lds + LX_TEXP);
        __syncthreads();
        if (tid < 64) {
            const int n = tid < NE ? (gtot[tid] + 255) >> 8 : 0; int inc = n;
#pragma unroll
            for (int d = 1; d < 32; d <<= 1) { const int v = __shfl_up(inc, d); if ((tid & 63) >= d) inc += v; }
            const int start = inc - n;
            if (tid < NE) for (int j = 0; j < n; ++j) texp[start + j] = tid;
            if (tid == NE - 1) texp[NTILEN] = inc;
        }
        __syncthreads();
    }
    if (IN(10)) {
        int kx = 1024; asm volatile("" : "+s"(kx));
        pg8::Gemm g{(const bf16_t*)(ws + WS_H2B), WguT, kx, kx, kx}; OrderMoe S{(const LAS int*)(lds + LX_TEXP), 8, bx, G, (size_t)2048 * 1024 * 2};
        {
            const int* row_flat = (const int*)(ws + WS_ROUTE + RT_ROWFLAT); pg8::Unit u;
            for (int i = 0; i < pg8::GTAB_UNITS; ++i) { if (!S.next(i, u)) break; if (tid < 256) { const int a = row_flat[u.pm * 256 + tid]; ((LAS unsigned short*)(lds + pg8::GTAB))[i * 256 + tid] = (unsigned short)(a >= 0 ? (a >> 2) : 0); } }
            __syncthreads();
        }
        EpiSwiGLU E{(const float*)(ws + WS_ROUTE + RT_RSROW), args.in[22], (bf16_t*)(ws + WS_HMID), (const LAS int*)(lds + LX_TEXP)};
        pg8::gemm_phase<EpiSwiGLU, OrderMoe, true, true, true>(lds, g, S, E);
    }
    GRID_BAR(10);
    if (IN(11)) {
        int kx = 1024; asm volatile("" : "+s"(kx));
        pg8::Gemm g{(const bf16_t*)(ws + WS_HMID), WdT, kx, kx, kx}; OrderMoe S{(const LAS int*)(lds + LX_TEXP), 4, bx, G, (size_t)1024 * 1024 * 2};
        EpiDown E{(const int*)(ws + WS_ROUTE + RT_ROWFLAT), (const float*)(ws + WS_ROUTE + RT_RGATE), args.in[24], (bf16_t*)(ws + WS_YBUF), (const LAS int*)(lds + LX_TEXP)};
        pg8::gemm_phase<EpiDown, OrderMoe, true, true>(lds, g, S, E);
    }
    GRID_BAR(11);
    if (IN(12)) {
        const bf16_t* h2b = (const bf16_t*)(ws + WS_H2B); const bf16_t* ybuf = (const bf16_t*)(ws + WS_YBUF); const float* g_final = args.in[25]; float* outp = args.out;
        const int gw = vcu * NWAVES + wave, NGW = G * NWAVES;
        for (int t = gw; t < T; t += NGW) {
            f32x4 v[4]; float ss = 0.f;
#pragma unroll
            for (int j = 0; j < 4; ++j) {
                const v2u hw = *(const v2u*)(h2b + (size_t)t * 1024 + 256 * j + 4 * lane);
                f32x4 a = (f32x4){__builtin_bit_cast(float, hw.x << 16), __builtin_bit_cast(float, hw.x & 0xffff0000u), __builtin_bit_cast(float, hw.y << 16), __builtin_bit_cast(float, hw.y & 0xffff0000u)};
#pragma unroll
                for (int k = 0; k < 4; ++k) { const v2u y = *(const v2u*)(ybuf + ((size_t)t * 4 + k) * 1024 + 256 * j + 4 * lane);
                    a[0] += __builtin_bit_cast(float, y.x << 16); a[1] += __builtin_bit_cast(float, y.x & 0xffff0000u); a[2] += __builtin_bit_cast(float, y.y << 16); a[3] += __builtin_bit_cast(float, y.y & 0xffff0000u); }
                v[j] = a; ss += (a[0] * a[0] + a[1] * a[1]) + (a[2] * a[2] + a[3] * a[3]);
            }
            ss = wave_sum(ss); const float rs = 1.0f / sqrtf(ss * (1.0f / 1024.0f) + 1e-6f);
#pragma unroll
            for (int j = 0; j < 4; ++j) *(f32x4*)(outp + (size_t)t * 1024 + 256 * j + 4 * lane) = v[j] * rs * *(const f32x4*)(g_final + 256 * j + 4 * lane);
        }
    }
#undef GRID_BAR
#undef BOTH
#undef IN
}

}
void launch_mk(hipStream_t st, const mk::Args& base, int lo, int hi, int grid) {
    mk::Args a = base; a.ph_lo = lo; a.ph_hi = hi;
    hipLaunchKernelGGL(mk::mk_fwd, dim3(grid), dim3(mk::NWAVES * 64), mk::LDS_BYTES, st, a);
}
}

extern "C" void kernel_launch(void* const* d_in, const int* in_sizes, int n_in, void* d_out, int out_size, void* d_ws, size_t ws_size, hipStream_t stream) {
    static int grid = 0;
    if (grid == 0) {
        int dev = 0, cus = 0;
        if (hipGetDevice(&dev) != hipSuccess || hipDeviceGetAttribute(&cus, hipDeviceAttributeMultiprocessorCount, dev) != hipSuccess) { grid = -1; return; }
        if (hipFuncSetAttribute((const void*)mk::mk_fwd, hipFuncAttributeMaxDynamicSharedMemorySize, mk::LDS_BYTES) != hipSuccess) { grid = -1; return; }
        grid = cus >= 256 ? 256 : cus;
    }
    if (grid < 0) return;
    const float* x = (const float*)d_in[0];
    const float* mem = (const float*)d_in[1];
    const int* pos = (const int*)d_in[2];
    const float* g_q_a = (const float*)d_in[5];
    const float* w_q_b = (const float*)d_in[6];
    const float* g_kv_a = (const float*)d_in[7];
    const float* w_kv_b = (const float*)d_in[8];
    const float* rel_bias = (const float*)d_in[9];
    const float* g_out_a = (const float*)d_in[10];
    const float* g_out_b = (const float*)d_in[11];
    const float* w_o = (const float*)d_in[12];
    const float* g_xattn = (const float*)d_in[13];
    const float* g_mem = (const float*)d_in[14];
    const float* w_mq = (const float*)d_in[15];
    const float* w_mkv = (const float*)d_in[16];
    const float* w_mo = (const float*)d_in[17];
    const float* g_moe = (const float*)d_in[18];
    const float* w_router = (const float*)d_in[19];
    const float* b_router = (const float*)d_in[20];
    const float* w_gate_up = (const float*)d_in[21];
    const float* b_gate_up = (const float*)d_in[22];
    const float* w_down = (const float*)d_in[23];
    const float* b_down = (const float*)d_in[24];
    const float* g_final = (const float*)d_in[25];
    float* out = (float*)d_out;
    (void)ws_size; (void)in_sizes; (void)n_in; (void)out_size;

    (void)hipMemsetAsync((char*)d_ws + mk::WS_CTL, 0, mk::CTL_ZERO_BYTES, stream);
    mk::Args ma; memset(&ma, 0, sizeof(ma));
    for (int i = 0; i < 26; ++i) ma.in[i] = (const float*)d_in[i];
    ma.out = out; ma.ws = (unsigned char*)d_ws; ma.flags = 1;
    for (int j = 0; j < 16; ++j) ma.rope_rev[j] = pow(10000.0, -(double)j / 16.0) / 6.283185307179586476925287;
#ifndef MK_N_LAUNCHES
#define MK_N_LAUNCHES 1
#endif
    if (MK_N_LAUNCHES == 1) launch_mk(stream, ma, 0, 13, grid);
    else for (int p = 0; p < 13; ++p) launch_mk(stream, ma, p, p + 1, grid);
#ifdef PROBE_MASK
#ifdef PROBE_FLAGS
    ma.flags |= PROBE_FLAGS;
#endif
    for (int r = 0; r < PROBE_N; ++r) for (int p = 0; p < 13; ++p) if ((PROBE_MASK >> p) & 1) launch_mk(stream, ma, p, p + 1, grid);
#endif
}
```

```cpp
#include <hip/hip_runtime.h>
#include <stdint.h>
#include <string.h>
#include <math.h>

namespace {
constexpr int NB = 4, S = 4096, D = 1024, T = NB * S, NMEM = 256, INW = 1952;
constexpr int NE = 32, TOPK = 4, NA = T * TOPK;

namespace pg8 {
#define PG8_LAS __attribute__((address_space(3)))
typedef unsigned short bf16_t;
typedef short bf16x8 __attribute__((ext_vector_type(8)));
typedef float f32x4 __attribute__((ext_vector_type(4)));
typedef unsigned u32x4 __attribute__((ext_vector_type(4)));
constexpr int BM = 256, BK = 64, HALF = 128, HTB = HALF * BK * 2  , STAGE_BYTES = 8 * HTB, NXCD = 8, WGM = 8;

__host__ __device__ __forceinline__ int lds_byte(int r, int c) { const int st = (r >> 4) * 2 + (c >> 5), rr = r & 15, cc = c & 31, ob = rr * 64 + cc * 2; return st * 1024 + (ob ^ (((ob >> 9) & 1) << 5)); }
__host__ __device__ __forceinline__ void stage_rc(int b, int& R, int& C) { const int st = b / 1024, sb = b % 1024, swz = sb ^ (((sb >> 9) & 1) << 5); R = (st >> 1) * 16 + swz / 64; C = (st & 1) * 32 + (swz % 64) / 2; }
__host__ __device__ __forceinline__ int perm32(int rho) { const int n = rho >> 4, i = rho & 15; return 8 * (i >> 2) + 4 * n + (i & 3); }

struct Unit { int pm, pn; size_t aoff, boff; };
struct Gemm { const bf16_t* A; const bf16_t* Bt; int lda, ldb, K; };

struct StaticOrder {
    int nM, nN, nwg, G, c; size_t ta, tb;
    __host__ __device__ __forceinline__ void init(int M, int N, int lda, int ldb, int G_, int c_) { nM = M / BM; nN = N / BM; nwg = nM * nN; G = G_; c = c_; ta = (size_t)BM * lda * 2; tb = (size_t)BM * ldb * 2; }
    __host__ __device__ __forceinline__ bool next(int i, Unit& u) const {
        const long L = (long)i * G + c; if (L >= nwg) return false;
        int wgid = (int)L; { const int q = nwg / NXCD, r = nwg % NXCD, xcd = wgid % NXCD, off = wgid / NXCD; wgid = (xcd < r ? xcd * (q + 1) : r * (q + 1) + (xcd - r) * q) + off; }
        const int nig = WGM * nN, gid = wgid / nig, fm = gid * WGM, gsz = (nM - fm) < WGM ? (nM - fm) : WGM;
        u.pm = fm + ((wgid % nig) % gsz); u.pn = (wgid % nig) / gsz; u.aoff = (size_t)u.pm * ta; u.boff = (size_t)u.pn * tb; return true;
    }
    __device__ __forceinline__ void a_ready(const Unit&) const {}
    __device__ __forceinline__ void done(const Unit&) const {}
};

__device__ __forceinline__ unsigned cvt_pk_bf16(float lo, float hi) { unsigned r; asm volatile("v_cvt_pk_bf16_f32 %0, %1, %2" : "=v"(r) : "v"(lo), "v"(hi)); return r; }
typedef float f32x2 __attribute__((ext_vector_type(2)));

constexpr int GTAB = 135168 + 4096, GTAB_UNITS = 10;
typedef int i32x4 __attribute__((ext_vector_type(4)));
typedef int i32x8 __attribute__((ext_vector_type(8)));
__device__ __forceinline__ i32x8 cat8(const bf16x8 a, const bf16x8 b) { return __builtin_shufflevector(__builtin_bit_cast(i32x4, a), __builtin_bit_cast(i32x4, b), 0, 1, 2, 3, 4, 5, 6, 7); }
template <class Epi, class Sched, bool ALIGN_EPI = false, bool SP2 = false, bool GATHER = false, bool F8 = false>
__device__ __forceinline__ void gemm_phase(PG8_LAS unsigned char* lds, const Gemm g, const Sched& S, const Epi& E) {
    const int tid = threadIdx.x, wid = __builtin_amdgcn_readfirstlane(tid >> 6), lane = tid & 63, wr = wid >> 2, wc = wid & 3, fr = lane & 15, fq = lane >> 4;
    static_assert(!GATHER || SP2, "GATHER is implemented for the SP2 loop only");
    const int K = g.K, nt = K / BK;
    unsigned voffA[2], voffB[2];
#pragma unroll
    for (int i = 0; i < 2; ++i) { int R, C; stage_rc(tid * 16 + i * 8192, R, C); const int Rb = Epi::PERM ? ((R & ~31) + perm32(R & 31)) : R;
        voffA[i] = (unsigned)(R * g.lda + C) * 2u; voffB[i] = (unsigned)(Rb * g.ldb + C) * 2u; }
    unsigned gidx[2], gcol[2];
#pragma unroll
    for (int i = 0; i < 2; ++i) { int R, C; stage_rc(tid * 16 + i * 8192, R, C); gidx[i] = (unsigned)R * 2u; gcol[i] = (unsigned)C * 2u; }
    const size_t kstep = (size_t)(BK * 2);
    const size_t hstepA = (size_t)HALF * g.lda * 2, hstepB = (size_t)HALF * g.ldb * 2;
    const unsigned ldsw = (unsigned)wid * 1024u;
    const int aoff = lds_byte(wr * 64 + fr, fq * 8), boff = lds_byte(wc * 32 + fr, fq * 8);
#define PG8_SA(b, h) (((b) * 2 + (h)) * HTB)
#define PG8_SB(b, h) ((4 + (b) * 2 + (h)) * HTB)
#define PG8_GLDS(gptr, off32, ldsdst) do { unsigned _o = (off32); asm volatile("" : "+v"(_o)); __builtin_amdgcn_global_load_lds((const unsigned*)((const char*)(gptr) + _o), (ldsdst), 16, 0, 0); } while (0)
#define PG8_STAGE(bufoff, gbase, voff) do { _Pragma("unroll") for (int _i = 0; _i < 2; ++_i) \
        PG8_GLDS(gbase, (voff)[_i], (PG8_LAS unsigned*)(lds + (bufoff) + ldsw + _i * 8192)); } while (0)
#define PG8_GTOK(h, sel) do { if constexpr (GATHER) { tk0 = *(const PG8_LAS unsigned short*)(lds + GTAB + (sel) * 512 + (h) * 256 + gidx[0]); tk1 = *(const PG8_LAS unsigned short*)(lds + GTAB + (sel) * 512 + (h) * 256 + gidx[1]); } } while (0)
#define PG8_STAGE_A(bufoff, gbase, h, sel) do { if constexpr (GATHER) { \
        PG8_GLDS(gbase, tk0 * (unsigned)(g.lda * 2) + gcol[0], (PG8_LAS unsigned*)(lds + (bufoff) + ldsw)); \
        PG8_GLDS(gbase, tk1 * (unsigned)(g.lda * 2) + gcol[1], (PG8_LAS unsigned*)(lds + (bufoff) + ldsw + 8192)); } \
    else { PG8_STAGE(bufoff, (gbase) + (h) * hstepA, voffA); } } while (0)
#define PG8_LDA(dst, b, h) do { _Pragma("unroll") for (int m = 0; m < 4; ++m) _Pragma("unroll") for (int k = 0; k < 2; ++k) dst[m][k] = *(const PG8_LAS bf16x8*)(lds + PG8_SA(b, h) + aoff + m * 2048 + k * 1024); } while (0)
#define PG8_LDB(dst, b, h) do { _Pragma("unroll") for (int n = 0; n < 2; ++n) _Pragma("unroll") for (int k = 0; k < 2; ++k) dst[n][k] = *(const PG8_LAS bf16x8*)(lds + PG8_SB(b, h) + boff + n * 2048 + k * 1024); } while (0)
#define PG8_MMA(ai, bj, At, Bt) do { __builtin_amdgcn_s_setprio(1); _Pragma("unroll") for (int m = 0; m < 4; ++m) _Pragma("unroll") for (int n = 0; n < 2; ++n) { \
        if constexpr (F8) { const i32x8 _b = cat8(Bt[n][0], Bt[n][1]), _a = cat8(At[m][0], At[m][1]); asm volatile("s_nop 1\n\tv_mfma_f32_16x16x128_f8f6f4 %0, %1, %2, %0" : "+v"(acc[ai][bj][m][n]) : "v"(_b), "v"(_a)); } \
        else { _Pragma("unroll") for (int k = 0; k < 2; ++k) acc[ai][bj][m][n] = __builtin_amdgcn_mfma_f32_16x16x32_bf16(Bt[n][k], At[m][k], acc[ai][bj][m][n], 0, 0, 0); } } __builtin_amdgcn_s_setprio(0); } while (0)
#define PG8_WAIT_V(n) asm volatile("s_waitcnt vmcnt(" #n ")" ::: "memory")
#define PG8_WAIT_L(n) asm volatile("s_waitcnt lgkmcnt(" #n ")" ::: "memory")
#define PG8_BAR __builtin_amdgcn_s_barrier()
#define PG8_SCHED __builtin_amdgcn_sched_barrier(0)
    Unit cur, nxt; int ui = 0; unsigned tk0 = 0, tk1 = 0; (void)tk0; (void)tk1;
    if (!S.next(0, cur)) return;
    f32x4 acc[2][2][4][2];
#pragma unroll
    for (int a = 0; a < 2; ++a)
#pragma unroll
        for (int b = 0; b < 2; ++b)
#pragma unroll
            for (int m = 0; m < 4; ++m)
#pragma unroll
                for (int n = 0; n < 2; ++n) acc[a][b][m][n] = (f32x4){0.f, 0.f, 0.f, 0.f};
    bf16x8 At[4][2], B0[2][2], B1[2][2];
    const char* cA = (const char*)g.A + (GATHER ? (size_t)0 : cur.aoff); const char* cB = (const char*)g.Bt + cur.boff;
    S.a_ready(cur);
    if constexpr (SP2) {
        PG8_STAGE(PG8_SB(0, 0), cB, voffB); PG8_STAGE(PG8_SB(0, 1), cB + hstepB, voffB); PG8_GTOK(0, ui); PG8_STAGE_A(PG8_SA(0, 0), cA, 0, ui); PG8_GTOK(1, ui); PG8_STAGE_A(PG8_SA(0, 1), cA, 1, ui);
        if (wr == 1) PG8_BAR;
        PG8_WAIT_V(2); PG8_BAR;
        PG8_STAGE(PG8_SB(1, 0), cB + kstep, voffB); PG8_GTOK(0, ui); PG8_STAGE_A(PG8_SA(1, 0), cA + kstep, 0, ui); PG8_STAGE(PG8_SB(1, 1), cB + hstepB + kstep, voffB);
        PG8_WAIT_V(6); PG8_BAR;
    } else {
        PG8_STAGE(PG8_SB(0, 0), cB, voffB); PG8_STAGE_A(PG8_SA(0, 0), cA, 0, ui); PG8_STAGE(PG8_SB(0, 1), cB + hstepB, voffB); PG8_STAGE_A(PG8_SA(0, 1), cA, 1, ui);
        if (wr == 1) PG8_BAR;
        PG8_WAIT_V(4); PG8_BAR;
        PG8_STAGE(PG8_SB(1, 0), cB + kstep, voffB); PG8_STAGE_A(PG8_SA(1, 0), cA + kstep, 0, ui); PG8_STAGE(PG8_SB(1, 1), cB + hstepB + kstep, voffB);
        PG8_WAIT_V(6); PG8_BAR;
    }
    for (;;) {
        const bool has_next = S.next(ui + 1, nxt);
        const char* nA = has_next ? (const char*)g.A + (GATHER ? (size_t)0 : nxt.aoff) : cA; const char* nB = has_next ? (const char*)g.Bt + nxt.boff : cB;
        for (int t = 0; t < nt; t += 2) {
            const bool last = (t == nt - 2);
            const char* a1 = cA + (size_t)(t + 1) * kstep;
            const char* a2 = last ? nA : cA + (size_t)(t + 2) * kstep; const char* b2 = last ? nB : cB + (size_t)(t + 2) * kstep;
            const char* a3 = a2 + kstep; const char* b3 = b2 + kstep; const int ui2 = (last && has_next) ? ui + 1 : ui; (void)ui2;
            if (last && has_next) S.a_ready(nxt);
            if constexpr (SP2) {
            PG8_GTOK(1, ui); PG8_LDB(B0, 0, 0); PG8_LDB(B1, 0, 1); PG8_SCHED; PG8_LDA(At, 0, 0); PG8_STAGE_A(PG8_SA(1, 1), a1, 1, ui);
            PG8_WAIT_V(8); PG8_WAIT_L(0); PG8_BAR; PG8_MMA(0, 0, At, B0); PG8_MMA(0, 1, At, B1); PG8_BAR; PG8_SCHED;
            PG8_GTOK(0, ui2); PG8_LDA(At, 0, 1); PG8_STAGE(PG8_SB(0, 0), b2, voffB); PG8_STAGE(PG8_SB(0, 1), b2 + hstepB, voffB); PG8_STAGE_A(PG8_SA(0, 0), a2, 0, ui2);
            PG8_WAIT_V(8); PG8_WAIT_L(0); PG8_BAR; PG8_MMA(1, 0, At, B0); PG8_MMA(1, 1, At, B1); PG8_BAR; PG8_SCHED;
            PG8_GTOK(1, ui2); PG8_LDB(B0, 1, 0); PG8_LDB(B1, 1, 1); PG8_SCHED; PG8_LDA(At, 1, 0); PG8_STAGE_A(PG8_SA(0, 1), a2, 1, ui2);
            PG8_WAIT_V(8); PG8_WAIT_L(0); PG8_BAR; PG8_MMA(0, 0, At, B0); PG8_MMA(0, 1, At, B1); PG8_BAR; PG8_SCHED;
            PG8_GTOK(0, ui2); PG8_LDA(At, 1, 1); PG8_STAGE(PG8_SB(1, 0), b3, voffB); PG8_STAGE(PG8_SB(1, 1), b3 + hstepB, voffB); PG8_STAGE_A(PG8_SA(1, 0), a3, 0, ui2);
            PG8_WAIT_V(8); PG8_WAIT_L(0); PG8_BAR; PG8_MMA(1, 0, At, B0); PG8_MMA(1, 1, At, B1); PG8_BAR; PG8_SCHED;
            } else {
            PG8_LDB(B0, 0, 0); PG8_SCHED; PG8_LDA(At, 0, 0); PG8_STAGE_A(PG8_SA(1, 1), a1, 1, ui);
            PG8_WAIT_L(8); PG8_BAR; PG8_WAIT_L(0); PG8_MMA(0, 0, At, B0); PG8_BAR; PG8_SCHED;
            PG8_LDB(B1, 0, 1); PG8_STAGE(PG8_SB(0, 0), b2, voffB);
            PG8_BAR; PG8_WAIT_L(0); PG8_MMA(0, 1, At, B1); PG8_BAR;
            PG8_LDA(At, 0, 1); PG8_STAGE_A(PG8_SA(0, 0), a2, 0, ui2);
            PG8_BAR; PG8_WAIT_L(0); PG8_MMA(1, 0, At, B0); PG8_BAR; PG8_SCHED;
            PG8_STAGE(PG8_SB(0, 1), b2 + hstepB, voffB);
            PG8_WAIT_V(6); PG8_BAR; PG8_MMA(1, 1, At, B1); PG8_BAR;
            PG8_LDB(B0, 1, 0); PG8_SCHED; PG8_LDA(At, 1, 0); PG8_STAGE_A(PG8_SA(0, 1), a2, 1, ui2);
            PG8_WAIT_L(8); PG8_BAR; PG8_WAIT_L(0); PG8_MMA(0, 0, At, B0); PG8_BAR; PG8_SCHED;
            PG8_LDB(B1, 1, 1); PG8_STAGE(PG8_SB(1, 0), b3, voffB);
            PG8_BAR; PG8_WAIT_L(0); PG8_MMA(0, 1, At, B1); PG8_BAR;
            PG8_LDA(At, 1, 1); PG8_STAGE_A(PG8_SA(1, 0), a3, 0, ui2);
            PG8_BAR; PG8_WAIT_L(0); PG8_MMA(1, 0, At, B0); PG8_BAR; PG8_SCHED;
            PG8_STAGE(PG8_SB(1, 1), b3 + hstepB, voffB);
            PG8_WAIT_V(6); PG8_BAR; PG8_MMA(1, 1, At, B1); PG8_BAR;
            }
        }
        if constexpr (F8) {
#define PG8_A4(a, b) "+v"(acc[a][b][0][0]), "+v"(acc[a][b][0][1]), "+v"(acc[a][b][1][0]), "+v"(acc[a][b][1][1]), "+v"(acc[a][b][2][0]), "+v"(acc[a][b][2][1]), "+v"(acc[a][b][3][0]), "+v"(acc[a][b][3][1])
            asm volatile("s_nop 11\n\ts_nop 3" : PG8_A4(0, 0), PG8_A4(0, 1));
            asm volatile("" : PG8_A4(1, 0), PG8_A4(1, 1));
#undef PG8_A4
        }
        if constexpr (ALIGN_EPI) { if (wr == 0) PG8_BAR; }
        if constexpr (!Epi::AFTER_DRAIN) { E(acc, cur, wr, wc, fr, fq); S.done(cur); }
        if (!has_next) break;
#pragma unroll
        for (int a = 0; a < 2; ++a)
#pragma unroll
            for (int b = 0; b < 2; ++b)
#pragma unroll
                for (int m = 0; m < 4; ++m)
#pragma unroll
                    for (int n = 0; n < 2; ++n) acc[a][b][m][n] = (f32x4){0.f, 0.f, 0.f, 0.f};
        cur = nxt; cA = nA; cB = nB; ++ui;
        if constexpr (ALIGN_EPI) { if (wr == 1) PG8_BAR; }
    }
    PG8_WAIT_V(0);
    if constexpr (!ALIGN_EPI) { if (wr == 0) PG8_BAR; }
    PG8_BAR;
    if constexpr (Epi::AFTER_DRAIN) { E.fused(acc, cur, wr, wc, fr, fq, lds, wid, lane); S.done(cur); }
#undef PG8_SA
#undef PG8_SB
#undef PG8_GLDS
#undef PG8_STAGE
#undef PG8_STAGE_A
#undef PG8_GTOK
#undef PG8_LDA
#undef PG8_LDB
#undef PG8_MMA
#undef PG8_WAIT_V
#undef PG8_WAIT_L
#undef PG8_BAR
#undef PG8_SCHED
}
}
namespace mla {
using bf16x8 = __attribute__((ext_vector_type(8))) short;
using s16x4  = __attribute__((ext_vector_type(4))) short;
using f32x16 = __attribute__((ext_vector_type(16))) float;
using u32x4  = __attribute__((ext_vector_type(4))) unsigned;
constexpr int NW = 8, QBLK = 32, KVBLK = 64;
constexpr float SCALE = 0.10206207261596577f;
constexpr float THR = 8.f;
constexpr int SHM_V = KVBLK * 64 * 2, SHM_K = KVBLK * 256;
constexpr int SHM_ATTN = 4 * SHM_V + 4 * SHM_K + NW * 64 * 4;
#define KSWZ(row, colB) ((row) * 256 + ((colB) ^ (((row) & 7) << 4)))
#define SBAR() __builtin_amdgcn_sched_barrier(0)
__device__ __forceinline__ int crow(int r, int hi) { return (r & 3) + 8 * (r >> 2) + 4 * hi; }
__device__ __forceinline__ unsigned cvtpk(float lo, float hi) { unsigned r; asm volatile("v_cvt_pk_bf16_f32 %0, %1, %2" : "=v"(r) : "v"(lo), "v"(hi)); return r; }

__device__ __forceinline__ float max3f(float a, float b, float c) { return __builtin_fmaxf(__builtin_fmaxf(a, b), c); }
template <int ABL> __device__ __forceinline__ void partialSM(f32x16& p0, f32x16& p1, float& m_reg, float& alpha, bool first) {
  float a = max3f(p0[0], p0[1], p0[2]), b = max3f(p0[3], p1[0], p1[1]), c = max3f(p1[2], p1[3], p0[4]), d = max3f(p0[5], p0[6], p0[7]);
  a = max3f(a, p1[4], p1[5]); b = max3f(b, p1[6], p1[7]);
#pragma unroll
  for (int r = 8; r < 16; r += 4) { a = max3f(a, p0[r], p0[r + 1]); b = max3f(b, p0[r + 2], p0[r + 3]); c = max3f(c, p1[r], p1[r + 1]); d = max3f(d, p1[r + 2], p1[r + 3]); }
  float pmax = fmaxf(fmaxf(a, b), fmaxf(c, d));
  { auto rr = __builtin_amdgcn_permlane32_swap(__float_as_uint(pmax), __float_as_uint(pmax), false, false);
    pmax = fmaxf(__uint_as_float(rr[0]), __uint_as_float(rr[1])); }
  if (__builtin_expect(!first && __all(pmax - m_reg <= THR * 1.4426950408889634f), 1)) { alpha = 1.f; }
  else { const float mn = first ? pmax : fmaxf(m_reg, pmax); alpha = first ? 1.f : __builtin_amdgcn_exp2f(m_reg - mn); m_reg = mn; }
#pragma unroll
  for (int r = 0; r < 16; ++r) { p0[r] -= m_reg; p1[r] -= m_reg; }
#pragma unroll
  for (int r = 0; r < 16; ++r) p0[r] = (ABL & 2) ? p0[r] * 0.5f : __builtin_amdgcn_exp2f(p0[r]);
}
template <int ABL> __device__ __forceinline__ void finishSM(f32x16& p0, f32x16& p1, float alpha, float& l_reg, bf16x8& pa0, bf16x8& pa1, bf16x8& pa2, bf16x8& pa3) {
#pragma unroll
  for (int r = 0; r < 16; ++r) p1[r] = (ABL & 2) ? p1[r] * 0.5f : __builtin_amdgcn_exp2f(p1[r]);
  float ps, s0 = 0.f, s1 = 0.f, s2 = 0.f, s3 = 0.f;
#pragma unroll
  for (int r = 0; r < 16; r += 4) { s0 += p0[r]; s1 += p0[r + 1]; s2 += p0[r + 2]; s3 += p0[r + 3]; }
#pragma unroll
  for (int r = 0; r < 16; r += 4) { s0 += p1[r]; s1 += p1[r + 1]; s2 += p1[r + 2]; s3 += p1[r + 3]; }
  ps = (s0 + s1) + (s2 + s3);
  { auto rr = __builtin_amdgcn_permlane32_swap(__float_as_uint(ps), __float_as_uint(ps), false, false);
    ps = __uint_as_float(rr[0]) + __uint_as_float(rr[1]); }
  l_reg = l_reg * alpha + ps;
#define PK4(P, BASE, OUT) do { u32x4 w = {cvtpk(P[BASE + 0], P[BASE + 1]), cvtpk(P[BASE + 2], P[BASE + 3]), cvtpk(P[BASE + 4], P[BASE + 5]), cvtpk(P[BASE + 6], P[BASE + 7])}; \
    OUT = *reinterpret_cast<bf16x8*>(&w); } while (0)
  PK4(p0, 0, pa0); PK4(p0, 8, pa1); PK4(p1, 0, pa2); PK4(p1, 8, pa3);
#undef PK4
}
__device__ __forceinline__ void qkt(f32x16& p0, f32x16& p1, const char* Ks, const bf16x8* qr, int r32, int hi) {
  p0 = f32x16{}; p1 = f32x16{};
#pragma unroll
  for (int d0 = 0; d0 < 6; ++d0) { int cb = (d0 * 16 + hi * 8) * 2;
    bf16x8 b0 = *reinterpret_cast<const bf16x8*>(Ks + KSWZ(r32, cb));
    bf16x8 b1 = *reinterpret_cast<const bf16x8*>(Ks + KSWZ(32 + r32, cb));
    p0 = __builtin_amdgcn_mfma_f32_32x32x16_bf16(b0, qr[d0], p0, 0, 0, 0);
    p1 = __builtin_amdgcn_mfma_f32_32x32x16_bf16(b1, qr[d0], p1, 0, 0, 0); }
}
__device__ __forceinline__ int v_st(int k, int c) { const int kk = k;
  return ((kk >> 3) * 2 + (c >> 5)) * 512 + ((kk & 7) * 32 + (c & 31)) * 2; }
__device__ __forceinline__ int v_rd_base(int lane) { return ((lane & 3) << 3) | (((lane >> 2) & 3) << 6) | (((lane >> 4) & 1) << 5) | (((lane >> 5) & 1) << 8); }
constexpr int v_rd_off(int d0, int ks, int half) { return d0 * 512 + ks * 2048 + half * 1024; }
template <int OFF> __device__ __forceinline__ s16x4 tr_read(int vb) {
  s16x4 r; asm volatile("ds_read_b64_tr_b16 %0, %1 offset:%2" : "=&v"(r) : "v"(vb), "i"(OFF) : "memory"); return r;
}
#define PK(L, H) (bf16x8){L[0], L[1], L[2], L[3], H[0], H[1], H[2], H[3]}
#define PV_RD(KS, LA, HA, LB, HB) do { LA = tr_read<v_rd_off(0, KS, 0)>(vb); HA = tr_read<v_rd_off(0, KS, 1)>(vb); LB = tr_read<v_rd_off(1, KS, 0)>(vb); HB = tr_read<v_rd_off(1, KS, 1)>(vb); } while (0)
#define PV_MM(PA, LA, HA, LB, HB) do { o[0] = __builtin_amdgcn_mfma_f32_32x32x16_bf16(PA, PK(LA, HA), o[0], 0, 0, 0); o[1] = __builtin_amdgcn_mfma_f32_32x32x16_bf16(PA, PK(LB, HB), o[1], 0, 0, 0); } while (0)
__device__ __forceinline__ void pv_d0(f32x16* o, int vb, bf16x8 pa0, bf16x8 pa1, bf16x8 pa2, bf16x8 pa3) {
  s16x4 la, ha, lb, hb, lc, hc, ld, hd;
  PV_RD(0, la, ha, lb, hb);
  PV_RD(1, lc, hc, ld, hd);
  asm volatile("s_waitcnt lgkmcnt(4)" ::: "memory"); SBAR();
  PV_MM(pa0, la, ha, lb, hb); SBAR();
  PV_RD(2, la, ha, lb, hb);
  asm volatile("s_waitcnt lgkmcnt(4)" ::: "memory"); SBAR();
  PV_MM(pa1, lc, hc, ld, hd); SBAR();
  PV_RD(3, lc, hc, ld, hd);
  asm volatile("s_waitcnt lgkmcnt(4)" ::: "memory"); SBAR();
  PV_MM(pa2, la, ha, lb, hb); SBAR();
  asm volatile("s_waitcnt lgkmcnt(0)" ::: "memory"); SBAR();
  PV_MM(pa3, lc, hc, ld, hd);
}
#undef PV_MM
#undef PV_RD
#undef PK
__device__ __forceinline__ float bf2f_(short b) { return __builtin_bit_cast(float, (unsigned)(unsigned short)b << 16); }

template <int ABL> __device__ __forceinline__ void mla_unit(const unsigned short* __restrict__ Qg, const unsigned short* __restrict__ Kn, const unsigned short* __restrict__ Kpe, const unsigned short* __restrict__ Vg,
                                         const float* __restrict__ cs, unsigned short* __restrict__ Og, int q0, int krow0, int h, int seq, char* lds) {
  const int tid = threadIdx.x, wid = __builtin_amdgcn_readfirstlane(tid >> 6), lane = tid & 63, r32 = lane & 31, hi = lane >> 5;
  char* V_lds = lds; char* K_lds = lds + 4 * SHM_V;
  float* ws = (float*)(lds + 4 * SHM_V + 4 * SHM_K) + wid * 64; float* li_l = ws; float* al_l = ws + 32;
  float m_reg = 0.f, l_reg = 0; f32x16 o[2] = {}; bf16x8 qr[6];
  {
    const int qrow = q0 + wid * QBLK + r32;
    const unsigned short* Qw = Qg + (size_t)qrow * 768 + h * 96 + hi * 8;
#pragma unroll
    for (int d0 = 0; d0 < 6; ++d0) qr[d0] = *reinterpret_cast<const bf16x8*>(Qw + d0 * 16);
    const float* cr = cs + (size_t)qrow * 32 + hi * 8;
    bf16x8 a = qr[4], b = qr[5]; u32x4 wa, wb; float n1[8], n2[8];
#pragma unroll
    for (int e = 0; e < 8; ++e) { const float c_ = cr[e], s_ = cr[16 + e]; const float x1 = bf2f_(a[e]), x2 = bf2f_(b[e]); n1[e] = x1 * c_ - x2 * s_; n2[e] = x1 * s_ + x2 * c_; }
    wa = (u32x4){cvtpk(n1[0], n1[1]), cvtpk(n1[2], n1[3]), cvtpk(n1[4], n1[5]), cvtpk(n1[6], n1[7])};
    wb = (u32x4){cvtpk(n2[0], n2[1]), cvtpk(n2[2], n2[3]), cvtpk(n2[4], n2[5]), cvtpk(n2[6], n2[7])};
    qr[4] = *reinterpret_cast<bf16x8*>(&wa); qr[5] = *reinterpret_cast<bf16x8*>(&wb);
  }
  const int sk = tid >> 3, sc = (tid & 7) * 8, rk = (tid & 255) >> 2, rc = (tid & 3) * 8;
  const int vst = v_st(sk, sc), kst = KSWZ(sk, sc * 2), rst = KSWZ(rk, (64 + rc) * 2);
  const int vb0 = (int)(uintptr_t)V_lds + v_rd_base(lane);
  const unsigned short* Vh = Vg + (size_t)krow0 * 512 + h * 64; const unsigned short* Kh = Kn + (size_t)krow0 * 512 + h * 64; const unsigned short* Rh = Kpe + (size_t)krow0 * 32;
  struct { bf16x8 vs, ks, rs; } sr_[2];
#define SLOAD(i, k0) do { sr_[i].vs = *reinterpret_cast<const bf16x8*>(&Vh[(size_t)((k0) + sk) * 512 + sc]); sr_[i].ks = *reinterpret_cast<const bf16x8*>(&Kh[(size_t)((k0) + sk) * 512 + sc]); \
    sr_[i].rs = *reinterpret_cast<const bf16x8*>(&Rh[(size_t)((k0) + rk) * 32 + rc]); } while (0)
#define SWRITE(b, i) do { *(bf16x8*)(V_lds + (b) * SHM_V + vst) = sr_[i].vs; *(bf16x8*)(K_lds + (b) * SHM_K + kst) = sr_[i].ks; *(bf16x8*)(K_lds + (b) * SHM_K + rst) = sr_[i].rs; } while (0)
#define RESC(a) do { if (__any((a) < 1.f)) { if (hi == 0) al_l[r32] = (a); asm volatile("s_waitcnt lgkmcnt(0)" ::: "memory"); \
    _Pragma("unroll") for (int d = 0; d < 2; ++d) _Pragma("unroll") for (int r = 0; r < 16; ++r) o[d][r] *= al_l[crow(r, hi)]; } } while (0)
#define EBAR() do { asm volatile("s_waitcnt lgkmcnt(0)" ::: "memory"); __builtin_amdgcn_s_barrier(); asm volatile("" ::: "memory"); } while (0)
  f32x16 p0, p1; float al; bf16x8 pa0, pa1, pa2, pa3; const int NT = seq / KVBLK;
  pa0 = pa1 = pa2 = pa3 = bf16x8{};
  SLOAD(0, 0); SLOAD(1, KVBLK); asm volatile("s_waitcnt vmcnt(0)" ::: "memory"); SWRITE(0, 0); SWRITE(1, 1);
  if (2 < NT) SLOAD(0, 2 * KVBLK);
  EBAR();
  if (wid >= 4) EBAR();
  for (int t = 0; t < NT; ++t) {
    SBAR(); __builtin_amdgcn_s_setprio(3); qkt(p0, p1, K_lds + (t & 3) * SHM_K, qr, r32, hi); SBAR();
    if (t > 0) pv_d0(o, vb0 + ((t - 1) & 3) * SHM_V, pa0, pa1, pa2, pa3);
    __builtin_amdgcn_s_setprio(0); EBAR();
    partialSM<ABL>(p0, p1, m_reg, al, t == 0);
    RESC(al);
    finishSM<ABL>(p0, p1, al, l_reg, pa0, pa1, pa2, pa3);
    if (t + 2 < NT) { asm volatile("s_waitcnt vmcnt(0)" ::: "memory"); SWRITE((t + 2) & 3, 0); }
    if (t + 3 < NT) SLOAD(0, (t + 3) * KVBLK);
    EBAR();
  }
  SBAR(); pv_d0(o, vb0 + ((NT - 1) & 3) * SHM_V, pa0, pa1, pa2, pa3);
  if (wid < 4) EBAR();
#undef EBAR
  if (hi == 0) li_l[r32] = l_reg; asm volatile("s_waitcnt lgkmcnt(0)" ::: "memory");
  float rli[16];
#pragma unroll
  for (int r = 0; r < 16; ++r) rli[r] = __builtin_amdgcn_rcpf(li_l[crow(r, hi)]);
  unsigned short* Ow = Og + (size_t)(q0 + wid * QBLK) * 512 + h * 64;
#pragma unroll
  for (int r = 0; r < 16; ++r) { int orow = crow(r, hi);
#pragma unroll
    for (int d0 = 0; d0 < 2; ++d0) Ow[(size_t)orow * 512 + d0 * 32 + r32] = (unsigned short)cvtpk(o[d0][r] * rli[r], 0.f); }
  __syncthreads();
#undef SLOAD
#undef SWRITE
#undef RESC
}
#undef KSWZ
#undef SBAR
}

namespace dil {
using bf16x8 = __attribute__((ext_vector_type(8))) short;
using s16x4  = __attribute__((ext_vector_type(4))) short;
using f32x16 = __attribute__((ext_vector_type(16))) float;
using u32x4  = __attribute__((ext_vector_type(4))) unsigned;
constexpr int TBL_PITCH = 2112;
constexpr int W_TBL = 0, W_K = 8448, W_V = 8448 + 4096, W_POS = 8448 + 8192, W_AL = W_POS + 128, W_BYTES = W_AL + 128;
__device__ __forceinline__ int crow(int r, int hi) { return (r & 3) + 8 * (r >> 2) + 4 * hi; }
__device__ __forceinline__ unsigned cvtpk(float lo, float hi) { unsigned r; asm volatile("v_cvt_pk_bf16_f32 %0, %1, %2" : "=v"(r) : "v"(lo), "v"(hi)); return r; }
#define DKSWZ(row, colB) ((row) * 128 + ((colB) ^ (((row) & 7) << 4)))
__device__ __forceinline__ int v_st(int k, int c) { const int kk = k;
  return ((kk >> 3) * 2 + (c >> 5)) * 512 + ((kk & 7) * 32 + (c & 31)) * 2; }
__device__ __forceinline__ int v_rd_base(int lane) { return ((lane & 3) << 3) | (((lane >> 2) & 3) << 6) | (((lane >> 4) & 1) << 5) | (((lane >> 5) & 1) << 8); }
constexpr int v_rd_off(int d0, int ks, int half) { return d0 * 512 + ks * 2048 + half * 1024; }
template <int OFF> __device__ __forceinline__ s16x4 tr_read(int vb) {
  s16x4 r; asm volatile("ds_read_b64_tr_b16 %0, %1 offset:%2" : "=&v"(r) : "v"(vb), "i"(OFF) : "memory"); return r;
}
template <int D0> __device__ __forceinline__ void pv_one(f32x16& od, int vb, bf16x8 pa0, bf16x8 pa1) {
  const s16x4 l0 = tr_read<v_rd_off(D0, 0, 0)>(vb), h0 = tr_read<v_rd_off(D0, 0, 1)>(vb), l1 = tr_read<v_rd_off(D0, 1, 0)>(vb), h1 = tr_read<v_rd_off(D0, 1, 1)>(vb);
  asm volatile("s_waitcnt lgkmcnt(0)" ::: "memory"); __builtin_amdgcn_sched_barrier(0);
#define PK(L, H) (bf16x8){L[0], L[1], L[2], L[3], H[0], H[1], H[2], H[3]}
  od = __builtin_amdgcn_mfma_f32_32x32x16_bf16(pa0, PK(l0, h0), od, 0, 0, 0);
  od = __builtin_amdgcn_mfma_f32_32x32x16_bf16(pa1, PK(l1, h1), od, 0, 0, 0);
#undef PK
}
struct KVRegs { bf16x8 k[4], v[4]; int pk; };
struct TaskId { int b, h, g, r, ub; };
__device__ __forceinline__ TaskId task_at(int i, int bx, int G, int wave) {
  TaskId t; int bh, k; t.b = 0; t.h = 0; t.g = 0; t.r = 0; t.ub = -1;
  if (G == 256) { if (i >= 6) return t; bh = (bx & 7) + 8 * (bx >> 6); k = ((((bx >> 3) & 7) * 6 + i) << 3) + wave; }
  else { const int id = (i * G + bx) * 8 + wave; if (id >= 12288) return t; bh = id / 384; k = id % 384; }
  const int g = k >> 7, kk = k & 127, nub = g == 0 ? 128 : (g == 1 ? 32 : 8);
  t.b = bh >> 3; t.h = bh & 7; t.g = g; t.r = kk / nub; t.ub = kk % nub; return t;
}
struct Pre { bf16x8 qr[4]; int pos_q; KVRegs R; };
__device__ __forceinline__ void load_blk(const unsigned short* __restrict__ qkv, const int* __restrict__ pos, const TaskId& t, int kb, KVRegs& R) {
  const int lane = threadIdx.x & 63, r32 = lane & 31, srow = lane >> 1, shalf = (lane & 1) * 32;
  const int dl = t.g == 0 ? 1 : (t.g == 1 ? 4 : 16), L = S / dl; const size_t rowb = (size_t)t.b * S;
  int up = 32 * (t.ub - 2 + kb) + srow; up = up < 0 ? 0 : (up >= L ? L - 1 : up);
  const unsigned short* base = qkv + (rowb + t.r + dl * up) * 1536 + t.h * 64 + shalf;
#pragma unroll
  for (int c = 0; c < 4; ++c) { R.k[c] = *reinterpret_cast<const bf16x8*>(base + 512 + c * 8); R.v[c] = *reinterpret_cast<const bf16x8*>(base + 1024 + c * 8); }
  int upl = 32 * (t.ub - 2 + kb) + r32; upl = upl < 0 ? 0 : (upl >= L ? L - 1 : upl);
  R.pk = pos[rowb + t.r + dl * upl];
}
__device__ __forceinline__ int kb_first(const TaskId& t) { return (t.ub >= 2) ? 0 : (2 - t.ub); }
__device__ __forceinline__ void dil_prefetch(const unsigned short* __restrict__ qkv, const int* __restrict__ pos, const TaskId& t, Pre& P) {
  const int lane = threadIdx.x & 63, r32 = lane & 31, hi = lane >> 5;
  const int dl = t.g == 0 ? 1 : (t.g == 1 ? 4 : 16); const size_t rowb = (size_t)t.b * S; const int tok_q = t.r + dl * (32 * t.ub + r32);
  const unsigned short* Qw = qkv + (rowb + tok_q) * 1536 + t.h * 64 + hi * 8;
#pragma unroll
  for (int d0 = 0; d0 < 4; ++d0) P.qr[d0] = *reinterpret_cast<const bf16x8*>(Qw + d0 * 16);
  P.pos_q = pos[rowb + tok_q];
  load_blk(qkv, pos, t, kb_first(t), P.R);
}
__device__ __forceinline__ void dil_task(const unsigned short* __restrict__ qkv, const int* __restrict__ pos, unsigned short* __restrict__ oap, float* __restrict__ lse,
                                         const TaskId t, Pre& P, bool has_next, const TaskId tn, char* wl  ) {
  const int lane = threadIdx.x & 63, r32 = lane & 31, hi = lane >> 5;
  const int b = t.b, h = t.h, g = t.g, r = t.r, ub = t.ub;
  const int dl = g == 0 ? 1 : (g == 1 ? 4 : 16), L = S / dl;
  const int u_q = 32 * ub + r32;
  const size_t rowb = (size_t)b * S;
  const int tok_q = r + dl * u_q;
  const float* tblw = (const float*)(wl + W_TBL); int* posw = (int*)(wl + W_POS); float* alw = (float*)(wl + W_AL);
  bf16x8 qr[4];
#pragma unroll
  for (int d0 = 0; d0 < 4; ++d0) qr[d0] = P.qr[d0];
  const int pos_q = P.pos_q;
  const int srow = lane >> 1, shalf = (lane & 1) * 32;
  const int vb0 = (int)(uintptr_t)(wl + W_V) + v_rd_base(lane);
  float m_reg = -1e30f, l_reg = 0.f; f32x16 o[2] = {};
  const int kb_lo = kb_first(t), kb_hi = (32 * (ub + 3) <= L) ? 4 : (4 - ((32 * (ub + 3) - L) >> 5));
  KVRegs R = P.R;
  for (int kb = kb_lo; kb <= kb_hi; ++kb) {
#pragma unroll
    for (int c = 0; c < 4; ++c) {
      *(bf16x8*)(wl + W_K + DKSWZ(srow, (shalf + c * 8) * 2)) = R.k[c];
      *(bf16x8*)(wl + W_V + v_st(srow, shalf + c * 8)) = R.v[c];
    }
    if (hi == 0) posw[r32] = R.pk;
    if (kb < kb_hi) load_blk(qkv, pos, t, kb + 1, R);
    asm volatile("s_waitcnt lgkmcnt(0)" ::: "memory"); __builtin_amdgcn_sched_barrier(0);
    f32x16 p = {};
#pragma unroll
    for (int d0 = 0; d0 < 4; ++d0) {
      const bf16x8 kf = *reinterpret_cast<const bf16x8*>(wl + W_K + DKSWZ(r32, (d0 * 16 + hi * 8) * 2));
      p = __builtin_amdgcn_mfma_f32_32x32x16_bf16(kf, qr[d0], p, 0, 0, 0);
    }
    float bmax;
    {
      int idx[16];
#pragma unroll
      for (int rr = 0; rr < 16; ++rr) { int rel = posw[crow(rr, hi)] - pos_q; rel = rel < -1024 ? -1024 : (rel > 1024 ? 1024 : rel); const int i_ = rel + 1024; idx[rr] = i_ ^ ((i_ >> 5) & 31); }
#pragma unroll
      for (int rr = 0; rr < 16; ++rr) p[rr] += tblw[idx[rr]];
    }
    if (kb == 0) {
#pragma unroll
      for (int rr = 0; rr < 16; ++rr) p[rr] = crow(rr, hi) >= r32 ? p[rr] : -INFINITY;
    } else if (kb == 4) {
#pragma unroll
      for (int rr = 0; rr < 16; ++rr) p[rr] = crow(rr, hi) <= r32 ? p[rr] : -INFINITY;
    }
    bmax = fmaxf(fmaxf(p[0], p[1]), fmaxf(p[2], p[3]));
#pragma unroll
    for (int rr = 4; rr < 16; rr += 4) bmax = fmaxf(bmax, fmaxf(fmaxf(p[rr], p[rr + 1]), fmaxf(p[rr + 2], p[rr + 3])));
    { auto x = __builtin_amdgcn_permlane32_swap(__float_as_uint(bmax), __float_as_uint(bmax), false, false); bmax = fmaxf(__uint_as_float(x[0]), __uint_as_float(x[1])); }
    float alpha = 1.f; bool resc = false;
    if (!__all(bmax - m_reg <= 11.5f)) { const float mn = fmaxf(m_reg, bmax); alpha = __builtin_amdgcn_exp2f(m_reg - mn); m_reg = mn; resc = true; }
    float ps = 0.f;
#pragma unroll
    for (int rr = 0; rr < 16; ++rr) p[rr] = __builtin_amdgcn_exp2f(p[rr] - m_reg);
    ps = ((p[0] + p[1]) + (p[2] + p[3])) + ((p[4] + p[5]) + (p[6] + p[7])) + (((p[8] + p[9]) + (p[10] + p[11])) + ((p[12] + p[13]) + (p[14] + p[15])));
    { auto x = __builtin_amdgcn_permlane32_swap(__float_as_uint(ps), __float_as_uint(ps), false, false); ps = __uint_as_float(x[0]) + __uint_as_float(x[1]); }
    l_reg = l_reg * alpha + ps;
    if (resc && kb != kb_lo) {
      if (hi == 0) alw[r32] = alpha;
      asm volatile("s_waitcnt lgkmcnt(0)" ::: "memory");
#pragma unroll
      for (int d = 0; d < 2; ++d)
#pragma unroll
        for (int rr = 0; rr < 16; ++rr) o[d][rr] *= alw[crow(rr, hi)];
    }
    bf16x8 pa0, pa1;
#define PK4(P, BASE, OUT) do { u32x4 w = {cvtpk(P[BASE + 0], P[BASE + 1]), cvtpk(P[BASE + 2], P[BASE + 3]), cvtpk(P[BASE + 4], P[BASE + 5]), cvtpk(P[BASE + 6], P[BASE + 7])}; \
    OUT = *reinterpret_cast<bf16x8*>(&w); } while (0)
    PK4(p, 0, pa0); PK4(p, 8, pa1);
#undef PK4
    pv_one<0>(o[0], vb0, pa0, pa1); pv_one<1>(o[1], vb0, pa0, pa1);
  }
  if (has_next) dil_prefetch(qkv, pos, tn, P);
  float* liw = alw;
  if (hi == 0) liw[r32] = l_reg;
  asm volatile("s_waitcnt lgkmcnt(0)" ::: "memory");
  if (hi == 0) lse[((size_t)g * T + rowb + tok_q) * 8 + h] = (m_reg + __log2f(l_reg)) * 0.6931471805599453f;
  unsigned short* Ow = oap + ((size_t)g * T + rowb + r + (size_t)dl * 32 * ub) * 512 + h * 64;
  char* ot = wl + W_K;
#pragma unroll
  for (int rr = 0; rr < 16; ++rr) { const int orow = crow(rr, hi); const float rl = __builtin_amdgcn_rcpf(liw[orow]);
#pragma unroll
    for (int d0 = 0; d0 < 2; ++d0) *(unsigned short*)(ot + orow * 144 + (d0 * 32 + r32) * 2) = (unsigned short)cvtpk(o[d0][rr] * rl, 0.f); }
  asm volatile("s_waitcnt lgkmcnt(0)" ::: "memory");
#pragma unroll
  for (int ps = 0; ps < 4; ++ps) { const int orow = ps * 8 + (lane >> 3), c = lane & 7;
    const u32x4 w = *(const u32x4*)(ot + orow * 144 + c * 16);
    *(u32x4*)(Ow + (size_t)orow * dl * 512 + c * 8) = w; }
  asm volatile("s_waitcnt lgkmcnt(0)" ::: "memory");
}
#undef DKSWZ
}

namespace mk {
#define GAS __attribute__((address_space(1)))
#define LAS __attribute__((address_space(3)))
typedef unsigned short bf16_t;
typedef unsigned v4u __attribute__((ext_vector_type(4)));
typedef unsigned v2u __attribute__((ext_vector_type(2)));
typedef float f32x4 __attribute__((ext_vector_type(4)));
#define LDS_WAIT() asm volatile("s_waitcnt lgkmcnt(0)" ::: "memory")
#define VM_WAIT() asm volatile("s_waitcnt vmcnt(0)" ::: "memory")
__device__ __forceinline__ unsigned f2bf(float f) { unsigned u = __builtin_bit_cast(unsigned, f); return (u + 0x7fffu + ((u >> 16) & 1u)) >> 16; }
typedef float f32x2_t __attribute__((ext_vector_type(2))); typedef __bf16 bf16x2_t __attribute__((ext_vector_type(2)));
__device__ __forceinline__ unsigned pk2(float lo, float hi) { const f32x2_t v = {lo, hi}; const bf16x2_t b = __builtin_convertvector(v, bf16x2_t); return __builtin_bit_cast(unsigned, b); }
__device__ __forceinline__ float bf2f(unsigned short b) { return __builtin_bit_cast(float, (unsigned)b << 16); }
__device__ __forceinline__ float wave_sum(float v) {
#pragma unroll
    for (int o = 1; o < 64; o <<= 1) v += __shfl_xor(v, o);
    return v;
}

#define XB_TMO      128
#define XB_XCNT(j)  (256  + 64 * (j))
#define XB_XSUB(j)  (1280 + 64 * (j))
#define XB_XGEN(j)  (2304 + 64 * (j))
#define XB_TOP      3328
#define XB_TOPGEN   3392
#define XCD_BAR_WORDS 3456
#define XB_SPIN_CAP (1u << 18)

__device__ __forceinline__ unsigned xb_ld(unsigned* p)              { return __hip_atomic_load(p, __ATOMIC_RELAXED, __HIP_MEMORY_SCOPE_AGENT); }
__device__ __forceinline__ unsigned xb_add(unsigned* p, unsigned v) { return __hip_atomic_fetch_add(p, v, __ATOMIC_RELAXED, __HIP_MEMORY_SCOPE_AGENT); }
__device__ __forceinline__ unsigned xb_xcc_id() { return (unsigned)__builtin_amdgcn_s_getreg((3 << 11) | 20) & 0xFu; }
#define XB_SPIN(cond, bar) do { unsigned _sp = 0; while (cond) { __builtin_amdgcn_s_sleep(1); \
    if ((++_sp & 255u) == 0u) { if (xb_ld(&(bar)[XB_TMO])) break; if (_sp > XB_SPIN_CAP) { atomicAdd(&(bar)[XB_TMO], 1u); break; } } } } while (0)

struct XcdBarrier {
    unsigned* bar; unsigned x;
    volatile LAS unsigned* st;
};

__device__ __forceinline__ XcdBarrier xcd_barrier_post(unsigned* bar, volatile LAS unsigned* st) {
    XcdBarrier b; b.bar = bar; b.x = xb_xcc_id(); b.st = st;
    if (threadIdx.x == 0) (void)xb_add(&bar[XB_XCNT(b.x)], 1u);
    return b;
}
__device__ __forceinline__ void xcd_barrier_complete(unsigned* bar, unsigned x, unsigned& nloc, unsigned& nx) {
    const unsigned G = gridDim.x * gridDim.y * gridDim.z;
    unsigned sum, cnt, mine, sp = 0u;
    for (;;) {
        sum = 0u; cnt = 0u; mine = 0u;
#pragma unroll
        for (unsigned j = 0; j < 16; ++j) { const unsigned c = xb_ld(&bar[XB_XCNT(j)]); sum += c; cnt += (c > 0u) ? 1u : 0u; mine = (j == x) ? c : mine; }
        if (sum == G) break;
        __builtin_amdgcn_s_sleep(1);
        if ((++sp & 255u) == 0u) { if (xb_ld(&bar[XB_TMO])) break; if (sp > XB_SPIN_CAP) { atomicAdd(&bar[XB_TMO], 1u); break; } }
    }
    nloc = mine > 0u ? mine : 1u; nx = cnt > 0u ? cnt : 1u;
}

__device__ __forceinline__ void xcd_barrier(const XcdBarrier& b) {
    asm volatile("s_waitcnt vmcnt(0)" ::: "memory");
    __syncthreads();
    if (threadIdx.x == 0) {
        unsigned* bar = b.bar;
        __builtin_amdgcn_s_waitcnt(0);
        unsigned nloc = b.st[0], nx = b.st[1];
        if (nloc == 0u) { xcd_barrier_complete(bar, b.x, nloc, nx); b.st[0] = nloc; b.st[1] = nx; }
        const unsigned old = xb_add(&bar[XB_XSUB(b.x)], 1u);
        const unsigned gen = old / nloc;
        if (old + 1u == (gen + 1u) * nloc) {
            __builtin_amdgcn_fence(__ATOMIC_RELEASE, "agent");
            asm volatile("s_waitcnt vmcnt(0)" ::: "memory");
            const unsigned og = xb_add(&bar[XB_TOP], 1u);
            const unsigned tg = og / nx;
            if (og + 1u == (tg + 1u) * nx) xb_add(&bar[XB_TOPGEN], 1u);
            else XB_SPIN(xb_ld(&bar[XB_TOPGEN]) == tg, bar);
            __builtin_amdgcn_fence(__ATOMIC_ACQUIRE, "agent");
            xb_add(&bar[XB_XGEN(b.x)], 1u);
            asm volatile("s_waitcnt vmcnt(0)" ::: "memory");
        } else {
            XB_SPIN(xb_ld(&bar[XB_XGEN(b.x)]) == gen, bar);
            __builtin_amdgcn_fence(__ATOMIC_ACQUIRE, "agent");
            asm volatile("s_waitcnt vmcnt(0)" ::: "memory");
        }
    }
    __syncthreads();
}

constexpr int NWAVES = 8;
constexpr int LDS_BYTES = 147456;
constexpr int RING_BYTES = 131072;
constexpr int CTRL_OFF = 135168;
constexpr int MISC_OFF = CTRL_OFF + 320;
constexpr size_t MiB = 1u << 20;
constexpr size_t WS_CTL = 0, CTL_ZERO_BYTES = 1 * MiB;
constexpr int CW_BAR = 16384;
constexpr size_t WS_WIN = 1 * MiB, WS_WQB = 5 * MiB, WS_WKVB = 5 * MiB + 512 * 1024, WS_WO = 6 * MiB, WS_WMQG = 8 * MiB, WS_WMKV = 10 * MiB, WS_WMO = 14 * MiB;
constexpr size_t WS_RSTDX = 16 * MiB, WS_RSTDM = 16 * MiB + 64 * 1024, WS_SSQQ = 16 * MiB + 256 * 1024, WS_SSQKV = 16 * MiB + 512 * 1024, WS_TBL = 16 * MiB + 768 * 1024;
constexpr size_t WS_WRG = 16 * MiB + 896 * 1024;
constexpr size_t WS_SSQH1 = 17 * MiB, WS_SSQH2 = 18 * MiB, WS_ZKPE = 20 * MiB, WS_CS = 22 * MiB;
constexpr size_t WS_XB = 24 * MiB, WS_MEMB = 56 * MiB, WS_KVMEM = 58 * MiB, WS_KPE = 62 * MiB;
constexpr size_t WS_QKVA = 64 * MiB, WS_ZQ = 112 * MiB, WS_ZKV = 120 * MiB, WS_QB = 124 * MiB, WS_KN = 148 * MiB, WS_VB = 164 * MiB;
constexpr size_t WS_WPT = 180 * MiB, WS_VWT = 188 * MiB, WS_H2 = 196 * MiB, WS_H2B = 260 * MiB, WS_ROUTE = 292 * MiB, WS_XS = 296 * MiB;
constexpr size_t WS_HMID = 296 * MiB, WS_OAP = 440 * MiB, WS_LSE = 488 * MiB, WS_OB = 490 * MiB, WS_OMIX = 506 * MiB;
constexpr size_t WS_H1 = 538 * MiB, WS_H1B = 602 * MiB, WS_P = 634 * MiB, WS_YBUF = 666 * MiB;
constexpr size_t WS_WGU = 794 * MiB, WS_WD = 922 * MiB, WS_END = 986 * MiB;

constexpr size_t WS_H2Q = 954 * MiB;
constexpr float W8_MUL = 64.0f, W8_INV = 1.0f / 64.0f, HM8_MUL = 4.0f, HM8_INV = 0.25f;
struct Args { const float* in[26]; float* out; unsigned char* ws; double rope_rev[16]; int ph_lo, ph_hi, flags, pad; };

struct CvtDesc { const float* W; const float* gain; bf16_t* WT; int K, N, mode, item, f8; float mul; };
__device__ __forceinline__ unsigned pk4f8(float a, float b, float c, float d) { int w = __builtin_amdgcn_cvt_pk_fp8_f32(a, b, 0, false); w = __builtin_amdgcn_cvt_pk_fp8_f32(c, d, w, true); return (unsigned)w; }
__device__ __forceinline__ void cvt_load(const CvtDesc& d, f32x4 (&v)[16], int lane) {
    const int nblk = (d.N + 63) >> 6, kb = d.item / nblk, nb = d.item % nblk, k0 = 64 * kb, n0 = 64 * nb;
    const int lk = lane >> 4, ln = (lane & 15) * 4;
    const bool ok = n0 + ln < d.N;
    const float* wp = d.W + (size_t)(k0 + lk) * d.N + n0 + ln;
#pragma unroll
    for (int i = 0; i < 16; ++i) v[i] = ok ? __builtin_nontemporal_load((const f32x4*)(wp + (size_t)(4 * i) * d.N)) : (f32x4){0.f, 0.f, 0.f, 0.f};
}
__device__ __forceinline__ void cvt_store(const CvtDesc& d, f32x4 (&v)[16], LAS float* scr, int lane) {
    const int nblk = (d.N + 63) >> 6, kb = d.item / nblk, nb = d.item % nblk, k0 = 64 * kb, n0 = 64 * nb;
    const int lk = lane >> 4, ln = (lane & 15) * 4;
    if (d.gain) {
#pragma unroll
        for (int i = 0; i < 16; ++i) v[i] = v[i] * (d.gain[k0 + 4 * i + lk] * d.mul);
    } else if (d.f8) {
#pragma unroll
        for (int i = 0; i < 16; ++i) v[i] = v[i] * d.mul;
    }
#pragma unroll
    for (int i = 0; i < 16; ++i) { LAS float* p = scr + (4 * i + lk) * 65 + ln; p[0] = v[i][0]; p[1] = v[i][1]; p[2] = v[i][2]; p[3] = v[i][3]; }
    LDS_WAIT(); asm volatile("" ::: "memory");
    int drow0 = n0; if (d.mode == 1) { const int half = n0 >> 10, c = n0 & 1023; drow0 = (c >> 7) * 256 + half * 128 + (c & 127); }
    if (d.f8) {
        const int c = lane & 3;
#pragma unroll
        for (int j = 0; j < 4; ++j) { const int n = (lane >> 2) + 16 * j; const LAS float* sp = scr + (16 * c) * 65 + n;
            v4u o; o.x = pk4f8(sp[0 * 65], sp[1 * 65], sp[2 * 65], sp[3 * 65]); o.y = pk4f8(sp[4 * 65], sp[5 * 65], sp[6 * 65], sp[7 * 65]);
            o.z = pk4f8(sp[8 * 65], sp[9 * 65], sp[10 * 65], sp[11 * 65]); o.w = pk4f8(sp[12 * 65], sp[13 * 65], sp[14 * 65], sp[15 * 65]);
            __builtin_nontemporal_store(o, (v4u*)((unsigned char*)d.WT + (size_t)(drow0 + n) * d.K + k0 + 16 * c)); }
    } else {
    const int c = lane & 7;
#pragma unroll
    for (int j = 0; j < 8; ++j) { const int n = (lane >> 3) + 8 * j; const LAS float* sp = scr + (8 * c) * 65 + n;
        v4u o; o.x = pk2(sp[0 * 65], sp[1 * 65]); o.y = pk2(sp[2 * 65], sp[3 * 65]); o.z = pk2(sp[4 * 65], sp[5 * 65]); o.w = pk2(sp[6 * 65], sp[7 * 65]);
        __builtin_nontemporal_store(o, (v4u*)(d.WT + (size_t)(drow0 + n) * d.K + k0 + 8 * c)); }
    }
    LDS_WAIT(); asm volatile("" ::: "memory");
}
__device__ __forceinline__ void prep_rows4(const float* x0, bf16_t* o0, float* rstd_out, int lane) {
    f32x4 v[4][4]; float s[4];
#pragma unroll
    for (int r = 0; r < 4; ++r)
#pragma unroll
        for (int j = 0; j < 4; ++j) v[r][j] = ((const f32x4*)(x0 + (size_t)r * 1024))[lane + 64 * j];
#pragma unroll
    for (int r = 0; r < 4; ++r) { float a = 0.f;
#pragma unroll
        for (int j = 0; j < 4; ++j) a += (v[r][j].x * v[r][j].x + v[r][j].y * v[r][j].y) + (v[r][j].z * v[r][j].z + v[r][j].w * v[r][j].w);
        s[r] = wave_sum(a); }
    if (lane < 4) rstd_out[lane] = 1.0f / sqrtf((lane == 0 ? s[0] : lane == 1 ? s[1] : lane == 2 ? s[2] : s[3]) * (1.0f / 1024.0f) + 1e-6f);
#pragma unroll
    for (int r = 0; r < 4; ++r) { unsigned long long* o8 = (unsigned long long*)(o0 + (size_t)r * 1024) + lane;
#pragma unroll
        for (int j = 0; j < 4; ++j) o8[64 * j] = (unsigned long long)pk2(v[r][j].x, v[r][j].y) | ((unsigned long long)pk2(v[r][j].z, v[r][j].w) << 32); }
}

__device__ __forceinline__ v4u pack8(const f32x4 a, const f32x4 b) { v4u w; w.x = pk2(a[0], a[1]); w.y = pk2(a[2], a[3]); w.z = pk2(b[0], b[1]); w.w = pk2(b[2], b[3]); return w; }
__device__ __forceinline__ float sq8(const f32x4 a, const f32x4 b) { return (a[0] * a[0] + a[1] * a[1]) + (a[2] * a[2] + a[3] * a[3]) + (b[0] * b[0] + b[1] * b[1]) + (b[2] * b[2] + b[3] * b[3]); }

struct EpiInProj {
    static constexpr bool PERM = true, AFTER_DRAIN = false;
    const float* rstd; bf16_t* qkv; bf16_t* zq; bf16_t* zkv; float* zkpe; float* ssq_q; float* ssq_kv;
    __device__ __forceinline__ void operator()(const pg8::f32x4 (&acc)[2][2][4][2], const pg8::Unit& u, int wr, int wc, int fr, int fq) const {
        const int row0 = u.pm * 256 + wr * 64 + fr;
        const float qs = u.pn < 2 ? 0.125f * 1.4426950408889634f : 1.0f;
        float rsv[8];
#pragma unroll
        for (int q = 0; q < 8; ++q) rsv[q] = rstd[row0 + (q >> 2) * 128 + (q & 3) * 16];
#pragma unroll
        for (int ai = 0; ai < 2; ++ai)
#pragma unroll
            for (int m = 0; m < 4; ++m) {
                const int row = row0 + ai * 128 + m * 16;
                const float rs = rsv[ai * 4 + m];
                float ss = 0.f;
#pragma unroll
                for (int bj = 0; bj < 2; ++bj) {
                    const f32x4 v0 = acc[ai][bj][m][0] * rs, v1 = acc[ai][bj][m][1] * rs;
                    const int ct = bj * 128 + wc * 32 + 8 * fq;
                    if (u.pn < 6) { *(v4u*)(qkv + (size_t)row * 1536 + u.pn * 256 + ct) = pack8(v0 * qs, v1 * qs); }
                    else if (u.pn == 6) { *(v4u*)(zq + (size_t)row * 256 + ct) = pack8(v0, v1); ss += sq8(v0, v1); }
                    else if (bj == 0) { *(v4u*)(zkv + (size_t)row * 128 + ct) = pack8(v0, v1); ss += sq8(v0, v1); }
                    else if (wc == 0) { *(f32x4*)(zkpe + (size_t)row * 32 + 8 * fq) = v0; *(f32x4*)(zkpe + (size_t)row * 32 + 8 * fq + 4) = v1; }
                }
                if (u.pn >= 6) { ss += __shfl_xor(ss, 16); ss += __shfl_xor(ss, 32); if (fq == 0) (u.pn == 6 ? ssq_q : ssq_kv)[(size_t)row * 4 + wc] = ss; }
            }
    }
};


struct EpiQ {
    static constexpr bool PERM = true, AFTER_DRAIN = false;
    const float* ssq; bf16_t* Q;
    __device__ __forceinline__ void operator()(const pg8::f32x4 (&acc)[2][2][4][2], const pg8::Unit& u, int wr, int wc, int fr, int fq) const {
        const int row0 = u.pm * 256 + wr * 64 + fr;
#pragma unroll
        for (int ai = 0; ai < 2; ++ai)
#pragma unroll
            for (int m = 0; m < 4; ++m) {
                const int row = row0 + ai * 128 + m * 16;
                const f32x4 sp = *(const f32x4*)(ssq + (size_t)row * 4);
                const float rs = (0.10206207261596577f * 1.4426950408889634f) / sqrtf(((sp[0] + sp[1]) + (sp[2] + sp[3])) * (1.0f / 256.0f) + 1e-6f);
#pragma unroll
                for (int bj = 0; bj < 2; ++bj)
                    *(v4u*)(Q + (size_t)row * 768 + u.pn * 256 + bj * 128 + wc * 32 + 8 * fq) = pack8(acc[ai][bj][m][0] * rs, acc[ai][bj][m][1] * rs);
            }
    }
};
struct EpiKV {
    static constexpr bool PERM = true, AFTER_DRAIN = false;
    const float* ssq; bf16_t* Kn; bf16_t* Vb;
    __device__ __forceinline__ void operator()(const pg8::f32x4 (&acc)[2][2][4][2], const pg8::Unit& u, int wr, int wc, int fr, int fq) const {
        const int row0 = u.pm * 256 + wr * 64 + fr;
        bf16_t* dst = (wc < 2 ? Kn : Vb) + (wc & 1) * 32 + 8 * fq;
#pragma unroll
        for (int ai = 0; ai < 2; ++ai)
#pragma unroll
            for (int m = 0; m < 4; ++m) {
                const int row = row0 + ai * 128 + m * 16;
                const f32x4 sp = *(const f32x4*)(ssq + (size_t)row * 4);
                const float rs = 1.0f / sqrtf(((sp[0] + sp[1]) + (sp[2] + sp[3])) * (1.0f / 128.0f) + 1e-6f);
#pragma unroll
                for (int bj = 0; bj < 2; ++bj)
                    *(v4u*)(dst + (size_t)row * 512 + (u.pn * 2 + bj) * 64) = pack8(acc[ai][bj][m][0] * rs, acc[ai][bj][m][1] * rs);
            }
    }
};
struct EpiRowScale {
    static constexpr bool PERM = true, AFTER_DRAIN = false;
    const float* rs; bf16_t* O; int ldc;
    __device__ __forceinline__ void operator()(const pg8::f32x4 (&acc)[2][2][4][2], const pg8::Unit& u, int wr, int wc, int fr, int fq) const {
        const int row0 = u.pm * 256 + wr * 64 + fr;
#pragma unroll
        for (int ai = 0; ai < 2; ++ai)
#pragma unroll
            for (int m = 0; m < 4; ++m) {
                const int row = row0 + ai * 128 + m * 16;
                const float r = rs[row];
#pragma unroll
                for (int bj = 0; bj < 2; ++bj)
                    *(v4u*)(O + (size_t)row * ldc + u.pn * 256 + bj * 128 + wc * 32 + 8 * fq) = pack8(acc[ai][bj][m][0] * r, acc[ai][bj][m][1] * r);
            }
    }
};

template <bool BASE_BF16, bool F8OUT = false> struct EpiResid {
    static constexpr bool PERM = true, AFTER_DRAIN = false;
    const void* base; bf16_t* outb; float* ssq; unsigned char* outq;
    __device__ __forceinline__ void operator()(const pg8::f32x4 (&acc)[2][2][4][2], const pg8::Unit& u, int wr, int wc, int fr, int fq) const {
        const int row0 = u.pm * 256 + wr * 64 + fr;
#pragma unroll
        for (int ai = 0; ai < 2; ++ai)
#pragma unroll
            for (int m = 0; m < 4; ++m) {
                const int row = row0 + ai * 128 + m * 16;
                float ss = 0.f;
#pragma unroll
                for (int bj = 0; bj < 2; ++bj) {
                    const size_t o = (size_t)row * 1024 + u.pn * 256 + bj * 128 + wc * 32 + 8 * fq;
                    f32x4 b0, b1;
                    if constexpr (BASE_BF16) { const v4u w = *(const v4u*)((const bf16_t*)base + o);
                        b0 = (f32x4){__builtin_bit_cast(float, w[0] << 16), __builtin_bit_cast(float, w[0] & 0xffff0000u), __builtin_bit_cast(float, w[1] << 16), __builtin_bit_cast(float, w[1] & 0xffff0000u)};
                        b1 = (f32x4){__builtin_bit_cast(float, w[2] << 16), __builtin_bit_cast(float, w[2] & 0xffff0000u), __builtin_bit_cast(float, w[3] << 16), __builtin_bit_cast(float, w[3] & 0xffff0000u)}; }
                    else { b0 = *(const f32x4*)((const float*)base + o); b1 = *(const f32x4*)((const float*)base + o + 4); }
                    const f32x4 v0 = acc[ai][bj][m][0] + b0, v1 = acc[ai][bj][m][1] + b1;
                    *(v4u*)(outb + o) = pack8(v0, v1); ss += sq8(v0, v1);
                    if constexpr (F8OUT) *(v2u*)(outq + o) = (v2u){pk4f8(v0[0], v0[1], v0[2], v0[3]), pk4f8(v1[0], v1[1], v1[2], v1[3])};
                }
                ss += __shfl_xor(ss, 16); ss += __shfl_xor(ss, 32);
                if (fq == 0) ssq[(size_t)row * 16 + u.pn * 4 + wc] = ss;
                asm volatile("" ::: "memory");
            }
    }
};
struct EpiPlain {
    static constexpr bool PERM = true, AFTER_DRAIN = false;
    bf16_t* O; int ldc;
    __device__ __forceinline__ void operator()(const pg8::f32x4 (&acc)[2][2][4][2], const pg8::Unit& u, int wr, int wc, int fr, int fq) const {
        const int row0 = u.pm * 256 + wr * 64 + fr;
#pragma unroll
        for (int ai = 0; ai < 2; ++ai)
#pragma unroll
            for (int m = 0; m < 4; ++m)
#pragma unroll
                for (int bj = 0; bj < 2; ++bj)
                    *(v4u*)(O + (size_t)(row0 + ai * 128 + m * 16) * ldc + u.pn * 256 + bj * 128 + wc * 32 + 8 * fq) = pack8(acc[ai][bj][m][0], acc[ai][bj][m][1]);
    }
};
struct EpiSoftmax {
    static constexpr bool PERM = true, AFTER_DRAIN = true;
    bf16_t* P; int rsl_off;
    __device__ __forceinline__ void fused(pg8::f32x4 (&acc)[2][2][4][2], const pg8::Unit& u, int wr, int wc, int fr, int fq, PG8_LAS unsigned char* lds, int wid, int lane) const {
        typedef float f32x2v __attribute__((ext_vector_type(2)));
        const PG8_LAS float* rsl = (const PG8_LAS float*)(lds + rsl_off);
        PG8_LAS f32x2v* X = (PG8_LAS f32x2v*)lds;
        constexpr float L2E = 1.4426950408889634f;
#pragma unroll
        for (int ai = 0; ai < 2; ++ai)
#pragma unroll
            for (int m = 0; m < 4; ++m) {
                const int rt = ai * 128 + wr * 64 + m * 16 + fr;
                const float rs = rsl[rt] * (0.0625f * L2E);
                float mx = -3.0e38f;
#pragma unroll
                for (int bj = 0; bj < 2; ++bj)
#pragma unroll
                    for (int n = 0; n < 2; ++n) { f32x4 v = acc[ai][bj][m][n] * rs; acc[ai][bj][m][n] = v; mx = fmaxf(mx, fmaxf(fmaxf(v[0], v[1]), fmaxf(v[2], v[3]))); }
                mx = fmaxf(mx, __shfl_xor(mx, 16)); mx = fmaxf(mx, __shfl_xor(mx, 32));
                float sm = 0.f;
#pragma unroll
                for (int bj = 0; bj < 2; ++bj)
#pragma unroll
                    for (int n = 0; n < 2; ++n) { const f32x4 v = acc[ai][bj][m][n]; sm += (__builtin_amdgcn_exp2f(v[0] - mx) + __builtin_amdgcn_exp2f(v[1] - mx)) + (__builtin_amdgcn_exp2f(v[2] - mx) + __builtin_amdgcn_exp2f(v[3] - mx)); }
                sm += __shfl_xor(sm, 16); sm += __shfl_xor(sm, 32);
                if (fq == 0) X[rt * 4 + wc] = (f32x2v){mx, sm};
            }
        asm volatile("s_waitcnt lgkmcnt(0)" ::: "memory"); __builtin_amdgcn_s_barrier(); asm volatile("" ::: "memory");
#pragma unroll
        for (int ai = 0; ai < 2; ++ai)
#pragma unroll
            for (int m = 0; m < 4; ++m) {
                const int rt = ai * 128 + wr * 64 + m * 16 + fr;
                const f32x2v x0 = X[rt * 4 + 0], x1 = X[rt * 4 + 1], x2 = X[rt * 4 + 2], x3 = X[rt * 4 + 3];
                const float M = fmaxf(fmaxf(x0.x, x1.x), fmaxf(x2.x, x3.x));
                const float tot = (x0.y * __builtin_amdgcn_exp2f(x0.x - M) + x1.y * __builtin_amdgcn_exp2f(x1.x - M)) + (x2.y * __builtin_amdgcn_exp2f(x2.x - M) + x3.y * __builtin_amdgcn_exp2f(x3.x - M));
                const float inv = 1.0f / tot;
#pragma unroll
                for (int bj = 0; bj < 2; ++bj) {
                    f32x4 a = acc[ai][bj][m][0], b = acc[ai][bj][m][1];
#pragma unroll
                    for (int j = 0; j < 4; ++j) { a[j] = __builtin_amdgcn_exp2f(a[j] - M) * inv; b[j] = __builtin_amdgcn_exp2f(b[j] - M) * inv; }
                    *(v4u*)(P + (size_t)(u.pm * 256 + rt) * 1024 + u.pn * 256 + bj * 128 + wc * 32 + 8 * fq) = pack8(a, b);
                }
            }
    }
};
struct OrderWp {
    int c;
    __device__ __forceinline__ bool next(int i, pg8::Unit& u) const { if (i > 0 || c >= 64) return false; const int bhh = c >> 2, pn = c & 3, b = bhh >> 2, h = bhh & 3;
        u.pm = bhh; u.pn = pn; u.aoff = ((size_t)(b * 256) * 2048 + h * 256) * 2; u.boff = ((size_t)(pn * 256) * 1024 + h * 256) * 2; return true; }
    __device__ __forceinline__ void a_ready(const pg8::Unit&) const {}
    __device__ __forceinline__ void done(const pg8::Unit&) const {}
};
struct OrderVw {
    int c;
    __device__ __forceinline__ bool next(int i, pg8::Unit& u) const { if (i > 0 || c >= 64) return false; const int b = c >> 4, ct = (c >> 2) & 3, h = c & 3;
        u.pm = b * 4 + ct; u.pn = h; u.aoff = ((size_t)(ct * 256) * 1024 + h * 256) * 2; u.boff = ((size_t)(b * 256) * 2048 + 1024 + h * 256) * 2; return true; }
    __device__ __forceinline__ void a_ready(const pg8::Unit&) const {}
    __device__ __forceinline__ void done(const pg8::Unit&) const {}
};
struct OrderBatch {
    pg8::StaticOrder so;
    __device__ __forceinline__ bool next(int i, pg8::Unit& u) const { if (!so.next(i, u)) return false; u.boff = ((size_t)((u.pm >> 4) * 1024 + u.pn * 256) * 1024) * 2; return true; }
    __device__ __forceinline__ void a_ready(const pg8::Unit&) const {}
    __device__ __forceinline__ void done(const pg8::Unit&) const {}
};

constexpr int MPADN = NA + NE * 256, NTILEN = MPADN / 256;
constexpr int CW_GCOUNT = 8192;
constexpr size_t RT_TOPI = 0, RT_TOPG = 256 * 1024, RT_SLOT = 512 * 1024, RT_ROWFLAT = 768 * 1024, RT_RSROW = 1088 * 1024, RT_RSTD = 1408 * 1024, RT_CNT = 1536 * 1024, RT_TOT = 1600 * 1024, RT_RGATE = 1664 * 1024;
constexpr int LX_TEXP = CTRL_OFF + 2048;
struct OrderMoe {
    const LAS int* texp; int nper, c, G; size_t ebytes;
    __device__ __forceinline__ bool next(int i, pg8::Unit& u) const {
        const int L = i * G + (c & 7) * (G >> 3) + (c >> 3); const int tile = L / nper, pn = L % nper;
        if (tile >= texp[NTILEN]) return false;
        u.pm = tile; u.pn = pn; u.aoff = (size_t)tile * 256 * 1024; u.boff = (size_t)texp[tile] * ebytes + (size_t)pn * 256 * 1024; return true; }
    __device__ __forceinline__ void a_ready(const pg8::Unit&) const {}
    __device__ __forceinline__ void done(const pg8::Unit&) const {}
};
__device__ __forceinline__ float swiglu1(float g, float u) { g = fminf(g, 7.0f); u = fminf(fmaxf(u, -7.0f), 7.0f); return (u + 1.0f) * g * __builtin_amdgcn_rcpf(1.0f + __builtin_amdgcn_exp2f(-1.702f * 1.4426950408889634f * g)); }
struct EpiSwiGLU {
    static constexpr bool PERM = true, AFTER_DRAIN = false;
    const float* rs_row; const float* bgu; unsigned char* hmid; const LAS int* texp;
    __device__ __forceinline__ void operator()(const pg8::f32x4 (&acc)[2][2][4][2], const pg8::Unit& u, int wr, int wc, int fr, int fq) const {
        const int row0 = u.pm * 256 + wr * 64 + fr, e = texp[u.pm], c0 = u.pn * 128 + wc * 32 + 8 * fq;
        const float* bg = bgu + (size_t)e * 2048 + c0;
        const f32x4 bg0 = *(const f32x4*)bg, bg1 = *(const f32x4*)(bg + 4), bu0 = *(const f32x4*)(bg + 1024), bu1 = *(const f32x4*)(bg + 1028);
        float rsv[8];
#pragma unroll
        for (int q = 0; q < 8; ++q) rsv[q] = rs_row[row0 + (q >> 2) * 128 + (q & 3) * 16] * W8_INV;
#pragma unroll
        for (int ai = 0; ai < 2; ++ai)
#pragma unroll
            for (int m = 0; m < 4; ++m) {
                const int row = row0 + ai * 128 + m * 16; const float rs = rsv[ai * 4 + m];
                const f32x4 g0 = acc[ai][0][m][0] * rs + bg0, g1 = acc[ai][0][m][1] * rs + bg1, u0 = acc[ai][1][m][0] * rs + bu0, u1 = acc[ai][1][m][1] * rs + bu1;
                f32x4 h0, h1;
#pragma unroll
                for (int j = 0; j < 4; ++j) { h0[j] = swiglu1(g0[j], u0[j]) * HM8_MUL; h1[j] = swiglu1(g1[j], u1[j]) * HM8_MUL; }
                *(v2u*)(hmid + (size_t)row * 1024 + c0) = (v2u){pk4f8(h0[0], h0[1], h0[2], h0[3]), pk4f8(h1[0], h1[1], h1[2], h1[3])};
            }
    }
};
struct EpiDown {
    static constexpr bool PERM = true, AFTER_DRAIN = false;
    const int* row_flat; const float* topg; const float* bd; bf16_t* ybuf; const LAS int* texp;
    __device__ __forceinline__ void operator()(const pg8::f32x4 (&acc)[2][2][4][2], const pg8::Unit& u, int wr, int wc, int fr, int fq) const {
        const int row0 = u.pm * 256 + wr * 64 + fr, e = texp[u.pm], c0 = u.pn * 256 + wc * 32 + 8 * fq;
        const float* bp = bd + (size_t)e * 1024 + c0;
        f32x4 bv[2][2];
#pragma unroll
        for (int bj = 0; bj < 2; ++bj) { bv[bj][0] = *(const f32x4*)(bp + bj * 128); bv[bj][1] = *(const f32x4*)(bp + bj * 128 + 4); }
        int av[8]; float gv[8];
#pragma unroll
        for (int q = 0; q < 8; ++q) { const int row = row0 + (q >> 2) * 128 + (q & 3) * 16; av[q] = row_flat[row]; gv[q] = topg[row]; }
#pragma unroll
        for (int ai = 0; ai < 2; ++ai)
#pragma unroll
            for (int m = 0; m < 4; ++m) {
                const int a = av[ai * 4 + m];
                if (a >= 0) { const float gt = gv[ai * 4 + m];
#pragma unroll
                    for (int bj = 0; bj < 2; ++bj)
                        *(v4u*)(ybuf + (size_t)a * 1024 + c0 + bj * 128) = pack8((acc[ai][bj][m][0] * (W8_INV * HM8_INV) + bv[bj][0]) * gt, (acc[ai][bj][m][1] * (W8_INV * HM8_INV) + bv[bj][1]) * gt); }
            }
    }
};

__device__ __forceinline__ int rel_bucket_d(int rel) {
    int n = rel < 0 ? -rel : rel;
    int b;
    if (n < 8) b = n; else if (n < 15) b = 8; else if (n < 27) b = 9; else if (n < 50) b = 10; else if (n < 91) b = 11;
    else if (n < 166) b = 12; else if (n < 305) b = 13; else if (n < 559) b = 14; else b = 15;
    return b + (rel > 0 ? 16 : 0);
}

static_assert(pg8::GTAB == CTRL_OFF + 4096 && pg8::GTAB + pg8::GTAB_UNITS * 512 <= LDS_BYTES && (NTILEN * 8 + 255) / 256 <= pg8::GTAB_UNITS && NWAVES * dil::W_BYTES <= CTRL_OFF && mla::SHM_ATTN <= CTRL_OFF && RING_BYTES <= CTRL_OFF && LX_TEXP + 4 * (NTILEN + 1) <= LDS_BYTES, "LDS map");
__global__ void __launch_bounds__(NWAVES * 64, 2) mk_fwd(Args args) {
    extern __shared__ __attribute__((aligned(16))) unsigned char lds_raw[];
    LAS unsigned char* lds = (LAS unsigned char*)lds_raw;
    const int tid = threadIdx.x, lane = tid & 63, wave = __builtin_amdgcn_readfirstlane(tid >> 6);
    const int G = gridDim.x; const int bx = blockIdx.x; const int vcu = (G % 8 == 0) ? (bx % 8) * (G / 8) + bx / 8 : bx;
    unsigned char* ws = args.ws;
    const int lo = args.ph_lo, hi = args.ph_hi;
#define IN(k) (lo <= (k) && (k) < hi)
#define BOTH(k) (IN(k) && IN((k) + 1))
    for (int u = tid; u < (LDS_BYTES - CTRL_OFF) / 4; u += NWAVES * 64) ((LAS unsigned*)(lds + CTRL_OFF))[u] = 0u;
    __syncthreads();
    XcdBarrier bar; bar.bar = (unsigned*)(ws + WS_CTL) + CW_BAR; bar.x = 0; bar.st = nullptr;
    if (hi - lo > 1) bar = xcd_barrier_post((unsigned*)(ws + WS_CTL) + CW_BAR, (volatile LAS unsigned*)(lds + MISC_OFF) + 8);
#define GRID_BAR(k) do { if (BOTH(k)) xcd_barrier(bar); } while (0)
    const float* x = args.in[0]; const float* mem = args.in[1]; const float* g_mix = args.in[3]; const float* w_in = args.in[4];
    const float* g_q_a = args.in[5]; const float* w_q_b = args.in[6]; const float* g_kv_a = args.in[7]; const float* w_kv_b = args.in[8];
    const float* w_o = args.in[12]; const float* g_xattn = args.in[13]; const float* g_mem = args.in[14]; const float* w_mq = args.in[15];
    const float* w_mkv = args.in[16]; const float* w_mo = args.in[17]; const float* g_moe = args.in[18];
    const float* w_gate_up = args.in[21]; const float* w_down = args.in[23];
    bf16_t* WinT = (bf16_t*)(ws + WS_WIN); bf16_t* WqbT = (bf16_t*)(ws + WS_WQB); bf16_t* WkvbT = (bf16_t*)(ws + WS_WKVB); bf16_t* WoT = (bf16_t*)(ws + WS_WO);
    bf16_t* Wmqg = (bf16_t*)(ws + WS_WMQG); bf16_t* WmkvT = (bf16_t*)(ws + WS_WMKV); bf16_t* WmoT = (bf16_t*)(ws + WS_WMO);
    bf16_t* WguT = (bf16_t*)(ws + WS_WGU); bf16_t* WdT = (bf16_t*)(ws + WS_WD);
    bf16_t* xb = (bf16_t*)(ws + WS_XB); bf16_t* memb = (bf16_t*)(ws + WS_MEMB);
    float* rstd_x = (float*)(ws + WS_RSTDX); float* rstd_mem = (float*)(ws + WS_RSTDM);

    if (IN(0)) {
        LAS float* scr = (LAS float*)(lds + wave * 16640);
        const int gw = vcu * NWAVES + wave, NGW = G * NWAVES;
        constexpr int I_IN = 16 * 31, I_QB = 4 * 12, I_KVB = 2 * 16, I_O = 16 * 16, I_MKV = 16 * 32, I_MO = 16 * 16, I_GU = 16 * 32, I_D = 16 * 16;
        const int n_exp = (args.flags & 1) ? 32 : 0;
        const int NITEMS = I_IN + I_QB + I_KVB + I_O + I_MKV + I_MO + n_exp * (I_GU + I_D);
        auto desc = [&](int it) {
            CvtDesc d; int r = it; d.mode = 0; d.f8 = 0; d.mul = 1.0f;
            if (r < I_IN) { d.W = w_in; d.K = 1024; d.N = 1952; d.gain = g_mix; d.WT = WinT; }
            else if ((r -= I_IN) < I_QB) { d.W = w_q_b; d.K = 256; d.N = 768; d.gain = g_q_a; d.WT = WqbT; }
            else if ((r -= I_QB) < I_KVB) { d.W = w_kv_b; d.K = 128; d.N = 1024; d.gain = g_kv_a; d.WT = WkvbT; }
            else if ((r -= I_KVB) < I_O) { d.W = w_o; d.K = 1024; d.N = 1024; d.gain = nullptr; d.WT = WoT; }
            else if ((r -= I_O) < I_MKV) { d.W = w_mkv; d.K = 1024; d.N = 2048; d.gain = g_mem; d.WT = WmkvT; }
            else if ((r -= I_MKV) < I_MO) { d.W = w_mo; d.K = 1024; d.N = 1024; d.gain = nullptr; d.WT = WmoT; }
            else if ((r -= I_MO) < 32 * I_GU) { const int e = r / I_GU; r -= e * I_GU; d.W = w_gate_up + (size_t)e * 1024 * 2048; d.K = 1024; d.N = 2048; d.gain = g_moe; d.WT = (bf16_t*)((unsigned char*)WguT + (size_t)e * 2048 * 1024); d.mode = 1; d.f8 = 1; d.mul = W8_MUL; }
            else { r -= 32 * I_GU; const int e = r / I_D; r -= e * I_D; d.W = w_down + (size_t)e * 1024 * 1024; d.K = 1024; d.N = 1024; d.gain = nullptr; d.WT = (bf16_t*)((unsigned char*)WdT + (size_t)e * 1024 * 1024); d.f8 = 1; d.mul = W8_MUL; }
            d.item = r; return d; };
        {
            f32x4 va[16], vb[16]; CvtDesc dc = desc(0), dn = dc; bool have = false;
            for (int it = gw; ; it += NGW) {
                const bool more = it < NITEMS;
                if (more) { dn = desc(it); cvt_load(dn, vb, lane); }
                if (have) cvt_store(dc, va, scr, lane);
                if (!more) break;
#pragma unroll
                for (int i = 0; i < 16; ++i) va[i] = vb[i];
                dc = dn; have = true;
            }
        }
        for (int i = gw * 64 + lane; i < 64 * 1024 / 8; i += NGW * 64) ((v4u*)(WinT + (size_t)1984 * 1024))[i] = (v4u){0u, 0u, 0u, 0u};
        for (int m = gw * 4; m < T; m += NGW * 4) prep_rows4(x + (size_t)m * D, xb + (size_t)m * D, rstd_x + m, lane);
        for (int m = gw * 4; m < NB * NMEM; m += NGW * 4) prep_rows4(mem + (size_t)m * D, memb + (size_t)m * D, rstd_mem + m, lane);
        { const float* w_router = args.in[19]; float* wrg = (float*)(ws + WS_WRG); for (int i = bx * 512 + tid; i < 1024 * 32; i += G * 512) wrg[i] = w_router[i] * g_moe[i >> 5]; }
        for (int m = gw; m < D; m += NGW) {
            const f32x4* xr = (const f32x4*)(w_mq + (size_t)m * D) + lane; const float gc = g_xattn[m];
            unsigned long long* o8 = (unsigned long long*)(Wmqg + (size_t)m * D) + lane;
#pragma unroll
            for (int j = 0; j < 4; ++j) { const f32x4 v = xr[64 * j] * gc; o8[64 * j] = (unsigned long long)pk2(v.x, v.y) | ((unsigned long long)pk2(v.z, v.w) << 32); }
        }
    }
    if (IN(0)) {
        const float* rel_bias = args.in[9]; float* tbl = (float*)(ws + WS_TBL);
        for (int i = bx * 512 + tid; i < 8 * 2049; i += G * 512) { const int h = i / 2049, r = i % 2049; tbl[h * 2112 + r] = rel_bias[rel_bucket_d(r - 1024) * 8 + h]; }
    }
    GRID_BAR(0);
    if (IN(1)) {
        int kx = 1024; asm volatile("" : "+s"(kx)); pg8::Gemm g{xb, WinT, kx, kx, kx}; pg8::StaticOrder S; S.init(T, 2048, 1024, 1024, G, bx);
        EpiInProj E{rstd_x, (bf16_t*)(ws + WS_QKVA), (bf16_t*)(ws + WS_ZQ), (bf16_t*)(ws + WS_ZKV), (float*)(ws + WS_ZKPE), (float*)(ws + WS_SSQQ), (float*)(ws + WS_SSQKV)};
        pg8::gemm_phase<EpiInProj, pg8::StaticOrder, true, true>(lds, g, S, E);
    }
    GRID_BAR(1);
    if (IN(2)) {
        const int* pos = (const int*)args.in[2];
        float* cs = (float*)(ws + WS_CS); const float* zkpe = (const float*)(ws + WS_ZKPE); bf16_t* kpe = (bf16_t*)(ws + WS_KPE);
        for (int i = bx * 512 + tid; i < T * 16; i += G * 512) {
            const int t = i >> 4, j = i & 15;
            const double rev = (double)pos[t] * args.rope_rev[j];
            const float fr_ = (float)(rev - floor(rev));
            const float sn = __builtin_amdgcn_sinf(fr_), c_ = __builtin_amdgcn_cosf(fr_);
            cs[(size_t)t * 32 + j] = c_; cs[(size_t)t * 32 + 16 + j] = sn;
            const float x1 = zkpe[(size_t)t * 32 + j], x2 = zkpe[(size_t)t * 32 + 16 + j];
            kpe[(size_t)t * 32 + j] = (bf16_t)f2bf(x1 * c_ - x2 * sn); kpe[(size_t)t * 32 + 16 + j] = (bf16_t)f2bf(x1 * sn + x2 * c_);
        }
        {   int kq = 256; asm volatile("" : "+s"(kq)); pg8::Gemm g{(const bf16_t*)(ws + WS_ZQ), WqbT, kq, kq, kq}; pg8::StaticOrder S; S.init(T, 768, 256, 256, G, bx);
            EpiQ E{(const float*)(ws + WS_SSQQ), (bf16_t*)(ws + WS_QB)};
            pg8::gemm_phase<EpiQ, pg8::StaticOrder, true, true>(lds, g, S, E); }
        {   int kk = 128; asm volatile("" : "+s"(kk)); pg8::Gemm g{(const bf16_t*)(ws + WS_ZKV), WkvbT, kk, kk, kk}; const bool memcu = ((bx + 64) % G) < 32 && G > 64; const int bx2 = bx - (bx >= G - 64 + 32 ? 32 : 0);
            pg8::StaticOrder S; S.init(memcu ? 0 : T, 1024, 128, 128, G > 64 ? G - 32 : G, G > 64 ? bx2 : bx);
            EpiKV E{(const float*)(ws + WS_SSQKV), (bf16_t*)(ws + WS_KN), (bf16_t*)(ws + WS_VB)};
            pg8::gemm_phase<EpiKV, pg8::StaticOrder, true, true>(lds, g, S, E); }
        {   int kx = 1024; asm volatile("" : "+s"(kx)); pg8::Gemm g{memb, WmkvT, kx, kx, kx}; pg8::StaticOrder S; S.init(NB * NMEM, 2048, 1024, 1024, G, (bx + 64) % G);
            EpiRowScale E{rstd_mem, (bf16_t*)(ws + WS_KVMEM), 2048};
            pg8::gemm_phase<EpiRowScale, pg8::StaticOrder, true, true>(lds, g, S, E); }
    }
    GRID_BAR(2);
    if (IN(3)) {
        const unsigned short* Qg = (const unsigned short*)(ws + WS_QB); const unsigned short* Kn = (const unsigned short*)(ws + WS_KN);
        const unsigned short* Kp = (const unsigned short*)(ws + WS_KPE); const unsigned short* Vg = (const unsigned short*)(ws + WS_VB);
        const float* cs = (const float*)(ws + WS_CS); unsigned short* Og = (unsigned short*)(ws + WS_OB);
        for (int i = 0; !(args.flags & 8); ++i) {
            int bh, qb;
            if (G == 256) { if (i >= 2) break; const int idx = i * 32 + (bx >> 3); bh = (bx & 7) + 8 * (idx >> 4); qb = idx & 15; }
            else { const int un = i * G + bx; if (un >= 512) break; bh = un >> 4; qb = un & 15; }
            const int b = bh >> 3, h = bh & 7;
#ifdef MLA_ABL
            if (args.flags & 16) mla::mla_unit<MLA_ABL>(Qg, Kn, Kp, Vg, cs, Og, b * S + qb * 256, b * S, h, S, (char*)lds_raw); else
#endif
            mla::mla_unit<0>(Qg, Kn, Kp, Vg, cs, Og, b * S + qb * 256, b * S, h, S, (char*)lds_raw);
        }
        {
            const unsigned short* qkv = (const unsigned short*)(ws + WS_QKVA); const int* pos = (const int*)args.in[2];
            const float* tbl = (const float*)(ws + WS_TBL); unsigned short* oap = (unsigned short*)(ws + WS_OAP); float* lse = (float*)(ws + WS_LSE);
            char* wl = (char*)lds_raw + wave * dil::W_BYTES;
            __syncthreads();
            int cur_h = -1;
            dil::TaskId tc = dil::task_at(0, bx, G, wave), tn = tc; dil::Pre P;
            bool have = !(args.flags & 4) && tc.ub >= 0;
            if (have) dil::dil_prefetch(qkv, pos, tc, P);
            for (int i = 0; have; ++i) {
                tn = dil::task_at(i + 1, bx, G, wave); const bool has_next = tn.ub >= 0;
                if (tc.h != cur_h) { float* tw = (float*)(wl + dil::W_TBL); for (int j = lane; j < 2049; j += 64) tw[j ^ ((j >> 5) & 31)] = tbl[tc.h * dil::TBL_PITCH + j] * 1.4426950408889634f; cur_h = tc.h; asm volatile("s_waitcnt vmcnt(0) lgkmcnt(0)" ::: "memory"); }
                dil::dil_task(qkv, pos, oap, lse, tc, P, has_next, tn, wl);
                tc = tn; have = has_next;
            }
        }
    }
    GRID_BAR(3);
    if (IN(4)) {
        { int kx = 256; asm volatile("" : "+s"(kx));
          if (bx < 64) { pg8::Gemm g{(const bf16_t*)(ws + WS_KVMEM), Wmqg, 2048, 1024, kx}; OrderWp S{bx}; EpiPlain E{(bf16_t*)(ws + WS_WPT), 1024};
              pg8::gemm_phase<EpiPlain, OrderWp, true, true>(lds, g, S, E); }
          else if (bx < 128) { pg8::Gemm g{WmoT, (const bf16_t*)(ws + WS_KVMEM), 1024, 2048, kx}; OrderVw S{bx - 64}; EpiPlain E{(bf16_t*)(ws + WS_VWT), 1024};
              pg8::gemm_phase<EpiPlain, OrderVw, true, true>(lds, g, S, E); } }
        const bf16_t* oap = (const bf16_t*)(ws + WS_OAP); const float* lse = (const float*)(ws + WS_LSE); const bf16_t* obp = (const bf16_t*)(ws + WS_OB);
        const float* g_out_a = args.in[10]; const float* g_out_b = args.in[11]; bf16_t* omix = (bf16_t*)(ws + WS_OMIX);
        const int gw = vcu * NWAVES + wave, NGW = G * NWAVES;
        const f32x4 ga0 = *(const f32x4*)(g_out_a + 8 * lane), ga1 = *(const f32x4*)(g_out_a + 8 * lane + 4), gb0 = *(const f32x4*)(g_out_b + 8 * lane), gb1 = *(const f32x4*)(g_out_b + 8 * lane + 4);
#define UNPK_LO(V_) ((f32x4){__builtin_bit_cast(float, (V_)[0] << 16), __builtin_bit_cast(float, (V_)[0] & 0xffff0000u), __builtin_bit_cast(float, (V_)[1] << 16), __builtin_bit_cast(float, (V_)[1] & 0xffff0000u)})
#define UNPK_HI(V_) ((f32x4){__builtin_bit_cast(float, (V_)[2] << 16), __builtin_bit_cast(float, (V_)[2] & 0xffff0000u), __builtin_bit_cast(float, (V_)[3] << 16), __builtin_bit_cast(float, (V_)[3] & 0xffff0000u)})
        for (int tok = gw; tok < T; tok += NGW) {
            const int head = lane >> 3;
            const float l0 = lse[((size_t)0 * T + tok) * 8 + head], l1 = lse[((size_t)1 * T + tok) * 8 + head], l2 = lse[((size_t)2 * T + tok) * 8 + head];
            const float mx = fmaxf(l0, fmaxf(l1, l2)); float w0 = __expf(l0 - mx), w1 = __expf(l1 - mx), w2 = __expf(l2 - mx); const float wi = 1.0f / (w0 + w1 + w2); w0 *= wi; w1 *= wi; w2 *= wi;
            const v4u q0 = *(const v4u*)(oap + ((size_t)0 * T + tok) * 512 + 8 * lane), q1 = *(const v4u*)(oap + ((size_t)1 * T + tok) * 512 + 8 * lane);
            const v4u q2 = *(const v4u*)(oap + ((size_t)2 * T + tok) * 512 + 8 * lane), qb = *(const v4u*)(obp + (size_t)tok * 512 + 8 * lane);
            const f32x4 a0 = UNPK_LO(q0) * w0 + UNPK_LO(q1) * w1 + UNPK_LO(q2) * w2, a1 = UNPK_HI(q0) * w0 + UNPK_HI(q1) * w1 + UNPK_HI(q2) * w2, b0 = UNPK_LO(qb), b1 = UNPK_HI(qb);
            const float sa = wave_sum(sq8(a0, a1)), sb = wave_sum(sq8(b0, b1));
            const float ra = 1.0f / sqrtf(sa * (1.0f / 512.0f) + 1e-6f), rb = 1.0f / sqrtf(sb * (1.0f / 512.0f) + 1e-6f);
            *(v4u*)(omix + (size_t)tok * 1024 + 8 * lane) = pack8(a0 * ra * ga0, a1 * ra * ga1);
            *(v4u*)(omix + (size_t)tok * 1024 + 512 + 8 * lane) = pack8(b0 * rb * gb0, b1 * rb * gb1);
        }
#undef UNPK_LO
#undef UNPK_HI
    }
    GRID_BAR(4);
    if (IN(5)) {
        int kx = 1024; asm volatile("" : "+s"(kx));
        pg8::Gemm g{(const bf16_t*)(ws + WS_OMIX), WoT, kx, kx, kx}; pg8::StaticOrder S; S.init(T, 1024, 1024, 1024, G, bx);
        EpiResid<false> E{x, (bf16_t*)(ws + WS_H1B), (float*)(ws + WS_SSQH1), nullptr};
        pg8::gemm_phase<EpiResid<false>, pg8::StaticOrder, true, true>(lds, g, S, E);
    }
    GRID_BAR(5);
    if (IN(6)) {
        int kx = 1024; asm volatile("" : "+s"(kx));
        pg8::Gemm g{(const bf16_t*)(ws + WS_H1B), (const bf16_t*)(ws + WS_WPT), kx, kx, kx}; OrderBatch S; S.so.init(T, 1024, 1024, 1024, G, bx);
        pg8::Unit u0; const bool has = S.next(0, u0);
        LAS float* rsl = (LAS float*)(lds + CTRL_OFF + 1024);
        if (has && tid < 256) { const float* sp = (const float*)(ws + WS_SSQH1) + (size_t)(u0.pm * 256 + tid) * 16; float a = 0.f;
#pragma unroll
            for (int j = 0; j < 4; ++j) { const f32x4 v = ((const f32x4*)sp)[j]; a += (v[0] + v[1]) + (v[2] + v[3]); }
            rsl[tid] = 1.0f / sqrtf(a * (1.0f / 1024.0f) + 1e-6f); }
        __syncthreads();
        EpiSoftmax E{(bf16_t*)(ws + WS_P), CTRL_OFF + 1024};
        pg8::gemm_phase<EpiSoftmax, OrderBatch, false, true>(lds, g, S, E);
    }
    GRID_BAR(6);
    if (IN(7)) {
        int kx = 1024; asm volatile("" : "+s"(kx));
        pg8::Gemm g{(const bf16_t*)(ws + WS_P), (const bf16_t*)(ws + WS_VWT), kx, kx, kx}; OrderBatch S; S.so.init(T, 1024, 1024, 1024, G, bx);
        EpiResid<true, true> E{(const bf16_t*)(ws + WS_H1B), (bf16_t*)(ws + WS_H2B), (float*)(ws + WS_SSQH2), (unsigned char*)(ws + WS_H2Q)};
        pg8::gemm_phase<EpiResid<true, true>, OrderBatch, true, true>(lds, g, S, E);
    }
    GRID_BAR(7);
    if (IN(8)) {
        typedef float f32x16 __attribute__((ext_vector_type(16)));
        const bf16_t* h2b = (const bf16_t*)(ws + WS_H2B); const float* b_router = args.in[20]; const float* ssq2 = (const float*)(ws + WS_SSQH2);
        int* topi = (int*)(ws + WS_ROUTE + RT_TOPI); float* topg = (float*)(ws + WS_ROUTE + RT_TOPG); int* tslot = (int*)(ws + WS_ROUTE + RT_SLOT); int* row_flat = (int*)(ws + WS_ROUTE + RT_ROWFLAT);
        for (int i = bx * 512 + tid; i < MPADN; i += G * 512) row_flat[i] = -1;
        LAS float* part = (LAS float*)lds;
        LAS float* lgt = (LAS float*)(lds + 32768);
        for (int ch = bx; ch < T / 64; ch += G) {
            const int tok0 = ch * 64, tb = wave & 1, kq = wave >> 1, kh = lane >> 5, row = tok0 + 32 * tb + (lane & 31);
            f32x16 acc = {};
            const bf16_t* ap = h2b + (size_t)row * 1024 + 256 * kq + 4 * kh; const float* wp = (const float*)(ws + WS_WRG) + (size_t)(256 * kq + 4 * kh) * 32 + (lane & 31);
#pragma unroll 8
            for (int j = 0; j < 32; ++j) {
                const v2u aw = *(const v2u*)(ap + 8 * j);
                const f32x4 a4 = (f32x4){__builtin_bit_cast(float, aw.x << 16), __builtin_bit_cast(float, aw.x & 0xffff0000u), __builtin_bit_cast(float, aw.y << 16), __builtin_bit_cast(float, aw.y & 0xffff0000u)};
#pragma unroll
                for (int e = 0; e < 4; ++e) acc = __builtin_amdgcn_mfma_f32_32x32x2f32(a4[e], wp[(size_t)(8 * j + e) * 32], acc, 0, 0, 0);
            }
#pragma unroll
            for (int r = 0; r < 16; ++r) part[((kq * 64) + tb * 32 + (r & 3) + 8 * (r >> 2) + 4 * kh) * 32 + (lane & 31)] = acc[r];
            __syncthreads();
            {
                const int tk = tid >> 3, e0 = (tid & 7) * 4; const float* sp = ssq2 + (size_t)(tok0 + tk) * 16; float a = 0.f;
#pragma unroll
                for (int j = 0; j < 4; ++j) { const f32x4 v = ((const f32x4*)sp)[j]; a += (v[0] + v[1]) + (v[2] + v[3]); }
                const float rs = 1.0f / sqrtf(a * (1.0f / 1024.0f) + 1e-6f);
                if (e0 == 0) ((float*)(ws + WS_ROUTE + RT_RSTD))[tok0 + tk] = rs;
#pragma unroll
                for (int e = 0; e < 4; ++e) lgt[tk * 33 + e0 + e] = rs * ((part[(0 * 64 + tk) * 32 + e0 + e] + part[(1 * 64 + tk) * 32 + e0 + e]) + (part[(2 * 64 + tk) * 32 + e0 + e] + part[(3 * 64 + tk) * 32 + e0 + e])) + b_router[e0 + e];
            }
            __syncthreads();
            if (tid < 64) {
                int c0 = -1, c1 = -1, c2 = -1, c3 = -1; float v0 = 0.f, v1 = 0.f, v2 = 0.f, v3 = 0.f; int s0 = 0, s1 = 0, s2 = 0, s3 = 0;
                for (int k = 0; k < 4; ++k) {
                    float best = -3.0e38f; int bi = 0;
                    for (int e = 0; e < 32; ++e) { const float v = lgt[tid * 33 + e]; if (e == c0 || e == c1 || e == c2 || e == c3) continue; if (v > best) { best = v; bi = e; } }
                    if (k == 0) { c0 = bi; v0 = best; } else if (k == 1) { c1 = bi; v1 = best; } else if (k == 2) { c2 = bi; v2 = best; } else { c3 = bi; v3 = best; }
                }
                const unsigned long long lt = (1ull << lane) - 1ull; int* cntc = (int*)(ws + WS_ROUTE + RT_CNT) + ch * 32;
                for (int e = 0; e < 32; ++e) {
                    const unsigned long long m0 = __ballot(c0 == e), m1 = __ballot(c1 == e), m2 = __ballot(c2 == e), m3 = __ballot(c3 == e);
                    const int before = __popcll(m0 & lt) + __popcll(m1 & lt) + __popcll(m2 & lt) + __popcll(m3 & lt);
                    if (c0 == e) s0 = before; if (c1 == e) s1 = before; if (c2 == e) s2 = before; if (c3 == e) s3 = before;
                    if (lane == e) cntc[e] = __popcll(m0) + __popcll(m1) + __popcll(m2) + __popcll(m3);
                }
                const int t = tok0 + tid;
                const float e1 = __expf(v1 - v0), e2 = __expf(v2 - v0), e3 = __expf(v3 - v0), inv = 1.0f / (1.0f + e1 + e2 + e3);
                *(int4*)(topi + t * 4) = make_int4(c0, c1, c2, c3);
                *(f32x4*)(topg + t * 4) = (f32x4){inv, e1 * inv, e2 * inv, e3 * inv};
                *(int4*)(tslot + t * 4) = make_int4(s0, s1, s2, s3);
            }
            __syncthreads();
        }
    }
    GRID_BAR(8);
    if (IN(9)) {
        const int* topi = (const int*)(ws + WS_ROUTE + RT_TOPI); const int* tslot = (const int*)(ws + WS_ROUTE + RT_SLOT); const int* cnt = (const int*)(ws + WS_ROUTE + RT_CNT);
        int* row_flat = (int*)(ws + WS_ROUTE + RT_ROWFLAT); float* rs_row = (float*)(ws + WS_ROUTE + RT_RSROW); const float* rstd2 = (const float*)(ws + WS_ROUTE + RT_RSTD);
        LAS int* red = (LAS int*)lds;
        for (int base = bx * 512; base < NA; base += G * 512) {
            const int chA = base >> 8, e = tid & 31, part = tid >> 5;
            int tot = 0, pa = 0, pb = 0;
            for (int c = part; c < T / 64; c += 16) { const int v = cnt[c * 32 + e]; tot += v; pa += c < chA ? v : 0; pb += c <= chA ? v : 0; }
            __syncthreads();
            red[(0 * 16 + part) * 32 + e] = tot; red[(1 * 16 + part) * 32 + e] = pa; red[(2 * 16 + part) * 32 + e] = pb;
            __syncthreads();
            if (tid < 96) { const int w = tid >> 5; int a = 0; for (int p = 0; p < 16; ++p) a += red[(w * 16 + p) * 32 + e]; red[1536 + w * 32 + e] = a; }
            __syncthreads();
            if (tid == 0) { int run = 0; for (int q = 0; q < NE; ++q) { red[1632 + q] = run; run += ((red[1536 + q] + 255) >> 8) << 8; } }
            if (bx == 0 && base == 0 && tid < 32) ((int*)(ws + WS_ROUTE + RT_TOT))[tid] = red[1536 + tid];
            __syncthreads();
            const int a = base + tid, ex = topi[a], row = red[1632 + ex] + red[1536 + 32 * (1 + (((a >> 8) - chA) & 1)) + ex] + tslot[a];
            row_flat[row] = a; rs_row[row] = rstd2[a >> 2]; ((float*)(ws + WS_ROUTE + RT_RGATE))[row] = ((const float*)(ws + WS_ROUTE + RT_TOPG))[a];
        }
    }
    GRID_BAR(9);
    if (IN(10) || IN(11)) {
        const int* gtot = (const int*)(ws + WS_ROUTE + RT_TOT); LAS int* texp = (LAS int*)(lds + LX_TEXP);
        __syncthreads();
        if (tid < 64) {
            const int n = tid < NE ? (gtot[tid] + 255) >> 8 : 0; int inc = n;
#pragma unroll
            for (int d = 1; d < 32; d <<= 1) { const int v = __shfl_up(inc, d); if ((tid & 63) >= d) inc += v; }
            const int start = inc - n;
            if (tid < NE) for (int j = 0; j < n; ++j) texp[start + j] = tid;
            if (tid == NE - 1) texp[NTILEN] = inc;
        }
        __syncthreads();
    }
    if (IN(10)) {
        int kx = 512; asm volatile("" : "+s"(kx));
        pg8::Gemm g{(const bf16_t*)(ws + WS_H2Q), WguT, kx, kx, kx}; OrderMoe S{(const LAS int*)(lds + LX_TEXP), 8, bx, G, (size_t)2048 * 1024};
        {
            const int* row_flat = (const int*)(ws + WS_ROUTE + RT_ROWFLAT); pg8::Unit u;
            int av[pg8::GTAB_UNITS];
#pragma unroll
            for (int i = 0; i < pg8::GTAB_UNITS; ++i) { av[i] = -2; if (S.next(i, u) && tid < 256) av[i] = row_flat[u.pm * 256 + tid]; }
#pragma unroll
            for (int i = 0; i < pg8::GTAB_UNITS; ++i) if (av[i] != -2) ((LAS unsigned short*)(lds + pg8::GTAB))[i * 256 + tid] = (unsigned short)(av[i] >= 0 ? (av[i] >> 2) : 0);
            __syncthreads();
        }
        EpiSwiGLU E{(const float*)(ws + WS_ROUTE + RT_RSROW), args.in[22], (unsigned char*)(ws + WS_HMID), (const LAS int*)(lds + LX_TEXP)};
        pg8::gemm_phase<EpiSwiGLU, OrderMoe, true, true, true, true>(lds, g, S, E);
    }
    GRID_BAR(10);
    if (IN(11)) {
        int kx = 512; asm volatile("" : "+s"(kx));
        pg8::Gemm g{(const bf16_t*)(ws + WS_HMID), WdT, kx, kx, kx}; OrderMoe S{(const LAS int*)(lds + LX_TEXP), 4, bx, G, (size_t)1024 * 1024};
        EpiDown E{(const int*)(ws + WS_ROUTE + RT_ROWFLAT), (const float*)(ws + WS_ROUTE + RT_RGATE), args.in[24], (bf16_t*)(ws + WS_YBUF), (const LAS int*)(lds + LX_TEXP)};
        pg8::gemm_phase<EpiDown, OrderMoe, true, true, false, true>(lds, g, S, E);
    }
    GRID_BAR(11);
    if (IN(12)) {
        const bf16_t* h2b = (const bf16_t*)(ws + WS_H2B); const bf16_t* ybuf = (const bf16_t*)(ws + WS_YBUF); const float* g_final = args.in[25]; float* outp = args.out;
        const int gw = vcu * NWAVES + wave, NGW = G * NWAVES;
        for (int t = gw; t < T; t += NGW) {
            f32x4 v[4]; float ss = 0.f;
#pragma unroll
            for (int j = 0; j < 4; ++j) {
                const v2u hw = *(const v2u*)(h2b + (size_t)t * 1024 + 256 * j + 4 * lane);
                f32x4 a = (f32x4){__builtin_bit_cast(float, hw.x << 16), __builtin_bit_cast(float, hw.x & 0xffff0000u), __builtin_bit_cast(float, hw.y << 16), __builtin_bit_cast(float, hw.y & 0xffff0000u)};
#pragma unroll
                for (int k = 0; k < 4; ++k) { const v2u y = *(const v2u*)(ybuf + ((size_t)t * 4 + k) * 1024 + 256 * j + 4 * lane);
                    a[0] += __builtin_bit_cast(float, y.x << 16); a[1] += __builtin_bit_cast(float, y.x & 0xffff0000u); a[2] += __builtin_bit_cast(float, y.y << 16); a[3] += __builtin_bit_cast(float, y.y & 0xffff0000u); }
                v[j] = a; ss += (a[0] * a[0] + a[1] * a[1]) + (a[2] * a[2] + a[3] * a[3]);
            }
            ss = wave_sum(ss); const float rs = 1.0f / sqrtf(ss * (1.0f / 1024.0f) + 1e-6f);
#pragma unroll
            for (int j = 0; j < 4; ++j) *(f32x4*)(outp + (size_t)t * 1024 + 256 * j + 4 * lane) = v[j] * rs * *(const f32x4*)(g_final + 256 * j + 4 * lane);
        }
    }
#undef GRID_BAR
#undef BOTH
#undef IN
}

}
void launch_mk(hipStream_t st, const mk::Args& base, int lo, int hi, int grid) {
    mk::Args a = base; a.ph_lo = lo; a.ph_hi = hi;
    hipLaunchKernelGGL(mk::mk_fwd, dim3(grid), dim3(mk::NWAVES * 64), mk::LDS_BYTES, st, a);
}
}

extern "C" void kernel_launch(void* const* d_in, const int* in_sizes, int n_in, void* d_out, int out_size, void* d_ws, size_t ws_size, hipStream_t stream) {
    static int grid = 0;
    if (grid == 0) {
        int dev = 0, cus = 0;
        if (hipGetDevice(&dev) != hipSuccess || hipDeviceGetAttribute(&cus, hipDeviceAttributeMultiprocessorCount, dev) != hipSuccess) { grid = -1; return; }
        if (hipFuncSetAttribute((const void*)mk::mk_fwd, hipFuncAttributeMaxDynamicSharedMemorySize, mk::LDS_BYTES) != hipSuccess) { grid = -1; return; }
        grid = cus >= 256 ? 256 : cus;
    }
    if (grid < 0) return;
    const float* x = (const float*)d_in[0];
    const float* mem = (const float*)d_in[1];
    const int* pos = (const int*)d_in[2];
    const float* g_q_a = (const float*)d_in[5];
    const float* w_q_b = (const float*)d_in[6];
    const float* g_kv_a = (const float*)d_in[7];
    const float* w_kv_b = (const float*)d_in[8];
    const float* rel_bias = (const float*)d_in[9];
    const float* g_out_a = (const float*)d_in[10];
    const float* g_out_b = (const float*)d_in[11];
    const float* w_o = (const float*)d_in[12];
    const float* g_xattn = (const float*)d_in[13];
    const float* g_mem = (const float*)d_in[14];
    const float* w_mq = (const float*)d_in[15];
    const float* w_mkv = (const float*)d_in[16];
    const float* w_mo = (const float*)d_in[17];
    const float* g_moe = (const float*)d_in[18];
    const float* w_router = (const float*)d_in[19];
    const float* b_router = (const float*)d_in[20];
    const float* w_gate_up = (const float*)d_in[21];
    const float* b_gate_up = (const float*)d_in[22];
    const float* w_down = (const float*)d_in[23];
    const float* b_down = (const float*)d_in[24];
    const float* g_final = (const float*)d_in[25];
    float* out = (float*)d_out;
    (void)ws_size; (void)in_sizes; (void)n_in; (void)out_size;

    (void)hipMemsetAsync((char*)d_ws + mk::WS_CTL, 0, mk::CTL_ZERO_BYTES, stream);
    mk::Args ma; memset(&ma, 0, sizeof(ma));
    for (int i = 0; i < 26; ++i) ma.in[i] = (const float*)d_in[i];
    ma.out = out; ma.ws = (unsigned char*)d_ws; ma.flags = 1;
    for (int j = 0; j < 16; ++j) ma.rope_rev[j] = pow(10000.0, -(double)j / 16.0) / 6.283185307179586476925287;
#ifndef MK_N_LAUNCHES
#define MK_N_LAUNCHES 1
#endif
    if (MK_N_LAUNCHES == 1) launch_mk(stream, ma, 0, 13, grid);
    else for (int p = 0; p < 13; ++p) launch_mk(stream, ma, p, p + 1, grid);
#ifdef PROBE_MASK
#ifdef PROBE_FLAGS
    ma.flags |= PROBE_FLAGS;
#endif
    for (int r = 0; r < PROBE_N; ++r) for (int p = 0; p < 13; ++p) if ((PROBE_MASK >> p) & 1) launch_mk(stream, ma, p, p + 1, grid);
#endif
}
```

```cpp
#include <hip/hip_runtime.h>
#include <stdint.h>
#include <string.h>
#include <math.h>

namespace {
constexpr int NB = 4, S = 4096, D = 1024, T = NB * S, NMEM = 256, INW = 1952;
constexpr int NE = 32, TOPK = 4, NA = T * TOPK;

namespace pg8 {
#define PG8_LAS __attribute__((address_space(3)))
typedef unsigned short bf16_t;
typedef short bf16x8 __attribute__((ext_vector_type(8)));
typedef float f32x4 __attribute__((ext_vector_type(4)));
typedef unsigned u32x4 __attribute__((ext_vector_type(4)));
constexpr int BM = 256, BK = 64, HALF = 128, HTB = HALF * BK * 2  , STAGE_BYTES = 8 * HTB, NXCD = 8, WGM = 8;

__host__ __device__ __forceinline__ int lds_byte(int r, int c) { const int st = (r >> 4) * 2 + (c >> 5), rr = r & 15, cc = c & 31, ob = rr * 64 + cc * 2; return st * 1024 + (ob ^ (((ob >> 9) & 1) << 5)); }
__host__ __device__ __forceinline__ void stage_rc(int b, int& R, int& C) { const int st = b / 1024, sb = b % 1024, swz = sb ^ (((sb >> 9) & 1) << 5); R = (st >> 1) * 16 + swz / 64; C = (st & 1) * 32 + (swz % 64) / 2; }
__host__ __device__ __forceinline__ int perm32(int rho) { const int n = rho >> 4, i = rho & 15; return 8 * (i >> 2) + 4 * n + (i & 3); }

struct Unit { int pm, pn; size_t aoff, boff; };
struct Gemm { const bf16_t* A; const bf16_t* Bt; int lda, ldb, K; };

struct StaticOrder {
    int nM, nN, nwg, G, c; size_t ta, tb;
    __host__ __device__ __forceinline__ void init(int M, int N, int lda, int ldb, int G_, int c_) { nM = M / BM; nN = N / BM; nwg = nM * nN; G = G_; c = c_; ta = (size_t)BM * lda * 2; tb = (size_t)BM * ldb * 2; }
    __host__ __device__ __forceinline__ bool next(int i, Unit& u) const {
        const long L = (long)i * G + c; if (L >= nwg) return false;
        int wgid = (int)L; { const int q = nwg / NXCD, r = nwg % NXCD, xcd = wgid % NXCD, off = wgid / NXCD; wgid = (xcd < r ? xcd * (q + 1) : r * (q + 1) + (xcd - r) * q) + off; }
        const int nig = WGM * nN, gid = wgid / nig, fm = gid * WGM, gsz = (nM - fm) < WGM ? (nM - fm) : WGM;
        u.pm = fm + ((wgid % nig) % gsz); u.pn = (wgid % nig) / gsz; u.aoff = (size_t)u.pm * ta; u.boff = (size_t)u.pn * tb; return true;
    }
    __device__ __forceinline__ void a_ready(const Unit&) const {}
    __device__ __forceinline__ void done(const Unit&) const {}
};

__device__ __forceinline__ unsigned cvt_pk_bf16(float lo, float hi) { unsigned r; asm volatile("v_cvt_pk_bf16_f32 %0, %1, %2" : "=v"(r) : "v"(lo), "v"(hi)); return r; }
typedef float f32x2 __attribute__((ext_vector_type(2)));

constexpr int GTAB = 135168 + 4096, GTAB_UNITS = 10;
typedef int i32x4 __attribute__((ext_vector_type(4)));
typedef int i32x8 __attribute__((ext_vector_type(8)));
__device__ __forceinline__ i32x8 cat8(const bf16x8 a, const bf16x8 b) { return __builtin_shufflevector(__builtin_bit_cast(i32x4, a), __builtin_bit_cast(i32x4, b), 0, 1, 2, 3, 4, 5, 6, 7); }
template <class Epi, class Sched, bool ALIGN_EPI = false, bool SP2 = false, bool GATHER = false, bool F8 = false>
__device__ __forceinline__ void gemm_phase(PG8_LAS unsigned char* lds, const Gemm g, const Sched& S, const Epi& E) {
    const int tid = threadIdx.x, wid = __builtin_amdgcn_readfirstlane(tid >> 6), lane = tid & 63, wr = wid >> 2, wc = wid & 3, fr = lane & 15, fq = lane >> 4;
    static_assert(!GATHER || SP2, "GATHER is implemented for the SP2 loop only");
    const int K = g.K, nt = K / BK;
    unsigned voffA[2], voffB[2];
#pragma unroll
    for (int i = 0; i < 2; ++i) { int R, C; stage_rc(tid * 16 + i * 8192, R, C); const int Rb = Epi::PERM ? ((R & ~31) + perm32(R & 31)) : R;
        voffA[i] = (unsigned)(R * g.lda + C) * 2u; voffB[i] = (unsigned)(Rb * g.ldb + C) * 2u; }
    unsigned gidx[2], gcol[2];
#pragma unroll
    for (int i = 0; i < 2; ++i) { int R, C; stage_rc(tid * 16 + i * 8192, R, C); gidx[i] = (unsigned)R * 2u; gcol[i] = (unsigned)C * 2u; }
    const size_t kstep = (size_t)(BK * 2);
    const size_t hstepA = (size_t)HALF * g.lda * 2, hstepB = (size_t)HALF * g.ldb * 2;
    const unsigned ldsw = (unsigned)wid * 1024u;
    const int aoff = lds_byte(wr * 64 + fr, fq * 8), boff = lds_byte(wc * 32 + fr, fq * 8);
#define PG8_SA(b, h) (((b) * 2 + (h)) * HTB)
#define PG8_SB(b, h) ((4 + (b) * 2 + (h)) * HTB)
#define PG8_GLDS(gptr, off32, ldsdst) do { unsigned _o = (off32); asm volatile("" : "+v"(_o)); __builtin_amdgcn_global_load_lds((const unsigned*)((const char*)(gptr) + _o), (ldsdst), 16, 0, 0); } while (0)
#define PG8_STAGE(bufoff, gbase, voff) do { _Pragma("unroll") for (int _i = 0; _i < 2; ++_i) \
        PG8_GLDS(gbase, (voff)[_i], (PG8_LAS unsigned*)(lds + (bufoff) + ldsw + _i * 8192)); } while (0)
#define PG8_GTOK(h, sel) do { if constexpr (GATHER) { tk0 = *(const PG8_LAS unsigned short*)(lds + GTAB + (sel) * 512 + (h) * 256 + gidx[0]); tk1 = *(const PG8_LAS unsigned short*)(lds + GTAB + (sel) * 512 + (h) * 256 + gidx[1]); } } while (0)
#define PG8_STAGE_A(bufoff, gbase, h, sel) do { if constexpr (GATHER) { \
        PG8_GLDS(gbase, tk0 * (unsigned)(g.lda * 2) + gcol[0], (PG8_LAS unsigned*)(lds + (bufoff) + ldsw)); \
        PG8_GLDS(gbase, tk1 * (unsigned)(g.lda * 2) + gcol[1], (PG8_LAS unsigned*)(lds + (bufoff) + ldsw + 8192)); } \
    else { PG8_STAGE(bufoff, (gbase) + (h) * hstepA, voffA); } } while (0)
#define PG8_LDA(dst, b, h) do { _Pragma("unroll") for (int m = 0; m < 4; ++m) _Pragma("unroll") for (int k = 0; k < 2; ++k) dst[m][k] = *(const PG8_LAS bf16x8*)(lds + PG8_SA(b, h) + aoff + m * 2048 + k * 1024); } while (0)
#define PG8_LDB(dst, b, h) do { _Pragma("unroll") for (int n = 0; n < 2; ++n) _Pragma("unroll") for (int k = 0; k < 2; ++k) dst[n][k] = *(const PG8_LAS bf16x8*)(lds + PG8_SB(b, h) + boff + n * 2048 + k * 1024); } while (0)
#define PG8_MMA(ai, bj, At, Bt) do { __builtin_amdgcn_s_setprio(1); _Pragma("unroll") for (int m = 0; m < 4; ++m) _Pragma("unroll") for (int n = 0; n < 2; ++n) { \
        if constexpr (F8) { const i32x8 _b = cat8(Bt[n][0], Bt[n][1]), _a = cat8(At[m][0], At[m][1]); asm volatile("s_nop 1\n\tv_mfma_f32_16x16x128_f8f6f4 %0, %1, %2, %0" : "+v"(acc[ai][bj][m][n]) : "v"(_b), "v"(_a)); } \
        else { _Pragma("unroll") for (int k = 0; k < 2; ++k) acc[ai][bj][m][n] = __builtin_amdgcn_mfma_f32_16x16x32_bf16(Bt[n][k], At[m][k], acc[ai][bj][m][n], 0, 0, 0); } } __builtin_amdgcn_s_setprio(0); } while (0)
#define PG8_WAIT_V(n) asm volatile("s_waitcnt vmcnt(" #n ")" ::: "memory")
#define PG8_WAIT_L(n) asm volatile("s_waitcnt lgkmcnt(" #n ")" ::: "memory")
#define PG8_BAR __builtin_amdgcn_s_barrier()
#define PG8_SCHED __builtin_amdgcn_sched_barrier(0)
    Unit cur, nxt; int ui = 0; unsigned tk0 = 0, tk1 = 0; (void)tk0; (void)tk1;
    if (!S.next(0, cur)) return;
    f32x4 acc[2][2][4][2];
#pragma unroll
    for (int a = 0; a < 2; ++a)
#pragma unroll
        for (int b = 0; b < 2; ++b)
#pragma unroll
            for (int m = 0; m < 4; ++m)
#pragma unroll
                for (int n = 0; n < 2; ++n) acc[a][b][m][n] = (f32x4){0.f, 0.f, 0.f, 0.f};
    bf16x8 At[4][2], B0[2][2], B1[2][2];
    const char* cA = (const char*)g.A + (GATHER ? (size_t)0 : cur.aoff); const char* cB = (const char*)g.Bt + cur.boff;
    S.a_ready(cur);
    if constexpr (SP2) {
        PG8_STAGE(PG8_SB(0, 0), cB, voffB); PG8_STAGE(PG8_SB(0, 1), cB + hstepB, voffB); PG8_GTOK(0, ui); PG8_STAGE_A(PG8_SA(0, 0), cA, 0, ui); PG8_GTOK(1, ui); PG8_STAGE_A(PG8_SA(0, 1), cA, 1, ui);
        if (wr == 1) PG8_BAR;
        PG8_WAIT_V(2); PG8_BAR;
        PG8_STAGE(PG8_SB(1, 0), cB + kstep, voffB); PG8_GTOK(0, ui); PG8_STAGE_A(PG8_SA(1, 0), cA + kstep, 0, ui); PG8_STAGE(PG8_SB(1, 1), cB + hstepB + kstep, voffB);
        PG8_WAIT_V(6); PG8_BAR;
    } else {
        PG8_STAGE(PG8_SB(0, 0), cB, voffB); PG8_STAGE_A(PG8_SA(0, 0), cA, 0, ui); PG8_STAGE(PG8_SB(0, 1), cB + hstepB, voffB); PG8_STAGE_A(PG8_SA(0, 1), cA, 1, ui);
        if (wr == 1) PG8_BAR;
        PG8_WAIT_V(4); PG8_BAR;
        PG8_STAGE(PG8_SB(1, 0), cB + kstep, voffB); PG8_STAGE_A(PG8_SA(1, 0), cA + kstep, 0, ui); PG8_STAGE(PG8_SB(1, 1), cB + hstepB + kstep, voffB);
        PG8_WAIT_V(6); PG8_BAR;
    }
    for (;;) {
        const bool has_next = S.next(ui + 1, nxt);
        const char* nA = has_next ? (const char*)g.A + (GATHER ? (size_t)0 : nxt.aoff) : cA; const char* nB = has_next ? (const char*)g.Bt + nxt.boff : cB;
        for (int t = 0; t < nt; t += 2) {
            const bool last = (t == nt - 2);
            const char* a1 = cA + (size_t)(t + 1) * kstep;
            const char* a2 = last ? nA : cA + (size_t)(t + 2) * kstep; const char* b2 = last ? nB : cB + (size_t)(t + 2) * kstep;
            const char* a3 = a2 + kstep; const char* b3 = b2 + kstep; const int ui2 = (last && has_next) ? ui + 1 : ui; (void)ui2;
            if (last && has_next) S.a_ready(nxt);
            if constexpr (SP2) {
            PG8_GTOK(1, ui); PG8_LDB(B0, 0, 0); PG8_LDB(B1, 0, 1); PG8_SCHED; PG8_LDA(At, 0, 0); PG8_STAGE_A(PG8_SA(1, 1), a1, 1, ui);
            PG8_WAIT_V(8); PG8_WAIT_L(0); PG8_BAR; PG8_MMA(0, 0, At, B0); PG8_MMA(0, 1, At, B1); PG8_BAR; PG8_SCHED;
            PG8_GTOK(0, ui2); PG8_LDA(At, 0, 1); PG8_STAGE(PG8_SB(0, 0), b2, voffB); PG8_STAGE(PG8_SB(0, 1), b2 + hstepB, voffB); PG8_STAGE_A(PG8_SA(0, 0), a2, 0, ui2);
            PG8_WAIT_V(8); PG8_WAIT_L(0); PG8_BAR; PG8_MMA(1, 0, At, B0); PG8_MMA(1, 1, At, B1); PG8_BAR; PG8_SCHED;
            PG8_GTOK(1, ui2); PG8_LDB(B0, 1, 0); PG8_LDB(B1, 1, 1); PG8_SCHED; PG8_LDA(At, 1, 0); PG8_STAGE_A(PG8_SA(0, 1), a2, 1, ui2);
            PG8_WAIT_V(8); PG8_WAIT_L(0); PG8_BAR; PG8_MMA(0, 0, At, B0); PG8_MMA(0, 1, At, B1); PG8_BAR; PG8_SCHED;
            PG8_GTOK(0, ui2); PG8_LDA(At, 1, 1); PG8_STAGE(PG8_SB(1, 0), b3, voffB); PG8_STAGE(PG8_SB(1, 1), b3 + hstepB, voffB); PG8_STAGE_A(PG8_SA(1, 0), a3, 0, ui2);
            PG8_WAIT_V(8); PG8_WAIT_L(0); PG8_BAR; PG8_MMA(1, 0, At, B0); PG8_MMA(1, 1, At, B1); PG8_BAR; PG8_SCHED;
            } else {
            PG8_LDB(B0, 0, 0); PG8_SCHED; PG8_LDA(At, 0, 0); PG8_STAGE_A(PG8_SA(1, 1), a1, 1, ui);
            PG8_WAIT_L(8); PG8_BAR; PG8_WAIT_L(0); PG8_MMA(0, 0, At, B0); PG8_BAR; PG8_SCHED;
            PG8_LDB(B1, 0, 1); PG8_STAGE(PG8_SB(0, 0), b2, voffB);
            PG8_BAR; PG8_WAIT_L(0); PG8_MMA(0, 1, At, B1); PG8_BAR;
            PG8_LDA(At, 0, 1); PG8_STAGE_A(PG8_SA(0, 0), a2, 0, ui2);
            PG8_BAR; PG8_WAIT_L(0); PG8_MMA(1, 0, At, B0); PG8_BAR; PG8_SCHED;
            PG8_STAGE(PG8_SB(0, 1), b2 + hstepB, voffB);
            PG8_WAIT_V(6); PG8_BAR; PG8_MMA(1, 1, At, B1); PG8_BAR;
            PG8_LDB(B0, 1, 0); PG8_SCHED; PG8_LDA(At, 1, 0); PG8_STAGE_A(PG8_SA(0, 1), a2, 1, ui2);
            PG8_WAIT_L(8); PG8_BAR; PG8_WAIT_L(0); PG8_MMA(0, 0, At, B0); PG8_BAR; PG8_SCHED;
            PG8_LDB(B1, 1, 1); PG8_STAGE(PG8_SB(1, 0), b3, voffB);
            PG8_BAR; PG8_WAIT_L(0); PG8_MMA(0, 1, At, B1); PG8_BAR;
            PG8_LDA(At, 1, 1); PG8_STAGE_A(PG8_SA(1, 0), a3, 0, ui2);
            PG8_BAR; PG8_WAIT_L(0); PG8_MMA(1, 0, At, B0); PG8_BAR; PG8_SCHED;
            PG8_STAGE(PG8_SB(1, 1), b3 + hstepB, voffB);
            PG8_WAIT_V(6); PG8_BAR; PG8_MMA(1, 1, At, B1); PG8_BAR;
            }
        }
        if constexpr (F8) {
#define PG8_A4(a, b) "+v"(acc[a][b][0][0]), "+v"(acc[a][b][0][1]), "+v"(acc[a][b][1][0]), "+v"(acc[a][b][1][1]), "+v"(acc[a][b][2][0]), "+v"(acc[a][b][2][1]), "+v"(acc[a][b][3][0]), "+v"(acc[a][b][3][1])
            asm volatile("s_nop 11\n\ts_nop 3" : PG8_A4(0, 0), PG8_A4(0, 1));
            asm volatile("" : PG8_A4(1, 0), PG8_A4(1, 1));
#undef PG8_A4
        }
        if constexpr (ALIGN_EPI) { if (wr == 0) PG8_BAR; }
        if constexpr (!Epi::AFTER_DRAIN) { E(acc, cur, wr, wc, fr, fq); S.done(cur); }
        if (!has_next) break;
#pragma unroll
        for (int a = 0; a < 2; ++a)
#pragma unroll
            for (int b = 0; b < 2; ++b)
#pragma unroll
                for (int m = 0; m < 4; ++m)
#pragma unroll
                    for (int n = 0; n < 2; ++n) acc[a][b][m][n] = (f32x4){0.f, 0.f, 0.f, 0.f};
        cur = nxt; cA = nA; cB = nB; ++ui;
        if constexpr (ALIGN_EPI) { if (wr == 1) PG8_BAR; }
    }
    PG8_WAIT_V(0);
    if constexpr (!ALIGN_EPI) { if (wr == 0) PG8_BAR; }
    PG8_BAR;
    if constexpr (Epi::AFTER_DRAIN) { E.fused(acc, cur, wr, wc, fr, fq, lds, wid, lane); S.done(cur); }
#undef PG8_SA
#undef PG8_SB
#undef PG8_GLDS
#undef PG8_STAGE
#undef PG8_STAGE_A
#undef PG8_GTOK
#undef PG8_LDA
#undef PG8_LDB
#undef PG8_MMA
#undef PG8_WAIT_V
#undef PG8_WAIT_L
#undef PG8_BAR
#undef PG8_SCHED
}
}
namespace mla {
using bf16x8 = __attribute__((ext_vector_type(8))) short;
using s16x4  = __attribute__((ext_vector_type(4))) short;
using f32x16 = __attribute__((ext_vector_type(16))) float;
using u32x4  = __attribute__((ext_vector_type(4))) unsigned;
constexpr int NW = 8, QBLK = 32, KVBLK = 64;
constexpr float SCALE = 0.10206207261596577f;
constexpr float THR = 8.f;
constexpr int SHM_V = KVBLK * 64 * 2, SHM_K = KVBLK * 256;
constexpr int SHM_ATTN = 4 * SHM_V + 4 * SHM_K + NW * 64 * 4;
#define KSWZ(row, colB) ((row) * 256 + ((colB) ^ (((row) & 7) << 4)))
#define SBAR() __builtin_amdgcn_sched_barrier(0)
__device__ __forceinline__ int crow(int r, int hi) { return (r & 3) + 8 * (r >> 2) + 4 * hi; }
__device__ __forceinline__ unsigned cvtpk(float lo, float hi) { unsigned r; asm volatile("v_cvt_pk_bf16_f32 %0, %1, %2" : "=v"(r) : "v"(lo), "v"(hi)); return r; }

__device__ __forceinline__ float max3f(float a, float b, float c) { return __builtin_fmaxf(__builtin_fmaxf(a, b), c); }
template <int ABL> __device__ __forceinline__ void partialSM(f32x16& p0, f32x16& p1, float& m_reg, float& alpha, bool first) {
  float a = max3f(p0[0], p0[1], p0[2]), b = max3f(p0[3], p1[0], p1[1]), c = max3f(p1[2], p1[3], p0[4]), d = max3f(p0[5], p0[6], p0[7]);
  a = max3f(a, p1[4], p1[5]); b = max3f(b, p1[6], p1[7]);
#pragma unroll
  for (int r = 8; r < 16; r += 4) { a = max3f(a, p0[r], p0[r + 1]); b = max3f(b, p0[r + 2], p0[r + 3]); c = max3f(c, p1[r], p1[r + 1]); d = max3f(d, p1[r + 2], p1[r + 3]); }
  float pmax = fmaxf(fmaxf(a, b), fmaxf(c, d));
  { auto rr = __builtin_amdgcn_permlane32_swap(__float_as_uint(pmax), __float_as_uint(pmax), false, false);
    pmax = fmaxf(__uint_as_float(rr[0]), __uint_as_float(rr[1])); }
  if (__builtin_expect(!first && __all(pmax - m_reg <= THR * 1.4426950408889634f), 1)) { alpha = 1.f; }
  else { const float mn = first ? pmax : fmaxf(m_reg, pmax); alpha = first ? 1.f : __builtin_amdgcn_exp2f(m_reg - mn); m_reg = mn; }
#pragma unroll
  for (int r = 0; r < 16; ++r) { p0[r] -= m_reg; p1[r] -= m_reg; }
#pragma unroll
  for (int r = 0; r < 16; ++r) p0[r] = (ABL & 2) ? p0[r] * 0.5f : __builtin_amdgcn_exp2f(p0[r]);
}
template <int ABL> __device__ __forceinline__ void finishSM(f32x16& p0, f32x16& p1, float alpha, float& l_reg, bf16x8& pa0, bf16x8& pa1, bf16x8& pa2, bf16x8& pa3) {
#pragma unroll
  for (int r = 0; r < 16; ++r) p1[r] = (ABL & 2) ? p1[r] * 0.5f : __builtin_amdgcn_exp2f(p1[r]);
  float ps, s0 = 0.f, s1 = 0.f, s2 = 0.f, s3 = 0.f;
#pragma unroll
  for (int r = 0; r < 16; r += 4) { s0 += p0[r]; s1 += p0[r + 1]; s2 += p0[r + 2]; s3 += p0[r + 3]; }
#pragma unroll
  for (int r = 0; r < 16; r += 4) { s0 += p1[r]; s1 += p1[r + 1]; s2 += p1[r + 2]; s3 += p1[r + 3]; }
  ps = (s0 + s1) + (s2 + s3);
  { auto rr = __builtin_amdgcn_permlane32_swap(__float_as_uint(ps), __float_as_uint(ps), false, false);
    ps = __uint_as_float(rr[0]) + __uint_as_float(rr[1]); }
  l_reg = l_reg * alpha + ps;
#define PK4(P, BASE, OUT) do { u32x4 w = {cvtpk(P[BASE + 0], P[BASE + 1]), cvtpk(P[BASE + 2], P[BASE + 3]), cvtpk(P[BASE + 4], P[BASE + 5]), cvtpk(P[BASE + 6], P[BASE + 7])}; \
    OUT = *reinterpret_cast<bf16x8*>(&w); } while (0)
  PK4(p0, 0, pa0); PK4(p0, 8, pa1); PK4(p1, 0, pa2); PK4(p1, 8, pa3);
#undef PK4
}
__device__ __forceinline__ void qkt(f32x16& p0, f32x16& p1, const char* Ks, const bf16x8* qr, int r32, int hi) {
  p0 = f32x16{}; p1 = f32x16{};
#pragma unroll
  for (int d0 = 0; d0 < 6; ++d0) { int cb = (d0 * 16 + hi * 8) * 2;
    bf16x8 b0 = *reinterpret_cast<const bf16x8*>(Ks + KSWZ(r32, cb));
    bf16x8 b1 = *reinterpret_cast<const bf16x8*>(Ks + KSWZ(32 + r32, cb));
    p0 = __builtin_amdgcn_mfma_f32_32x32x16_bf16(b0, qr[d0], p0, 0, 0, 0);
    p1 = __builtin_amdgcn_mfma_f32_32x32x16_bf16(b1, qr[d0], p1, 0, 0, 0); }
}
__device__ __forceinline__ int v_st(int k, int c) { const int kk = k;
  return ((kk >> 3) * 2 + (c >> 5)) * 512 + ((kk & 7) * 32 + (c & 31)) * 2; }
__device__ __forceinline__ int v_rd_base(int lane) { return ((lane & 3) << 3) | (((lane >> 2) & 3) << 6) | (((lane >> 4) & 1) << 5) | (((lane >> 5) & 1) << 8); }
constexpr int v_rd_off(int d0, int ks, int half) { return d0 * 512 + ks * 2048 + half * 1024; }
template <int OFF> __device__ __forceinline__ s16x4 tr_read(int vb) {
  s16x4 r; asm volatile("ds_read_b64_tr_b16 %0, %1 offset:%2" : "=&v"(r) : "v"(vb), "i"(OFF) : "memory"); return r;
}
#define PK(L, H) (bf16x8){L[0], L[1], L[2], L[3], H[0], H[1], H[2], H[3]}
#define PV_RD(KS, LA, HA, LB, HB) do { LA = tr_read<v_rd_off(0, KS, 0)>(vb); HA = tr_read<v_rd_off(0, KS, 1)>(vb); LB = tr_read<v_rd_off(1, KS, 0)>(vb); HB = tr_read<v_rd_off(1, KS, 1)>(vb); } while (0)
#define PV_MM(PA, LA, HA, LB, HB) do { o[0] = __builtin_amdgcn_mfma_f32_32x32x16_bf16(PA, PK(LA, HA), o[0], 0, 0, 0); o[1] = __builtin_amdgcn_mfma_f32_32x32x16_bf16(PA, PK(LB, HB), o[1], 0, 0, 0); } while (0)
__device__ __forceinline__ void pv_d0(f32x16* o, int vb, bf16x8 pa0, bf16x8 pa1, bf16x8 pa2, bf16x8 pa3) {
  s16x4 la, ha, lb, hb, lc, hc, ld, hd;
  PV_RD(0, la, ha, lb, hb);
  PV_RD(1, lc, hc, ld, hd);
  asm volatile("s_waitcnt lgkmcnt(4)" ::: "memory"); SBAR();
  PV_MM(pa0, la, ha, lb, hb); SBAR();
  PV_RD(2, la, ha, lb, hb);
  asm volatile("s_waitcnt lgkmcnt(4)" ::: "memory"); SBAR();
  PV_MM(pa1, lc, hc, ld, hd); SBAR();
  PV_RD(3, lc, hc, ld, hd);
  asm volatile("s_waitcnt lgkmcnt(4)" ::: "memory"); SBAR();
  PV_MM(pa2, la, ha, lb, hb); SBAR();
  asm volatile("s_waitcnt lgkmcnt(0)" ::: "memory"); SBAR();
  PV_MM(pa3, lc, hc, ld, hd);
}
#undef PV_MM
#undef PV_RD
#undef PK
__device__ __forceinline__ float bf2f_(short b) { return __builtin_bit_cast(float, (unsigned)(unsigned short)b << 16); }

template <int ABL> __device__ __forceinline__ void mla_unit(const unsigned short* __restrict__ Qg, const unsigned short* __restrict__ Kn, const unsigned short* __restrict__ Kpe, const unsigned short* __restrict__ Vg,
                                         const float* __restrict__ cs, unsigned short* __restrict__ Og, int q0, int krow0, int h, int seq, char* lds) {
  const int tid = threadIdx.x, wid = __builtin_amdgcn_readfirstlane(tid >> 6), lane = tid & 63, r32 = lane & 31, hi = lane >> 5;
  char* V_lds = lds; char* K_lds = lds + 4 * SHM_V;
  float* ws = (float*)(lds + 4 * SHM_V + 4 * SHM_K) + wid * 64; float* li_l = ws; float* al_l = ws + 32;
  float m_reg = 0.f, l_reg = 0; f32x16 o[2] = {}; bf16x8 qr[6];
  {
    const int qrow = q0 + wid * QBLK + r32;
    const unsigned short* Qw = Qg + (size_t)qrow * 768 + h * 96 + hi * 8;
#pragma unroll
    for (int d0 = 0; d0 < 6; ++d0) qr[d0] = *reinterpret_cast<const bf16x8*>(Qw + d0 * 16);
    const float* cr = cs + (size_t)qrow * 32 + hi * 8;
    bf16x8 a = qr[4], b = qr[5]; u32x4 wa, wb; float n1[8], n2[8];
#pragma unroll
    for (int e = 0; e < 8; ++e) { const float c_ = cr[e], s_ = cr[16 + e]; const float x1 = bf2f_(a[e]), x2 = bf2f_(b[e]); n1[e] = x1 * c_ - x2 * s_; n2[e] = x1 * s_ + x2 * c_; }
    wa = (u32x4){cvtpk(n1[0], n1[1]), cvtpk(n1[2], n1[3]), cvtpk(n1[4], n1[5]), cvtpk(n1[6], n1[7])};
    wb = (u32x4){cvtpk(n2[0], n2[1]), cvtpk(n2[2], n2[3]), cvtpk(n2[4], n2[5]), cvtpk(n2[6], n2[7])};
    qr[4] = *reinterpret_cast<bf16x8*>(&wa); qr[5] = *reinterpret_cast<bf16x8*>(&wb);
  }
  const int sk = tid >> 3, sc = (tid & 7) * 8, rk = (tid & 255) >> 2, rc = (tid & 3) * 8;
  const int vst = v_st(sk, sc), kst = KSWZ(sk, sc * 2), rst = KSWZ(rk, (64 + rc) * 2);
  const int vb0 = (int)(uintptr_t)V_lds + v_rd_base(lane);
  const unsigned short* Vh = Vg + (size_t)krow0 * 512 + h * 64; const unsigned short* Kh = Kn + (size_t)krow0 * 512 + h * 64; const unsigned short* Rh = Kpe + (size_t)krow0 * 32;
  struct { bf16x8 vs, ks, rs; } sr_[2];
#define SLOAD(i, k0) do { sr_[i].vs = *reinterpret_cast<const bf16x8*>(&Vh[(size_t)((k0) + sk) * 512 + sc]); sr_[i].ks = *reinterpret_cast<const bf16x8*>(&Kh[(size_t)((k0) + sk) * 512 + sc]); \
    sr_[i].rs = *reinterpret_cast<const bf16x8*>(&Rh[(size_t)((k0) + rk) * 32 + rc]); } while (0)
#define SWRITE(b, i) do { *(bf16x8*)(V_lds + (b) * SHM_V + vst) = sr_[i].vs; *(bf16x8*)(K_lds + (b) * SHM_K + kst) = sr_[i].ks; *(bf16x8*)(K_lds + (b) * SHM_K + rst) = sr_[i].rs; } while (0)
#define RESC(a) do { if (__any((a) < 1.f)) { if (hi == 0) al_l[r32] = (a); asm volatile("s_waitcnt lgkmcnt(0)" ::: "memory"); \
    _Pragma("unroll") for (int d = 0; d < 2; ++d) _Pragma("unroll") for (int r = 0; r < 16; ++r) o[d][r] *= al_l[crow(r, hi)]; } } while (0)
#define EBAR() do { asm volatile("s_waitcnt lgkmcnt(0)" ::: "memory"); __builtin_amdgcn_s_barrier(); asm volatile("" ::: "memory"); } while (0)
  f32x16 p0, p1; float al; bf16x8 pa0, pa1, pa2, pa3; const int NT = seq / KVBLK;
  pa0 = pa1 = pa2 = pa3 = bf16x8{};
  SLOAD(0, 0); SLOAD(1, KVBLK); asm volatile("s_waitcnt vmcnt(0)" ::: "memory"); SWRITE(0, 0); SWRITE(1, 1);
  if (2 < NT) SLOAD(0, 2 * KVBLK);
  EBAR();
  if (wid >= 4) EBAR();
  for (int t = 0; t < NT; ++t) {
    SBAR(); __builtin_amdgcn_s_setprio(3); qkt(p0, p1, K_lds + (t & 3) * SHM_K, qr, r32, hi); SBAR();
    if (t > 0) pv_d0(o, vb0 + ((t - 1) & 3) * SHM_V, pa0, pa1, pa2, pa3);
    __builtin_amdgcn_s_setprio(0); EBAR();
    partialSM<ABL>(p0, p1, m_reg, al, t == 0);
    RESC(al);
    finishSM<ABL>(p0, p1, al, l_reg, pa0, pa1, pa2, pa3);
    if (t + 2 < NT) { asm volatile("s_waitcnt vmcnt(0)" ::: "memory"); SWRITE((t + 2) & 3, 0); }
    if (t + 3 < NT) SLOAD(0, (t + 3) * KVBLK);
    EBAR();
  }
  SBAR(); pv_d0(o, vb0 + ((NT - 1) & 3) * SHM_V, pa0, pa1, pa2, pa3);
  if (wid < 4) EBAR();
#undef EBAR
  if (hi == 0) li_l[r32] = l_reg; asm volatile("s_waitcnt lgkmcnt(0)" ::: "memory");
  float rli[16];
#pragma unroll
  for (int r = 0; r < 16; ++r) rli[r] = __builtin_amdgcn_rcpf(li_l[crow(r, hi)]);
  unsigned short* Ow = Og + (size_t)(q0 + wid * QBLK) * 512 + h * 64;
#pragma unroll
  for (int r = 0; r < 16; ++r) { int orow = crow(r, hi);
#pragma unroll
    for (int d0 = 0; d0 < 2; ++d0) Ow[(size_t)orow * 512 + d0 * 32 + r32] = (unsigned short)cvtpk(o[d0][r] * rli[r], 0.f); }
  __syncthreads();
#undef SLOAD
#undef SWRITE
#undef RESC
}
#undef KSWZ
#undef SBAR
}

namespace dil {
using bf16x8 = __attribute__((ext_vector_type(8))) short;
using s16x4  = __attribute__((ext_vector_type(4))) short;
using f32x16 = __attribute__((ext_vector_type(16))) float;
using u32x4  = __attribute__((ext_vector_type(4))) unsigned;
constexpr int TBL_PITCH = 2112;
constexpr int W_TBL = 0, W_K = 8448, W_V = 8448 + 4096, W_POS = 8448 + 8192, W_AL = W_POS + 128, W_BYTES = W_AL + 128;
__device__ __forceinline__ int crow(int r, int hi) { return (r & 3) + 8 * (r >> 2) + 4 * hi; }
__device__ __forceinline__ unsigned cvtpk(float lo, float hi) { unsigned r; asm volatile("v_cvt_pk_bf16_f32 %0, %1, %2" : "=v"(r) : "v"(lo), "v"(hi)); return r; }
#define DKSWZ(row, colB) ((row) * 128 + ((colB) ^ (((row) & 7) << 4)))
__device__ __forceinline__ int v_st(int k, int c) { const int kk = k;
  return ((kk >> 3) * 2 + (c >> 5)) * 512 + ((kk & 7) * 32 + (c & 31)) * 2; }
__device__ __forceinline__ int v_rd_base(int lane) { return ((lane & 3) << 3) | (((lane >> 2) & 3) << 6) | (((lane >> 4) & 1) << 5) | (((lane >> 5) & 1) << 8); }
constexpr int v_rd_off(int d0, int ks, int half) { return d0 * 512 + ks * 2048 + half * 1024; }
template <int OFF> __device__ __forceinline__ s16x4 tr_read(int vb) {
  s16x4 r; asm volatile("ds_read_b64_tr_b16 %0, %1 offset:%2" : "=&v"(r) : "v"(vb), "i"(OFF) : "memory"); return r;
}
template <int D0> __device__ __forceinline__ void pv_one(f32x16& od, int vb, bf16x8 pa0, bf16x8 pa1) {
  const s16x4 l0 = tr_read<v_rd_off(D0, 0, 0)>(vb), h0 = tr_read<v_rd_off(D0, 0, 1)>(vb), l1 = tr_read<v_rd_off(D0, 1, 0)>(vb), h1 = tr_read<v_rd_off(D0, 1, 1)>(vb);
  asm volatile("s_waitcnt lgkmcnt(0)" ::: "memory"); __builtin_amdgcn_sched_barrier(0);
#define PK(L, H) (bf16x8){L[0], L[1], L[2], L[3], H[0], H[1], H[2], H[3]}
  od = __builtin_amdgcn_mfma_f32_32x32x16_bf16(pa0, PK(l0, h0), od, 0, 0, 0);
  od = __builtin_amdgcn_mfma_f32_32x32x16_bf16(pa1, PK(l1, h1), od, 0, 0, 0);
#undef PK
}
struct KVRegs { bf16x8 k[4], v[4]; int pk; };
struct TaskId { int b, h, g, r, ub; };
__device__ __forceinline__ TaskId task_at(int i, int bx, int G, int wave) {
  TaskId t; int bh, k; t.b = 0; t.h = 0; t.g = 0; t.r = 0; t.ub = -1;
  if (G == 256) { if (i >= 6) return t; bh = (bx & 7) + 8 * (bx >> 6); k = ((((bx >> 3) & 7) * 6 + i) << 3) + wave; }
  else { const int id = (i * G + bx) * 8 + wave; if (id >= 12288) return t; bh = id / 384; k = id % 384; }
  const int g = k >> 7, kk = k & 127, nub = g == 0 ? 128 : (g == 1 ? 32 : 8);
  t.b = bh >> 3; t.h = bh & 7; t.g = g; t.r = kk / nub; t.ub = kk % nub; return t;
}
struct Pre { bf16x8 qr[4]; int pos_q; KVRegs R; };
__device__ __forceinline__ void load_blk(const unsigned short* __restrict__ qkv, const int* __restrict__ pos, const TaskId& t, int kb, KVRegs& R) {
  const int lane = threadIdx.x & 63, r32 = lane & 31, srow = lane >> 1, shalf = (lane & 1) * 32;
  const int dl = t.g == 0 ? 1 : (t.g == 1 ? 4 : 16), L = S / dl; const size_t rowb = (size_t)t.b * S;
  int up = 32 * (t.ub - 2 + kb) + srow; up = up < 0 ? 0 : (up >= L ? L - 1 : up);
  const unsigned short* base = qkv + (rowb + t.r + dl * up) * 1536 + t.h * 64 + shalf;
#pragma unroll
  for (int c = 0; c < 4; ++c) { R.k[c] = *reinterpret_cast<const bf16x8*>(base + 512 + c * 8); R.v[c] = *reinterpret_cast<const bf16x8*>(base + 1024 + c * 8); }
  int upl = 32 * (t.ub - 2 + kb) + r32; upl = upl < 0 ? 0 : (upl >= L ? L - 1 : upl);
  R.pk = pos[rowb + t.r + dl * upl];
}
__device__ __forceinline__ int kb_first(const TaskId& t) { return (t.ub >= 2) ? 0 : (2 - t.ub); }
__device__ __forceinline__ void dil_prefetch(const unsigned short* __restrict__ qkv, const int* __restrict__ pos, const TaskId& t, Pre& P) {
  const int lane = threadIdx.x & 63, r32 = lane & 31, hi = lane >> 5;
  const int dl = t.g == 0 ? 1 : (t.g == 1 ? 4 : 16); const size_t rowb = (size_t)t.b * S; const int tok_q = t.r + dl * (32 * t.ub + r32);
  const unsigned short* Qw = qkv + (rowb + tok_q) * 1536 + t.h * 64 + hi * 8;
#pragma unroll
  for (int d0 = 0; d0 < 4; ++d0) P.qr[d0] = *reinterpret_cast<const bf16x8*>(Qw + d0 * 16);
  P.pos_q = pos[rowb + tok_q];
  load_blk(qkv, pos, t, kb_first(t), P.R);
}
__device__ __forceinline__ void dil_task(const unsigned short* __restrict__ qkv, const int* __restrict__ pos, unsigned short* __restrict__ oap, float* __restrict__ lse,
                                         const TaskId t, Pre& P, bool has_next, const TaskId tn, char* wl  ) {
  const int lane = threadIdx.x & 63, r32 = lane & 31, hi = lane >> 5;
  const int b = t.b, h = t.h, g = t.g, r = t.r, ub = t.ub;
  const int dl = g == 0 ? 1 : (g == 1 ? 4 : 16), L = S / dl;
  const int u_q = 32 * ub + r32;
  const size_t rowb = (size_t)b * S;
  const int tok_q = r + dl * u_q;
  const float* tblw = (const float*)(wl + W_TBL); int* posw = (int*)(wl + W_POS); float* alw = (float*)(wl + W_AL);
  bf16x8 qr[4];
#pragma unroll
  for (int d0 = 0; d0 < 4; ++d0) qr[d0] = P.qr[d0];
  const int pos_q = P.pos_q;
  const int srow = lane >> 1, shalf = (lane & 1) * 32;
  const int vb0 = (int)(uintptr_t)(wl + W_V) + v_rd_base(lane);
  float m_reg = -1e30f, l_reg = 0.f; f32x16 o[2] = {};
  const int kb_lo = kb_first(t), kb_hi = (32 * (ub + 3) <= L) ? 4 : (4 - ((32 * (ub + 3) - L) >> 5));
  KVRegs R = P.R;
  for (int kb = kb_lo; kb <= kb_hi; ++kb) {
#pragma unroll
    for (int c = 0; c < 4; ++c) {
      *(bf16x8*)(wl + W_K + DKSWZ(srow, (shalf + c * 8) * 2)) = R.k[c];
      *(bf16x8*)(wl + W_V + v_st(srow, shalf + c * 8)) = R.v[c];
    }
    if (hi == 0) posw[r32] = R.pk;
    if (kb < kb_hi) load_blk(qkv, pos, t, kb + 1, R);
    asm volatile("s_waitcnt lgkmcnt(0)" ::: "memory"); __builtin_amdgcn_sched_barrier(0);
    f32x16 p = {};
#pragma unroll
    for (int d0 = 0; d0 < 4; ++d0) {
      const bf16x8 kf = *reinterpret_cast<const bf16x8*>(wl + W_K + DKSWZ(r32, (d0 * 16 + hi * 8) * 2));
      p = __builtin_amdgcn_mfma_f32_32x32x16_bf16(kf, qr[d0], p, 0, 0, 0);
    }
    float bmax;
    {
      int idx[16];
#pragma unroll
      for (int rr = 0; rr < 16; ++rr) { int rel = posw[crow(rr, hi)] - pos_q; rel = rel < -1024 ? -1024 : (rel > 1024 ? 1024 : rel); const int i_ = rel + 1024; idx[rr] = i_ ^ ((i_ >> 5) & 31); }
#pragma unroll
      for (int rr = 0; rr < 16; ++rr) p[rr] += tblw[idx[rr]];
    }
    if (kb == 0) {
#pragma unroll
      for (int rr = 0; rr < 16; ++rr) p[rr] = crow(rr, hi) >= r32 ? p[rr] : -INFINITY;
    } else if (kb == 4) {
#pragma unroll
      for (int rr = 0; rr < 16; ++rr) p[rr] = crow(rr, hi) <= r32 ? p[rr] : -INFINITY;
    }
    bmax = fmaxf(fmaxf(p[0], p[1]), fmaxf(p[2], p[3]));
#pragma unroll
    for (int rr = 4; rr < 16; rr += 4) bmax = fmaxf(bmax, fmaxf(fmaxf(p[rr], p[rr + 1]), fmaxf(p[rr + 2], p[rr + 3])));
    { auto x = __builtin_amdgcn_permlane32_swap(__float_as_uint(bmax), __float_as_uint(bmax), false, false); bmax = fmaxf(__uint_as_float(x[0]), __uint_as_float(x[1])); }
    float alpha = 1.f; bool resc = false;
    if (!__all(bmax - m_reg <= 11.5f)) { const float mn = fmaxf(m_reg, bmax); alpha = __builtin_amdgcn_exp2f(m_reg - mn); m_reg = mn; resc = true; }
    float ps = 0.f;
#pragma unroll
    for (int rr = 0; rr < 16; ++rr) p[rr] = __builtin_amdgcn_exp2f(p[rr] - m_reg);
    ps = ((p[0] + p[1]) + (p[2] + p[3])) + ((p[4] + p[5]) + (p[6] + p[7])) + (((p[8] + p[9]) + (p[10] + p[11])) + ((p[12] + p[13]) + (p[14] + p[15])));
    { auto x = __builtin_amdgcn_permlane32_swap(__float_as_uint(ps), __float_as_uint(ps), false, false); ps = __uint_as_float(x[0]) + __uint_as_float(x[1]); }
    l_reg = l_reg * alpha + ps;
    if (resc && kb != kb_lo) {
      if (hi == 0) alw[r32] = alpha;
      asm volatile("s_waitcnt lgkmcnt(0)" ::: "memory");
#pragma unroll
      for (int d = 0; d < 2; ++d)
#pragma unroll
        for (int rr = 0; rr < 16; ++rr) o[d][rr] *= alw[crow(rr, hi)];
    }
    bf16x8 pa0, pa1;
#define PK4(P, BASE, OUT) do { u32x4 w = {cvtpk(P[BASE + 0], P[BASE + 1]), cvtpk(P[BASE + 2], P[BASE + 3]), cvtpk(P[BASE + 4], P[BASE + 5]), cvtpk(P[BASE + 6], P[BASE + 7])}; \
    OUT = *reinterpret_cast<bf16x8*>(&w); } while (0)
    PK4(p, 0, pa0); PK4(p, 8, pa1);
#undef PK4
    pv_one<0>(o[0], vb0, pa0, pa1); pv_one<1>(o[1], vb0, pa0, pa1);
  }
  if (has_next) dil_prefetch(qkv, pos, tn, P);
  float* liw = alw;
  if (hi == 0) liw[r32] = l_reg;
  asm volatile("s_waitcnt lgkmcnt(0)" ::: "memory");
  if (hi == 0) lse[((size_t)g * T + rowb + tok_q) * 8 + h] = (m_reg + __log2f(l_reg)) * 0.6931471805599453f;
  unsigned short* Ow = oap + ((size_t)g * T + rowb + r + (size_t)dl * 32 * ub) * 512 + h * 64;
  char* ot = wl + W_K;
#pragma unroll
  for (int rr = 0; rr < 16; ++rr) { const int orow = crow(rr, hi); const float rl = __builtin_amdgcn_rcpf(liw[orow]);
#pragma unroll
    for (int d0 = 0; d0 < 2; ++d0) *(unsigned short*)(ot + orow * 144 + (d0 * 32 + r32) * 2) = (unsigned short)cvtpk(o[d0][rr] * rl, 0.f); }
  asm volatile("s_waitcnt lgkmcnt(0)" ::: "memory");
#pragma unroll
  for (int ps = 0; ps < 4; ++ps) { const int orow = ps * 8 + (lane >> 3), c = lane & 7;
    const u32x4 w = *(const u32x4*)(ot + orow * 144 + c * 16);
    *(u32x4*)(Ow + (size_t)orow * dl * 512 + c * 8) = w; }
  asm volatile("s_waitcnt lgkmcnt(0)" ::: "memory");
}
#undef DKSWZ
}

namespace mk {
#define GAS __attribute__((address_space(1)))
#define LAS __attribute__((address_space(3)))
typedef unsigned short bf16_t;
typedef unsigned v4u __attribute__((ext_vector_type(4)));
typedef unsigned v2u __attribute__((ext_vector_type(2)));
typedef float f32x4 __attribute__((ext_vector_type(4)));
#define LDS_WAIT() asm volatile("s_waitcnt lgkmcnt(0)" ::: "memory")
#define VM_WAIT() asm volatile("s_waitcnt vmcnt(0)" ::: "memory")
__device__ __forceinline__ unsigned f2bf(float f) { unsigned u = __builtin_bit_cast(unsigned, f); return (u + 0x7fffu + ((u >> 16) & 1u)) >> 16; }
typedef float f32x2_t __attribute__((ext_vector_type(2))); typedef __bf16 bf16x2_t __attribute__((ext_vector_type(2)));
__device__ __forceinline__ unsigned pk2(float lo, float hi) { const f32x2_t v = {lo, hi}; const bf16x2_t b = __builtin_convertvector(v, bf16x2_t); return __builtin_bit_cast(unsigned, b); }
__device__ __forceinline__ float bf2f(unsigned short b) { return __builtin_bit_cast(float, (unsigned)b << 16); }
__device__ __forceinline__ float wave_sum(float v) {
#pragma unroll
    for (int o = 1; o < 64; o <<= 1) v += __shfl_xor(v, o);
    return v;
}

#define XB_TMO      128
#define XB_XCNT(j)  (256  + 64 * (j))
#define XB_XSUB(j)  (1280 + 64 * (j))
#define XB_XGEN(j)  (2304 + 64 * (j))
#define XB_TOP      3328
#define XB_TOPGEN   3392
#define XCD_BAR_WORDS 3456
#define XB_SPIN_CAP (1u << 18)

__device__ __forceinline__ unsigned xb_ld(unsigned* p)              { return __hip_atomic_load(p, __ATOMIC_RELAXED, __HIP_MEMORY_SCOPE_AGENT); }
__device__ __forceinline__ unsigned xb_add(unsigned* p, unsigned v) { return __hip_atomic_fetch_add(p, v, __ATOMIC_RELAXED, __HIP_MEMORY_SCOPE_AGENT); }
__device__ __forceinline__ unsigned xb_xcc_id() { return (unsigned)__builtin_amdgcn_s_getreg((3 << 11) | 20) & 0xFu; }
#define XB_SPIN(cond, bar) do { unsigned _sp = 0; while (cond) { __builtin_amdgcn_s_sleep(1); \
    if ((++_sp & 255u) == 0u) { if (xb_ld(&(bar)[XB_TMO])) break; if (_sp > XB_SPIN_CAP) { atomicAdd(&(bar)[XB_TMO], 1u); break; } } } } while (0)

struct XcdBarrier {
    unsigned* bar; unsigned x;
    volatile LAS unsigned* st;
};

__device__ __forceinline__ XcdBarrier xcd_barrier_post(unsigned* bar, volatile LAS unsigned* st) {
    XcdBarrier b; b.bar = bar; b.x = xb_xcc_id(); b.st = st;
    if (threadIdx.x == 0) (void)xb_add(&bar[XB_XCNT(b.x)], 1u);
    return b;
}
__device__ __forceinline__ void xcd_barrier_complete(unsigned* bar, unsigned x, unsigned& nloc, unsigned& nx) {
    const unsigned G = gridDim.x * gridDim.y * gridDim.z;
    unsigned sum, cnt, mine, sp = 0u;
    for (;;) {
        sum = 0u; cnt = 0u; mine = 0u;
#pragma unroll
        for (unsigned j = 0; j < 16; ++j) { const unsigned c = xb_ld(&bar[XB_XCNT(j)]); sum += c; cnt += (c > 0u) ? 1u : 0u; mine = (j == x) ? c : mine; }
        if (sum == G) break;
        __builtin_amdgcn_s_sleep(1);
        if ((++sp & 255u) == 0u) { if (xb_ld(&bar[XB_TMO])) break; if (sp > XB_SPIN_CAP) { atomicAdd(&bar[XB_TMO], 1u); break; } }
    }
    nloc = mine > 0u ? mine : 1u; nx = cnt > 0u ? cnt : 1u;
}

__device__ __forceinline__ void xcd_barrier(const XcdBarrier& b) {
    asm volatile("s_waitcnt vmcnt(0)" ::: "memory");
    __syncthreads();
    if (threadIdx.x == 0) {
        unsigned* bar = b.bar;
        __builtin_amdgcn_s_waitcnt(0);
        unsigned nloc = b.st[0], nx = b.st[1];
        if (nloc == 0u) { xcd_barrier_complete(bar, b.x, nloc, nx); b.st[0] = nloc; b.st[1] = nx; }
        const unsigned old = xb_add(&bar[XB_XSUB(b.x)], 1u);
        const unsigned gen = old / nloc;
        if (old + 1u == (gen + 1u) * nloc) {
            __builtin_amdgcn_fence(__ATOMIC_RELEASE, "agent");
            asm volatile("s_waitcnt vmcnt(0)" ::: "memory");
            const unsigned og = xb_add(&bar[XB_TOP], 1u);
            const unsigned tg = og / nx;
            if (og + 1u == (tg + 1u) * nx) xb_add(&bar[XB_TOPGEN], 1u);
            else XB_SPIN(xb_ld(&bar[XB_TOPGEN]) == tg, bar);
            __builtin_amdgcn_fence(__ATOMIC_ACQUIRE, "agent");
            xb_add(&bar[XB_XGEN(b.x)], 1u);
            asm volatile("s_waitcnt vmcnt(0)" ::: "memory");
        } else {
            XB_SPIN(xb_ld(&bar[XB_XGEN(b.x)]) == gen, bar);
            __builtin_amdgcn_fence(__ATOMIC_ACQUIRE, "agent");
            asm volatile("s_waitcnt vmcnt(0)" ::: "memory");
        }
    }
    __syncthreads();
}

constexpr int NWAVES = 8;
constexpr int LDS_BYTES = 147456;
constexpr int RING_BYTES = 131072;
constexpr int CTRL_OFF = 135168;
constexpr int MISC_OFF = CTRL_OFF + 320;
constexpr size_t MiB = 1u << 20;
constexpr size_t WS_CTL = 0, CTL_ZERO_BYTES = 1 * MiB;
constexpr int CW_BAR = 16384;
constexpr size_t WS_WIN = 1 * MiB, WS_WQB = 5 * MiB, WS_WKVB = 5 * MiB + 512 * 1024, WS_WO = 6 * MiB, WS_WMQG = 8 * MiB, WS_WMKV = 10 * MiB, WS_WMO = 14 * MiB;
constexpr size_t WS_RSTDX = 16 * MiB, WS_RSTDM = 16 * MiB + 64 * 1024, WS_SSQQ = 16 * MiB + 256 * 1024, WS_SSQKV = 16 * MiB + 512 * 1024, WS_TBL = 16 * MiB + 768 * 1024;
constexpr size_t WS_WRG = 16 * MiB + 896 * 1024;
constexpr size_t WS_SSQH1 = 17 * MiB, WS_SSQH2 = 18 * MiB, WS_ZKPE = 20 * MiB, WS_CS = 22 * MiB;
constexpr size_t WS_XB = 24 * MiB, WS_MEMB = 56 * MiB, WS_KVMEM = 58 * MiB, WS_KPE = 62 * MiB;
constexpr size_t WS_QKVA = 64 * MiB, WS_ZQ = 112 * MiB, WS_ZKV = 120 * MiB, WS_QB = 124 * MiB, WS_KN = 148 * MiB, WS_VB = 164 * MiB;
constexpr size_t WS_WPT = 180 * MiB, WS_VWT = 188 * MiB, WS_H2 = 196 * MiB, WS_H2B = 260 * MiB, WS_ROUTE = 292 * MiB, WS_XS = 296 * MiB;
constexpr size_t WS_HMID = 296 * MiB, WS_OAP = 440 * MiB, WS_LSE = 488 * MiB, WS_OB = 490 * MiB, WS_OMIX = 506 * MiB;
constexpr size_t WS_H1 = 538 * MiB, WS_H1B = 602 * MiB, WS_P = 634 * MiB, WS_YBUF = 666 * MiB;
constexpr size_t WS_WGU = 794 * MiB, WS_WD = 922 * MiB, WS_END = 986 * MiB;

constexpr size_t WS_H2Q = 954 * MiB;
constexpr size_t WS_H1Q = 970 * MiB;
constexpr float XA8_MUL = 8.0f, XA8_INV = 0.125f, P8_MUL = 256.0f, P8_INV = 1.0f / 256.0f;
constexpr float W8_MUL = 64.0f, W8_INV = 1.0f / 64.0f, HM8_MUL = 4.0f, HM8_INV = 0.25f;
struct Args { const float* in[26]; float* out; unsigned char* ws; double rope_rev[16]; int ph_lo, ph_hi, flags, pad; };

struct CvtDesc { const float* W; const float* gain; bf16_t* WT; int K, N, mode, item, f8; float mul; };
__device__ __forceinline__ unsigned pk4f8(float a, float b, float c, float d) { int w = __builtin_amdgcn_cvt_pk_fp8_f32(a, b, 0, false); w = __builtin_amdgcn_cvt_pk_fp8_f32(c, d, w, true); return (unsigned)w; }
__device__ __forceinline__ void cvt_load(const CvtDesc& d, f32x4 (&v)[16], int lane) {
    const int nblk = (d.N + 63) >> 6, kb = d.item / nblk, nb = d.item % nblk, k0 = 64 * kb, n0 = 64 * nb;
    const int lk = lane >> 4, ln = (lane & 15) * 4;
    const bool ok = n0 + ln < d.N;
    const float* wp = d.W + (size_t)(k0 + lk) * d.N + n0 + ln;
#pragma unroll
    for (int i = 0; i < 16; ++i) v[i] = ok ? __builtin_nontemporal_load((const f32x4*)(wp + (size_t)(4 * i) * d.N)) : (f32x4){0.f, 0.f, 0.f, 0.f};
}
__device__ __forceinline__ void cvt_store(const CvtDesc& d, f32x4 (&v)[16], LAS float* scr, int lane) {
    const int nblk = (d.N + 63) >> 6, kb = d.item / nblk, nb = d.item % nblk, k0 = 64 * kb, n0 = 64 * nb;
    const int lk = lane >> 4, ln = (lane & 15) * 4;
    if (d.gain) {
#pragma unroll
        for (int i = 0; i < 16; ++i) v[i] = v[i] * (d.gain[k0 + 4 * i + lk] * d.mul);
    } else if (d.f8) {
#pragma unroll
        for (int i = 0; i < 16; ++i) v[i] = v[i] * d.mul;
    }
#pragma unroll
    for (int i = 0; i < 16; ++i) { LAS float* p = scr + (4 * i + lk) * 65 + ln; p[0] = v[i][0]; p[1] = v[i][1]; p[2] = v[i][2]; p[3] = v[i][3]; }
    LDS_WAIT(); asm volatile("" ::: "memory");
    int drow0 = n0; if (d.mode == 1) { const int half = n0 >> 10, c = n0 & 1023; drow0 = (c >> 7) * 256 + half * 128 + (c & 127); }
    if (d.f8) {
        const int c = lane & 3;
#pragma unroll
        for (int j = 0; j < 4; ++j) { const int n = (lane >> 2) + 16 * j; const LAS float* sp = scr + (16 * c) * 65 + n;
            v4u o; o.x = pk4f8(sp[0 * 65], sp[1 * 65], sp[2 * 65], sp[3 * 65]); o.y = pk4f8(sp[4 * 65], sp[5 * 65], sp[6 * 65], sp[7 * 65]);
            o.z = pk4f8(sp[8 * 65], sp[9 * 65], sp[10 * 65], sp[11 * 65]); o.w = pk4f8(sp[12 * 65], sp[13 * 65], sp[14 * 65], sp[15 * 65]);
            __builtin_nontemporal_store(o, (v4u*)((unsigned char*)d.WT + (size_t)(drow0 + n) * d.K + k0 + 16 * c)); }
    } else {
    const int c = lane & 7;
#pragma unroll
    for (int j = 0; j < 8; ++j) { const int n = (lane >> 3) + 8 * j; const LAS float* sp = scr + (8 * c) * 65 + n;
        v4u o; o.x = pk2(sp[0 * 65], sp[1 * 65]); o.y = pk2(sp[2 * 65], sp[3 * 65]); o.z = pk2(sp[4 * 65], sp[5 * 65]); o.w = pk2(sp[6 * 65], sp[7 * 65]);
        __builtin_nontemporal_store(o, (v4u*)(d.WT + (size_t)(drow0 + n) * d.K + k0 + 8 * c)); }
    }
    LDS_WAIT(); asm volatile("" ::: "memory");
}
__device__ __forceinline__ void prep_rows4(const float* x0, bf16_t* o0, float* rstd_out, int lane) {
    f32x4 v[4][4]; float s[4];
#pragma unroll
    for (int r = 0; r < 4; ++r)
#pragma unroll
        for (int j = 0; j < 4; ++j) v[r][j] = ((const f32x4*)(x0 + (size_t)r * 1024))[lane + 64 * j];
#pragma unroll
    for (int r = 0; r < 4; ++r) { float a = 0.f;
#pragma unroll
        for (int j = 0; j < 4; ++j) a += (v[r][j].x * v[r][j].x + v[r][j].y * v[r][j].y) + (v[r][j].z * v[r][j].z + v[r][j].w * v[r][j].w);
        s[r] = wave_sum(a); }
    if (lane < 4) rstd_out[lane] = 1.0f / sqrtf((lane == 0 ? s[0] : lane == 1 ? s[1] : lane == 2 ? s[2] : s[3]) * (1.0f / 1024.0f) + 1e-6f);
#pragma unroll
    for (int r = 0; r < 4; ++r) { unsigned long long* o8 = (unsigned long long*)(o0 + (size_t)r * 1024) + lane;
#pragma unroll
        for (int j = 0; j < 4; ++j) o8[64 * j] = (unsigned long long)pk2(v[r][j].x, v[r][j].y) | ((unsigned long long)pk2(v[r][j].z, v[r][j].w) << 32); }
}

__device__ __forceinline__ v4u pack8(const f32x4 a, const f32x4 b) { v4u w; w.x = pk2(a[0], a[1]); w.y = pk2(a[2], a[3]); w.z = pk2(b[0], b[1]); w.w = pk2(b[2], b[3]); return w; }
__device__ __forceinline__ float sq8(const f32x4 a, const f32x4 b) { return (a[0] * a[0] + a[1] * a[1]) + (a[2] * a[2] + a[3] * a[3]) + (b[0] * b[0] + b[1] * b[1]) + (b[2] * b[2] + b[3] * b[3]); }

struct EpiInProj {
    static constexpr bool PERM = true, AFTER_DRAIN = false;
    const float* rstd; bf16_t* qkv; bf16_t* zq; bf16_t* zkv; float* zkpe; float* ssq_q; float* ssq_kv;
    __device__ __forceinline__ void operator()(const pg8::f32x4 (&acc)[2][2][4][2], const pg8::Unit& u, int wr, int wc, int fr, int fq) const {
        const int row0 = u.pm * 256 + wr * 64 + fr;
        const float qs = u.pn < 2 ? 0.125f * 1.4426950408889634f : 1.0f;
        float rsv[8];
#pragma unroll
        for (int q = 0; q < 8; ++q) rsv[q] = rstd[row0 + (q >> 2) * 128 + (q & 3) * 16];
#pragma unroll
        for (int ai = 0; ai < 2; ++ai)
#pragma unroll
            for (int m = 0; m < 4; ++m) {
                const int row = row0 + ai * 128 + m * 16;
                const float rs = rsv[ai * 4 + m];
                float ss = 0.f;
#pragma unroll
                for (int bj = 0; bj < 2; ++bj) {
                    const f32x4 v0 = acc[ai][bj][m][0] * rs, v1 = acc[ai][bj][m][1] * rs;
                    const int ct = bj * 128 + wc * 32 + 8 * fq;
                    if (u.pn < 6) { *(v4u*)(qkv + (size_t)row * 1536 + u.pn * 256 + ct) = pack8(v0 * qs, v1 * qs); }
                    else if (u.pn == 6) { *(v4u*)(zq + (size_t)row * 256 + ct) = pack8(v0, v1); ss += sq8(v0, v1); }
                    else if (bj == 0) { *(v4u*)(zkv + (size_t)row * 128 + ct) = pack8(v0, v1); ss += sq8(v0, v1); }
                    else if (wc == 0) { *(f32x4*)(zkpe + (size_t)row * 32 + 8 * fq) = v0; *(f32x4*)(zkpe + (size_t)row * 32 + 8 * fq + 4) = v1; }
                }
                if (u.pn >= 6) { ss += __shfl_xor(ss, 16); ss += __shfl_xor(ss, 32); if (fq == 0) (u.pn == 6 ? ssq_q : ssq_kv)[(size_t)row * 4 + wc] = ss; }
            }
    }
};


struct EpiQ {
    static constexpr bool PERM = true, AFTER_DRAIN = false;
    const float* ssq; bf16_t* Q;
    __device__ __forceinline__ void operator()(const pg8::f32x4 (&acc)[2][2][4][2], const pg8::Unit& u, int wr, int wc, int fr, int fq) const {
        const int row0 = u.pm * 256 + wr * 64 + fr;
#pragma unroll
        for (int ai = 0; ai < 2; ++ai)
#pragma unroll
            for (int m = 0; m < 4; ++m) {
                const int row = row0 + ai * 128 + m * 16;
                const f32x4 sp = *(const f32x4*)(ssq + (size_t)row * 4);
                const float rs = (0.10206207261596577f * 1.4426950408889634f) / sqrtf(((sp[0] + sp[1]) + (sp[2] + sp[3])) * (1.0f / 256.0f) + 1e-6f);
#pragma unroll
                for (int bj = 0; bj < 2; ++bj)
                    *(v4u*)(Q + (size_t)row * 768 + u.pn * 256 + bj * 128 + wc * 32 + 8 * fq) = pack8(acc[ai][bj][m][0] * rs, acc[ai][bj][m][1] * rs);
            }
    }
};
struct EpiKV {
    static constexpr bool PERM = true, AFTER_DRAIN = false;
    const float* ssq; bf16_t* Kn; bf16_t* Vb;
    __device__ __forceinline__ void operator()(const pg8::f32x4 (&acc)[2][2][4][2], const pg8::Unit& u, int wr, int wc, int fr, int fq) const {
        const int row0 = u.pm * 256 + wr * 64 + fr;
        bf16_t* dst = (wc < 2 ? Kn : Vb) + (wc & 1) * 32 + 8 * fq;
#pragma unroll
        for (int ai = 0; ai < 2; ++ai)
#pragma unroll
            for (int m = 0; m < 4; ++m) {
                const int row = row0 + ai * 128 + m * 16;
                const f32x4 sp = *(const f32x4*)(ssq + (size_t)row * 4);
                const float rs = 1.0f / sqrtf(((sp[0] + sp[1]) + (sp[2] + sp[3])) * (1.0f / 128.0f) + 1e-6f);
#pragma unroll
                for (int bj = 0; bj < 2; ++bj)
                    *(v4u*)(dst + (size_t)row * 512 + (u.pn * 2 + bj) * 64) = pack8(acc[ai][bj][m][0] * rs, acc[ai][bj][m][1] * rs);
            }
    }
};
struct EpiRowScale {
    static constexpr bool PERM = true, AFTER_DRAIN = false;
    const float* rs; bf16_t* O; int ldc;
    __device__ __forceinline__ void operator()(const pg8::f32x4 (&acc)[2][2][4][2], const pg8::Unit& u, int wr, int wc, int fr, int fq) const {
        const int row0 = u.pm * 256 + wr * 64 + fr;
#pragma unroll
        for (int ai = 0; ai < 2; ++ai)
#pragma unroll
            for (int m = 0; m < 4; ++m) {
                const int row = row0 + ai * 128 + m * 16;
                const float r = rs[row];
#pragma unroll
                for (int bj = 0; bj < 2; ++bj)
                    *(v4u*)(O + (size_t)row * ldc + u.pn * 256 + bj * 128 + wc * 32 + 8 * fq) = pack8(acc[ai][bj][m][0] * r, acc[ai][bj][m][1] * r);
            }
    }
};

template <bool BASE_BF16, bool F8OUT = false> struct EpiResid {
    static constexpr bool PERM = true, AFTER_DRAIN = false;
    const void* base; bf16_t* outb; float* ssq; unsigned char* outq; float ascale;
    __device__ __forceinline__ void operator()(const pg8::f32x4 (&acc)[2][2][4][2], const pg8::Unit& u, int wr, int wc, int fr, int fq) const {
        const int row0 = u.pm * 256 + wr * 64 + fr;
#pragma unroll
        for (int ai = 0; ai < 2; ++ai)
#pragma unroll
            for (int m = 0; m < 4; ++m) {
                const int row = row0 + ai * 128 + m * 16;
                float ss = 0.f;
#pragma unroll
                for (int bj = 0; bj < 2; ++bj) {
                    const size_t o = (size_t)row * 1024 + u.pn * 256 + bj * 128 + wc * 32 + 8 * fq;
                    f32x4 b0, b1;
                    if constexpr (BASE_BF16) { const v4u w = *(const v4u*)((const bf16_t*)base + o);
                        b0 = (f32x4){__builtin_bit_cast(float, w[0] << 16), __builtin_bit_cast(float, w[0] & 0xffff0000u), __builtin_bit_cast(float, w[1] << 16), __builtin_bit_cast(float, w[1] & 0xffff0000u)};
                        b1 = (f32x4){__builtin_bit_cast(float, w[2] << 16), __builtin_bit_cast(float, w[2] & 0xffff0000u), __builtin_bit_cast(float, w[3] << 16), __builtin_bit_cast(float, w[3] & 0xffff0000u)}; }
                    else { b0 = *(const f32x4*)((const float*)base + o); b1 = *(const f32x4*)((const float*)base + o + 4); }
                    const f32x4 v0 = acc[ai][bj][m][0] * ascale + b0, v1 = acc[ai][bj][m][1] * ascale + b1;
                    *(v4u*)(outb + o) = pack8(v0, v1); ss += sq8(v0, v1);
                    if constexpr (F8OUT) *(v2u*)(outq + o) = (v2u){pk4f8(v0[0], v0[1], v0[2], v0[3]), pk4f8(v1[0], v1[1], v1[2], v1[3])};
                }
                ss += __shfl_xor(ss, 16); ss += __shfl_xor(ss, 32);
                if (fq == 0) ssq[(size_t)row * 16 + u.pn * 4 + wc] = ss;
                asm volatile("" ::: "memory");
            }
    }
};
struct EpiPlain {
    static constexpr bool PERM = true, AFTER_DRAIN = false;
    unsigned char* O; int ldc;
    __device__ __forceinline__ void operator()(const pg8::f32x4 (&acc)[2][2][4][2], const pg8::Unit& u, int wr, int wc, int fr, int fq) const {
        const int row0 = u.pm * 256 + wr * 64 + fr;
#pragma unroll
        for (int ai = 0; ai < 2; ++ai)
#pragma unroll
            for (int m = 0; m < 4; ++m)
#pragma unroll
                for (int bj = 0; bj < 2; ++bj) { const f32x4 a = acc[ai][bj][m][0] * XA8_MUL, b = acc[ai][bj][m][1] * XA8_MUL;
                    *(v2u*)(O + (size_t)(row0 + ai * 128 + m * 16) * ldc + u.pn * 256 + bj * 128 + wc * 32 + 8 * fq) = (v2u){pk4f8(a[0], a[1], a[2], a[3]), pk4f8(b[0], b[1], b[2], b[3])}; }
    }
};
struct EpiSoftmax {
    static constexpr bool PERM = true, AFTER_DRAIN = true;
    unsigned char* P; int rsl_off;
    __device__ __forceinline__ void fused(pg8::f32x4 (&acc)[2][2][4][2], const pg8::Unit& u, int wr, int wc, int fr, int fq, PG8_LAS unsigned char* lds, int wid, int lane) const {
        typedef float f32x2v __attribute__((ext_vector_type(2)));
        const PG8_LAS float* rsl = (const PG8_LAS float*)(lds + rsl_off);
        PG8_LAS f32x2v* X = (PG8_LAS f32x2v*)lds;
        constexpr float L2E = 1.4426950408889634f;
#pragma unroll
        for (int ai = 0; ai < 2; ++ai)
#pragma unroll
            for (int m = 0; m < 4; ++m) {
                const int rt = ai * 128 + wr * 64 + m * 16 + fr;
                const float rs = rsl[rt] * (0.0625f * L2E * XA8_INV);
                float mx = -3.0e38f;
#pragma unroll
                for (int bj = 0; bj < 2; ++bj)
#pragma unroll
                    for (int n = 0; n < 2; ++n) { f32x4 v = acc[ai][bj][m][n] * rs; acc[ai][bj][m][n] = v; mx = fmaxf(mx, fmaxf(fmaxf(v[0], v[1]), fmaxf(v[2], v[3]))); }
                mx = fmaxf(mx, __shfl_xor(mx, 16)); mx = fmaxf(mx, __shfl_xor(mx, 32));
                float sm = 0.f;
#pragma unroll
                for (int bj = 0; bj < 2; ++bj)
#pragma unroll
                    for (int n = 0; n < 2; ++n) { const f32x4 v = acc[ai][bj][m][n]; sm += (__builtin_amdgcn_exp2f(v[0] - mx) + __builtin_amdgcn_exp2f(v[1] - mx)) + (__builtin_amdgcn_exp2f(v[2] - mx) + __builtin_amdgcn_exp2f(v[3] - mx)); }
                sm += __shfl_xor(sm, 16); sm += __shfl_xor(sm, 32);
                if (fq == 0) X[rt * 4 + wc] = (f32x2v){mx, sm};
            }
        asm volatile("s_waitcnt lgkmcnt(0)" ::: "memory"); __builtin_amdgcn_s_barrier(); asm volatile("" ::: "memory");
#pragma unroll
        for (int ai = 0; ai < 2; ++ai)
#pragma unroll
            for (int m = 0; m < 4; ++m) {
                const int rt = ai * 128 + wr * 64 + m * 16 + fr;
                const f32x2v x0 = X[rt * 4 + 0], x1 = X[rt * 4 + 1], x2 = X[rt * 4 + 2], x3 = X[rt * 4 + 3];
                const float M = fmaxf(fmaxf(x0.x, x1.x), fmaxf(x2.x, x3.x));
                const float tot = (x0.y * __builtin_amdgcn_exp2f(x0.x - M) + x1.y * __builtin_amdgcn_exp2f(x1.x - M)) + (x2.y * __builtin_amdgcn_exp2f(x2.x - M) + x3.y * __builtin_amdgcn_exp2f(x3.x - M));
                const float inv = P8_MUL / tot;
#pragma unroll
                for (int bj = 0; bj < 2; ++bj) {
                    f32x4 a = acc[ai][bj][m][0], b = acc[ai][bj][m][1];
#pragma unroll
                    for (int j = 0; j < 4; ++j) { a[j] = __builtin_amdgcn_exp2f(a[j] - M) * inv; b[j] = __builtin_amdgcn_exp2f(b[j] - M) * inv; }
                    *(v2u*)(P + (size_t)(u.pm * 256 + rt) * 1024 + u.pn * 256 + bj * 128 + wc * 32 + 8 * fq) = (v2u){pk4f8(a[0], a[1], a[2], a[3]), pk4f8(b[0], b[1], b[2], b[3])};
                }
            }
    }
};
struct OrderWp {
    int c;
    __device__ __forceinline__ bool next(int i, pg8::Unit& u) const { if (i > 0 || c >= 64) return false; const int bhh = c >> 2, pn = c & 3, b = bhh >> 2, h = bhh & 3;
        u.pm = bhh; u.pn = pn; u.aoff = ((size_t)(b * 256) * 2048 + h * 256) * 2; u.boff = ((size_t)(pn * 256) * 1024 + h * 256) * 2; return true; }
    __device__ __forceinline__ void a_ready(const pg8::Unit&) const {}
    __device__ __forceinline__ void done(const pg8::Unit&) const {}
};
struct OrderVw {
    int c;
    __device__ __forceinline__ bool next(int i, pg8::Unit& u) const { if (i > 0 || c >= 64) return false; const int b = c >> 4, ct = (c >> 2) & 3, h = c & 3;
        u.pm = b * 4 + ct; u.pn = h; u.aoff = ((size_t)(ct * 256) * 1024 + h * 256) * 2; u.boff = ((size_t)(b * 256) * 2048 + 1024 + h * 256) * 2; return true; }
    __device__ __forceinline__ void a_ready(const pg8::Unit&) const {}
    __device__ __forceinline__ void done(const pg8::Unit&) const {}
};
struct OrderBatch {
    pg8::StaticOrder so;
    __device__ __forceinline__ bool next(int i, pg8::Unit& u) const { if (!so.next(i, u)) return false; u.boff = ((size_t)((u.pm >> 4) * 1024 + u.pn * 256) * 1024); return true; }
    __device__ __forceinline__ void a_ready(const pg8::Unit&) const {}
    __device__ __forceinline__ void done(const pg8::Unit&) const {}
};

constexpr int MPADN = NA + NE * 256, NTILEN = MPADN / 256;
constexpr int CW_GCOUNT = 8192;
constexpr size_t RT_TOPI = 0, RT_TOPG = 256 * 1024, RT_SLOT = 512 * 1024, RT_ROWFLAT = 768 * 1024, RT_RSROW = 1088 * 1024, RT_RSTD = 1408 * 1024, RT_CNT = 1536 * 1024, RT_TOT = 1600 * 1024, RT_RGATE = 1664 * 1024;
constexpr int LX_TEXP = CTRL_OFF + 2048;
struct OrderMoe {
    const LAS int* texp; int nper, c, G; size_t ebytes;
    __device__ __forceinline__ bool next(int i, pg8::Unit& u) const {
        const int L = i * G + (c & 7) * (G >> 3) + (c >> 3); const int tile = L / nper, pn = L % nper;
        if (tile >= texp[NTILEN]) return false;
        u.pm = tile; u.pn = pn; u.aoff = (size_t)tile * 256 * 1024; u.boff = (size_t)texp[tile] * ebytes + (size_t)pn * 256 * 1024; return true; }
    __device__ __forceinline__ void a_ready(const pg8::Unit&) const {}
    __device__ __forceinline__ void done(const pg8::Unit&) const {}
};
__device__ __forceinline__ float swiglu1(float g, float u) { g = fminf(g, 7.0f); u = fminf(fmaxf(u, -7.0f), 7.0f); return (u + 1.0f) * g * __builtin_amdgcn_rcpf(1.0f + __builtin_amdgcn_exp2f(-1.702f * 1.4426950408889634f * g)); }
struct EpiSwiGLU {
    static constexpr bool PERM = true, AFTER_DRAIN = false;
    const float* rs_row; const float* bgu; unsigned char* hmid; const LAS int* texp;
    __device__ __forceinline__ void operator()(const pg8::f32x4 (&acc)[2][2][4][2], const pg8::Unit& u, int wr, int wc, int fr, int fq) const {
        const int row0 = u.pm * 256 + wr * 64 + fr, e = texp[u.pm], c0 = u.pn * 128 + wc * 32 + 8 * fq;
        const float* bg = bgu + (size_t)e * 2048 + c0;
        const f32x4 bg0 = *(const f32x4*)bg, bg1 = *(const f32x4*)(bg + 4), bu0 = *(const f32x4*)(bg + 1024), bu1 = *(const f32x4*)(bg + 1028);
        float rsv[8];
#pragma unroll
        for (int q = 0; q < 8; ++q) rsv[q] = rs_row[row0 + (q >> 2) * 128 + (q & 3) * 16] * W8_INV;
#pragma unroll
        for (int ai = 0; ai < 2; ++ai)
#pragma unroll
            for (int m = 0; m < 4; ++m) {
                const int row = row0 + ai * 128 + m * 16; const float rs = rsv[ai * 4 + m];
                const f32x4 g0 = acc[ai][0][m][0] * rs + bg0, g1 = acc[ai][0][m][1] * rs + bg1, u0 = acc[ai][1][m][0] * rs + bu0, u1 = acc[ai][1][m][1] * rs + bu1;
                f32x4 h0, h1;
#pragma unroll
                for (int j = 0; j < 4; ++j) { h0[j] = swiglu1(g0[j], u0[j]) * HM8_MUL; h1[j] = swiglu1(g1[j], u1[j]) * HM8_MUL; }
                *(v2u*)(hmid + (size_t)row * 1024 + c0) = (v2u){pk4f8(h0[0], h0[1], h0[2], h0[3]), pk4f8(h1[0], h1[1], h1[2], h1[3])};
            }
    }
};
struct EpiDown {
    static constexpr bool PERM = true, AFTER_DRAIN = false;
    const int* row_flat; const float* topg; const float* bd; bf16_t* ybuf; const LAS int* texp;
    __device__ __forceinline__ void operator()(const pg8::f32x4 (&acc)[2][2][4][2], const pg8::Unit& u, int wr, int wc, int fr, int fq) const {
        const int row0 = u.pm * 256 + wr * 64 + fr, e = texp[u.pm], c0 = u.pn * 256 + wc * 32 + 8 * fq;
        const float* bp = bd + (size_t)e * 1024 + c0;
        f32x4 bv[2][2];
#pragma unroll
        for (int bj = 0; bj < 2; ++bj) { bv[bj][0] = *(const f32x4*)(bp + bj * 128); bv[bj][1] = *(const f32x4*)(bp + bj * 128 + 4); }
        int av[8]; float gv[8];
#pragma unroll
        for (int q = 0; q < 8; ++q) { const int row = row0 + (q >> 2) * 128 + (q & 3) * 16; av[q] = row_flat[row]; gv[q] = topg[row]; }
#pragma unroll
        for (int ai = 0; ai < 2; ++ai)
#pragma unroll
            for (int m = 0; m < 4; ++m) {
                const int a = av[ai * 4 + m];
                if (a >= 0) { const float gt = gv[ai * 4 + m];
#pragma unroll
                    for (int bj = 0; bj < 2; ++bj)
                        *(v4u*)(ybuf + (size_t)a * 1024 + c0 + bj * 128) = pack8((acc[ai][bj][m][0] * (W8_INV * HM8_INV) + bv[bj][0]) * gt, (acc[ai][bj][m][1] * (W8_INV * HM8_INV) + bv[bj][1]) * gt); }
            }
    }
};

__device__ __forceinline__ int rel_bucket_d(int rel) {
    int n = rel < 0 ? -rel : rel;
    int b;
    if (n < 8) b = n; else if (n < 15) b = 8; else if (n < 27) b = 9; else if (n < 50) b = 10; else if (n < 91) b = 11;
    else if (n < 166) b = 12; else if (n < 305) b = 13; else if (n < 559) b = 14; else b = 15;
    return b + (rel > 0 ? 16 : 0);
}

static_assert(pg8::GTAB == CTRL_OFF + 4096 && pg8::GTAB + pg8::GTAB_UNITS * 512 <= LDS_BYTES && (NTILEN * 8 + 255) / 256 <= pg8::GTAB_UNITS && NWAVES * dil::W_BYTES <= CTRL_OFF && mla::SHM_ATTN <= CTRL_OFF && RING_BYTES <= CTRL_OFF && LX_TEXP + 4 * (NTILEN + 1) <= LDS_BYTES, "LDS map");
__global__ void __launch_bounds__(NWAVES * 64, 2) mk_fwd(Args args) {
    extern __shared__ __attribute__((aligned(16))) unsigned char lds_raw[];
    LAS unsigned char* lds = (LAS unsigned char*)lds_raw;
    const int tid = threadIdx.x, lane = tid & 63, wave = __builtin_amdgcn_readfirstlane(tid >> 6);
    const int G = gridDim.x; const int bx = blockIdx.x; const int vcu = (G % 8 == 0) ? (bx % 8) * (G / 8) + bx / 8 : bx;
    unsigned char* ws = args.ws;
    const int lo = args.ph_lo, hi = args.ph_hi;
#define IN(k) (lo <= (k) && (k) < hi)
#define BOTH(k) (IN(k) && IN((k) + 1))
    for (int u = tid; u < (LDS_BYTES - CTRL_OFF) / 4; u += NWAVES * 64) ((LAS unsigned*)(lds + CTRL_OFF))[u] = 0u;
    __syncthreads();
    XcdBarrier bar; bar.bar = (unsigned*)(ws + WS_CTL) + CW_BAR; bar.x = 0; bar.st = nullptr;
    if (hi - lo > 1) bar = xcd_barrier_post((unsigned*)(ws + WS_CTL) + CW_BAR, (volatile LAS unsigned*)(lds + MISC_OFF) + 8);
#define GRID_BAR(k) do { if (BOTH(k)) xcd_barrier(bar); } while (0)
    const float* x = args.in[0]; const float* mem = args.in[1]; const float* g_mix = args.in[3]; const float* w_in = args.in[4];
    const float* g_q_a = args.in[5]; const float* w_q_b = args.in[6]; const float* g_kv_a = args.in[7]; const float* w_kv_b = args.in[8];
    const float* w_o = args.in[12]; const float* g_xattn = args.in[13]; const float* g_mem = args.in[14]; const float* w_mq = args.in[15];
    const float* w_mkv = args.in[16]; const float* w_mo = args.in[17]; const float* g_moe = args.in[18];
    const float* w_gate_up = args.in[21]; const float* w_down = args.in[23];
    bf16_t* WinT = (bf16_t*)(ws + WS_WIN); bf16_t* WqbT = (bf16_t*)(ws + WS_WQB); bf16_t* WkvbT = (bf16_t*)(ws + WS_WKVB); bf16_t* WoT = (bf16_t*)(ws + WS_WO);
    bf16_t* Wmqg = (bf16_t*)(ws + WS_WMQG); bf16_t* WmkvT = (bf16_t*)(ws + WS_WMKV); bf16_t* WmoT = (bf16_t*)(ws + WS_WMO);
    bf16_t* WguT = (bf16_t*)(ws + WS_WGU); bf16_t* WdT = (bf16_t*)(ws + WS_WD);
    bf16_t* xb = (bf16_t*)(ws + WS_XB); bf16_t* memb = (bf16_t*)(ws + WS_MEMB);
    float* rstd_x = (float*)(ws + WS_RSTDX); float* rstd_mem = (float*)(ws + WS_RSTDM);

    if (IN(0)) {
        LAS float* scr = (LAS float*)(lds + wave * 16640);
        const int gw = vcu * NWAVES + wave, NGW = G * NWAVES;
        constexpr int I_IN = 16 * 31, I_QB = 4 * 12, I_KVB = 2 * 16, I_O = 16 * 16, I_MKV = 16 * 32, I_MO = 16 * 16, I_GU = 16 * 32, I_D = 16 * 16;
        const int n_exp = (args.flags & 1) ? 32 : 0;
        const int NITEMS = I_IN + I_QB + I_KVB + I_O + I_MKV + I_MO + n_exp * (I_GU + I_D);
        auto desc = [&](int it) {
            CvtDesc d; int r = it; d.mode = 0; d.f8 = 0; d.mul = 1.0f;
            if (r < I_IN) { d.W = w_in; d.K = 1024; d.N = 1952; d.gain = g_mix; d.WT = WinT; }
            else if ((r -= I_IN) < I_QB) { d.W = w_q_b; d.K = 256; d.N = 768; d.gain = g_q_a; d.WT = WqbT; }
            else if ((r -= I_QB) < I_KVB) { d.W = w_kv_b; d.K = 128; d.N = 1024; d.gain = g_kv_a; d.WT = WkvbT; }
            else if ((r -= I_KVB) < I_O) { d.W = w_o; d.K = 1024; d.N = 1024; d.gain = nullptr; d.WT = WoT; }
            else if ((r -= I_O) < I_MKV) { d.W = w_mkv; d.K = 1024; d.N = 2048; d.gain = g_mem; d.WT = WmkvT; }
            else if ((r -= I_MKV) < I_MO) { d.W = w_mo; d.K = 1024; d.N = 1024; d.gain = nullptr; d.WT = WmoT; }
            else if ((r -= I_MO) < 32 * I_GU) { const int e = r / I_GU; r -= e * I_GU; d.W = w_gate_up + (size_t)e * 1024 * 2048; d.K = 1024; d.N = 2048; d.gain = g_moe; d.WT = (bf16_t*)((unsigned char*)WguT + (size_t)e * 2048 * 1024); d.mode = 1; d.f8 = 1; d.mul = W8_MUL; }
            else { r -= 32 * I_GU; const int e = r / I_D; r -= e * I_D; d.W = w_down + (size_t)e * 1024 * 1024; d.K = 1024; d.N = 1024; d.gain = nullptr; d.WT = (bf16_t*)((unsigned char*)WdT + (size_t)e * 1024 * 1024); d.f8 = 1; d.mul = W8_MUL; }
            d.item = r; return d; };
        {
            f32x4 va[16], vb[16]; CvtDesc dc = desc(0), dn = dc; bool have = false;
            for (int it = gw; ; it += NGW) {
                const bool more = it < NITEMS;
                if (more) { dn = desc(it); cvt_load(dn, vb, lane); }
                if (have) cvt_store(dc, va, scr, lane);
                if (!more) break;
#pragma unroll
                for (int i = 0; i < 16; ++i) va[i] = vb[i];
                dc = dn; have = true;
            }
        }
        for (int i = gw * 64 + lane; i < 64 * 1024 / 8; i += NGW * 64) ((v4u*)(WinT + (size_t)1984 * 1024))[i] = (v4u){0u, 0u, 0u, 0u};
        for (int m = gw * 4; m < T; m += NGW * 4) prep_rows4(x + (size_t)m * D, xb + (size_t)m * D, rstd_x + m, lane);
        for (int m = gw * 4; m < NB * NMEM; m += NGW * 4) prep_rows4(mem + (size_t)m * D, memb + (size_t)m * D, rstd_mem + m, lane);
        { const float* w_router = args.in[19]; float* wrg = (float*)(ws + WS_WRG); for (int i = bx * 512 + tid; i < 1024 * 32; i += G * 512) wrg[i] = w_router[i] * g_moe[i >> 5]; }
        for (int m = gw; m < D; m += NGW) {
            const f32x4* xr = (const f32x4*)(w_mq + (size_t)m * D) + lane; const float gc = g_xattn[m];
            unsigned long long* o8 = (unsigned long long*)(Wmqg + (size_t)m * D) + lane;
#pragma unroll
            for (int j = 0; j < 4; ++j) { const f32x4 v = xr[64 * j] * gc; o8[64 * j] = (unsigned long long)pk2(v.x, v.y) | ((unsigned long long)pk2(v.z, v.w) << 32); }
        }
    }
    if (IN(0)) {
        const float* rel_bias = args.in[9]; float* tbl = (float*)(ws + WS_TBL);
        for (int i = bx * 512 + tid; i < 8 * 2049; i += G * 512) { const int h = i / 2049, r = i % 2049; tbl[h * 2112 + r] = rel_bias[rel_bucket_d(r - 1024) * 8 + h]; }
    }
    GRID_BAR(0);
    if (IN(1)) {
        int kx = 1024; asm volatile("" : "+s"(kx)); pg8::Gemm g{xb, WinT, kx, kx, kx}; pg8::StaticOrder S; S.init(T, 2048, 1024, 1024, G, bx);
        EpiInProj E{rstd_x, (bf16_t*)(ws + WS_QKVA), (bf16_t*)(ws + WS_ZQ), (bf16_t*)(ws + WS_ZKV), (float*)(ws + WS_ZKPE), (float*)(ws + WS_SSQQ), (float*)(ws + WS_SSQKV)};
        pg8::gemm_phase<EpiInProj, pg8::StaticOrder, true, true>(lds, g, S, E);
    }
    GRID_BAR(1);
    if (IN(2)) {
        const int* pos = (const int*)args.in[2];
        float* cs = (float*)(ws + WS_CS); const float* zkpe = (const float*)(ws + WS_ZKPE); bf16_t* kpe = (bf16_t*)(ws + WS_KPE);
        for (int i = bx * 512 + tid; i < T * 16; i += G * 512) {
            const int t = i >> 4, j = i & 15;
            const double rev = (double)pos[t] * args.rope_rev[j];
            const float fr_ = (float)(rev - floor(rev));
            const float sn = __builtin_amdgcn_sinf(fr_), c_ = __builtin_amdgcn_cosf(fr_);
            cs[(size_t)t * 32 + j] = c_; cs[(size_t)t * 32 + 16 + j] = sn;
            const float x1 = zkpe[(size_t)t * 32 + j], x2 = zkpe[(size_t)t * 32 + 16 + j];
            kpe[(size_t)t * 32 + j] = (bf16_t)f2bf(x1 * c_ - x2 * sn); kpe[(size_t)t * 32 + 16 + j] = (bf16_t)f2bf(x1 * sn + x2 * c_);
        }
        {   int kq = 256; asm volatile("" : "+s"(kq)); pg8::Gemm g{(const bf16_t*)(ws + WS_ZQ), WqbT, kq, kq, kq}; pg8::StaticOrder S; S.init(T, 768, 256, 256, G, bx);
            EpiQ E{(const float*)(ws + WS_SSQQ), (bf16_t*)(ws + WS_QB)};
            pg8::gemm_phase<EpiQ, pg8::StaticOrder, true, true>(lds, g, S, E); }
        {   int kk = 128; asm volatile("" : "+s"(kk)); pg8::Gemm g{(const bf16_t*)(ws + WS_ZKV), WkvbT, kk, kk, kk}; const bool memcu = ((bx + 64) % G) < 32 && G > 64; const int bx2 = bx - (bx >= G - 64 + 32 ? 32 : 0);
            pg8::StaticOrder S; S.init(memcu ? 0 : T, 1024, 128, 128, G > 64 ? G - 32 : G, G > 64 ? bx2 : bx);
            EpiKV E{(const float*)(ws + WS_SSQKV), (bf16_t*)(ws + WS_KN), (bf16_t*)(ws + WS_VB)};
            pg8::gemm_phase<EpiKV, pg8::StaticOrder, true, true>(lds, g, S, E); }
        {   int kx = 1024; asm volatile("" : "+s"(kx)); pg8::Gemm g{memb, WmkvT, kx, kx, kx}; pg8::StaticOrder S; S.init(NB * NMEM, 2048, 1024, 1024, G, (bx + 64) % G);
            EpiRowScale E{rstd_mem, (bf16_t*)(ws + WS_KVMEM), 2048};
            pg8::gemm_phase<EpiRowScale, pg8::StaticOrder, true, true>(lds, g, S, E); }
    }
    GRID_BAR(2);
    if (IN(3)) {
        const unsigned short* Qg = (const unsigned short*)(ws + WS_QB); const unsigned short* Kn = (const unsigned short*)(ws + WS_KN);
        const unsigned short* Kp = (const unsigned short*)(ws + WS_KPE); const unsigned short* Vg = (const unsigned short*)(ws + WS_VB);
        const float* cs = (const float*)(ws + WS_CS); unsigned short* Og = (unsigned short*)(ws + WS_OB);
        for (int i = 0; !(args.flags & 8); ++i) {
            int bh, qb;
            if (G == 256) { if (i >= 2) break; const int idx = i * 32 + (bx >> 3); bh = (bx & 7) + 8 * (idx >> 4); qb = idx & 15; }
            else { const int un = i * G + bx; if (un >= 512) break; bh = un >> 4; qb = un & 15; }
            const int b = bh >> 3, h = bh & 7;
#ifdef MLA_ABL
            if (args.flags & 16) mla::mla_unit<MLA_ABL>(Qg, Kn, Kp, Vg, cs, Og, b * S + qb * 256, b * S, h, S, (char*)lds_raw); else
#endif
            mla::mla_unit<0>(Qg, Kn, Kp, Vg, cs, Og, b * S + qb * 256, b * S, h, S, (char*)lds_raw);
        }
        {
            const unsigned short* qkv = (const unsigned short*)(ws + WS_QKVA); const int* pos = (const int*)args.in[2];
            const float* tbl = (const float*)(ws + WS_TBL); unsigned short* oap = (unsigned short*)(ws + WS_OAP); float* lse = (float*)(ws + WS_LSE);
            char* wl = (char*)lds_raw + wave * dil::W_BYTES;
            __syncthreads();
            int cur_h = -1;
            dil::TaskId tc = dil::task_at(0, bx, G, wave), tn = tc; dil::Pre P;
            bool have = !(args.flags & 4) && tc.ub >= 0;
            if (have) dil::dil_prefetch(qkv, pos, tc, P);
            for (int i = 0; have; ++i) {
                tn = dil::task_at(i + 1, bx, G, wave); const bool has_next = tn.ub >= 0;
                if (tc.h != cur_h) { float* tw = (float*)(wl + dil::W_TBL); for (int j = lane; j < 2049; j += 64) tw[j ^ ((j >> 5) & 31)] = tbl[tc.h * dil::TBL_PITCH + j] * 1.4426950408889634f; cur_h = tc.h; asm volatile("s_waitcnt vmcnt(0) lgkmcnt(0)" ::: "memory"); }
                dil::dil_task(qkv, pos, oap, lse, tc, P, has_next, tn, wl);
                tc = tn; have = has_next;
            }
        }
    }
    GRID_BAR(3);
    if (IN(4)) {
        { int kx = 256; asm volatile("" : "+s"(kx));
          if (bx < 64) { pg8::Gemm g{(const bf16_t*)(ws + WS_KVMEM), Wmqg, 2048, 1024, kx}; OrderWp S{bx}; EpiPlain E{(unsigned char*)(ws + WS_WPT), 1024};
              pg8::gemm_phase<EpiPlain, OrderWp, true, true>(lds, g, S, E); }
          else if (bx < 128) { pg8::Gemm g{WmoT, (const bf16_t*)(ws + WS_KVMEM), 1024, 2048, kx}; OrderVw S{bx - 64}; EpiPlain E{(unsigned char*)(ws + WS_VWT), 1024};
              pg8::gemm_phase<EpiPlain, OrderVw, true, true>(lds, g, S, E); } }
        const bf16_t* oap = (const bf16_t*)(ws + WS_OAP); const float* lse = (const float*)(ws + WS_LSE); const bf16_t* obp = (const bf16_t*)(ws + WS_OB);
        const float* g_out_a = args.in[10]; const float* g_out_b = args.in[11]; bf16_t* omix = (bf16_t*)(ws + WS_OMIX);
        const int gw = vcu * NWAVES + wave, NGW = G * NWAVES;
        const f32x4 ga0 = *(const f32x4*)(g_out_a + 8 * lane), ga1 = *(const f32x4*)(g_out_a + 8 * lane + 4), gb0 = *(const f32x4*)(g_out_b + 8 * lane), gb1 = *(const f32x4*)(g_out_b + 8 * lane + 4);
#define UNPK_LO(V_) ((f32x4){__builtin_bit_cast(float, (V_)[0] << 16), __builtin_bit_cast(float, (V_)[0] & 0xffff0000u), __builtin_bit_cast(float, (V_)[1] << 16), __builtin_bit_cast(float, (V_)[1] & 0xffff0000u)})
#define UNPK_HI(V_) ((f32x4){__builtin_bit_cast(float, (V_)[2] << 16), __builtin_bit_cast(float, (V_)[2] & 0xffff0000u), __builtin_bit_cast(float, (V_)[3] << 16), __builtin_bit_cast(float, (V_)[3] & 0xffff0000u)})
        for (int tok = gw; tok < T; tok += NGW) {
            const int head = lane >> 3;
            const float l0 = lse[((size_t)0 * T + tok) * 8 + head], l1 = lse[((size_t)1 * T + tok) * 8 + head], l2 = lse[((size_t)2 * T + tok) * 8 + head];
            const float mx = fmaxf(l0, fmaxf(l1, l2)); float w0 = __expf(l0 - mx), w1 = __expf(l1 - mx), w2 = __expf(l2 - mx); const float wi = 1.0f / (w0 + w1 + w2); w0 *= wi; w1 *= wi; w2 *= wi;
            const v4u q0 = *(const v4u*)(oap + ((size_t)0 * T + tok) * 512 + 8 * lane), q1 = *(const v4u*)(oap + ((size_t)1 * T + tok) * 512 + 8 * lane);
            const v4u q2 = *(const v4u*)(oap + ((size_t)2 * T + tok) * 512 + 8 * lane), qb = *(const v4u*)(obp + (size_t)tok * 512 + 8 * lane);
            const f32x4 a0 = UNPK_LO(q0) * w0 + UNPK_LO(q1) * w1 + UNPK_LO(q2) * w2, a1 = UNPK_HI(q0) * w0 + UNPK_HI(q1) * w1 + UNPK_HI(q2) * w2, b0 = UNPK_LO(qb), b1 = UNPK_HI(qb);
            const float sa = wave_sum(sq8(a0, a1)), sb = wave_sum(sq8(b0, b1));
            const float ra = 1.0f / sqrtf(sa * (1.0f / 512.0f) + 1e-6f), rb = 1.0f / sqrtf(sb * (1.0f / 512.0f) + 1e-6f);
            *(v4u*)(omix + (size_t)tok * 1024 + 8 * lane) = pack8(a0 * ra * ga0, a1 * ra * ga1);
            *(v4u*)(omix + (size_t)tok * 1024 + 512 + 8 * lane) = pack8(b0 * rb * gb0, b1 * rb * gb1);
        }
#undef UNPK_LO
#undef UNPK_HI
    }
    GRID_BAR(4);
    if (IN(5)) {
        int kx = 1024; asm volatile("" : "+s"(kx));
        pg8::Gemm g{(const bf16_t*)(ws + WS_OMIX), WoT, kx, kx, kx}; pg8::StaticOrder S; S.init(T, 1024, 1024, 1024, G, bx);
        EpiResid<false, true> E{x, (bf16_t*)(ws + WS_H1B), (float*)(ws + WS_SSQH1), (unsigned char*)(ws + WS_H1Q), 1.0f};
        pg8::gemm_phase<EpiResid<false, true>, pg8::StaticOrder, true, true>(lds, g, S, E);
    }
    GRID_BAR(5);
    if (IN(6)) {
        int kx = 512; asm volatile("" : "+s"(kx));
        pg8::Gemm g{(const bf16_t*)(ws + WS_H1Q), (const bf16_t*)(ws + WS_WPT), kx, kx, kx}; OrderBatch S; S.so.init(T, 1024, 512, 512, G, bx);
        pg8::Unit u0; const bool has = S.next(0, u0);
        LAS float* rsl = (LAS float*)(lds + CTRL_OFF + 1024);
        if (has && tid < 256) { const float* sp = (const float*)(ws + WS_SSQH1) + (size_t)(u0.pm * 256 + tid) * 16; float a = 0.f;
#pragma unroll
            for (int j = 0; j < 4; ++j) { const f32x4 v = ((const f32x4*)sp)[j]; a += (v[0] + v[1]) + (v[2] + v[3]); }
            rsl[tid] = 1.0f / sqrtf(a * (1.0f / 1024.0f) + 1e-6f); }
        __syncthreads();
        EpiSoftmax E{(unsigned char*)(ws + WS_P), CTRL_OFF + 1024};
        pg8::gemm_phase<EpiSoftmax, OrderBatch, false, true, false, true>(lds, g, S, E);
    }
    GRID_BAR(6);
    if (IN(7)) {
        int kx = 512; asm volatile("" : "+s"(kx));
        pg8::Gemm g{(const bf16_t*)(ws + WS_P), (const bf16_t*)(ws + WS_VWT), kx, kx, kx}; OrderBatch S; S.so.init(T, 1024, 512, 512, G, bx);
        EpiResid<true, true> E{(const bf16_t*)(ws + WS_H1B), (bf16_t*)(ws + WS_H2B), (float*)(ws + WS_SSQH2), (unsigned char*)(ws + WS_H2Q), P8_INV * XA8_INV};
        pg8::gemm_phase<EpiResid<true, true>, OrderBatch, true, true, false, true>(lds, g, S, E);
    }
    GRID_BAR(7);
    if (IN(8)) {
        typedef float f32x16 __attribute__((ext_vector_type(16)));
        const bf16_t* h2b = (const bf16_t*)(ws + WS_H2B); const float* b_router = args.in[20]; const float* ssq2 = (const float*)(ws + WS_SSQH2);
        int* topi = (int*)(ws + WS_ROUTE + RT_TOPI); float* topg = (float*)(ws + WS_ROUTE + RT_TOPG); int* tslot = (int*)(ws + WS_ROUTE + RT_SLOT); int* row_flat = (int*)(ws + WS_ROUTE + RT_ROWFLAT);
        for (int i = bx * 512 + tid; i < MPADN; i += G * 512) row_flat[i] = -1;
        LAS float* part = (LAS float*)lds;
        LAS float* lgt = (LAS float*)(lds + 32768);
        for (int ch = bx; ch < T / 64; ch += G) {
            const int tok0 = ch * 64, tb = wave & 1, kq = wave >> 1, kh = lane >> 5, row = tok0 + 32 * tb + (lane & 31);
            f32x16 acc = {};
            const bf16_t* ap = h2b + (size_t)row * 1024 + 256 * kq + 4 * kh; const float* wp = (const float*)(ws + WS_WRG) + (size_t)(256 * kq + 4 * kh) * 32 + (lane & 31);
#pragma unroll 8
            for (int j = 0; j < 32; ++j) {
                const v2u aw = *(const v2u*)(ap + 8 * j);
                const f32x4 a4 = (f32x4){__builtin_bit_cast(float, aw.x << 16), __builtin_bit_cast(float, aw.x & 0xffff0000u), __builtin_bit_cast(float, aw.y << 16), __builtin_bit_cast(float, aw.y & 0xffff0000u)};
#pragma unroll
                for (int e = 0; e < 4; ++e) acc = __builtin_amdgcn_mfma_f32_32x32x2f32(a4[e], wp[(size_t)(8 * j + e) * 32], acc, 0, 0, 0);
            }
#pragma unroll
            for (int r = 0; r < 16; ++r) part[((kq * 64) + tb * 32 + (r & 3) + 8 * (r >> 2) + 4 * kh) * 32 + (lane & 31)] = acc[r];
            __syncthreads();
            {
                const int tk = tid >> 3, e0 = (tid & 7) * 4; const float* sp = ssq2 + (size_t)(tok0 + tk) * 16; float a = 0.f;
#pragma unroll
                for (int j = 0; j < 4; ++j) { const f32x4 v = ((const f32x4*)sp)[j]; a += (v[0] + v[1]) + (v[2] + v[3]); }
                const float rs = 1.0f / sqrtf(a * (1.0f / 1024.0f) + 1e-6f);
                if (e0 == 0) ((float*)(ws + WS_ROUTE + RT_RSTD))[tok0 + tk] = rs;
#pragma unroll
                for (int e = 0; e < 4; ++e) lgt[tk * 33 + e0 + e] = rs * ((part[(0 * 64 + tk) * 32 + e0 + e] + part[(1 * 64 + tk) * 32 + e0 + e]) + (part[(2 * 64 + tk) * 32 + e0 + e] + part[(3 * 64 + tk) * 32 + e0 + e])) + b_router[e0 + e];
            }
            __syncthreads();
            if (tid < 64) {
                int c0 = -1, c1 = -1, c2 = -1, c3 = -1; float v0 = 0.f, v1 = 0.f, v2 = 0.f, v3 = 0.f; int s0 = 0, s1 = 0, s2 = 0, s3 = 0;
                for (int k = 0; k < 4; ++k) {
                    float best = -3.0e38f; int bi = 0;
                    for (int e = 0; e < 32; ++e) { const float v = lgt[tid * 33 + e]; if (e == c0 || e == c1 || e == c2 || e == c3) continue; if (v > best) { best = v; bi = e; } }
                    if (k == 0) { c0 = bi; v0 = best; } else if (k == 1) { c1 = bi; v1 = best; } else if (k == 2) { c2 = bi; v2 = best; } else { c3 = bi; v3 = best; }
                }
                const unsigned long long lt = (1ull << lane) - 1ull; int* cntc = (int*)(ws + WS_ROUTE + RT_CNT) + ch * 32;
                for (int e = 0; e < 32; ++e) {
                    const unsigned long long m0 = __ballot(c0 == e), m1 = __ballot(c1 == e), m2 = __ballot(c2 == e), m3 = __ballot(c3 == e);
                    const int before = __popcll(m0 & lt) + __popcll(m1 & lt) + __popcll(m2 & lt) + __popcll(m3 & lt);
                    if (c0 == e) s0 = before; if (c1 == e) s1 = before; if (c2 == e) s2 = before; if (c3 == e) s3 = before;
                    if (lane == e) cntc[e] = __popcll(m0) + __popcll(m1) + __popcll(m2) + __popcll(m3);
                }
                const int t = tok0 + tid;
                const float e1 = __expf(v1 - v0), e2 = __expf(v2 - v0), e3 = __expf(v3 - v0), inv = 1.0f / (1.0f + e1 + e2 + e3);
                *(int4*)(topi + t * 4) = make_int4(c0, c1, c2, c3);
                *(f32x4*)(topg + t * 4) = (f32x4){inv, e1 * inv, e2 * inv, e3 * inv};
                *(int4*)(tslot + t * 4) = make_int4(s0, s1, s2, s3);
            }
            __syncthreads();
        }
    }
    GRID_BAR(8);
    if (IN(9)) {
        const int* topi = (const int*)(ws + WS_ROUTE + RT_TOPI); const int* tslot = (const int*)(ws + WS_ROUTE + RT_SLOT); const int* cnt = (const int*)(ws + WS_ROUTE + RT_CNT);
        int* row_flat = (int*)(ws + WS_ROUTE + RT_ROWFLAT); float* rs_row = (float*)(ws + WS_ROUTE + RT_RSROW); const float* rstd2 = (const float*)(ws + WS_ROUTE + RT_RSTD);
        LAS int* red = (LAS int*)lds;
        for (int base = bx * 512; base < NA; base += G * 512) {
            const int chA = base >> 8, e = tid & 31, part = tid >> 5;
            int tot = 0, pa = 0, pb = 0;
            for (int c = part; c < T / 64; c += 16) { const int v = cnt[c * 32 + e]; tot += v; pa += c < chA ? v : 0; pb += c <= chA ? v : 0; }
            __syncthreads();
            red[(0 * 16 + part) * 32 + e] = tot; red[(1 * 16 + part) * 32 + e] = pa; red[(2 * 16 + part) * 32 + e] = pb;
            __syncthreads();
            if (tid < 96) { const int w = tid >> 5; int a = 0; for (int p = 0; p < 16; ++p) a += red[(w * 16 + p) * 32 + e]; red[1536 + w * 32 + e] = a; }
            __syncthreads();
            if (tid == 0) { int run = 0; for (int q = 0; q < NE; ++q) { red[1632 + q] = run; run += ((red[1536 + q] + 255) >> 8) << 8; } }
            if (bx == 0 && base == 0 && tid < 32) ((int*)(ws + WS_ROUTE + RT_TOT))[tid] = red[1536 + tid];
            __syncthreads();
            const int a = base + tid, ex = topi[a], row = red[1632 + ex] + red[1536 + 32 * (1 + (((a >> 8) - chA) & 1)) + ex] + tslot[a];
            row_flat[row] = a; rs_row[row] = rstd2[a >> 2]; ((float*)(ws + WS_ROUTE + RT_RGATE))[row] = ((const float*)(ws + WS_ROUTE + RT_TOPG))[a];
        }
    }
    GRID_BAR(9);
    if (IN(10) || IN(11)) {
        const int* gtot = (const int*)(ws + WS_ROUTE + RT_TOT); LAS int* texp = (LAS int*)(lds + LX_TEXP);
        __syncthreads();
        if (tid < 64) {
            const int n = tid < NE ? (gtot[tid] + 255) >> 8 : 0; int inc = n;
#pragma unroll
            for (int d = 1; d < 32; d <<= 1) { const int v = __shfl_up(inc, d); if ((tid & 63) >= d) inc += v; }
            const int start = inc - n;
            if (tid < NE) for (int j = 0; j < n; ++j) texp[start + j] = tid;
            if (tid == NE - 1) texp[NTILEN] = inc;
        }
        __syncthreads();
    }
    if (IN(10)) {
        int kx = 512; asm volatile("" : "+s"(kx));
        pg8::Gemm g{(const bf16_t*)(ws + WS_H2Q), WguT, kx, kx, kx}; OrderMoe S{(const LAS int*)(lds + LX_TEXP), 8, bx, G, (size_t)2048 * 1024};
        {
            const int* row_flat = (const int*)(ws + WS_ROUTE + RT_ROWFLAT); pg8::Unit u;
            int av[pg8::GTAB_UNITS];
#pragma unroll
            for (int i = 0; i < pg8::GTAB_UNITS; ++i) { av[i] = -2; if (S.next(i, u) && tid < 256) av[i] = row_flat[u.pm * 256 + tid]; }
#pragma unroll
            for (int i = 0; i < pg8::GTAB_UNITS; ++i) if (av[i] != -2) ((LAS unsigned short*)(lds + pg8::GTAB))[i * 256 + tid] = (unsigned short)(av[i] >= 0 ? (av[i] >> 2) : 0);
            __syncthreads();
        }
        EpiSwiGLU E{(const float*)(ws + WS_ROUTE + RT_RSROW), args.in[22], (unsigned char*)(ws + WS_HMID), (const LAS int*)(lds + LX_TEXP)};
        pg8::gemm_phase<EpiSwiGLU, OrderMoe, true, true, true, true>(lds, g, S, E);
    }
    GRID_BAR(10);
    if (IN(11)) {
        int kx = 512; asm volatile("" : "+s"(kx));
        pg8::Gemm g{(const bf16_t*)(ws + WS_HMID), WdT, kx, kx, kx}; OrderMoe S{(const LAS int*)(lds + LX_TEXP), 4, bx, G, (size_t)1024 * 1024};
        EpiDown E{(const int*)(ws + WS_ROUTE + RT_ROWFLAT), (const float*)(ws + WS_ROUTE + RT_RGATE), args.in[24], (bf16_t*)(ws + WS_YBUF), (const LAS int*)(lds + LX_TEXP)};
        pg8::gemm_phase<EpiDown, OrderMoe, true, true, false, true>(lds, g, S, E);
    }
    GRID_BAR(11);
    if (IN(12)) {
        const bf16_t* h2b = (const bf16_t*)(ws + WS_H2B); const bf16_t* ybuf = (const bf16_t*)(ws + WS_YBUF); const float* g_final = args.in[25]; float* outp = args.out;
        const int gw = vcu * NWAVES + wave, NGW = G * NWAVES;
        for (int t = gw; t < T; t += NGW) {
            f32x4 v[4]; float ss = 0.f;
#pragma unroll
            for (int j = 0; j < 4; ++j) {
                const v2u hw = *(const v2u*)(h2b + (size_t)t * 1024 + 256 * j + 4 * lane);
                f32x4 a = (f32x4){__builtin_bit_cast(float, hw.x << 16), __builtin_bit_cast(float, hw.x & 0xffff0000u), __builtin_bit_cast(float, hw.y << 16), __builtin_bit_cast(float, hw.y & 0xffff0000u)};
#pragma unroll
                for (int k = 0; k < 4; ++k) { const v2u y = *(const v2u*)(ybuf + ((size_t)t * 4 + k) * 1024 + 256 * j + 4 * lane);
                    a[0] += __builtin_bit_cast(float, y.x << 16); a[1] += __builtin_bit_cast(float, y.x & 0xffff0000u); a[2] += __builtin_bit_cast(float, y.y << 16); a[3] += __builtin_bit_cast(float, y.y & 0xffff0000u); }
                v[j] = a; ss += (a[0] * a[0] + a[1] * a[1]) + (a[2] * a[2] + a[3] * a[3]);
            }
            ss = wave_sum(ss); const float rs = 1.0f / sqrtf(ss * (1.0f / 1024.0f) + 1e-6f);
#pragma unroll
            for (int j = 0; j < 4; ++j) *(f32x4*)(outp + (size_t)t * 1024 + 256 * j + 4 * lane) = v[j] * rs * *(const f32x4*)(g_final + 256 * j + 4 * lane);
        }
    }
#undef GRID_BAR
#undef BOTH
#undef IN
}

}
void launch_mk(hipStream_t st, const mk::Args& base, int lo, int hi, int grid) {
    mk::Args a = base; a.ph_lo = lo; a.ph_hi = hi;
    hipLaunchKernelGGL(mk::mk_fwd, dim3(grid), dim3(mk::NWAVES * 64), mk::LDS_BYTES, st, a);
}
}

extern "C" void kernel_launch(void* const* d_in, const int* in_sizes, int n_in, void* d_out, int out_size, void* d_ws, size_t ws_size, hipStream_t stream) {
    static int grid = 0;
    if (grid == 0) {
        int dev = 0, cus = 0;
        if (hipGetDevice(&dev) != hipSuccess || hipDeviceGetAttribute(&cus, hipDeviceAttributeMultiprocessorCount, dev) != hipSuccess) { grid = -1; return; }
        if (hipFuncSetAttribute((const void*)mk::mk_fwd, hipFuncAttributeMaxDynamicSharedMemorySize, mk::LDS_BYTES) != hipSuccess) { grid = -1; return; }
        grid = cus >= 256 ? 256 : cus;
    }
    if (grid < 0) return;
    const float* x = (const float*)d_in[0];
    const float* mem = (const float*)d_in[1];
    const int* pos = (const int*)d_in[2];
    const float* g_q_a = (const float*)d_in[5];
    const float* w_q_b = (const float*)d_in[6];
    const float* g_kv_a = (const float*)d_in[7];
    const float* w_kv_b = (const float*)d_in[8];
    const float* rel_bias = (const float*)d_in[9];
    const float* g_out_a = (const float*)d_in[10];
    const float* g_out_b = (const float*)d_in[11];
    const float* w_o = (const float*)d_in[12];
    const float* g_xattn = (const float*)d_in[13];
    const float* g_mem = (const float*)d_in[14];
    const float* w_mq = (const float*)d_in[15];
    const float* w_mkv = (const float*)d_in[16];
    const float* w_mo = (const float*)d_in[17];
    const float* g_moe = (const float*)d_in[18];
    const float* w_router = (const float*)d_in[19];
    const float* b_router = (const float*)d_in[20];
    const float* w_gate_up = (const float*)d_in[21];
    const float* b_gate_up = (const float*)d_in[22];
    const float* w_down = (const float*)d_in[23];
    const float* b_down = (const float*)d_in[24];
    const float* g_final = (const float*)d_in[25];
    float* out = (float*)d_out;
    (void)ws_size; (void)in_sizes; (void)n_in; (void)out_size;

    (void)hipMemsetAsync((char*)d_ws + mk::WS_CTL, 0, mk::CTL_ZERO_BYTES, stream);
    mk::Args ma; memset(&ma, 0, sizeof(ma));
    for (int i = 0; i < 26; ++i) ma.in[i] = (const float*)d_in[i];
    ma.out = out; ma.ws = (unsigned char*)d_ws; ma.flags = 1;
    for (int j = 0; j < 16; ++j) ma.rope_rev[j] = pow(10000.0, -(double)j / 16.0) / 6.283185307179586476925287;
#ifndef MK_N_LAUNCHES
#define MK_N_LAUNCHES 1
#endif
    if (MK_N_LAUNCHES == 1) launch_mk(stream, ma, 0, 13, grid);
    else for (int p = 0; p < 13; ++p) launch_mk(stream, ma, p, p + 1, grid);
#ifdef PROBE_MASK
#ifdef PROBE_FLAGS
    ma.flags |= PROBE_FLAGS;
#endif
    for (int r = 0; r < PROBE_N; ++r) for (int p = 0; p < 13; ++p) if ((PROBE_MASK >> p) & 1) launch_mk(stream, ma, p, p + 1, grid);
#endif
}
```

```cpp
#include <hip/hip_runtime.h>
#include <stdint.h>
#include <string.h>
#include <math.h>

namespace {
constexpr int NB = 4, S = 4096, D = 1024, T = NB * S, NMEM = 256, INW = 1952;
constexpr int NE = 32, TOPK = 4, NA = T * TOPK;

namespace pg8 {
#define PG8_LAS __attribute__((address_space(3)))
typedef unsigned short bf16_t;
typedef short bf16x8 __attribute__((ext_vector_type(8)));
typedef float f32x4 __attribute__((ext_vector_type(4)));
typedef unsigned u32x4 __attribute__((ext_vector_type(4)));
constexpr int BM = 256, BK = 64, HALF = 128, HTB = HALF * BK * 2  , STAGE_BYTES = 8 * HTB, NXCD = 8, WGM = 8;

__host__ __device__ __forceinline__ int lds_byte(int r, int c) { const int st = (r >> 4) * 2 + (c >> 5), rr = r & 15, cc = c & 31, ob = rr * 64 + cc * 2; return st * 1024 + (ob ^ (((ob >> 9) & 1) << 5)); }
__host__ __device__ __forceinline__ void stage_rc(int b, int& R, int& C) { const int st = b / 1024, sb = b % 1024, swz = sb ^ (((sb >> 9) & 1) << 5); R = (st >> 1) * 16 + swz / 64; C = (st & 1) * 32 + (swz % 64) / 2; }
__host__ __device__ __forceinline__ int perm32(int rho) { const int n = rho >> 4, i = rho & 15; return 8 * (i >> 2) + 4 * n + (i & 3); }

struct Unit { int pm, pn; size_t aoff, boff; };
struct Gemm { const bf16_t* A; const bf16_t* Bt; int lda, ldb, K; };

struct StaticOrder {
    int nM, nN, nwg, G, c; size_t ta, tb;
    __host__ __device__ __forceinline__ void init(int M, int N, int lda, int ldb, int G_, int c_) { nM = M / BM; nN = N / BM; nwg = nM * nN; G = G_; c = c_; ta = (size_t)BM * lda * 2; tb = (size_t)BM * ldb * 2; }
    __host__ __device__ __forceinline__ bool next(int i, Unit& u) const {
        const long L = (long)i * G + c; if (L >= nwg) return false;
        int wgid = (int)L; { const int q = nwg / NXCD, r = nwg % NXCD, xcd = wgid % NXCD, off = wgid / NXCD; wgid = (xcd < r ? xcd * (q + 1) : r * (q + 1) + (xcd - r) * q) + off; }
        const int nig = WGM * nN, gid = wgid / nig, fm = gid * WGM, gsz = (nM - fm) < WGM ? (nM - fm) : WGM;
        u.pm = fm + ((wgid % nig) % gsz); u.pn = (wgid % nig) / gsz; u.aoff = (size_t)u.pm * ta; u.boff = (size_t)u.pn * tb; return true;
    }
    __device__ __forceinline__ void a_ready(const Unit&) const {}
    __device__ __forceinline__ void done(const Unit&) const {}
};

__device__ __forceinline__ unsigned cvt_pk_bf16(float lo, float hi) { unsigned r; asm volatile("v_cvt_pk_bf16_f32 %0, %1, %2" : "=v"(r) : "v"(lo), "v"(hi)); return r; }
typedef float f32x2 __attribute__((ext_vector_type(2)));

constexpr int GTAB = 135168 + 4096, GTAB_UNITS = 10;
typedef int i32x4 __attribute__((ext_vector_type(4)));
typedef int i32x8 __attribute__((ext_vector_type(8)));
__device__ __forceinline__ i32x8 cat8(const bf16x8 a, const bf16x8 b) { return __builtin_shufflevector(__builtin_bit_cast(i32x4, a), __builtin_bit_cast(i32x4, b), 0, 1, 2, 3, 4, 5, 6, 7); }
template <class Epi, class Sched, bool ALIGN_EPI = false, bool SP2 = false, bool GATHER = false, bool F8 = false>
__device__ __forceinline__ void gemm_phase(PG8_LAS unsigned char* lds, const Gemm g, const Sched& S, const Epi& E) {
    const int tid = threadIdx.x, wid = __builtin_amdgcn_readfirstlane(tid >> 6), lane = tid & 63, wr = wid >> 2, wc = wid & 3, fr = lane & 15, fq = lane >> 4;
    static_assert(!GATHER || SP2, "GATHER is implemented for the SP2 loop only");
    const int K = g.K, nt = K / BK;
    unsigned voffA[2], voffB[2];
#pragma unroll
    for (int i = 0; i < 2; ++i) { int R, C; stage_rc(tid * 16 + i * 8192, R, C); const int Rb = Epi::PERM ? ((R & ~31) + perm32(R & 31)) : R;
        voffA[i] = (unsigned)(R * g.lda + C) * 2u; voffB[i] = (unsigned)(Rb * g.ldb + C) * 2u; }
    unsigned gidx[2], gcol[2];
#pragma unroll
    for (int i = 0; i < 2; ++i) { int R, C; stage_rc(tid * 16 + i * 8192, R, C); gidx[i] = (unsigned)R * 2u; gcol[i] = (unsigned)C * 2u; }
    const size_t kstep = (size_t)(BK * 2);
    const size_t hstepA = (size_t)HALF * g.lda * 2, hstepB = (size_t)HALF * g.ldb * 2;
    const unsigned ldsw = (unsigned)wid * 1024u;
    const int aoff = lds_byte(wr * 64 + fr, fq * 8), boff = lds_byte(wc * 32 + fr, fq * 8);
#define PG8_SA(b, h) (((b) * 2 + (h)) * HTB)
#define PG8_SB(b, h) ((4 + (b) * 2 + (h)) * HTB)
#define PG8_GLDS(gptr, off32, ldsdst) do { unsigned _o = (off32); asm volatile("" : "+v"(_o)); __builtin_amdgcn_global_load_lds((const unsigned*)((const char*)(gptr) + _o), (ldsdst), 16, 0, 0); } while (0)
#define PG8_STAGE(bufoff, gbase, voff) do { _Pragma("unroll") for (int _i = 0; _i < 2; ++_i) \
        PG8_GLDS(gbase, (voff)[_i], (PG8_LAS unsigned*)(lds + (bufoff) + ldsw + _i * 8192)); } while (0)
#define PG8_GTOK(h, sel) do { if constexpr (GATHER) { tk0 = *(const PG8_LAS unsigned short*)(lds + GTAB + (sel) * 512 + (h) * 256 + gidx[0]); tk1 = *(const PG8_LAS unsigned short*)(lds + GTAB + (sel) * 512 + (h) * 256 + gidx[1]); } } while (0)
#define PG8_STAGE_A(bufoff, gbase, h, sel) do { if constexpr (GATHER) { \
        PG8_GLDS(gbase, tk0 * (unsigned)(g.lda * 2) + gcol[0], (PG8_LAS unsigned*)(lds + (bufoff) + ldsw)); \
        PG8_GLDS(gbase, tk1 * (unsigned)(g.lda * 2) + gcol[1], (PG8_LAS unsigned*)(lds + (bufoff) + ldsw + 8192)); } \
    else { PG8_STAGE(bufoff, (gbase) + (h) * hstepA, voffA); } } while (0)
#define PG8_LDA(dst, b, h) do { _Pragma("unroll") for (int m = 0; m < 4; ++m) _Pragma("unroll") for (int k = 0; k < 2; ++k) dst[m][k] = *(const PG8_LAS bf16x8*)(lds + PG8_SA(b, h) + aoff + m * 2048 + k * 1024); } while (0)
#define PG8_LDB(dst, b, h) do { _Pragma("unroll") for (int n = 0; n < 2; ++n) _Pragma("unroll") for (int k = 0; k < 2; ++k) dst[n][k] = *(const PG8_LAS bf16x8*)(lds + PG8_SB(b, h) + boff + n * 2048 + k * 1024); } while (0)
#define PG8_MMA(ai, bj, At, Bt) do { __builtin_amdgcn_s_setprio(1); _Pragma("unroll") for (int m = 0; m < 4; ++m) _Pragma("unroll") for (int n = 0; n < 2; ++n) { \
        if constexpr (F8) { const i32x8 _b = cat8(Bt[n][0], Bt[n][1]), _a = cat8(At[m][0], At[m][1]); asm volatile("s_nop 1\n\tv_mfma_f32_16x16x128_f8f6f4 %0, %1, %2, %0" : "+v"(acc[ai][bj][m][n]) : "v"(_b), "v"(_a)); } \
        else { _Pragma("unroll") for (int k = 0; k < 2; ++k) acc[ai][bj][m][n] = __builtin_amdgcn_mfma_f32_16x16x32_bf16(Bt[n][k], At[m][k], acc[ai][bj][m][n], 0, 0, 0); } } __builtin_amdgcn_s_setprio(0); } while (0)
#define PG8_WAIT_V(n) asm volatile("s_waitcnt vmcnt(" #n ")" ::: "memory")
#define PG8_WAIT_L(n) asm volatile("s_waitcnt lgkmcnt(" #n ")" ::: "memory")
#define PG8_BAR __builtin_amdgcn_s_barrier()
#define PG8_SCHED __builtin_amdgcn_sched_barrier(0)
    Unit cur, nxt; int ui = 0; unsigned tk0 = 0, tk1 = 0; (void)tk0; (void)tk1;
    if (!S.next(0, cur)) return;
    f32x4 acc[2][2][4][2];
#pragma unroll
    for (int a = 0; a < 2; ++a)
#pragma unroll
        for (int b = 0; b < 2; ++b)
#pragma unroll
            for (int m = 0; m < 4; ++m)
#pragma unroll
                for (int n = 0; n < 2; ++n) acc[a][b][m][n] = (f32x4){0.f, 0.f, 0.f, 0.f};
    bf16x8 At[4][2], B0[2][2], B1[2][2];
    const char* cA = (const char*)g.A + (GATHER ? (size_t)0 : cur.aoff); const char* cB = (const char*)g.Bt + cur.boff;
    S.a_ready(cur);
    if constexpr (SP2) {
        PG8_STAGE(PG8_SB(0, 0), cB, voffB); PG8_STAGE(PG8_SB(0, 1), cB + hstepB, voffB); PG8_GTOK(0, ui); PG8_STAGE_A(PG8_SA(0, 0), cA, 0, ui); PG8_GTOK(1, ui); PG8_STAGE_A(PG8_SA(0, 1), cA, 1, ui);
        if (wr == 1) PG8_BAR;
        PG8_WAIT_V(2); PG8_BAR;
        PG8_STAGE(PG8_SB(1, 0), cB + kstep, voffB); PG8_GTOK(0, ui); PG8_STAGE_A(PG8_SA(1, 0), cA + kstep, 0, ui); PG8_STAGE(PG8_SB(1, 1), cB + hstepB + kstep, voffB);
        PG8_WAIT_V(6); PG8_BAR;
    } else {
        PG8_STAGE(PG8_SB(0, 0), cB, voffB); PG8_STAGE_A(PG8_SA(0, 0), cA, 0, ui); PG8_STAGE(PG8_SB(0, 1), cB + hstepB, voffB); PG8_STAGE_A(PG8_SA(0, 1), cA, 1, ui);
        if (wr == 1) PG8_BAR;
        PG8_WAIT_V(4); PG8_BAR;
        PG8_STAGE(PG8_SB(1, 0), cB + kstep, voffB); PG8_STAGE_A(PG8_SA(1, 0), cA + kstep, 0, ui); PG8_STAGE(PG8_SB(1, 1), cB + hstepB + kstep, voffB);
        PG8_WAIT_V(6); PG8_BAR;
    }
    for (;;) {
        const bool has_next = S.next(ui + 1, nxt);
        const char* nA = has_next ? (const char*)g.A + (GATHER ? (size_t)0 : nxt.aoff) : cA; const char* nB = has_next ? (const char*)g.Bt + nxt.boff : cB;
        for (int t = 0; t < nt; t += 2) {
            const bool last = (t == nt - 2);
            const char* a1 = cA + (size_t)(t + 1) * kstep;
            const char* a2 = last ? nA : cA + (size_t)(t + 2) * kstep; const char* b2 = last ? nB : cB + (size_t)(t + 2) * kstep;
            const char* a3 = a2 + kstep; const char* b3 = b2 + kstep; const int ui2 = (last && has_next) ? ui + 1 : ui; (void)ui2;
            if (last && has_next) S.a_ready(nxt);
            if constexpr (SP2) {
            PG8_GTOK(1, ui); PG8_LDB(B0, 0, 0); PG8_LDB(B1, 0, 1); PG8_SCHED; PG8_LDA(At, 0, 0); PG8_STAGE_A(PG8_SA(1, 1), a1, 1, ui);
            PG8_WAIT_V(8); PG8_WAIT_L(0); PG8_BAR; PG8_MMA(0, 0, At, B0); PG8_MMA(0, 1, At, B1); PG8_BAR; PG8_SCHED;
            PG8_GTOK(0, ui2); PG8_LDA(At, 0, 1); PG8_STAGE(PG8_SB(0, 0), b2, voffB); PG8_STAGE(PG8_SB(0, 1), b2 + hstepB, voffB); PG8_STAGE_A(PG8_SA(0, 0), a2, 0, ui2);
            PG8_WAIT_V(8); PG8_WAIT_L(0); PG8_BAR; PG8_MMA(1, 0, At, B0); PG8_MMA(1, 1, At, B1); PG8_BAR; PG8_SCHED;
            PG8_GTOK(1, ui2); PG8_LDB(B0, 1, 0); PG8_LDB(B1, 1, 1); PG8_SCHED; PG8_LDA(At, 1, 0); PG8_STAGE_A(PG8_SA(0, 1), a2, 1, ui2);
            PG8_WAIT_V(8); PG8_WAIT_L(0); PG8_BAR; PG8_MMA(0, 0, At, B0); PG8_MMA(0, 1, At, B1); PG8_BAR; PG8_SCHED;
            PG8_GTOK(0, ui2); PG8_LDA(At, 1, 1); PG8_STAGE(PG8_SB(1, 0), b3, voffB); PG8_STAGE(PG8_SB(1, 1), b3 + hstepB, voffB); PG8_STAGE_A(PG8_SA(1, 0), a3, 0, ui2);
            PG8_WAIT_V(8); PG8_WAIT_L(0); PG8_BAR; PG8_MMA(1, 0, At, B0); PG8_MMA(1, 1, At, B1); PG8_BAR; PG8_SCHED;
            } else {
            PG8_LDB(B0, 0, 0); PG8_SCHED; PG8_LDA(At, 0, 0); PG8_STAGE_A(PG8_SA(1, 1), a1, 1, ui);
            PG8_WAIT_L(8); PG8_BAR; PG8_WAIT_L(0); PG8_MMA(0, 0, At, B0); PG8_BAR; PG8_SCHED;
            PG8_LDB(B1, 0, 1); PG8_STAGE(PG8_SB(0, 0), b2, voffB);
            PG8_BAR; PG8_WAIT_L(0); PG8_MMA(0, 1, At, B1); PG8_BAR;
            PG8_LDA(At, 0, 1); PG8_STAGE_A(PG8_SA(0, 0), a2, 0, ui2);
            PG8_BAR; PG8_WAIT_L(0); PG8_MMA(1, 0, At, B0); PG8_BAR; PG8_SCHED;
            PG8_STAGE(PG8_SB(0, 1), b2 + hstepB, voffB);
            PG8_WAIT_V(6); PG8_BAR; PG8_MMA(1, 1, At, B1); PG8_BAR;
            PG8_LDB(B0, 1, 0); PG8_SCHED; PG8_LDA(At, 1, 0); PG8_STAGE_A(PG8_SA(0, 1), a2, 1, ui2);
            PG8_WAIT_L(8); PG8_BAR; PG8_WAIT_L(0); PG8_MMA(0, 0, At, B0); PG8_BAR; PG8_SCHED;
            PG8_LDB(B1, 1, 1); PG8_STAGE(PG8_SB(1, 0), b3, voffB);
            PG8_BAR; PG8_WAIT_L(0); PG8_MMA(0, 1, At, B1); PG8_BAR;
            PG8_LDA(At, 1, 1); PG8_STAGE_A(PG8_SA(1, 0), a3, 0, ui2);
            PG8_BAR; PG8_WAIT_L(0); PG8_MMA(1, 0, At, B0); PG8_BAR; PG8_SCHED;
            PG8_STAGE(PG8_SB(1, 1), b3 + hstepB, voffB);
            PG8_WAIT_V(6); PG8_BAR; PG8_MMA(1, 1, At, B1); PG8_BAR;
            }
        }
        if constexpr (F8) {
#define PG8_A4(a, b) "+v"(acc[a][b][0][0]), "+v"(acc[a][b][0][1]), "+v"(acc[a][b][1][0]), "+v"(acc[a][b][1][1]), "+v"(acc[a][b][2][0]), "+v"(acc[a][b][2][1]), "+v"(acc[a][b][3][0]), "+v"(acc[a][b][3][1])
            asm volatile("s_nop 11\n\ts_nop 3" : PG8_A4(0, 0), PG8_A4(0, 1));
            asm volatile("" : PG8_A4(1, 0), PG8_A4(1, 1));
#undef PG8_A4
        }
        if constexpr (ALIGN_EPI) { if (wr == 0) PG8_BAR; }
        if constexpr (!Epi::AFTER_DRAIN) { E(acc, cur, wr, wc, fr, fq); S.done(cur); }
        if (!has_next) break;
#pragma unroll
        for (int a = 0; a < 2; ++a)
#pragma unroll
            for (int b = 0; b < 2; ++b)
#pragma unroll
                for (int m = 0; m < 4; ++m)
#pragma unroll
                    for (int n = 0; n < 2; ++n) acc[a][b][m][n] = (f32x4){0.f, 0.f, 0.f, 0.f};
        cur = nxt; cA = nA; cB = nB; ++ui;
        if constexpr (ALIGN_EPI) { if (wr == 1) PG8_BAR; }
    }
    PG8_WAIT_V(0);
    if constexpr (!ALIGN_EPI) { if (wr == 0) PG8_BAR; }
    PG8_BAR;
    if constexpr (Epi::AFTER_DRAIN) { E.fused(acc, cur, wr, wc, fr, fq, lds, wid, lane); S.done(cur); }
#undef PG8_SA
#undef PG8_SB
#undef PG8_GLDS
#undef PG8_STAGE
#undef PG8_STAGE_A
#undef PG8_GTOK
#undef PG8_LDA
#undef PG8_LDB
#undef PG8_MMA
#undef PG8_WAIT_V
#undef PG8_WAIT_L
#undef PG8_BAR
#undef PG8_SCHED
}
}
namespace mla {
using bf16x8 = __attribute__((ext_vector_type(8))) short;
using s16x4  = __attribute__((ext_vector_type(4))) short;
using f32x16 = __attribute__((ext_vector_type(16))) float;
using u32x4  = __attribute__((ext_vector_type(4))) unsigned;
constexpr int NW = 8, QBLK = 32, KVBLK = 64;
constexpr float SCALE = 0.10206207261596577f;
constexpr float THR = 8.f;
constexpr int SHM_V = KVBLK * 64 * 2, SHM_K = KVBLK * 256;
constexpr int SHM_ATTN = 4 * SHM_V + 4 * SHM_K + NW * 64 * 4;
#define KSWZ(row, colB) ((row) * 256 + ((colB) ^ (((row) & 7) << 4)))
#define SBAR() __builtin_amdgcn_sched_barrier(0)
__device__ __forceinline__ int crow(int r, int hi) { return (r & 3) + 8 * (r >> 2) + 4 * hi; }
__device__ __forceinline__ unsigned cvtpk(float lo, float hi) { unsigned r; asm volatile("v_cvt_pk_bf16_f32 %0, %1, %2" : "=v"(r) : "v"(lo), "v"(hi)); return r; }

__device__ __forceinline__ float max3f(float a, float b, float c) { return __builtin_fmaxf(__builtin_fmaxf(a, b), c); }
template <int ABL> __device__ __forceinline__ void partialSM(f32x16& p0, f32x16& p1, float& m_reg, float& alpha, bool first) {
  float a = max3f(p0[0], p0[1], p0[2]), b = max3f(p0[3], p1[0], p1[1]), c = max3f(p1[2], p1[3], p0[4]), d = max3f(p0[5], p0[6], p0[7]);
  a = max3f(a, p1[4], p1[5]); b = max3f(b, p1[6], p1[7]);
#pragma unroll
  for (int r = 8; r < 16; r += 4) { a = max3f(a, p0[r], p0[r + 1]); b = max3f(b, p0[r + 2], p0[r + 3]); c = max3f(c, p1[r], p1[r + 1]); d = max3f(d, p1[r + 2], p1[r + 3]); }
  float pmax = fmaxf(fmaxf(a, b), fmaxf(c, d));
  { auto rr = __builtin_amdgcn_permlane32_swap(__float_as_uint(pmax), __float_as_uint(pmax), false, false);
    pmax = fmaxf(__uint_as_float(rr[0]), __uint_as_float(rr[1])); }
  if (__builtin_expect(!first && __all(pmax - m_reg <= THR * 1.4426950408889634f), 1)) { alpha = 1.f; }
  else { const float mn = first ? pmax : fmaxf(m_reg, pmax); alpha = first ? 1.f : __builtin_amdgcn_exp2f(m_reg - mn); m_reg = mn; }
#pragma unroll
  for (int r = 0; r < 16; ++r) { p0[r] -= m_reg; p1[r] -= m_reg; }
#pragma unroll
  for (int r = 0; r < 16; ++r) p0[r] = (ABL & 2) ? p0[r] * 0.5f : __builtin_amdgcn_exp2f(p0[r]);
}
template <int ABL> __device__ __forceinline__ void finishSM(f32x16& p0, f32x16& p1, float alpha, float& l_reg, bf16x8& pa0, bf16x8& pa1, bf16x8& pa2, bf16x8& pa3) {
#pragma unroll
  for (int r = 0; r < 16; ++r) p1[r] = (ABL & 2) ? p1[r] * 0.5f : __builtin_amdgcn_exp2f(p1[r]);
  float ps, s0 = 0.f, s1 = 0.f, s2 = 0.f, s3 = 0.f;
#pragma unroll
  for (int r = 0; r < 16; r += 4) { s0 += p0[r]; s1 += p0[r + 1]; s2 += p0[r + 2]; s3 += p0[r + 3]; }
#pragma unroll
  for (int r = 0; r < 16; r += 4) { s0 += p1[r]; s1 += p1[r + 1]; s2 += p1[r + 2]; s3 += p1[r + 3]; }
  ps = (s0 + s1) + (s2 + s3);
  { auto rr = __builtin_amdgcn_permlane32_swap(__float_as_uint(ps), __float_as_uint(ps), false, false);
    ps = __uint_as_float(rr[0]) + __uint_as_float(rr[1]); }
  l_reg = l_reg * alpha + ps;
#define PK4(P, BASE, OUT) do { u32x4 w = {cvtpk(P[BASE + 0], P[BASE + 1]), cvtpk(P[BASE + 2], P[BASE + 3]), cvtpk(P[BASE + 4], P[BASE + 5]), cvtpk(P[BASE + 6], P[BASE + 7])}; \
    OUT = *reinterpret_cast<bf16x8*>(&w); } while (0)
  PK4(p0, 0, pa0); PK4(p0, 8, pa1); PK4(p1, 0, pa2); PK4(p1, 8, pa3);
#undef PK4
}
__device__ __forceinline__ void qkt(f32x16& p0, f32x16& p1, const char* Ks, const bf16x8* qr, int r32, int hi) {
  p0 = f32x16{}; p1 = f32x16{};
#pragma unroll
  for (int d0 = 0; d0 < 6; ++d0) { int cb = (d0 * 16 + hi * 8) * 2;
    bf16x8 b0 = *reinterpret_cast<const bf16x8*>(Ks + KSWZ(r32, cb));
    bf16x8 b1 = *reinterpret_cast<const bf16x8*>(Ks + KSWZ(32 + r32, cb));
    p0 = __builtin_amdgcn_mfma_f32_32x32x16_bf16(b0, qr[d0], p0, 0, 0, 0);
    p1 = __builtin_amdgcn_mfma_f32_32x32x16_bf16(b1, qr[d0], p1, 0, 0, 0); }
}
__device__ __forceinline__ int v_st(int k, int c) { const int kk = k;
  return ((kk >> 3) * 2 + (c >> 5)) * 512 + ((kk & 7) * 32 + (c & 31)) * 2; }
__device__ __forceinline__ int v_rd_base(int lane) { return ((lane & 3) << 3) | (((lane >> 2) & 3) << 6) | (((lane >> 4) & 1) << 5) | (((lane >> 5) & 1) << 8); }
constexpr int v_rd_off(int d0, int ks, int half) { return d0 * 512 + ks * 2048 + half * 1024; }
template <int OFF> __device__ __forceinline__ s16x4 tr_read(int vb) {
  s16x4 r; asm volatile("ds_read_b64_tr_b16 %0, %1 offset:%2" : "=&v"(r) : "v"(vb), "i"(OFF) : "memory"); return r;
}
#define PK(L, H) (bf16x8){L[0], L[1], L[2], L[3], H[0], H[1], H[2], H[3]}
#define PV_RD(KS, LA, HA, LB, HB) do { LA = tr_read<v_rd_off(0, KS, 0)>(vb); HA = tr_read<v_rd_off(0, KS, 1)>(vb); LB = tr_read<v_rd_off(1, KS, 0)>(vb); HB = tr_read<v_rd_off(1, KS, 1)>(vb); } while (0)
#define PV_MM(PA, LA, HA, LB, HB) do { o[0] = __builtin_amdgcn_mfma_f32_32x32x16_bf16(PA, PK(LA, HA), o[0], 0, 0, 0); o[1] = __builtin_amdgcn_mfma_f32_32x32x16_bf16(PA, PK(LB, HB), o[1], 0, 0, 0); } while (0)
__device__ __forceinline__ void pv_d0(f32x16* o, int vb, bf16x8 pa0, bf16x8 pa1, bf16x8 pa2, bf16x8 pa3) {
  s16x4 la, ha, lb, hb, lc, hc, ld, hd;
  PV_RD(0, la, ha, lb, hb);
  PV_RD(1, lc, hc, ld, hd);
  asm volatile("s_waitcnt lgkmcnt(4)" ::: "memory"); SBAR();
  PV_MM(pa0, la, ha, lb, hb); SBAR();
  PV_RD(2, la, ha, lb, hb);
  asm volatile("s_waitcnt lgkmcnt(4)" ::: "memory"); SBAR();
  PV_MM(pa1, lc, hc, ld, hd); SBAR();
  PV_RD(3, lc, hc, ld, hd);
  asm volatile("s_waitcnt lgkmcnt(4)" ::: "memory"); SBAR();
  PV_MM(pa2, la, ha, lb, hb); SBAR();
  asm volatile("s_waitcnt lgkmcnt(0)" ::: "memory"); SBAR();
  PV_MM(pa3, lc, hc, ld, hd);
}
#undef PV_MM
#undef PV_RD
#undef PK
__device__ __forceinline__ float bf2f_(short b) { return __builtin_bit_cast(float, (unsigned)(unsigned short)b << 16); }

template <int ABL> __device__ __forceinline__ void mla_unit(const unsigned short* __restrict__ Qg, const unsigned short* __restrict__ Kn, const unsigned short* __restrict__ Kpe, const unsigned short* __restrict__ Vg,
                                         const float* __restrict__ cs, unsigned short* __restrict__ Og, int q0, int krow0, int h, int seq, char* lds) {
  const int tid = threadIdx.x, wid = __builtin_amdgcn_readfirstlane(tid >> 6), lane = tid & 63, r32 = lane & 31, hi = lane >> 5;
  char* V_lds = lds; char* K_lds = lds + 4 * SHM_V;
  float* ws = (float*)(lds + 4 * SHM_V + 4 * SHM_K) + wid * 64; float* li_l = ws; float* al_l = ws + 32;
  float m_reg = 0.f, l_reg = 0; f32x16 o[2] = {}; bf16x8 qr[6];
  {
    const int qrow = q0 + wid * QBLK + r32;
    const unsigned short* Qw = Qg + (size_t)qrow * 768 + h * 96 + hi * 8;
#pragma unroll
    for (int d0 = 0; d0 < 6; ++d0) qr[d0] = *reinterpret_cast<const bf16x8*>(Qw + d0 * 16);
    const float* cr = cs + (size_t)qrow * 32 + hi * 8;
    bf16x8 a = qr[4], b = qr[5]; u32x4 wa, wb; float n1[8], n2[8];
#pragma unroll
    for (int e = 0; e < 8; ++e) { const float c_ = cr[e], s_ = cr[16 + e]; const float x1 = bf2f_(a[e]), x2 = bf2f_(b[e]); n1[e] = x1 * c_ - x2 * s_; n2[e] = x1 * s_ + x2 * c_; }
    wa = (u32x4){cvtpk(n1[0], n1[1]), cvtpk(n1[2], n1[3]), cvtpk(n1[4], n1[5]), cvtpk(n1[6], n1[7])};
    wb = (u32x4){cvtpk(n2[0], n2[1]), cvtpk(n2[2], n2[3]), cvtpk(n2[4], n2[5]), cvtpk(n2[6], n2[7])};
    qr[4] = *reinterpret_cast<bf16x8*>(&wa); qr[5] = *reinterpret_cast<bf16x8*>(&wb);
  }
  const int sk = tid >> 3, sc = (tid & 7) * 8, rk = (tid & 255) >> 2, rc = (tid & 3) * 8;
  const int vst = v_st(sk, sc), kst = KSWZ(sk, sc * 2), rst = KSWZ(rk, (64 + rc) * 2);
  const int vb0 = (int)(uintptr_t)V_lds + v_rd_base(lane);
  const unsigned short* Vh = Vg + (size_t)krow0 * 512 + h * 64; const unsigned short* Kh = Kn + (size_t)krow0 * 512 + h * 64; const unsigned short* Rh = Kpe + (size_t)krow0 * 32;
  struct { bf16x8 vs, ks, rs; } sr_[2];
#define SLOAD(i, k0) do { sr_[i].vs = *reinterpret_cast<const bf16x8*>(&Vh[(size_t)((k0) + sk) * 512 + sc]); sr_[i].ks = *reinterpret_cast<const bf16x8*>(&Kh[(size_t)((k0) + sk) * 512 + sc]); \
    sr_[i].rs = *reinterpret_cast<const bf16x8*>(&Rh[(size_t)((k0) + rk) * 32 + rc]); } while (0)
#define SWRITE(b, i) do { *(bf16x8*)(V_lds + (b) * SHM_V + vst) = sr_[i].vs; *(bf16x8*)(K_lds + (b) * SHM_K + kst) = sr_[i].ks; *(bf16x8*)(K_lds + (b) * SHM_K + rst) = sr_[i].rs; } while (0)
#define RESC(a) do { if (__any((a) < 1.f)) { if (hi == 0) al_l[r32] = (a); asm volatile("s_waitcnt lgkmcnt(0)" ::: "memory"); \
    _Pragma("unroll") for (int d = 0; d < 2; ++d) _Pragma("unroll") for (int r = 0; r < 16; ++r) o[d][r] *= al_l[crow(r, hi)]; } } while (0)
#define EBAR() do { asm volatile("s_waitcnt lgkmcnt(0)" ::: "memory"); __builtin_amdgcn_s_barrier(); asm volatile("" ::: "memory"); } while (0)
  f32x16 p0, p1; float al; bf16x8 pa0, pa1, pa2, pa3; const int NT = seq / KVBLK;
  pa0 = pa1 = pa2 = pa3 = bf16x8{};
  SLOAD(0, 0); SLOAD(1, KVBLK); asm volatile("s_waitcnt vmcnt(0)" ::: "memory"); SWRITE(0, 0); SWRITE(1, 1);
  if (2 < NT) SLOAD(0, 2 * KVBLK);
  EBAR();
  if (wid >= 4) EBAR();
  for (int t = 0; t < NT; ++t) {
    SBAR(); __builtin_amdgcn_s_setprio(3); qkt(p0, p1, K_lds + (t & 3) * SHM_K, qr, r32, hi); SBAR();
    if (t > 0) pv_d0(o, vb0 + ((t - 1) & 3) * SHM_V, pa0, pa1, pa2, pa3);
    __builtin_amdgcn_s_setprio(0); EBAR();
    partialSM<ABL>(p0, p1, m_reg, al, t == 0);
    RESC(al);
    finishSM<ABL>(p0, p1, al, l_reg, pa0, pa1, pa2, pa3);
    if (t + 2 < NT) { asm volatile("s_waitcnt vmcnt(0)" ::: "memory"); SWRITE((t + 2) & 3, 0); }
    if (t + 3 < NT) SLOAD(0, (t + 3) * KVBLK);
    EBAR();
  }
  SBAR(); pv_d0(o, vb0 + ((NT - 1) & 3) * SHM_V, pa0, pa1, pa2, pa3);
  if (wid < 4) EBAR();
#undef EBAR
  if (hi == 0) li_l[r32] = l_reg; asm volatile("s_waitcnt lgkmcnt(0)" ::: "memory");
  float rli[16];
#pragma unroll
  for (int r = 0; r < 16; ++r) rli[r] = __builtin_amdgcn_rcpf(li_l[crow(r, hi)]);
  unsigned short* Ow = Og + (size_t)(q0 + wid * QBLK) * 512 + h * 64;
#pragma unroll
  for (int r = 0; r < 16; ++r) { int orow = crow(r, hi);
#pragma unroll
    for (int d0 = 0; d0 < 2; ++d0) Ow[(size_t)orow * 512 + d0 * 32 + r32] = (unsigned short)cvtpk(o[d0][r] * rli[r], 0.f); }
  __syncthreads();
#undef SLOAD
#undef SWRITE
#undef RESC
}
#undef KSWZ
#undef SBAR
}

namespace dil {
using bf16x8 = __attribute__((ext_vector_type(8))) short;
using s16x4  = __attribute__((ext_vector_type(4))) short;
using f32x16 = __attribute__((ext_vector_type(16))) float;
using u32x4  = __attribute__((ext_vector_type(4))) unsigned;
constexpr int TBL_PITCH = 2112;
constexpr int W_TBL = 0, W_K = 8448, W_V = 8448 + 4096, W_POS = 8448 + 8192, W_AL = W_POS + 128, W_BYTES = W_AL + 128;
__device__ __forceinline__ int crow(int r, int hi) { return (r & 3) + 8 * (r >> 2) + 4 * hi; }
__device__ __forceinline__ unsigned cvtpk(float lo, float hi) { unsigned r; asm volatile("v_cvt_pk_bf16_f32 %0, %1, %2" : "=v"(r) : "v"(lo), "v"(hi)); return r; }
#define DKSWZ(row, colB) ((row) * 128 + ((colB) ^ (((row) & 7) << 4)))
__device__ __forceinline__ int v_st(int k, int c) { const int kk = k;
  return ((kk >> 3) * 2 + (c >> 5)) * 512 + ((kk & 7) * 32 + (c & 31)) * 2; }
__device__ __forceinline__ int v_rd_base(int lane) { return ((lane & 3) << 3) | (((lane >> 2) & 3) << 6) | (((lane >> 4) & 1) << 5) | (((lane >> 5) & 1) << 8); }
constexpr int v_rd_off(int d0, int ks, int half) { return d0 * 512 + ks * 2048 + half * 1024; }
template <int OFF> __device__ __forceinline__ s16x4 tr_read(int vb) {
  s16x4 r; asm volatile("ds_read_b64_tr_b16 %0, %1 offset:%2" : "=&v"(r) : "v"(vb), "i"(OFF) : "memory"); return r;
}
template <int D0> __device__ __forceinline__ void pv_one(f32x16& od, int vb, bf16x8 pa0, bf16x8 pa1) {
  const s16x4 l0 = tr_read<v_rd_off(D0, 0, 0)>(vb), h0 = tr_read<v_rd_off(D0, 0, 1)>(vb), l1 = tr_read<v_rd_off(D0, 1, 0)>(vb), h1 = tr_read<v_rd_off(D0, 1, 1)>(vb);
  asm volatile("s_waitcnt lgkmcnt(0)" ::: "memory"); __builtin_amdgcn_sched_barrier(0);
#define PK(L, H) (bf16x8){L[0], L[1], L[2], L[3], H[0], H[1], H[2], H[3]}
  od = __builtin_amdgcn_mfma_f32_32x32x16_bf16(pa0, PK(l0, h0), od, 0, 0, 0);
  od = __builtin_amdgcn_mfma_f32_32x32x16_bf16(pa1, PK(l1, h1), od, 0, 0, 0);
#undef PK
}
struct KVRegs { bf16x8 k[4], v[4]; int pk; };
struct TaskId { int b, h, g, r, ub; };
__device__ __forceinline__ TaskId task_at(int i, int bx, int G, int wave) {
  TaskId t; int bh, k; t.b = 0; t.h = 0; t.g = 0; t.r = 0; t.ub = -1;
  if (G == 256) { if (i >= 6) return t; bh = (bx & 7) + 8 * (bx >> 6); k = ((((bx >> 3) & 7) * 6 + i) << 3) + wave; }
  else { const int id = (i * G + bx) * 8 + wave; if (id >= 12288) return t; bh = id / 384; k = id % 384; }
  const int g = k >> 7, kk = k & 127, nub = g == 0 ? 128 : (g == 1 ? 32 : 8);
  t.b = bh >> 3; t.h = bh & 7; t.g = g; t.r = kk / nub; t.ub = kk % nub; return t;
}
struct Pre { bf16x8 qr[4]; int pos_q; KVRegs R; };
__device__ __forceinline__ void load_blk(const unsigned short* __restrict__ qkv, const int* __restrict__ pos, const TaskId& t, int kb, KVRegs& R) {
  const int lane = threadIdx.x & 63, r32 = lane & 31, srow = lane >> 1, shalf = (lane & 1) * 32;
  const int dl = t.g == 0 ? 1 : (t.g == 1 ? 4 : 16), L = S / dl; const size_t rowb = (size_t)t.b * S;
  int up = 32 * (t.ub - 2 + kb) + srow; up = up < 0 ? 0 : (up >= L ? L - 1 : up);
  const unsigned short* base = qkv + (rowb + t.r + dl * up) * 1536 + t.h * 64 + shalf;
#pragma unroll
  for (int c = 0; c < 4; ++c) { R.k[c] = *reinterpret_cast<const bf16x8*>(base + 512 + c * 8); R.v[c] = *reinterpret_cast<const bf16x8*>(base + 1024 + c * 8); }
  int upl = 32 * (t.ub - 2 + kb) + r32; upl = upl < 0 ? 0 : (upl >= L ? L - 1 : upl);
  R.pk = pos[rowb + t.r + dl * upl];
}
__device__ __forceinline__ int kb_first(const TaskId& t) { return (t.ub >= 2) ? 0 : (2 - t.ub); }
__device__ __forceinline__ void dil_prefetch(const unsigned short* __restrict__ qkv, const int* __restrict__ pos, const TaskId& t, Pre& P) {
  const int lane = threadIdx.x & 63, r32 = lane & 31, hi = lane >> 5;
  const int dl = t.g == 0 ? 1 : (t.g == 1 ? 4 : 16); const size_t rowb = (size_t)t.b * S; const int tok_q = t.r + dl * (32 * t.ub + r32);
  const unsigned short* Qw = qkv + (rowb + tok_q) * 1536 + t.h * 64 + hi * 8;
#pragma unroll
  for (int d0 = 0; d0 < 4; ++d0) P.qr[d0] = *reinterpret_cast<const bf16x8*>(Qw + d0 * 16);
  P.pos_q = pos[rowb + tok_q];
  load_blk(qkv, pos, t, kb_first(t), P.R);
}
__device__ __forceinline__ void dil_task(const unsigned short* __restrict__ qkv, const int* __restrict__ pos, unsigned short* __restrict__ oap, float* __restrict__ lse,
                                         const TaskId t, Pre& P, bool has_next, const TaskId tn, char* wl  ) {
  const int lane = threadIdx.x & 63, r32 = lane & 31, hi = lane >> 5;
  const int b = t.b, h = t.h, g = t.g, r = t.r, ub = t.ub;
  const int dl = g == 0 ? 1 : (g == 1 ? 4 : 16), L = S / dl;
  const int u_q = 32 * ub + r32;
  const size_t rowb = (size_t)b * S;
  const int tok_q = r + dl * u_q;
  const float* tblw = (const float*)(wl + W_TBL); int* posw = (int*)(wl + W_POS); float* alw = (float*)(wl + W_AL);
  bf16x8 qr[4];
#pragma unroll
  for (int d0 = 0; d0 < 4; ++d0) qr[d0] = P.qr[d0];
  const int pos_q = P.pos_q;
  const int srow = lane >> 1, shalf = (lane & 1) * 32;
  const int vb0 = (int)(uintptr_t)(wl + W_V) + v_rd_base(lane);
  float m_reg = -1e30f, l_reg = 0.f; f32x16 o[2] = {};
  const int kb_lo = kb_first(t), kb_hi = (32 * (ub + 3) <= L) ? 4 : (4 - ((32 * (ub + 3) - L) >> 5));
  KVRegs R = P.R;
  for (int kb = kb_lo; kb <= kb_hi; ++kb) {
#pragma unroll
    for (int c = 0; c < 4; ++c) {
      *(bf16x8*)(wl + W_K + DKSWZ(srow, (shalf + c * 8) * 2)) = R.k[c];
      *(bf16x8*)(wl + W_V + v_st(srow, shalf + c * 8)) = R.v[c];
    }
    if (hi == 0) posw[r32] = R.pk;
    if (kb < kb_hi) load_blk(qkv, pos, t, kb + 1, R);
    asm volatile("s_waitcnt lgkmcnt(0)" ::: "memory"); __builtin_amdgcn_sched_barrier(0);
    f32x16 p = {};
#pragma unroll
    for (int d0 = 0; d0 < 4; ++d0) {
      const bf16x8 kf = *reinterpret_cast<const bf16x8*>(wl + W_K + DKSWZ(r32, (d0 * 16 + hi * 8) * 2));
      p = __builtin_amdgcn_mfma_f32_32x32x16_bf16(kf, qr[d0], p, 0, 0, 0);
    }
    float bmax;
    {
      int idx[16];
#pragma unroll
      for (int rr = 0; rr < 16; ++rr) { int rel = posw[crow(rr, hi)] - pos_q; rel = rel < -1024 ? -1024 : (rel > 1024 ? 1024 : rel); const int i_ = rel + 1024; idx[rr] = i_ ^ ((i_ >> 5) & 31); }
#pragma unroll
      for (int rr = 0; rr < 16; ++rr) p[rr] += tblw[idx[rr]];
    }
    if (kb == 0) {
#pragma unroll
      for (int rr = 0; rr < 16; ++rr) p[rr] = crow(rr, hi) >= r32 ? p[rr] : -INFINITY;
    } else if (kb == 4) {
#pragma unroll
      for (int rr = 0; rr < 16; ++rr) p[rr] = crow(rr, hi) <= r32 ? p[rr] : -INFINITY;
    }
    bmax = fmaxf(fmaxf(p[0], p[1]), fmaxf(p[2], p[3]));
#pragma unroll
    for (int rr = 4; rr < 16; rr += 4) bmax = fmaxf(bmax, fmaxf(fmaxf(p[rr], p[rr + 1]), fmaxf(p[rr + 2], p[rr + 3])));
    { auto x = __builtin_amdgcn_permlane32_swap(__float_as_uint(bmax), __float_as_uint(bmax), false, false); bmax = fmaxf(__uint_as_float(x[0]), __uint_as_float(x[1])); }
    float alpha = 1.f; bool resc = false;
    if (!__all(bmax - m_reg <= 11.5f)) { const float mn = fmaxf(m_reg, bmax); alpha = __builtin_amdgcn_exp2f(m_reg - mn); m_reg = mn; resc = true; }
    float ps = 0.f;
#pragma unroll
    for (int rr = 0; rr < 16; ++rr) p[rr] = __builtin_amdgcn_exp2f(p[rr] - m_reg);
    ps = ((p[0] + p[1]) + (p[2] + p[3])) + ((p[4] + p[5]) + (p[6] + p[7])) + (((p[8] + p[9]) + (p[10] + p[11])) + ((p[12] + p[13]) + (p[14] + p[15])));
    { auto x = __builtin_amdgcn_permlane32_swap(__float_as_uint(ps), __float_as_uint(ps), false, false); ps = __uint_as_float(x[0]) + __uint_as_float(x[1]); }
    l_reg = l_reg * alpha + ps;
    if (resc && kb != kb_lo) {
      if (hi == 0) alw[r32] = alpha;
      asm volatile("s_waitcnt lgkmcnt(0)" ::: "memory");
#pragma unroll
      for (int d = 0; d < 2; ++d)
#pragma unroll
        for (int rr = 0; rr < 16; ++rr) o[d][rr] *= alw[crow(rr, hi)];
    }
    bf16x8 pa0, pa1;
#define PK4(P, BASE, OUT) do { u32x4 w = {cvtpk(P[BASE + 0], P[BASE + 1]), cvtpk(P[BASE + 2], P[BASE + 3]), cvtpk(P[BASE + 4], P[BASE + 5]), cvtpk(P[BASE + 6], P[BASE + 7])}; \
    OUT = *reinterpret_cast<bf16x8*>(&w); } while (0)
    PK4(p, 0, pa0); PK4(p, 8, pa1);
#undef PK4
    pv_one<0>(o[0], vb0, pa0, pa1); pv_one<1>(o[1], vb0, pa0, pa1);
  }
  if (has_next) dil_prefetch(qkv, pos, tn, P);
  float* liw = alw;
  if (hi == 0) liw[r32] = l_reg;
  asm volatile("s_waitcnt lgkmcnt(0)" ::: "memory");
  if (hi == 0) lse[((size_t)g * T + rowb + tok_q) * 8 + h] = (m_reg + __log2f(l_reg)) * 0.6931471805599453f;
  unsigned short* Ow = oap + ((size_t)g * T + rowb + r + (size_t)dl * 32 * ub) * 512 + h * 64;
  char* ot = wl + W_K;
#pragma unroll
  for (int rr = 0; rr < 16; ++rr) { const int orow = crow(rr, hi); const float rl = __builtin_amdgcn_rcpf(liw[orow]);
#pragma unroll
    for (int d0 = 0; d0 < 2; ++d0) *(unsigned short*)(ot + orow * 144 + (d0 * 32 + r32) * 2) = (unsigned short)cvtpk(o[d0][rr] * rl, 0.f); }
  asm volatile("s_waitcnt lgkmcnt(0)" ::: "memory");
#pragma unroll
  for (int ps = 0; ps < 4; ++ps) { const int orow = ps * 8 + (lane >> 3), c = lane & 7;
    const u32x4 w = *(const u32x4*)(ot + orow * 144 + c * 16);
    *(u32x4*)(Ow + (size_t)orow * dl * 512 + c * 8) = w; }
  asm volatile("s_waitcnt lgkmcnt(0)" ::: "memory");
}
#undef DKSWZ
}

namespace mk {
#define GAS __attribute__((address_space(1)))
#define LAS __attribute__((address_space(3)))
typedef unsigned short bf16_t;
typedef unsigned v4u __attribute__((ext_vector_type(4)));
typedef unsigned v2u __attribute__((ext_vector_type(2)));
typedef float f32x4 __attribute__((ext_vector_type(4)));
#define LDS_WAIT() asm volatile("s_waitcnt lgkmcnt(0)" ::: "memory")
#define VM_WAIT() asm volatile("s_waitcnt vmcnt(0)" ::: "memory")
__device__ __forceinline__ unsigned f2bf(float f) { unsigned u = __builtin_bit_cast(unsigned, f); return (u + 0x7fffu + ((u >> 16) & 1u)) >> 16; }
typedef float f32x2_t __attribute__((ext_vector_type(2))); typedef __bf16 bf16x2_t __attribute__((ext_vector_type(2)));
__device__ __forceinline__ unsigned pk2(float lo, float hi) { const f32x2_t v = {lo, hi}; const bf16x2_t b = __builtin_convertvector(v, bf16x2_t); return __builtin_bit_cast(unsigned, b); }
__device__ __forceinline__ float bf2f(unsigned short b) { return __builtin_bit_cast(float, (unsigned)b << 16); }
__device__ __forceinline__ float wave_sum(float v) {
#pragma unroll
    for (int o = 1; o < 64; o <<= 1) v += __shfl_xor(v, o);
    return v;
}

#define XB_TMO      128
#define XB_XCNT(j)  (256  + 64 * (j))
#define XB_XSUB(j)  (1280 + 64 * (j))
#define XB_XGEN(j)  (2304 + 64 * (j))
#define XB_TOP      3328
#define XB_TOPGEN   3392
#define XCD_BAR_WORDS 3456
#define XB_SPIN_CAP (1u << 18)

__device__ __forceinline__ unsigned xb_ld(unsigned* p)              { return __hip_atomic_load(p, __ATOMIC_RELAXED, __HIP_MEMORY_SCOPE_AGENT); }
__device__ __forceinline__ unsigned xb_add(unsigned* p, unsigned v) { return __hip_atomic_fetch_add(p, v, __ATOMIC_RELAXED, __HIP_MEMORY_SCOPE_AGENT); }
__device__ __forceinline__ unsigned xb_xcc_id() { return (unsigned)__builtin_amdgcn_s_getreg((3 << 11) | 20) & 0xFu; }
#define XB_SPIN(cond, bar) do { unsigned _sp = 0; while (cond) { __builtin_amdgcn_s_sleep(1); \
    if ((++_sp & 255u) == 0u) { if (xb_ld(&(bar)[XB_TMO])) break; if (_sp > XB_SPIN_CAP) { atomicAdd(&(bar)[XB_TMO], 1u); break; } } } } while (0)

struct XcdBarrier {
    unsigned* bar; unsigned x;
    volatile LAS unsigned* st;
};

__device__ __forceinline__ XcdBarrier xcd_barrier_post(unsigned* bar, volatile LAS unsigned* st) {
    XcdBarrier b; b.bar = bar; b.x = xb_xcc_id(); b.st = st;
    if (threadIdx.x == 0) (void)xb_add(&bar[XB_XCNT(b.x)], 1u);
    return b;
}
__device__ __forceinline__ void xcd_barrier_complete(unsigned* bar, unsigned x, unsigned& nloc, unsigned& nx) {
    const unsigned G = gridDim.x * gridDim.y * gridDim.z;
    unsigned sum, cnt, mine, sp = 0u;
    for (;;) {
        sum = 0u; cnt = 0u; mine = 0u;
#pragma unroll
        for (unsigned j = 0; j < 16; ++j) { const unsigned c = xb_ld(&bar[XB_XCNT(j)]); sum += c; cnt += (c > 0u) ? 1u : 0u; mine = (j == x) ? c : mine; }
        if (sum == G) break;
        __builtin_amdgcn_s_sleep(1);
        if ((++sp & 255u) == 0u) { if (xb_ld(&bar[XB_TMO])) break; if (sp > XB_SPIN_CAP) { atomicAdd(&bar[XB_TMO], 1u); break; } }
    }
    nloc = mine > 0u ? mine : 1u; nx = cnt > 0u ? cnt : 1u;
}

__device__ __forceinline__ void xcd_barrier(const XcdBarrier& b) {
    asm volatile("s_waitcnt vmcnt(0)" ::: "memory");
    __syncthreads();
    if (threadIdx.x == 0) {
        unsigned* bar = b.bar;
        __builtin_amdgcn_s_waitcnt(0);
        unsigned nloc = b.st[0], nx = b.st[1];
        if (nloc == 0u) { xcd_barrier_complete(bar, b.x, nloc, nx); b.st[0] = nloc; b.st[1] = nx; }
        const unsigned old = xb_add(&bar[XB_XSUB(b.x)], 1u);
        const unsigned gen = old / nloc;
        if (old + 1u == (gen + 1u) * nloc) {
            __builtin_amdgcn_fence(__ATOMIC_RELEASE, "agent");
            asm volatile("s_waitcnt vmcnt(0)" ::: "memory");
            const unsigned og = xb_add(&bar[XB_TOP], 1u);
            const unsigned tg = og / nx;
            if (og + 1u == (tg + 1u) * nx) xb_add(&bar[XB_TOPGEN], 1u);
            else XB_SPIN(xb_ld(&bar[XB_TOPGEN]) == tg, bar);
            __builtin_amdgcn_fence(__ATOMIC_ACQUIRE, "agent");
            xb_add(&bar[XB_XGEN(b.x)], 1u);
            asm volatile("s_waitcnt vmcnt(0)" ::: "memory");
        } else {
            XB_SPIN(xb_ld(&bar[XB_XGEN(b.x)]) == gen, bar);
            __builtin_amdgcn_fence(__ATOMIC_ACQUIRE, "agent");
            asm volatile("s_waitcnt vmcnt(0)" ::: "memory");
        }
    }
    __syncthreads();
}

constexpr int NWAVES = 8;
constexpr int LDS_BYTES = 147456;
constexpr int RING_BYTES = 131072;
constexpr int CTRL_OFF = 135168;
constexpr int MISC_OFF = CTRL_OFF + 320;
constexpr size_t MiB = 1u << 20;
constexpr size_t WS_CTL = 0, CTL_ZERO_BYTES = 1 * MiB;
constexpr int CW_BAR = 16384;
constexpr size_t WS_WIN = 1 * MiB, WS_WQB = 5 * MiB, WS_WKVB = 5 * MiB + 512 * 1024, WS_WO = 6 * MiB, WS_WMQG = 8 * MiB, WS_WMKV = 10 * MiB, WS_WMO = 14 * MiB;
constexpr size_t WS_RSTDX = 16 * MiB, WS_RSTDM = 16 * MiB + 64 * 1024, WS_SSQQ = 16 * MiB + 256 * 1024, WS_SSQKV = 16 * MiB + 512 * 1024, WS_TBL = 16 * MiB + 768 * 1024;
constexpr size_t WS_WRG = 16 * MiB + 896 * 1024;
constexpr size_t WS_SSQH1 = 17 * MiB, WS_SSQH2 = 18 * MiB, WS_ZKPE = 20 * MiB, WS_CS = 22 * MiB;
constexpr size_t WS_XB = 24 * MiB, WS_MEMB = 56 * MiB, WS_KVMEM = 58 * MiB, WS_KPE = 62 * MiB;
constexpr size_t WS_QKVA = 64 * MiB, WS_ZQ = 112 * MiB, WS_ZKV = 120 * MiB, WS_QB = 124 * MiB, WS_KN = 148 * MiB, WS_VB = 164 * MiB;
constexpr size_t WS_WPT = 180 * MiB, WS_VWT = 188 * MiB, WS_H2 = 196 * MiB, WS_H2B = 260 * MiB, WS_ROUTE = 292 * MiB, WS_XS = 296 * MiB;
constexpr size_t WS_HMID = 296 * MiB, WS_OAP = 440 * MiB, WS_LSE = 488 * MiB, WS_OB = 490 * MiB, WS_OMIX = 506 * MiB;
constexpr size_t WS_H1 = 538 * MiB, WS_H1B = 602 * MiB, WS_P = 634 * MiB, WS_YBUF = 666 * MiB;
constexpr size_t WS_WGU = 794 * MiB, WS_WD = 922 * MiB, WS_END = 986 * MiB;

constexpr size_t WS_H2Q = 954 * MiB;
constexpr size_t WS_H1Q = 970 * MiB;
constexpr float XA8_MUL = 8.0f, XA8_INV = 0.125f, P8_MUL = 256.0f, P8_INV = 1.0f / 256.0f;
constexpr float Y8_MUL = 8.0f, Y8_INV = 0.125f;
constexpr float W8_MUL = 64.0f, W8_INV = 1.0f / 64.0f, HM8_MUL = 4.0f, HM8_INV = 0.25f;
struct Args { const float* in[26]; float* out; unsigned char* ws; double rope_rev[16]; int ph_lo, ph_hi, flags, pad; };

struct CvtDesc { const float* W; const float* gain; bf16_t* WT; int K, N, mode, item, f8; float mul; };
__device__ __forceinline__ unsigned pk4f8(float a, float b, float c, float d) { int w = __builtin_amdgcn_cvt_pk_fp8_f32(a, b, 0, false); w = __builtin_amdgcn_cvt_pk_fp8_f32(c, d, w, true); return (unsigned)w; }
__device__ __forceinline__ void cvt_load(const CvtDesc& d, f32x4 (&v)[16], int lane) {
    const int nblk = (d.N + 63) >> 6, kb = d.item / nblk, nb = d.item % nblk, k0 = 64 * kb, n0 = 64 * nb;
    const int lk = lane >> 4, ln = (lane & 15) * 4;
    const bool ok = n0 + ln < d.N;
    const float* wp = d.W + (size_t)(k0 + lk) * d.N + n0 + ln;
#pragma unroll
    for (int i = 0; i < 16; ++i) v[i] = ok ? __builtin_nontemporal_load((const f32x4*)(wp + (size_t)(4 * i) * d.N)) : (f32x4){0.f, 0.f, 0.f, 0.f};
}
__device__ __forceinline__ void cvt_store(const CvtDesc& d, f32x4 (&v)[16], LAS float* scr, int lane) {
    const int nblk = (d.N + 63) >> 6, kb = d.item / nblk, nb = d.item % nblk, k0 = 64 * kb, n0 = 64 * nb;
    const int lk = lane >> 4, ln = (lane & 15) * 4;
    if (d.gain) {
#pragma unroll
        for (int i = 0; i < 16; ++i) v[i] = v[i] * (d.gain[k0 + 4 * i + lk] * d.mul);
    } else if (d.f8) {
#pragma unroll
        for (int i = 0; i < 16; ++i) v[i] = v[i] * d.mul;
    }
#pragma unroll
    for (int i = 0; i < 16; ++i) { LAS float* p = scr + (4 * i + lk) * 65 + ln; p[0] = v[i][0]; p[1] = v[i][1]; p[2] = v[i][2]; p[3] = v[i][3]; }
    LDS_WAIT(); asm volatile("" ::: "memory");
    int drow0 = n0; if (d.mode == 1) { const int half = n0 >> 10, c = n0 & 1023; drow0 = (c >> 7) * 256 + half * 128 + (c & 127); }
    if (d.f8) {
        const int c = lane & 3;
#pragma unroll
        for (int j = 0; j < 4; ++j) { const int n = (lane >> 2) + 16 * j; const LAS float* sp = scr + (16 * c) * 65 + n;
            v4u o; o.x = pk4f8(sp[0 * 65], sp[1 * 65], sp[2 * 65], sp[3 * 65]); o.y = pk4f8(sp[4 * 65], sp[5 * 65], sp[6 * 65], sp[7 * 65]);
            o.z = pk4f8(sp[8 * 65], sp[9 * 65], sp[10 * 65], sp[11 * 65]); o.w = pk4f8(sp[12 * 65], sp[13 * 65], sp[14 * 65], sp[15 * 65]);
            __builtin_nontemporal_store(o, (v4u*)((unsigned char*)d.WT + (size_t)(drow0 + n) * d.K + k0 + 16 * c)); }
    } else {
    const int c = lane & 7;
#pragma unroll
    for (int j = 0; j < 8; ++j) { const int n = (lane >> 3) + 8 * j; const LAS float* sp = scr + (8 * c) * 65 + n;
        v4u o; o.x = pk2(sp[0 * 65], sp[1 * 65]); o.y = pk2(sp[2 * 65], sp[3 * 65]); o.z = pk2(sp[4 * 65], sp[5 * 65]); o.w = pk2(sp[6 * 65], sp[7 * 65]);
        __builtin_nontemporal_store(o, (v4u*)(d.WT + (size_t)(drow0 + n) * d.K + k0 + 8 * c)); }
    }
    LDS_WAIT(); asm volatile("" ::: "memory");
}
__device__ __forceinline__ void prep_rows4(const float* x0, bf16_t* o0, float* rstd_out, int lane) {
    f32x4 v[4][4]; float s[4];
#pragma unroll
    for (int r = 0; r < 4; ++r)
#pragma unroll
        for (int j = 0; j < 4; ++j) v[r][j] = ((const f32x4*)(x0 + (size_t)r * 1024))[lane + 64 * j];
#pragma unroll
    for (int r = 0; r < 4; ++r) { float a = 0.f;
#pragma unroll
        for (int j = 0; j < 4; ++j) a += (v[r][j].x * v[r][j].x + v[r][j].y * v[r][j].y) + (v[r][j].z * v[r][j].z + v[r][j].w * v[r][j].w);
        s[r] = wave_sum(a); }
    if (lane < 4) rstd_out[lane] = 1.0f / sqrtf((lane == 0 ? s[0] : lane == 1 ? s[1] : lane == 2 ? s[2] : s[3]) * (1.0f / 1024.0f) + 1e-6f);
#pragma unroll
    for (int r = 0; r < 4; ++r) { unsigned long long* o8 = (unsigned long long*)(o0 + (size_t)r * 1024) + lane;
#pragma unroll
        for (int j = 0; j < 4; ++j) o8[64 * j] = (unsigned long long)pk2(v[r][j].x, v[r][j].y) | ((unsigned long long)pk2(v[r][j].z, v[r][j].w) << 32); }
}

__device__ __forceinline__ v4u pack8(const f32x4 a, const f32x4 b) { v4u w; w.x = pk2(a[0], a[1]); w.y = pk2(a[2], a[3]); w.z = pk2(b[0], b[1]); w.w = pk2(b[2], b[3]); return w; }
__device__ __forceinline__ float sq8(const f32x4 a, const f32x4 b) { return (a[0] * a[0] + a[1] * a[1]) + (a[2] * a[2] + a[3] * a[3]) + (b[0] * b[0] + b[1] * b[1]) + (b[2] * b[2] + b[3] * b[3]); }

struct EpiInProj {
    static constexpr bool PERM = true, AFTER_DRAIN = false;
    const float* rstd; bf16_t* qkv; bf16_t* zq; bf16_t* zkv; float* zkpe; float* ssq_q; float* ssq_kv;
    __device__ __forceinline__ void operator()(const pg8::f32x4 (&acc)[2][2][4][2], const pg8::Unit& u, int wr, int wc, int fr, int fq) const {
        const int row0 = u.pm * 256 + wr * 64 + fr;
        const float qs = u.pn < 2 ? 0.125f * 1.4426950408889634f : 1.0f;
        float rsv[8];
#pragma unroll
        for (int q = 0; q < 8; ++q) rsv[q] = rstd[row0 + (q >> 2) * 128 + (q & 3) * 16];
#pragma unroll
        for (int ai = 0; ai < 2; ++ai)
#pragma unroll
            for (int m = 0; m < 4; ++m) {
                const int row = row0 + ai * 128 + m * 16;
                const float rs = rsv[ai * 4 + m];
                float ss = 0.f;
#pragma unroll
                for (int bj = 0; bj < 2; ++bj) {
                    const f32x4 v0 = acc[ai][bj][m][0] * rs, v1 = acc[ai][bj][m][1] * rs;
                    const int ct = bj * 128 + wc * 32 + 8 * fq;
                    if (u.pn < 6) { *(v4u*)(qkv + (size_t)row * 1536 + u.pn * 256 + ct) = pack8(v0 * qs, v1 * qs); }
                    else if (u.pn == 6) { *(v4u*)(zq + (size_t)row * 256 + ct) = pack8(v0, v1); ss += sq8(v0, v1); }
                    else if (bj == 0) { *(v4u*)(zkv + (size_t)row * 128 + ct) = pack8(v0, v1); ss += sq8(v0, v1); }
                    else if (wc == 0) { *(f32x4*)(zkpe + (size_t)row * 32 + 8 * fq) = v0; *(f32x4*)(zkpe + (size_t)row * 32 + 8 * fq + 4) = v1; }
                }
                if (u.pn >= 6) { ss += __shfl_xor(ss, 16); ss += __shfl_xor(ss, 32); if (fq == 0) (u.pn == 6 ? ssq_q : ssq_kv)[(size_t)row * 4 + wc] = ss; }
            }
    }
};


struct EpiQ {
    static constexpr bool PERM = true, AFTER_DRAIN = false;
    const float* ssq; bf16_t* Q;
    __device__ __forceinline__ void operator()(const pg8::f32x4 (&acc)[2][2][4][2], const pg8::Unit& u, int wr, int wc, int fr, int fq) const {
        const int row0 = u.pm * 256 + wr * 64 + fr;
#pragma unroll
        for (int ai = 0; ai < 2; ++ai)
#pragma unroll
            for (int m = 0; m < 4; ++m) {
                const int row = row0 + ai * 128 + m * 16;
                const f32x4 sp = *(const f32x4*)(ssq + (size_t)row * 4);
                const float rs = (0.10206207261596577f * 1.4426950408889634f) / sqrtf(((sp[0] + sp[1]) + (sp[2] + sp[3])) * (1.0f / 256.0f) + 1e-6f);
#pragma unroll
                for (int bj = 0; bj < 2; ++bj)
                    *(v4u*)(Q + (size_t)row * 768 + u.pn * 256 + bj * 128 + wc * 32 + 8 * fq) = pack8(acc[ai][bj][m][0] * rs, acc[ai][bj][m][1] * rs);
            }
    }
};
struct EpiKV {
    static constexpr bool PERM = true, AFTER_DRAIN = false;
    const float* ssq; bf16_t* Kn; bf16_t* Vb;
    __device__ __forceinline__ void operator()(const pg8::f32x4 (&acc)[2][2][4][2], const pg8::Unit& u, int wr, int wc, int fr, int fq) const {
        const int row0 = u.pm * 256 + wr * 64 + fr;
        bf16_t* dst = (wc < 2 ? Kn : Vb) + (wc & 1) * 32 + 8 * fq;
#pragma unroll
        for (int ai = 0; ai < 2; ++ai)
#pragma unroll
            for (int m = 0; m < 4; ++m) {
                const int row = row0 + ai * 128 + m * 16;
                const f32x4 sp = *(const f32x4*)(ssq + (size_t)row * 4);
                const float rs = 1.0f / sqrtf(((sp[0] + sp[1]) + (sp[2] + sp[3])) * (1.0f / 128.0f) + 1e-6f);
#pragma unroll
                for (int bj = 0; bj < 2; ++bj)
                    *(v4u*)(dst + (size_t)row * 512 + (u.pn * 2 + bj) * 64) = pack8(acc[ai][bj][m][0] * rs, acc[ai][bj][m][1] * rs);
            }
    }
};
struct EpiRowScale {
    static constexpr bool PERM = true, AFTER_DRAIN = false;
    const float* rs; bf16_t* O; int ldc;
    __device__ __forceinline__ void operator()(const pg8::f32x4 (&acc)[2][2][4][2], const pg8::Unit& u, int wr, int wc, int fr, int fq) const {
        const int row0 = u.pm * 256 + wr * 64 + fr;
#pragma unroll
        for (int ai = 0; ai < 2; ++ai)
#pragma unroll
            for (int m = 0; m < 4; ++m) {
                const int row = row0 + ai * 128 + m * 16;
                const float r = rs[row];
#pragma unroll
                for (int bj = 0; bj < 2; ++bj)
                    *(v4u*)(O + (size_t)row * ldc + u.pn * 256 + bj * 128 + wc * 32 + 8 * fq) = pack8(acc[ai][bj][m][0] * r, acc[ai][bj][m][1] * r);
            }
    }
};

template <bool BASE_BF16, bool F8OUT = false> struct EpiResid {
    static constexpr bool PERM = true, AFTER_DRAIN = false;
    const void* base; bf16_t* outb; float* ssq; unsigned char* outq; float ascale;
    __device__ __forceinline__ void operator()(const pg8::f32x4 (&acc)[2][2][4][2], const pg8::Unit& u, int wr, int wc, int fr, int fq) const {
        const int row0 = u.pm * 256 + wr * 64 + fr;
#pragma unroll
        for (int ai = 0; ai < 2; ++ai)
#pragma unroll
            for (int m = 0; m < 4; ++m) {
                const int row = row0 + ai * 128 + m * 16;
                float ss = 0.f;
#pragma unroll
                for (int bj = 0; bj < 2; ++bj) {
                    const size_t o = (size_t)row * 1024 + u.pn * 256 + bj * 128 + wc * 32 + 8 * fq;
                    f32x4 b0, b1;
                    if constexpr (BASE_BF16) { const v4u w = *(const v4u*)((const bf16_t*)base + o);
                        b0 = (f32x4){__builtin_bit_cast(float, w[0] << 16), __builtin_bit_cast(float, w[0] & 0xffff0000u), __builtin_bit_cast(float, w[1] << 16), __builtin_bit_cast(float, w[1] & 0xffff0000u)};
                        b1 = (f32x4){__builtin_bit_cast(float, w[2] << 16), __builtin_bit_cast(float, w[2] & 0xffff0000u), __builtin_bit_cast(float, w[3] << 16), __builtin_bit_cast(float, w[3] & 0xffff0000u)}; }
                    else { b0 = *(const f32x4*)((const float*)base + o); b1 = *(const f32x4*)((const float*)base + o + 4); }
                    const f32x4 v0 = acc[ai][bj][m][0] * ascale + b0, v1 = acc[ai][bj][m][1] * ascale + b1;
                    *(v4u*)(outb + o) = pack8(v0, v1); ss += sq8(v0, v1);
                    if constexpr (F8OUT) *(v2u*)(outq + o) = (v2u){pk4f8(v0[0], v0[1], v0[2], v0[3]), pk4f8(v1[0], v1[1], v1[2], v1[3])};
                }
                ss += __shfl_xor(ss, 16); ss += __shfl_xor(ss, 32);
                if (fq == 0) ssq[(size_t)row * 16 + u.pn * 4 + wc] = ss;
                asm volatile("" ::: "memory");
            }
    }
};
struct EpiPlain {
    static constexpr bool PERM = true, AFTER_DRAIN = false;
    unsigned char* O; int ldc;
    __device__ __forceinline__ void operator()(const pg8::f32x4 (&acc)[2][2][4][2], const pg8::Unit& u, int wr, int wc, int fr, int fq) const {
        const int row0 = u.pm * 256 + wr * 64 + fr;
#pragma unroll
        for (int ai = 0; ai < 2; ++ai)
#pragma unroll
            for (int m = 0; m < 4; ++m)
#pragma unroll
                for (int bj = 0; bj < 2; ++bj) { const f32x4 a = acc[ai][bj][m][0] * XA8_MUL, b = acc[ai][bj][m][1] * XA8_MUL;
                    *(v2u*)(O + (size_t)(row0 + ai * 128 + m * 16) * ldc + u.pn * 256 + bj * 128 + wc * 32 + 8 * fq) = (v2u){pk4f8(a[0], a[1], a[2], a[3]), pk4f8(b[0], b[1], b[2], b[3])}; }
    }
};
struct EpiSoftmax {
    static constexpr bool PERM = true, AFTER_DRAIN = true;
    unsigned char* P; int rsl_off;
    __device__ __forceinline__ void fused(pg8::f32x4 (&acc)[2][2][4][2], const pg8::Unit& u, int wr, int wc, int fr, int fq, PG8_LAS unsigned char* lds, int wid, int lane) const {
        typedef float f32x2v __attribute__((ext_vector_type(2)));
        const PG8_LAS float* rsl = (const PG8_LAS float*)(lds + rsl_off);
        PG8_LAS f32x2v* X = (PG8_LAS f32x2v*)lds;
        constexpr float L2E = 1.4426950408889634f;
#pragma unroll
        for (int ai = 0; ai < 2; ++ai)
#pragma unroll
            for (int m = 0; m < 4; ++m) {
                const int rt = ai * 128 + wr * 64 + m * 16 + fr;
                const float rs = rsl[rt] * (0.0625f * L2E * XA8_INV);
                float mx = -3.0e38f;
#pragma unroll
                for (int bj = 0; bj < 2; ++bj)
#pragma unroll
                    for (int n = 0; n < 2; ++n) { f32x4 v = acc[ai][bj][m][n] * rs; acc[ai][bj][m][n] = v; mx = fmaxf(mx, fmaxf(fmaxf(v[0], v[1]), fmaxf(v[2], v[3]))); }
                mx = fmaxf(mx, __shfl_xor(mx, 16)); mx = fmaxf(mx, __shfl_xor(mx, 32));
                float sm = 0.f;
#pragma unroll
                for (int bj = 0; bj < 2; ++bj)
#pragma unroll
                    for (int n = 0; n < 2; ++n) { const f32x4 v = acc[ai][bj][m][n]; sm += (__builtin_amdgcn_exp2f(v[0] - mx) + __builtin_amdgcn_exp2f(v[1] - mx)) + (__builtin_amdgcn_exp2f(v[2] - mx) + __builtin_amdgcn_exp2f(v[3] - mx)); }
                sm += __shfl_xor(sm, 16); sm += __shfl_xor(sm, 32);
                if (fq == 0) X[rt * 4 + wc] = (f32x2v){mx, sm};
            }
        asm volatile("s_waitcnt lgkmcnt(0)" ::: "memory"); __builtin_amdgcn_s_barrier(); asm volatile("" ::: "memory");
#pragma unroll
        for (int ai = 0; ai < 2; ++ai)
#pragma unroll
            for (int m = 0; m < 4; ++m) {
                const int rt = ai * 128 + wr * 64 + m * 16 + fr;
                const f32x2v x0 = X[rt * 4 + 0], x1 = X[rt * 4 + 1], x2 = X[rt * 4 + 2], x3 = X[rt * 4 + 3];
                const float M = fmaxf(fmaxf(x0.x, x1.x), fmaxf(x2.x, x3.x));
                const float tot = (x0.y * __builtin_amdgcn_exp2f(x0.x - M) + x1.y * __builtin_amdgcn_exp2f(x1.x - M)) + (x2.y * __builtin_amdgcn_exp2f(x2.x - M) + x3.y * __builtin_amdgcn_exp2f(x3.x - M));
                const float inv = P8_MUL / tot;
#pragma unroll
                for (int bj = 0; bj < 2; ++bj) {
                    f32x4 a = acc[ai][bj][m][0], b = acc[ai][bj][m][1];
#pragma unroll
                    for (int j = 0; j < 4; ++j) { a[j] = __builtin_amdgcn_exp2f(a[j] - M) * inv; b[j] = __builtin_amdgcn_exp2f(b[j] - M) * inv; }
                    *(v2u*)(P + (size_t)(u.pm * 256 + rt) * 1024 + u.pn * 256 + bj * 128 + wc * 32 + 8 * fq) = (v2u){pk4f8(a[0], a[1], a[2], a[3]), pk4f8(b[0], b[1], b[2], b[3])};
                }
            }
    }
};
struct OrderWp {
    int c;
    __device__ __forceinline__ bool next(int i, pg8::Unit& u) const { if (i > 0 || c >= 64) return false; const int bhh = c >> 2, pn = c & 3, b = bhh >> 2, h = bhh & 3;
        u.pm = bhh; u.pn = pn; u.aoff = ((size_t)(b * 256) * 2048 + h * 256) * 2; u.boff = ((size_t)(pn * 256) * 1024 + h * 256) * 2; return true; }
    __device__ __forceinline__ void a_ready(const pg8::Unit&) const {}
    __device__ __forceinline__ void done(const pg8::Unit&) const {}
};
struct OrderVw {
    int c;
    __device__ __forceinline__ bool next(int i, pg8::Unit& u) const { if (i > 0 || c >= 64) return false; const int b = c >> 4, ct = (c >> 2) & 3, h = c & 3;
        u.pm = b * 4 + ct; u.pn = h; u.aoff = ((size_t)(ct * 256) * 1024 + h * 256) * 2; u.boff = ((size_t)(b * 256) * 2048 + 1024 + h * 256) * 2; return true; }
    __device__ __forceinline__ void a_ready(const pg8::Unit&) const {}
    __device__ __forceinline__ void done(const pg8::Unit&) const {}
};
struct OrderBatch {
    pg8::StaticOrder so;
    __device__ __forceinline__ bool next(int i, pg8::Unit& u) const { if (!so.next(i, u)) return false; u.boff = ((size_t)((u.pm >> 4) * 1024 + u.pn * 256) * 1024); return true; }
    __device__ __forceinline__ void a_ready(const pg8::Unit&) const {}
    __device__ __forceinline__ void done(const pg8::Unit&) const {}
};

constexpr int MPADN = NA + NE * 256, NTILEN = MPADN / 256;
constexpr int CW_GCOUNT = 8192;
constexpr size_t RT_TOPI = 0, RT_TOPG = 256 * 1024, RT_SLOT = 512 * 1024, RT_ROWFLAT = 768 * 1024, RT_RSROW = 1088 * 1024, RT_RSTD = 1408 * 1024, RT_CNT = 1536 * 1024, RT_TOT = 1600 * 1024, RT_RGATE = 1664 * 1024;
constexpr int LX_TEXP = CTRL_OFF + 2048;
struct OrderMoe {
    const LAS int* texp; int nper, c, G; size_t ebytes;
    __device__ __forceinline__ bool next(int i, pg8::Unit& u) const {
        const int L = i * G + (c & 7) * (G >> 3) + (c >> 3); const int tile = L / nper, pn = L % nper;
        if (tile >= texp[NTILEN]) return false;
        u.pm = tile; u.pn = pn; u.aoff = (size_t)tile * 256 * 1024; u.boff = (size_t)texp[tile] * ebytes + (size_t)pn * 256 * 1024; return true; }
    __device__ __forceinline__ void a_ready(const pg8::Unit&) const {}
    __device__ __forceinline__ void done(const pg8::Unit&) const {}
};
__device__ __forceinline__ float swiglu1(float g, float u) { g = fminf(g, 7.0f); u = fminf(fmaxf(u, -7.0f), 7.0f); return (u + 1.0f) * g * __builtin_amdgcn_rcpf(1.0f + __builtin_amdgcn_exp2f(-1.702f * 1.4426950408889634f * g)); }
struct EpiSwiGLU {
    static constexpr bool PERM = true, AFTER_DRAIN = false;
    const float* rs_row; const float* bgu; unsigned char* hmid; const LAS int* texp;
    __device__ __forceinline__ void operator()(const pg8::f32x4 (&acc)[2][2][4][2], const pg8::Unit& u, int wr, int wc, int fr, int fq) const {
        const int row0 = u.pm * 256 + wr * 64 + fr, e = texp[u.pm], c0 = u.pn * 128 + wc * 32 + 8 * fq;
        const float* bg = bgu + (size_t)e * 2048 + c0;
        const f32x4 bg0 = *(const f32x4*)bg, bg1 = *(const f32x4*)(bg + 4), bu0 = *(const f32x4*)(bg + 1024), bu1 = *(const f32x4*)(bg + 1028);
        float rsv[8];
#pragma unroll
        for (int q = 0; q < 8; ++q) rsv[q] = rs_row[row0 + (q >> 2) * 128 + (q & 3) * 16] * W8_INV;
#pragma unroll
        for (int ai = 0; ai < 2; ++ai)
#pragma unroll
            for (int m = 0; m < 4; ++m) {
                const int row = row0 + ai * 128 + m * 16; const float rs = rsv[ai * 4 + m];
                const f32x4 g0 = acc[ai][0][m][0] * rs + bg0, g1 = acc[ai][0][m][1] * rs + bg1, u0 = acc[ai][1][m][0] * rs + bu0, u1 = acc[ai][1][m][1] * rs + bu1;
                f32x4 h0, h1;
#pragma unroll
                for (int j = 0; j < 4; ++j) { h0[j] = swiglu1(g0[j], u0[j]) * HM8_MUL; h1[j] = swiglu1(g1[j], u1[j]) * HM8_MUL; }
                *(v2u*)(hmid + (size_t)row * 1024 + c0) = (v2u){pk4f8(h0[0], h0[1], h0[2], h0[3]), pk4f8(h1[0], h1[1], h1[2], h1[3])};
            }
    }
};
struct EpiDown {
    static constexpr bool PERM = true, AFTER_DRAIN = false;
    const int* row_flat; const float* topg; const float* bd; unsigned char* ybuf; const LAS int* texp;
    __device__ __forceinline__ void operator()(const pg8::f32x4 (&acc)[2][2][4][2], const pg8::Unit& u, int wr, int wc, int fr, int fq) const {
        const int row0 = u.pm * 256 + wr * 64 + fr, e = texp[u.pm], c0 = u.pn * 256 + wc * 32 + 8 * fq;
        const float* bp = bd + (size_t)e * 1024 + c0;
        f32x4 bv[2][2];
#pragma unroll
        for (int bj = 0; bj < 2; ++bj) { bv[bj][0] = *(const f32x4*)(bp + bj * 128); bv[bj][1] = *(const f32x4*)(bp + bj * 128 + 4); }
        int av[8]; float gv[8];
#pragma unroll
        for (int q = 0; q < 8; ++q) { const int row = row0 + (q >> 2) * 128 + (q & 3) * 16; av[q] = row_flat[row]; gv[q] = topg[row]; }
#pragma unroll
        for (int ai = 0; ai < 2; ++ai)
#pragma unroll
            for (int m = 0; m < 4; ++m) {
                const int a = av[ai * 4 + m];
                if (a >= 0) { const float gt = gv[ai * 4 + m] * Y8_MUL;
#pragma unroll
                    for (int bj = 0; bj < 2; ++bj) { const f32x4 y0 = (acc[ai][bj][m][0] * (W8_INV * HM8_INV) + bv[bj][0]) * gt, y1 = (acc[ai][bj][m][1] * (W8_INV * HM8_INV) + bv[bj][1]) * gt;
                        *(v2u*)(ybuf + (size_t)a * 1024 + c0 + bj * 128) = (v2u){pk4f8(y0[0], y0[1], y0[2], y0[3]), pk4f8(y1[0], y1[1], y1[2], y1[3])}; } }
            }
    }
};

__device__ __forceinline__ int rel_bucket_d(int rel) {
    int n = rel < 0 ? -rel : rel;
    int b;
    if (n < 8) b = n; else if (n < 15) b = 8; else if (n < 27) b = 9; else if (n < 50) b = 10; else if (n < 91) b = 11;
    else if (n < 166) b = 12; else if (n < 305) b = 13; else if (n < 559) b = 14; else b = 15;
    return b + (rel > 0 ? 16 : 0);
}

static_assert(pg8::GTAB == CTRL_OFF + 4096 && pg8::GTAB + pg8::GTAB_UNITS * 512 <= LDS_BYTES && (NTILEN * 8 + 255) / 256 <= pg8::GTAB_UNITS && NWAVES * dil::W_BYTES <= CTRL_OFF && mla::SHM_ATTN <= CTRL_OFF && RING_BYTES <= CTRL_OFF && LX_TEXP + 4 * (NTILEN + 1) <= LDS_BYTES, "LDS map");
__global__ void __launch_bounds__(NWAVES * 64, 2) mk_fwd(Args args) {
    extern __shared__ __attribute__((aligned(16))) unsigned char lds_raw[];
    LAS unsigned char* lds = (LAS unsigned char*)lds_raw;
    const int tid = threadIdx.x, lane = tid & 63, wave = __builtin_amdgcn_readfirstlane(tid >> 6);
    const int G = gridDim.x; const int bx = blockIdx.x; const int vcu = (G % 8 == 0) ? (bx % 8) * (G / 8) + bx / 8 : bx;
    unsigned char* ws = args.ws;
    const int lo = args.ph_lo, hi = args.ph_hi;
#define IN(k) (lo <= (k) && (k) < hi)
#define BOTH(k) (IN(k) && IN((k) + 1))
    for (int u = tid; u < (LDS_BYTES - CTRL_OFF) / 4; u += NWAVES * 64) ((LAS unsigned*)(lds + CTRL_OFF))[u] = 0u;
    __syncthreads();
    XcdBarrier bar; bar.bar = (unsigned*)(ws + WS_CTL) + CW_BAR; bar.x = 0; bar.st = nullptr;
    if (hi - lo > 1) bar = xcd_barrier_post((unsigned*)(ws + WS_CTL) + CW_BAR, (volatile LAS unsigned*)(lds + MISC_OFF) + 8);
#define GRID_BAR(k) do { if (BOTH(k)) xcd_barrier(bar); } while (0)
    const float* x = args.in[0]; const float* mem = args.in[1]; const float* g_mix = args.in[3]; const float* w_in = args.in[4];
    const float* g_q_a = args.in[5]; const float* w_q_b = args.in[6]; const float* g_kv_a = args.in[7]; const float* w_kv_b = args.in[8];
    const float* w_o = args.in[12]; const float* g_xattn = args.in[13]; const float* g_mem = args.in[14]; const float* w_mq = args.in[15];
    const float* w_mkv = args.in[16]; const float* w_mo = args.in[17]; const float* g_moe = args.in[18];
    const float* w_gate_up = args.in[21]; const float* w_down = args.in[23];
    bf16_t* WinT = (bf16_t*)(ws + WS_WIN); bf16_t* WqbT = (bf16_t*)(ws + WS_WQB); bf16_t* WkvbT = (bf16_t*)(ws + WS_WKVB); bf16_t* WoT = (bf16_t*)(ws + WS_WO);
    bf16_t* Wmqg = (bf16_t*)(ws + WS_WMQG); bf16_t* WmkvT = (bf16_t*)(ws + WS_WMKV); bf16_t* WmoT = (bf16_t*)(ws + WS_WMO);
    bf16_t* WguT = (bf16_t*)(ws + WS_WGU); bf16_t* WdT = (bf16_t*)(ws + WS_WD);
    bf16_t* xb = (bf16_t*)(ws + WS_XB); bf16_t* memb = (bf16_t*)(ws + WS_MEMB);
    float* rstd_x = (float*)(ws + WS_RSTDX); float* rstd_mem = (float*)(ws + WS_RSTDM);

    if (IN(0)) {
        LAS float* scr = (LAS float*)(lds + wave * 16640);
        const int gw = vcu * NWAVES + wave, NGW = G * NWAVES;
        constexpr int I_IN = 16 * 31, I_QB = 4 * 12, I_KVB = 2 * 16, I_O = 16 * 16, I_MKV = 16 * 32, I_MO = 16 * 16, I_GU = 16 * 32, I_D = 16 * 16;
        const int n_exp = (args.flags & 1) ? 32 : 0;
        const int NITEMS = I_IN + I_QB + I_KVB + I_O + I_MKV + I_MO + n_exp * (I_GU + I_D);
        auto desc = [&](int it) {
            CvtDesc d; int r = it; d.mode = 0; d.f8 = 0; d.mul = 1.0f;
            if (r < I_IN) { d.W = w_in; d.K = 1024; d.N = 1952; d.gain = g_mix; d.WT = WinT; }
            else if ((r -= I_IN) < I_QB) { d.W = w_q_b; d.K = 256; d.N = 768; d.gain = g_q_a; d.WT = WqbT; }
            else if ((r -= I_QB) < I_KVB) { d.W = w_kv_b; d.K = 128; d.N = 1024; d.gain = g_kv_a; d.WT = WkvbT; }
            else if ((r -= I_KVB) < I_O) { d.W = w_o; d.K = 1024; d.N = 1024; d.gain = nullptr; d.WT = WoT; }
            else if ((r -= I_O) < I_MKV) { d.W = w_mkv; d.K = 1024; d.N = 2048; d.gain = g_mem; d.WT = WmkvT; }
            else if ((r -= I_MKV) < I_MO) { d.W = w_mo; d.K = 1024; d.N = 1024; d.gain = nullptr; d.WT = WmoT; }
            else if ((r -= I_MO) < 32 * I_GU) { const int e = r / I_GU; r -= e * I_GU; d.W = w_gate_up + (size_t)e * 1024 * 2048; d.K = 1024; d.N = 2048; d.gain = g_moe; d.WT = (bf16_t*)((unsigned char*)WguT + (size_t)e * 2048 * 1024); d.mode = 1; d.f8 = 1; d.mul = W8_MUL; }
            else { r -= 32 * I_GU; const int e = r / I_D; r -= e * I_D; d.W = w_down + (size_t)e * 1024 * 1024; d.K = 1024; d.N = 1024; d.gain = nullptr; d.WT = (bf16_t*)((unsigned char*)WdT + (size_t)e * 1024 * 1024); d.f8 = 1; d.mul = W8_MUL; }
            d.item = r; return d; };
        {
            f32x4 va[16], vb[16]; CvtDesc dc = desc(0), dn = dc; bool have = false;
            for (int it = gw; ; it += NGW) {
                const bool more = it < NITEMS;
                if (more) { dn = desc(it); cvt_load(dn, vb, lane); }
                if (have) cvt_store(dc, va, scr, lane);
                if (!more) break;
#pragma unroll
                for (int i = 0; i < 16; ++i) va[i] = vb[i];
                dc = dn; have = true;
            }
        }
        for (int i = gw * 64 + lane; i < 64 * 1024 / 8; i += NGW * 64) ((v4u*)(WinT + (size_t)1984 * 1024))[i] = (v4u){0u, 0u, 0u, 0u};
        for (int m = gw * 4; m < T; m += NGW * 4) prep_rows4(x + (size_t)m * D, xb + (size_t)m * D, rstd_x + m, lane);
        for (int m = gw * 4; m < NB * NMEM; m += NGW * 4) prep_rows4(mem + (size_t)m * D, memb + (size_t)m * D, rstd_mem + m, lane);
        { const float* w_router = args.in[19]; float* wrg = (float*)(ws + WS_WRG); for (int i = bx * 512 + tid; i < 1024 * 32; i += G * 512) wrg[i] = w_router[i] * g_moe[i >> 5]; }
        for (int m = gw; m < D; m += NGW) {
            const f32x4* xr = (const f32x4*)(w_mq + (size_t)m * D) + lane; const float gc = g_xattn[m];
            unsigned long long* o8 = (unsigned long long*)(Wmqg + (size_t)m * D) + lane;
#pragma unroll
            for (int j = 0; j < 4; ++j) { const f32x4 v = xr[64 * j] * gc; o8[64 * j] = (unsigned long long)pk2(v.x, v.y) | ((unsigned long long)pk2(v.z, v.w) << 32); }
        }
    }
    if (IN(0)) {
        const float* rel_bias = args.in[9]; float* tbl = (float*)(ws + WS_TBL);
        for (int i = bx * 512 + tid; i < 8 * 2049; i += G * 512) { const int h = i / 2049, r = i % 2049; tbl[h * 2112 + r] = rel_bias[rel_bucket_d(r - 1024) * 8 + h]; }
    }
    GRID_BAR(0);
    if (IN(1)) {
        int kx = 1024; asm volatile("" : "+s"(kx)); pg8::Gemm g{xb, WinT, kx, kx, kx}; pg8::StaticOrder S; S.init(T, 2048, 1024, 1024, G, bx);
        EpiInProj E{rstd_x, (bf16_t*)(ws + WS_QKVA), (bf16_t*)(ws + WS_ZQ), (bf16_t*)(ws + WS_ZKV), (float*)(ws + WS_ZKPE), (float*)(ws + WS_SSQQ), (float*)(ws + WS_SSQKV)};
        pg8::gemm_phase<EpiInProj, pg8::StaticOrder, true, true>(lds, g, S, E);
    }
    GRID_BAR(1);
    if (IN(2)) {
        const int* pos = (const int*)args.in[2];
        float* cs = (float*)(ws + WS_CS); const float* zkpe = (const float*)(ws + WS_ZKPE); bf16_t* kpe = (bf16_t*)(ws + WS_KPE);
        for (int i = bx * 512 + tid; i < T * 16; i += G * 512) {
            const int t = i >> 4, j = i & 15;
            const double rev = (double)pos[t] * args.rope_rev[j];
            const float fr_ = (float)(rev - floor(rev));
            const float sn = __builtin_amdgcn_sinf(fr_), c_ = __builtin_amdgcn_cosf(fr_);
            cs[(size_t)t * 32 + j] = c_; cs[(size_t)t * 32 + 16 + j] = sn;
            const float x1 = zkpe[(size_t)t * 32 + j], x2 = zkpe[(size_t)t * 32 + 16 + j];
            kpe[(size_t)t * 32 + j] = (bf16_t)f2bf(x1 * c_ - x2 * sn); kpe[(size_t)t * 32 + 16 + j] = (bf16_t)f2bf(x1 * sn + x2 * c_);
        }
        {   int kq = 256; asm volatile("" : "+s"(kq)); pg8::Gemm g{(const bf16_t*)(ws + WS_ZQ), WqbT, kq, kq, kq}; pg8::StaticOrder S; S.init(T, 768, 256, 256, G, bx);
            EpiQ E{(const float*)(ws + WS_SSQQ), (bf16_t*)(ws + WS_QB)};
            pg8::gemm_phase<EpiQ, pg8::StaticOrder, true, true>(lds, g, S, E); }
        {   int kk = 128; asm volatile("" : "+s"(kk)); pg8::Gemm g{(const bf16_t*)(ws + WS_ZKV), WkvbT, kk, kk, kk}; const bool memcu = ((bx + 64) % G) < 32 && G > 64; const int bx2 = bx - (bx >= G - 64 + 32 ? 32 : 0);
            pg8::StaticOrder S; S.init(memcu ? 0 : T, 1024, 128, 128, G > 64 ? G - 32 : G, G > 64 ? bx2 : bx);
            EpiKV E{(const float*)(ws + WS_SSQKV), (bf16_t*)(ws + WS_KN), (bf16_t*)(ws + WS_VB)};
            pg8::gemm_phase<EpiKV, pg8::StaticOrder, true, true>(lds, g, S, E); }
        {   int kx = 1024; asm volatile("" : "+s"(kx)); pg8::Gemm g{memb, WmkvT, kx, kx, kx}; pg8::StaticOrder S; S.init(NB * NMEM, 2048, 1024, 1024, G, (bx + 64) % G);
            EpiRowScale E{rstd_mem, (bf16_t*)(ws + WS_KVMEM), 2048};
            pg8::gemm_phase<EpiRowScale, pg8::StaticOrder, true, true>(lds, g, S, E); }
    }
    GRID_BAR(2);
    if (IN(3)) {
        const unsigned short* Qg = (const unsigned short*)(ws + WS_QB); const unsigned short* Kn = (const unsigned short*)(ws + WS_KN);
        const unsigned short* Kp = (const unsigned short*)(ws + WS_KPE); const unsigned short* Vg = (const unsigned short*)(ws + WS_VB);
        const float* cs = (const float*)(ws + WS_CS); unsigned short* Og = (unsigned short*)(ws + WS_OB);
        for (int i = 0; !(args.flags & 8); ++i) {
            int bh, qb;
            if (G == 256) { if (i >= 2) break; const int idx = i * 32 + (bx >> 3); bh = (bx & 7) + 8 * (idx >> 4); qb = idx & 15; }
            else { const int un = i * G + bx; if (un >= 512) break; bh = un >> 4; qb = un & 15; }
            const int b = bh >> 3, h = bh & 7;
#ifdef MLA_ABL
            if (args.flags & 16) mla::mla_unit<MLA_ABL>(Qg, Kn, Kp, Vg, cs, Og, b * S + qb * 256, b * S, h, S, (char*)lds_raw); else
#endif
            mla::mla_unit<0>(Qg, Kn, Kp, Vg, cs, Og, b * S + qb * 256, b * S, h, S, (char*)lds_raw);
        }
        {
            const unsigned short* qkv = (const unsigned short*)(ws + WS_QKVA); const int* pos = (const int*)args.in[2];
            const float* tbl = (const float*)(ws + WS_TBL); unsigned short* oap = (unsigned short*)(ws + WS_OAP); float* lse = (float*)(ws + WS_LSE);
            char* wl = (char*)lds_raw + wave * dil::W_BYTES;
            __syncthreads();
            int cur_h = -1;
            dil::TaskId tc = dil::task_at(0, bx, G, wave), tn = tc; dil::Pre P;
            bool have = !(args.flags & 4) && tc.ub >= 0;
            if (have) dil::dil_prefetch(qkv, pos, tc, P);
            for (int i = 0; have; ++i) {
                tn = dil::task_at(i + 1, bx, G, wave); const bool has_next = tn.ub >= 0;
                if (tc.h != cur_h) { float* tw = (float*)(wl + dil::W_TBL); for (int j = lane; j < 2049; j += 64) tw[j ^ ((j >> 5) & 31)] = tbl[tc.h * dil::TBL_PITCH + j] * 1.4426950408889634f; cur_h = tc.h; asm volatile("s_waitcnt vmcnt(0) lgkmcnt(0)" ::: "memory"); }
                dil::dil_task(qkv, pos, oap, lse, tc, P, has_next, tn, wl);
                tc = tn; have = has_next;
            }
        }
    }
    GRID_BAR(3);
    if (IN(4)) {
        { int kx = 256; asm volatile("" : "+s"(kx));
          if (bx < 64) { pg8::Gemm g{(const bf16_t*)(ws + WS_KVMEM), Wmqg, 2048, 1024, kx}; OrderWp S{bx}; EpiPlain E{(unsigned char*)(ws + WS_WPT), 1024};
              pg8::gemm_phase<EpiPlain, OrderWp, true, true>(lds, g, S, E); }
          else if (bx < 128) { pg8::Gemm g{WmoT, (const bf16_t*)(ws + WS_KVMEM), 1024, 2048, kx}; OrderVw S{bx - 64}; EpiPlain E{(unsigned char*)(ws + WS_VWT), 1024};
              pg8::gemm_phase<EpiPlain, OrderVw, true, true>(lds, g, S, E); } }
        const bf16_t* oap = (const bf16_t*)(ws + WS_OAP); const float* lse = (const float*)(ws + WS_LSE); const bf16_t* obp = (const bf16_t*)(ws + WS_OB);
        const float* g_out_a = args.in[10]; const float* g_out_b = args.in[11]; bf16_t* omix = (bf16_t*)(ws + WS_OMIX);
        const int gw = vcu * NWAVES + wave, NGW = G * NWAVES;
        const f32x4 ga0 = *(const f32x4*)(g_out_a + 8 * lane), ga1 = *(const f32x4*)(g_out_a + 8 * lane + 4), gb0 = *(const f32x4*)(g_out_b + 8 * lane), gb1 = *(const f32x4*)(g_out_b + 8 * lane + 4);
#define UNPK_LO(V_) ((f32x4){__builtin_bit_cast(float, (V_)[0] << 16), __builtin_bit_cast(float, (V_)[0] & 0xffff0000u), __builtin_bit_cast(float, (V_)[1] << 16), __builtin_bit_cast(float, (V_)[1] & 0xffff0000u)})
#define UNPK_HI(V_) ((f32x4){__builtin_bit_cast(float, (V_)[2] << 16), __builtin_bit_cast(float, (V_)[2] & 0xffff0000u), __builtin_bit_cast(float, (V_)[3] << 16), __builtin_bit_cast(float, (V_)[3] & 0xffff0000u)})
        for (int tok = gw; tok < T; tok += NGW) {
            const int head = lane >> 3;
            const float l0 = lse[((size_t)0 * T + tok) * 8 + head], l1 = lse[((size_t)1 * T + tok) * 8 + head], l2 = lse[((size_t)2 * T + tok) * 8 + head];
            const float mx = fmaxf(l0, fmaxf(l1, l2)); float w0 = __expf(l0 - mx), w1 = __expf(l1 - mx), w2 = __expf(l2 - mx); const float wi = 1.0f / (w0 + w1 + w2); w0 *= wi; w1 *= wi; w2 *= wi;
            const v4u q0 = *(const v4u*)(oap + ((size_t)0 * T + tok) * 512 + 8 * lane), q1 = *(const v4u*)(oap + ((size_t)1 * T + tok) * 512 + 8 * lane);
            const v4u q2 = *(const v4u*)(oap + ((size_t)2 * T + tok) * 512 + 8 * lane), qb = *(const v4u*)(obp + (size_t)tok * 512 + 8 * lane);
            const f32x4 a0 = UNPK_LO(q0) * w0 + UNPK_LO(q1) * w1 + UNPK_LO(q2) * w2, a1 = UNPK_HI(q0) * w0 + UNPK_HI(q1) * w1 + UNPK_HI(q2) * w2, b0 = UNPK_LO(qb), b1 = UNPK_HI(qb);
            const float sa = wave_sum(sq8(a0, a1)), sb = wave_sum(sq8(b0, b1));
            const float ra = 1.0f / sqrtf(sa * (1.0f / 512.0f) + 1e-6f), rb = 1.0f / sqrtf(sb * (1.0f / 512.0f) + 1e-6f);
            *(v4u*)(omix + (size_t)tok * 1024 + 8 * lane) = pack8(a0 * ra * ga0, a1 * ra * ga1);
            *(v4u*)(omix + (size_t)tok * 1024 + 512 + 8 * lane) = pack8(b0 * rb * gb0, b1 * rb * gb1);
        }
#undef UNPK_LO
#undef UNPK_HI
    }
    GRID_BAR(4);
    if (IN(5)) {
        int kx = 1024; asm volatile("" : "+s"(kx));
        pg8::Gemm g{(const bf16_t*)(ws + WS_OMIX), WoT, kx, kx, kx}; pg8::StaticOrder S; S.init(T, 1024, 1024, 1024, G, bx);
        EpiResid<false, true> E{x, (bf16_t*)(ws + WS_H1B), (float*)(ws + WS_SSQH1), (unsigned char*)(ws + WS_H1Q), 1.0f};
        pg8::gemm_phase<EpiResid<false, true>, pg8::StaticOrder, true, true>(lds, g, S, E);
    }
    GRID_BAR(5);
    if (IN(6)) {
        int kx = 512; asm volatile("" : "+s"(kx));
        pg8::Gemm g{(const bf16_t*)(ws + WS_H1Q), (const bf16_t*)(ws + WS_WPT), kx, kx, kx}; OrderBatch S; S.so.init(T, 1024, 512, 512, G, bx);
        pg8::Unit u0; const bool has = S.next(0, u0);
        LAS float* rsl = (LAS float*)(lds + CTRL_OFF + 1024);
        if (has && tid < 256) { const float* sp = (const float*)(ws + WS_SSQH1) + (size_t)(u0.pm * 256 + tid) * 16; float a = 0.f;
#pragma unroll
            for (int j = 0; j < 4; ++j) { const f32x4 v = ((const f32x4*)sp)[j]; a += (v[0] + v[1]) + (v[2] + v[3]); }
            rsl[tid] = 1.0f / sqrtf(a * (1.0f / 1024.0f) + 1e-6f); }
        __syncthreads();
        EpiSoftmax E{(unsigned char*)(ws + WS_P), CTRL_OFF + 1024};
        pg8::gemm_phase<EpiSoftmax, OrderBatch, false, true, false, true>(lds, g, S, E);
    }
    GRID_BAR(6);
    if (IN(7)) {
        int kx = 512; asm volatile("" : "+s"(kx));
        pg8::Gemm g{(const bf16_t*)(ws + WS_P), (const bf16_t*)(ws + WS_VWT), kx, kx, kx}; OrderBatch S; S.so.init(T, 1024, 512, 512, G, bx);
        EpiResid<true, true> E{(const bf16_t*)(ws + WS_H1B), (bf16_t*)(ws + WS_H2B), (float*)(ws + WS_SSQH2), (unsigned char*)(ws + WS_H2Q), P8_INV * XA8_INV};
        pg8::gemm_phase<EpiResid<true, true>, OrderBatch, true, true, false, true>(lds, g, S, E);
    }
    GRID_BAR(7);
    if (IN(8)) {
        typedef float f32x16 __attribute__((ext_vector_type(16)));
        const bf16_t* h2b = (const bf16_t*)(ws + WS_H2B); const float* b_router = args.in[20]; const float* ssq2 = (const float*)(ws + WS_SSQH2);
        int* topi = (int*)(ws + WS_ROUTE + RT_TOPI); float* topg = (float*)(ws + WS_ROUTE + RT_TOPG); int* tslot = (int*)(ws + WS_ROUTE + RT_SLOT); int* row_flat = (int*)(ws + WS_ROUTE + RT_ROWFLAT);
        for (int i = bx * 512 + tid; i < MPADN; i += G * 512) row_flat[i] = -1;
        LAS float* part = (LAS float*)lds;
        LAS float* lgt = (LAS float*)(lds + 32768);
        for (int ch = bx; ch < T / 64; ch += G) {
            const int tok0 = ch * 64, tb = wave & 1, kq = wave >> 1, kh = lane >> 5, row = tok0 + 32 * tb + (lane & 31);
            f32x16 acc = {};
            const bf16_t* ap = h2b + (size_t)row * 1024 + 256 * kq + 4 * kh; const float* wp = (const float*)(ws + WS_WRG) + (size_t)(256 * kq + 4 * kh) * 32 + (lane & 31);
#pragma unroll 8
            for (int j = 0; j < 32; ++j) {
                const v2u aw = *(const v2u*)(ap + 8 * j);
                const f32x4 a4 = (f32x4){__builtin_bit_cast(float, aw.x << 16), __builtin_bit_cast(float, aw.x & 0xffff0000u), __builtin_bit_cast(float, aw.y << 16), __builtin_bit_cast(float, aw.y & 0xffff0000u)};
#pragma unroll
                for (int e = 0; e < 4; ++e) acc = __builtin_amdgcn_mfma_f32_32x32x2f32(a4[e], wp[(size_t)(8 * j + e) * 32], acc, 0, 0, 0);
            }
#pragma unroll
            for (int r = 0; r < 16; ++r) part[((kq * 64) + tb * 32 + (r & 3) + 8 * (r >> 2) + 4 * kh) * 32 + (lane & 31)] = acc[r];
            __syncthreads();
            {
                const int tk = tid >> 3, e0 = (tid & 7) * 4; const float* sp = ssq2 + (size_t)(tok0 + tk) * 16; float a = 0.f;
#pragma unroll
                for (int j = 0; j < 4; ++j) { const f32x4 v = ((const f32x4*)sp)[j]; a += (v[0] + v[1]) + (v[2] + v[3]); }
                const float rs = 1.0f / sqrtf(a * (1.0f / 1024.0f) + 1e-6f);
                if (e0 == 0) ((float*)(ws + WS_ROUTE + RT_RSTD))[tok0 + tk] = rs;
#pragma unroll
                for (int e = 0; e < 4; ++e) lgt[tk * 33 + e0 + e] = rs * ((part[(0 * 64 + tk) * 32 + e0 + e] + part[(1 * 64 + tk) * 32 + e0 + e]) + (part[(2 * 64 + tk) * 32 + e0 + e] + part[(3 * 64 + tk) * 32 + e0 + e])) + b_router[e0 + e];
            }
            __syncthreads();
            if (tid < 64) {
                int c0 = -1, c1 = -1, c2 = -1, c3 = -1; float v0 = 0.f, v1 = 0.f, v2 = 0.f, v3 = 0.f; int s0 = 0, s1 = 0, s2 = 0, s3 = 0;
                for (int k = 0; k < 4; ++k) {
                    float best = -3.0e38f; int bi = 0;
                    for (int e = 0; e < 32; ++e) { const float v = lgt[tid * 33 + e]; if (e == c0 || e == c1 || e == c2 || e == c3) continue; if (v > best) { best = v; bi = e; } }
                    if (k == 0) { c0 = bi; v0 = best; } else if (k == 1) { c1 = bi; v1 = best; } else if (k == 2) { c2 = bi; v2 = best; } else { c3 = bi; v3 = best; }
                }
                const unsigned long long lt = (1ull << lane) - 1ull; int* cntc = (int*)(ws + WS_ROUTE + RT_CNT) + ch * 32;
                for (int e = 0; e < 32; ++e) {
                    const unsigned long long m0 = __ballot(c0 == e), m1 = __ballot(c1 == e), m2 = __ballot(c2 == e), m3 = __ballot(c3 == e);
                    const int before = __popcll(m0 & lt) + __popcll(m1 & lt) + __popcll(m2 & lt) + __popcll(m3 & lt);
                    if (c0 == e) s0 = before; if (c1 == e) s1 = before; if (c2 == e) s2 = before; if (c3 == e) s3 = before;
                    if (lane == e) cntc[e] = __popcll(m0) + __popcll(m1) + __popcll(m2) + __popcll(m3);
                }
                const int t = tok0 + tid;
                const float e1 = __expf(v1 - v0), e2 = __expf(v2 - v0), e3 = __expf(v3 - v0), inv = 1.0f / (1.0f + e1 + e2 + e3);
                *(int4*)(topi + t * 4) = make_int4(c0, c1, c2, c3);
                *(f32x4*)(topg + t * 4) = (f32x4){inv, e1 * inv, e2 * inv, e3 * inv};
                *(int4*)(tslot + t * 4) = make_int4(s0, s1, s2, s3);
            }
            __syncthreads();
        }
    }
    GRID_BAR(8);
    if (IN(9)) {
        const int* topi = (const int*)(ws + WS_ROUTE + RT_TOPI); const int* tslot = (const int*)(ws + WS_ROUTE + RT_SLOT); const int* cnt = (const int*)(ws + WS_ROUTE + RT_CNT);
        int* row_flat = (int*)(ws + WS_ROUTE + RT_ROWFLAT); float* rs_row = (float*)(ws + WS_ROUTE + RT_RSROW); const float* rstd2 = (const float*)(ws + WS_ROUTE + RT_RSTD);
        LAS int* red = (LAS int*)lds;
        for (int base = bx * 512; base < NA; base += G * 512) {
            const int chA = base >> 8, e = tid & 31, part = tid >> 5;
            int tot = 0, pa = 0, pb = 0;
            for (int c = part; c < T / 64; c += 16) { const int v = cnt[c * 32 + e]; tot += v; pa += c < chA ? v : 0; pb += c <= chA ? v : 0; }
            __syncthreads();
            red[(0 * 16 + part) * 32 + e] = tot; red[(1 * 16 + part) * 32 + e] = pa; red[(2 * 16 + part) * 32 + e] = pb;
            __syncthreads();
            if (tid < 96) { const int w = tid >> 5; int a = 0; for (int p = 0; p < 16; ++p) a += red[(w * 16 + p) * 32 + e]; red[1536 + w * 32 + e] = a; }
            __syncthreads();
            if (tid == 0) { int run = 0; for (int q = 0; q < NE; ++q) { red[1632 + q] = run; run += ((red[1536 + q] + 255) >> 8) << 8; } }
            if (bx == 0 && base == 0 && tid < 32) ((int*)(ws + WS_ROUTE + RT_TOT))[tid] = red[1536 + tid];
            __syncthreads();
            const int a = base + tid, ex = topi[a], row = red[1632 + ex] + red[1536 + 32 * (1 + (((a >> 8) - chA) & 1)) + ex] + tslot[a];
            row_flat[row] = a; rs_row[row] = rstd2[a >> 2]; ((float*)(ws + WS_ROUTE + RT_RGATE))[row] = ((const float*)(ws + WS_ROUTE + RT_TOPG))[a];
        }
    }
    GRID_BAR(9);
    if (IN(10) || IN(11)) {
        const int* gtot = (const int*)(ws + WS_ROUTE + RT_TOT); LAS int* texp = (LAS int*)(lds + LX_TEXP);
        __syncthreads();
        if (tid < 64) {
            const int n = tid < NE ? (gtot[tid] + 255) >> 8 : 0; int inc = n;
#pragma unroll
            for (int d = 1; d < 32; d <<= 1) { const int v = __shfl_up(inc, d); if ((tid & 63) >= d) inc += v; }
            const int start = inc - n;
            if (tid < NE) for (int j = 0; j < n; ++j) texp[start + j] = tid;
            if (tid == NE - 1) texp[NTILEN] = inc;
        }
        __syncthreads();
    }
    if (IN(10)) {
        int kx = 512; asm volatile("" : "+s"(kx));
        pg8::Gemm g{(const bf16_t*)(ws + WS_H2Q), WguT, kx, kx, kx}; OrderMoe S{(const LAS int*)(lds + LX_TEXP), 8, bx, G, (size_t)2048 * 1024};
        {
            const int* row_flat = (const int*)(ws + WS_ROUTE + RT_ROWFLAT); pg8::Unit u;
            int av[pg8::GTAB_UNITS];
#pragma unroll
            for (int i = 0; i < pg8::GTAB_UNITS; ++i) { av[i] = -2; if (S.next(i, u) && tid < 256) av[i] = row_flat[u.pm * 256 + tid]; }
#pragma unroll
            for (int i = 0; i < pg8::GTAB_UNITS; ++i) if (av[i] != -2) ((LAS unsigned short*)(lds + pg8::GTAB))[i * 256 + tid] = (unsigned short)(av[i] >= 0 ? (av[i] >> 2) : 0);
            __syncthreads();
        }
        EpiSwiGLU E{(const float*)(ws + WS_ROUTE + RT_RSROW), args.in[22], (unsigned char*)(ws + WS_HMID), (const LAS int*)(lds + LX_TEXP)};
        pg8::gemm_phase<EpiSwiGLU, OrderMoe, true, true, true, true>(lds, g, S, E);
    }
    GRID_BAR(10);
    if (IN(11)) {
        int kx = 512; asm volatile("" : "+s"(kx));
        pg8::Gemm g{(const bf16_t*)(ws + WS_HMID), WdT, kx, kx, kx}; OrderMoe S{(const LAS int*)(lds + LX_TEXP), 4, bx, G, (size_t)1024 * 1024};
        EpiDown E{(const int*)(ws + WS_ROUTE + RT_ROWFLAT), (const float*)(ws + WS_ROUTE + RT_RGATE), args.in[24], (unsigned char*)(ws + WS_YBUF), (const LAS int*)(lds + LX_TEXP)};
        pg8::gemm_phase<EpiDown, OrderMoe, true, true, false, true>(lds, g, S, E);
    }
    GRID_BAR(11);
    if (IN(12)) {
        const bf16_t* h2b = (const bf16_t*)(ws + WS_H2B); const unsigned char* ybuf = (const unsigned char*)(ws + WS_YBUF); const float* g_final = args.in[25]; float* outp = args.out;
        const int gw = vcu * NWAVES + wave, NGW = G * NWAVES;
        for (int t = gw; t < T; t += NGW) {
            f32x4 v[4]; float ss = 0.f;
#pragma unroll
            for (int j = 0; j < 4; ++j) {
                const v2u hw = *(const v2u*)(h2b + (size_t)t * 1024 + 256 * j + 4 * lane);
                f32x4 a = (f32x4){__builtin_bit_cast(float, hw.x << 16), __builtin_bit_cast(float, hw.x & 0xffff0000u), __builtin_bit_cast(float, hw.y << 16), __builtin_bit_cast(float, hw.y & 0xffff0000u)};
                f32x4 ys = {0.f, 0.f, 0.f, 0.f};
#pragma unroll
                for (int k = 0; k < 4; ++k) { const int y = *(const int*)(ybuf + ((size_t)t * 4 + k) * 1024 + 256 * j + 4 * lane);
                    const f32x2_t lo = __builtin_amdgcn_cvt_pk_f32_fp8(y, false), hi2 = __builtin_amdgcn_cvt_pk_f32_fp8(y, true);
                    ys[0] += lo[0]; ys[1] += lo[1]; ys[2] += hi2[0]; ys[3] += hi2[1]; }
                a = a + ys * Y8_INV;
                v[j] = a; ss += (a[0] * a[0] + a[1] * a[1]) + (a[2] * a[2] + a[3] * a[3]);
            }
            ss = wave_sum(ss); const float rs = 1.0f / sqrtf(ss * (1.0f / 1024.0f) + 1e-6f);
#pragma unroll
            for (int j = 0; j < 4; ++j) *(f32x4*)(outp + (size_t)t * 1024 + 256 * j + 4 * lane) = v[j] * rs * *(const f32x4*)(g_final + 256 * j + 4 * lane);
        }
    }
#undef GRID_BAR
#undef BOTH
#undef IN
}

}
void launch_mk(hipStream_t st, const mk::Args& base, int lo, int hi, int grid) {
    mk::Args a = base; a.ph_lo = lo; a.ph_hi = hi;
    hipLaunchKernelGGL(mk::mk_fwd, dim3(grid), dim3(mk::NWAVES * 64), mk::LDS_BYTES, st, a);
}
}

extern "C" void kernel_launch(void* const* d_in, const int* in_sizes, int n_in, void* d_out, int out_size, void* d_ws, size_t ws_size, hipStream_t stream) {
    static int grid = 0;
    if (grid == 0) {
        int dev = 0, cus = 0;
        if (hipGetDevice(&dev) != hipSuccess || hipDeviceGetAttribute(&cus, hipDeviceAttributeMultiprocessorCount, dev) != hipSuccess) { grid = -1; return; }
        if (hipFuncSetAttribute((const void*)mk::mk_fwd, hipFuncAttributeMaxDynamicSharedMemorySize, mk::LDS_BYTES) != hipSuccess) { grid = -1; return; }
        grid = cus >= 256 ? 256 : cus;
    }
    if (grid < 0) return;
    const float* x = (const float*)d_in[0];
    const float* mem = (const float*)d_in[1];
    const int* pos = (const int*)d_in[2];
    const float* g_q_a = (const float*)d_in[5];
    const float* w_q_b = (const float*)d_in[6];
    const float* g_kv_a = (const float*)d_in[7];
    const float* w_kv_b = (const float*)d_in[8];
    const float* rel_bias = (const float*)d_in[9];
    const float* g_out_a = (const float*)d_in[10];
    const float* g_out_b = (const float*)d_in[11];
    const float* w_o = (const float*)d_in[12];
    const float* g_xattn = (const float*)d_in[13];
    const float* g_mem = (const float*)d_in[14];
    const float* w_mq = (const float*)d_in[15];
    const float* w_mkv = (const float*)d_in[16];
    const float* w_mo = (const float*)d_in[17];
    const float* g_moe = (const float*)d_in[18];
    const float* w_router = (const float*)d_in[19];
    const float* b_router = (const float*)d_in[20];
    const float* w_gate_up = (const float*)d_in[21];
    const float* b_gate_up = (const float*)d_in[22];
    const float* w_down = (const float*)d_in[23];
    const float* b_down = (const float*)d_in[24];
    const float* g_final = (const float*)d_in[25];
    float* out = (float*)d_out;
    (void)ws_size; (void)in_sizes; (void)n_in; (void)out_size;

    (void)hipMemsetAsync((char*)d_ws + mk::WS_CTL, 0, mk::CTL_ZERO_BYTES, stream);
    mk::Args ma; memset(&ma, 0, sizeof(ma));
    for (int i = 0; i < 26; ++i) ma.in[i] = (const float*)d_in[i];
    ma.out = out; ma.ws = (unsigned char*)d_ws; ma.flags = 1;
    for (int j = 0; j < 16; ++j) ma.rope_rev[j] = pow(10000.0, -(double)j / 16.0) / 6.283185307179586476925287;
#ifndef MK_N_LAUNCHES
#define MK_N_LAUNCHES 1
#endif
    if (MK_N_LAUNCHES == 1) launch_mk(stream, ma, 0, 13, grid);
    else for (int p = 0; p < 13; ++p) launch_mk(stream, ma, p, p + 1, grid);
#ifdef PROBE_MASK
#ifdef PROBE_FLAGS
    ma.flags |= PROBE_FLAGS;
#endif
    for (int r = 0; r < PROBE_N; ++r) for (int p = 0; p < 13; ++p) if ((PROBE_MASK >> p) & 1) launch_mk(stream, ma, p, p + 1, grid);
#endif
}
```

```cpp
#include <hip/hip_runtime.h>
#include <stdint.h>
#include <string.h>
#include <math.h>

namespace {
constexpr int NB = 4, S = 4096, D = 1024, T = NB * S, NMEM = 256, INW = 1952;
constexpr int NE = 32, TOPK = 4, NA = T * TOPK;

namespace pg8 {
#define PG8_LAS __attribute__((address_space(3)))
typedef unsigned short bf16_t;
typedef short bf16x8 __attribute__((ext_vector_type(8)));
typedef float f32x4 __attribute__((ext_vector_type(4)));
typedef unsigned u32x4 __attribute__((ext_vector_type(4)));
constexpr int BM = 256, BK = 64, HALF = 128, HTB = HALF * BK * 2  , STAGE_BYTES = 8 * HTB, NXCD = 8, WGM = 8;

__host__ __device__ __forceinline__ int lds_byte(int r, int c) { const int st = (r >> 4) * 2 + (c >> 5), rr = r & 15, cc = c & 31, ob = rr * 64 + cc * 2; return st * 1024 + (ob ^ (((ob >> 9) & 1) << 5)); }
__host__ __device__ __forceinline__ void stage_rc(int b, int& R, int& C) { const int st = b / 1024, sb = b % 1024, swz = sb ^ (((sb >> 9) & 1) << 5); R = (st >> 1) * 16 + swz / 64; C = (st & 1) * 32 + (swz % 64) / 2; }
__host__ __device__ __forceinline__ int perm32(int rho) { const int n = rho >> 4, i = rho & 15; return 8 * (i >> 2) + 4 * n + (i & 3); }

struct Unit { int pm, pn; size_t aoff, boff; };
struct Gemm { const bf16_t* A; const bf16_t* Bt; int lda, ldb, K; };

struct StaticOrder {
    int nM, nN, nwg, G, c; size_t ta, tb;
    __host__ __device__ __forceinline__ void init(int M, int N, int lda, int ldb, int G_, int c_) { nM = M / BM; nN = N / BM; nwg = nM * nN; G = G_; c = c_; ta = (size_t)BM * lda * 2; tb = (size_t)BM * ldb * 2; }
    __host__ __device__ __forceinline__ bool next(int i, Unit& u) const {
        const long L = (long)i * G + c; if (L >= nwg) return false;
        int wgid = (int)L; { const int q = nwg / NXCD, r = nwg % NXCD, xcd = wgid % NXCD, off = wgid / NXCD; wgid = (xcd < r ? xcd * (q + 1) : r * (q + 1) + (xcd - r) * q) + off; }
        const int nig = WGM * nN, gid = wgid / nig, fm = gid * WGM, gsz = (nM - fm) < WGM ? (nM - fm) : WGM;
        u.pm = fm + ((wgid % nig) % gsz); u.pn = (wgid % nig) / gsz; u.aoff = (size_t)u.pm * ta; u.boff = (size_t)u.pn * tb; return true;
    }
    __device__ __forceinline__ void a_ready(const Unit&) const {}
    __device__ __forceinline__ void done(const Unit&) const {}
};

__device__ __forceinline__ unsigned cvt_pk_bf16(float lo, float hi) { unsigned r; asm volatile("v_cvt_pk_bf16_f32 %0, %1, %2" : "=v"(r) : "v"(lo), "v"(hi)); return r; }
typedef float f32x2 __attribute__((ext_vector_type(2)));

constexpr int GTAB = 135168 + 4096, GTAB_UNITS = 10;
typedef int i32x4 __attribute__((ext_vector_type(4)));
typedef int i32x8 __attribute__((ext_vector_type(8)));
__device__ __forceinline__ i32x8 cat8(const bf16x8 a, const bf16x8 b) { return __builtin_shufflevector(__builtin_bit_cast(i32x4, a), __builtin_bit_cast(i32x4, b), 0, 1, 2, 3, 4, 5, 6, 7); }
template <class Epi, class Sched, bool ALIGN_EPI = false, bool SP2 = false, bool GATHER = false, bool F8 = false>
__device__ __forceinline__ void gemm_phase(PG8_LAS unsigned char* lds, const Gemm g, const Sched& S, const Epi& E) {
    const int tid = threadIdx.x, wid = __builtin_amdgcn_readfirstlane(tid >> 6), lane = tid & 63, wr = wid >> 2, wc = wid & 3, fr = lane & 15, fq = lane >> 4;
    static_assert(!GATHER || SP2, "GATHER is implemented for the SP2 loop only");
    const int K = g.K, nt = K / BK;
    unsigned voffA[2], voffB[2];
#pragma unroll
    for (int i = 0; i < 2; ++i) { int R, C; stage_rc(tid * 16 + i * 8192, R, C); const int Rb = Epi::PERM ? ((R & ~31) + perm32(R & 31)) : R;
        voffA[i] = (unsigned)(R * g.lda + C) * 2u; voffB[i] = (unsigned)(Rb * g.ldb + C) * 2u; }
    unsigned gidx[2], gcol[2];
#pragma unroll
    for (int i = 0; i < 2; ++i) { int R, C; stage_rc(tid * 16 + i * 8192, R, C); gidx[i] = (unsigned)R * 2u; gcol[i] = (unsigned)C * 2u; }
    const size_t kstep = (size_t)(BK * 2);
    const size_t hstepA = (size_t)HALF * g.lda * 2, hstepB = (size_t)HALF * g.ldb * 2;
    const unsigned ldsw = (unsigned)wid * 1024u;
    const int aoff = lds_byte(wr * 64 + fr, fq * 8), boff = lds_byte(wc * 32 + fr, fq * 8);
#define PG8_SA(b, h) (((b) * 2 + (h)) * HTB)
#define PG8_SB(b, h) ((4 + (b) * 2 + (h)) * HTB)
#define PG8_GLDS(gptr, off32, ldsdst) do { unsigned _o = (off32); asm volatile("" : "+v"(_o)); __builtin_amdgcn_global_load_lds((const unsigned*)((const char*)(gptr) + _o), (ldsdst), 16, 0, 0); } while (0)
#define PG8_STAGE(bufoff, gbase, voff) do { _Pragma("unroll") for (int _i = 0; _i < 2; ++_i) \
        PG8_GLDS(gbase, (voff)[_i], (PG8_LAS unsigned*)(lds + (bufoff) + ldsw + _i * 8192)); } while (0)
#define PG8_GTOK(h, sel) do { if constexpr (GATHER) { tk0 = *(const PG8_LAS unsigned short*)(lds + GTAB + (sel) * 512 + (h) * 256 + gidx[0]); tk1 = *(const PG8_LAS unsigned short*)(lds + GTAB + (sel) * 512 + (h) * 256 + gidx[1]); } } while (0)
#define PG8_STAGE_A(bufoff, gbase, h, sel) do { if constexpr (GATHER) { \
        PG8_GLDS(gbase, tk0 * (unsigned)(g.lda * 2) + gcol[0], (PG8_LAS unsigned*)(lds + (bufoff) + ldsw)); \
        PG8_GLDS(gbase, tk1 * (unsigned)(g.lda * 2) + gcol[1], (PG8_LAS unsigned*)(lds + (bufoff) + ldsw + 8192)); } \
    else { PG8_STAGE(bufoff, (gbase) + (h) * hstepA, voffA); } } while (0)
#define PG8_LDA(dst, b, h) do { _Pragma("unroll") for (int m = 0; m < 4; ++m) _Pragma("unroll") for (int k = 0; k < 2; ++k) dst[m][k] = *(const PG8_LAS bf16x8*)(lds + PG8_SA(b, h) + aoff + m * 2048 + k * 1024); } while (0)
#define PG8_LDB(dst, b, h) do { _Pragma("unroll") for (int n = 0; n < 2; ++n) _Pragma("unroll") for (int k = 0; k < 2; ++k) dst[n][k] = *(const PG8_LAS bf16x8*)(lds + PG8_SB(b, h) + boff + n * 2048 + k * 1024); } while (0)
#define PG8_MMA(ai, bj, At, Bt) do { __builtin_amdgcn_s_setprio(1); _Pragma("unroll") for (int m = 0; m < 4; ++m) _Pragma("unroll") for (int n = 0; n < 2; ++n) { \
        if constexpr (F8) { const i32x8 _b = cat8(Bt[n][0], Bt[n][1]), _a = cat8(At[m][0], At[m][1]); asm volatile("s_nop 1\n\tv_mfma_f32_16x16x128_f8f6f4 %0, %1, %2, %0" : "+v"(acc[ai][bj][m][n]) : "v"(_b), "v"(_a)); } \
        else { _Pragma("unroll") for (int k = 0; k < 2; ++k) acc[ai][bj][m][n] = __builtin_amdgcn_mfma_f32_16x16x32_bf16(Bt[n][k], At[m][k], acc[ai][bj][m][n], 0, 0, 0); } } __builtin_amdgcn_s_setprio(0); } while (0)
#define PG8_WAIT_V(n) asm volatile("s_waitcnt vmcnt(" #n ")" ::: "memory")
#define PG8_WAIT_L(n) asm volatile("s_waitcnt lgkmcnt(" #n ")" ::: "memory")
#define PG8_BAR __builtin_amdgcn_s_barrier()
#define PG8_SCHED __builtin_amdgcn_sched_barrier(0)
    Unit cur, nxt; int ui = 0; unsigned tk0 = 0, tk1 = 0; (void)tk0; (void)tk1;
    if (!S.next(0, cur)) return;
    f32x4 acc[2][2][4][2];
#pragma unroll
    for (int a = 0; a < 2; ++a)
#pragma unroll
        for (int b = 0; b < 2; ++b)
#pragma unroll
            for (int m = 0; m < 4; ++m)
#pragma unroll
                for (int n = 0; n < 2; ++n) acc[a][b][m][n] = (f32x4){0.f, 0.f, 0.f, 0.f};
    bf16x8 At[4][2], B0[2][2], B1[2][2];
    const char* cA = (const char*)g.A + (GATHER ? (size_t)0 : cur.aoff); const char* cB = (const char*)g.Bt + cur.boff;
    S.a_ready(cur);
    if constexpr (SP2) {
        PG8_STAGE(PG8_SB(0, 0), cB, voffB); PG8_STAGE(PG8_SB(0, 1), cB + hstepB, voffB); PG8_GTOK(0, ui); PG8_STAGE_A(PG8_SA(0, 0), cA, 0, ui); PG8_GTOK(1, ui); PG8_STAGE_A(PG8_SA(0, 1), cA, 1, ui);
        if (wr == 1) PG8_BAR;
        PG8_WAIT_V(2); PG8_BAR;
        PG8_STAGE(PG8_SB(1, 0), cB + kstep, voffB); PG8_GTOK(0, ui); PG8_STAGE_A(PG8_SA(1, 0), cA + kstep, 0, ui); PG8_STAGE(PG8_SB(1, 1), cB + hstepB + kstep, voffB);
        PG8_WAIT_V(6); PG8_BAR;
    } else {
        PG8_STAGE(PG8_SB(0, 0), cB, voffB); PG8_STAGE_A(PG8_SA(0, 0), cA, 0, ui); PG8_STAGE(PG8_SB(0, 1), cB + hstepB, voffB); PG8_STAGE_A(PG8_SA(0, 1), cA, 1, ui);
        if (wr == 1) PG8_BAR;
        PG8_WAIT_V(4); PG8_BAR;
        PG8_STAGE(PG8_SB(1, 0), cB + kstep, voffB); PG8_STAGE_A(PG8_SA(1, 0), cA + kstep, 0, ui); PG8_STAGE(PG8_SB(1, 1), cB + hstepB + kstep, voffB);
        PG8_WAIT_V(6); PG8_BAR;
    }
    for (;;) {
        const bool has_next = S.next(ui + 1, nxt);
        const char* nA = has_next ? (const char*)g.A + (GATHER ? (size_t)0 : nxt.aoff) : cA; const char* nB = has_next ? (const char*)g.Bt + nxt.boff : cB;
        for (int t = 0; t < nt; t += 2) {
            const bool last = (t == nt - 2);
            const char* a1 = cA + (size_t)(t + 1) * kstep;
            const char* a2 = last ? nA : cA + (size_t)(t + 2) * kstep; const char* b2 = last ? nB : cB + (size_t)(t + 2) * kstep;
            const char* a3 = a2 + kstep; const char* b3 = b2 + kstep; const int ui2 = (last && has_next) ? ui + 1 : ui; (void)ui2;
            if (last && has_next) S.a_ready(nxt);
            if constexpr (SP2) {
            PG8_GTOK(1, ui); PG8_LDB(B0, 0, 0); PG8_LDB(B1, 0, 1); PG8_SCHED; PG8_LDA(At, 0, 0); PG8_STAGE_A(PG8_SA(1, 1), a1, 1, ui);
            PG8_WAIT_V(8); PG8_WAIT_L(0); PG8_BAR; PG8_MMA(0, 0, At, B0); PG8_MMA(0, 1, At, B1); PG8_BAR; PG8_SCHED;
            PG8_GTOK(0, ui2); PG8_LDA(At, 0, 1); PG8_STAGE(PG8_SB(0, 0), b2, voffB); PG8_STAGE(PG8_SB(0, 1), b2 + hstepB, voffB); PG8_STAGE_A(PG8_SA(0, 0), a2, 0, ui2);
            PG8_WAIT_V(8); PG8_WAIT_L(0); PG8_BAR; PG8_MMA(1, 0, At, B0); PG8_MMA(1, 1, At, B1); PG8_BAR; PG8_SCHED;
            PG8_GTOK(1, ui2); PG8_LDB(B0, 1, 0); PG8_LDB(B1, 1, 1); PG8_SCHED; PG8_LDA(At, 1, 0); PG8_STAGE_A(PG8_SA(0, 1), a2, 1, ui2);
            PG8_WAIT_V(8); PG8_WAIT_L(0); PG8_BAR; PG8_MMA(0, 0, At, B0); PG8_MMA(0, 1, At, B1); PG8_BAR; PG8_SCHED;
            PG8_GTOK(0, ui2); PG8_LDA(At, 1, 1); PG8_STAGE(PG8_SB(1, 0), b3, voffB); PG8_STAGE(PG8_SB(1, 1), b3 + hstepB, voffB); PG8_STAGE_A(PG8_SA(1, 0), a3, 0, ui2);
            PG8_WAIT_V(8); PG8_WAIT_L(0); PG8_BAR; PG8_MMA(1, 0, At, B0); PG8_MMA(1, 1, At, B1); PG8_BAR; PG8_SCHED;
            } else {
            PG8_LDB(B0, 0, 0); PG8_SCHED; PG8_LDA(At, 0, 0); PG8_STAGE_A(PG8_SA(1, 1), a1, 1, ui);
            PG8_WAIT_L(8); PG8_BAR; PG8_WAIT_L(0); PG8_MMA(0, 0, At, B0); PG8_BAR; PG8_SCHED;
            PG8_LDB(B1, 0, 1); PG8_STAGE(PG8_SB(0, 0), b2, voffB);
            PG8_BAR; PG8_WAIT_L(0); PG8_MMA(0, 1, At, B1); PG8_BAR;
            PG8_LDA(At, 0, 1); PG8_STAGE_A(PG8_SA(0, 0), a2, 0, ui2);
            PG8_BAR; PG8_WAIT_L(0); PG8_MMA(1, 0, At, B0); PG8_BAR; PG8_SCHED;
            PG8_STAGE(PG8_SB(0, 1), b2 + hstepB, voffB);
            PG8_WAIT_V(6); PG8_BAR; PG8_MMA(1, 1, At, B1); PG8_BAR;
            PG8_LDB(B0, 1, 0); PG8_SCHED; PG8_LDA(At, 1, 0); PG8_STAGE_A(PG8_SA(0, 1), a2, 1, ui2);
            PG8_WAIT_L(8); PG8_BAR; PG8_WAIT_L(0); PG8_MMA(0, 0, At, B0); PG8_BAR; PG8_SCHED;
            PG8_LDB(B1, 1, 1); PG8_STAGE(PG8_SB(1, 0), b3, voffB);
            PG8_BAR; PG8_WAIT_L(0); PG8_MMA(0, 1, At, B1); PG8_BAR;
            PG8_LDA(At, 1, 1); PG8_STAGE_A(PG8_SA(1, 0), a3, 0, ui2);
            PG8_BAR; PG8_WAIT_L(0); PG8_MMA(1, 0, At, B0); PG8_BAR; PG8_SCHED;
            PG8_STAGE(PG8_SB(1, 1), b3 + hstepB, voffB);
            PG8_WAIT_V(6); PG8_BAR; PG8_MMA(1, 1, At, B1); PG8_BAR;
            }
        }
        if constexpr (F8) {
#define PG8_A4(a, b) "+v"(acc[a][b][0][0]), "+v"(acc[a][b][0][1]), "+v"(acc[a][b][1][0]), "+v"(acc[a][b][1][1]), "+v"(acc[a][b][2][0]), "+v"(acc[a][b][2][1]), "+v"(acc[a][b][3][0]), "+v"(acc[a][b][3][1])
            asm volatile("s_nop 11\n\ts_nop 3" : PG8_A4(0, 0), PG8_A4(0, 1));
            asm volatile("" : PG8_A4(1, 0), PG8_A4(1, 1));
#undef PG8_A4
        }
        if constexpr (ALIGN_EPI) { if (wr == 0) PG8_BAR; }
        if constexpr (!Epi::AFTER_DRAIN) { E(acc, cur, wr, wc, fr, fq); S.done(cur); }
        if (!has_next) break;
#pragma unroll
        for (int a = 0; a < 2; ++a)
#pragma unroll
            for (int b = 0; b < 2; ++b)
#pragma unroll
                for (int m = 0; m < 4; ++m)
#pragma unroll
                    for (int n = 0; n < 2; ++n) acc[a][b][m][n] = (f32x4){0.f, 0.f, 0.f, 0.f};
        cur = nxt; cA = nA; cB = nB; ++ui;
        if constexpr (ALIGN_EPI) { if (wr == 1) PG8_BAR; }
    }
    PG8_WAIT_V(0);
    if constexpr (!ALIGN_EPI) { if (wr == 0) PG8_BAR; }
    PG8_BAR;
    if constexpr (Epi::AFTER_DRAIN) { E.fused(acc, cur, wr, wc, fr, fq, lds, wid, lane); S.done(cur); }
#undef PG8_SA
#undef PG8_SB
#undef PG8_GLDS
#undef PG8_STAGE
#undef PG8_STAGE_A
#undef PG8_GTOK
#undef PG8_LDA
#undef PG8_LDB
#undef PG8_MMA
#undef PG8_WAIT_V
#undef PG8_WAIT_L
#undef PG8_BAR
#undef PG8_SCHED
}
}
namespace mla {
using bf16x8 = __attribute__((ext_vector_type(8))) short;
using s16x4  = __attribute__((ext_vector_type(4))) short;
using f32x16 = __attribute__((ext_vector_type(16))) float;
using u32x4  = __attribute__((ext_vector_type(4))) unsigned;
constexpr int NW = 8, QBLK = 32, KVBLK = 64;
constexpr float SCALE = 0.10206207261596577f;
constexpr float THR = 8.f;
constexpr int SHM_V = KVBLK * 64 * 2, SHM_K = KVBLK * 256;
constexpr int SHM_ATTN = 4 * SHM_V + 4 * SHM_K + NW * 64 * 4;
#define KSWZ(row, colB) ((row) * 256 + ((colB) ^ (((row) & 7) << 4)))
#define SBAR() __builtin_amdgcn_sched_barrier(0)
__device__ __forceinline__ int crow(int r, int hi) { return (r & 3) + 8 * (r >> 2) + 4 * hi; }
__device__ __forceinline__ unsigned cvtpk(float lo, float hi) { unsigned r; asm volatile("v_cvt_pk_bf16_f32 %0, %1, %2" : "=v"(r) : "v"(lo), "v"(hi)); return r; }

__device__ __forceinline__ float max3f(float a, float b, float c) { return __builtin_fmaxf(__builtin_fmaxf(a, b), c); }
template <int ABL> __device__ __forceinline__ void partialSM(f32x16& p0, f32x16& p1, float& m_reg, float& alpha, bool first) {
  float a = max3f(p0[0], p0[1], p0[2]), b = max3f(p0[3], p1[0], p1[1]), c = max3f(p1[2], p1[3], p0[4]), d = max3f(p0[5], p0[6], p0[7]);
  a = max3f(a, p1[4], p1[5]); b = max3f(b, p1[6], p1[7]);
#pragma unroll
  for (int r = 8; r < 16; r += 4) { a = max3f(a, p0[r], p0[r + 1]); b = max3f(b, p0[r + 2], p0[r + 3]); c = max3f(c, p1[r], p1[r + 1]); d = max3f(d, p1[r + 2], p1[r + 3]); }
  float pmax = fmaxf(fmaxf(a, b), fmaxf(c, d));
  { auto rr = __builtin_amdgcn_permlane32_swap(__float_as_uint(pmax), __float_as_uint(pmax), false, false);
    pmax = fmaxf(__uint_as_float(rr[0]), __uint_as_float(rr[1])); }
  if (__builtin_expect(!first && __all(pmax - m_reg <= THR * 1.4426950408889634f), 1)) { alpha = 1.f; }
  else { const float mn = first ? pmax : fmaxf(m_reg, pmax); alpha = first ? 1.f : __builtin_amdgcn_exp2f(m_reg - mn); m_reg = mn; }
#pragma unroll
  for (int r = 0; r < 16; ++r) { p0[r] -= m_reg; p1[r] -= m_reg; }
#pragma unroll
  for (int r = 0; r < 16; ++r) p0[r] = (ABL & 2) ? p0[r] * 0.5f : __builtin_amdgcn_exp2f(p0[r]);
}
template <int ABL> __device__ __forceinline__ void finishSM(f32x16& p0, f32x16& p1, float alpha, float& l_reg, bf16x8& pa0, bf16x8& pa1, bf16x8& pa2, bf16x8& pa3) {
#pragma unroll
  for (int r = 0; r < 16; ++r) p1[r] = (ABL & 2) ? p1[r] * 0.5f : __builtin_amdgcn_exp2f(p1[r]);
  float ps, s0 = 0.f, s1 = 0.f, s2 = 0.f, s3 = 0.f;
#pragma unroll
  for (int r = 0; r < 16; r += 4) { s0 += p0[r]; s1 += p0[r + 1]; s2 += p0[r + 2]; s3 += p0[r + 3]; }
#pragma unroll
  for (int r = 0; r < 16; r += 4) { s0 += p1[r]; s1 += p1[r + 1]; s2 += p1[r + 2]; s3 += p1[r + 3]; }
  ps = (s0 + s1) + (s2 + s3);
  { auto rr = __builtin_amdgcn_permlane32_swap(__float_as_uint(ps), __float_as_uint(ps), false, false);
    ps = __uint_as_float(rr[0]) + __uint_as_float(rr[1]); }
  l_reg = l_reg * alpha + ps;
#define PK4(P, BASE, OUT) do { u32x4 w = {cvtpk(P[BASE + 0], P[BASE + 1]), cvtpk(P[BASE + 2], P[BASE + 3]), cvtpk(P[BASE + 4], P[BASE + 5]), cvtpk(P[BASE + 6], P[BASE + 7])}; \
    OUT = *reinterpret_cast<bf16x8*>(&w); } while (0)
  PK4(p0, 0, pa0); PK4(p0, 8, pa1); PK4(p1, 0, pa2); PK4(p1, 8, pa3);
#undef PK4
}
__device__ __forceinline__ void qkt(f32x16& p0, f32x16& p1, const char* Ks, const bf16x8* qr, int r32, int hi) {
  p0 = f32x16{}; p1 = f32x16{};
#pragma unroll
  for (int d0 = 0; d0 < 6; ++d0) { int cb = (d0 * 16 + hi * 8) * 2;
    bf16x8 b0 = *reinterpret_cast<const bf16x8*>(Ks + KSWZ(r32, cb));
    bf16x8 b1 = *reinterpret_cast<const bf16x8*>(Ks + KSWZ(32 + r32, cb));
    p0 = __builtin_amdgcn_mfma_f32_32x32x16_bf16(b0, qr[d0], p0, 0, 0, 0);
    p1 = __builtin_amdgcn_mfma_f32_32x32x16_bf16(b1, qr[d0], p1, 0, 0, 0); }
}
__device__ __forceinline__ int v_st(int k, int c) { const int kk = k;
  return ((kk >> 3) * 2 + (c >> 5)) * 512 + ((kk & 7) * 32 + (c & 31)) * 2; }
__device__ __forceinline__ int v_rd_base(int lane) { return ((lane & 3) << 3) | (((lane >> 2) & 3) << 6) | (((lane >> 4) & 1) << 5) | (((lane >> 5) & 1) << 8); }
constexpr int v_rd_off(int d0, int ks, int half) { return d0 * 512 + ks * 2048 + half * 1024; }
template <int OFF> __device__ __forceinline__ s16x4 tr_read(int vb) {
  s16x4 r; asm volatile("ds_read_b64_tr_b16 %0, %1 offset:%2" : "=&v"(r) : "v"(vb), "i"(OFF) : "memory"); return r;
}
#define PK(L, H) (bf16x8){L[0], L[1], L[2], L[3], H[0], H[1], H[2], H[3]}
#define PV_RD(KS, LA, HA, LB, HB) do { LA = tr_read<v_rd_off(0, KS, 0)>(vb); HA = tr_read<v_rd_off(0, KS, 1)>(vb); LB = tr_read<v_rd_off(1, KS, 0)>(vb); HB = tr_read<v_rd_off(1, KS, 1)>(vb); } while (0)
#define PV_MM(PA, LA, HA, LB, HB) do { o[0] = __builtin_amdgcn_mfma_f32_32x32x16_bf16(PA, PK(LA, HA), o[0], 0, 0, 0); o[1] = __builtin_amdgcn_mfma_f32_32x32x16_bf16(PA, PK(LB, HB), o[1], 0, 0, 0); } while (0)
__device__ __forceinline__ void pv_d0(f32x16* o, int vb, bf16x8 pa0, bf16x8 pa1, bf16x8 pa2, bf16x8 pa3) {
  s16x4 la, ha, lb, hb, lc, hc, ld, hd;
  PV_RD(0, la, ha, lb, hb);
  PV_RD(1, lc, hc, ld, hd);
  asm volatile("s_waitcnt lgkmcnt(4)" ::: "memory"); SBAR();
  PV_MM(pa0, la, ha, lb, hb); SBAR();
  PV_RD(2, la, ha, lb, hb);
  asm volatile("s_waitcnt lgkmcnt(4)" ::: "memory"); SBAR();
  PV_MM(pa1, lc, hc, ld, hd); SBAR();
  PV_RD(3, lc, hc, ld, hd);
  asm volatile("s_waitcnt lgkmcnt(4)" ::: "memory"); SBAR();
  PV_MM(pa2, la, ha, lb, hb); SBAR();
  asm volatile("s_waitcnt lgkmcnt(0)" ::: "memory"); SBAR();
  PV_MM(pa3, lc, hc, ld, hd);
}
#undef PV_MM
#undef PV_RD
#undef PK
__device__ __forceinline__ float bf2f_(short b) { return __builtin_bit_cast(float, (unsigned)(unsigned short)b << 16); }

template <int ABL> __device__ __forceinline__ void mla_unit(const unsigned short* __restrict__ Qg, const unsigned short* __restrict__ Kn, const unsigned short* __restrict__ Kpe, const unsigned short* __restrict__ Vg,
                                         const float* __restrict__ cs, unsigned short* __restrict__ Og, int q0, int krow0, int h, int seq, char* lds) {
  const int tid = threadIdx.x, wid = __builtin_amdgcn_readfirstlane(tid >> 6), lane = tid & 63, r32 = lane & 31, hi = lane >> 5;
  char* V_lds = lds; char* K_lds = lds + 4 * SHM_V;
  float* ws = (float*)(lds + 4 * SHM_V + 4 * SHM_K) + wid * 64; float* li_l = ws; float* al_l = ws + 32;
  float m_reg = 0.f, l_reg = 0; f32x16 o[2] = {}; bf16x8 qr[6];
  {
    const int qrow = q0 + wid * QBLK + r32;
    const unsigned short* Qw = Qg + (size_t)qrow * 768 + h * 96 + hi * 8;
#pragma unroll
    for (int d0 = 0; d0 < 6; ++d0) qr[d0] = *reinterpret_cast<const bf16x8*>(Qw + d0 * 16);
    const float* cr = cs + (size_t)qrow * 32 + hi * 8;
    bf16x8 a = qr[4], b = qr[5]; u32x4 wa, wb; float n1[8], n2[8];
#pragma unroll
    for (int e = 0; e < 8; ++e) { const float c_ = cr[e], s_ = cr[16 + e]; const float x1 = bf2f_(a[e]), x2 = bf2f_(b[e]); n1[e] = x1 * c_ - x2 * s_; n2[e] = x1 * s_ + x2 * c_; }
    wa = (u32x4){cvtpk(n1[0], n1[1]), cvtpk(n1[2], n1[3]), cvtpk(n1[4], n1[5]), cvtpk(n1[6], n1[7])};
    wb = (u32x4){cvtpk(n2[0], n2[1]), cvtpk(n2[2], n2[3]), cvtpk(n2[4], n2[5]), cvtpk(n2[6], n2[7])};
    qr[4] = *reinterpret_cast<bf16x8*>(&wa); qr[5] = *reinterpret_cast<bf16x8*>(&wb);
  }
  const int sk = tid >> 3, sc = (tid & 7) * 8, rk = (tid & 255) >> 2, rc = (tid & 3) * 8;
  const int vst = v_st(sk, sc), kst = KSWZ(sk, sc * 2), rst = KSWZ(rk, (64 + rc) * 2);
  const int vb0 = (int)(uintptr_t)V_lds + v_rd_base(lane);
  const unsigned short* Vh = Vg + (size_t)krow0 * 512 + h * 64; const unsigned short* Kh = Kn + (size_t)krow0 * 512 + h * 64; const unsigned short* Rh = Kpe + (size_t)krow0 * 32;
  struct { bf16x8 vs, ks, rs; } sr_[2];
#define SLOAD(i, k0) do { sr_[i].vs = *reinterpret_cast<const bf16x8*>(&Vh[(size_t)((k0) + sk) * 512 + sc]); sr_[i].ks = *reinterpret_cast<const bf16x8*>(&Kh[(size_t)((k0) + sk) * 512 + sc]); \
    sr_[i].rs = *reinterpret_cast<const bf16x8*>(&Rh[(size_t)((k0) + rk) * 32 + rc]); } while (0)
#define SWRITE(b, i) do { *(bf16x8*)(V_lds + (b) * SHM_V + vst) = sr_[i].vs; *(bf16x8*)(K_lds + (b) * SHM_K + kst) = sr_[i].ks; *(bf16x8*)(K_lds + (b) * SHM_K + rst) = sr_[i].rs; } while (0)
#define RESC(a) do { if (__any((a) < 1.f)) { if (hi == 0) al_l[r32] = (a); asm volatile("s_waitcnt lgkmcnt(0)" ::: "memory"); \
    _Pragma("unroll") for (int d = 0; d < 2; ++d) _Pragma("unroll") for (int r = 0; r < 16; ++r) o[d][r] *= al_l[crow(r, hi)]; } } while (0)
#define EBAR() do { asm volatile("s_waitcnt lgkmcnt(0)" ::: "memory"); __builtin_amdgcn_s_barrier(); asm volatile("" ::: "memory"); } while (0)
  f32x16 p0, p1; float al; bf16x8 pa0, pa1, pa2, pa3; const int NT = seq / KVBLK;
  pa0 = pa1 = pa2 = pa3 = bf16x8{};
  SLOAD(0, 0); SLOAD(1, KVBLK); asm volatile("s_waitcnt vmcnt(0)" ::: "memory"); SWRITE(0, 0); SWRITE(1, 1);
  if (2 < NT) SLOAD(0, 2 * KVBLK);
  EBAR();
  if (wid >= 4) EBAR();
  for (int t = 0; t < NT; ++t) {
    SBAR(); __builtin_amdgcn_s_setprio(3); qkt(p0, p1, K_lds + (t & 3) * SHM_K, qr, r32, hi); SBAR();
    if (t > 0) pv_d0(o, vb0 + ((t - 1) & 3) * SHM_V, pa0, pa1, pa2, pa3);
    __builtin_amdgcn_s_setprio(0); EBAR();
    partialSM<ABL>(p0, p1, m_reg, al, t == 0);
    RESC(al);
    finishSM<ABL>(p0, p1, al, l_reg, pa0, pa1, pa2, pa3);
    if (t + 2 < NT) { asm volatile("s_waitcnt vmcnt(0)" ::: "memory"); SWRITE((t + 2) & 3, 0); }
    if (t + 3 < NT) SLOAD(0, (t + 3) * KVBLK);
    EBAR();
  }
  SBAR(); pv_d0(o, vb0 + ((NT - 1) & 3) * SHM_V, pa0, pa1, pa2, pa3);
  if (wid < 4) EBAR();
#undef EBAR
  if (hi == 0) li_l[r32] = l_reg; asm volatile("s_waitcnt lgkmcnt(0)" ::: "memory");
  float rli[16];
#pragma unroll
  for (int r = 0; r < 16; ++r) rli[r] = __builtin_amdgcn_rcpf(li_l[crow(r, hi)]);
  unsigned short* Ow = Og + (size_t)(q0 + wid * QBLK) * 512 + h * 64;
#pragma unroll
  for (int r = 0; r < 16; ++r) { int orow = crow(r, hi);
#pragma unroll
    for (int d0 = 0; d0 < 2; ++d0) Ow[(size_t)orow * 512 + d0 * 32 + r32] = (unsigned short)cvtpk(o[d0][r] * rli[r], 0.f); }
  __syncthreads();
#undef SLOAD
#undef SWRITE
#undef RESC
}
#undef KSWZ
#undef SBAR
}

namespace dil {
using bf16x8 = __attribute__((ext_vector_type(8))) short;
using s16x4  = __attribute__((ext_vector_type(4))) short;
using f32x16 = __attribute__((ext_vector_type(16))) float;
using u32x4  = __attribute__((ext_vector_type(4))) unsigned;
constexpr int TBL_PITCH = 2112;
constexpr int W_TBL = 0, W_K = 8448, W_V = 8448 + 4096, W_POS = 8448 + 8192, W_AL = W_POS + 128, W_BYTES = W_AL + 128;
__device__ __forceinline__ int crow(int r, int hi) { return (r & 3) + 8 * (r >> 2) + 4 * hi; }
__device__ __forceinline__ unsigned cvtpk(float lo, float hi) { unsigned r; asm volatile("v_cvt_pk_bf16_f32 %0, %1, %2" : "=v"(r) : "v"(lo), "v"(hi)); return r; }
#define DKSWZ(row, colB) ((row) * 128 + ((colB) ^ (((row) & 7) << 4)))
__device__ __forceinline__ int v_st(int k, int c) { const int kk = k;
  return ((kk >> 3) * 2 + (c >> 5)) * 512 + ((kk & 7) * 32 + (c & 31)) * 2; }
__device__ __forceinline__ int v_rd_base(int lane) { return ((lane & 3) << 3) | (((lane >> 2) & 3) << 6) | (((lane >> 4) & 1) << 5) | (((lane >> 5) & 1) << 8); }
constexpr int v_rd_off(int d0, int ks, int half) { return d0 * 512 + ks * 2048 + half * 1024; }
template <int OFF> __device__ __forceinline__ s16x4 tr_read(int vb) {
  s16x4 r; asm volatile("ds_read_b64_tr_b16 %0, %1 offset:%2" : "=&v"(r) : "v"(vb), "i"(OFF) : "memory"); return r;
}
template <int D0> __device__ __forceinline__ void pv_one(f32x16& od, int vb, bf16x8 pa0, bf16x8 pa1) {
  const s16x4 l0 = tr_read<v_rd_off(D0, 0, 0)>(vb), h0 = tr_read<v_rd_off(D0, 0, 1)>(vb), l1 = tr_read<v_rd_off(D0, 1, 0)>(vb), h1 = tr_read<v_rd_off(D0, 1, 1)>(vb);
  asm volatile("s_waitcnt lgkmcnt(0)" ::: "memory"); __builtin_amdgcn_sched_barrier(0);
#define PK(L, H) (bf16x8){L[0], L[1], L[2], L[3], H[0], H[1], H[2], H[3]}
  od = __builtin_amdgcn_mfma_f32_32x32x16_bf16(pa0, PK(l0, h0), od, 0, 0, 0);
  od = __builtin_amdgcn_mfma_f32_32x32x16_bf16(pa1, PK(l1, h1), od, 0, 0, 0);
#undef PK
}
struct KVRegs { bf16x8 k[4], v[4]; int pk; };
struct TaskId { int b, h, g, r, ub; };
__device__ __forceinline__ TaskId task_at(int i, int bx, int G, int wave) {
  TaskId t; int bh, k; t.b = 0; t.h = 0; t.g = 0; t.r = 0; t.ub = -1;
  if (G == 256) { if (i >= 6) return t; bh = (bx & 7) + 8 * (bx >> 6); k = ((((bx >> 3) & 7) * 6 + i) << 3) + wave; }
  else { const int id = (i * G + bx) * 8 + wave; if (id >= 12288) return t; bh = id / 384; k = id % 384; }
  const int g = k >> 7, kk = k & 127, nub = g == 0 ? 128 : (g == 1 ? 32 : 8);
  t.b = bh >> 3; t.h = bh & 7; t.g = g; t.r = kk / nub; t.ub = kk % nub; return t;
}
struct Pre { bf16x8 qr[4]; int pos_q; KVRegs R; };
__device__ __forceinline__ void load_blk(const unsigned short* __restrict__ qkv, const int* __restrict__ pos, const TaskId& t, int kb, KVRegs& R) {
  const int lane = threadIdx.x & 63, r32 = lane & 31, srow = lane >> 1, shalf = (lane & 1) * 32;
  const int dl = t.g == 0 ? 1 : (t.g == 1 ? 4 : 16), L = S / dl; const size_t rowb = (size_t)t.b * S;
  int up = 32 * (t.ub - 2 + kb) + srow; up = up < 0 ? 0 : (up >= L ? L - 1 : up);
  const unsigned short* base = qkv + (rowb + t.r + dl * up) * 1536 + t.h * 64 + shalf;
#pragma unroll
  for (int c = 0; c < 4; ++c) { R.k[c] = *reinterpret_cast<const bf16x8*>(base + 512 + c * 8); R.v[c] = *reinterpret_cast<const bf16x8*>(base + 1024 + c * 8); }
  int upl = 32 * (t.ub - 2 + kb) + r32; upl = upl < 0 ? 0 : (upl >= L ? L - 1 : upl);
  R.pk = pos[rowb + t.r + dl * upl];
}
__device__ __forceinline__ int kb_first(const TaskId& t) { return (t.ub >= 2) ? 0 : (2 - t.ub); }
__device__ __forceinline__ void dil_prefetch(const unsigned short* __restrict__ qkv, const int* __restrict__ pos, const TaskId& t, Pre& P) {
  const int lane = threadIdx.x & 63, r32 = lane & 31, hi = lane >> 5;
  const int dl = t.g == 0 ? 1 : (t.g == 1 ? 4 : 16); const size_t rowb = (size_t)t.b * S; const int tok_q = t.r + dl * (32 * t.ub + r32);
  const unsigned short* Qw = qkv + (rowb + tok_q) * 1536 + t.h * 64 + hi * 8;
#pragma unroll
  for (int d0 = 0; d0 < 4; ++d0) P.qr[d0] = *reinterpret_cast<const bf16x8*>(Qw + d0 * 16);
  P.pos_q = pos[rowb + tok_q];
  load_blk(qkv, pos, t, kb_first(t), P.R);
}
__device__ __forceinline__ void dil_task(const unsigned short* __restrict__ qkv, const int* __restrict__ pos, unsigned short* __restrict__ oap, float* __restrict__ lse,
                                         const TaskId t, Pre& P, bool has_next, const TaskId tn, char* wl  ) {
  const int lane = threadIdx.x & 63, r32 = lane & 31, hi = lane >> 5;
  const int b = t.b, h = t.h, g = t.g, r = t.r, ub = t.ub;
  const int dl = g == 0 ? 1 : (g == 1 ? 4 : 16), L = S / dl;
  const int u_q = 32 * ub + r32;
  const size_t rowb = (size_t)b * S;
  const int tok_q = r + dl * u_q;
  const float* tblw = (const float*)(wl + W_TBL); int* posw = (int*)(wl + W_POS); float* alw = (float*)(wl + W_AL);
  bf16x8 qr[4];
#pragma unroll
  for (int d0 = 0; d0 < 4; ++d0) qr[d0] = P.qr[d0];
  const int pos_q = P.pos_q;
  const int pq0 = __builtin_amdgcn_readfirstlane(pos_q); const bool q_aff = __all(pos_q == pq0 + dl * r32);
  float* bvec = (float*)(wl + W_POS);
  const int srow = lane >> 1, shalf = (lane & 1) * 32;
  const int vb0 = (int)(uintptr_t)(wl + W_V) + v_rd_base(lane);
  float m_reg = -1e30f, l_reg = 0.f; f32x16 o[2] = {};
  const int kb_lo = kb_first(t), kb_hi = (32 * (ub + 3) <= L) ? 4 : (4 - ((32 * (ub + 3) - L) >> 5));
  KVRegs R = P.R;
  for (int kb = kb_lo; kb <= kb_hi; ++kb) {
#pragma unroll
    for (int c = 0; c < 4; ++c) {
      *(bf16x8*)(wl + W_K + DKSWZ(srow, (shalf + c * 8) * 2)) = R.k[c];
      *(bf16x8*)(wl + W_V + v_st(srow, shalf + c * 8)) = R.v[c];
    }
    const int pkb = R.pk; const int pk0 = __builtin_amdgcn_readfirstlane(pkb); const bool aff = q_aff && __all(pkb == pk0 + dl * r32);
    if (!aff) { if (hi == 0) posw[r32] = pkb; }
    else { int rel = pk0 - pq0 + dl * (lane - 31); rel = rel < -1024 ? -1024 : (rel > 1024 ? 1024 : rel); const int i_ = rel + 1024; bvec[lane] = tblw[i_ ^ ((i_ >> 5) & 31)]; }
    if (kb < kb_hi) load_blk(qkv, pos, t, kb + 1, R);
    asm volatile("s_waitcnt lgkmcnt(0)" ::: "memory"); __builtin_amdgcn_sched_barrier(0);
    f32x16 p = {};
#pragma unroll
    for (int d0 = 0; d0 < 4; ++d0) {
      const bf16x8 kf = *reinterpret_cast<const bf16x8*>(wl + W_K + DKSWZ(r32, (d0 * 16 + hi * 8) * 2));
      p = __builtin_amdgcn_mfma_f32_32x32x16_bf16(kf, qr[d0], p, 0, 0, 0);
    }
    float bmax;
    if (aff) {
      const float* bb = bvec + (31 - r32 + 4 * hi);
#pragma unroll
      for (int rr = 0; rr < 16; ++rr) p[rr] += bb[(rr & 3) + 8 * (rr >> 2)];
    } else {
      int idx[16];
#pragma unroll
      for (int rr = 0; rr < 16; ++rr) { int rel = posw[crow(rr, hi)] - pos_q; rel = rel < -1024 ? -1024 : (rel > 1024 ? 1024 : rel); const int i_ = rel + 1024; idx[rr] = i_ ^ ((i_ >> 5) & 31); }
#pragma unroll
      for (int rr = 0; rr < 16; ++rr) p[rr] += tblw[idx[rr]];
    }
    if (kb == 0) {
#pragma unroll
      for (int rr = 0; rr < 16; ++rr) p[rr] = crow(rr, hi) >= r32 ? p[rr] : -INFINITY;
    } else if (kb == 4) {
#pragma unroll
      for (int rr = 0; rr < 16; ++rr) p[rr] = crow(rr, hi) <= r32 ? p[rr] : -INFINITY;
    }
    bmax = fmaxf(fmaxf(p[0], p[1]), fmaxf(p[2], p[3]));
#pragma unroll
    for (int rr = 4; rr < 16; rr += 4) bmax = fmaxf(bmax, fmaxf(fmaxf(p[rr], p[rr + 1]), fmaxf(p[rr + 2], p[rr + 3])));
    { auto x = __builtin_amdgcn_permlane32_swap(__float_as_uint(bmax), __float_as_uint(bmax), false, false); bmax = fmaxf(__uint_as_float(x[0]), __uint_as_float(x[1])); }
    float alpha = 1.f; bool resc = false;
    if (!__all(bmax - m_reg <= 11.5f)) { const float mn = fmaxf(m_reg, bmax); alpha = __builtin_amdgcn_exp2f(m_reg - mn); m_reg = mn; resc = true; }
    float ps = 0.f;
#pragma unroll
    for (int rr = 0; rr < 16; ++rr) p[rr] = __builtin_amdgcn_exp2f(p[rr] - m_reg);
    ps = ((p[0] + p[1]) + (p[2] + p[3])) + ((p[4] + p[5]) + (p[6] + p[7])) + (((p[8] + p[9]) + (p[10] + p[11])) + ((p[12] + p[13]) + (p[14] + p[15])));
    { auto x = __builtin_amdgcn_permlane32_swap(__float_as_uint(ps), __float_as_uint(ps), false, false); ps = __uint_as_float(x[0]) + __uint_as_float(x[1]); }
    l_reg = l_reg * alpha + ps;
    if (resc && kb != kb_lo) {
      if (hi == 0) alw[r32] = alpha;
      asm volatile("s_waitcnt lgkmcnt(0)" ::: "memory");
#pragma unroll
      for (int d = 0; d < 2; ++d)
#pragma unroll
        for (int rr = 0; rr < 16; ++rr) o[d][rr] *= alw[crow(rr, hi)];
    }
    bf16x8 pa0, pa1;
#define PK4(P, BASE, OUT) do { u32x4 w = {cvtpk(P[BASE + 0], P[BASE + 1]), cvtpk(P[BASE + 2], P[BASE + 3]), cvtpk(P[BASE + 4], P[BASE + 5]), cvtpk(P[BASE + 6], P[BASE + 7])}; \
    OUT = *reinterpret_cast<bf16x8*>(&w); } while (0)
    PK4(p, 0, pa0); PK4(p, 8, pa1);
#undef PK4
    pv_one<0>(o[0], vb0, pa0, pa1); pv_one<1>(o[1], vb0, pa0, pa1);
  }
  if (has_next) dil_prefetch(qkv, pos, tn, P);
  float* liw = alw;
  if (hi == 0) liw[r32] = l_reg;
  asm volatile("s_waitcnt lgkmcnt(0)" ::: "memory");
  if (hi == 0) lse[((size_t)g * T + rowb + tok_q) * 8 + h] = (m_reg + __log2f(l_reg)) * 0.6931471805599453f;
  unsigned short* Ow = oap + ((size_t)g * T + rowb + r + (size_t)dl * 32 * ub) * 512 + h * 64;
  char* ot = wl + W_K;
#pragma unroll
  for (int rr = 0; rr < 16; ++rr) { const int orow = crow(rr, hi); const float rl = __builtin_amdgcn_rcpf(liw[orow]);
#pragma unroll
    for (int d0 = 0; d0 < 2; ++d0) *(unsigned short*)(ot + orow * 144 + (d0 * 32 + r32) * 2) = (unsigned short)cvtpk(o[d0][rr] * rl, 0.f); }
  asm volatile("s_waitcnt lgkmcnt(0)" ::: "memory");
#pragma unroll
  for (int ps = 0; ps < 4; ++ps) { const int orow = ps * 8 + (lane >> 3), c = lane & 7;
    const u32x4 w = *(const u32x4*)(ot + orow * 144 + c * 16);
    *(u32x4*)(Ow + (size_t)orow * dl * 512 + c * 8) = w; }
  asm volatile("s_waitcnt lgkmcnt(0)" ::: "memory");
}
#undef DKSWZ
}

namespace mk {
#define GAS __attribute__((address_space(1)))
#define LAS __attribute__((address_space(3)))
typedef unsigned short bf16_t;
typedef unsigned v4u __attribute__((ext_vector_type(4)));
typedef unsigned v2u __attribute__((ext_vector_type(2)));
typedef float f32x4 __attribute__((ext_vector_type(4)));
#define LDS_WAIT() asm volatile("s_waitcnt lgkmcnt(0)" ::: "memory")
#define VM_WAIT() asm volatile("s_waitcnt vmcnt(0)" ::: "memory")
__device__ __forceinline__ unsigned f2bf(float f) { unsigned u = __builtin_bit_cast(unsigned, f); return (u + 0x7fffu + ((u >> 16) & 1u)) >> 16; }
typedef float f32x2_t __attribute__((ext_vector_type(2))); typedef __bf16 bf16x2_t __attribute__((ext_vector_type(2)));
__device__ __forceinline__ unsigned pk2(float lo, float hi) { const f32x2_t v = {lo, hi}; const bf16x2_t b = __builtin_convertvector(v, bf16x2_t); return __builtin_bit_cast(unsigned, b); }
__device__ __forceinline__ float bf2f(unsigned short b) { return __builtin_bit_cast(float, (unsigned)b << 16); }
__device__ __forceinline__ float wave_sum(float v) {
#pragma unroll
    for (int o = 1; o < 64; o <<= 1) v += __shfl_xor(v, o);
    return v;
}

#define XB_TMO      128
#define XB_XCNT(j)  (256  + 64 * (j))
#define XB_XSUB(j)  (1280 + 64 * (j))
#define XB_XGEN(j)  (2304 + 64 * (j))
#define XB_TOP      3328
#define XB_TOPGEN   3392
#define XCD_BAR_WORDS 3456
#define XB_SPIN_CAP (1u << 18)

__device__ __forceinline__ unsigned xb_ld(unsigned* p)              { return __hip_atomic_load(p, __ATOMIC_RELAXED, __HIP_MEMORY_SCOPE_AGENT); }
__device__ __forceinline__ unsigned xb_add(unsigned* p, unsigned v) { return __hip_atomic_fetch_add(p, v, __ATOMIC_RELAXED, __HIP_MEMORY_SCOPE_AGENT); }
__device__ __forceinline__ unsigned xb_xcc_id() { return (unsigned)__builtin_amdgcn_s_getreg((3 << 11) | 20) & 0xFu; }
#define XB_SPIN(cond, bar) do { unsigned _sp = 0; while (cond) { __builtin_amdgcn_s_sleep(1); \
    if ((++_sp & 255u) == 0u) { if (xb_ld(&(bar)[XB_TMO])) break; if (_sp > XB_SPIN_CAP) { atomicAdd(&(bar)[XB_TMO], 1u); break; } } } } while (0)

struct XcdBarrier {
    unsigned* bar; unsigned x;
    volatile LAS unsigned* st;
};

__device__ __forceinline__ XcdBarrier xcd_barrier_post(unsigned* bar, volatile LAS unsigned* st) {
    XcdBarrier b; b.bar = bar; b.x = xb_xcc_id(); b.st = st;
    if (threadIdx.x == 0) (void)xb_add(&bar[XB_XCNT(b.x)], 1u);
    return b;
}
__device__ __forceinline__ void xcd_barrier_complete(unsigned* bar, unsigned x, unsigned& nloc, unsigned& nx) {
    const unsigned G = gridDim.x * gridDim.y * gridDim.z;
    unsigned sum, cnt, mine, sp = 0u;
    for (;;) {
        sum = 0u; cnt = 0u; mine = 0u;
#pragma unroll
        for (unsigned j = 0; j < 16; ++j) { const unsigned c = xb_ld(&bar[XB_XCNT(j)]); sum += c; cnt += (c > 0u) ? 1u : 0u; mine = (j == x) ? c : mine; }
        if (sum == G) break;
        __builtin_amdgcn_s_sleep(1);
        if ((++sp & 255u) == 0u) { if (xb_ld(&bar[XB_TMO])) break; if (sp > XB_SPIN_CAP) { atomicAdd(&bar[XB_TMO], 1u); break; } }
    }
    nloc = mine > 0u ? mine : 1u; nx = cnt > 0u ? cnt : 1u;
}

__device__ __forceinline__ void xcd_barrier(const XcdBarrier& b) {
    asm volatile("s_waitcnt vmcnt(0)" ::: "memory");
    __syncthreads();
    if (threadIdx.x == 0) {
        unsigned* bar = b.bar;
        __builtin_amdgcn_s_waitcnt(0);
        unsigned nloc = b.st[0], nx = b.st[1];
        if (nloc == 0u) { xcd_barrier_complete(bar, b.x, nloc, nx); b.st[0] = nloc; b.st[1] = nx; }
        const unsigned old = xb_add(&bar[XB_XSUB(b.x)], 1u);
        const unsigned gen = old / nloc;
        if (old + 1u == (gen + 1u) * nloc) {
            __builtin_amdgcn_fence(__ATOMIC_RELEASE, "agent");
            asm volatile("s_waitcnt vmcnt(0)" ::: "memory");
            const unsigned og = xb_add(&bar[XB_TOP], 1u);
            const unsigned tg = og / nx;
            if (og + 1u == (tg + 1u) * nx) xb_add(&bar[XB_TOPGEN], 1u);
            else XB_SPIN(xb_ld(&bar[XB_TOPGEN]) == tg, bar);
            __builtin_amdgcn_fence(__ATOMIC_ACQUIRE, "agent");
            xb_add(&bar[XB_XGEN(b.x)], 1u);
            asm volatile("s_waitcnt vmcnt(0)" ::: "memory");
        } else {
            XB_SPIN(xb_ld(&bar[XB_XGEN(b.x)]) == gen, bar);
            __builtin_amdgcn_fence(__ATOMIC_ACQUIRE, "agent");
            asm volatile("s_waitcnt vmcnt(0)" ::: "memory");
        }
    }
    __syncthreads();
}

constexpr int NWAVES = 8;
constexpr int LDS_BYTES = 147456;
constexpr int RING_BYTES = 131072;
constexpr int CTRL_OFF = 135168;
constexpr int MISC_OFF = CTRL_OFF + 320;
constexpr size_t MiB = 1u << 20;
constexpr size_t WS_CTL = 0, CTL_ZERO_BYTES = 1 * MiB;
constexpr int CW_BAR = 16384;
constexpr size_t WS_WIN = 1 * MiB, WS_WQB = 5 * MiB, WS_WKVB = 5 * MiB + 512 * 1024, WS_WO = 6 * MiB, WS_WMQG = 8 * MiB, WS_WMKV = 10 * MiB, WS_WMO = 14 * MiB;
constexpr size_t WS_RSTDX = 16 * MiB, WS_RSTDM = 16 * MiB + 64 * 1024, WS_SSQQ = 16 * MiB + 256 * 1024, WS_SSQKV = 16 * MiB + 512 * 1024, WS_TBL = 16 * MiB + 768 * 1024;
constexpr size_t WS_WRG = 16 * MiB + 896 * 1024;
constexpr size_t WS_SSQH1 = 17 * MiB, WS_SSQH2 = 18 * MiB, WS_ZKPE = 20 * MiB, WS_CS = 22 * MiB;
constexpr size_t WS_XB = 24 * MiB, WS_MEMB = 56 * MiB, WS_KVMEM = 58 * MiB, WS_KPE = 62 * MiB;
constexpr size_t WS_QKVA = 64 * MiB, WS_ZQ = 112 * MiB, WS_ZKV = 120 * MiB, WS_QB = 124 * MiB, WS_KN = 148 * MiB, WS_VB = 164 * MiB;
constexpr size_t WS_WPT = 180 * MiB, WS_VWT = 188 * MiB, WS_H2 = 196 * MiB, WS_H2B = 260 * MiB, WS_ROUTE = 292 * MiB, WS_XS = 296 * MiB;
constexpr size_t WS_HMID = 296 * MiB, WS_OAP = 440 * MiB, WS_LSE = 488 * MiB, WS_OB = 490 * MiB, WS_OMIX = 506 * MiB;
constexpr size_t WS_H1 = 538 * MiB, WS_H1B = 602 * MiB, WS_P = 634 * MiB, WS_YBUF = 666 * MiB;
constexpr size_t WS_WGU = 794 * MiB, WS_WD = 922 * MiB, WS_END = 986 * MiB;

constexpr size_t WS_H2Q = 954 * MiB;
constexpr size_t WS_H1Q = 970 * MiB;
constexpr float XA8_MUL = 8.0f, XA8_INV = 0.125f, P8_MUL = 256.0f, P8_INV = 1.0f / 256.0f;
constexpr float Y8_MUL = 8.0f, Y8_INV = 0.125f;
constexpr float W8_MUL = 64.0f, W8_INV = 1.0f / 64.0f, HM8_MUL = 4.0f, HM8_INV = 0.25f;
struct Args { const float* in[26]; float* out; unsigned char* ws; double rope_rev[16]; int ph_lo, ph_hi, flags, pad; };

struct CvtDesc { const float* W; const float* gain; bf16_t* WT; int K, N, mode, item, f8; float mul; };
__device__ __forceinline__ unsigned pk4f8(float a, float b, float c, float d) { int w = __builtin_amdgcn_cvt_pk_fp8_f32(a, b, 0, false); w = __builtin_amdgcn_cvt_pk_fp8_f32(c, d, w, true); return (unsigned)w; }
__device__ __forceinline__ void cvt_load(const CvtDesc& d, f32x4 (&v)[16], int lane) {
    const int nblk = (d.N + 63) >> 6, kb = d.item / nblk, nb = d.item % nblk, k0 = 64 * kb, n0 = 64 * nb;
    const int lk = lane >> 4, ln = (lane & 15) * 4;
    const bool ok = n0 + ln < d.N;
    const float* wp = d.W + (size_t)(k0 + lk) * d.N + n0 + ln;
#pragma unroll
    for (int i = 0; i < 16; ++i) v[i] = ok ? __builtin_nontemporal_load((const f32x4*)(wp + (size_t)(4 * i) * d.N)) : (f32x4){0.f, 0.f, 0.f, 0.f};
}
__device__ __forceinline__ void cvt_store(const CvtDesc& d, f32x4 (&v)[16], LAS float* scr, int lane) {
    const int nblk = (d.N + 63) >> 6, kb = d.item / nblk, nb = d.item % nblk, k0 = 64 * kb, n0 = 64 * nb;
    const int lk = lane >> 4, ln = (lane & 15) * 4;
    if (d.gain) {
#pragma unroll
        for (int i = 0; i < 16; ++i) v[i] = v[i] * (d.gain[k0 + 4 * i + lk] * d.mul);
    } else if (d.f8) {
#pragma unroll
        for (int i = 0; i < 16; ++i) v[i] = v[i] * d.mul;
    }
#pragma unroll
    for (int i = 0; i < 16; ++i) { LAS float* p = scr + (4 * i + lk) * 65 + ln; p[0] = v[i][0]; p[1] = v[i][1]; p[2] = v[i][2]; p[3] = v[i][3]; }
    LDS_WAIT(); asm volatile("" ::: "memory");
    int drow0 = n0; if (d.mode == 1) { const int half = n0 >> 10, c = n0 & 1023; drow0 = (c >> 7) * 256 + half * 128 + (c & 127); }
    if (d.f8) {
        const int c = lane & 3;
#pragma unroll
        for (int j = 0; j < 4; ++j) { const int n = (lane >> 2) + 16 * j; const LAS float* sp = scr + (16 * c) * 65 + n;
            v4u o; o.x = pk4f8(sp[0 * 65], sp[1 * 65], sp[2 * 65], sp[3 * 65]); o.y = pk4f8(sp[4 * 65], sp[5 * 65], sp[6 * 65], sp[7 * 65]);
            o.z = pk4f8(sp[8 * 65], sp[9 * 65], sp[10 * 65], sp[11 * 65]); o.w = pk4f8(sp[12 * 65], sp[13 * 65], sp[14 * 65], sp[15 * 65]);
            __builtin_nontemporal_store(o, (v4u*)((unsigned char*)d.WT + (size_t)(drow0 + n) * d.K + k0 + 16 * c)); }
    } else {
    const int c = lane & 7;
#pragma unroll
    for (int j = 0; j < 8; ++j) { const int n = (lane >> 3) + 8 * j; const LAS float* sp = scr + (8 * c) * 65 + n;
        v4u o; o.x = pk2(sp[0 * 65], sp[1 * 65]); o.y = pk2(sp[2 * 65], sp[3 * 65]); o.z = pk2(sp[4 * 65], sp[5 * 65]); o.w = pk2(sp[6 * 65], sp[7 * 65]);
        __builtin_nontemporal_store(o, (v4u*)(d.WT + (size_t)(drow0 + n) * d.K + k0 + 8 * c)); }
    }
    LDS_WAIT(); asm volatile("" ::: "memory");
}
__device__ __forceinline__ void prep_rows4(const float* x0, bf16_t* o0, float* rstd_out, int lane) {
    f32x4 v[4][4]; float s[4];
#pragma unroll
    for (int r = 0; r < 4; ++r)
#pragma unroll
        for (int j = 0; j < 4; ++j) v[r][j] = ((const f32x4*)(x0 + (size_t)r * 1024))[lane + 64 * j];
#pragma unroll
    for (int r = 0; r < 4; ++r) { float a = 0.f;
#pragma unroll
        for (int j = 0; j < 4; ++j) a += (v[r][j].x * v[r][j].x + v[r][j].y * v[r][j].y) + (v[r][j].z * v[r][j].z + v[r][j].w * v[r][j].w);
        s[r] = wave_sum(a); }
    if (lane < 4) rstd_out[lane] = 1.0f / sqrtf((lane == 0 ? s[0] : lane == 1 ? s[1] : lane == 2 ? s[2] : s[3]) * (1.0f / 1024.0f) + 1e-6f);
#pragma unroll
    for (int r = 0; r < 4; ++r) { unsigned long long* o8 = (unsigned long long*)(o0 + (size_t)r * 1024) + lane;
#pragma unroll
        for (int j = 0; j < 4; ++j) o8[64 * j] = (unsigned long long)pk2(v[r][j].x, v[r][j].y) | ((unsigned long long)pk2(v[r][j].z, v[r][j].w) << 32); }
}

__device__ __forceinline__ v4u pack8(const f32x4 a, const f32x4 b) { v4u w; w.x = pk2(a[0], a[1]); w.y = pk2(a[2], a[3]); w.z = pk2(b[0], b[1]); w.w = pk2(b[2], b[3]); return w; }
__device__ __forceinline__ float sq8(const f32x4 a, const f32x4 b) { return (a[0] * a[0] + a[1] * a[1]) + (a[2] * a[2] + a[3] * a[3]) + (b[0] * b[0] + b[1] * b[1]) + (b[2] * b[2] + b[3] * b[3]); }

struct EpiInProj {
    static constexpr bool PERM = true, AFTER_DRAIN = false;
    const float* rstd; bf16_t* qkv; bf16_t* zq; bf16_t* zkv; float* zkpe; float* ssq_q; float* ssq_kv;
    __device__ __forceinline__ void operator()(const pg8::f32x4 (&acc)[2][2][4][2], const pg8::Unit& u, int wr, int wc, int fr, int fq) const {
        const int row0 = u.pm * 256 + wr * 64 + fr;
        const float qs = u.pn < 2 ? 0.125f * 1.4426950408889634f : 1.0f;
        float rsv[8];
#pragma unroll
        for (int q = 0; q < 8; ++q) rsv[q] = rstd[row0 + (q >> 2) * 128 + (q & 3) * 16];
#pragma unroll
        for (int ai = 0; ai < 2; ++ai)
#pragma unroll
            for (int m = 0; m < 4; ++m) {
                const int row = row0 + ai * 128 + m * 16;
                const float rs = rsv[ai * 4 + m];
                float ss = 0.f;
#pragma unroll
                for (int bj = 0; bj < 2; ++bj) {
                    const f32x4 v0 = acc[ai][bj][m][0] * rs, v1 = acc[ai][bj][m][1] * rs;
                    const int ct = bj * 128 + wc * 32 + 8 * fq;
                    if (u.pn < 6) { *(v4u*)(qkv + (size_t)row * 1536 + u.pn * 256 + ct) = pack8(v0 * qs, v1 * qs); }
                    else if (u.pn == 6) { *(v4u*)(zq + (size_t)row * 256 + ct) = pack8(v0, v1); ss += sq8(v0, v1); }
                    else if (bj == 0) { *(v4u*)(zkv + (size_t)row * 128 + ct) = pack8(v0, v1); ss += sq8(v0, v1); }
                    else if (wc == 0) { *(f32x4*)(zkpe + (size_t)row * 32 + 8 * fq) = v0; *(f32x4*)(zkpe + (size_t)row * 32 + 8 * fq + 4) = v1; }
                }
                if (u.pn >= 6) { ss += __shfl_xor(ss, 16); ss += __shfl_xor(ss, 32); if (fq == 0) (u.pn == 6 ? ssq_q : ssq_kv)[(size_t)row * 4 + wc] = ss; }
            }
    }
};


struct EpiQ {
    static constexpr bool PERM = true, AFTER_DRAIN = false;
    const float* ssq; bf16_t* Q;
    __device__ __forceinline__ void operator()(const pg8::f32x4 (&acc)[2][2][4][2], const pg8::Unit& u, int wr, int wc, int fr, int fq) const {
        const int row0 = u.pm * 256 + wr * 64 + fr;
#pragma unroll
        for (int ai = 0; ai < 2; ++ai)
#pragma unroll
            for (int m = 0; m < 4; ++m) {
                const int row = row0 + ai * 128 + m * 16;
                const f32x4 sp = *(const f32x4*)(ssq + (size_t)row * 4);
                const float rs = (0.10206207261596577f * 1.4426950408889634f) / sqrtf(((sp[0] + sp[1]) + (sp[2] + sp[3])) * (1.0f / 256.0f) + 1e-6f);
#pragma unroll
                for (int bj = 0; bj < 2; ++bj)
                    *(v4u*)(Q + (size_t)row * 768 + u.pn * 256 + bj * 128 + wc * 32 + 8 * fq) = pack8(acc[ai][bj][m][0] * rs, acc[ai][bj][m][1] * rs);
            }
    }
};
struct EpiKV {
    static constexpr bool PERM = true, AFTER_DRAIN = false;
    const float* ssq; bf16_t* Kn; bf16_t* Vb;
    __device__ __forceinline__ void operator()(const pg8::f32x4 (&acc)[2][2][4][2], const pg8::Unit& u, int wr, int wc, int fr, int fq) const {
        const int row0 = u.pm * 256 + wr * 64 + fr;
        bf16_t* dst = (wc < 2 ? Kn : Vb) + (wc & 1) * 32 + 8 * fq;
#pragma unroll
        for (int ai = 0; ai < 2; ++ai)
#pragma unroll
            for (int m = 0; m < 4; ++m) {
                const int row = row0 + ai * 128 + m * 16;
                const f32x4 sp = *(const f32x4*)(ssq + (size_t)row * 4);
                const float rs = 1.0f / sqrtf(((sp[0] + sp[1]) + (sp[2] + sp[3])) * (1.0f / 128.0f) + 1e-6f);
#pragma unroll
                for (int bj = 0; bj < 2; ++bj)
                    *(v4u*)(dst + (size_t)row * 512 + (u.pn * 2 + bj) * 64) = pack8(acc[ai][bj][m][0] * rs, acc[ai][bj][m][1] * rs);
            }
    }
};
struct EpiRowScale {
    static constexpr bool PERM = true, AFTER_DRAIN = false;
    const float* rs; bf16_t* O; int ldc;
    __device__ __forceinline__ void operator()(const pg8::f32x4 (&acc)[2][2][4][2], const pg8::Unit& u, int wr, int wc, int fr, int fq) const {
        const int row0 = u.pm * 256 + wr * 64 + fr;
#pragma unroll
        for (int ai = 0; ai < 2; ++ai)
#pragma unroll
            for (int m = 0; m < 4; ++m) {
                const int row = row0 + ai * 128 + m * 16;
                const float r = rs[row];
#pragma unroll
                for (int bj = 0; bj < 2; ++bj)
                    *(v4u*)(O + (size_t)row * ldc + u.pn * 256 + bj * 128 + wc * 32 + 8 * fq) = pack8(acc[ai][bj][m][0] * r, acc[ai][bj][m][1] * r);
            }
    }
};

template <bool BASE_BF16, bool F8OUT = false> struct EpiResid {
    static constexpr bool PERM = true, AFTER_DRAIN = false;
    const void* base; bf16_t* outb; float* ssq; unsigned char* outq; float ascale;
    __device__ __forceinline__ void operator()(const pg8::f32x4 (&acc)[2][2][4][2], const pg8::Unit& u, int wr, int wc, int fr, int fq) const {
        const int row0 = u.pm * 256 + wr * 64 + fr;
#pragma unroll
        for (int ai = 0; ai < 2; ++ai)
#pragma unroll
            for (int m = 0; m < 4; ++m) {
                const int row = row0 + ai * 128 + m * 16;
                float ss = 0.f;
#pragma unroll
                for (int bj = 0; bj < 2; ++bj) {
                    const size_t o = (size_t)row * 1024 + u.pn * 256 + bj * 128 + wc * 32 + 8 * fq;
                    f32x4 b0, b1;
                    if constexpr (BASE_BF16) { const v4u w = *(const v4u*)((const bf16_t*)base + o);
                        b0 = (f32x4){__builtin_bit_cast(float, w[0] << 16), __builtin_bit_cast(float, w[0] & 0xffff0000u), __builtin_bit_cast(float, w[1] << 16), __builtin_bit_cast(float, w[1] & 0xffff0000u)};
                        b1 = (f32x4){__builtin_bit_cast(float, w[2] << 16), __builtin_bit_cast(float, w[2] & 0xffff0000u), __builtin_bit_cast(float, w[3] << 16), __builtin_bit_cast(float, w[3] & 0xffff0000u)}; }
                    else { b0 = *(const f32x4*)((const float*)base + o); b1 = *(const f32x4*)((const float*)base + o + 4); }
                    const f32x4 v0 = acc[ai][bj][m][0] * ascale + b0, v1 = acc[ai][bj][m][1] * ascale + b1;
                    *(v4u*)(outb + o) = pack8(v0, v1); ss += sq8(v0, v1);
                    if constexpr (F8OUT) *(v2u*)(outq + o) = (v2u){pk4f8(v0[0], v0[1], v0[2], v0[3]), pk4f8(v1[0], v1[1], v1[2], v1[3])};
                }
                ss += __shfl_xor(ss, 16); ss += __shfl_xor(ss, 32);
                if (fq == 0) ssq[(size_t)row * 16 + u.pn * 4 + wc] = ss;
                asm volatile("" ::: "memory");
            }
    }
};
struct EpiPlain {
    static constexpr bool PERM = true, AFTER_DRAIN = false;
    unsigned char* O; int ldc;
    __device__ __forceinline__ void operator()(const pg8::f32x4 (&acc)[2][2][4][2], const pg8::Unit& u, int wr, int wc, int fr, int fq) const {
        const int row0 = u.pm * 256 + wr * 64 + fr;
#pragma unroll
        for (int ai = 0; ai < 2; ++ai)
#pragma unroll
            for (int m = 0; m < 4; ++m)
#pragma unroll
                for (int bj = 0; bj < 2; ++bj) { const f32x4 a = acc[ai][bj][m][0] * XA8_MUL, b = acc[ai][bj][m][1] * XA8_MUL;
                    *(v2u*)(O + (size_t)(row0 + ai * 128 + m * 16) * ldc + u.pn * 256 + bj * 128 + wc * 32 + 8 * fq) = (v2u){pk4f8(a[0], a[1], a[2], a[3]), pk4f8(b[0], b[1], b[2], b[3])}; }
    }
};
struct EpiSoftmax {
    static constexpr bool PERM = true, AFTER_DRAIN = true;
    unsigned char* P; int rsl_off;
    __device__ __forceinline__ void fused(pg8::f32x4 (&acc)[2][2][4][2], const pg8::Unit& u, int wr, int wc, int fr, int fq, PG8_LAS unsigned char* lds, int wid, int lane) const {
        typedef float f32x2v __attribute__((ext_vector_type(2)));
        const PG8_LAS float* rsl = (const PG8_LAS float*)(lds + rsl_off);
        PG8_LAS f32x2v* X = (PG8_LAS f32x2v*)lds;
        constexpr float L2E = 1.4426950408889634f;
#pragma unroll
        for (int ai = 0; ai < 2; ++ai)
#pragma unroll
            for (int m = 0; m < 4; ++m) {
                const int rt = ai * 128 + wr * 64 + m * 16 + fr;
                const float rs = rsl[rt] * (0.0625f * L2E * XA8_INV);
                float mx = -3.0e38f;
#pragma unroll
                for (int bj = 0; bj < 2; ++bj)
#pragma unroll
                    for (int n = 0; n < 2; ++n) { f32x4 v = acc[ai][bj][m][n] * rs; acc[ai][bj][m][n] = v; mx = fmaxf(mx, fmaxf(fmaxf(v[0], v[1]), fmaxf(v[2], v[3]))); }
                mx = fmaxf(mx, __shfl_xor(mx, 16)); mx = fmaxf(mx, __shfl_xor(mx, 32));
                float sm = 0.f;
#pragma unroll
                for (int bj = 0; bj < 2; ++bj)
#pragma unroll
                    for (int n = 0; n < 2; ++n) { const f32x4 v = acc[ai][bj][m][n]; sm += (__builtin_amdgcn_exp2f(v[0] - mx) + __builtin_amdgcn_exp2f(v[1] - mx)) + (__builtin_amdgcn_exp2f(v[2] - mx) + __builtin_amdgcn_exp2f(v[3] - mx)); }
                sm += __shfl_xor(sm, 16); sm += __shfl_xor(sm, 32);
                if (fq == 0) X[rt * 4 + wc] = (f32x2v){mx, sm};
            }
        asm volatile("s_waitcnt lgkmcnt(0)" ::: "memory"); __builtin_amdgcn_s_barrier(); asm volatile("" ::: "memory");
#pragma unroll
        for (int ai = 0; ai < 2; ++ai)
#pragma unroll
            for (int m = 0; m < 4; ++m) {
                const int rt = ai * 128 + wr * 64 + m * 16 + fr;
                const f32x2v x0 = X[rt * 4 + 0], x1 = X[rt * 4 + 1], x2 = X[rt * 4 + 2], x3 = X[rt * 4 + 3];
                const float M = fmaxf(fmaxf(x0.x, x1.x), fmaxf(x2.x, x3.x));
                const float tot = (x0.y * __builtin_amdgcn_exp2f(x0.x - M) + x1.y * __builtin_amdgcn_exp2f(x1.x - M)) + (x2.y * __builtin_amdgcn_exp2f(x2.x - M) + x3.y * __builtin_amdgcn_exp2f(x3.x - M));
                const float inv = P8_MUL / tot;
#pragma unroll
                for (int bj = 0; bj < 2; ++bj) {
                    f32x4 a = acc[ai][bj][m][0], b = acc[ai][bj][m][1];
#pragma unroll
                    for (int j = 0; j < 4; ++j) { a[j] = __builtin_amdgcn_exp2f(a[j] - M) * inv; b[j] = __builtin_amdgcn_exp2f(b[j] - M) * inv; }
                    *(v2u*)(P + (size_t)(u.pm * 256 + rt) * 1024 + u.pn * 256 + bj * 128 + wc * 32 + 8 * fq) = (v2u){pk4f8(a[0], a[1], a[2], a[3]), pk4f8(b[0], b[1], b[2], b[3])};
                }
            }
    }
};
struct OrderWp {
    int c;
    __device__ __forceinline__ bool next(int i, pg8::Unit& u) const { if (i > 0 || c >= 64) return false; const int bhh = c >> 2, pn = c & 3, b = bhh >> 2, h = bhh & 3;
        u.pm = bhh; u.pn = pn; u.aoff = ((size_t)(b * 256) * 2048 + h * 256) * 2; u.boff = ((size_t)(pn * 256) * 1024 + h * 256) * 2; return true; }
    __device__ __forceinline__ void a_ready(const pg8::Unit&) const {}
    __device__ __forceinline__ void done(const pg8::Unit&) const {}
};
struct OrderVw {
    int c;
    __device__ __forceinline__ bool next(int i, pg8::Unit& u) const { if (i > 0 || c >= 64) return false; const int b = c >> 4, ct = (c >> 2) & 3, h = c & 3;
        u.pm = b * 4 + ct; u.pn = h; u.aoff = ((size_t)(ct * 256) * 1024 + h * 256) * 2; u.boff = ((size_t)(b * 256) * 2048 + 1024 + h * 256) * 2; return true; }
    __device__ __forceinline__ void a_ready(const pg8::Unit&) const {}
    __device__ __forceinline__ void done(const pg8::Unit&) const {}
};
struct OrderBatch {
    pg8::StaticOrder so;
    __device__ __forceinline__ bool next(int i, pg8::Unit& u) const { if (!so.next(i, u)) return false; u.boff = ((size_t)((u.pm >> 4) * 1024 + u.pn * 256) * 1024); return true; }
    __device__ __forceinline__ void a_ready(const pg8::Unit&) const {}
    __device__ __forceinline__ void done(const pg8::Unit&) const {}
};

constexpr int MPADN = NA + NE * 256, NTILEN = MPADN / 256;
constexpr int CW_GCOUNT = 8192;
constexpr size_t RT_TOPI = 0, RT_TOPG = 256 * 1024, RT_SLOT = 512 * 1024, RT_ROWFLAT = 768 * 1024, RT_RSROW = 1088 * 1024, RT_RSTD = 1408 * 1024, RT_CNT = 1536 * 1024, RT_TOT = 1600 * 1024, RT_RGATE = 1664 * 1024;
constexpr int LX_TEXP = CTRL_OFF + 2048;
struct OrderMoe {
    const LAS int* texp; int nper, c, G; size_t ebytes;
    __device__ __forceinline__ bool next(int i, pg8::Unit& u) const {
        const int L = i * G + (c & 7) * (G >> 3) + (c >> 3); const int tile = L / nper, pn = L % nper;
        if (tile >= texp[NTILEN]) return false;
        u.pm = tile; u.pn = pn; u.aoff = (size_t)tile * 256 * 1024; u.boff = (size_t)texp[tile] * ebytes + (size_t)pn * 256 * 1024; return true; }
    __device__ __forceinline__ void a_ready(const pg8::Unit&) const {}
    __device__ __forceinline__ void done(const pg8::Unit&) const {}
};
__device__ __forceinline__ float swiglu1(float g, float u) { g = fminf(g, 7.0f); u = fminf(fmaxf(u, -7.0f), 7.0f); return (u + 1.0f) * g * __builtin_amdgcn_rcpf(1.0f + __builtin_amdgcn_exp2f(-1.702f * 1.4426950408889634f * g)); }
struct EpiSwiGLU {
    static constexpr bool PERM = true, AFTER_DRAIN = false;
    const float* rs_row; const float* bgu; unsigned char* hmid; const LAS int* texp;
    __device__ __forceinline__ void operator()(const pg8::f32x4 (&acc)[2][2][4][2], const pg8::Unit& u, int wr, int wc, int fr, int fq) const {
        const int row0 = u.pm * 256 + wr * 64 + fr, e = texp[u.pm], c0 = u.pn * 128 + wc * 32 + 8 * fq;
        const float* bg = bgu + (size_t)e * 2048 + c0;
        const f32x4 bg0 = *(const f32x4*)bg, bg1 = *(const f32x4*)(bg + 4), bu0 = *(const f32x4*)(bg + 1024), bu1 = *(const f32x4*)(bg + 1028);
        float rsv[8];
#pragma unroll
        for (int q = 0; q < 8; ++q) rsv[q] = rs_row[row0 + (q >> 2) * 128 + (q & 3) * 16] * W8_INV;
#pragma unroll
        for (int ai = 0; ai < 2; ++ai)
#pragma unroll
            for (int m = 0; m < 4; ++m) {
                const int row = row0 + ai * 128 + m * 16; const float rs = rsv[ai * 4 + m];
                const f32x4 g0 = acc[ai][0][m][0] * rs + bg0, g1 = acc[ai][0][m][1] * rs + bg1, u0 = acc[ai][1][m][0] * rs + bu0, u1 = acc[ai][1][m][1] * rs + bu1;
                f32x4 h0, h1;
#pragma unroll
                for (int j = 0; j < 4; ++j) { h0[j] = swiglu1(g0[j], u0[j]) * HM8_MUL; h1[j] = swiglu1(g1[j], u1[j]) * HM8_MUL; }
                *(v2u*)(hmid + (size_t)row * 1024 + c0) = (v2u){pk4f8(h0[0], h0[1], h0[2], h0[3]), pk4f8(h1[0], h1[1], h1[2], h1[3])};
            }
    }
};
struct EpiDown {
    static constexpr bool PERM = true, AFTER_DRAIN = false;
    const int* row_flat; const float* topg; const float* bd; unsigned char* ybuf; const LAS int* texp;
    __device__ __forceinline__ void operator()(const pg8::f32x4 (&acc)[2][2][4][2], const pg8::Unit& u, int wr, int wc, int fr, int fq) const {
        const int row0 = u.pm * 256 + wr * 64 + fr, e = texp[u.pm], c0 = u.pn * 256 + wc * 32 + 8 * fq;
        const float* bp = bd + (size_t)e * 1024 + c0;
        f32x4 bv[2][2];
#pragma unroll
        for (int bj = 0; bj < 2; ++bj) { bv[bj][0] = *(const f32x4*)(bp + bj * 128); bv[bj][1] = *(const f32x4*)(bp + bj * 128 + 4); }
        int av[8]; float gv[8];
#pragma unroll
        for (int q = 0; q < 8; ++q) { const int row = row0 + (q >> 2) * 128 + (q & 3) * 16; av[q] = row_flat[row]; gv[q] = topg[row]; }
#pragma unroll
        for (int ai = 0; ai < 2; ++ai)
#pragma unroll
            for (int m = 0; m < 4; ++m) {
                const int a = av[ai * 4 + m];
                if (a >= 0) { const float gt = gv[ai * 4 + m] * Y8_MUL;
#pragma unroll
                    for (int bj = 0; bj < 2; ++bj) { const f32x4 y0 = (acc[ai][bj][m][0] * (W8_INV * HM8_INV) + bv[bj][0]) * gt, y1 = (acc[ai][bj][m][1] * (W8_INV * HM8_INV) + bv[bj][1]) * gt;
                        *(v2u*)(ybuf + (size_t)a * 1024 + c0 + bj * 128) = (v2u){pk4f8(y0[0], y0[1], y0[2], y0[3]), pk4f8(y1[0], y1[1], y1[2], y1[3])}; } }
            }
    }
};

__device__ __forceinline__ int rel_bucket_d(int rel) {
    int n = rel < 0 ? -rel : rel;
    int b;
    if (n < 8) b = n; else if (n < 15) b = 8; else if (n < 27) b = 9; else if (n < 50) b = 10; else if (n < 91) b = 11;
    else if (n < 166) b = 12; else if (n < 305) b = 13; else if (n < 559) b = 14; else b = 15;
    return b + (rel > 0 ? 16 : 0);
}

static_assert(pg8::GTAB == CTRL_OFF + 4096 && pg8::GTAB + pg8::GTAB_UNITS * 512 <= LDS_BYTES && (NTILEN * 8 + 255) / 256 <= pg8::GTAB_UNITS && NWAVES * dil::W_BYTES <= CTRL_OFF && mla::SHM_ATTN <= CTRL_OFF && RING_BYTES <= CTRL_OFF && LX_TEXP + 4 * (NTILEN + 1) <= LDS_BYTES, "LDS map");
__global__ void __launch_bounds__(NWAVES * 64, 2) mk_fwd(Args args) {
    extern __shared__ __attribute__((aligned(16))) unsigned char lds_raw[];
    LAS unsigned char* lds = (LAS unsigned char*)lds_raw;
    const int tid = threadIdx.x, lane = tid & 63, wave = __builtin_amdgcn_readfirstlane(tid >> 6);
    const int G = gridDim.x; const int bx = blockIdx.x; const int vcu = (G % 8 == 0) ? (bx % 8) * (G / 8) + bx / 8 : bx;
    unsigned char* ws = args.ws;
    const int lo = args.ph_lo, hi = args.ph_hi;
#define IN(k) (lo <= (k) && (k) < hi)
#define BOTH(k) (IN(k) && IN((k) + 1))
    for (int u = tid; u < (LDS_BYTES - CTRL_OFF) / 4; u += NWAVES * 64) ((LAS unsigned*)(lds + CTRL_OFF))[u] = 0u;
    __syncthreads();
    XcdBarrier bar; bar.bar = (unsigned*)(ws + WS_CTL) + CW_BAR; bar.x = 0; bar.st = nullptr;
    if (hi - lo > 1) bar = xcd_barrier_post((unsigned*)(ws + WS_CTL) + CW_BAR, (volatile LAS unsigned*)(lds + MISC_OFF) + 8);
#define GRID_BAR(k) do { if (BOTH(k)) xcd_barrier(bar); } while (0)
    const float* x = args.in[0]; const float* mem = args.in[1]; const float* g_mix = args.in[3]; const float* w_in = args.in[4];
    const float* g_q_a = args.in[5]; const float* w_q_b = args.in[6]; const float* g_kv_a = args.in[7]; const float* w_kv_b = args.in[8];
    const float* w_o = args.in[12]; const float* g_xattn = args.in[13]; const float* g_mem = args.in[14]; const float* w_mq = args.in[15];
    const float* w_mkv = args.in[16]; const float* w_mo = args.in[17]; const float* g_moe = args.in[18];
    const float* w_gate_up = args.in[21]; const float* w_down = args.in[23];
    bf16_t* WinT = (bf16_t*)(ws + WS_WIN); bf16_t* WqbT = (bf16_t*)(ws + WS_WQB); bf16_t* WkvbT = (bf16_t*)(ws + WS_WKVB); bf16_t* WoT = (bf16_t*)(ws + WS_WO);
    bf16_t* Wmqg = (bf16_t*)(ws + WS_WMQG); bf16_t* WmkvT = (bf16_t*)(ws + WS_WMKV); bf16_t* WmoT = (bf16_t*)(ws + WS_WMO);
    bf16_t* WguT = (bf16_t*)(ws + WS_WGU); bf16_t* WdT = (bf16_t*)(ws + WS_WD);
    bf16_t* xb = (bf16_t*)(ws + WS_XB); bf16_t* memb = (bf16_t*)(ws + WS_MEMB);
    float* rstd_x = (float*)(ws + WS_RSTDX); float* rstd_mem = (float*)(ws + WS_RSTDM);

    if (IN(0)) {
        LAS float* scr = (LAS float*)(lds + wave * 16640);
        const int gw = vcu * NWAVES + wave, NGW = G * NWAVES;
        constexpr int I_IN = 16 * 31, I_QB = 4 * 12, I_KVB = 2 * 16, I_O = 16 * 16, I_MKV = 16 * 32, I_MO = 16 * 16, I_GU = 16 * 32, I_D = 16 * 16;
        const int n_exp = (args.flags & 1) ? 32 : 0;
        const int NITEMS = I_IN + I_QB + I_KVB + I_O + I_MKV + I_MO + n_exp * (I_GU + I_D);
        auto desc = [&](int it) {
            CvtDesc d; int r = it; d.mode = 0; d.f8 = 0; d.mul = 1.0f;
            if (r < I_IN) { d.W = w_in; d.K = 1024; d.N = 1952; d.gain = g_mix; d.WT = WinT; }
            else if ((r -= I_IN) < I_QB) { d.W = w_q_b; d.K = 256; d.N = 768; d.gain = g_q_a; d.WT = WqbT; }
            else if ((r -= I_QB) < I_KVB) { d.W = w_kv_b; d.K = 128; d.N = 1024; d.gain = g_kv_a; d.WT = WkvbT; }
            else if ((r -= I_KVB) < I_O) { d.W = w_o; d.K = 1024; d.N = 1024; d.gain = nullptr; d.WT = WoT; }
            else if ((r -= I_O) < I_MKV) { d.W = w_mkv; d.K = 1024; d.N = 2048; d.gain = g_mem; d.WT = WmkvT; }
            else if ((r -= I_MKV) < I_MO) { d.W = w_mo; d.K = 1024; d.N = 1024; d.gain = nullptr; d.WT = WmoT; }
            else if ((r -= I_MO) < 32 * I_GU) { const int e = r / I_GU; r -= e * I_GU; d.W = w_gate_up + (size_t)e * 1024 * 2048; d.K = 1024; d.N = 2048; d.gain = g_moe; d.WT = (bf16_t*)((unsigned char*)WguT + (size_t)e * 2048 * 1024); d.mode = 1; d.f8 = 1; d.mul = W8_MUL; }
            else { r -= 32 * I_GU; const int e = r / I_D; r -= e * I_D; d.W = w_down + (size_t)e * 1024 * 1024; d.K = 1024; d.N = 1024; d.gain = nullptr; d.WT = (bf16_t*)((unsigned char*)WdT + (size_t)e * 1024 * 1024); d.f8 = 1; d.mul = W8_MUL; }
            d.item = r; return d; };
        {
            f32x4 va[16], vb[16]; CvtDesc dc = desc(0), dn = dc; bool have = false;
            for (int it = gw; ; it += NGW) {
                const bool more = it < NITEMS;
                if (more) { dn = desc(it); cvt_load(dn, vb, lane); }
                if (have) cvt_store(dc, va, scr, lane);
                if (!more) break;
#pragma unroll
                for (int i = 0; i < 16; ++i) va[i] = vb[i];
                dc = dn; have = true;
            }
        }
        for (int i = gw * 64 + lane; i < 64 * 1024 / 8; i += NGW * 64) ((v4u*)(WinT + (size_t)1984 * 1024))[i] = (v4u){0u, 0u, 0u, 0u};
        for (int m = gw * 4; m < T; m += NGW * 4) prep_rows4(x + (size_t)m * D, xb + (size_t)m * D, rstd_x + m, lane);
        for (int m = gw * 4; m < NB * NMEM; m += NGW * 4) prep_rows4(mem + (size_t)m * D, memb + (size_t)m * D, rstd_mem + m, lane);
        { const float* w_router = args.in[19]; float* wrg = (float*)(ws + WS_WRG); for (int i = bx * 512 + tid; i < 1024 * 32; i += G * 512) wrg[i] = w_router[i] * g_moe[i >> 5]; }
        for (int m = gw; m < D; m += NGW) {
            const f32x4* xr = (const f32x4*)(w_mq + (size_t)m * D) + lane; const float gc = g_xattn[m];
            unsigned long long* o8 = (unsigned long long*)(Wmqg + (size_t)m * D) + lane;
#pragma unroll
            for (int j = 0; j < 4; ++j) { const f32x4 v = xr[64 * j] * gc; o8[64 * j] = (unsigned long long)pk2(v.x, v.y) | ((unsigned long long)pk2(v.z, v.w) << 32); }
        }
    }
    if (IN(0)) {
        const float* rel_bias = args.in[9]; float* tbl = (float*)(ws + WS_TBL);
        for (int i = bx * 512 + tid; i < 8 * 2049; i += G * 512) { const int h = i / 2049, r = i % 2049; tbl[h * 2112 + r] = rel_bias[rel_bucket_d(r - 1024) * 8 + h]; }
    }
    GRID_BAR(0);
    if (IN(1)) {
        int kx = 1024; asm volatile("" : "+s"(kx)); pg8::Gemm g{xb, WinT, kx, kx, kx}; pg8::StaticOrder S; S.init(T, 2048, 1024, 1024, G, bx);
        EpiInProj E{rstd_x, (bf16_t*)(ws + WS_QKVA), (bf16_t*)(ws + WS_ZQ), (bf16_t*)(ws + WS_ZKV), (float*)(ws + WS_ZKPE), (float*)(ws + WS_SSQQ), (float*)(ws + WS_SSQKV)};
        pg8::gemm_phase<EpiInProj, pg8::StaticOrder, true, true>(lds, g, S, E);
    }
    GRID_BAR(1);
    if (IN(2)) {
        const int* pos = (const int*)args.in[2];
        float* cs = (float*)(ws + WS_CS); const float* zkpe = (const float*)(ws + WS_ZKPE); bf16_t* kpe = (bf16_t*)(ws + WS_KPE);
        for (int i = bx * 512 + tid; i < T * 16; i += G * 512) {
            const int t = i >> 4, j = i & 15;
            const double rev = (double)pos[t] * args.rope_rev[j];
            const float fr_ = (float)(rev - floor(rev));
            const float sn = __builtin_amdgcn_sinf(fr_), c_ = __builtin_amdgcn_cosf(fr_);
            cs[(size_t)t * 32 + j] = c_; cs[(size_t)t * 32 + 16 + j] = sn;
            const float x1 = zkpe[(size_t)t * 32 + j], x2 = zkpe[(size_t)t * 32 + 16 + j];
            kpe[(size_t)t * 32 + j] = (bf16_t)f2bf(x1 * c_ - x2 * sn); kpe[(size_t)t * 32 + 16 + j] = (bf16_t)f2bf(x1 * sn + x2 * c_);
        }
        {   int kq = 256; asm volatile("" : "+s"(kq)); pg8::Gemm g{(const bf16_t*)(ws + WS_ZQ), WqbT, kq, kq, kq}; pg8::StaticOrder S; S.init(T, 768, 256, 256, G, bx);
            EpiQ E{(const float*)(ws + WS_SSQQ), (bf16_t*)(ws + WS_QB)};
            pg8::gemm_phase<EpiQ, pg8::StaticOrder, true, true>(lds, g, S, E); }
        {   int kk = 128; asm volatile("" : "+s"(kk)); pg8::Gemm g{(const bf16_t*)(ws + WS_ZKV), WkvbT, kk, kk, kk}; const bool memcu = ((bx + 64) % G) < 32 && G > 64; const int bx2 = bx - (bx >= G - 64 + 32 ? 32 : 0);
            pg8::StaticOrder S; S.init(memcu ? 0 : T, 1024, 128, 128, G > 64 ? G - 32 : G, G > 64 ? bx2 : bx);
            EpiKV E{(const float*)(ws + WS_SSQKV), (bf16_t*)(ws + WS_KN), (bf16_t*)(ws + WS_VB)};
            pg8::gemm_phase<EpiKV, pg8::StaticOrder, true, true>(lds, g, S, E); }
        {   int kx = 1024; asm volatile("" : "+s"(kx)); pg8::Gemm g{memb, WmkvT, kx, kx, kx}; pg8::StaticOrder S; S.init(NB * NMEM, 2048, 1024, 1024, G, (bx + 64) % G);
            EpiRowScale E{rstd_mem, (bf16_t*)(ws + WS_KVMEM), 2048};
            pg8::gemm_phase<EpiRowScale, pg8::StaticOrder, true, true>(lds, g, S, E); }
    }
    GRID_BAR(2);
    if (IN(3)) {
        const unsigned short* Qg = (const unsigned short*)(ws + WS_QB); const unsigned short* Kn = (const unsigned short*)(ws + WS_KN);
        const unsigned short* Kp = (const unsigned short*)(ws + WS_KPE); const unsigned short* Vg = (const unsigned short*)(ws + WS_VB);
        const float* cs = (const float*)(ws + WS_CS); unsigned short* Og = (unsigned short*)(ws + WS_OB);
        for (int i = 0; !(args.flags & 8); ++i) {
            int bh, qb;
            if (G == 256) { if (i >= 2) break; const int idx = i * 32 + (bx >> 3); bh = (bx & 7) + 8 * (idx >> 4); qb = idx & 15; }
            else { const int un = i * G + bx; if (un >= 512) break; bh = un >> 4; qb = un & 15; }
            const int b = bh >> 3, h = bh & 7;
#ifdef MLA_ABL
            if (args.flags & 16) mla::mla_unit<MLA_ABL>(Qg, Kn, Kp, Vg, cs, Og, b * S + qb * 256, b * S, h, S, (char*)lds_raw); else
#endif
            mla::mla_unit<0>(Qg, Kn, Kp, Vg, cs, Og, b * S + qb * 256, b * S, h, S, (char*)lds_raw);
        }
        {
            const unsigned short* qkv = (const unsigned short*)(ws + WS_QKVA); const int* pos = (const int*)args.in[2];
            const float* tbl = (const float*)(ws + WS_TBL); unsigned short* oap = (unsigned short*)(ws + WS_OAP); float* lse = (float*)(ws + WS_LSE);
            char* wl = (char*)lds_raw + wave * dil::W_BYTES;
            __syncthreads();
            int cur_h = -1;
            dil::TaskId tc = dil::task_at(0, bx, G, wave), tn = tc; dil::Pre P;
            bool have = !(args.flags & 4) && tc.ub >= 0;
            if (have) dil::dil_prefetch(qkv, pos, tc, P);
            for (int i = 0; have; ++i) {
                tn = dil::task_at(i + 1, bx, G, wave); const bool has_next = tn.ub >= 0;
                if (tc.h != cur_h) { float* tw = (float*)(wl + dil::W_TBL); for (int j = lane; j < 2049; j += 64) tw[j ^ ((j >> 5) & 31)] = tbl[tc.h * dil::TBL_PITCH + j] * 1.4426950408889634f; cur_h = tc.h; asm volatile("s_waitcnt vmcnt(0) lgkmcnt(0)" ::: "memory"); }
                dil::dil_task(qkv, pos, oap, lse, tc, P, has_next, tn, wl);
                tc = tn; have = has_next;
            }
        }
    }
    GRID_BAR(3);
    if (IN(4)) {
        { int kx = 256; asm volatile("" : "+s"(kx));
          if (bx < 64) { pg8::Gemm g{(const bf16_t*)(ws + WS_KVMEM), Wmqg, 2048, 1024, kx}; OrderWp S{bx}; EpiPlain E{(unsigned char*)(ws + WS_WPT), 1024};
              pg8::gemm_phase<EpiPlain, OrderWp, true, true>(lds, g, S, E); }
          else if (bx < 128) { pg8::Gemm g{WmoT, (const bf16_t*)(ws + WS_KVMEM), 1024, 2048, kx}; OrderVw S{bx - 64}; EpiPlain E{(unsigned char*)(ws + WS_VWT), 1024};
              pg8::gemm_phase<EpiPlain, OrderVw, true, true>(lds, g, S, E); } }
        const bf16_t* oap = (const bf16_t*)(ws + WS_OAP); const float* lse = (const float*)(ws + WS_LSE); const bf16_t* obp = (const bf16_t*)(ws + WS_OB);
        const float* g_out_a = args.in[10]; const float* g_out_b = args.in[11]; bf16_t* omix = (bf16_t*)(ws + WS_OMIX);
        const int gw = vcu * NWAVES + wave, NGW = G * NWAVES;
        const f32x4 ga0 = *(const f32x4*)(g_out_a + 8 * lane), ga1 = *(const f32x4*)(g_out_a + 8 * lane + 4), gb0 = *(const f32x4*)(g_out_b + 8 * lane), gb1 = *(const f32x4*)(g_out_b + 8 * lane + 4);
#define UNPK_LO(V_) ((f32x4){__builtin_bit_cast(float, (V_)[0] << 16), __builtin_bit_cast(float, (V_)[0] & 0xffff0000u), __builtin_bit_cast(float, (V_)[1] << 16), __builtin_bit_cast(float, (V_)[1] & 0xffff0000u)})
#define UNPK_HI(V_) ((f32x4){__builtin_bit_cast(float, (V_)[2] << 16), __builtin_bit_cast(float, (V_)[2] & 0xffff0000u), __builtin_bit_cast(float, (V_)[3] << 16), __builtin_bit_cast(float, (V_)[3] & 0xffff0000u)})
        for (int tok = gw; tok < T; tok += NGW) {
            const int head = lane >> 3;
            const float l0 = lse[((size_t)0 * T + tok) * 8 + head], l1 = lse[((size_t)1 * T + tok) * 8 + head], l2 = lse[((size_t)2 * T + tok) * 8 + head];
            const float mx = fmaxf(l0, fmaxf(l1, l2)); float w0 = __expf(l0 - mx), w1 = __expf(l1 - mx), w2 = __expf(l2 - mx); const float wi = 1.0f / (w0 + w1 + w2); w0 *= wi; w1 *= wi; w2 *= wi;
            const v4u q0 = *(const v4u*)(oap + ((size_t)0 * T + tok) * 512 + 8 * lane), q1 = *(const v4u*)(oap + ((size_t)1 * T + tok) * 512 + 8 * lane);
            const v4u q2 = *(const v4u*)(oap + ((size_t)2 * T + tok) * 512 + 8 * lane), qb = *(const v4u*)(obp + (size_t)tok * 512 + 8 * lane);
            const f32x4 a0 = UNPK_LO(q0) * w0 + UNPK_LO(q1) * w1 + UNPK_LO(q2) * w2, a1 = UNPK_HI(q0) * w0 + UNPK_HI(q1) * w1 + UNPK_HI(q2) * w2, b0 = UNPK_LO(qb), b1 = UNPK_HI(qb);
            const float sa = wave_sum(sq8(a0, a1)), sb = wave_sum(sq8(b0, b1));
            const float ra = 1.0f / sqrtf(sa * (1.0f / 512.0f) + 1e-6f), rb = 1.0f / sqrtf(sb * (1.0f / 512.0f) + 1e-6f);
            *(v4u*)(omix + (size_t)tok * 1024 + 8 * lane) = pack8(a0 * ra * ga0, a1 * ra * ga1);
            *(v4u*)(omix + (size_t)tok * 1024 + 512 + 8 * lane) = pack8(b0 * rb * gb0, b1 * rb * gb1);
        }
#undef UNPK_LO
#undef UNPK_HI
    }
    GRID_BAR(4);
    if (IN(5)) {
        int kx = 1024; asm volatile("" : "+s"(kx));
        pg8::Gemm g{(const bf16_t*)(ws + WS_OMIX), WoT, kx, kx, kx}; pg8::StaticOrder S; S.init(T, 1024, 1024, 1024, G, bx);
        EpiResid<false, true> E{x, (bf16_t*)(ws + WS_H1B), (float*)(ws + WS_SSQH1), (unsigned char*)(ws + WS_H1Q), 1.0f};
        pg8::gemm_phase<EpiResid<false, true>, pg8::StaticOrder, true, true>(lds, g, S, E);
    }
    GRID_BAR(5);
    if (IN(6)) {
        int kx = 512; asm volatile("" : "+s"(kx));
        pg8::Gemm g{(const bf16_t*)(ws + WS_H1Q), (const bf16_t*)(ws + WS_WPT), kx, kx, kx}; OrderBatch S; S.so.init(T, 1024, 512, 512, G, bx);
        pg8::Unit u0; const bool has = S.next(0, u0);
        LAS float* rsl = (LAS float*)(lds + CTRL_OFF + 1024);
        if (has && tid < 256) { const float* sp = (const float*)(ws + WS_SSQH1) + (size_t)(u0.pm * 256 + tid) * 16; float a = 0.f;
#pragma unroll
            for (int j = 0; j < 4; ++j) { const f32x4 v = ((const f32x4*)sp)[j]; a += (v[0] + v[1]) + (v[2] + v[3]); }
            rsl[tid] = 1.0f / sqrtf(a * (1.0f / 1024.0f) + 1e-6f); }
        __syncthreads();
        EpiSoftmax E{(unsigned char*)(ws + WS_P), CTRL_OFF + 1024};
        pg8::gemm_phase<EpiSoftmax, OrderBatch, false, true, false, true>(lds, g, S, E);
    }
    GRID_BAR(6);
    if (IN(7)) {
        int kx = 512; asm volatile("" : "+s"(kx));
        pg8::Gemm g{(const bf16_t*)(ws + WS_P), (const bf16_t*)(ws + WS_VWT), kx, kx, kx}; OrderBatch S; S.so.init(T, 1024, 512, 512, G, bx);
        EpiResid<true, true> E{(const bf16_t*)(ws + WS_H1B), (bf16_t*)(ws + WS_H2B), (float*)(ws + WS_SSQH2), (unsigned char*)(ws + WS_H2Q), P8_INV * XA8_INV};
        pg8::gemm_phase<EpiResid<true, true>, OrderBatch, true, true, false, true>(lds, g, S, E);
    }
    GRID_BAR(7);
    if (IN(8)) {
        typedef float f32x16 __attribute__((ext_vector_type(16)));
        const bf16_t* h2b = (const bf16_t*)(ws + WS_H2B); const float* b_router = args.in[20]; const float* ssq2 = (const float*)(ws + WS_SSQH2);
        int* topi = (int*)(ws + WS_ROUTE + RT_TOPI); float* topg = (float*)(ws + WS_ROUTE + RT_TOPG); int* tslot = (int*)(ws + WS_ROUTE + RT_SLOT); int* row_flat = (int*)(ws + WS_ROUTE + RT_ROWFLAT);
        for (int i = bx * 512 + tid; i < MPADN; i += G * 512) row_flat[i] = -1;
        LAS float* part = (LAS float*)lds;
        LAS float* lgt = (LAS float*)(lds + 32768);
        for (int ch = bx; ch < T / 64; ch += G) {
            const int tok0 = ch * 64, tb = wave & 1, kq = wave >> 1, kh = lane >> 5, row = tok0 + 32 * tb + (lane & 31);
            f32x16 acc = {};
            const bf16_t* ap = h2b + (size_t)row * 1024 + 256 * kq + 4 * kh; const float* wp = (const float*)(ws + WS_WRG) + (size_t)(256 * kq + 4 * kh) * 32 + (lane & 31);
#pragma unroll 8
            for (int j = 0; j < 32; ++j) {
                const v2u aw = *(const v2u*)(ap + 8 * j);
                const f32x4 a4 = (f32x4){__builtin_bit_cast(float, aw.x << 16), __builtin_bit_cast(float, aw.x & 0xffff0000u), __builtin_bit_cast(float, aw.y << 16), __builtin_bit_cast(float, aw.y & 0xffff0000u)};
#pragma unroll
                for (int e = 0; e < 4; ++e) acc = __builtin_amdgcn_mfma_f32_32x32x2f32(a4[e], wp[(size_t)(8 * j + e) * 32], acc, 0, 0, 0);
            }
#pragma unroll
            for (int r = 0; r < 16; ++r) part[((kq * 64) + tb * 32 + (r & 3) + 8 * (r >> 2) + 4 * kh) * 32 + (lane & 31)] = acc[r];
            __syncthreads();
            {
                const int tk = tid >> 3, e0 = (tid & 7) * 4; const float* sp = ssq2 + (size_t)(tok0 + tk) * 16; float a = 0.f;
#pragma unroll
                for (int j = 0; j < 4; ++j) { const f32x4 v = ((const f32x4*)sp)[j]; a += (v[0] + v[1]) + (v[2] + v[3]); }
                const float rs = 1.0f / sqrtf(a * (1.0f / 1024.0f) + 1e-6f);
                if (e0 == 0) ((float*)(ws + WS_ROUTE + RT_RSTD))[tok0 + tk] = rs;
#pragma unroll
                for (int e = 0; e < 4; ++e) lgt[tk * 33 + e0 + e] = rs * ((part[(0 * 64 + tk) * 32 + e0 + e] + part[(1 * 64 + tk) * 32 + e0 + e]) + (part[(2 * 64 + tk) * 32 + e0 + e] + part[(3 * 64 + tk) * 32 + e0 + e])) + b_router[e0 + e];
            }
            __syncthreads();
            if (tid < 64) {
                int c0 = -1, c1 = -1, c2 = -1, c3 = -1; float v0 = 0.f, v1 = 0.f, v2 = 0.f, v3 = 0.f; int s0 = 0, s1 = 0, s2 = 0, s3 = 0;
                for (int k = 0; k < 4; ++k) {
                    float best = -3.0e38f; int bi = 0;
                    for (int e = 0; e < 32; ++e) { const float v = lgt[tid * 33 + e]; if (e == c0 || e == c1 || e == c2 || e == c3) continue; if (v > best) { best = v; bi = e; } }
                    if (k == 0) { c0 = bi; v0 = best; } else if (k == 1) { c1 = bi; v1 = best; } else if (k == 2) { c2 = bi; v2 = best; } else { c3 = bi; v3 = best; }
                }
                const unsigned long long lt = (1ull << lane) - 1ull; int* cntc = (int*)(ws + WS_ROUTE + RT_CNT) + ch * 32;
                for (int e = 0; e < 32; ++e) {
                    const unsigned long long m0 = __ballot(c0 == e), m1 = __ballot(c1 == e), m2 = __ballot(c2 == e), m3 = __ballot(c3 == e);
                    const int before = __popcll(m0 & lt) + __popcll(m1 & lt) + __popcll(m2 & lt) + __popcll(m3 & lt);
                    if (c0 == e) s0 = before; if (c1 == e) s1 = before; if (c2 == e) s2 = before; if (c3 == e) s3 = before;
                    if (lane == e) cntc[e] = __popcll(m0) + __popcll(m1) + __popcll(m2) + __popcll(m3);
                }
                const int t = tok0 + tid;
                const float e1 = __expf(v1 - v0), e2 = __expf(v2 - v0), e3 = __expf(v3 - v0), inv = 1.0f / (1.0f + e1 + e2 + e3);
                *(int4*)(topi + t * 4) = make_int4(c0, c1, c2, c3);
                *(f32x4*)(topg + t * 4) = (f32x4){inv, e1 * inv, e2 * inv, e3 * inv};
                *(int4*)(tslot + t * 4) = make_int4(s0, s1, s2, s3);
            }
            __syncthreads();
        }
    }
    GRID_BAR(8);
    if (IN(9)) {
        const int* topi = (const int*)(ws + WS_ROUTE + RT_TOPI); const int* tslot = (const int*)(ws + WS_ROUTE + RT_SLOT); const int* cnt = (const int*)(ws + WS_ROUTE + RT_CNT);
        int* row_flat = (int*)(ws + WS_ROUTE + RT_ROWFLAT); float* rs_row = (float*)(ws + WS_ROUTE + RT_RSROW); const float* rstd2 = (const float*)(ws + WS_ROUTE + RT_RSTD);
        LAS int* red = (LAS int*)lds;
        for (int base = bx * 512; base < NA; base += G * 512) {
            const int chA = base >> 8, e = tid & 31, part = tid >> 5;
            int tot = 0, pa = 0, pb = 0;
            for (int c = part; c < T / 64; c += 16) { const int v = cnt[c * 32 + e]; tot += v; pa += c < chA ? v : 0; pb += c <= chA ? v : 0; }
            __syncthreads();
            red[(0 * 16 + part) * 32 + e] = tot; red[(1 * 16 + part) * 32 + e] = pa; red[(2 * 16 + part) * 32 + e] = pb;
            __syncthreads();
            if (tid < 96) { const int w = tid >> 5; int a = 0; for (int p = 0; p < 16; ++p) a += red[(w * 16 + p) * 32 + e]; red[1536 + w * 32 + e] = a; }
            __syncthreads();
            if (tid == 0) { int run = 0; for (int q = 0; q < NE; ++q) { red[1632 + q] = run; run += ((red[1536 + q] + 255) >> 8) << 8; } }
            if (bx == 0 && base == 0 && tid < 32) ((int*)(ws + WS_ROUTE + RT_TOT))[tid] = red[1536 + tid];
            __syncthreads();
            const int a = base + tid, ex = topi[a], row = red[1632 + ex] + red[1536 + 32 * (1 + (((a >> 8) - chA) & 1)) + ex] + tslot[a];
            row_flat[row] = a; rs_row[row] = rstd2[a >> 2]; ((float*)(ws + WS_ROUTE + RT_RGATE))[row] = ((const float*)(ws + WS_ROUTE + RT_TOPG))[a];
        }
    }
    GRID_BAR(9);
    if (IN(10) || IN(11)) {
        const int* gtot = (const int*)(ws + WS_ROUTE + RT_TOT); LAS int* texp = (LAS int*)(lds + LX_TEXP);
        __syncthreads();
        if (tid < 64) {
            const int n = tid < NE ? (gtot[tid] + 255) >> 8 : 0; int inc = n;
#pragma unroll
            for (int d = 1; d < 32; d <<= 1) { const int v = __shfl_up(inc, d); if ((tid & 63) >= d) inc += v; }
            const int start = inc - n;
            if (tid < NE) for (int j = 0; j < n; ++j) texp[start + j] = tid;
            if (tid == NE - 1) texp[NTILEN] = inc;
        }
        __syncthreads();
    }
    if (IN(10)) {
        int kx = 512; asm volatile("" : "+s"(kx));
        pg8::Gemm g{(const bf16_t*)(ws + WS_H2Q), WguT, kx, kx, kx}; OrderMoe S{(const LAS int*)(lds + LX_TEXP), 8, bx, G, (size_t)2048 * 1024};
        {
            const int* row_flat = (const int*)(ws + WS_ROUTE + RT_ROWFLAT); pg8::Unit u;
            int av[pg8::GTAB_UNITS];
#pragma unroll
            for (int i = 0; i < pg8::GTAB_UNITS; ++i) { av[i] = -2; if (S.next(i, u) && tid < 256) av[i] = row_flat[u.pm * 256 + tid]; }
#pragma unroll
            for (int i = 0; i < pg8::GTAB_UNITS; ++i) if (av[i] != -2) ((LAS unsigned short*)(lds + pg8::GTAB))[i * 256 + tid] = (unsigned short)(av[i] >= 0 ? (av[i] >> 2) : 0);
            __syncthreads();
        }
        EpiSwiGLU E{(const float*)(ws + WS_ROUTE + RT_RSROW), args.in[22], (unsigned char*)(ws + WS_HMID), (const LAS int*)(lds + LX_TEXP)};
        pg8::gemm_phase<EpiSwiGLU, OrderMoe, true, true, true, true>(lds, g, S, E);
    }
    GRID_BAR(10);
    if (IN(11)) {
        int kx = 512; asm volatile("" : "+s"(kx));
        pg8::Gemm g{(const bf16_t*)(ws + WS_HMID), WdT, kx, kx, kx}; OrderMoe S{(const LAS int*)(lds + LX_TEXP), 4, bx, G, (size_t)1024 * 1024};
        EpiDown E{(const int*)(ws + WS_ROUTE + RT_ROWFLAT), (const float*)(ws + WS_ROUTE + RT_RGATE), args.in[24], (unsigned char*)(ws + WS_YBUF), (const LAS int*)(lds + LX_TEXP)};
        pg8::gemm_phase<EpiDown, OrderMoe, true, true, false, true>(lds, g, S, E);
    }
    GRID_BAR(11);
    if (IN(12)) {
        const bf16_t* h2b = (const bf16_t*)(ws + WS_H2B); const unsigned char* ybuf = (const unsigned char*)(ws + WS_YBUF); const float* g_final = args.in[25]; float* outp = args.out;
        const int gw = vcu * NWAVES + wave, NGW = G * NWAVES;
        for (int t = gw; t < T; t += NGW) {
            f32x4 v[4]; float ss = 0.f;
#pragma unroll
            for (int j = 0; j < 4; ++j) {
                const v2u hw = *(const v2u*)(h2b + (size_t)t * 1024 + 256 * j + 4 * lane);
                f32x4 a = (f32x4){__builtin_bit_cast(float, hw.x << 16), __builtin_bit_cast(float, hw.x & 0xffff0000u), __builtin_bit_cast(float, hw.y << 16), __builtin_bit_cast(float, hw.y & 0xffff0000u)};
                f32x4 ys = {0.f, 0.f, 0.f, 0.f};
#pragma unroll
                for (int k = 0; k < 4; ++k) { const int y = *(const int*)(ybuf + ((size_t)t * 4 + k) * 1024 + 256 * j + 4 * lane);
                    const f32x2_t lo = __builtin_amdgcn_cvt_pk_f32_fp8(y, false), hi2 = __builtin_amdgcn_cvt_pk_f32_fp8(y, true);
                    ys[0] += lo[0]; ys[1] += lo[1]; ys[2] += hi2[0]; ys[3] += hi2[1]; }
                a = a + ys * Y8_INV;
                v[j] = a; ss += (a[0] * a[0] + a[1] * a[1]) + (a[2] * a[2] + a[3] * a[3]);
            }
            ss = wave_sum(ss); const float rs = 1.0f / sqrtf(ss * (1.0f / 1024.0f) + 1e-6f);
#pragma unroll
            for (int j = 0; j < 4; ++j) *(f32x4*)(outp + (size_t)t * 1024 + 256 * j + 4 * lane) = v[j] * rs * *(const f32x4*)(g_final + 256 * j + 4 * lane);
        }
    }
#undef GRID_BAR
#undef BOTH
#undef IN
}

}
void launch_mk(hipStream_t st, const mk::Args& base, int lo, int hi, int grid) {
    mk::Args a = base; a.ph_lo = lo; a.ph_hi = hi;
    hipLaunchKernelGGL(mk::mk_fwd, dim3(grid), dim3(mk::NWAVES * 64), mk::LDS_BYTES, st, a);
}
}

extern "C" void kernel_launch(void* const* d_in, const int* in_sizes, int n_in, void* d_out, int out_size, void* d_ws, size_t ws_size, hipStream_t stream) {
    static int grid = 0;
    if (grid == 0) {
        int dev = 0, cus = 0;
        if (hipGetDevice(&dev) != hipSuccess || hipDeviceGetAttribute(&cus, hipDeviceAttributeMultiprocessorCount, dev) != hipSuccess) { grid = -1; return; }
        if (hipFuncSetAttribute((const void*)mk::mk_fwd, hipFuncAttributeMaxDynamicSharedMemorySize, mk::LDS_BYTES) != hipSuccess) { grid = -1; return; }
        grid = cus >= 256 ? 256 : cus;
    }
    if (grid < 0) return;
    const float* x = (const float*)d_in[0];
    const float* mem = (const float*)d_in[1];
    const int* pos = (const int*)d_in[2];
    const float* g_q_a = (const float*)d_in[5];
    const float* w_q_b = (const float*)d_in[6];
    const float* g_kv_a = (const float*)d_in[7];
    const float* w_kv_b = (const float*)d_in[8];
    const float* rel_bias = (const float*)d_in[9];
    const float* g_out_a = (const float*)d_in[10];
    const float* g_out_b = (const float*)d_in[11];
    const float* w_o = (const float*)d_in[12];
    const float* g_xattn = (const float*)d_in[13];
    const float* g_mem = (const float*)d_in[14];
    const float* w_mq = (const float*)d_in[15];
    const float* w_mkv = (const float*)d_in[16];
    const float* w_mo = (const float*)d_in[17];
    const float* g_moe = (const float*)d_in[18];
    const float* w_router = (const float*)d_in[19];
    const float* b_router = (const float*)d_in[20];
    const float* w_gate_up = (const float*)d_in[21];
    const float* b_gate_up = (const float*)d_in[22];
    const float* w_down = (const float*)d_in[23];
    const float* b_down = (const float*)d_in[24];
    const float* g_final = (const float*)d_in[25];
    float* out = (float*)d_out;
    (void)ws_size; (void)in_sizes; (void)n_in; (void)out_size;

    (void)hipMemsetAsync((char*)d_ws + mk::WS_CTL, 0, mk::CTL_ZERO_BYTES, stream);
    mk::Args ma; memset(&ma, 0, sizeof(ma));
    for (int i = 0; i < 26; ++i) ma.in[i] = (const float*)d_in[i];
    ma.out = out; ma.ws = (unsigned char*)d_ws; ma.flags = 1;
    for (int j = 0; j < 16; ++j) ma.rope_rev[j] = pow(10000.0, -(double)j / 16.0) / 6.283185307179586476925287;
#ifndef MK_N_LAUNCHES
#define MK_N_LAUNCHES 1
#endif
    if (MK_N_LAUNCHES == 1) launch_mk(stream, ma, 0, 13, grid);
    else for (int p = 0; p < 13; ++p) launch_mk(stream, ma, p, p + 1, grid);
#ifdef PROBE_MASK
#ifdef PROBE_FLAGS
    ma.flags |= PROBE_FLAGS;
#endif
    for (int r = 0; r < PROBE_N; ++r) for (int p = 0; p < 13; ++p) if ((PROBE_MASK >> p) & 1) launch_mk(stream, ma, p, p + 1, grid);
#endif
}
```
